# Optimizing an MI355X kernel written in HIP

```python
import math
import jax
import jax.numpy as jnp
from jax import lax
import numpy as np


D_MODEL = 1024
BATCH = 2
SEQ = 16384
DEPTH = 2

GRID_W = 64
CTX_LEN = 256
BRANCH_W = D_MODEL // 2
N_BRANCH = 3
EPS = 1e-6
GLA_HEADS = 4
GLA_DV = BRANCH_W // GLA_HEADS
GLA_DK = GLA_DV // 2
GLA_KW = GLA_HEADS * GLA_DK
GLA_VW = GLA_HEADS * GLA_DV
GLA_RANK = 16
GLA_GATE_NORM = 16.0
GLA_CHUNK = 64
ATTN_HD = 64
ATTN_HEADS = BRANCH_W // ATTN_HD
ATTN_KV_HEADS = ATTN_HEADS // 4
ATTN_GROUP = ATTN_HEADS // ATTN_KV_HEADS
ATTN_QW = ATTN_HEADS * ATTN_HD
ATTN_KVW = ATTN_KV_HEADS * ATTN_HD
Q_BLOCK = 128
ROPE_THETA = 10000.0
HY_W = BRANCH_W
HY_ORDER = 2
HY_EMB = 33
HY_BANDS = (HY_EMB - 1) // 2
HY_FFN = 64
HY_SHORT = 3
HY_MOD_SHIFT = 0.05
HY_DECAY_SHORT_PCT = 0.3
HY_DECAY_LONG_PCT = 1.5
HY_DECAY_TARGET = 1e-2
N_FILT = 2 * HY_ORDER * HY_W
SPLITS = (GLA_KW, GLA_KW, GLA_VW, GLA_VW, GLA_RANK, GLA_RANK,
          ATTN_QW, ATTN_KVW, ATTN_KVW, ATTN_QW,
          (HY_ORDER + 1) * HY_W, HY_W,
          N_BRANCH * D_MODEL)
N_IN = sum(SPLITS)

kernel_name = "hybrid_gla_gqa_hyena_prefix_dit"


def rms_norm(a):
    af = a.astype(jnp.float32)
    return (af * lax.rsqrt(jnp.mean(af * af, axis=-1, keepdims=True) + EPS)).astype(a.dtype)


def heads(a, n):
    return a.reshape(a.shape[:-1] + (n, a.shape[-1] // n))


def rev(a):
    return a[:, ::-1]


def split_proj(p):
    idx = [int(i) for i in np.cumsum(SPLITS)[:-1]]
    return jnp.split(p, idx, axis=-1)


def axial_rope_angles(L):
    t = jnp.arange(L)
    row = (t // GRID_W).astype(jnp.float32)
    col = (t % GRID_W).astype(jnp.float32)
    half = ATTN_HD // 2
    inv = ROPE_THETA ** (-jnp.arange(0, half, 2, dtype=jnp.float32) / half)
    return jnp.concatenate([row[:, None] * inv, col[:, None] * inv], axis=-1)


def apply_rope(a, ang):
    af = a.astype(jnp.float32).reshape(a.shape[:-1] + (ATTN_HD // 2, 2))
    cos = jnp.cos(ang)[None, :, None, :]
    sin = jnp.sin(ang)[None, :, None, :]
    a0, a1 = af[..., 0], af[..., 1]
    out = jnp.stack([a0 * cos - a1 * sin, a0 * sin + a1 * cos], axis=-1)
    return out.reshape(a.shape).astype(a.dtype)


def gla_decays(af, ab, wa_f, ba_f, wa_b, ba_b):
    gf = jax.nn.log_sigmoid((af @ wa_f + ba_f).astype(jnp.float32)) / GLA_GATE_NORM
    gb = jax.nn.log_sigmoid((ab @ wa_b + ba_b).astype(jnp.float32)) / GLA_GATE_NORM
    return heads(gf, GLA_HEADS), heads(gb, GLA_HEADS)


def gla_scan(q, k, v, g, s0):
    b_, L, H, _ = q.shape
    dv = v.shape[-1]
    nc = L // GLA_CHUNK

    def chunks(a):
        return a.reshape(b_, nc, GLA_CHUNK, H, a.shape[-1]).transpose(1, 0, 3, 2, 4)

    mask = jnp.tril(jnp.ones((GLA_CHUNK, GLA_CHUNK), dtype=bool))[:, :, None]

    def step(s, inp):
        qc, kc, vc, gc = inp
        bcum = jnp.cumsum(gc, axis=2)
        blast = bcum[:, :, -1:, :]
        diff = bcum[:, :, :, None, :] - bcum[:, :, None, :, :]
        decay = jnp.exp(jnp.where(mask, diff, -jnp.inf))
        att = jnp.einsum('bhid,bhjd,bhijd->bhij', qc, kc, decay)
        o = (jnp.einsum('bhij,bhjv->bhiv', att, vc)
             + jnp.einsum('bhid,bhdv->bhiv', qc * jnp.exp(bcum), s))
        s_new = (jnp.exp(blast[:, :, 0, :])[..., None] * s
                 + jnp.einsum('bhjd,bhjv->bhdv', kc * jnp.exp(blast - bcum), vc))
        return s_new, o

    s_fin, o = lax.scan(step, s0, (chunks(q), chunks(k), chunks(v), chunks(g)))
    o = o.transpose(1, 0, 3, 2, 4).reshape(b_, L, H, dv)
    return o, s_fin


def gla_final_state(k, v, g):
    bcum = jnp.cumsum(g, axis=1)
    w = jnp.exp(bcum[:, -1:] - bcum)
    return jnp.einsum('blhd,blhv->bhdv', k * w, v)


def gla_out(o, norm_w, z):
    o = rms_norm(o) * norm_w.astype(jnp.float32)
    return o.reshape(o.shape[:2] + (GLA_VW,)).astype(z.dtype) * jax.nn.silu(z)


def attend(qg, keys, vals):
    s = jnp.einsum('bqgrd,bkgd->bgrqk', qg, keys).astype(jnp.float32) * (ATTN_HD ** -0.5)
    p = jax.nn.softmax(s, axis=-1).astype(vals.dtype)
    return jnp.einsum('bgrqk,bkgd->bqgrd', p, vals)


def attn_latent(q, k, v, k_ctx, v_ctx):
    b_, L = q.shape[0], q.shape[1]
    nb = L // Q_BLOCK
    keys = jnp.concatenate([k, k_ctx], axis=1)
    vals = jnp.concatenate([v, v_ctx], axis=1)
    qb = q.reshape(b_, nb, Q_BLOCK, ATTN_KV_HEADS, ATTN_GROUP, ATTN_HD).transpose(1, 0, 2, 3, 4, 5)
    o = lax.map(lambda qblk: attend(qblk, keys, vals), qb)
    return o.transpose(1, 0, 2, 3, 4, 5).reshape(b_, L, ATTN_QW)


def qk_norm(a, gain):
    return rms_norm(a) * gain


def short_conv(u, w, bias):
    L = u.shape[1]
    pad = HY_SHORT // 2
    up = jnp.pad(u, ((0, 0), (pad, pad), (0, 0)))
    out = bias
    for i in range(HY_SHORT):
        out = out + up[:, i:i + L] * w[i]
    return out


def hyena_filters(L, f1_w, f1_b, f1_freq, f2_w, f2_b, f2_freq, f3_w):
    f32 = jnp.float32
    t = jnp.linspace(0.0, 1.0, L, dtype=f32)[:, None]
    w = 2.0 * math.pi * jnp.arange(L, dtype=f32)[:, None] / L
    fr = jnp.linspace(1e-4, HY_BANDS - 1, HY_BANDS, dtype=f32)[None]
    emb = jnp.concatenate([t, jnp.cos(fr * w), -jnp.sin(fr * w)], axis=-1)
    h = jnp.sin(f1_freq.astype(f32) * (emb @ f1_w.astype(f32) + f1_b.astype(f32)))
    h = jnp.sin(f2_freq.astype(f32) * (h @ f2_w.astype(f32) + f2_b.astype(f32)))
    h = h @ f3_w.astype(f32)
    deltas = jnp.abs(jnp.linspace(math.log(HY_DECAY_TARGET) / HY_DECAY_SHORT_PCT,
                                  math.log(HY_DECAY_TARGET) / HY_DECAY_LONG_PCT, N_FILT, dtype=f32))
    h = h * (jnp.exp(-t * deltas) + HY_MOD_SHIFT)
    h = h / jnp.sum(jnp.abs(h), axis=0, keepdims=True)
    return h.reshape(L, HY_ORDER, 2, HY_W)


def bidir_long_conv(z, hf, hb):
    L = z.shape[1]
    filt = jnp.concatenate([hf, jnp.zeros_like(hf[:1]), hb[:0:-1]], axis=0)
    ff = jnp.fft.rfft(filt, axis=0)
    zf = jnp.fft.rfft(z, n=2 * L, axis=1)
    return jnp.fft.irfft(zf * ff[None], n=2 * L, axis=1)[:, :L]


def hyena_mix(u, conv_w, conv_b, f1_w, f1_b, f1_freq, f2_w, f2_b, f2_freq, f3_w, skip):
    L = u.shape[1]
    u = short_conv(u, conv_w, conv_b)
    v, x1, x2 = jnp.split(u, HY_ORDER + 1, axis=-1)
    h = hyena_filters(L, f1_w, f1_b, f1_freq, f2_w, f2_b, f2_freq, f3_w)
    z = v.astype(jnp.float32)
    for o, gt in enumerate((x1, x2)):
        z = gt.astype(jnp.float32) * (bidir_long_conv(z, h[:, o, 0], h[:, o, 1])
                                      + skip[o].astype(jnp.float32) * z)
    return z.astype(u.dtype)


def merge_branches(y_gla, y_attn, y_hy, mg, w_g, w_a, w_h, w_o):
    m = jax.nn.sigmoid(mg.astype(jnp.float32)).astype(y_gla.dtype)
    m_g, m_a, m_h = jnp.split(m, N_BRANCH, axis=-1)
    y = m_g * (y_gla @ w_g) + m_a * (y_attn @ w_a) + m_h * (y_hy @ w_h)
    return y @ w_o


def setup_inputs(seed: int = 0) -> dict:
    key = jax.random.key(seed)
    ks = jax.random.split(key, 32)
    f32 = jnp.float32
    D = D_MODEL

    def nrm(k, shape, scale):
        return scale * jax.random.normal(k, shape, f32)

    return {
        'x': nrm(ks[0], (BATCH, SEQ, D), 1.0),
        'c': nrm(ks[1], (BATCH, D), 1.0),
        'ctx': nrm(ks[2], (BATCH, CTX_LEN, D), 1.0),
        'c_ctx': nrm(ks[3], (D,), 1.0),
        'w_ada': nrm(ks[4], (DEPTH, D, 3 * D), 0.5 * D ** -0.5),
        'b_ada': nrm(ks[5], (DEPTH, 3 * D), 0.02),
        'w_in': nrm(ks[6], (DEPTH, D, N_IN), D ** -0.5),
        'gla_wa_f': nrm(ks[7], (DEPTH, GLA_RANK, GLA_KW), GLA_RANK ** -0.5),
        'gla_ba_f': nrm(ks[8], (DEPTH, GLA_KW), 0.1),
        'gla_wa_b': nrm(ks[9], (DEPTH, GLA_RANK, GLA_KW), GLA_RANK ** -0.5),
        'gla_ba_b': nrm(ks[10], (DEPTH, GLA_KW), 0.1),
        'gla_norm': 1.0 + nrm(ks[11], (DEPTH, GLA_DV), 0.02),
        'attn_qnorm': 1.0 + nrm(ks[12], (DEPTH, ATTN_HD), 0.02),
        'attn_knorm': 1.0 + nrm(ks[13], (DEPTH, ATTN_HD), 0.02),
        'hy_conv_w': nrm(ks[14], (DEPTH, HY_SHORT, (HY_ORDER + 1) * HY_W), HY_SHORT ** -0.5),
        'hy_conv_b': nrm(ks[15], (DEPTH, (HY_ORDER + 1) * HY_W), 0.02),
        'hy_f1_w': nrm(ks[16], (DEPTH, HY_EMB, HY_FFN), HY_EMB ** -0.5),
        'hy_f1_b': nrm(ks[17], (DEPTH, HY_FFN), 0.1),
        'hy_f1_freq': 1.0 + nrm(ks[18], (DEPTH, HY_FFN), 0.02),
        'hy_f2_w': nrm(ks[19], (DEPTH, HY_FFN, HY_FFN), HY_FFN ** -0.5),
        'hy_f2_b': nrm(ks[20], (DEPTH, HY_FFN), 0.1),
        'hy_f2_freq': 1.0 + nrm(ks[21], (DEPTH, HY_FFN), 0.02),
        'hy_f3_w': nrm(ks[22], (DEPTH, HY_FFN, N_FILT), HY_FFN ** -0.5),
        'hy_skip': nrm(ks[23], (DEPTH, HY_ORDER, HY_W), 0.5),
        'w_br_gla': nrm(ks[24], (DEPTH, BRANCH_W, D), BRANCH_W ** -0.5),
        'w_br_attn': nrm(ks[25], (DEPTH, BRANCH_W, D), BRANCH_W ** -0.5),
        'w_br_hy': nrm(ks[26], (DEPTH, BRANCH_W, D), BRANCH_W ** -0.5),
        'w_out': nrm(ks[27], (DEPTH, D, D), D ** -0.5),
        'final_norm': 1.0 + nrm(ks[28], (D,), 0.02),
    }


def reference(x, c, ctx, c_ctx, w_ada, b_ada, w_in, gla_wa_f, gla_ba_f, gla_wa_b, gla_ba_b,
              gla_norm, attn_qnorm, attn_knorm, hy_conv_w, hy_conv_b, hy_f1_w, hy_f1_b,
              hy_f1_freq, hy_f2_w, hy_f2_b, hy_f2_freq, hy_f3_w, hy_skip, w_br_gla, w_br_attn,
              w_br_hy, w_out, final_norm):
    b_ = x.shape[0]
    L = x.shape[1]
    Lc = ctx.shape[1]
    ang = axial_rope_angles(L)
    s_lat = jax.nn.silu(c)
    s_ctx = jax.nn.silu(c_ctx)
    zero_state = jnp.zeros((b_, GLA_HEADS, GLA_DK, GLA_DV), jnp.float32)
    gla_scale = GLA_DK ** -0.5

    for l in range(DEPTH):
        need_ctx = l < DEPTH - 1
        shift, scale, gate = jnp.split(s_lat @ w_ada[l] + b_ada[l], 3, axis=-1)
        shift_c, scale_c, gate_c = jnp.split(s_ctx @ w_ada[l] + b_ada[l], 3, axis=-1)
        h = rms_norm(x) * (1.0 + scale[:, None]) + shift[:, None]
        hc = rms_norm(ctx) * (1.0 + scale_c) + shift_c
        (g_q, g_k, g_v, g_z, g_af, g_ab, a_q, a_k, a_v, a_z, y_u, y_z, m_lat) = split_proj(h @ w_in[l])
        (gc_q, gc_k, gc_v, gc_z, gc_af, gc_ab, ac_q, ac_k, ac_v, ac_z, yc_u, yc_z, m_ctx) = split_proj(hc @ w_in[l])
        gla_p = (gla_wa_f[l], gla_ba_f[l], gla_wa_b[l], gla_ba_b[l])
        hy_p = (hy_conv_w[l], hy_conv_b[l], hy_f1_w[l], hy_f1_b[l], hy_f1_freq[l],
                hy_f2_w[l], hy_f2_b[l], hy_f2_freq[l], hy_f3_w[l], hy_skip[l])

        k, v = heads(g_k, GLA_HEADS), heads(g_v, GLA_HEADS)
        q = heads(g_q, GLA_HEADS) * gla_scale
        gf, gb = gla_decays(g_af, g_ab, *gla_p)
        kc, vc = heads(gc_k, GLA_HEADS), heads(gc_v, GLA_HEADS)
        gfc, gbc = gla_decays(gc_af, gc_ab, *gla_p)
        if need_ctx:
            qc = heads(gc_q, GLA_HEADS) * gla_scale
            oc_f, sc_f = gla_scan(qc, kc, vc, gfc, zero_state)
            oc_b, sc_b = gla_scan(rev(qc), rev(kc), rev(vc), rev(gbc), zero_state)
            yc_gla = gla_out(oc_f + rev(oc_b), gla_norm[l], gc_z)
        else:
            sc_f = gla_final_state(kc, vc, gfc)
            sc_b = gla_final_state(rev(kc), rev(vc), rev(gbc))
        o_f, _ = gla_scan(q, k, v, gf, sc_f)
        o_b, _ = gla_scan(rev(q), rev(k), rev(v), rev(gb), sc_b)
        y_gla = gla_out(o_f + rev(o_b), gla_norm[l], g_z)

        kc_a = qk_norm(heads(ac_k, ATTN_KV_HEADS), attn_knorm[l])
        vc_a = heads(ac_v, ATTN_KV_HEADS)
        q_a = apply_rope(qk_norm(heads(a_q, ATTN_HEADS), attn_qnorm[l]), ang)
        k_a = apply_rope(qk_norm(heads(a_k, ATTN_KV_HEADS), attn_knorm[l]), ang)
        y_attn = attn_latent(q_a, k_a, heads(a_v, ATTN_KV_HEADS), kc_a, vc_a) * jax.nn.silu(a_z)

        y_hy = hyena_mix(y_u, *hy_p) * jax.nn.silu(y_z)

        out = merge_branches(y_gla, y_attn, y_hy, m_lat, w_br_gla[l], w_br_attn[l], w_br_hy[l], w_out[l])
        x_new = x + gate[:, None] * out

        if need_ctx:
            qc_a = qk_norm(heads(ac_q, ATTN_HEADS), attn_qnorm[l])
            qc_g = qc_a.reshape(b_, Lc, ATTN_KV_HEADS, ATTN_GROUP, ATTN_HD)
            yc_attn = attend(qc_g, kc_a, vc_a).reshape(b_, Lc, ATTN_QW) * jax.nn.silu(ac_z)
            yc_hy = hyena_mix(yc_u, *hy_p) * jax.nn.silu(yc_z)
            out_c = merge_branches(yc_gla, yc_attn, yc_hy, m_ctx, w_br_gla[l], w_br_attn[l], w_br_hy[l], w_out[l])
            ctx = ctx + gate_c * out_c
        x = x_new

    return rms_norm(x) * final_norm
```

```cpp
#include <hip/hip_runtime.h>
#include <hip/hip_cooperative_groups.h>
#include <cstdio>
namespace cg = cooperative_groups;

typedef unsigned short u16;
typedef __attribute__((ext_vector_type(8))) short bf16x8;
typedef __attribute__((ext_vector_type(16))) float f32x16;
typedef __attribute__((ext_vector_type(4))) unsigned u32x4;
typedef __attribute__((ext_vector_type(2))) unsigned u32x2;
#define DI __device__ __forceinline__
#define MFMA(a, b, c) __builtin_amdgcn_mfma_f32_32x32x16_bf16((a), (b), (c), 0, 0, 0)

#ifndef MULTI_LAUNCH
#define MULTI_LAUNCH 0
#endif

constexpr int D = 1024, NBATCH = 2, L = 16384, LC = 256, TB = L + LC, R = NBATCH * TB;
constexpr int NIN = 7968;
constexpr int NP = 2208;
constexpr int NCH = 2688;
constexpr int PC_GQ = 0, PC_GK = 256, PC_GZ = 512, PC_AF = 1024, PC_AQ = 1056, PC_AK = 1568, PC_AZ = 1696;
constexpr int CH_YU = 0, CH_YZ = 1536, CH_GV = 2048, CH_AV = 2560;
constexpr int NCK = 260;
constexpr float EPS = 1e-6f;
constexpr int NT = 512;
constexpr int LDT = 72;

constexpr size_t OFF_P = 0;
constexpr size_t OFF_CT = OFF_P + (size_t)R * NP * 2;
constexpr size_t OFF_H = OFF_CT + (size_t)NCH * 2 * TB * 2;
constexpr size_t OFF_FS = OFF_H + (size_t)R * 1024 * 2;
constexpr size_t OFF_WT = OFF_FS + (size_t)256 * 262144;
constexpr size_t WT_IN = (size_t)NIN * 1024 * 2, WT_BR = (size_t)1024 * 512 * 2, WT_OUT = (size_t)1024 * 1024 * 2;
constexpr size_t WT_LAYER = WT_IN + 3 * WT_BR + WT_OUT;
constexpr size_t OFF_H2T = OFF_WT + 2 * WT_LAYER;
constexpr size_t OFF_H2C = OFF_H2T + (size_t)2 * 64 * L * 4;
constexpr size_t OFF_MOD = OFF_H2C + (size_t)2 * 256 * 64 * 4;
constexpr size_t OFF_CTX1 = OFF_MOD + (size_t)2 * 3 * 3072 * 4;
constexpr size_t OFF_GD = OFF_CTX1 + (size_t)512 * 1024 * 4;
constexpr size_t OFF_PK = OFF_GD + (size_t)16 * NCK * 64 * 4;
constexpr int PK_WAF = 0, PK_BAF = 8192, PK_WAB = 8704, PK_BAB = 16896, PK_GN = 17408, PK_QN = 17664, PK_KN = 17792, PK_CW = 17920,
              PK_CB = 27136, PK_SK = 30208, PK_FN = 32256, PK_F3 = 33280, PK_END = 33280 + 262144;
constexpr size_t WS_END = OFF_PK + (size_t)PK_END * 4;
constexpr size_t OFF_GS = OFF_CT;
constexpr size_t OFF_Y = OFF_CT;
static_assert((size_t)16 * NCK * 8192 * 2 <= (size_t)1536 * 2 * TB * 2, "alias");
static_assert((size_t)R * 1024 * 2 <= (size_t)1536 * 2 * TB * 2, "alias");

constexpr int LDS_BYTES = 131072 + 512;

struct Params {
  const float *x, *c, *ctx, *c_ctx, *w_ada, *b_ada, *w_in, *wa_f, *ba_f, *wa_b, *ba_b, *gla_norm, *qnorm, *knorm,
      *conv_w, *conv_b, *f1_w, *f1_b, *f1_freq, *f2_w, *f2_b, *f2_freq, *f3_w, *skip, *w_g, *w_a, *w_h, *w_o, *final_norm;
  float* out;
  char* ws;
  long long phase_lo, phase_hi;
};

DI u16 f2bf(float x) { unsigned u = __float_as_uint(x); u += 0x7fffu + ((u >> 16) & 1u); return (u16)(u >> 16); }
DI float bf2f(u16 v) { return __uint_as_float(((unsigned)v) << 16); }
DI unsigned pack2(float a, float b) { return (unsigned)f2bf(a) | ((unsigned)f2bf(b) << 16); }
DI float bflo(unsigned u) { return __uint_as_float(u << 16); }
DI float bfhi(unsigned u) { return __uint_as_float(u & 0xffff0000u); }
DI float silu_f(float x) { return x / (1.f + __expf(-x)); }
DI float wave_sum(float v) {
#pragma unroll
  for (int o = 32; o >= 1; o >>= 1) v += __shfl_xor(v, o);
  return v;
}
DI int crow(int reg, int h) { return (reg & 3) + 8 * (reg >> 2) + 4 * h; }
DI f32x16 zero16() { f32x16 z; for (int i = 0; i < 16; ++i) z[i] = 0.f; return z; }
DI bf16x8 pack8(const f32x16& x, int s) {
  u32x4 u;
  u.x = pack2(x[8 * s + 0], x[8 * s + 1]); u.y = pack2(x[8 * s + 2], x[8 * s + 3]);
  u.z = pack2(x[8 * s + 4], x[8 * s + 5]); u.w = pack2(x[8 * s + 6], x[8 * s + 7]);
  return __builtin_bit_cast(bf16x8, u);
}
DI bf16x8 ld2x64(const u16* p0, const u16* p1) {
  u32x2 a = *(const u32x2*)p0, b = *(const u32x2*)p1;
  u32x4 u; u.x = a.x; u.y = a.y; u.z = b.x; u.w = b.y;
  return __builtin_bit_cast(bf16x8, u);
}
DI float2 cmul(float2 a, float2 b) { return make_float2(a.x * b.x - a.y * b.y, a.x * b.y + a.y * b.x); }
DI float2 cadd(float2 a, float2 b) { return make_float2(a.x + b.x, a.y + b.y); }
DI float2 csub(float2 a, float2 b) { return make_float2(a.x - b.x, a.y - b.y); }

DI const float* xrow_in(const Params& p, int layer, int row) {
  int b = row / TB, tk = row - b * TB;
  if (tk < LC) return (layer == 0 ? p.ctx : (const float*)(p.ws + OFF_CTX1)) + (size_t)(b * LC + tk) * D;
  return (layer == 0 ? p.x : (const float*)p.out) + (size_t)(b * L + tk - LC) * D;
}
DI float* xrow_out(const Params& p, int row) {
  int b = row / TB, tk = row - b * TB;
  if (tk < LC) return (float*)(p.ws + OFF_CTX1) + (size_t)(b * LC + tk) * D;
  return p.out + (size_t)(b * L + tk - LC) * D;
}
DI const float* pk(const Params& p, int off) { return (const float*)(p.ws + OFF_PK) + off; }
DI int modvec_of(int row) { int b = row / TB, tk = row - b * TB; return tk < LC ? 2 : b; }

struct ALoadN {
  const u16* A; int lda;
  template <int BM> DI void fetch(u32x4 (&r)[BM / 64], int k0, int tid) const {
#pragma unroll
    for (int i = 0; i < BM / 64; ++i) { int q = tid + NT * i; r[i] = *(const u32x4*)(A + (size_t)(q >> 3) * lda + k0 + (q & 7) * 8); }
  }
  template <int BM> DI void commit(const u32x4 (&r)[BM / 64], u16* As, int tid) const {
#pragma unroll
    for (int i = 0; i < BM / 64; ++i) { int q = tid + NT * i; *(u32x4*)(As + (q >> 3) * LDT + (q & 7) * 8) = r[i]; }
  }
};
struct ALoadT {
  const u16* A; size_t chs;
  template <int BM> DI void fetch(u32x4 (&r)[BM / 64], int k0, int tid) const {
#pragma unroll
    for (int i = 0; i < 2; ++i) { int q = tid + NT * i; r[i] = *(const u32x4*)(A + (size_t)(k0 + (q >> 4)) * chs + (q & 15) * 8); }
  }
  template <int BM> DI void commit(const u32x4 (&r)[BM / 64], u16* As, int tid) const {
#pragma unroll
    for (int i = 0; i < 2; ++i) {
      int q = tid + NT * i; int ch = q >> 4, t0 = (q & 15) * 8;
      unsigned w[4] = {r[i].x, r[i].y, r[i].z, r[i].w};
#pragma unroll
      for (int e = 0; e < 4; ++e) { As[(t0 + 2 * e) * LDT + ch] = (u16)(w[e] & 0xffffu); As[(t0 + 2 * e + 1) * LDT + ch] = (u16)(w[e] >> 16); }
    }
  }
};

template <int BM, class AL, int KSU = 4>
DI void gemm_tile(const AL& al, const u16* __restrict__ Bt, int ldb, int K, char* smem, f32x16 (&acc)[BM / 128][2]) {
  u16* As = (u16*)smem;
  u16* Bs = As + 2 * BM * LDT;
  const int tid = threadIdx.x, lane = tid & 63, wid = tid >> 6, r = lane & 31, h = lane >> 5;
  const int wm = wid & 3, wn = wid >> 2;
  u32x4 ra[BM / 64], rb[2];
  const int KT = K >> 6;
  al.template fetch<BM>(ra, 0, tid);
#pragma unroll
  for (int i = 0; i < 2; ++i) { int q = tid + NT * i; rb[i] = *(const u32x4*)(Bt + (size_t)(q >> 3) * ldb + (q & 7) * 8); }
  __syncthreads();
  al.template commit<BM>(ra, As, tid);
#pragma unroll
  for (int i = 0; i < 2; ++i) { int q = tid + NT * i; *(u32x4*)(Bs + (q >> 3) * LDT + (q & 7) * 8) = rb[i]; }
  __syncthreads();
  for (int kt = 0; kt < KT; ++kt) {
    const int cur = kt & 1;
    if (kt + 1 < KT) {
      al.template fetch<BM>(ra, (kt + 1) * 64, tid);
#pragma unroll
      for (int i = 0; i < 2; ++i) { int q = tid + NT * i; rb[i] = *(const u32x4*)(Bt + (size_t)(q >> 3) * ldb + (kt + 1) * 64 + (q & 7) * 8); }
    }
    const u16* Ac = As + cur * BM * LDT;
    const u16* Bc = Bs + cur * 128 * LDT;
#pragma unroll KSU
    for (int ks = 0; ks < 4; ++ks) {
      bf16x8 a[BM / 128], b[2];
#pragma unroll
      for (int i = 0; i < BM / 128; ++i) a[i] = *(const bf16x8*)(Ac + (wm * (BM / 4) + i * 32 + r) * LDT + ks * 16 + h * 8);
#pragma unroll
      for (int j = 0; j < 2; ++j) b[j] = *(const bf16x8*)(Bc + (wn * 64 + j * 32 + r) * LDT + ks * 16 + h * 8);
#pragma unroll
      for (int i = 0; i < BM / 128; ++i)
#pragma unroll
        for (int j = 0; j < 2; ++j) acc[i][j] = MFMA(a[i], b[j], acc[i][j]);
    }
    if (kt + 1 < KT) {
      al.template commit<BM>(ra, As + (cur ^ 1) * BM * LDT, tid);
#pragma unroll
      for (int i = 0; i < 2; ++i) { int q = tid + NT * i; *(u32x4*)(Bs + (cur ^ 1) * 128 * LDT + (q >> 3) * LDT + (q & 7) * 8) = rb[i]; }
    }
    __syncthreads();
  }
}

DI void phase0(const Params& p, char* smem) {
  const int tid = threadIdx.x, lane = tid & 63, wid = tid >> 6, bid = blockIdx.x, nb = gridDim.x;
  float* sm = (float*)smem;
  {
    float* PKW = (float*)(p.ws + OFF_PK);
    const int gt = bid * NT + tid, gn = nb * NT;
#define PKCP(src, off, cnt) for (int i = gt; i < (cnt); i += gn) PKW[(off) + i] = (src)[i];
    PKCP(p.wa_f, PK_WAF, 8192) PKCP(p.ba_f, PK_BAF, 512) PKCP(p.wa_b, PK_WAB, 8192) PKCP(p.ba_b, PK_BAB, 512)
    PKCP(p.gla_norm, PK_GN, 256) PKCP(p.qnorm, PK_QN, 128) PKCP(p.knorm, PK_KN, 128) PKCP(p.conv_w, PK_CW, 9216)
    PKCP(p.conv_b, PK_CB, 3072) PKCP(p.skip, PK_SK, 2048) PKCP(p.final_norm, PK_FN, 1024) PKCP(p.f3_w, PK_F3, 262144)
#undef PKCP
  }
  float* mod = (float*)(p.ws + OFF_MOD);
  for (int task = bid; task < 96; task += nb) {
    const int l = task / 48, cb = task % 48, col = cb * 64 + lane;
    const float* W = p.w_ada + (size_t)l * 1024 * 3072;
    float a0 = 0.f, a1 = 0.f, a2 = 0.f;
#pragma unroll 8
    for (int k = wid * 128; k < wid * 128 + 128; ++k) {
      float wv = W[(size_t)k * 3072 + col];
      a0 += silu_f(p.c[k]) * wv; a1 += silu_f(p.c[1024 + k]) * wv; a2 += silu_f(p.c_ctx[k]) * wv;
    }
    __syncthreads();
    sm[(wid * 3 + 0) * 64 + lane] = a0; sm[(wid * 3 + 1) * 64 + lane] = a1; sm[(wid * 3 + 2) * 64 + lane] = a2;
    __syncthreads();
    if (tid < 192) {
      int v = tid >> 6; float s = p.b_ada[l * 3072 + col];
      for (int w = 0; w < 8; ++w) s += sm[(w * 3 + v) * 64 + lane];
      mod[(l * 3 + v) * 3072 + col] = s;
    }
    __syncthreads();
  }
  for (int it = bid; it < (2 * TB) / 8; it += nb) {
    const int gr = it * 8 + wid, l = gr / TB, rr = gr - l * TB;
    const bool lat = rr < L; const int t = lat ? rr : rr - L; const int Lq = lat ? L : LC;
    float* em = sm + wid * 104; float* h1 = em + 40;
    __syncthreads();
    if (lane < 33) {
      float v;
      if (lane == 0) v = (float)t / (float)(Lq - 1);
      else {
        int bi = (lane - 1) & 15; float fr = 1e-4f + (float)bi * ((15.f - 1e-4f) / 15.f);
        float w = 6.283185307179586f * (float)t / (float)Lq;
        v = (lane <= 16) ? cosf(fr * w) : -sinf(fr * w);
      }
      em[lane] = v;
    }
    __syncthreads();
    {
      float a = p.f1_b[l * 64 + lane];
      for (int e = 0; e < 33; ++e) a += em[e] * p.f1_w[(l * 33 + e) * 64 + lane];
      h1[lane] = sinf(p.f1_freq[l * 64 + lane] * a);
    }
    __syncthreads();
    {
      float a = p.f2_b[l * 64 + lane];
      for (int i = 0; i < 64; ++i) a += h1[i] * p.f2_w[(l * 64 + i) * 64 + lane];
      float v = sinf(p.f2_freq[l * 64 + lane] * a);
      if (lat) ((float*)(p.ws + OFF_H2T))[((size_t)l * 64 + lane) * L + t] = v;
      else ((float*)(p.ws + OFF_H2C))[((size_t)l * 256 + t) * 64 + lane] = v;
    }
  }
  __syncthreads();
  {
    constexpr int T_IN = 16 * 249, T_BR = 8 * 32, T_OUT = 16 * 32, T_LAYER = T_IN + 3 * T_BR + T_OUT;
    float* tile = sm;
    for (int task = bid; task < 2 * T_LAYER; task += nb) {
      const int l = task / T_LAYER; int tt = task - l * T_LAYER;
      const float* src; u16* dst; int K, N, kt, ntile;
      char* wt = p.ws + OFF_WT + (size_t)l * WT_LAYER;
      if (tt < T_IN) { src = p.w_in + (size_t)l * 1024 * NIN; dst = (u16*)wt; K = 1024; N = NIN; kt = tt / 249; ntile = tt % 249; }
      else if (tt < T_IN + 3 * T_BR) {
        tt -= T_IN; int br = tt / T_BR; tt -= br * T_BR;
        src = (br == 0 ? p.w_g : (br == 1 ? p.w_a : p.w_h)) + (size_t)l * 512 * 1024; dst = (u16*)(wt + WT_IN + br * WT_BR);
        K = 512; N = 1024; kt = tt / 32; ntile = tt % 32;
      } else { tt -= T_IN + 3 * T_BR; src = p.w_o + (size_t)l * 1024 * 1024; dst = (u16*)(wt + WT_IN + 3 * WT_BR); K = 1024; N = 1024; kt = tt / 32; ntile = tt % 32; }
      const int k0 = kt * 64, n0 = ntile * 32;
#pragma unroll
      for (int i = 0; i < 4; ++i) { int kk = (tid >> 5) + 16 * i, nn = tid & 31; tile[kk * 33 + nn] = src[(size_t)(k0 + kk) * N + n0 + nn]; }
      __syncthreads();
#pragma unroll
      for (int i = 0; i < 4; ++i) { int nn = (tid >> 6) + 8 * i, kk = tid & 63; dst[(size_t)(n0 + nn) * K + k0 + kk] = f2bf(tile[kk * 33 + nn]); }
      __syncthreads();
    }
  }
}

DI void phase_norm(const Params& p, int l) {
  const int tid = threadIdx.x, lane = tid & 63, wid = tid >> 6;
  const float* mod = (const float*)(p.ws + OFF_MOD);
  u16* H = (u16*)(p.ws + OFF_H);
  for (int row = blockIdx.x * 8 + wid; row < R; row += gridDim.x * 8) {
    const float* src = xrow_in(p, l, row);
    const float* mv = mod + (l * 3 + modvec_of(row)) * 3072;
    float4 xv[4]; float ss = 0.f;
#pragma unroll
    for (int i = 0; i < 4; ++i) { xv[i] = *(const float4*)(src + (i * 64 + lane) * 4); ss += xv[i].x * xv[i].x + xv[i].y * xv[i].y + xv[i].z * xv[i].z + xv[i].w * xv[i].w; }
    ss = wave_sum(ss);
    const float rs = rsqrtf(ss * (1.f / 1024.f) + EPS);
#pragma unroll
    for (int i = 0; i < 4; ++i) {
      const int col = (i * 64 + lane) * 4;
      float4 sh = *(const float4*)(mv + col), sc = *(const float4*)(mv + 1024 + col);
      u32x2 o;
      o.x = pack2(xv[i].x * rs * (1.f + sc.x) + sh.x, xv[i].y * rs * (1.f + sc.y) + sh.y);
      o.y = pack2(xv[i].z * rs * (1.f + sc.z) + sh.z, xv[i].w * rs * (1.f + sc.w) + sh.w);
      *(u32x2*)(H + (size_t)row * 1024 + col) = o;
    }
  }
}

DI void phase_proj(const Params& p, int l, char* smem) {
  const int tid = threadIdx.x, lane = tid & 63, wid = tid >> 6, r = lane & 31, h = lane >> 5, wm = wid & 3, wn = wid >> 2;
  const u16* H = (const u16*)(p.ws + OFF_H);
  const u16* WT = (const u16*)(p.ws + OFF_WT + (size_t)l * WT_LAYER);
  u16* P = (u16*)(p.ws + OFF_P);
  u16* CT = (u16*)(p.ws + OFF_CT);
  for (int t = blockIdx.x; t < 130 * 39; t += gridDim.x) {
    const int mt = t / 39, nt = t - mt * 39, m0 = mt * 256, n0 = nt * 128;
    f32x16 acc[2][2];
#pragma unroll
    for (int i = 0; i < 2; ++i) for (int j = 0; j < 2; ++j) acc[i][j] = zero16();
    ALoadN al{H + (size_t)m0 * 1024, 1024};
    gemm_tile<256>(al, WT + (size_t)n0 * 1024, 1024, 1024, smem, acc);
    const int b = m0 / TB, tk0 = m0 - b * TB;
#pragma unroll
    for (int j = 0; j < 2; ++j) {
      const int cb = n0 + wn * 64 + j * 32;
      if (cb >= 4896) continue;
      bool chan; int cm;
      if (cb < 512) { chan = false; cm = cb; }
      else if (cb < 1024) { chan = true; cm = CH_GV + cb - 512; }
      else if (cb < 2208) { chan = false; cm = cb - 512; }
      else if (cb < 2336) { chan = true; cm = CH_AV + cb - 2208; }
      else if (cb < 2848) { chan = false; cm = cb - 640; }
      else { chan = true; cm = cb - 2848; }
#pragma unroll
      for (int i = 0; i < 2; ++i) {
        const int rbase = wm * 64 + i * 32;
        if (!chan) {
#pragma unroll
          for (int reg = 0; reg < 16; ++reg) P[(size_t)(m0 + rbase + crow(reg, h)) * NP + cm + r] = f2bf(acc[i][j][reg]);
        } else {
#pragma unroll
          for (int g = 0; g < 4; ++g) {
            u32x2 o; o.x = pack2(acc[i][j][4 * g], acc[i][j][4 * g + 1]); o.y = pack2(acc[i][j][4 * g + 2], acc[i][j][4 * g + 3]);
            *(u32x2*)(CT + ((size_t)(cm + r) * 2 + b) * TB + tk0 + rbase + 8 * g + 4 * h) = o;
          }
        }
      }
    }
  }
}

DI void attn_prep(const Params& p, int l) {
  const int tid = threadIdx.x, lane = tid & 63, wid = tid >> 6;
  u16* P = (u16*)(p.ws + OFF_P);
  const float gq = pk(p, PK_QN)[l * 64 + lane], gk = pk(p, PK_KN)[l * 64 + lane];
  for (int row = blockIdx.x * 8 + wid; row < R; row += gridDim.x * 8) {
    u16* Pr = P + (size_t)row * NP;
    const int b = row / TB, tk = row - b * TB;
    float cs = 1.f, sn = 0.f;
    if (tk >= LC) {
      const int t = tk - LC, pi = lane >> 1;
      const float pos = (pi < 16) ? (float)(t >> 6) : (float)(t & 63);
      const float inv = powf(10000.f, -(float)(2 * (pi & 15)) / 32.f);
      sincosf(pos * inv, &sn, &cs);
    }
#pragma unroll
    for (int hd = 0; hd < 10; ++hd) {
      const int col = (hd < 8) ? PC_AQ + hd * 64 + lane : PC_AK + (hd - 8) * 64 + lane;
      float v = bf2f(Pr[col]);
      const float ss = wave_sum(v * v);
      v = v * rsqrtf(ss * (1.f / 64.f) + EPS) * (hd < 8 ? gq : gk);
      const float pv = __shfl_xor(v, 1);
      float o = (lane & 1) ? (pv * sn + v * cs) : (v * cs - pv * sn);
      if (hd < 8) o *= 0.125f * 1.4426950408889634f;
      Pr[col] = f2bf(o);
    }
  }
}

DI void fft_fwd(float2* X, int tid) {
#pragma unroll 1
  for (int h2 = 4096; h2 >= 1; h2 >>= 2) {
    const float inv4 = 0.25f / (float)h2;
#pragma unroll 2
    for (int i = 0; i < 8; ++i) {
      const int g = tid + NT * i, jp = g & (h2 - 1), base = ((g - jp) << 2) + jp;
      float2 e0 = X[base], e1 = X[base + h2], e2 = X[base + 2 * h2], e3 = X[base + 3 * h2];
      const float fr = (float)jp * inv4;
      const float2 T1 = make_float2(__builtin_amdgcn_cosf(fr), -__builtin_amdgcn_sinf(fr));
      const float2 T2 = cmul(T1, T1);
      float2 a0 = cadd(e0, e2), a2 = cmul(csub(e0, e2), T1);
      float2 a1 = cadd(e1, e3), d13 = cmul(csub(e1, e3), T1);
      float2 a3 = make_float2(d13.y, -d13.x);
      X[base] = cadd(a0, a1); X[base + h2] = cmul(csub(a0, a1), T2);
      X[base + 2 * h2] = cadd(a2, a3); X[base + 3 * h2] = cmul(csub(a2, a3), T2);
    }
    __syncthreads();
  }
}
DI void fft_inv(float2* X, int tid) {
#pragma unroll 1
  for (int h1 = 1; h1 <= 4096; h1 <<= 2) {
    const float inv4 = 0.25f / (float)h1;
#pragma unroll 2
    for (int i = 0; i < 8; ++i) {
      const int g = tid + NT * i, jp = g & (h1 - 1), base = ((g - jp) << 2) + jp;
      float2 e0 = X[base], e1 = X[base + h1], e2 = X[base + 2 * h1], e3 = X[base + 3 * h1];
      const float fr = (float)jp * inv4;
      const float2 V = make_float2(__builtin_amdgcn_cosf(fr), __builtin_amdgcn_sinf(fr));
      const float2 Wc = cmul(V, V);
      float2 t1 = cmul(e1, Wc), t3 = cmul(e3, Wc);
      float2 a0 = cadd(e0, t1), a1 = csub(e0, t1), a2 = cadd(e2, t3), a3 = csub(e2, t3);
      float2 u2 = cmul(a2, V), u3 = cmul(a3, V);
      u3 = make_float2(-u3.y, u3.x);
      X[base] = cadd(a0, u2); X[base + 2 * h1] = csub(a0, u2);
      X[base + h1] = cadd(a1, u3); X[base + 3 * h1] = csub(a1, u3);
    }
    __syncthreads();
  }
}
DI float sconv_at(const u16* src, int t, int len, float w0, float w1, float w2, float bb) {
  float ym = t > 0 ? bf2f(src[t - 1]) : 0.f, y0 = bf2f(src[t]), yp = t < len - 1 ? bf2f(src[t + 1]) : 0.f;
  return bb + w0 * ym + w1 * y0 + w2 * yp;
}
DI float hy_delta(int col) {
  const float A0 = -4.605170185988091f / 0.3f, A1 = -4.605170185988091f / 1.5f;
  return fabsf(A0 + (A1 - A0) * ((float)col / 2047.f));
}

DI void hyena_latent_task(const Params& p, int l, int c, char* smem) {
  float2* X = (float2*)smem;
  float* red = (float*)(smem + 131072);
  const int tid = threadIdx.x, lane = tid & 63, wid = tid >> 6;
  u16* CT = (u16*)(p.ws + OFF_CT);
  float2* FE = (float2*)(p.ws + OFF_FS + (size_t)blockIdx.x * 262144);
  float2* FO = FE + 16384;
  const float* h2T = (const float*)(p.ws + OFF_H2T) + (size_t)l * 64 * L;
  const float* f3w = pk(p, PK_F3) + (size_t)l * 64 * 2048;
  const float* cw = pk(p, PK_CW) + (size_t)l * 3 * 1536;
  const float* cbv = pk(p, PK_CB) + (size_t)l * 1536;
  const float vw0 = cw[c], vw1 = cw[1536 + c], vw2 = cw[3072 + c], vbb = cbv[c];
  const u16* v0 = CT + ((size_t)(CH_YU + c) * 2 + 0) * TB + LC;
  const u16* v1 = CT + ((size_t)(CH_YU + c) * 2 + 1) * TB + LC;
  u16* z10 = CT + ((size_t)(CH_YU + 512 + c) * 2 + 0) * TB + LC;
  u16* z11 = CT + ((size_t)(CH_YU + 512 + c) * 2 + 1) * TB + LC;
#pragma unroll 1
  for (int o = 0; o < 2; ++o) {
    const int cf = o * 1024 + c, cbk = cf + 512;
    float sf = 0.f, sb = 0.f;
    __syncthreads();
#pragma unroll 1
    for (int half = 0; half < 2; ++half) {
      float af[16], ab[16];
#pragma unroll
      for (int i = 0; i < 16; ++i) { af[i] = 0.f; ab[i] = 0.f; }
#pragma unroll 1
      for (int j = 0; j < 64; ++j) {
        const float wf = f3w[j * 2048 + cf], wb = f3w[j * 2048 + cbk];
        const float* hrow = h2T + (size_t)j * L + tid + half * 16 * NT;
#pragma unroll
        for (int i = 0; i < 16; ++i) { const float hv = hrow[NT * i]; af[i] += hv * wf; ab[i] += hv * wb; }
      }
      const float df = hy_delta(cf), db = hy_delta(cbk);
#pragma unroll
      for (int i = 0; i < 16; ++i) {
        const int t = tid + NT * (i + half * 16); const float tt = (float)t / (float)(L - 1);
        const float vf = af[i] * (__expf(-tt * df) + 0.05f), vb = ab[i] * (__expf(-tt * db) + 0.05f);
        sf += fabsf(vf); sb += fabsf(vb);
        X[t].x = vf;
        if (t >= 1) X[L - t].y = vb; else X[0].y = 0.f;
      }
    }
    sf = wave_sum(sf); sb = wave_sum(sb);
    if (lane == 0) { red[wid] = sf; red[8 + wid] = sb; }
    __syncthreads();
    float nf = 0.f, nbk = 0.f;
#pragma unroll
    for (int w = 0; w < 8; ++w) { nf += red[w]; nbk += red[8 + w]; }
    const float inv_f = 1.f / nf, inv_b = 1.f / nbk;
#pragma unroll 4
    for (int i = 0; i < 32; ++i) { const int n = tid + NT * i; const float2 s = X[n]; FO[n] = s; X[n] = make_float2(s.x * inv_f + s.y * inv_b, 0.f); }
    __syncthreads();
    fft_fwd(X, tid);
#pragma unroll 4
    for (int i = 0; i < 32; ++i) { const int n = tid + NT * i; FE[n] = X[n]; }
    __syncthreads();
#pragma unroll 4
    for (int i = 0; i < 32; ++i) {
      const int n = tid + NT * i; const float2 s = FO[n]; const float dd = s.x * inv_f - s.y * inv_b; const float fr = (float)n * (1.f / 32768.f);
      X[n] = make_float2(dd * __builtin_amdgcn_cosf(fr), -dd * __builtin_amdgcn_sinf(fr));
    }
    __syncthreads();
    fft_fwd(X, tid);
#pragma unroll 4
    for (int i = 0; i < 32; ++i) { const int n = tid + NT * i; FO[n] = X[n]; }
    __syncthreads();
#pragma unroll 4
    for (int i = 0; i < 32; ++i) {
      const int n = tid + NT * i;
      float2 zz;
      if (o == 0) { zz.x = sconv_at(v0, n, L, vw0, vw1, vw2, vbb); zz.y = sconv_at(v1, n, L, vw0, vw1, vw2, vbb); }
      else { zz.x = bf2f(z10[n]); zz.y = bf2f(z11[n]); }
      X[n] = zz;
    }
    __syncthreads();
    fft_fwd(X, tid);
#pragma unroll 4
    for (int i = 0; i < 32; ++i) { const int n = tid + NT * i; X[n] = cmul(X[n], FE[n]); }
    __syncthreads();
    fft_inv(X, tid);
#pragma unroll 4
    for (int i = 0; i < 32; ++i) { const int n = tid + NT * i; FE[n] = X[n]; }
    __syncthreads();
#pragma unroll 4
    for (int i = 0; i < 32; ++i) {
      const int n = tid + NT * i; const float fr = (float)n * (1.f / 32768.f);
      float2 zz;
      if (o == 0) { zz.x = sconv_at(v0, n, L, vw0, vw1, vw2, vbb); zz.y = sconv_at(v1, n, L, vw0, vw1, vw2, vbb); }
      else { zz.x = bf2f(z10[n]); zz.y = bf2f(z11[n]); }
      X[n] = cmul(zz, make_float2(__builtin_amdgcn_cosf(fr), -__builtin_amdgcn_sinf(fr)));
    }
    __syncthreads();
    fft_fwd(X, tid);
#pragma unroll 4
    for (int i = 0; i < 32; ++i) { const int n = tid + NT * i; X[n] = cmul(X[n], FO[n]); }
    __syncthreads();
    fft_inv(X, tid);
    {
      const int gch = CH_YU + 512 * (o + 1) + c;
      const float w0 = cw[gch], w1 = cw[1536 + gch], w2 = cw[3072 + gch], bb = cbv[gch];
      const u16* s0 = CT + ((size_t)gch * 2 + 0) * TB + LC;
      const u16* s1 = CT + ((size_t)gch * 2 + 1) * TB + LC;
      const float sk = pk(p, PK_SK)[(l * 2 + o) * 512 + c];
#pragma unroll 4
      for (int i = 0; i < 32; ++i) {
        const int n = tid + NT * i; const float fr = (float)n * (1.f / 32768.f);
        const float2 wb = cmul(X[n], make_float2(__builtin_amdgcn_cosf(fr), __builtin_amdgcn_sinf(fr)));
        const float2 A = FE[n];
        const float yr = (A.x + wb.x) * (1.f / 32768.f), yi = (A.y + wb.y) * (1.f / 32768.f);
        const float g0 = sconv_at(s0, n, L, w0, w1, w2, bb), g1 = sconv_at(s1, n, L, w0, w1, w2, bb);
        float2 zz;
        if (o == 0) { zz.x = sconv_at(v0, n, L, vw0, vw1, vw2, vbb); zz.y = sconv_at(v1, n, L, vw0, vw1, vw2, vbb); }
        else { zz.x = bf2f(z10[n]); zz.y = bf2f(z11[n]); }
        X[n] = make_float2(g0 * (yr + sk * zz.x), g1 * (yi + sk * zz.y));
      }
    }
    __syncthreads();
    if (o == 0) {
#pragma unroll 4
      for (int i = 0; i < 32; ++i) { const int n = tid + NT * i; const float2 zz = X[n]; z10[n] = f2bf(zz.x); z11[n] = f2bf(zz.y); }
    } else {
      u16* d0 = CT + ((size_t)(CH_YZ + c) * 2 + 0) * TB + LC;
      u16* d1 = CT + ((size_t)(CH_YZ + c) * 2 + 1) * TB + LC;
#pragma unroll 4
      for (int i = 0; i < 32; ++i) {
        const int n = tid + NT * i; const float2 zz = X[n];
        d0[n] = f2bf(zz.x * silu_f(bf2f(d0[n]))); d1[n] = f2bf(zz.y * silu_f(bf2f(d1[n])));
      }
    }
    __syncthreads();
  }
}

DI void hyena_ctx_task(const Params& p, int l, int c, char* smem) {
  float* filt = (float*)smem;
  float* zs = filt + 1024;
  float* nrm = zs + 1024;
  const int tid = threadIdx.x, lane = tid & 63, wid = tid >> 6, t = tid & 255, hb = tid >> 8;
  u16* CT = (u16*)(p.ws + OFF_CT);
  const float* h2c = (const float*)(p.ws + OFF_H2C) + (size_t)l * 256 * 64;
  const float* f3w = pk(p, PK_F3) + (size_t)l * 64 * 2048;
  const float* cw = pk(p, PK_CW) + (size_t)l * 3 * 1536;
  const float* cbv = pk(p, PK_CB) + (size_t)l * 1536;
  __syncthreads();
  {
    const int cf = hb * 1024 + c, cbk = cf + 512;
    float a_f = 0.f, a_b = 0.f;
    for (int j = 0; j < 64; ++j) { const float hv = h2c[t * 64 + j]; a_f += hv * f3w[j * 2048 + cf]; a_b += hv * f3w[j * 2048 + cbk]; }
    const float tt = (float)t / 255.f;
    filt[(hb * 2 + 0) * 256 + t] = a_f * (__expf(-tt * hy_delta(cf)) + 0.05f);
    filt[(hb * 2 + 1) * 256 + t] = a_b * (__expf(-tt * hy_delta(cbk)) + 0.05f);
    const u16* src = CT + ((size_t)(CH_YU + c) * 2 + hb) * TB;
    zs[hb * 256 + t] = sconv_at(src, t, LC, cw[c], cw[1536 + c], cw[3072 + c], cbv[c]);
  }
  __syncthreads();
  if (wid < 4) {
    float s = 0.f;
    for (int k = 0; k < 4; ++k) s += fabsf(filt[wid * 256 + lane + 64 * k]);
    s = wave_sum(s);
    if (lane == 0) nrm[wid] = s;
  }
  __syncthreads();
  const int b = hb;
  for (int o = 0; o < 2; ++o) {
    const float inf_ = 1.f / nrm[o * 2], inb_ = 1.f / nrm[o * 2 + 1];
    const float* hf = filt + (o * 2) * 256; const float* hbk = filt + (o * 2 + 1) * 256;
    const float* zc = zs + (o & 1) * 512 + b * 256;
    float accf = 0.f, accb = 0.f;
    for (int s = 0; s <= t; ++s) accf += hf[t - s] * zc[s];
    for (int s = t + 1; s < 256; ++s) accb += hbk[s - t] * zc[s];
    const int gch = CH_YU + 512 * (o + 1) + c;
    const float gate = sconv_at(CT + ((size_t)gch * 2 + b) * TB, t, LC, cw[gch], cw[1536 + gch], cw[3072 + gch], cbv[gch]);
    const float zn = gate * (accf * inf_ + accb * inb_ + pk(p, PK_SK)[(l * 2 + o) * 512 + c] * zc[t]);
    zs[((o + 1) & 1) * 512 + b * 256 + t] = zn;
    __syncthreads();
  }
  {
    u16* d = CT + ((size_t)(CH_YZ + c) * 2 + b) * TB;
    d[t] = f2bf(zs[b * 256 + t] * silu_f(bf2f(d[t])));
  }
  __syncthreads();
}

DI void gla_bcum(const Params& p, int l, int row0, int hh, int dir, float* gs, float* segs, float* was, float* as_) {
  const int tid = threadIdx.x;
  const u16* P = (const u16*)(p.ws + OFF_P);
  const float* wa = pk(p, dir ? PK_WAB : PK_WAF) + (size_t)l * 16 * 256 + hh * 64;
  const float* ba = pk(p, dir ? PK_BAB : PK_BAF) + l * 256 + hh * 64;
#pragma unroll
  for (int i = 0; i < 2; ++i) {
    const int idx = tid + NT * i;
    was[idx] = wa[(idx >> 6) * 256 + (idx & 63)];
    as_[(idx >> 4) * 17 + (idx & 15)] = bf2f(P[(size_t)(row0 + (idx >> 4)) * NP + PC_AF + dir * 16 + (idx & 15)]);
  }
  __syncthreads();
  {
    const int t = tid >> 3, d0 = (tid & 7) * 8;
    float lin[8];
#pragma unroll
    for (int e = 0; e < 8; ++e) lin[e] = ba[d0 + e];
#pragma unroll 2
    for (int rr = 0; rr < 16; ++rr) {
      const float av = as_[t * 17 + rr];
      const float4 w0 = *(const float4*)(was + rr * 64 + d0), w1 = *(const float4*)(was + rr * 64 + d0 + 4);
      lin[0] += av * w0.x; lin[1] += av * w0.y; lin[2] += av * w0.z; lin[3] += av * w0.w;
      lin[4] += av * w1.x; lin[5] += av * w1.y; lin[6] += av * w1.z; lin[7] += av * w1.w;
    }
#pragma unroll
    for (int e = 0; e < 8; ++e) gs[t * 65 + d0 + e] = (fminf(lin[e], 0.f) - log1pf(__expf(-fabsf(lin[e])))) * (1.f / 16.f);
  }
  __syncthreads();
  {
    const int d = tid & 63, seg = tid >> 6;
    float v[8]; float run = 0.f;
#pragma unroll
    for (int e = 0; e < 8; ++e) { const int tt = dir ? seg * 8 + 7 - e : seg * 8 + e; run += gs[tt * 65 + d]; v[e] = run; }
    segs[seg * 64 + d] = run;
    __syncthreads();
    float off = 0.f;
#pragma unroll
    for (int s = 0; s < 8; ++s) { const bool before = dir ? (s > seg) : (s < seg); if (before) off += segs[s * 64 + d]; }
#pragma unroll
    for (int e = 0; e < 8; ++e) { const int tt = dir ? seg * 8 + 7 - e : seg * 8 + e; gs[tt * 65 + d] = v[e] + off; }
  }
  __syncthreads();
}
DI int gla_tok0(int dir, int n) {
  if (n < 4) return (dir ? 3 - n : n) * 64;
  return LC + (dir ? 255 - (n - 4) : n - 4) * 64;
}
constexpr int G_GS = 0;
constexpr int G_SEG = G_GS + 64 * 65 * 4;
constexpr int G_QS = G_SEG + 8 * 64 * 4;
constexpr int G_KS = G_QS + 64 * LDT * 2;
constexpr int G_VT = G_KS + 64 * LDT * 2;
constexpr int G_ST = G_VT + 128 * LDT * 2;
constexpr int G_RED = G_ST + 128 * LDT * 2;
constexpr int G_WA = G_RED + 8 * 32 * 4;
constexpr int G_AS = G_WA + 16 * 64 * 4;

DI void gla_g1_task(const Params& p, int l, int chain, int n, char* smem) {
  const int tid = threadIdx.x, lane = tid & 63, wid = tid >> 6, r = lane & 31, h = lane >> 5;
  const int b = chain >> 3, hh = (chain >> 1) & 3, dir = chain & 1;
  const int tk0 = gla_tok0(dir, n), row0 = b * TB + tk0;
  float* gs = (float*)(smem + G_GS); float* segs = (float*)(smem + G_SEG);
  u16* kT = (u16*)(smem + G_KS); u16* vT = (u16*)(smem + G_VT);
  const u16* P = (const u16*)(p.ws + OFF_P);
  const u16* CT = (const u16*)(p.ws + OFF_CT);
  __syncthreads();
  gla_bcum(p, l, row0, hh, dir, gs, segs, (float*)(smem + G_WA), (float*)(smem + G_AS));
  const int tl = dir ? 0 : 63;
  {
    const int t = tid >> 3, d0 = (tid & 7) * 8;
    const u32x4 kv = *(const u32x4*)(P + (size_t)(row0 + t) * NP + PC_GK + hh * 64 + d0);
    const unsigned w[4] = {kv.x, kv.y, kv.z, kv.w};
#pragma unroll
    for (int e = 0; e < 8; ++e) {
      const float kx = (e & 1) ? bfhi(w[e >> 1]) : bflo(w[e >> 1]);
      kT[(d0 + e) * LDT + t] = f2bf(kx * __expf(gs[tl * 65 + d0 + e] - gs[t * 65 + d0 + e]));
    }
#pragma unroll
    for (int i = 0; i < 2; ++i) {
      const int q = tid + NT * i, v = q >> 3, cc = q & 7;
      *(u32x4*)(vT + v * LDT + cc * 8) = *(const u32x4*)(CT + ((size_t)(CH_GV + hh * 128 + v) * 2 + b) * TB + tk0 + cc * 8);
    }
    if (tid < 64) ((float*)(p.ws + OFF_GD))[((size_t)chain * NCK + n) * 64 + tid] = __expf(gs[tl * 65 + tid]);
  }
  __syncthreads();
  {
    const int vm = wid >> 1, dn = wid & 1;
    f32x16 acc = zero16();
#pragma unroll
    for (int s = 0; s < 4; ++s) {
      const bf16x8 a = *(const bf16x8*)(vT + (vm * 32 + r) * LDT + s * 16 + h * 8);
      const bf16x8 bb = *(const bf16x8*)(kT + (dn * 32 + r) * LDT + s * 16 + h * 8);
      acc = MFMA(a, bb, acc);
    }
    u16* GS = (u16*)(p.ws + OFF_GS) + ((size_t)chain * NCK + n) * 8192;
#pragma unroll
    for (int reg = 0; reg < 16; ++reg) GS[(vm * 32 + crow(reg, h)) * 64 + dn * 32 + r] = f2bf(acc[reg]);
  }
}
DI void gla_g2(const Params& p) {
  u16* GSb = (u16*)(p.ws + OFF_GS);
  const float* GD = (const float*)(p.ws + OFF_GD);
  for (int gi = blockIdx.x * NT + threadIdx.x; gi < 16 * 8192; gi += gridDim.x * NT) {
    const int chain = gi >> 13, e = gi & 8191, d = e & 63;
    u16* ptr = GSb + (size_t)chain * NCK * 8192 + e;
    const float* dec = GD + (size_t)chain * NCK * 64 + d;
    float S = 0.f;
#pragma unroll 1
    for (int n0 = 0; n0 < NCK; n0 += 10) {
      float ds[10], a[10];
#pragma unroll
      for (int k = 0; k < 10; ++k) { ds[k] = bf2f(ptr[(size_t)(n0 + k) * 8192]); a[k] = dec[(n0 + k) * 64]; }
#pragma unroll
      for (int k = 0; k < 10; ++k) { ptr[(size_t)(n0 + k) * 8192] = f2bf(S); S = a[k] * S + ds[k]; }
    }
  }
}
DI void gla_g3_task(const Params& p, int l, int b, int hh, int ci, char* smem) {
  const int tid = threadIdx.x, lane = tid & 63, wid = tid >> 6, r = lane & 31, h = lane >> 5;
  const int tk0 = ci * 64, row0 = b * TB + tk0;
  float* gs = (float*)(smem + G_GS); float* segs = (float*)(smem + G_SEG); float* red = (float*)(smem + G_RED);
  u16* qs = (u16*)(smem + G_QS); u16* ks = (u16*)(smem + G_KS); u16* vT = (u16*)(smem + G_VT); u16* sT = (u16*)(smem + G_ST);
  u16* P = (u16*)(p.ws + OFF_P);
  const u16* CT = (const u16*)(p.ws + OFF_CT);
  const int vm = wid >> 1, in = wid & 1;
  f32x16 o = zero16();
  __syncthreads();
#pragma unroll 1
  for (int dir = 0; dir < 2; ++dir) {
    gla_bcum(p, l, row0, hh, dir, gs, segs, (float*)(smem + G_WA), (float*)(smem + G_AS));
    const int chain = b * 8 + hh * 2 + dir;
    const int n = dir ? ((ci < 4) ? 3 - ci : 263 - ci) : ci;
    {
      const int t = tid >> 3, d0 = (tid & 7) * 8;
      const u32x4 qv = *(const u32x4*)(P + (size_t)(row0 + t) * NP + PC_GQ + hh * 64 + d0);
      const u32x4 kv = *(const u32x4*)(P + (size_t)(row0 + t) * NP + PC_GK + hh * 64 + d0);
      const unsigned qw[4] = {qv.x, qv.y, qv.z, qv.w}, kw[4] = {kv.x, kv.y, kv.z, kv.w};
      unsigned qo[4], ko[4];
#pragma unroll
      for (int e = 0; e < 4; ++e) {
        const float b0 = gs[t * 65 + d0 + 2 * e], b1 = gs[t * 65 + d0 + 2 * e + 1];
        qo[e] = pack2(bflo(qw[e]) * 0.125f * __expf(b0), bfhi(qw[e]) * 0.125f * __expf(b1));
        ko[e] = pack2(bflo(kw[e]) * __expf(-b0), bfhi(kw[e]) * __expf(-b1));
      }
      *(u32x4*)(qs + t * LDT + d0) = u32x4{qo[0], qo[1], qo[2], qo[3]};
      *(u32x4*)(ks + t * LDT + d0) = u32x4{ko[0], ko[1], ko[2], ko[3]};
      const u16* GS = (const u16*)(p.ws + OFF_GS) + ((size_t)chain * NCK + n) * 8192;
#pragma unroll
      for (int i = 0; i < 2; ++i) {
        const int q = tid + NT * i, v = q >> 3, cc = q & 7;
        *(u32x4*)(sT + v * LDT + cc * 8) = *(const u32x4*)(GS + v * 64 + cc * 8);
        if (dir == 0) *(u32x4*)(vT + v * LDT + cc * 8) = *(const u32x4*)(CT + ((size_t)(CH_GV + hh * 128 + v) * 2 + b) * TB + tk0 + cc * 8);
      }
    }
    __syncthreads();
    bf16x8 qf[4];
#pragma unroll
    for (int s = 0; s < 4; ++s) qf[s] = *(const bf16x8*)(qs + (in * 32 + r) * LDT + s * 16 + h * 8);
#pragma unroll
    for (int jt = 0; jt < 2; ++jt) {
      f32x16 at = zero16();
#pragma unroll
      for (int s = 0; s < 4; ++s) at = MFMA(*(const bf16x8*)(ks + (jt * 32 + r) * LDT + s * 16 + h * 8), qf[s], at);
      const int ii = in * 32 + r;
#pragma unroll
      for (int reg = 0; reg < 16; ++reg) {
        const int jj = jt * 32 + crow(reg, h);
        const bool keep = dir ? (jj >= ii) : (jj <= ii);
        if (!keep) at[reg] = 0.f;
      }
#pragma unroll
      for (int s = 0; s < 2; ++s) {
        const u16* vp = vT + (vm * 32 + r) * LDT + jt * 32 + 16 * s + 4 * h;
        o = MFMA(ld2x64(vp, vp + 8), pack8(at, s), o);
      }
    }
#pragma unroll
    for (int s = 0; s < 4; ++s) o = MFMA(*(const bf16x8*)(sT + (vm * 32 + r) * LDT + s * 16 + h * 8), qf[s], o);
    __syncthreads();
  }
  float ss = 0.f;
#pragma unroll
  for (int reg = 0; reg < 16; ++reg) ss += o[reg] * o[reg];
  ss += __shfl_xor(ss, 32);
  if (h == 0) red[wid * 32 + r] = ss;
  __syncthreads();
  float tot = 0.f;
#pragma unroll
  for (int m = 0; m < 4; ++m) tot += red[(m * 2 + in) * 32 + r];
  const float rs = rsqrtf(tot * (1.f / 128.f) + EPS);
  u16* zp = P + (size_t)(row0 + in * 32 + r) * NP + PC_GZ + hh * 128 + vm * 32 + 4 * h;
  const float* gn = pk(p, PK_GN) + l * 128 + vm * 32 + 4 * h;
#pragma unroll
  for (int g = 0; g < 4; ++g) {
    const u32x2 zz = *(const u32x2*)(zp + 8 * g);
    const float4 gw = *(const float4*)(gn + 8 * g);
    u32x2 out;
    out.x = pack2(o[4 * g] * rs * gw.x * silu_f(bflo(zz.x)), o[4 * g + 1] * rs * gw.y * silu_f(bfhi(zz.x)));
    out.y = pack2(o[4 * g + 2] * rs * gw.z * silu_f(bflo(zz.y)), o[4 * g + 3] * rs * gw.w * silu_f(bfhi(zz.y)));
    *(u32x2*)(zp + 8 * g) = out;
  }
}

DI void attn_item(const Params& p, int b, int g, int qtk0, int ntiles, char* smem) {
  const int tid = threadIdx.x, lane = tid & 63, wid = tid >> 6, r = lane & 31, h = lane >> 5;
  u16* P = (u16*)(p.ws + OFF_P);
  const u16* CT = (const u16*)(p.ws + OFF_CT);
  u16* Ks = (u16*)smem;
  u16* Vs = Ks + 2 * 64 * LDT;
  const int hq = g * 4 + (wid >> 1);
  const size_t qrow = (size_t)b * TB + qtk0 + (wid & 1) * 32 + r;
  bf16x8 qf[4];
#pragma unroll
  for (int s = 0; s < 4; ++s) qf[s] = *(const bf16x8*)(P + qrow * NP + PC_AQ + hq * 64 + s * 16 + h * 8);
  f32x16 O[2] = {zero16(), zero16()};
  float m = -1e30f, lsum = 0.f;
  const int lr = tid >> 3, lc = (tid & 7) * 8;
  const u16* kg = P + ((size_t)b * TB + lr) * NP + PC_AK + g * 64 + lc;
  const u16* vg = CT + ((size_t)(CH_AV + g * 64 + lr) * 2 + b) * TB + lc;
  u32x4 rk = *(const u32x4*)kg, rv = *(const u32x4*)vg;
  __syncthreads();
  *(u32x4*)(Ks + lr * LDT + lc) = rk; *(u32x4*)(Vs + lr * LDT + lc) = rv;
  __syncthreads();
#pragma unroll 1
  for (int kt = 0; kt < ntiles; ++kt) {
    const int cur = kt & 1;
    if (kt + 1 < ntiles) { rk = *(const u32x4*)(kg + (size_t)(kt + 1) * 64 * NP); rv = *(const u32x4*)(vg + (kt + 1) * 64); }
    const u16* Kc = Ks + cur * 64 * LDT; const u16* Vc = Vs + cur * 64 * LDT;
    f32x16 st[2];
#pragma unroll
    for (int kk = 0; kk < 2; ++kk) {
      st[kk] = zero16();
#pragma unroll
      for (int s = 0; s < 4; ++s) st[kk] = MFMA(*(const bf16x8*)(Kc + (kk * 32 + r) * LDT + s * 16 + h * 8), qf[s], st[kk]);
    }
    float mx = st[0][0];
#pragma unroll
    for (int i = 0; i < 16; ++i) { mx = fmaxf(mx, st[0][i]); mx = fmaxf(mx, st[1][i]); }
    mx = fmaxf(mx, __shfl_xor(mx, 32));
    const float mn = fmaxf(m, mx);
    const float alpha = exp2f(m - mn);
    m = mn;
    float rsum = 0.f;
#pragma unroll
    for (int kk = 0; kk < 2; ++kk)
#pragma unroll
      for (int i = 0; i < 16; ++i) { const float pv = exp2f(st[kk][i] - mn); st[kk][i] = pv; rsum += pv; }
    lsum = lsum * alpha + rsum;
#pragma unroll
    for (int mt = 0; mt < 2; ++mt)
#pragma unroll
      for (int i = 0; i < 16; ++i) O[mt][i] *= alpha;
#pragma unroll
    for (int kk = 0; kk < 2; ++kk)
#pragma unroll
      for (int s = 0; s < 2; ++s) {
        const bf16x8 pb = pack8(st[kk], s);
#pragma unroll
        for (int mt = 0; mt < 2; ++mt) {
          const u16* vp = Vc + (mt * 32 + r) * LDT + kk * 32 + 16 * s + 4 * h;
          O[mt] = MFMA(ld2x64(vp, vp + 8), pb, O[mt]);
        }
      }
    if (kt + 1 < ntiles) { *(u32x4*)(Ks + (cur ^ 1) * 64 * LDT + lr * LDT + lc) = rk; *(u32x4*)(Vs + (cur ^ 1) * 64 * LDT + lr * LDT + lc) = rv; }
    __syncthreads();
  }
  lsum += __shfl_xor(lsum, 32);
  const float inv = 1.f / lsum;
  u16* op = P + qrow * NP + PC_AQ + hq * 64 + 4 * h;
  const u16* zp = P + qrow * NP + PC_AZ + hq * 64 + 4 * h;
#pragma unroll
  for (int mt = 0; mt < 2; ++mt)
#pragma unroll
    for (int gg = 0; gg < 4; ++gg) {
      const u32x2 zz = *(const u32x2*)(zp + mt * 32 + 8 * gg);
      u32x2 out;
      out.x = pack2(O[mt][4 * gg] * inv * silu_f(bflo(zz.x)), O[mt][4 * gg + 1] * inv * silu_f(bfhi(zz.x)));
      out.y = pack2(O[mt][4 * gg + 2] * inv * silu_f(bflo(zz.y)), O[mt][4 * gg + 3] * inv * silu_f(bfhi(zz.y)));
      *(u32x2*)(op + mt * 32 + 8 * gg) = out;
    }
}

DI void merge_accum(f32x16 (&ysum)[2], const f32x16 (&am)[1][2], const f32x16 (&ab)[1][2]) {
#pragma unroll
  for (int j = 0; j < 2; ++j)
#pragma unroll
    for (int i = 0; i < 16; ++i) ysum[j][i] += ab[0][j][i] / (1.f + __expf(-am[0][j][i]));
}
DI void phase_merge(const Params& p, int l, char* smem) {
  const int tid = threadIdx.x, lane = tid & 63, wid = tid >> 6, r = lane & 31, h = lane >> 5, wm = wid & 3, wn = wid >> 2;
  for (int t = blockIdx.x; t < 260 * 8; t += gridDim.x) {
    const int mt = t >> 3, nt = t & 7, m0 = mt * 128, n0 = nt * 128;
    const int b = m0 / TB, tk0 = m0 - b * TB;
    if (l == 1 && tk0 < LC) continue;
    const u16* H = (const u16*)(p.ws + OFF_H) + (size_t)m0 * 1024;
    const u16* WM = (const u16*)(p.ws + OFF_WT + (size_t)l * WT_LAYER) + (size_t)(4896 + n0) * 1024;
    const u16* WBR = (const u16*)(p.ws + OFF_WT + (size_t)l * WT_LAYER + WT_IN) + (size_t)n0 * 512;
    f32x16 ysum[2] = {zero16(), zero16()};
#pragma unroll 1
    for (int br = 0; br < 2; ++br) {
      f32x16 am[1][2] = {{zero16(), zero16()}};
      ALoadN ah{H, 1024};
      gemm_tile<128, ALoadN, 1>(ah, WM + (size_t)br * 1024 * 1024, 1024, 1024, smem, am);
      f32x16 ab[1][2] = {{zero16(), zero16()}};
      ALoadN ay{(const u16*)(p.ws + OFF_P) + (size_t)m0 * NP + (br == 0 ? PC_GZ : PC_AQ), NP};
      gemm_tile<128, ALoadN, 1>(ay, WBR + (size_t)br * 1024 * 512, 512, 512, smem, ab);
      merge_accum(ysum, am, ab);
    }
    {
      f32x16 am[1][2] = {{zero16(), zero16()}};
      ALoadN ah{H, 1024};
      gemm_tile<128, ALoadN, 1>(ah, WM + (size_t)2 * 1024 * 1024, 1024, 1024, smem, am);
      f32x16 ab[1][2] = {{zero16(), zero16()}};
      ALoadT ay{(const u16*)(p.ws + OFF_CT) + ((size_t)CH_YZ * 2 + b) * TB + tk0, (size_t)2 * TB};
      gemm_tile<128, ALoadT, 1>(ay, WBR + (size_t)2 * 1024 * 512, 512, 512, smem, ab);
      merge_accum(ysum, am, ab);
    }
    u16* Y = (u16*)(p.ws + OFF_Y) + (size_t)(m0 + wm * 32 + 4 * h) * 1024 + n0 + wn * 64 + r;
#pragma unroll
    for (int j = 0; j < 2; ++j)
#pragma unroll
      for (int reg = 0; reg < 16; ++reg) Y[(size_t)((reg & 3) + 8 * (reg >> 2)) * 1024 + j * 32] = f2bf(ysum[j][reg]);
  }
}

DI void phase_out(const Params& p, int l, char* smem) {
  const int tid = threadIdx.x, lane = tid & 63, wid = tid >> 6, r = lane & 31, h = lane >> 5, wm = wid & 3, wn = wid >> 2;
  const u16* Y = (const u16*)(p.ws + OFF_Y);
  const u16* WO = (const u16*)(p.ws + OFF_WT + (size_t)l * WT_LAYER + WT_IN + 3 * WT_BR);
  const float* mod = (const float*)(p.ws + OFF_MOD);
  for (int t = blockIdx.x; t < 260 * 8; t += gridDim.x) {
    const int mt = t >> 3, nt = t & 7, m0 = mt * 128, n0 = nt * 128;
    const int b = m0 / TB, tk0 = m0 - b * TB;
    if (l == 1 && tk0 < LC) continue;
    f32x16 acc[1][2] = {{zero16(), zero16()}};
    ALoadN ay{Y + (size_t)m0 * 1024, 1024};
    gemm_tile<128>(ay, WO + (size_t)n0 * 1024, 1024, 1024, smem, acc);
    const float* gv = mod + (l * 3 + (tk0 < LC ? 2 : b)) * 3072 + 2048;
    const float* xin = xrow_in(p, l, m0);
    float* xout = xrow_out(p, m0);
#pragma unroll
    for (int j = 0; j < 2; ++j) {
      const int col = n0 + wn * 64 + j * 32 + r;
      const float gate = gv[col];
#pragma unroll
      for (int reg = 0; reg < 16; ++reg) {
        const size_t off = (size_t)(wm * 32 + crow(reg, h)) * D + col;
        xout[off] = xin[off] + gate * acc[0][j][reg];
      }
    }
  }
}

DI void phase_final(const Params& p) {
  const int tid = threadIdx.x, lane = tid & 63, wid = tid >> 6;
  for (int row = blockIdx.x * 8 + wid; row < NBATCH * L; row += gridDim.x * 8) {
    float* src = p.out + (size_t)row * D;
    float4 xv[4]; float ss = 0.f;
#pragma unroll
    for (int i = 0; i < 4; ++i) { xv[i] = *(const float4*)(src + (i * 64 + lane) * 4); ss += xv[i].x * xv[i].x + xv[i].y * xv[i].y + xv[i].z * xv[i].z + xv[i].w * xv[i].w; }
    ss = wave_sum(ss);
    const float rs = rsqrtf(ss * (1.f / 1024.f) + EPS);
#pragma unroll
    for (int i = 0; i < 4; ++i) {
      const int col = (i * 64 + lane) * 4;
      const float4 fw = *(const float4*)(pk(p, PK_FN) + col);
      *(float4*)(src + col) = make_float4(xv[i].x * rs * fw.x, xv[i].y * rs * fw.y, xv[i].z * rs * fw.z, xv[i].w * rs * fw.w);
    }
  }
}

DI void run_phase(const Params& p, int ph, char* smem) {
  const int bid = blockIdx.x, nb = gridDim.x;
  if (ph == 0) { phase0(p, smem); return; }
  if (ph == 17) { phase_final(p); return; }
  const int l = (ph - 1) >> 3, s = (ph - 1) & 7;
  switch (s) {
    case 0: phase_norm(p, l); break;
    case 1: phase_proj(p, l, smem); break;
    case 2: {
      attn_prep(p, l);
      if (l == 0) for (int c = bid; c < 512; c += nb) hyena_ctx_task(p, l, c, smem);
      for (int c = bid; c < 512; c += nb) hyena_latent_task(p, l, c, smem);
    } break;
    case 3: for (int t = bid; t < 16 * NCK; t += nb) gla_g1_task(p, l, t / NCK, t % NCK, smem); break;
    case 4: gla_g2(p); break;
    case 5: {
      for (int it = bid; it < 1024; it += nb) { const int b = it >> 9, g = (it >> 8) & 1, qb = it & 255; attn_item(p, b, g, LC + qb * 64, NCK, smem); }
      if (l == 0) for (int it = bid; it < 16; it += nb) { const int b = it >> 3, g = (it >> 2) & 1, qb = it & 3; attn_item(p, b, g, qb * 64, 4, smem); }
      const int c0 = (l == 0) ? 0 : 4, per = NCK - c0;
      for (int t = bid; t < 8 * per; t += nb) { const int bh = t / per, ci = c0 + t % per; gla_g3_task(p, l, bh >> 2, bh & 3, ci, smem); }
    } break;
    case 6: phase_merge(p, l, smem); break;
    case 7: phase_out(p, l, smem); break;
  }
}

#if MULTI_LAUNCH
template <int PH> __global__ void __launch_bounds__(NT) phase_kernel(Params p) {
  extern __shared__ __attribute__((aligned(16))) char smem[];
  run_phase(p, PH, smem);
}
template <int PH> static void launch_phase(const Params& p, int grid, hipStream_t stream) {
  static bool attr = false;
  if (!attr) { (void)hipFuncSetAttribute((const void*)phase_kernel<PH>, hipFuncAttributeMaxDynamicSharedMemorySize, LDS_BYTES); attr = true; }
  hipLaunchKernelGGL(phase_kernel<PH>, dim3(grid), dim3(NT), LDS_BYTES, stream, p);
}
#else
__global__ void __launch_bounds__(NT) fwd_kernel(Params p) {
  extern __shared__ __attribute__((aligned(16))) char smem[];
  cg::grid_group grid = cg::this_grid();
#define PHS(n) run_phase(p, n, smem); grid.sync();
  PHS(0) PHS(1) PHS(2) PHS(3) PHS(4) PHS(5) PHS(6) PHS(7) PHS(8)
  PHS(9) PHS(10) PHS(11) PHS(12) PHS(13) PHS(14) PHS(15) PHS(16)
  run_phase(p, 17, smem);
}
#endif

extern "C" void kernel_launch(void* const* d_in, const int* in_sizes, int n_in, void* d_out, int out_size, void* d_ws, size_t ws_size,
                              hipStream_t stream) {
  static int grid = 0;
  if (grid == 0) {
    if (n_in != 29 || ws_size < WS_END) { fprintf(stderr, "kernel_launch: need 29 inputs and %zu B of workspace, got %d / %zu\n", (size_t)WS_END, n_in, ws_size); grid = -1; return; }
#if MULTI_LAUNCH
    grid = 256;
#else
    int dev = 0, cus = 0, per_cu = 0;
    (void)hipGetDevice(&dev);
    (void)hipDeviceGetAttribute(&cus, hipDeviceAttributeMultiprocessorCount, dev);
    if (hipFuncSetAttribute((const void*)fwd_kernel, hipFuncAttributeMaxDynamicSharedMemorySize, LDS_BYTES) != hipSuccess) { fprintf(stderr, "kernel_launch: hipFuncSetAttribute failed\n"); grid = -1; return; }
    (void)hipOccupancyMaxActiveBlocksPerMultiprocessor(&per_cu, (const void*)fwd_kernel, NT, LDS_BYTES);
    if (per_cu < 1) { fprintf(stderr, "kernel_launch: occupancy query returned %d\n", per_cu); per_cu = 1; }
    (void)hipGetLastError();
    grid = cus * per_cu;
    if (grid > 256) grid = 256;
#endif
  }
  if (grid < 0) return;
  Params p{};
  const float** pp = (const float**)&p;
  for (int i = 0; i < 29; ++i) pp[i] = (const float*)d_in[i];
  p.out = (float*)d_out; p.ws = (char*)d_ws;
  p.phase_lo = 0; p.phase_hi = 18;
#if MULTI_LAUNCH
  launch_phase<0>(p, grid, stream); launch_phase<1>(p, grid, stream); launch_phase<2>(p, grid, stream); launch_phase<3>(p, grid, stream);
  launch_phase<4>(p, grid, stream); launch_phase<5>(p, grid, stream); launch_phase<6>(p, grid, stream); launch_phase<7>(p, grid, stream);
  launch_phase<8>(p, grid, stream); launch_phase<9>(p, grid, stream); launch_phase<10>(p, grid, stream); launch_phase<11>(p, grid, stream);
  launch_phase<12>(p, grid, stream); launch_phase<13>(p, grid, stream); launch_phase<14>(p, grid, stream); launch_phase<15>(p, grid, stream);
  launch_phase<16>(p, grid, stream); launch_phase<17>(p, grid, stream);
#else
  void* args[] = {&p};
  hipError_t e = hipLaunchCooperativeKernel((const void*)fwd_kernel, dim3(grid), dim3(NT), args, LDS_BYTES, stream);
  if (e != hipSuccess) fprintf(stderr, "kernel_launch: cooperative launch failed: %s (grid %d)\n", hipGetErrorString(e), grid);
#endif
}
```

```cpp
#include <hip/hip_runtime.h>
#include <hip/hip_cooperative_groups.h>
#include <cstdio>
namespace cg = cooperative_groups;

typedef unsigned short u16;
typedef __attribute__((ext_vector_type(8))) short bf16x8;
typedef __attribute__((ext_vector_type(16))) float f32x16;
typedef __attribute__((ext_vector_type(4))) unsigned u32x4;
typedef __attribute__((ext_vector_type(2))) unsigned u32x2;
#define DI __device__ __forceinline__
#define MFMA(a, b, c) __builtin_amdgcn_mfma_f32_32x32x16_bf16((a), (b), (c), 0, 0, 0)

#ifndef MULTI_LAUNCH
#define MULTI_LAUNCH 0
#endif

constexpr int D = 1024, NBATCH = 2, L = 16384, LC = 256, TB = L + LC, R = NBATCH * TB;
constexpr int NIN = 7968;
constexpr int NP = 2208;
constexpr int NCH = 2688;
constexpr int PC_GQ = 0, PC_GK = 256, PC_GZ = 512, PC_AF = 1024, PC_AQ = 1056, PC_AK = 1568, PC_AZ = 1696;
constexpr int CH_YU = 0, CH_YZ = 1536, CH_GV = 2048, CH_AV = 2560;
constexpr int NCK = 260;
constexpr float EPS = 1e-6f;
constexpr int NT = 512;
constexpr int LDT = 72;

constexpr size_t OFF_P = 0;
constexpr size_t OFF_CT = OFF_P + (size_t)R * NP * 2;
constexpr size_t OFF_H = OFF_CT + (size_t)NCH * 2 * TB * 2;
constexpr size_t OFF_FS = OFF_H + (size_t)R * 1024 * 2;
constexpr size_t OFF_WT = OFF_FS + (size_t)256 * 262144;
constexpr size_t WT_IN = (size_t)NIN * 1024 * 2, WT_BR = (size_t)1024 * 512 * 2, WT_OUT = (size_t)1024 * 1024 * 2;
constexpr size_t WT_LAYER = WT_IN + 3 * WT_BR + WT_OUT;
constexpr size_t OFF_H2T = OFF_WT + 2 * WT_LAYER;
constexpr size_t OFF_H2C = OFF_H2T + (size_t)2 * 64 * L * 4;
constexpr size_t OFF_MOD = OFF_H2C + (size_t)2 * 256 * 64 * 4;
constexpr size_t OFF_CTX1 = OFF_MOD + (size_t)2 * 3 * 3072 * 4;
constexpr size_t OFF_GD = OFF_CTX1 + (size_t)512 * 1024 * 4;
constexpr size_t OFF_PK = OFF_GD + (size_t)16 * NCK * 64 * 4;
constexpr int PK_WAF = 0, PK_BAF = 8192, PK_WAB = 8704, PK_BAB = 16896, PK_GN = 17408, PK_QN = 17664, PK_KN = 17792, PK_CW = 17920,
              PK_CB = 27136, PK_SK = 30208, PK_FN = 32256, PK_F3 = 33280, PK_END = 33280 + 262144;
constexpr size_t WS_END = OFF_PK + (size_t)PK_END * 4;
constexpr size_t OFF_GS = OFF_CT;
constexpr size_t OFF_Y = OFF_CT;
static_assert((size_t)16 * NCK * 8192 * 2 <= (size_t)1536 * 2 * TB * 2, "alias");
static_assert((size_t)R * 1024 * 2 <= (size_t)1536 * 2 * TB * 2, "alias");

constexpr int LDS_BYTES = 131072 + 512;

struct Params {
  const float *x, *c, *ctx, *c_ctx, *w_ada, *b_ada, *w_in, *wa_f, *ba_f, *wa_b, *ba_b, *gla_norm, *qnorm, *knorm,
      *conv_w, *conv_b, *f1_w, *f1_b, *f1_freq, *f2_w, *f2_b, *f2_freq, *f3_w, *skip, *w_g, *w_a, *w_h, *w_o, *final_norm;
  float* out;
  char* ws;
  long long phase_lo, phase_hi;
};

typedef __attribute__((ext_vector_type(2))) float f32x2v;
typedef __attribute__((ext_vector_type(2))) __bf16 bf16x2v;
DI u16 f2bf(float x) { return __builtin_bit_cast(u16, (__bf16)x); }
DI float bf2f(u16 v) { return __uint_as_float(((unsigned)v) << 16); }
DI unsigned pack2(float a, float b) { f32x2v v = {a, b}; return __builtin_bit_cast(unsigned, __builtin_convertvector(v, bf16x2v)); }
DI float bflo(unsigned u) { return __uint_as_float(u << 16); }
DI float bfhi(unsigned u) { return __uint_as_float(u & 0xffff0000u); }
DI float silu_f(float x) { return x / (1.f + __expf(-x)); }
DI float wave_sum(float v) {
#pragma unroll
  for (int o = 32; o >= 1; o >>= 1) v += __shfl_xor(v, o);
  return v;
}
DI int crow(int reg, int h) { return (reg & 3) + 8 * (reg >> 2) + 4 * h; }
DI f32x16 zero16() { f32x16 z; for (int i = 0; i < 16; ++i) z[i] = 0.f; return z; }
DI bf16x8 pack8(const f32x16& x, int s) {
  u32x4 u;
  u.x = pack2(x[8 * s + 0], x[8 * s + 1]); u.y = pack2(x[8 * s + 2], x[8 * s + 3]);
  u.z = pack2(x[8 * s + 4], x[8 * s + 5]); u.w = pack2(x[8 * s + 6], x[8 * s + 7]);
  return __builtin_bit_cast(bf16x8, u);
}
DI bf16x8 ld2x64(const u16* p0, const u16* p1) {
  u32x2 a = *(const u32x2*)p0, b = *(const u32x2*)p1;
  u32x4 u; u.x = a.x; u.y = a.y; u.z = b.x; u.w = b.y;
  return __builtin_bit_cast(bf16x8, u);
}
DI float2 cmul(float2 a, float2 b) { return make_float2(a.x * b.x - a.y * b.y, a.x * b.y + a.y * b.x); }
DI float2 cadd(float2 a, float2 b) { return make_float2(a.x + b.x, a.y + b.y); }
DI float2 csub(float2 a, float2 b) { return make_float2(a.x - b.x, a.y - b.y); }

DI const float* xrow_in(const Params& p, int layer, int row) {
  int b = row / TB, tk = row - b * TB;
  if (tk < LC) return (layer == 0 ? p.ctx : (const float*)(p.ws + OFF_CTX1)) + (size_t)(b * LC + tk) * D;
  return (layer == 0 ? p.x : (const float*)p.out) + (size_t)(b * L + tk - LC) * D;
}
DI float* xrow_out(const Params& p, int row) {
  int b = row / TB, tk = row - b * TB;
  if (tk < LC) return (float*)(p.ws + OFF_CTX1) + (size_t)(b * LC + tk) * D;
  return p.out + (size_t)(b * L + tk - LC) * D;
}
DI const float* pk(const Params& p, int off) { return (const float*)(p.ws + OFF_PK) + off; }
DI int modvec_of(int row) { int b = row / TB, tk = row - b * TB; return tk < LC ? 2 : b; }

struct ALoadN {
  const u16* A; int lda;
  template <int BM> DI void fetch(u32x4 (&r)[BM / 64], int k0, int tid) const {
#pragma unroll
    for (int i = 0; i < BM / 64; ++i) { int q = tid + NT * i; r[i] = *(const u32x4*)(A + (size_t)(q >> 3) * lda + k0 + (q & 7) * 8); }
  }
  template <int BM> DI void commit(const u32x4 (&r)[BM / 64], u16* As, int tid) const {
#pragma unroll
    for (int i = 0; i < BM / 64; ++i) { int q = tid + NT * i; *(u32x4*)(As + (q >> 3) * LDT + (q & 7) * 8) = r[i]; }
  }
};
struct ALoadT {
  const u16* A; size_t chs;
  template <int BM> DI void fetch(u32x4 (&r)[BM / 64], int k0, int tid) const {
#pragma unroll
    for (int i = 0; i < 2; ++i) { int q = tid + NT * i; r[i] = *(const u32x4*)(A + (size_t)(k0 + (q >> 4)) * chs + (q & 15) * 8); }
  }
  template <int BM> DI void commit(const u32x4 (&r)[BM / 64], u16* As, int tid) const {
#pragma unroll
    for (int i = 0; i < 2; ++i) {
      int q = tid + NT * i; int ch = q >> 4, t0 = (q & 15) * 8;
      unsigned w[4] = {r[i].x, r[i].y, r[i].z, r[i].w};
#pragma unroll
      for (int e = 0; e < 4; ++e) { As[(t0 + 2 * e) * LDT + ch] = (u16)(w[e] & 0xffffu); As[(t0 + 2 * e + 1) * LDT + ch] = (u16)(w[e] >> 16); }
    }
  }
};

template <int BM, class AL, int KSU = 4>
DI void gemm_tile(const AL& al, const u16* __restrict__ Bt, int ldb, int K, char* smem, f32x16 (&acc)[BM / 128][2]) {
  u16* As = (u16*)smem;
  u16* Bs = As + 2 * BM * LDT;
  const int tid = threadIdx.x, lane = tid & 63, wid = tid >> 6, r = lane & 31, h = lane >> 5;
  const int wm = wid & 3, wn = wid >> 2;
  u32x4 ra[BM / 64], rb[2];
  const int KT = K >> 6;
  al.template fetch<BM>(ra, 0, tid);
#pragma unroll
  for (int i = 0; i < 2; ++i) { int q = tid + NT * i; rb[i] = *(const u32x4*)(Bt + (size_t)(q >> 3) * ldb + (q & 7) * 8); }
  __syncthreads();
  al.template commit<BM>(ra, As, tid);
#pragma unroll
  for (int i = 0; i < 2; ++i) { int q = tid + NT * i; *(u32x4*)(Bs + (q >> 3) * LDT + (q & 7) * 8) = rb[i]; }
  __syncthreads();
  for (int kt = 0; kt < KT; ++kt) {
    const int cur = kt & 1;
    if (kt + 1 < KT) {
      al.template fetch<BM>(ra, (kt + 1) * 64, tid);
#pragma unroll
      for (int i = 0; i < 2; ++i) { int q = tid + NT * i; rb[i] = *(const u32x4*)(Bt + (size_t)(q >> 3) * ldb + (kt + 1) * 64 + (q & 7) * 8); }
    }
    const u16* Ac = As + cur * BM * LDT;
    const u16* Bc = Bs + cur * 128 * LDT;
#pragma unroll KSU
    for (int ks = 0; ks < 4; ++ks) {
      bf16x8 a[BM / 128], b[2];
#pragma unroll
      for (int i = 0; i < BM / 128; ++i) a[i] = *(const bf16x8*)(Ac + (wm * (BM / 4) + i * 32 + r) * LDT + ks * 16 + h * 8);
#pragma unroll
      for (int j = 0; j < 2; ++j) b[j] = *(const bf16x8*)(Bc + (wn * 64 + j * 32 + r) * LDT + ks * 16 + h * 8);
#pragma unroll
      for (int i = 0; i < BM / 128; ++i)
#pragma unroll
        for (int j = 0; j < 2; ++j) acc[i][j] = MFMA(a[i], b[j], acc[i][j]);
    }
    if (kt + 1 < KT) {
      al.template commit<BM>(ra, As + (cur ^ 1) * BM * LDT, tid);
#pragma unroll
      for (int i = 0; i < 2; ++i) { int q = tid + NT * i; *(u32x4*)(Bs + (cur ^ 1) * 128 * LDT + (q >> 3) * LDT + (q & 7) * 8) = rb[i]; }
    }
    __syncthreads();
  }
}

DI void phase0(const Params& p, char* smem) {
  const int tid = threadIdx.x, lane = tid & 63, wid = tid >> 6, bid = blockIdx.x, nb = gridDim.x;
  float* sm = (float*)smem;
  {
    float* PKW = (float*)(p.ws + OFF_PK);
    const int gt = bid * NT + tid, gn = nb * NT;
#define PKCP(src, off, cnt) for (int i = gt; i < (cnt); i += gn) PKW[(off) + i] = (src)[i];
    PKCP(p.wa_f, PK_WAF, 8192) PKCP(p.ba_f, PK_BAF, 512) PKCP(p.wa_b, PK_WAB, 8192) PKCP(p.ba_b, PK_BAB, 512)
    PKCP(p.gla_norm, PK_GN, 256) PKCP(p.qnorm, PK_QN, 128) PKCP(p.knorm, PK_KN, 128) PKCP(p.conv_w, PK_CW, 9216)
    PKCP(p.conv_b, PK_CB, 3072) PKCP(p.skip, PK_SK, 2048) PKCP(p.final_norm, PK_FN, 1024) PKCP(p.f3_w, PK_F3, 262144)
#undef PKCP
  }
  float* mod = (float*)(p.ws + OFF_MOD);
  for (int task = bid; task < 96; task += nb) {
    const int l = task / 48, cb = task % 48, col = cb * 64 + lane;
    const float* W = p.w_ada + (size_t)l * 1024 * 3072;
    float a0 = 0.f, a1 = 0.f, a2 = 0.f;
#pragma unroll 8
    for (int k = wid * 128; k < wid * 128 + 128; ++k) {
      float wv = W[(size_t)k * 3072 + col];
      a0 += silu_f(p.c[k]) * wv; a1 += silu_f(p.c[1024 + k]) * wv; a2 += silu_f(p.c_ctx[k]) * wv;
    }
    __syncthreads();
    sm[(wid * 3 + 0) * 64 + lane] = a0; sm[(wid * 3 + 1) * 64 + lane] = a1; sm[(wid * 3 + 2) * 64 + lane] = a2;
    __syncthreads();
    if (tid < 192) {
      int v = tid >> 6; float s = p.b_ada[l * 3072 + col];
      for (int w = 0; w < 8; ++w) s += sm[(w * 3 + v) * 64 + lane];
      mod[(l * 3 + v) * 3072 + col] = s;
    }
    __syncthreads();
  }
  for (int it = bid; it < (2 * TB) / 8; it += nb) {
    const int gr = it * 8 + wid, l = gr / TB, rr = gr - l * TB;
    const bool lat = rr < L; const int t = lat ? rr : rr - L; const int Lq = lat ? L : LC;
    float* em = sm + wid * 104; float* h1 = em + 40;
    __syncthreads();
    if (lane < 33) {
      float v;
      if (lane == 0) v = (float)t / (float)(Lq - 1);
      else {
        int bi = (lane - 1) & 15; float fr = 1e-4f + (float)bi * ((15.f - 1e-4f) / 15.f);
        float w = 6.283185307179586f * (float)t / (float)Lq;
        v = (lane <= 16) ? cosf(fr * w) : -sinf(fr * w);
      }
      em[lane] = v;
    }
    __syncthreads();
    {
      float a = p.f1_b[l * 64 + lane];
      for (int e = 0; e < 33; ++e) a += em[e] * p.f1_w[(l * 33 + e) * 64 + lane];
      h1[lane] = sinf(p.f1_freq[l * 64 + lane] * a);
    }
    __syncthreads();
    {
      float a = p.f2_b[l * 64 + lane];
      for (int i = 0; i < 64; ++i) a += h1[i] * p.f2_w[(l * 64 + i) * 64 + lane];
      float v = sinf(p.f2_freq[l * 64 + lane] * a);
      if (lat) ((float*)(p.ws + OFF_H2T))[((size_t)l * 64 + lane) * L + t] = v;
      else ((float*)(p.ws + OFF_H2C))[((size_t)l * 256 + t) * 64 + lane] = v;
    }
  }
  __syncthreads();
  {
    constexpr int T_IN = 16 * 249, T_BR = 8 * 32, T_OUT = 16 * 32, T_LAYER = T_IN + 3 * T_BR + T_OUT;
    float* tile = sm;
    for (int task = bid; task < 2 * T_LAYER; task += nb) {
      const int l = task / T_LAYER; int tt = task - l * T_LAYER;
      const float* src; u16* dst; int K, N, kt, ntile;
      char* wt = p.ws + OFF_WT + (size_t)l * WT_LAYER;
      if (tt < T_IN) { src = p.w_in + (size_t)l * 1024 * NIN; dst = (u16*)wt; K = 1024; N = NIN; kt = tt / 249; ntile = tt % 249; }
      else if (tt < T_IN + 3 * T_BR) {
        tt -= T_IN; int br = tt / T_BR; tt -= br * T_BR;
        src = (br == 0 ? p.w_g : (br == 1 ? p.w_a : p.w_h)) + (size_t)l * 512 * 1024; dst = (u16*)(wt + WT_IN + br * WT_BR);
        K = 512; N = 1024; kt = tt / 32; ntile = tt % 32;
      } else { tt -= T_IN + 3 * T_BR; src = p.w_o + (size_t)l * 1024 * 1024; dst = (u16*)(wt + WT_IN + 3 * WT_BR); K = 1024; N = 1024; kt = tt / 32; ntile = tt % 32; }
      const int k0 = kt * 64, n0 = ntile * 32;
#pragma unroll
      for (int i = 0; i < 4; ++i) { int kk = (tid >> 5) + 16 * i, nn = tid & 31; tile[kk * 33 + nn] = src[(size_t)(k0 + kk) * N + n0 + nn]; }
      __syncthreads();
#pragma unroll
      for (int i = 0; i < 4; ++i) { int nn = (tid >> 6) + 8 * i, kk = tid & 63; dst[(size_t)(n0 + nn) * K + k0 + kk] = f2bf(tile[kk * 33 + nn]); }
      __syncthreads();
    }
  }
}

DI void phase_norm(const Params& p, int l) {
  const int tid = threadIdx.x, lane = tid & 63, wid = tid >> 6;
  const float* mod = (const float*)(p.ws + OFF_MOD);
  u16* H = (u16*)(p.ws + OFF_H);
  for (int row = blockIdx.x * 8 + wid; row < R; row += gridDim.x * 8) {
    const float* src = xrow_in(p, l, row);
    const float* mv = mod + (l * 3 + modvec_of(row)) * 3072;
    float4 xv[4]; float ss = 0.f;
#pragma unroll
    for (int i = 0; i < 4; ++i) { xv[i] = *(const float4*)(src + (i * 64 + lane) * 4); ss += xv[i].x * xv[i].x + xv[i].y * xv[i].y + xv[i].z * xv[i].z + xv[i].w * xv[i].w; }
    ss = wave_sum(ss);
    const float rs = rsqrtf(ss * (1.f / 1024.f) + EPS);
#pragma unroll
    for (int i = 0; i < 4; ++i) {
      const int col = (i * 64 + lane) * 4;
      float4 sh = *(const float4*)(mv + col), sc = *(const float4*)(mv + 1024 + col);
      u32x2 o;
      o.x = pack2(xv[i].x * rs * (1.f + sc.x) + sh.x, xv[i].y * rs * (1.f + sc.y) + sh.y);
      o.y = pack2(xv[i].z * rs * (1.f + sc.z) + sh.z, xv[i].w * rs * (1.f + sc.w) + sh.w);
      *(u32x2*)(H + (size_t)row * 1024 + col) = o;
    }
  }
}

DI void phase_proj(const Params& p, int l, char* smem) {
  const int tid = threadIdx.x, lane = tid & 63, wid = tid >> 6, r = lane & 31, h = lane >> 5, wm = wid & 3, wn = wid >> 2;
  const u16* H = (const u16*)(p.ws + OFF_H);
  const u16* WT = (const u16*)(p.ws + OFF_WT + (size_t)l * WT_LAYER);
  u16* P = (u16*)(p.ws + OFF_P);
  u16* CT = (u16*)(p.ws + OFF_CT);
  for (int t = blockIdx.x; t < 130 * 39; t += gridDim.x) {
    const int mt = t / 39, nt = t - mt * 39, m0 = mt * 256, n0 = nt * 128;
    f32x16 acc[2][2];
#pragma unroll
    for (int i = 0; i < 2; ++i) for (int j = 0; j < 2; ++j) acc[i][j] = zero16();
    ALoadN al{H + (size_t)m0 * 1024, 1024};
    gemm_tile<256>(al, WT + (size_t)n0 * 1024, 1024, 1024, smem, acc);
    const int b = m0 / TB, tk0 = m0 - b * TB;
#pragma unroll
    for (int j = 0; j < 2; ++j) {
      const int cb = n0 + wn * 64 + j * 32;
      if (cb >= 4896) continue;
      bool chan; int cm;
      if (cb < 512) { chan = false; cm = cb; }
      else if (cb < 1024) { chan = true; cm = CH_GV + cb - 512; }
      else if (cb < 2208) { chan = false; cm = cb - 512; }
      else if (cb < 2336) { chan = true; cm = CH_AV + cb - 2208; }
      else if (cb < 2848) { chan = false; cm = cb - 640; }
      else { chan = true; cm = cb - 2848; }
#pragma unroll
      for (int i = 0; i < 2; ++i) {
        const int rbase = wm * 64 + i * 32;
        if (!chan) {
#pragma unroll
          for (int reg = 0; reg < 16; ++reg) P[(size_t)(m0 + rbase + crow(reg, h)) * NP + cm + r] = f2bf(acc[i][j][reg]);
        } else {
#pragma unroll
          for (int g = 0; g < 4; ++g) {
            u32x2 o; o.x = pack2(acc[i][j][4 * g], acc[i][j][4 * g + 1]); o.y = pack2(acc[i][j][4 * g + 2], acc[i][j][4 * g + 3]);
            *(u32x2*)(CT + ((size_t)(cm + r) * 2 + b) * TB + tk0 + rbase + 8 * g + 4 * h) = o;
          }
        }
      }
    }
  }
}

DI void attn_prep(const Params& p, int l, int dry) {
  const int tid = threadIdx.x, lane = tid & 63, wid = tid >> 6;
  u16* P = (u16*)(p.ws + OFF_P);
  const float gq = pk(p, PK_QN)[l * 64 + lane], gk = pk(p, PK_KN)[l * 64 + lane];
  for (int row = blockIdx.x * 8 + wid; row < R; row += gridDim.x * 8) {
    u16* Pr = P + (size_t)row * NP;
    const int b = row / TB, tk = row - b * TB;
    float cs = 1.f, sn = 0.f;
    if (tk >= LC) {
      const int t = tk - LC, pi = lane >> 1;
      const float pos = (pi < 16) ? (float)(t >> 6) : (float)(t & 63);
      const float inv = powf(10000.f, -(float)(2 * (pi & 15)) / 32.f);
      sincosf(pos * inv, &sn, &cs);
    }
#pragma unroll
    for (int hd = 0; hd < 10; ++hd) {
      const int col = (hd < 8) ? PC_AQ + hd * 64 + lane : PC_AK + (hd - 8) * 64 + lane;
      float v = bf2f(Pr[col]);
      const float ss = wave_sum(v * v);
      v = v * rsqrtf(ss * (1.f / 64.f) + EPS) * (hd < 8 ? gq : gk);
      const float pv = __shfl_xor(v, 1);
      float o = (lane & 1) ? (pv * sn + v * cs) : (v * cs - pv * sn);
      if (hd < 8) o *= 0.125f * 1.4426950408889634f;
      if (!dry) Pr[col] = f2bf(o);
    }
  }
}

DI void fft_fwd(float2* X, int tid) {
#pragma unroll 1
  for (int h2 = 4096; h2 >= 1; h2 >>= 2) {
    const float inv4 = 0.25f / (float)h2;
#pragma unroll 2
    for (int i = 0; i < 8; ++i) {
      const int g = tid + NT * i, jp = g & (h2 - 1), base = ((g - jp) << 2) + jp;
      float2 e0 = X[base], e1 = X[base + h2], e2 = X[base + 2 * h2], e3 = X[base + 3 * h2];
      const float fr = (float)jp * inv4;
      const float2 T1 = make_float2(__builtin_amdgcn_cosf(fr), -__builtin_amdgcn_sinf(fr));
      const float2 T2 = cmul(T1, T1);
      float2 a0 = cadd(e0, e2), a2 = cmul(csub(e0, e2), T1);
      float2 a1 = cadd(e1, e3), d13 = cmul(csub(e1, e3), T1);
      float2 a3 = make_float2(d13.y, -d13.x);
      X[base] = cadd(a0, a1); X[base + h2] = cmul(csub(a0, a1), T2);
      X[base + 2 * h2] = cadd(a2, a3); X[base + 3 * h2] = cmul(csub(a2, a3), T2);
    }
    __syncthreads();
  }
}
DI void fft_inv(float2* X, int tid) {
#pragma unroll 1
  for (int h1 = 1; h1 <= 4096; h1 <<= 2) {
    const float inv4 = 0.25f / (float)h1;
#pragma unroll 2
    for (int i = 0; i < 8; ++i) {
      const int g = tid + NT * i, jp = g & (h1 - 1), base = ((g - jp) << 2) + jp;
      float2 e0 = X[base], e1 = X[base + h1], e2 = X[base + 2 * h1], e3 = X[base + 3 * h1];
      const float fr = (float)jp * inv4;
      const float2 V = make_float2(__builtin_amdgcn_cosf(fr), __builtin_amdgcn_sinf(fr));
      const float2 Wc = cmul(V, V);
      float2 t1 = cmul(e1, Wc), t3 = cmul(e3, Wc);
      float2 a0 = cadd(e0, t1), a1 = csub(e0, t1), a2 = cadd(e2, t3), a3 = csub(e2, t3);
      float2 u2 = cmul(a2, V), u3 = cmul(a3, V);
      u3 = make_float2(-u3.y, u3.x);
      X[base] = cadd(a0, u2); X[base + 2 * h1] = csub(a0, u2);
      X[base + h1] = cadd(a1, u3); X[base + 3 * h1] = csub(a1, u3);
    }
    __syncthreads();
  }
}
DI float sconv_at(const u16* src, int t, int len, float w0, float w1, float w2, float bb) {
  float ym = t > 0 ? bf2f(src[t - 1]) : 0.f, y0 = bf2f(src[t]), yp = t < len - 1 ? bf2f(src[t + 1]) : 0.f;
  return bb + w0 * ym + w1 * y0 + w2 * yp;
}
DI float hy_delta(int col) {
  const float A0 = -4.605170185988091f / 0.3f, A1 = -4.605170185988091f / 1.5f;
  return fabsf(A0 + (A1 - A0) * ((float)col / 2047.f));
}

DI void hyena_latent_task(const Params& p, int l, int c, char* smem, int dry) {
  float2* X = (float2*)smem;
  float* red = (float*)(smem + 131072);
  const int tid = threadIdx.x, lane = tid & 63, wid = tid >> 6;
  u16* CT = (u16*)(p.ws + OFF_CT);
  float2* FE = (float2*)(p.ws + OFF_FS + (size_t)blockIdx.x * 262144);
  float2* FO = FE + 16384;
  const float* h2T = (const float*)(p.ws + OFF_H2T) + (size_t)l * 64 * L;
  const float* f3w = pk(p, PK_F3) + (size_t)l * 64 * 2048;
  const float* cw = pk(p, PK_CW) + (size_t)l * 3 * 1536;
  const float* cbv = pk(p, PK_CB) + (size_t)l * 1536;
  const float vw0 = cw[c], vw1 = cw[1536 + c], vw2 = cw[3072 + c], vbb = cbv[c];
  const u16* v0 = CT + ((size_t)(CH_YU + c) * 2 + 0) * TB + LC;
  const u16* v1 = CT + ((size_t)(CH_YU + c) * 2 + 1) * TB + LC;
  u16* z10 = CT + ((size_t)(CH_YU + 512 + c) * 2 + 0) * TB + LC;
  u16* z11 = CT + ((size_t)(CH_YU + 512 + c) * 2 + 1) * TB + LC;
#pragma unroll 1
  for (int o = 0; o < 2; ++o) {
    const int cf = o * 1024 + c, cbk = cf + 512;
    float sf = 0.f, sb = 0.f;
    __syncthreads();
#pragma unroll 1
    for (int half = 0; half < 2; ++half) {
      float af[16], ab[16];
#pragma unroll
      for (int i = 0; i < 16; ++i) { af[i] = 0.f; ab[i] = 0.f; }
#pragma unroll 1
      for (int j = 0; j < 64; ++j) {
        const float wf = f3w[j * 2048 + cf], wb = f3w[j * 2048 + cbk];
        const float* hrow = h2T + (size_t)j * L + tid + half * 16 * NT;
#pragma unroll
        for (int i = 0; i < 16; ++i) { const float hv = hrow[NT * i]; af[i] += hv * wf; ab[i] += hv * wb; }
      }
      const float df = hy_delta(cf), db = hy_delta(cbk);
#pragma unroll
      for (int i = 0; i < 16; ++i) {
        const int t = tid + NT * (i + half * 16); const float tt = (float)t / (float)(L - 1);
        const float vf = af[i] * (__expf(-tt * df) + 0.05f), vb = ab[i] * (__expf(-tt * db) + 0.05f);
        sf += fabsf(vf); sb += fabsf(vb);
        X[t].x = vf;
        if (t >= 1) X[L - t].y = vb; else X[0].y = 0.f;
      }
    }
    sf = wave_sum(sf); sb = wave_sum(sb);
    if (lane == 0) { red[wid] = sf; red[8 + wid] = sb; }
    __syncthreads();
    float nf = 0.f, nbk = 0.f;
#pragma unroll
    for (int w = 0; w < 8; ++w) { nf += red[w]; nbk += red[8 + w]; }
    const float inv_f = 1.f / nf, inv_b = 1.f / nbk;
#pragma unroll 4
    for (int i = 0; i < 32; ++i) { const int n = tid + NT * i; const float2 s = X[n]; FO[n] = s; X[n] = make_float2(s.x * inv_f + s.y * inv_b, 0.f); }
    __syncthreads();
    fft_fwd(X, tid);
#pragma unroll 4
    for (int i = 0; i < 32; ++i) { const int n = tid + NT * i; FE[n] = X[n]; }
    __syncthreads();
#pragma unroll 4
    for (int i = 0; i < 32; ++i) {
      const int n = tid + NT * i; const float2 s = FO[n]; const float dd = s.x * inv_f - s.y * inv_b; const float fr = (float)n * (1.f / 32768.f);
      X[n] = make_float2(dd * __builtin_amdgcn_cosf(fr), -dd * __builtin_amdgcn_sinf(fr));
    }
    __syncthreads();
    fft_fwd(X, tid);
#pragma unroll 4
    for (int i = 0; i < 32; ++i) { const int n = tid + NT * i; FO[n] = X[n]; }
    __syncthreads();
#pragma unroll 4
    for (int i = 0; i < 32; ++i) {
      const int n = tid + NT * i;
      float2 zz;
      if (o == 0) { zz.x = sconv_at(v0, n, L, vw0, vw1, vw2, vbb); zz.y = sconv_at(v1, n, L, vw0, vw1, vw2, vbb); }
      else { zz.x = bf2f(z10[n]); zz.y = bf2f(z11[n]); }
      X[n] = zz;
    }
    __syncthreads();
    fft_fwd(X, tid);
#pragma unroll 4
    for (int i = 0; i < 32; ++i) { const int n = tid + NT * i; X[n] = cmul(X[n], FE[n]); }
    __syncthreads();
    fft_inv(X, tid);
#pragma unroll 4
    for (int i = 0; i < 32; ++i) { const int n = tid + NT * i; FE[n] = X[n]; }
    __syncthreads();
#pragma unroll 4
    for (int i = 0; i < 32; ++i) {
      const int n = tid + NT * i; const float fr = (float)n * (1.f / 32768.f);
      float2 zz;
      if (o == 0) { zz.x = sconv_at(v0, n, L, vw0, vw1, vw2, vbb); zz.y = sconv_at(v1, n, L, vw0, vw1, vw2, vbb); }
      else { zz.x = bf2f(z10[n]); zz.y = bf2f(z11[n]); }
      X[n] = cmul(zz, make_float2(__builtin_amdgcn_cosf(fr), -__builtin_amdgcn_sinf(fr)));
    }
    __syncthreads();
    fft_fwd(X, tid);
#pragma unroll 4
    for (int i = 0; i < 32; ++i) { const int n = tid + NT * i; X[n] = cmul(X[n], FO[n]); }
    __syncthreads();
    fft_inv(X, tid);
    {
      const int gch = CH_YU + 512 * (o + 1) + c;
      const float w0 = cw[gch], w1 = cw[1536 + gch], w2 = cw[3072 + gch], bb = cbv[gch];
      const u16* s0 = CT + ((size_t)gch * 2 + 0) * TB + LC;
      const u16* s1 = CT + ((size_t)gch * 2 + 1) * TB + LC;
      const float sk = pk(p, PK_SK)[(l * 2 + o) * 512 + c];
#pragma unroll 4
      for (int i = 0; i < 32; ++i) {
        const int n = tid + NT * i; const float fr = (float)n * (1.f / 32768.f);
        const float2 wb = cmul(X[n], make_float2(__builtin_amdgcn_cosf(fr), __builtin_amdgcn_sinf(fr)));
        const float2 A = FE[n];
        const float yr = (A.x + wb.x) * (1.f / 32768.f), yi = (A.y + wb.y) * (1.f / 32768.f);
        const float g0 = sconv_at(s0, n, L, w0, w1, w2, bb), g1 = sconv_at(s1, n, L, w0, w1, w2, bb);
        float2 zz;
        if (o == 0) { zz.x = sconv_at(v0, n, L, vw0, vw1, vw2, vbb); zz.y = sconv_at(v1, n, L, vw0, vw1, vw2, vbb); }
        else { zz.x = bf2f(z10[n]); zz.y = bf2f(z11[n]); }
        X[n] = make_float2(g0 * (yr + sk * zz.x), g1 * (yi + sk * zz.y));
      }
    }
    __syncthreads();
    if (o == 0) {
#pragma unroll 4
      for (int i = 0; i < 32; ++i) { const int n = tid + NT * i; const float2 zz = X[n]; if (!dry) { z10[n] = f2bf(zz.x); z11[n] = f2bf(zz.y); } }
    } else {
      u16* d0 = CT + ((size_t)(CH_YZ + c) * 2 + 0) * TB + LC;
      u16* d1 = CT + ((size_t)(CH_YZ + c) * 2 + 1) * TB + LC;
#pragma unroll 4
      for (int i = 0; i < 32; ++i) {
        const int n = tid + NT * i; const float2 zz = X[n];
        const u16 q0 = f2bf(zz.x * silu_f(bf2f(d0[n]))), q1 = f2bf(zz.y * silu_f(bf2f(d1[n])));
        if (!dry) { d0[n] = q0; d1[n] = q1; }
      }
    }
    __syncthreads();
  }
}

DI void hyena_ctx_task(const Params& p, int l, int c, char* smem, int dry) {
  float* filt = (float*)smem;
  float* zs = filt + 1024;
  float* nrm = zs + 1024;
  const int tid = threadIdx.x, lane = tid & 63, wid = tid >> 6, t = tid & 255, hb = tid >> 8;
  u16* CT = (u16*)(p.ws + OFF_CT);
  const float* h2c = (const float*)(p.ws + OFF_H2C) + (size_t)l * 256 * 64;
  const float* f3w = pk(p, PK_F3) + (size_t)l * 64 * 2048;
  const float* cw = pk(p, PK_CW) + (size_t)l * 3 * 1536;
  const float* cbv = pk(p, PK_CB) + (size_t)l * 1536;
  __syncthreads();
  {
    const int cf = hb * 1024 + c, cbk = cf + 512;
    float a_f = 0.f, a_b = 0.f;
    for (int j = 0; j < 64; ++j) { const float hv = h2c[t * 64 + j]; a_f += hv * f3w[j * 2048 + cf]; a_b += hv * f3w[j * 2048 + cbk]; }
    const float tt = (float)t / 255.f;
    filt[(hb * 2 + 0) * 256 + t] = a_f * (__expf(-tt * hy_delta(cf)) + 0.05f);
    filt[(hb * 2 + 1) * 256 + t] = a_b * (__expf(-tt * hy_delta(cbk)) + 0.05f);
    const u16* src = CT + ((size_t)(CH_YU + c) * 2 + hb) * TB;
    zs[hb * 256 + t] = sconv_at(src, t, LC, cw[c], cw[1536 + c], cw[3072 + c], cbv[c]);
  }
  __syncthreads();
  if (wid < 4) {
    float s = 0.f;
    for (int k = 0; k < 4; ++k) s += fabsf(filt[wid * 256 + lane + 64 * k]);
    s = wave_sum(s);
    if (lane == 0) nrm[wid] = s;
  }
  __syncthreads();
  const int b = hb;
  for (int o = 0; o < 2; ++o) {
    const float inf_ = 1.f / nrm[o * 2], inb_ = 1.f / nrm[o * 2 + 1];
    const float* hf = filt + (o * 2) * 256; const float* hbk = filt + (o * 2 + 1) * 256;
    const float* zc = zs + (o & 1) * 512 + b * 256;
    float accf = 0.f, accb = 0.f;
    for (int s = 0; s <= t; ++s) accf += hf[t - s] * zc[s];
    for (int s = t + 1; s < 256; ++s) accb += hbk[s - t] * zc[s];
    const int gch = CH_YU + 512 * (o + 1) + c;
    const float gate = sconv_at(CT + ((size_t)gch * 2 + b) * TB, t, LC, cw[gch], cw[1536 + gch], cw[3072 + gch], cbv[gch]);
    const float zn = gate * (accf * inf_ + accb * inb_ + pk(p, PK_SK)[(l * 2 + o) * 512 + c] * zc[t]);
    zs[((o + 1) & 1) * 512 + b * 256 + t] = zn;
    __syncthreads();
  }
  {
    u16* d = CT + ((size_t)(CH_YZ + c) * 2 + b) * TB;
    const u16 q0 = f2bf(zs[b * 256 + t] * silu_f(bf2f(d[t])));
    if (!dry) d[t] = q0;
  }
  __syncthreads();
}

DI void gla_bcum(const Params& p, int l, int row0, int hh, int dir, float* gs, float* segs, float* was, float* as_) {
  const int tid = threadIdx.x;
  const u16* P = (const u16*)(p.ws + OFF_P);
  const float* wa = pk(p, dir ? PK_WAB : PK_WAF) + (size_t)l * 16 * 256 + hh * 64;
  const float* ba = pk(p, dir ? PK_BAB : PK_BAF) + l * 256 + hh * 64;
#pragma unroll
  for (int i = 0; i < 2; ++i) {
    const int idx = tid + NT * i;
    was[idx] = wa[(idx >> 6) * 256 + (idx & 63)];
    as_[(idx >> 4) * 17 + (idx & 15)] = bf2f(P[(size_t)(row0 + (idx >> 4)) * NP + PC_AF + dir * 16 + (idx & 15)]);
  }
  __syncthreads();
  {
    const int t = tid >> 3, d0 = (tid & 7) * 8;
    float lin[8];
#pragma unroll
    for (int e = 0; e < 8; ++e) lin[e] = ba[d0 + e];
#pragma unroll 2
    for (int rr = 0; rr < 16; ++rr) {
      const float av = as_[t * 17 + rr];
      const float4 w0 = *(const float4*)(was + rr * 64 + d0), w1 = *(const float4*)(was + rr * 64 + d0 + 4);
      lin[0] += av * w0.x; lin[1] += av * w0.y; lin[2] += av * w0.z; lin[3] += av * w0.w;
      lin[4] += av * w1.x; lin[5] += av * w1.y; lin[6] += av * w1.z; lin[7] += av * w1.w;
    }
#pragma unroll
    for (int e = 0; e < 8; ++e) gs[t * 65 + d0 + e] = (fminf(lin[e], 0.f) - log1pf(__expf(-fabsf(lin[e])))) * (1.f / 16.f);
  }
  __syncthreads();
  {
    const int d = tid & 63, seg = tid >> 6;
    float v[8]; float run = 0.f;
#pragma unroll
    for (int e = 0; e < 8; ++e) { const int tt = dir ? seg * 8 + 7 - e : seg * 8 + e; run += gs[tt * 65 + d]; v[e] = run; }
    segs[seg * 64 + d] = run;
    __syncthreads();
    float off = 0.f;
#pragma unroll
    for (int s = 0; s < 8; ++s) { const bool before = dir ? (s > seg) : (s < seg); if (before) off += segs[s * 64 + d]; }
#pragma unroll
    for (int e = 0; e < 8; ++e) { const int tt = dir ? seg * 8 + 7 - e : seg * 8 + e; gs[tt * 65 + d] = v[e] + off; }
  }
  __syncthreads();
}
DI int gla_tok0(int dir, int n) {
  if (n < 4) return (dir ? 3 - n : n) * 64;
  return LC + (dir ? 255 - (n - 4) : n - 4) * 64;
}
constexpr int G_GS = 0;
constexpr int G_SEG = G_GS + 64 * 65 * 4;
constexpr int G_QS = G_SEG + 8 * 64 * 4;
constexpr int G_KS = G_QS + 64 * LDT * 2;
constexpr int G_VT = G_KS + 64 * LDT * 2;
constexpr int G_ST = G_VT + 128 * LDT * 2;
constexpr int G_RED = G_ST + 128 * LDT * 2;
constexpr int G_WA = G_RED + 8 * 32 * 4;
constexpr int G_AS = G_WA + 16 * 64 * 4;

DI void gla_g1_task(const Params& p, int l, int chain, int n, char* smem) {
  const int tid = threadIdx.x, lane = tid & 63, wid = tid >> 6, r = lane & 31, h = lane >> 5;
  const int b = chain >> 3, hh = (chain >> 1) & 3, dir = chain & 1;
  const int tk0 = gla_tok0(dir, n), row0 = b * TB + tk0;
  float* gs = (float*)(smem + G_GS); float* segs = (float*)(smem + G_SEG);
  u16* kT = (u16*)(smem + G_KS); u16* vT = (u16*)(smem + G_VT);
  const u16* P = (const u16*)(p.ws + OFF_P);
  const u16* CT = (const u16*)(p.ws + OFF_CT);
  __syncthreads();
  gla_bcum(p, l, row0, hh, dir, gs, segs, (float*)(smem + G_WA), (float*)(smem + G_AS));
  const int tl = dir ? 0 : 63;
  {
    const int t = tid >> 3, d0 = (tid & 7) * 8;
    const u32x4 kv = *(const u32x4*)(P + (size_t)(row0 + t) * NP + PC_GK + hh * 64 + d0);
    const unsigned w[4] = {kv.x, kv.y, kv.z, kv.w};
#pragma unroll
    for (int e = 0; e < 8; ++e) {
      const float kx = (e & 1) ? bfhi(w[e >> 1]) : bflo(w[e >> 1]);
      kT[(d0 + e) * LDT + t] = f2bf(kx * __expf(gs[tl * 65 + d0 + e] - gs[t * 65 + d0 + e]));
    }
#pragma unroll
    for (int i = 0; i < 2; ++i) {
      const int q = tid + NT * i, v = q >> 3, cc = q & 7;
      *(u32x4*)(vT + v * LDT + cc * 8) = *(const u32x4*)(CT + ((size_t)(CH_GV + hh * 128 + v) * 2 + b) * TB + tk0 + cc * 8);
    }
    if (tid < 64) ((float*)(p.ws + OFF_GD))[((size_t)chain * NCK + n) * 64 + tid] = __expf(gs[tl * 65 + tid]);
  }
  __syncthreads();
  {
    const int vm = wid >> 1, dn = wid & 1;
    f32x16 acc = zero16();
#pragma unroll
    for (int s = 0; s < 4; ++s) {
      const bf16x8 a = *(const bf16x8*)(vT + (vm * 32 + r) * LDT + s * 16 + h * 8);
      const bf16x8 bb = *(const bf16x8*)(kT + (dn * 32 + r) * LDT + s * 16 + h * 8);
      acc = MFMA(a, bb, acc);
    }
    u16* GS = (u16*)(p.ws + OFF_GS) + ((size_t)chain * NCK + n) * 8192;
#pragma unroll
    for (int reg = 0; reg < 16; ++reg) GS[(vm * 32 + crow(reg, h)) * 64 + dn * 32 + r] = f2bf(acc[reg]);
  }
}
DI void gla_g2(const Params& p, int dry) {
  u16* GSb = (u16*)(p.ws + OFF_GS);
  const float* GD = (const float*)(p.ws + OFF_GD);
  for (int gi = blockIdx.x * NT + threadIdx.x; gi < 16 * 8192; gi += gridDim.x * NT) {
    const int chain = gi >> 13, e = gi & 8191, d = e & 63;
    u16* ptr = GSb + (size_t)chain * NCK * 8192 + e;
    const float* dec = GD + (size_t)chain * NCK * 64 + d;
    float S = 0.f;
#pragma unroll 1
    for (int n0 = 0; n0 < NCK; n0 += 10) {
      float ds[10], a[10];
#pragma unroll
      for (int k = 0; k < 10; ++k) { ds[k] = bf2f(ptr[(size_t)(n0 + k) * 8192]); a[k] = dec[(n0 + k) * 64]; }
#pragma unroll
      for (int k = 0; k < 10; ++k) { if (!dry) ptr[(size_t)(n0 + k) * 8192] = f2bf(S); S = a[k] * S + ds[k]; }
    }
  }
}
DI void gla_g3_task(const Params& p, int l, int b, int hh, int ci, char* smem, int dry) {
  const int tid = threadIdx.x, lane = tid & 63, wid = tid >> 6, r = lane & 31, h = lane >> 5;
  const int tk0 = ci * 64, row0 = b * TB + tk0;
  float* gs = (float*)(smem + G_GS); float* segs = (float*)(smem + G_SEG); float* red = (float*)(smem + G_RED);
  u16* qs = (u16*)(smem + G_QS); u16* ks = (u16*)(smem + G_KS); u16* vT = (u16*)(smem + G_VT); u16* sT = (u16*)(smem + G_ST);
  u16* P = (u16*)(p.ws + OFF_P);
  const u16* CT = (const u16*)(p.ws + OFF_CT);
  const int vm = wid >> 1, in = wid & 1;
  f32x16 o = zero16();
  __syncthreads();
#pragma unroll 1
  for (int dir = 0; dir < 2; ++dir) {
    gla_bcum(p, l, row0, hh, dir, gs, segs, (float*)(smem + G_WA), (float*)(smem + G_AS));
    const int chain = b * 8 + hh * 2 + dir;
    const int n = dir ? ((ci < 4) ? 3 - ci : 263 - ci) : ci;
    {
      const int t = tid >> 3, d0 = (tid & 7) * 8;
      const u32x4 qv = *(const u32x4*)(P + (size_t)(row0 + t) * NP + PC_GQ + hh * 64 + d0);
      const u32x4 kv = *(const u32x4*)(P + (size_t)(row0 + t) * NP + PC_GK + hh * 64 + d0);
      const unsigned qw[4] = {qv.x, qv.y, qv.z, qv.w}, kw[4] = {kv.x, kv.y, kv.z, kv.w};
      unsigned qo[4], ko[4];
#pragma unroll
      for (int e = 0; e < 4; ++e) {
        const float b0 = gs[t * 65 + d0 + 2 * e], b1 = gs[t * 65 + d0 + 2 * e + 1];
        qo[e] = pack2(bflo(qw[e]) * 0.125f * __expf(b0), bfhi(qw[e]) * 0.125f * __expf(b1));
        ko[e] = pack2(bflo(kw[e]) * __expf(-b0), bfhi(kw[e]) * __expf(-b1));
      }
      *(u32x4*)(qs + t * LDT + d0) = u32x4{qo[0], qo[1], qo[2], qo[3]};
      *(u32x4*)(ks + t * LDT + d0) = u32x4{ko[0], ko[1], ko[2], ko[3]};
      const u16* GS = (const u16*)(p.ws + OFF_GS) + ((size_t)chain * NCK + n) * 8192;
#pragma unroll
      for (int i = 0; i < 2; ++i) {
        const int q = tid + NT * i, v = q >> 3, cc = q & 7;
        *(u32x4*)(sT + v * LDT + cc * 8) = *(const u32x4*)(GS + v * 64 + cc * 8);
        if (dir == 0) *(u32x4*)(vT + v * LDT + cc * 8) = *(const u32x4*)(CT + ((size_t)(CH_GV + hh * 128 + v) * 2 + b) * TB + tk0 + cc * 8);
      }
    }
    __syncthreads();
    bf16x8 qf[4];
#pragma unroll
    for (int s = 0; s < 4; ++s) qf[s] = *(const bf16x8*)(qs + (in * 32 + r) * LDT + s * 16 + h * 8);
#pragma unroll
    for (int jt = 0; jt < 2; ++jt) {
      f32x16 at = zero16();
#pragma unroll
      for (int s = 0; s < 4; ++s) at = MFMA(*(const bf16x8*)(ks + (jt * 32 + r) * LDT + s * 16 + h * 8), qf[s], at);
      const int ii = in * 32 + r;
#pragma unroll
      for (int reg = 0; reg < 16; ++reg) {
        const int jj = jt * 32 + crow(reg, h);
        const bool keep = dir ? (jj >= ii) : (jj <= ii);
        if (!keep) at[reg] = 0.f;
      }
#pragma unroll
      for (int s = 0; s < 2; ++s) {
        const u16* vp = vT + (vm * 32 + r) * LDT + jt * 32 + 16 * s + 4 * h;
        o = MFMA(ld2x64(vp, vp + 8), pack8(at, s), o);
      }
    }
#pragma unroll
    for (int s = 0; s < 4; ++s) o = MFMA(*(const bf16x8*)(sT + (vm * 32 + r) * LDT + s * 16 + h * 8), qf[s], o);
    __syncthreads();
  }
  float ss = 0.f;
#pragma unroll
  for (int reg = 0; reg < 16; ++reg) ss += o[reg] * o[reg];
  ss += __shfl_xor(ss, 32);
  if (h == 0) red[wid * 32 + r] = ss;
  __syncthreads();
  float tot = 0.f;
#pragma unroll
  for (int m = 0; m < 4; ++m) tot += red[(m * 2 + in) * 32 + r];
  const float rs = rsqrtf(tot * (1.f / 128.f) + EPS);
  u16* zp = P + (size_t)(row0 + in * 32 + r) * NP + PC_GZ + hh * 128 + vm * 32 + 4 * h;
  const float* gn = pk(p, PK_GN) + l * 128 + vm * 32 + 4 * h;
#pragma unroll
  for (int g = 0; g < 4; ++g) {
    const u32x2 zz = *(const u32x2*)(zp + 8 * g);
    const float4 gw = *(const float4*)(gn + 8 * g);
    u32x2 out;
    out.x = pack2(o[4 * g] * rs * gw.x * silu_f(bflo(zz.x)), o[4 * g + 1] * rs * gw.y * silu_f(bfhi(zz.x)));
    out.y = pack2(o[4 * g + 2] * rs * gw.z * silu_f(bflo(zz.y)), o[4 * g + 3] * rs * gw.w * silu_f(bfhi(zz.y)));
    if (!dry) *(u32x2*)(zp + 8 * g) = out;
  }
}

DI void attn_item(const Params& p, int l, int b, int g, int qtk0, int ntiles, char* smem, int dry) {
  const int tid = threadIdx.x, lane = tid & 63, wid = tid >> 6, r = lane & 31, h = lane >> 5;
  u16* P = (u16*)(p.ws + OFF_P);
  const u16* CT = (const u16*)(p.ws + OFF_CT);
  u16* Ks = (u16*)smem;
  u16* Vs = Ks + 2 * 64 * LDT;
  const int hq = g * 4 + (wid >> 1);
  const size_t qrow = (size_t)b * TB + qtk0 + (wid & 1) * 32 + r;
  bf16x8 qf[4];
#pragma unroll
  for (int s = 0; s < 4; ++s) qf[s] = *(const bf16x8*)(P + qrow * NP + PC_AQ + hq * 64 + s * 16 + h * 8);
  f32x16 O[2] = {zero16(), zero16()};
  float m = -1e30f, lsum = 0.f;
  const int lr = tid >> 3, lc = (tid & 7) * 8;
  const u16* kg = P + ((size_t)b * TB + lr) * NP + PC_AK + g * 64 + lc;
  const u16* vg = CT + ((size_t)(CH_AV + g * 64 + lr) * 2 + b) * TB + lc;
  u32x4 rk = *(const u32x4*)kg, rv = *(const u32x4*)vg;
  __syncthreads();
  *(u32x4*)(Ks + lr * LDT + lc) = rk; *(u32x4*)(Vs + lr * LDT + lc) = rv;
  __syncthreads();
  float gqm = fabsf(pk(p, PK_QN)[l * 64 + lane]), gkm = fabsf(pk(p, PK_KN)[l * 64 + lane]);
#pragma unroll
  for (int o = 32; o >= 1; o >>= 1) { gqm = fmaxf(gqm, __shfl_xor(gqm, o)); gkm = fmaxf(gkm, __shfl_xor(gkm, o)); }
  const float mshift = 8.2f * 1.4426950408889634f * gqm * gkm;
  if (mshift <= 60.f) {
    f32x16 sinit;
#pragma unroll
    for (int i = 0; i < 16; ++i) sinit[i] = -mshift;
#pragma unroll 1
    for (int kt = 0; kt < ntiles; ++kt) {
      const int cur = kt & 1;
      if (kt + 1 < ntiles) { rk = *(const u32x4*)(kg + (size_t)(kt + 1) * 64 * NP); rv = *(const u32x4*)(vg + (kt + 1) * 64); }
      const u16* Kc = Ks + cur * 64 * LDT; const u16* Vc = Vs + cur * 64 * LDT;
      f32x16 st[2];
#pragma unroll
      for (int kk = 0; kk < 2; ++kk) {
        st[kk] = sinit;
#pragma unroll
        for (int s = 0; s < 4; ++s) st[kk] = MFMA(*(const bf16x8*)(Kc + (kk * 32 + r) * LDT + s * 16 + h * 8), qf[s], st[kk]);
      }
#pragma unroll
      for (int kk = 0; kk < 2; ++kk)
#pragma unroll
        for (int i = 0; i < 16; ++i) { const float pv = __builtin_amdgcn_exp2f(st[kk][i]); st[kk][i] = pv; lsum += pv; }
#pragma unroll
      for (int kk = 0; kk < 2; ++kk)
#pragma unroll
        for (int s = 0; s < 2; ++s) {
          const bf16x8 pb = pack8(st[kk], s);
#pragma unroll
          for (int mt = 0; mt < 2; ++mt) {
            const u16* vp = Vc + (mt * 32 + r) * LDT + kk * 32 + 16 * s + 4 * h;
            O[mt] = MFMA(ld2x64(vp, vp + 8), pb, O[mt]);
          }
        }
      if (kt + 1 < ntiles) { *(u32x4*)(Ks + (cur ^ 1) * 64 * LDT + lr * LDT + lc) = rk; *(u32x4*)(Vs + (cur ^ 1) * 64 * LDT + lr * LDT + lc) = rv; }
      __syncthreads();
    }
  } else {
#pragma unroll 1
    for (int kt = 0; kt < ntiles; ++kt) {
      const int cur = kt & 1;
      if (kt + 1 < ntiles) { rk = *(const u32x4*)(kg + (size_t)(kt + 1) * 64 * NP); rv = *(const u32x4*)(vg + (kt + 1) * 64); }
      const u16* Kc = Ks + cur * 64 * LDT; const u16* Vc = Vs + cur * 64 * LDT;
      f32x16 st[2];
#pragma unroll
      for (int kk = 0; kk < 2; ++kk) {
        st[kk] = zero16();
#pragma unroll
        for (int s = 0; s < 4; ++s) st[kk] = MFMA(*(const bf16x8*)(Kc + (kk * 32 + r) * LDT + s * 16 + h * 8), qf[s], st[kk]);
      }
      float mx = st[0][0];
#pragma unroll
      for (int i = 0; i < 16; ++i) { mx = fmaxf(mx, st[0][i]); mx = fmaxf(mx, st[1][i]); }
      mx = fmaxf(mx, __shfl_xor(mx, 32));
      const float mn = fmaxf(m, mx);
      const float alpha = exp2f(m - mn);
      m = mn;
      float rsum = 0.f;
#pragma unroll
      for (int kk = 0; kk < 2; ++kk)
#pragma unroll
        for (int i = 0; i < 16; ++i) { const float pv = exp2f(st[kk][i] - mn); st[kk][i] = pv; rsum += pv; }
      lsum = lsum * alpha + rsum;
#pragma unroll
      for (int mt = 0; mt < 2; ++mt)
#pragma unroll
        for (int i = 0; i < 16; ++i) O[mt][i] *= alpha;
#pragma unroll
      for (int kk = 0; kk < 2; ++kk)
#pragma unroll
        for (int s = 0; s < 2; ++s) {
          const bf16x8 pb = pack8(st[kk], s);
#pragma unroll
          for (int mt = 0; mt < 2; ++mt) {
            const u16* vp = Vc + (mt * 32 + r) * LDT + kk * 32 + 16 * s + 4 * h;
            O[mt] = MFMA(ld2x64(vp, vp + 8), pb, O[mt]);
          }
        }
      if (kt + 1 < ntiles) { *(u32x4*)(Ks + (cur ^ 1) * 64 * LDT + lr * LDT + lc) = rk; *(u32x4*)(Vs + (cur ^ 1) * 64 * LDT + lr * LDT + lc) = rv; }
      __syncthreads();
    }
  }
  lsum += __shfl_xor(lsum, 32);
  const float inv = 1.f / lsum;
  u16* op = P + qrow * NP + PC_AQ + hq * 64 + 4 * h;
  const u16* zp = P + qrow * NP + PC_AZ + hq * 64 + 4 * h;
#pragma unroll
  for (int mt = 0; mt < 2; ++mt)
#pragma unroll
    for (int gg = 0; gg < 4; ++gg) {
      const u32x2 zz = *(const u32x2*)(zp + mt * 32 + 8 * gg);
      u32x2 out;
      out.x = pack2(O[mt][4 * gg] * inv * silu_f(bflo(zz.x)), O[mt][4 * gg + 1] * inv * silu_f(bfhi(zz.x)));
      out.y = pack2(O[mt][4 * gg + 2] * inv * silu_f(bflo(zz.y)), O[mt][4 * gg + 3] * inv * silu_f(bfhi(zz.y)));
      if (!dry) *(u32x2*)(op + mt * 32 + 8 * gg) = out;
    }
}

DI void merge_accum(f32x16 (&ysum)[2], const f32x16 (&am)[1][2], const f32x16 (&ab)[1][2]) {
#pragma unroll
  for (int j = 0; j < 2; ++j)
#pragma unroll
    for (int i = 0; i < 16; ++i) ysum[j][i] += ab[0][j][i] / (1.f + __expf(-am[0][j][i]));
}
DI void phase_merge(const Params& p, int l, char* smem) {
  const int tid = threadIdx.x, lane = tid & 63, wid = tid >> 6, r = lane & 31, h = lane >> 5, wm = wid & 3, wn = wid >> 2;
  for (int t = blockIdx.x; t < 260 * 8; t += gridDim.x) {
    const int mt = t >> 3, nt = t & 7, m0 = mt * 128, n0 = nt * 128;
    const int b = m0 / TB, tk0 = m0 - b * TB;
    if (l == 1 && tk0 < LC) continue;
    const u16* H = (const u16*)(p.ws + OFF_H) + (size_t)m0 * 1024;
    const u16* WM = (const u16*)(p.ws + OFF_WT + (size_t)l * WT_LAYER) + (size_t)(4896 + n0) * 1024;
    const u16* WBR = (const u16*)(p.ws + OFF_WT + (size_t)l * WT_LAYER + WT_IN) + (size_t)n0 * 512;
    f32x16 ysum[2] = {zero16(), zero16()};
#pragma unroll 1
    for (int br = 0; br < 2; ++br) {
      f32x16 am[1][2] = {{zero16(), zero16()}};
      ALoadN ah{H, 1024};
      gemm_tile<128, ALoadN, 1>(ah, WM + (size_t)br * 1024 * 1024, 1024, 1024, smem, am);
      f32x16 ab[1][2] = {{zero16(), zero16()}};
      ALoadN ay{(const u16*)(p.ws + OFF_P) + (size_t)m0 * NP + (br == 0 ? PC_GZ : PC_AQ), NP};
      gemm_tile<128, ALoadN, 1>(ay, WBR + (size_t)br * 1024 * 512, 512, 512, smem, ab);
      merge_accum(ysum, am, ab);
    }
    {
      f32x16 am[1][2] = {{zero16(), zero16()}};
      ALoadN ah{H, 1024};
      gemm_tile<128, ALoadN, 1>(ah, WM + (size_t)2 * 1024 * 1024, 1024, 1024, smem, am);
      f32x16 ab[1][2] = {{zero16(), zero16()}};
      ALoadT ay{(const u16*)(p.ws + OFF_CT) + ((size_t)CH_YZ * 2 + b) * TB + tk0, (size_t)2 * TB};
      gemm_tile<128, ALoadT, 1>(ay, WBR + (size_t)2 * 1024 * 512, 512, 512, smem, ab);
      merge_accum(ysum, am, ab);
    }
    u16* Y = (u16*)(p.ws + OFF_Y) + (size_t)(m0 + wm * 32 + 4 * h) * 1024 + n0 + wn * 64 + r;
#pragma unroll
    for (int j = 0; j < 2; ++j)
#pragma unroll
      for (int reg = 0; reg < 16; ++reg) Y[(size_t)((reg & 3) + 8 * (reg >> 2)) * 1024 + j * 32] = f2bf(ysum[j][reg]);
  }
}

DI void phase_out(const Params& p, int l, char* smem) {
  const int tid = threadIdx.x, lane = tid & 63, wid = tid >> 6, r = lane & 31, h = lane >> 5, wm = wid & 3, wn = wid >> 2;
  const u16* Y = (const u16*)(p.ws + OFF_Y);
  const u16* WO = (const u16*)(p.ws + OFF_WT + (size_t)l * WT_LAYER + WT_IN + 3 * WT_BR);
  const float* mod = (const float*)(p.ws + OFF_MOD);
  for (int t = blockIdx.x; t < 260 * 8; t += gridDim.x) {
    const int mt = t >> 3, nt = t & 7, m0 = mt * 128, n0 = nt * 128;
    const int b = m0 / TB, tk0 = m0 - b * TB;
    if (l == 1 && tk0 < LC) continue;
    f32x16 acc[1][2] = {{zero16(), zero16()}};
    ALoadN ay{Y + (size_t)m0 * 1024, 1024};
    gemm_tile<128>(ay, WO + (size_t)n0 * 1024, 1024, 1024, smem, acc);
    const float* gv = mod + (l * 3 + (tk0 < LC ? 2 : b)) * 3072 + 2048;
    const float* xin = xrow_in(p, l, m0);
    float* xout = xrow_out(p, m0);
#pragma unroll
    for (int j = 0; j < 2; ++j) {
      const int col = n0 + wn * 64 + j * 32 + r;
      const float gate = gv[col];
#pragma unroll
      for (int reg = 0; reg < 16; ++reg) {
        const size_t off = (size_t)(wm * 32 + crow(reg, h)) * D + col;
        xout[off] = xin[off] + gate * acc[0][j][reg];
      }
    }
  }
}

DI void phase_final(const Params& p) {
  const int tid = threadIdx.x, lane = tid & 63, wid = tid >> 6;
  for (int row = blockIdx.x * 8 + wid; row < NBATCH * L; row += gridDim.x * 8) {
    float* src = p.out + (size_t)row * D;
    float4 xv[4]; float ss = 0.f;
#pragma unroll
    for (int i = 0; i < 4; ++i) { xv[i] = *(const float4*)(src + (i * 64 + lane) * 4); ss += xv[i].x * xv[i].x + xv[i].y * xv[i].y + xv[i].z * xv[i].z + xv[i].w * xv[i].w; }
    ss = wave_sum(ss);
    const float rs = rsqrtf(ss * (1.f / 1024.f) + EPS);
#pragma unroll
    for (int i = 0; i < 4; ++i) {
      const int col = (i * 64 + lane) * 4;
      const float4 fw = *(const float4*)(pk(p, PK_FN) + col);
      *(float4*)(src + col) = make_float4(xv[i].x * rs * fw.x, xv[i].y * rs * fw.y, xv[i].z * rs * fw.z, xv[i].w * rs * fw.w);
    }
  }
}

DI void run_phase(const Params& p, int ph, char* smem, int dry = 0) {
  const int bid = blockIdx.x, nb = gridDim.x;
  if (ph == 0) { phase0(p, smem); return; }
  if (ph == 17) { phase_final(p); return; }
  const int l = (ph - 1) >> 3, s = (ph - 1) & 7;
  switch (s) {
    case 0: phase_norm(p, l); break;
    case 1: phase_proj(p, l, smem); break;
    case 2: {
      attn_prep(p, l, dry);
      if (l == 0) for (int c = bid; c < 512; c += nb) hyena_ctx_task(p, l, c, smem, dry);
      for (int c = bid; c < 512; c += nb) hyena_latent_task(p, l, c, smem, dry);
    } break;
    case 3: for (int t = bid; t < 16 * NCK; t += nb) gla_g1_task(p, l, t / NCK, t % NCK, smem); break;
    case 4: gla_g2(p, dry); break;
    case 5: {
      for (int it = bid; it < 1024; it += nb) { const int b = it >> 9, g = (it >> 8) & 1, qb = it & 255; attn_item(p, l, b, g, LC + qb * 64, NCK, smem, dry); }
      if (l == 0) for (int it = bid; it < 16; it += nb) { const int b = it >> 3, g = (it >> 2) & 1, qb = it & 3; attn_item(p, l, b, g, qb * 64, 4, smem, dry); }
      const int c0 = (l == 0) ? 0 : 4, per = NCK - c0;
      for (int t = bid; t < 8 * per; t += nb) { const int bh = t / per, ci = c0 + t % per; gla_g3_task(p, l, bh >> 2, bh & 3, ci, smem, dry); }
    } break;
    case 6: phase_merge(p, l, smem); break;
    case 7: phase_out(p, l, smem); break;
  }
}

#if MULTI_LAUNCH
template <int PH> __global__ void __launch_bounds__(NT) phase_kernel(Params p) {
  extern __shared__ __attribute__((aligned(16))) char smem[];
  run_phase(p, PH, smem);
}
template <int PH> static void launch_phase(const Params& p, int grid, hipStream_t stream) {
  static bool attr = false;
  if (!attr) { (void)hipFuncSetAttribute((const void*)phase_kernel<PH>, hipFuncAttributeMaxDynamicSharedMemorySize, LDS_BYTES); attr = true; }
  hipLaunchKernelGGL(phase_kernel<PH>, dim3(grid), dim3(NT), LDS_BYTES, stream, p);
}
#else
#ifndef PROBE_DUP
#define PROBE_DUP -1
#endif
#ifndef PROBE_DUP2
#define PROBE_DUP2 -1
#endif
#ifndef PROBE_DUP3
#define PROBE_DUP3 -1
#endif
__global__ void __launch_bounds__(NT) fwd_kernel(Params p) {
  extern __shared__ __attribute__((aligned(16))) char smem[];
  cg::grid_group grid = cg::this_grid();
#if PROBE_DUP >= 0
#define PHS(n) if ((n) == PROBE_DUP || (n) == PROBE_DUP2 || (n) == PROBE_DUP3) { run_phase(p, n, smem, p.phase_lo == 0 ? 1 : 0); grid.sync(); } run_phase(p, n, smem); grid.sync();
#else
#define PHS(n) run_phase(p, n, smem); grid.sync();
#endif
  PHS(0) PHS(1) PHS(2) PHS(3) PHS(4) PHS(5) PHS(6) PHS(7) PHS(8)
  PHS(9) PHS(10) PHS(11) PHS(12) PHS(13) PHS(14) PHS(15) PHS(16)
  run_phase(p, 17, smem);
}
#endif

extern "C" void kernel_launch(void* const* d_in, const int* in_sizes, int n_in, void* d_out, int out_size, void* d_ws, size_t ws_size,
                              hipStream_t stream) {
  static int grid = 0;
  if (grid == 0) {
    if (n_in != 29 || ws_size < WS_END) { fprintf(stderr, "kernel_launch: need 29 inputs and %zu B of workspace, got %d / %zu\n", (size_t)WS_END, n_in, ws_size); grid = -1; return; }
#if MULTI_LAUNCH
    grid = 256;
#else
    int dev = 0, cus = 0, per_cu = 0;
    (void)hipGetDevice(&dev);
    (void)hipDeviceGetAttribute(&cus, hipDeviceAttributeMultiprocessorCount, dev);
    if (hipFuncSetAttribute((const void*)fwd_kernel, hipFuncAttributeMaxDynamicSharedMemorySize, LDS_BYTES) != hipSuccess) { fprintf(stderr, "kernel_launch: hipFuncSetAttribute failed\n"); grid = -1; return; }
    (void)hipOccupancyMaxActiveBlocksPerMultiprocessor(&per_cu, (const void*)fwd_kernel, NT, LDS_BYTES);
    if (per_cu < 1) { fprintf(stderr, "kernel_launch: occupancy query returned %d\n", per_cu); per_cu = 1; }
    (void)hipGetLastError();
    grid = cus * per_cu;
    if (grid > 256) grid = 256;
#endif
  }
  if (grid < 0) return;
  Params p{};
  const float** pp = (const float**)&p;
  for (int i = 0; i < 29; ++i) pp[i] = (const float*)d_in[i];
  p.out = (float*)d_out; p.ws = (char*)d_ws;
  p.phase_lo = 0; p.phase_hi = 18;
#if MULTI_LAUNCH
  launch_phase<0>(p, grid, stream); launch_phase<1>(p, grid, stream); launch_phase<2>(p, grid, stream); launch_phase<3>(p, grid, stream);
  launch_phase<4>(p, grid, stream); launch_phase<5>(p, grid, stream); launch_phase<6>(p, grid, stream); launch_phase<7>(p, grid, stream);
  launch_phase<8>(p, grid, stream); launch_phase<9>(p, grid, stream); launch_phase<10>(p, grid, stream); launch_phase<11>(p, grid, stream);
  launch_phase<12>(p, grid, stream); launch_phase<13>(p, grid, stream); launch_phase<14>(p, grid, stream); launch_phase<15>(p, grid, stream);
  launch_phase<16>(p, grid, stream); launch_phase<17>(p, grid, stream);
#else
  void* args[] = {&p};
  hipError_t e = hipLaunchCooperativeKernel((const void*)fwd_kernel, dim3(grid), dim3(NT), args, LDS_BYTES, stream);
  if (e != hipSuccess) fprintf(stderr, "kernel_launch: cooperative launch failed: %s (grid %d)\n", hipGetErrorString(e), grid);
#endif
}
```

```cpp
#include <hip/hip_runtime.h>
#include <hip/hip_cooperative_groups.h>
#include <cstdio>
namespace cg = cooperative_groups;

typedef unsigned short u16;
typedef __attribute__((ext_vector_type(8))) short bf16x8;
typedef __attribute__((ext_vector_type(16))) float f32x16;
typedef __attribute__((ext_vector_type(4))) unsigned u32x4;
typedef __attribute__((ext_vector_type(2))) unsigned u32x2;
#define DI __device__ __forceinline__
#define MFMA(a, b, c) __builtin_amdgcn_mfma_f32_32x32x16_bf16((a), (b), (c), 0, 0, 0)

#ifndef MULTI_LAUNCH
#define MULTI_LAUNCH 0
#endif

constexpr int D = 1024, NBATCH = 2, L = 16384, LC = 256, TB = L + LC, R = NBATCH * TB;
constexpr int NIN = 7968;
constexpr int NP = 2208;
constexpr int NCH = 2688;
constexpr int PC_GQ = 0, PC_GK = 256, PC_GZ = 512, PC_AF = 1024, PC_AQ = 1056, PC_AK = 1568, PC_AZ = 1696;
constexpr int CH_YU = 0, CH_YZ = 1536, CH_GV = 2048, CH_AV = 2560;
constexpr int NCK = 260;
constexpr float EPS = 1e-6f;
constexpr int NT = 512;
constexpr int LDT = 72;

constexpr size_t OFF_P = 0;
constexpr size_t OFF_CT = OFF_P + (size_t)R * NP * 2;
constexpr size_t OFF_H = OFF_CT + (size_t)NCH * 2 * TB * 2;
constexpr size_t OFF_FS = OFF_H + (size_t)R * 1024 * 2;
constexpr size_t OFF_WT = OFF_FS + (size_t)256 * 262144;
constexpr size_t WT_IN = (size_t)NIN * 1024 * 2, WT_BR = (size_t)1024 * 512 * 2, WT_OUT = (size_t)1024 * 1024 * 2;
constexpr size_t WT_LAYER = WT_IN + 3 * WT_BR + WT_OUT;
constexpr size_t OFF_H2T = OFF_WT + 2 * WT_LAYER;
constexpr size_t OFF_H2C = OFF_H2T + (size_t)2 * 64 * L * 4;
constexpr size_t OFF_MOD = OFF_H2C + (size_t)2 * 256 * 64 * 4;
constexpr size_t OFF_CTX1 = OFF_MOD + (size_t)2 * 3 * 3072 * 4;
constexpr size_t OFF_GD = OFF_CTX1 + (size_t)512 * 1024 * 4;
constexpr size_t OFF_PK = OFF_GD + (size_t)16 * NCK * 64 * 4;
constexpr int PK_WAF = 0, PK_BAF = 8192, PK_WAB = 8704, PK_BAB = 16896, PK_GN = 17408, PK_QN = 17664, PK_KN = 17792, PK_CW = 17920,
              PK_CB = 27136, PK_SK = 30208, PK_FN = 32256, PK_F3 = 33280, PK_END = 33280 + 262144;
constexpr size_t WS_END = OFF_PK + (size_t)PK_END * 4;
constexpr size_t OFF_GS = OFF_CT;
constexpr size_t OFF_Y = OFF_CT;
static_assert((size_t)16 * NCK * 8192 * 2 <= (size_t)1536 * 2 * TB * 2, "alias");
static_assert((size_t)R * 1024 * 2 <= (size_t)1536 * 2 * TB * 2, "alias");

constexpr int LDS_BYTES = 131072 + 512;

struct Params {
  const float *x, *c, *ctx, *c_ctx, *w_ada, *b_ada, *w_in, *wa_f, *ba_f, *wa_b, *ba_b, *gla_norm, *qnorm, *knorm,
      *conv_w, *conv_b, *f1_w, *f1_b, *f1_freq, *f2_w, *f2_b, *f2_freq, *f3_w, *skip, *w_g, *w_a, *w_h, *w_o, *final_norm;
  float* out;
  char* ws;
  long long phase_lo, phase_hi;
};

typedef __attribute__((ext_vector_type(2))) float f32x2v;
typedef __attribute__((ext_vector_type(2))) __bf16 bf16x2v;
DI u16 f2bf(float x) { return __builtin_bit_cast(u16, (__bf16)x); }
DI float bf2f(u16 v) { return __uint_as_float(((unsigned)v) << 16); }
DI unsigned pack2(float a, float b) { f32x2v v = {a, b}; return __builtin_bit_cast(unsigned, __builtin_convertvector(v, bf16x2v)); }
DI float bflo(unsigned u) { return __uint_as_float(u << 16); }
DI float bfhi(unsigned u) { return __uint_as_float(u & 0xffff0000u); }
DI float silu_f(float x) { return x / (1.f + __expf(-x)); }
DI float wave_sum(float v) {
#pragma unroll
  for (int o = 32; o >= 1; o >>= 1) v += __shfl_xor(v, o);
  return v;
}
DI int crow(int reg, int h) { return (reg & 3) + 8 * (reg >> 2) + 4 * h; }
DI f32x16 zero16() { f32x16 z; for (int i = 0; i < 16; ++i) z[i] = 0.f; return z; }
DI bf16x8 pack8(const f32x16& x, int s) {
  u32x4 u;
  u.x = pack2(x[8 * s + 0], x[8 * s + 1]); u.y = pack2(x[8 * s + 2], x[8 * s + 3]);
  u.z = pack2(x[8 * s + 4], x[8 * s + 5]); u.w = pack2(x[8 * s + 6], x[8 * s + 7]);
  return __builtin_bit_cast(bf16x8, u);
}
DI bf16x8 ld2x64(const u16* p0, const u16* p1) {
  u32x2 a = *(const u32x2*)p0, b = *(const u32x2*)p1;
  u32x4 u; u.x = a.x; u.y = a.y; u.z = b.x; u.w = b.y;
  return __builtin_bit_cast(bf16x8, u);
}
DI float2 cmul(float2 a, float2 b) { return make_float2(a.x * b.x - a.y * b.y, a.x * b.y + a.y * b.x); }
DI float2 cadd(float2 a, float2 b) { return make_float2(a.x + b.x, a.y + b.y); }
DI float2 csub(float2 a, float2 b) { return make_float2(a.x - b.x, a.y - b.y); }

DI const float* xrow_in(const Params& p, int layer, int row) {
  int b = row / TB, tk = row - b * TB;
  if (tk < LC) return (layer == 0 ? p.ctx : (const float*)(p.ws + OFF_CTX1)) + (size_t)(b * LC + tk) * D;
  return (layer == 0 ? p.x : (const float*)p.out) + (size_t)(b * L + tk - LC) * D;
}
DI float* xrow_out(const Params& p, int row) {
  int b = row / TB, tk = row - b * TB;
  if (tk < LC) return (float*)(p.ws + OFF_CTX1) + (size_t)(b * LC + tk) * D;
  return p.out + (size_t)(b * L + tk - LC) * D;
}
DI const float* pk(const Params& p, int off) { return (const float*)(p.ws + OFF_PK) + off; }
DI int modvec_of(int row) { int b = row / TB, tk = row - b * TB; return tk < LC ? 2 : b; }

struct ALoadN {
  const u16* A; int lda;
  template <int BM> DI void fetch(u32x4 (&r)[BM / 64], int k0, int tid) const {
#pragma unroll
    for (int i = 0; i < BM / 64; ++i) { int q = tid + NT * i; r[i] = *(const u32x4*)(A + (size_t)(q >> 3) * lda + k0 + (q & 7) * 8); }
  }
  template <int BM> DI void commit(const u32x4 (&r)[BM / 64], u16* As, int tid) const {
#pragma unroll
    for (int i = 0; i < BM / 64; ++i) { int q = tid + NT * i; *(u32x4*)(As + (q >> 3) * LDT + (q & 7) * 8) = r[i]; }
  }
};
struct ALoadT {
  const u16* A; size_t chs;
  template <int BM> DI void fetch(u32x4 (&r)[BM / 64], int k0, int tid) const {
#pragma unroll
    for (int i = 0; i < 2; ++i) { int q = tid + NT * i; r[i] = *(const u32x4*)(A + (size_t)(k0 + (q >> 4)) * chs + (q & 15) * 8); }
  }
  template <int BM> DI void commit(const u32x4 (&r)[BM / 64], u16* As, int tid) const {
#pragma unroll
    for (int i = 0; i < 2; ++i) {
      int q = tid + NT * i; int ch = q >> 4, t0 = (q & 15) * 8;
      unsigned w[4] = {r[i].x, r[i].y, r[i].z, r[i].w};
#pragma unroll
      for (int e = 0; e < 4; ++e) { As[(t0 + 2 * e) * LDT + ch] = (u16)(w[e] & 0xffffu); As[(t0 + 2 * e + 1) * LDT + ch] = (u16)(w[e] >> 16); }
    }
  }
};

template <int BM, int KSU>
DI void gemm_compute(const u16* Ac, const u16* Bc, int wm, int wn, int r, int h, f32x16 (&acc)[BM / 128][2]) {
#pragma unroll KSU
  for (int ks = 0; ks < 4; ++ks) {
    bf16x8 a[BM / 128], b[2];
#pragma unroll
    for (int i = 0; i < BM / 128; ++i) a[i] = *(const bf16x8*)(Ac + (wm * (BM / 4) + i * 32 + r) * LDT + ks * 16 + h * 8);
#pragma unroll
    for (int j = 0; j < 2; ++j) b[j] = *(const bf16x8*)(Bc + (wn * 64 + j * 32 + r) * LDT + ks * 16 + h * 8);
#pragma unroll
    for (int i = 0; i < BM / 128; ++i)
#pragma unroll
      for (int j = 0; j < 2; ++j) acc[i][j] = MFMA(a[i], b[j], acc[i][j]);
  }
}
DI void fetch_b(u32x4 (&rb)[2], const u16* Bt, int ldb, int k0, int tid) {
#pragma unroll
  for (int i = 0; i < 2; ++i) { int q = tid + NT * i; rb[i] = *(const u32x4*)(Bt + (size_t)(q >> 3) * ldb + k0 + (q & 7) * 8); }
}
DI void commit_b(const u32x4 (&rb)[2], u16* Bs, int tid) {
#pragma unroll
  for (int i = 0; i < 2; ++i) { int q = tid + NT * i; *(u32x4*)(Bs + (q >> 3) * LDT + (q & 7) * 8) = rb[i]; }
}
template <int BM, class AL, int KSU = 4, int K = 1024>
DI void gemm_tile(const AL& al, const u16* __restrict__ Bt, int ldb, char* smem, f32x16 (&acc)[BM / 128][2]) {
  u16* As0 = (u16*)smem;
  u16* As1 = As0 + BM * LDT;
  u16* Bs0 = As0 + 2 * BM * LDT;
  u16* Bs1 = Bs0 + 128 * LDT;
  const int tid = threadIdx.x, lane = tid & 63, wid = tid >> 6, r = lane & 31, h = lane >> 5;
  const int wm = wid & 3, wn = wid >> 2;
  u32x4 ra0[BM / 64], rb0[2], ra1[BM / 64], rb1[2];
  constexpr int KT = K >> 6;
  al.template fetch<BM>(ra0, 0, tid); fetch_b(rb0, Bt, ldb, 0, tid); asm volatile("" ::: "memory");
  al.template fetch<BM>(ra1, 64, tid); fetch_b(rb1, Bt, ldb, 64, tid); asm volatile("" ::: "memory");
  __syncthreads();
  al.template commit<BM>(ra0, As0, tid); commit_b(rb0, Bs0, tid);
  __syncthreads();
  if (KT > 2) { al.template fetch<BM>(ra0, 128, tid); fetch_b(rb0, Bt, ldb, 128, tid); asm volatile("" ::: "memory"); }
#pragma unroll
  for (int kt = 0; kt < KT; kt += 2) {
    al.template commit<BM>(ra1, As1, tid); commit_b(rb1, Bs1, tid);
    asm volatile("" ::: "memory");
    if (kt + 3 < KT) { al.template fetch<BM>(ra1, (kt + 3) * 64, tid); fetch_b(rb1, Bt, ldb, (kt + 3) * 64, tid); asm volatile("" ::: "memory"); }
    gemm_compute<BM, KSU>(As0, Bs0, wm, wn, r, h, acc);
    __syncthreads();
    if (kt + 2 < KT) {
      al.template commit<BM>(ra0, As0, tid); commit_b(rb0, Bs0, tid);
      asm volatile("" ::: "memory");
    }
    if (kt + 4 < KT) { al.template fetch<BM>(ra0, (kt + 4) * 64, tid); fetch_b(rb0, Bt, ldb, (kt + 4) * 64, tid); asm volatile("" ::: "memory"); }
    gemm_compute<BM, KSU>(As1, Bs1, wm, wn, r, h, acc);
    __syncthreads();
  }
}

DI void phase0(const Params& p, char* smem) {
  const int tid = threadIdx.x, lane = tid & 63, wid = tid >> 6, bid = blockIdx.x, nb = gridDim.x;
  float* sm = (float*)smem;
  {
    float* PKW = (float*)(p.ws + OFF_PK);
    const int gt = bid * NT + tid, gn = nb * NT;
#define PKCP(src, off, cnt) for (int i = gt; i < (cnt); i += gn) PKW[(off) + i] = (src)[i];
    PKCP(p.wa_f, PK_WAF, 8192) PKCP(p.ba_f, PK_BAF, 512) PKCP(p.wa_b, PK_WAB, 8192) PKCP(p.ba_b, PK_BAB, 512)
    PKCP(p.gla_norm, PK_GN, 256) PKCP(p.qnorm, PK_QN, 128) PKCP(p.knorm, PK_KN, 128) PKCP(p.conv_w, PK_CW, 9216)
    PKCP(p.conv_b, PK_CB, 3072) PKCP(p.skip, PK_SK, 2048) PKCP(p.final_norm, PK_FN, 1024) PKCP(p.f3_w, PK_F3, 262144)
#undef PKCP
  }
  float* mod = (float*)(p.ws + OFF_MOD);
  for (int task = bid; task < 96; task += nb) {
    const int l = task / 48, cb = task % 48, col = cb * 64 + lane;
    const float* W = p.w_ada + (size_t)l * 1024 * 3072;
    float a0 = 0.f, a1 = 0.f, a2 = 0.f;
#pragma unroll 8
    for (int k = wid * 128; k < wid * 128 + 128; ++k) {
      float wv = W[(size_t)k * 3072 + col];
      a0 += silu_f(p.c[k]) * wv; a1 += silu_f(p.c[1024 + k]) * wv; a2 += silu_f(p.c_ctx[k]) * wv;
    }
    __syncthreads();
    sm[(wid * 3 + 0) * 64 + lane] = a0; sm[(wid * 3 + 1) * 64 + lane] = a1; sm[(wid * 3 + 2) * 64 + lane] = a2;
    __syncthreads();
    if (tid < 192) {
      int v = tid >> 6; float s = p.b_ada[l * 3072 + col];
      for (int w = 0; w < 8; ++w) s += sm[(w * 3 + v) * 64 + lane];
      mod[(l * 3 + v) * 3072 + col] = s;
    }
    __syncthreads();
  }
  for (int it = bid; it < (2 * TB) / 8; it += nb) {
    const int gr = it * 8 + wid, l = gr / TB, rr = gr - l * TB;
    const bool lat = rr < L; const int t = lat ? rr : rr - L; const int Lq = lat ? L : LC;
    float* em = sm + wid * 104; float* h1 = em + 40;
    __syncthreads();
    if (lane < 33) {
      float v;
      if (lane == 0) v = (float)t / (float)(Lq - 1);
      else {
        int bi = (lane - 1) & 15; float fr = 1e-4f + (float)bi * ((15.f - 1e-4f) / 15.f);
        float w = 6.283185307179586f * (float)t / (float)Lq;
        v = (lane <= 16) ? cosf(fr * w) : -sinf(fr * w);
      }
      em[lane] = v;
    }
    __syncthreads();
    {
      float a = p.f1_b[l * 64 + lane];
      for (int e = 0; e < 33; ++e) a += em[e] * p.f1_w[(l * 33 + e) * 64 + lane];
      h1[lane] = sinf(p.f1_freq[l * 64 + lane] * a);
    }
    __syncthreads();
    {
      float a = p.f2_b[l * 64 + lane];
      for (int i = 0; i < 64; ++i) a += h1[i] * p.f2_w[(l * 64 + i) * 64 + lane];
      float v = sinf(p.f2_freq[l * 64 + lane] * a);
      if (lat) ((float*)(p.ws + OFF_H2T))[((size_t)l * 64 + lane) * L + t] = v;
      else ((float*)(p.ws + OFF_H2C))[((size_t)l * 256 + t) * 64 + lane] = v;
    }
  }
  __syncthreads();
  {
    constexpr int T_IN = 16 * 249, T_BR = 8 * 32, T_OUT = 16 * 32, T_LAYER = T_IN + 3 * T_BR + T_OUT;
    float* tile = sm;
    for (int task = bid; task < 2 * T_LAYER; task += nb) {
      const int l = task / T_LAYER; int tt = task - l * T_LAYER;
      const float* src; u16* dst; int K, N, kt, ntile;
      char* wt = p.ws + OFF_WT + (size_t)l * WT_LAYER;
      if (tt < T_IN) { src = p.w_in + (size_t)l * 1024 * NIN; dst = (u16*)wt; K = 1024; N = NIN; kt = tt / 249; ntile = tt % 249; }
      else if (tt < T_IN + 3 * T_BR) {
        tt -= T_IN; int br = tt / T_BR; tt -= br * T_BR;
        src = (br == 0 ? p.w_g : (br == 1 ? p.w_a : p.w_h)) + (size_t)l * 512 * 1024; dst = (u16*)(wt + WT_IN + br * WT_BR);
        K = 512; N = 1024; kt = tt / 32; ntile = tt % 32;
      } else { tt -= T_IN + 3 * T_BR; src = p.w_o + (size_t)l * 1024 * 1024; dst = (u16*)(wt + WT_IN + 3 * WT_BR); K = 1024; N = 1024; kt = tt / 32; ntile = tt % 32; }
      const int k0 = kt * 64, n0 = ntile * 32;
#pragma unroll
      for (int i = 0; i < 4; ++i) { int kk = (tid >> 5) + 16 * i, nn = tid & 31; tile[kk * 33 + nn] = src[(size_t)(k0 + kk) * N + n0 + nn]; }
      __syncthreads();
#pragma unroll
      for (int i = 0; i < 4; ++i) { int nn = (tid >> 6) + 8 * i, kk = tid & 63; dst[(size_t)(n0 + nn) * K + k0 + kk] = f2bf(tile[kk * 33 + nn]); }
      __syncthreads();
    }
  }
}

DI void phase_norm(const Params& p, int l) {
  const int tid = threadIdx.x, lane = tid & 63, wid = tid >> 6;
  const float* mod = (const float*)(p.ws + OFF_MOD);
  u16* H = (u16*)(p.ws + OFF_H);
  for (int row = blockIdx.x * 8 + wid; row < R; row += gridDim.x * 8) {
    const float* src = xrow_in(p, l, row);
    const float* mv = mod + (l * 3 + modvec_of(row)) * 3072;
    float4 xv[4]; float ss = 0.f;
#pragma unroll
    for (int i = 0; i < 4; ++i) { xv[i] = *(const float4*)(src + (i * 64 + lane) * 4); ss += xv[i].x * xv[i].x + xv[i].y * xv[i].y + xv[i].z * xv[i].z + xv[i].w * xv[i].w; }
    ss = wave_sum(ss);
    const float rs = rsqrtf(ss * (1.f / 1024.f) + EPS);
#pragma unroll
    for (int i = 0; i < 4; ++i) {
      const int col = (i * 64 + lane) * 4;
      float4 sh = *(const float4*)(mv + col), sc = *(const float4*)(mv + 1024 + col);
      u32x2 o;
      o.x = pack2(xv[i].x * rs * (1.f + sc.x) + sh.x, xv[i].y * rs * (1.f + sc.y) + sh.y);
      o.y = pack2(xv[i].z * rs * (1.f + sc.z) + sh.z, xv[i].w * rs * (1.f + sc.w) + sh.w);
      *(u32x2*)(H + (size_t)row * 1024 + col) = o;
    }
  }
}

DI void phase_proj(const Params& p, int l, char* smem) {
  const int tid = threadIdx.x, lane = tid & 63, wid = tid >> 6, r = lane & 31, h = lane >> 5, wm = wid & 3, wn = wid >> 2;
  const u16* H = (const u16*)(p.ws + OFF_H);
  const u16* WT = (const u16*)(p.ws + OFF_WT + (size_t)l * WT_LAYER);
  u16* P = (u16*)(p.ws + OFF_P);
  u16* CT = (u16*)(p.ws + OFF_CT);
  const int xcd = blockIdx.x & 7, nloc = gridDim.x >> 3;
  for (int q = blockIdx.x >> 3; q < 5 * 156; q += nloc) {
    const int g = q / 156, rem = q - g * 156, nt = rem >> 2, mt = (g * 4 + (rem & 3)) * 8 + xcd;
    if (mt >= 130) continue;
    const int m0 = mt * 256, n0 = nt * 128;
    f32x16 acc[2][2];
#pragma unroll
    for (int i = 0; i < 2; ++i) for (int j = 0; j < 2; ++j) acc[i][j] = zero16();
    ALoadN al{H + (size_t)m0 * 1024, 1024};
    gemm_tile<256, ALoadN, 4, 1024>(al, WT + (size_t)n0 * 1024, 1024, smem, acc);
    const int b = m0 / TB, tk0 = m0 - b * TB;
#pragma unroll
    for (int j = 0; j < 2; ++j) {
      const int cb = n0 + wn * 64 + j * 32;
      if (cb >= 4896) continue;
      bool chan; int cm;
      if (cb < 512) { chan = false; cm = cb; }
      else if (cb < 1024) { chan = true; cm = CH_GV + cb - 512; }
      else if (cb < 2208) { chan = false; cm = cb - 512; }
      else if (cb < 2336) { chan = true; cm = CH_AV + cb - 2208; }
      else if (cb < 2848) { chan = false; cm = cb - 640; }
      else { chan = true; cm = cb - 2848; }
#pragma unroll
      for (int i = 0; i < 2; ++i) {
        const int rbase = wm * 64 + i * 32;
        if (!chan) {
#pragma unroll
          for (int reg = 0; reg < 16; ++reg) P[(size_t)(m0 + rbase + crow(reg, h)) * NP + cm + r] = f2bf(acc[i][j][reg]);
        } else {
#pragma unroll
          for (int g = 0; g < 4; ++g) {
            u32x2 o; o.x = pack2(acc[i][j][4 * g], acc[i][j][4 * g + 1]); o.y = pack2(acc[i][j][4 * g + 2], acc[i][j][4 * g + 3]);
            *(u32x2*)(CT + ((size_t)(cm + r) * 2 + b) * TB + tk0 + rbase + 8 * g + 4 * h) = o;
          }
        }
      }
    }
  }
}

DI void attn_prep(const Params& p, int l, int dry) {
  const int tid = threadIdx.x, lane = tid & 63, wid = tid >> 6;
  u16* P = (u16*)(p.ws + OFF_P);
  const float gq = pk(p, PK_QN)[l * 64 + lane], gk = pk(p, PK_KN)[l * 64 + lane];
  for (int row = blockIdx.x * 8 + wid; row < R; row += gridDim.x * 8) {
    u16* Pr = P + (size_t)row * NP;
    const int b = row / TB, tk = row - b * TB;
    float cs = 1.f, sn = 0.f;
    if (tk >= LC) {
      const int t = tk - LC, pi = lane >> 1;
      const float pos = (pi < 16) ? (float)(t >> 6) : (float)(t & 63);
      const float inv = powf(10000.f, -(float)(2 * (pi & 15)) / 32.f);
      sincosf(pos * inv, &sn, &cs);
    }
#pragma unroll
    for (int hd = 0; hd < 10; ++hd) {
      const int col = (hd < 8) ? PC_AQ + hd * 64 + lane : PC_AK + (hd - 8) * 64 + lane;
      float v = bf2f(Pr[col]);
      const float ss = wave_sum(v * v);
      v = v * rsqrtf(ss * (1.f / 64.f) + EPS) * (hd < 8 ? gq : gk);
      const float pv = __shfl_xor(v, 1);
      float o = (lane & 1) ? (pv * sn + v * cs) : (v * cs - pv * sn);
      if (hd < 8) o *= 0.125f * 1.4426950408889634f;
      if (!dry) Pr[col] = f2bf(o);
    }
  }
}

DI void fft_fwd(float2* X, int tid) {
#pragma unroll 1
  for (int h2 = 4096; h2 >= 1; h2 >>= 2) {
    const float inv4 = 0.25f / (float)h2;
#pragma unroll 2
    for (int i = 0; i < 8; ++i) {
      const int g = tid + NT * i, jp = g & (h2 - 1), base = ((g - jp) << 2) + jp;
      float2 e0 = X[base], e1 = X[base + h2], e2 = X[base + 2 * h2], e3 = X[base + 3 * h2];
      const float fr = (float)jp * inv4;
      const float2 T1 = make_float2(__builtin_amdgcn_cosf(fr), -__builtin_amdgcn_sinf(fr));
      const float2 T2 = cmul(T1, T1);
      float2 a0 = cadd(e0, e2), a2 = cmul(csub(e0, e2), T1);
      float2 a1 = cadd(e1, e3), d13 = cmul(csub(e1, e3), T1);
      float2 a3 = make_float2(d13.y, -d13.x);
      X[base] = cadd(a0, a1); X[base + h2] = cmul(csub(a0, a1), T2);
      X[base + 2 * h2] = cadd(a2, a3); X[base + 3 * h2] = cmul(csub(a2, a3), T2);
    }
    __syncthreads();
  }
}
DI void fft_inv(float2* X, int tid) {
#pragma unroll 1
  for (int h1 = 1; h1 <= 4096; h1 <<= 2) {
    const float inv4 = 0.25f / (float)h1;
#pragma unroll 2
    for (int i = 0; i < 8; ++i) {
      const int g = tid + NT * i, jp = g & (h1 - 1), base = ((g - jp) << 2) + jp;
      float2 e0 = X[base], e1 = X[base + h1], e2 = X[base + 2 * h1], e3 = X[base + 3 * h1];
      const float fr = (float)jp * inv4;
      const float2 V = make_float2(__builtin_amdgcn_cosf(fr), __builtin_amdgcn_sinf(fr));
      const float2 Wc = cmul(V, V);
      float2 t1 = cmul(e1, Wc), t3 = cmul(e3, Wc);
      float2 a0 = cadd(e0, t1), a1 = csub(e0, t1), a2 = cadd(e2, t3), a3 = csub(e2, t3);
      float2 u2 = cmul(a2, V), u3 = cmul(a3, V);
      u3 = make_float2(-u3.y, u3.x);
      X[base] = cadd(a0, u2); X[base + 2 * h1] = csub(a0, u2);
      X[base + h1] = cadd(a1, u3); X[base + 3 * h1] = csub(a1, u3);
    }
    __syncthreads();
  }
}
DI float sconv_at(const u16* src, int t, int len, float w0, float w1, float w2, float bb) {
  float ym = t > 0 ? bf2f(src[t - 1]) : 0.f, y0 = bf2f(src[t]), yp = t < len - 1 ? bf2f(src[t + 1]) : 0.f;
  return bb + w0 * ym + w1 * y0 + w2 * yp;
}
DI float hy_delta(int col) {
  const float A0 = -4.605170185988091f / 0.3f, A1 = -4.605170185988091f / 1.5f;
  return fabsf(A0 + (A1 - A0) * ((float)col / 2047.f));
}

DI void hyena_latent_task(const Params& p, int l, int c, char* smem, int dry) {
  float2* X = (float2*)smem;
  float* red = (float*)(smem + 131072);
  const int tid = threadIdx.x, lane = tid & 63, wid = tid >> 6;
  u16* CT = (u16*)(p.ws + OFF_CT);
  float2* FE = (float2*)(p.ws + OFF_FS + (size_t)blockIdx.x * 262144);
  float2* FO = FE + 16384;
  const float* h2T = (const float*)(p.ws + OFF_H2T) + (size_t)l * 64 * L;
  const float* f3w = pk(p, PK_F3) + (size_t)l * 64 * 2048;
  const float* cw = pk(p, PK_CW) + (size_t)l * 3 * 1536;
  const float* cbv = pk(p, PK_CB) + (size_t)l * 1536;
  const float vw0 = cw[c], vw1 = cw[1536 + c], vw2 = cw[3072 + c], vbb = cbv[c];
  const u16* v0 = CT + ((size_t)(CH_YU + c) * 2 + 0) * TB + LC;
  const u16* v1 = CT + ((size_t)(CH_YU + c) * 2 + 1) * TB + LC;
  u16* z10 = CT + ((size_t)(CH_YU + 512 + c) * 2 + 0) * TB + LC;
  u16* z11 = CT + ((size_t)(CH_YU + 512 + c) * 2 + 1) * TB + LC;
#pragma unroll 1
  for (int o = 0; o < 2; ++o) {
    const int cf = o * 1024 + c, cbk = cf + 512;
    float sf = 0.f, sb = 0.f;
    __syncthreads();
#ifdef PROBE_FFT
    fft_fwd(X, tid); fft_inv(X, tid);
#endif
#pragma unroll 1
    for (int half = 0; half < 2; ++half) {
      float af[16], ab[16];
#pragma unroll
      for (int i = 0; i < 16; ++i) { af[i] = 0.f; ab[i] = 0.f; }
#pragma unroll 1
      for (int j = 0; j < 64; ++j) {
        const float wf = f3w[j * 2048 + cf], wb = f3w[j * 2048 + cbk];
        const float* hrow = h2T + (size_t)j * L + tid + half * 16 * NT;
#pragma unroll
        for (int i = 0; i < 16; ++i) { const float hv = hrow[NT * i]; af[i] += hv * wf; ab[i] += hv * wb; }
      }
      const float df = hy_delta(cf), db = hy_delta(cbk);
#pragma unroll
      for (int i = 0; i < 16; ++i) {
        const int t = tid + NT * (i + half * 16); const float tt = (float)t / (float)(L - 1);
        const float vf = af[i] * (__expf(-tt * df) + 0.05f), vb = ab[i] * (__expf(-tt * db) + 0.05f);
        sf += fabsf(vf); sb += fabsf(vb);
        X[t].x = vf;
        if (t >= 1) X[L - t].y = vb; else X[0].y = 0.f;
      }
    }
    sf = wave_sum(sf); sb = wave_sum(sb);
    if (lane == 0) { red[wid] = sf; red[8 + wid] = sb; }
    __syncthreads();
    float nf = 0.f, nbk = 0.f;
#pragma unroll
    for (int w = 0; w < 8; ++w) { nf += red[w]; nbk += red[8 + w]; }
    const float inv_f = 1.f / nf, inv_b = 1.f / nbk;
#pragma unroll 8
    for (int i = 0; i < 32; ++i) { const int n = tid + NT * i; const float2 s = X[n]; FO[n] = s; X[n] = make_float2(s.x * inv_f + s.y * inv_b, 0.f); }
    __syncthreads();
    fft_fwd(X, tid);
#pragma unroll 8
    for (int i = 0; i < 32; ++i) { const int n = tid + NT * i; FE[n] = X[n]; }
    __syncthreads();
#pragma unroll 8
    for (int i = 0; i < 32; ++i) {
      const int n = tid + NT * i; const float2 s = FO[n]; const float dd = s.x * inv_f - s.y * inv_b; const float fr = (float)n * (1.f / 32768.f);
      X[n] = make_float2(dd * __builtin_amdgcn_cosf(fr), -dd * __builtin_amdgcn_sinf(fr));
    }
    __syncthreads();
    fft_fwd(X, tid);
#pragma unroll 8
    for (int i = 0; i < 32; ++i) { const int n = tid + NT * i; FO[n] = X[n]; }
    __syncthreads();
#pragma unroll 8
    for (int i = 0; i < 32; ++i) {
      const int n = tid + NT * i;
      float2 zz;
      if (o == 0) { zz.x = sconv_at(v0, n, L, vw0, vw1, vw2, vbb); zz.y = sconv_at(v1, n, L, vw0, vw1, vw2, vbb); }
      else { zz.x = bf2f(z10[n]); zz.y = bf2f(z11[n]); }
      X[n] = zz;
    }
    __syncthreads();
    fft_fwd(X, tid);
#pragma unroll 8
    for (int i = 0; i < 32; ++i) { const int n = tid + NT * i; X[n] = cmul(X[n], FE[n]); }
    __syncthreads();
    fft_inv(X, tid);
#pragma unroll 8
    for (int i = 0; i < 32; ++i) { const int n = tid + NT * i; FE[n] = X[n]; }
    __syncthreads();
#pragma unroll 8
    for (int i = 0; i < 32; ++i) {
      const int n = tid + NT * i; const float fr = (float)n * (1.f / 32768.f);
      float2 zz;
      if (o == 0) { zz.x = sconv_at(v0, n, L, vw0, vw1, vw2, vbb); zz.y = sconv_at(v1, n, L, vw0, vw1, vw2, vbb); }
      else { zz.x = bf2f(z10[n]); zz.y = bf2f(z11[n]); }
      X[n] = cmul(zz, make_float2(__builtin_amdgcn_cosf(fr), -__builtin_amdgcn_sinf(fr)));
    }
    __syncthreads();
    fft_fwd(X, tid);
#pragma unroll 8
    for (int i = 0; i < 32; ++i) { const int n = tid + NT * i; X[n] = cmul(X[n], FO[n]); }
    __syncthreads();
    fft_inv(X, tid);
    {
      const int gch = CH_YU + 512 * (o + 1) + c;
      const float w0 = cw[gch], w1 = cw[1536 + gch], w2 = cw[3072 + gch], bb = cbv[gch];
      const u16* s0 = CT + ((size_t)gch * 2 + 0) * TB + LC;
      const u16* s1 = CT + ((size_t)gch * 2 + 1) * TB + LC;
      const float sk = pk(p, PK_SK)[(l * 2 + o) * 512 + c];
#pragma unroll 8
      for (int i = 0; i < 32; ++i) {
        const int n = tid + NT * i; const float fr = (float)n * (1.f / 32768.f);
        const float2 wb = cmul(X[n], make_float2(__builtin_amdgcn_cosf(fr), __builtin_amdgcn_sinf(fr)));
        const float2 A = FE[n];
        const float yr = (A.x + wb.x) * (1.f / 32768.f), yi = (A.y + wb.y) * (1.f / 32768.f);
        const float g0 = sconv_at(s0, n, L, w0, w1, w2, bb), g1 = sconv_at(s1, n, L, w0, w1, w2, bb);
        float2 zz;
        if (o == 0) { zz.x = sconv_at(v0, n, L, vw0, vw1, vw2, vbb); zz.y = sconv_at(v1, n, L, vw0, vw1, vw2, vbb); }
        else { zz.x = bf2f(z10[n]); zz.y = bf2f(z11[n]); }
        X[n] = make_float2(g0 * (yr + sk * zz.x), g1 * (yi + sk * zz.y));
      }
    }
    __syncthreads();
    if (o == 0) {
#pragma unroll 8
      for (int i = 0; i < 32; ++i) { const int n = tid + NT * i; const float2 zz = X[n]; if (!dry) { z10[n] = f2bf(zz.x); z11[n] = f2bf(zz.y); } }
    } else {
      u16* d0 = CT + ((size_t)(CH_YZ + c) * 2 + 0) * TB + LC;
      u16* d1 = CT + ((size_t)(CH_YZ + c) * 2 + 1) * TB + LC;
#pragma unroll 1
      for (int ib = 0; ib < 32; ib += 8) {
        u16 g0[8], g1[8];
#pragma unroll
        for (int i = 0; i < 8; ++i) { const int n = tid + NT * (ib + i); g0[i] = d0[n]; g1[i] = d1[n]; }
#pragma unroll
        for (int i = 0; i < 8; ++i) {
          const int n = tid + NT * (ib + i); const float2 zz = X[n];
          const u16 q0 = f2bf(zz.x * silu_f(bf2f(g0[i]))), q1 = f2bf(zz.y * silu_f(bf2f(g1[i])));
          if (!dry) { d0[n] = q0; d1[n] = q1; }
        }
      }
    }
    __syncthreads();
  }
}

DI void hyena_ctx_task(const Params& p, int l, int c, char* smem, int dry) {
  float* filt = (float*)smem;
  float* zs = filt + 1024;
  float* nrm = zs + 1024;
  const int tid = threadIdx.x, lane = tid & 63, wid = tid >> 6, t = tid & 255, hb = tid >> 8;
  u16* CT = (u16*)(p.ws + OFF_CT);
  const float* h2c = (const float*)(p.ws + OFF_H2C) + (size_t)l * 256 * 64;
  const float* f3w = pk(p, PK_F3) + (size_t)l * 64 * 2048;
  const float* cw = pk(p, PK_CW) + (size_t)l * 3 * 1536;
  const float* cbv = pk(p, PK_CB) + (size_t)l * 1536;
  __syncthreads();
  {
    const int cf = hb * 1024 + c, cbk = cf + 512;
    float a_f = 0.f, a_b = 0.f;
    for (int j = 0; j < 64; ++j) { const float hv = h2c[t * 64 + j]; a_f += hv * f3w[j * 2048 + cf]; a_b += hv * f3w[j * 2048 + cbk]; }
    const float tt = (float)t / 255.f;
    filt[(hb * 2 + 0) * 256 + t] = a_f * (__expf(-tt * hy_delta(cf)) + 0.05f);
    filt[(hb * 2 + 1) * 256 + t] = a_b * (__expf(-tt * hy_delta(cbk)) + 0.05f);
    const u16* src = CT + ((size_t)(CH_YU + c) * 2 + hb) * TB;
    zs[hb * 256 + t] = sconv_at(src, t, LC, cw[c], cw[1536 + c], cw[3072 + c], cbv[c]);
  }
  __syncthreads();
  if (wid < 4) {
    float s = 0.f;
    for (int k = 0; k < 4; ++k) s += fabsf(filt[wid * 256 + lane + 64 * k]);
    s = wave_sum(s);
    if (lane == 0) nrm[wid] = s;
  }
  __syncthreads();
  const int b = hb;
  for (int o = 0; o < 2; ++o) {
    const float inf_ = 1.f / nrm[o * 2], inb_ = 1.f / nrm[o * 2 + 1];
    const float* hf = filt + (o * 2) * 256; const float* hbk = filt + (o * 2 + 1) * 256;
    const float* zc = zs + (o & 1) * 512 + b * 256;
    float accf = 0.f, accb = 0.f;
    for (int s = 0; s <= t; ++s) accf += hf[t - s] * zc[s];
    for (int s = t + 1; s < 256; ++s) accb += hbk[s - t] * zc[s];
    const int gch = CH_YU + 512 * (o + 1) + c;
    const float gate = sconv_at(CT + ((size_t)gch * 2 + b) * TB, t, LC, cw[gch], cw[1536 + gch], cw[3072 + gch], cbv[gch]);
    const float zn = gate * (accf * inf_ + accb * inb_ + pk(p, PK_SK)[(l * 2 + o) * 512 + c] * zc[t]);
    zs[((o + 1) & 1) * 512 + b * 256 + t] = zn;
    __syncthreads();
  }
  {
    u16* d = CT + ((size_t)(CH_YZ + c) * 2 + b) * TB;
    const u16 q0 = f2bf(zs[b * 256 + t] * silu_f(bf2f(d[t])));
    if (!dry) d[t] = q0;
  }
  __syncthreads();
}

DI void gla_bcum(const Params& p, int l, int row0, int hh, int dir, float* gs, float* segs, float* was, float* as_) {
  const int tid = threadIdx.x;
  const u16* P = (const u16*)(p.ws + OFF_P);
  const float* wa = pk(p, dir ? PK_WAB : PK_WAF) + (size_t)l * 16 * 256 + hh * 64;
  const float* ba = pk(p, dir ? PK_BAB : PK_BAF) + l * 256 + hh * 64;
#pragma unroll
  for (int i = 0; i < 2; ++i) {
    const int idx = tid + NT * i;
    was[idx] = wa[(idx >> 6) * 256 + (idx & 63)];
    as_[(idx >> 4) * 17 + (idx & 15)] = bf2f(P[(size_t)(row0 + (idx >> 4)) * NP + PC_AF + dir * 16 + (idx & 15)]);
  }
  __syncthreads();
  {
    const int t = tid >> 3, d0 = (tid & 7) * 8;
    float lin[8];
#pragma unroll
    for (int e = 0; e < 8; ++e) lin[e] = ba[d0 + e];
#pragma unroll 2
    for (int rr = 0; rr < 16; ++rr) {
      const float av = as_[t * 17 + rr];
      const float4 w0 = *(const float4*)(was + rr * 64 + d0), w1 = *(const float4*)(was + rr * 64 + d0 + 4);
      lin[0] += av * w0.x; lin[1] += av * w0.y; lin[2] += av * w0.z; lin[3] += av * w0.w;
      lin[4] += av * w1.x; lin[5] += av * w1.y; lin[6] += av * w1.z; lin[7] += av * w1.w;
    }
#pragma unroll
    for (int e = 0; e < 8; ++e) gs[t * 65 + d0 + e] = (fminf(lin[e], 0.f) - log1pf(__expf(-fabsf(lin[e])))) * (1.f / 16.f);
  }
  __syncthreads();
  {
    const int d = tid & 63, seg = tid >> 6;
    float v[8]; float run = 0.f;
#pragma unroll
    for (int e = 0; e < 8; ++e) { const int tt = dir ? seg * 8 + 7 - e : seg * 8 + e; run += gs[tt * 65 + d]; v[e] = run; }
    segs[seg * 64 + d] = run;
    __syncthreads();
    float off = 0.f;
#pragma unroll
    for (int s = 0; s < 8; ++s) { const bool before = dir ? (s > seg) : (s < seg); if (before) off += segs[s * 64 + d]; }
#pragma unroll
    for (int e = 0; e < 8; ++e) { const int tt = dir ? seg * 8 + 7 - e : seg * 8 + e; gs[tt * 65 + d] = v[e] + off; }
  }
  __syncthreads();
}
DI int gla_tok0(int dir, int n) {
  if (n < 4) return (dir ? 3 - n : n) * 64;
  return LC + (dir ? 255 - (n - 4) : n - 4) * 64;
}
constexpr int G_GS = 0;
constexpr int G_SEG = G_GS + 64 * 65 * 4;
constexpr int G_QS = G_SEG + 8 * 64 * 4;
constexpr int G_KS = G_QS + 64 * LDT * 2;
constexpr int G_VT = G_KS + 64 * LDT * 2;
constexpr int G_ST = G_VT + 128 * LDT * 2;
constexpr int G_RED = G_ST + 128 * LDT * 2;
constexpr int G_WA = G_RED + 8 * 32 * 4;
constexpr int G_AS = G_WA + 16 * 64 * 4;

DI void gla_g1_task(const Params& p, int l, int chain, int n, char* smem) {
  const int tid = threadIdx.x, lane = tid & 63, wid = tid >> 6, r = lane & 31, h = lane >> 5;
  const int b = chain >> 3, hh = (chain >> 1) & 3, dir = chain & 1;
  const int tk0 = gla_tok0(dir, n), row0 = b * TB + tk0;
  float* gs = (float*)(smem + G_GS); float* segs = (float*)(smem + G_SEG);
  u16* kT = (u16*)(smem + G_KS); u16* vT = (u16*)(smem + G_VT);
  const u16* P = (const u16*)(p.ws + OFF_P);
  const u16* CT = (const u16*)(p.ws + OFF_CT);
  __syncthreads();
  gla_bcum(p, l, row0, hh, dir, gs, segs, (float*)(smem + G_WA), (float*)(smem + G_AS));
  const int tl = dir ? 0 : 63;
  {
    const int t = tid >> 3, d0 = (tid & 7) * 8;
    const u32x4 kv = *(const u32x4*)(P + (size_t)(row0 + t) * NP + PC_GK + hh * 64 + d0);
    const unsigned w[4] = {kv.x, kv.y, kv.z, kv.w};
#pragma unroll
    for (int e = 0; e < 8; ++e) {
      const float kx = (e & 1) ? bfhi(w[e >> 1]) : bflo(w[e >> 1]);
      kT[(d0 + e) * LDT + t] = f2bf(kx * __expf(gs[tl * 65 + d0 + e] - gs[t * 65 + d0 + e]));
    }
#pragma unroll
    for (int i = 0; i < 2; ++i) {
      const int q = tid + NT * i, v = q >> 3, cc = q & 7;
      *(u32x4*)(vT + v * LDT + cc * 8) = *(const u32x4*)(CT + ((size_t)(CH_GV + hh * 128 + v) * 2 + b) * TB + tk0 + cc * 8);
    }
    if (tid < 64) ((float*)(p.ws + OFF_GD))[((size_t)chain * NCK + n) * 64 + tid] = __expf(gs[tl * 65 + tid]);
  }
  __syncthreads();
  {
    const int vm = wid >> 1, dn = wid & 1;
    f32x16 acc = zero16();
#pragma unroll
    for (int s = 0; s < 4; ++s) {
      const bf16x8 a = *(const bf16x8*)(vT + (vm * 32 + r) * LDT + s * 16 + h * 8);
      const bf16x8 bb = *(const bf16x8*)(kT + (dn * 32 + r) * LDT + s * 16 + h * 8);
      acc = MFMA(a, bb, acc);
    }
    u16* GS = (u16*)(p.ws + OFF_GS) + ((size_t)chain * NCK + n) * 8192;
#pragma unroll
    for (int reg = 0; reg < 16; ++reg) GS[(vm * 32 + crow(reg, h)) * 64 + dn * 32 + r] = f2bf(acc[reg]);
  }
}
DI void gla_g2(const Params& p, int dry) {
  u16* GSb = (u16*)(p.ws + OFF_GS);
  const float* GD = (const float*)(p.ws + OFF_GD);
  for (int gi = blockIdx.x * NT + threadIdx.x; gi < 16 * 8192; gi += gridDim.x * NT) {
    const int chain = gi >> 13, e = gi & 8191, d = e & 63;
    u16* ptr = GSb + (size_t)chain * NCK * 8192 + e;
    const float* dec = GD + (size_t)chain * NCK * 64 + d;
    float S = 0.f;
#pragma unroll 1
    for (int n0 = 0; n0 < NCK; n0 += 10) {
      float ds[10], a[10];
#pragma unroll
      for (int k = 0; k < 10; ++k) { ds[k] = bf2f(ptr[(size_t)(n0 + k) * 8192]); a[k] = dec[(n0 + k) * 64]; }
#pragma unroll
      for (int k = 0; k < 10; ++k) { if (!dry) ptr[(size_t)(n0 + k) * 8192] = f2bf(S); S = a[k] * S + ds[k]; }
    }
  }
}
DI void gla_g3_task(const Params& p, int l, int b, int hh, int ci, char* smem, int dry) {
  const int tid = threadIdx.x, lane = tid & 63, wid = tid >> 6, r = lane & 31, h = lane >> 5;
  const int tk0 = ci * 64, row0 = b * TB + tk0;
  float* gs = (float*)(smem + G_GS); float* segs = (float*)(smem + G_SEG); float* red = (float*)(smem + G_RED);
  u16* qs = (u16*)(smem + G_QS); u16* ks = (u16*)(smem + G_KS); u16* vT = (u16*)(smem + G_VT); u16* sT = (u16*)(smem + G_ST);
  u16* P = (u16*)(p.ws + OFF_P);
  const u16* CT = (const u16*)(p.ws + OFF_CT);
  const int vm = wid >> 1, in = wid & 1;
  f32x16 o = zero16();
  __syncthreads();
#pragma unroll 1
  for (int dir = 0; dir < 2; ++dir) {
    gla_bcum(p, l, row0, hh, dir, gs, segs, (float*)(smem + G_WA), (float*)(smem + G_AS));
    const int chain = b * 8 + hh * 2 + dir;
    const int n = dir ? ((ci < 4) ? 3 - ci : 263 - ci) : ci;
    {
      const int t = tid >> 3, d0 = (tid & 7) * 8;
      const u32x4 qv = *(const u32x4*)(P + (size_t)(row0 + t) * NP + PC_GQ + hh * 64 + d0);
      const u32x4 kv = *(const u32x4*)(P + (size_t)(row0 + t) * NP + PC_GK + hh * 64 + d0);
      const unsigned qw[4] = {qv.x, qv.y, qv.z, qv.w}, kw[4] = {kv.x, kv.y, kv.z, kv.w};
      unsigned qo[4], ko[4];
#pragma unroll
      for (int e = 0; e < 4; ++e) {
        const float b0 = gs[t * 65 + d0 + 2 * e], b1 = gs[t * 65 + d0 + 2 * e + 1];
        qo[e] = pack2(bflo(qw[e]) * 0.125f * __expf(b0), bfhi(qw[e]) * 0.125f * __expf(b1));
        ko[e] = pack2(bflo(kw[e]) * __expf(-b0), bfhi(kw[e]) * __expf(-b1));
      }
      *(u32x4*)(qs + t * LDT + d0) = u32x4{qo[0], qo[1], qo[2], qo[3]};
      *(u32x4*)(ks + t * LDT + d0) = u32x4{ko[0], ko[1], ko[2], ko[3]};
      const u16* GS = (const u16*)(p.ws + OFF_GS) + ((size_t)chain * NCK + n) * 8192;
#pragma unroll
      for (int i = 0; i < 2; ++i) {
        const int q = tid + NT * i, v = q >> 3, cc = q & 7;
        *(u32x4*)(sT + v * LDT + cc * 8) = *(const u32x4*)(GS + v * 64 + cc * 8);
        if (dir == 0) *(u32x4*)(vT + v * LDT + cc * 8) = *(const u32x4*)(CT + ((size_t)(CH_GV + hh * 128 + v) * 2 + b) * TB + tk0 + cc * 8);
      }
    }
    __syncthreads();
    bf16x8 qf[4];
#pragma unroll
    for (int s = 0; s < 4; ++s) qf[s] = *(const bf16x8*)(qs + (in * 32 + r) * LDT + s * 16 + h * 8);
#pragma unroll
    for (int jt = 0; jt < 2; ++jt) {
      f32x16 at = zero16();
#pragma unroll
      for (int s = 0; s < 4; ++s) at = MFMA(*(const bf16x8*)(ks + (jt * 32 + r) * LDT + s * 16 + h * 8), qf[s], at);
      const int ii = in * 32 + r;
#pragma unroll
      for (int reg = 0; reg < 16; ++reg) {
        const int jj = jt * 32 + crow(reg, h);
        const bool keep = dir ? (jj >= ii) : (jj <= ii);
        if (!keep) at[reg] = 0.f;
      }
#pragma unroll
      for (int s = 0; s < 2; ++s) {
        const u16* vp = vT + (vm * 32 + r) * LDT + jt * 32 + 16 * s + 4 * h;
        o = MFMA(ld2x64(vp, vp + 8), pack8(at, s), o);
      }
    }
#pragma unroll
    for (int s = 0; s < 4; ++s) o = MFMA(*(const bf16x8*)(sT + (vm * 32 + r) * LDT + s * 16 + h * 8), qf[s], o);
    __syncthreads();
  }
  float ss = 0.f;
#pragma unroll
  for (int reg = 0; reg < 16; ++reg) ss += o[reg] * o[reg];
  ss += __shfl_xor(ss, 32);
  if (h == 0) red[wid * 32 + r] = ss;
  __syncthreads();
  float tot = 0.f;
#pragma unroll
  for (int m = 0; m < 4; ++m) tot += red[(m * 2 + in) * 32 + r];
  const float rs = rsqrtf(tot * (1.f / 128.f) + EPS);
  u16* zp = P + (size_t)(row0 + in * 32 + r) * NP + PC_GZ + hh * 128 + vm * 32 + 4 * h;
  const float* gn = pk(p, PK_GN) + l * 128 + vm * 32 + 4 * h;
#pragma unroll
  for (int g = 0; g < 4; ++g) {
    const u32x2 zz = *(const u32x2*)(zp + 8 * g);
    const float4 gw = *(const float4*)(gn + 8 * g);
    u32x2 out;
    out.x = pack2(o[4 * g] * rs * gw.x * silu_f(bflo(zz.x)), o[4 * g + 1] * rs * gw.y * silu_f(bfhi(zz.x)));
    out.y = pack2(o[4 * g + 2] * rs * gw.z * silu_f(bflo(zz.y)), o[4 * g + 3] * rs * gw.w * silu_f(bfhi(zz.y)));
    if (!dry) *(u32x2*)(zp + 8 * g) = out;
  }
}

DI void attn_item(const Params& p, int l, int b, int g, int qtk0, int ntiles, char* smem, int dry) {
  const int tid = threadIdx.x, lane = tid & 63, wid = tid >> 6, r = lane & 31, h = lane >> 5;
  u16* P = (u16*)(p.ws + OFF_P);
  const u16* CT = (const u16*)(p.ws + OFF_CT);
  u16* Ks = (u16*)smem;
  u16* Vs = Ks + 2 * 64 * LDT;
  const int hq = g * 4 + (wid >> 1);
  const size_t qrow = (size_t)b * TB + qtk0 + (wid & 1) * 32 + r;
  bf16x8 qf[4];
#pragma unroll
  for (int s = 0; s < 4; ++s) qf[s] = *(const bf16x8*)(P + qrow * NP + PC_AQ + hq * 64 + s * 16 + h * 8);
  f32x16 O[2] = {zero16(), zero16()};
  float m = -1e30f, lsum = 0.f;
  const int lr = tid >> 3, lc = (tid & 7) * 8;
  const u16* kg = P + ((size_t)b * TB + lr) * NP + PC_AK + g * 64 + lc;
  const u16* vg = CT + ((size_t)(CH_AV + g * 64 + lr) * 2 + b) * TB + lc;
  u32x4 rk = *(const u32x4*)kg, rv = *(const u32x4*)vg;
  __syncthreads();
  *(u32x4*)(Ks + lr * LDT + lc) = rk; *(u32x4*)(Vs + lr * LDT + lc) = rv;
  __syncthreads();
  float gqm = fabsf(pk(p, PK_QN)[l * 64 + lane]), gkm = fabsf(pk(p, PK_KN)[l * 64 + lane]);
#pragma unroll
  for (int o = 32; o >= 1; o >>= 1) { gqm = fmaxf(gqm, __shfl_xor(gqm, o)); gkm = fmaxf(gkm, __shfl_xor(gkm, o)); }
  const float mshift = 8.2f * 1.4426950408889634f * gqm * gkm;
  if (mshift <= 60.f) {
    f32x16 sinit;
#pragma unroll
    for (int i = 0; i < 16; ++i) sinit[i] = -mshift;
#pragma unroll 1
    for (int kt = 0; kt < ntiles; ++kt) {
      const int cur = kt & 1;
      if (kt + 1 < ntiles) { rk = *(const u32x4*)(kg + (size_t)(kt + 1) * 64 * NP); rv = *(const u32x4*)(vg + (kt + 1) * 64); }
      const u16* Kc = Ks + cur * 64 * LDT; const u16* Vc = Vs + cur * 64 * LDT;
      f32x16 st[2];
#pragma unroll
      for (int kk = 0; kk < 2; ++kk) {
        st[kk] = sinit;
#pragma unroll
        for (int s = 0; s < 4; ++s) st[kk] = MFMA(*(const bf16x8*)(Kc + (kk * 32 + r) * LDT + s * 16 + h * 8), qf[s], st[kk]);
      }
#pragma unroll
      for (int kk = 0; kk < 2; ++kk)
#pragma unroll
        for (int i = 0; i < 16; ++i) { const float pv = __builtin_amdgcn_exp2f(st[kk][i]); st[kk][i] = pv; lsum += pv; }
#pragma unroll
      for (int kk = 0; kk < 2; ++kk)
#pragma unroll
        for (int s = 0; s < 2; ++s) {
          const bf16x8 pb = pack8(st[kk], s);
#pragma unroll
          for (int mt = 0; mt < 2; ++mt) {
            const u16* vp = Vc + (mt * 32 + r) * LDT + kk * 32 + 16 * s + 4 * h;
            O[mt] = MFMA(ld2x64(vp, vp + 8), pb, O[mt]);
          }
        }
      if (kt + 1 < ntiles) { *(u32x4*)(Ks + (cur ^ 1) * 64 * LDT + lr * LDT + lc) = rk; *(u32x4*)(Vs + (cur ^ 1) * 64 * LDT + lr * LDT + lc) = rv; }
      __syncthreads();
    }
  } else {
#pragma unroll 1
    for (int kt = 0; kt < ntiles; ++kt) {
      const int cur = kt & 1;
      if (kt + 1 < ntiles) { rk = *(const u32x4*)(kg + (size_t)(kt + 1) * 64 * NP); rv = *(const u32x4*)(vg + (kt + 1) * 64); }
      const u16* Kc = Ks + cur * 64 * LDT; const u16* Vc = Vs + cur * 64 * LDT;
      f32x16 st[2];
#pragma unroll
      for (int kk = 0; kk < 2; ++kk) {
        st[kk] = zero16();
#pragma unroll
        for (int s = 0; s < 4; ++s) st[kk] = MFMA(*(const bf16x8*)(Kc + (kk * 32 + r) * LDT + s * 16 + h * 8), qf[s], st[kk]);
      }
      float mx = st[0][0];
#pragma unroll
      for (int i = 0; i < 16; ++i) { mx = fmaxf(mx, st[0][i]); mx = fmaxf(mx, st[1][i]); }
      mx = fmaxf(mx, __shfl_xor(mx, 32));
      const float mn = fmaxf(m, mx);
      const float alpha = exp2f(m - mn);
      m = mn;
      float rsum = 0.f;
#pragma unroll
      for (int kk = 0; kk < 2; ++kk)
#pragma unroll
        for (int i = 0; i < 16; ++i) { const float pv = exp2f(st[kk][i] - mn); st[kk][i] = pv; rsum += pv; }
      lsum = lsum * alpha + rsum;
#pragma unroll
      for (int mt = 0; mt < 2; ++mt)
#pragma unroll
        for (int i = 0; i < 16; ++i) O[mt][i] *= alpha;
#pragma unroll
      for (int kk = 0; kk < 2; ++kk)
#pragma unroll
        for (int s = 0; s < 2; ++s) {
          const bf16x8 pb = pack8(st[kk], s);
#pragma unroll
          for (int mt = 0; mt < 2; ++mt) {
            const u16* vp = Vc + (mt * 32 + r) * LDT + kk * 32 + 16 * s + 4 * h;
            O[mt] = MFMA(ld2x64(vp, vp + 8), pb, O[mt]);
          }
        }
      if (kt + 1 < ntiles) { *(u32x4*)(Ks + (cur ^ 1) * 64 * LDT + lr * LDT + lc) = rk; *(u32x4*)(Vs + (cur ^ 1) * 64 * LDT + lr * LDT + lc) = rv; }
      __syncthreads();
    }
  }
  lsum += __shfl_xor(lsum, 32);
  const float inv = 1.f / lsum;
  u16* op = P + qrow * NP + PC_AQ + hq * 64 + 4 * h;
  const u16* zp = P + qrow * NP + PC_AZ + hq * 64 + 4 * h;
#pragma unroll
  for (int mt = 0; mt < 2; ++mt)
#pragma unroll
    for (int gg = 0; gg < 4; ++gg) {
      const u32x2 zz = *(const u32x2*)(zp + mt * 32 + 8 * gg);
      u32x2 out;
      out.x = pack2(O[mt][4 * gg] * inv * silu_f(bflo(zz.x)), O[mt][4 * gg + 1] * inv * silu_f(bfhi(zz.x)));
      out.y = pack2(O[mt][4 * gg + 2] * inv * silu_f(bflo(zz.y)), O[mt][4 * gg + 3] * inv * silu_f(bfhi(zz.y)));
      if (!dry) *(u32x2*)(op + mt * 32 + 8 * gg) = out;
    }
}

DI void merge_accum(f32x16 (&ysum)[2], const f32x16 (&am)[1][2], const f32x16 (&ab)[1][2]) {
#pragma unroll
  for (int j = 0; j < 2; ++j)
#pragma unroll
    for (int i = 0; i < 16; ++i) ysum[j][i] += ab[0][j][i] / (1.f + __expf(-am[0][j][i]));
}
DI void phase_merge(const Params& p, int l, char* smem) {
  const int tid = threadIdx.x, lane = tid & 63, wid = tid >> 6, r = lane & 31, h = lane >> 5, wm = wid & 3, wn = wid >> 2;
  const int xcd = blockIdx.x & 7, nloc = gridDim.x >> 3;
  for (int q = blockIdx.x >> 3; q < 33 * 8; q += nloc) {
    const int mt = (q >> 3) * 8 + xcd, nt = q & 7, m0 = mt * 128, n0 = nt * 128;
    if (mt >= 260) continue;
    const int b = m0 / TB, tk0 = m0 - b * TB;
    if (l == 1 && tk0 < LC) continue;
    const u16* H = (const u16*)(p.ws + OFF_H) + (size_t)m0 * 1024;
    const u16* WM = (const u16*)(p.ws + OFF_WT + (size_t)l * WT_LAYER) + (size_t)(4896 + n0) * 1024;
    const u16* WBR = (const u16*)(p.ws + OFF_WT + (size_t)l * WT_LAYER + WT_IN) + (size_t)n0 * 512;
    f32x16 ysum[2] = {zero16(), zero16()};
#pragma unroll 1
    for (int br = 0; br < 2; ++br) {
      f32x16 am[1][2] = {{zero16(), zero16()}};
      ALoadN ah{H, 1024};
      gemm_tile<128, ALoadN, 1, 1024>(ah, WM + (size_t)br * 1024 * 1024, 1024, smem, am);
      f32x16 ab[1][2] = {{zero16(), zero16()}};
      ALoadN ay{(const u16*)(p.ws + OFF_P) + (size_t)m0 * NP + (br == 0 ? PC_GZ : PC_AQ), NP};
      gemm_tile<128, ALoadN, 1, 512>(ay, WBR + (size_t)br * 1024 * 512, 512, smem, ab);
      merge_accum(ysum, am, ab);
    }
    {
      f32x16 am[1][2] = {{zero16(), zero16()}};
      ALoadN ah{H, 1024};
      gemm_tile<128, ALoadN, 1, 1024>(ah, WM + (size_t)2 * 1024 * 1024, 1024, smem, am);
      f32x16 ab[1][2] = {{zero16(), zero16()}};
      ALoadT ay{(const u16*)(p.ws + OFF_CT) + ((size_t)CH_YZ * 2 + b) * TB + tk0, (size_t)2 * TB};
      gemm_tile<128, ALoadT, 1, 512>(ay, WBR + (size_t)2 * 1024 * 512, 512, smem, ab);
      merge_accum(ysum, am, ab);
    }
    u16* Y = (u16*)(p.ws + OFF_Y) + (size_t)(m0 + wm * 32 + 4 * h) * 1024 + n0 + wn * 64 + r;
#pragma unroll
    for (int j = 0; j < 2; ++j)
#pragma unroll
      for (int reg = 0; reg < 16; ++reg) Y[(size_t)((reg & 3) + 8 * (reg >> 2)) * 1024 + j * 32] = f2bf(ysum[j][reg]);
  }
}

DI void phase_out(const Params& p, int l, char* smem) {
  const int tid = threadIdx.x, lane = tid & 63, wid = tid >> 6, r = lane & 31, h = lane >> 5, wm = wid & 3, wn = wid >> 2;
  const u16* Y = (const u16*)(p.ws + OFF_Y);
  const u16* WO = (const u16*)(p.ws + OFF_WT + (size_t)l * WT_LAYER + WT_IN + 3 * WT_BR);
  const float* mod = (const float*)(p.ws + OFF_MOD);
  const int xcd = blockIdx.x & 7, nloc = gridDim.x >> 3;
  for (int q = blockIdx.x >> 3; q < 33 * 8; q += nloc) {
    const int mt = (q >> 3) * 8 + xcd, nt = q & 7, m0 = mt * 128, n0 = nt * 128;
    if (mt >= 260) continue;
    const int b = m0 / TB, tk0 = m0 - b * TB;
    if (l == 1 && tk0 < LC) continue;
    f32x16 acc[1][2] = {{zero16(), zero16()}};
    ALoadN ay{Y + (size_t)m0 * 1024, 1024};
    gemm_tile<128, ALoadN, 4, 1024>(ay, WO + (size_t)n0 * 1024, 1024, smem, acc);
    const float* gv = mod + (l * 3 + (tk0 < LC ? 2 : b)) * 3072 + 2048;
    const float* xin = xrow_in(p, l, m0);
    float* xout = xrow_out(p, m0);
#pragma unroll
    for (int j = 0; j < 2; ++j) {
      const int col = n0 + wn * 64 + j * 32 + r;
      const float gate = gv[col];
#pragma unroll
      for (int reg = 0; reg < 16; ++reg) {
        const size_t off = (size_t)(wm * 32 + crow(reg, h)) * D + col;
        xout[off] = xin[off] + gate * acc[0][j][reg];
      }
    }
  }
}

DI void phase_final(const Params& p) {
  const int tid = threadIdx.x, lane = tid & 63, wid = tid >> 6;
  for (int row = blockIdx.x * 8 + wid; row < NBATCH * L; row += gridDim.x * 8) {
    float* src = p.out + (size_t)row * D;
    float4 xv[4]; float ss = 0.f;
#pragma unroll
    for (int i = 0; i < 4; ++i) { xv[i] = *(const float4*)(src + (i * 64 + lane) * 4); ss += xv[i].x * xv[i].x + xv[i].y * xv[i].y + xv[i].z * xv[i].z + xv[i].w * xv[i].w; }
    ss = wave_sum(ss);
    const float rs = rsqrtf(ss * (1.f / 1024.f) + EPS);
#pragma unroll
    for (int i = 0; i < 4; ++i) {
      const int col = (i * 64 + lane) * 4;
      const float4 fw = *(const float4*)(pk(p, PK_FN) + col);
      *(float4*)(src + col) = make_float4(xv[i].x * rs * fw.x, xv[i].y * rs * fw.y, xv[i].z * rs * fw.z, xv[i].w * rs * fw.w);
    }
  }
}

DI void run_phase(const Params& p, int ph, char* smem, int dry = 0) {
  const int bid = blockIdx.x, nb = gridDim.x;
  if (ph == 0) { phase0(p, smem); return; }
  if (ph == 17) { phase_final(p); return; }
  const int l = (ph - 1) >> 3, s = (ph - 1) & 7;
  switch (s) {
    case 0: phase_norm(p, l); break;
    case 1: phase_proj(p, l, smem); break;
    case 2: {
      attn_prep(p, l, dry);
      if (l == 0) for (int c = bid; c < 512; c += nb) hyena_ctx_task(p, l, c, smem, dry);
      for (int c = bid; c < 512; c += nb) hyena_latent_task(p, l, c, smem, dry);
    } break;
    case 3: for (int t = bid; t < 16 * NCK; t += nb) gla_g1_task(p, l, t / NCK, t % NCK, smem); break;
    case 4: gla_g2(p, dry); break;
    case 5: {
      for (int it = bid; it < 1024; it += nb) { const int b = it >> 9, g = (it >> 8) & 1, qb = it & 255; attn_item(p, l, b, g, LC + qb * 64, NCK, smem, dry); }
      if (l == 0) for (int it = bid; it < 16; it += nb) { const int b = it >> 3, g = (it >> 2) & 1, qb = it & 3; attn_item(p, l, b, g, qb * 64, 4, smem, dry); }
      const int c0 = (l == 0) ? 0 : 4, per = NCK - c0;
      for (int t = bid; t < 8 * per; t += nb) { const int bh = t / per, ci = c0 + t % per; gla_g3_task(p, l, bh >> 2, bh & 3, ci, smem, dry); }
    } break;
    case 6: phase_merge(p, l, smem); break;
    case 7: phase_out(p, l, smem); break;
  }
}

#if MULTI_LAUNCH
template <int PH> __global__ void __launch_bounds__(NT) phase_kernel(Params p) {
  extern __shared__ __attribute__((aligned(16))) char smem[];
  run_phase(p, PH, smem);
}
template <int PH> static void launch_phase(const Params& p, int grid, hipStream_t stream) {
  static bool attr = false;
  if (!attr) { (void)hipFuncSetAttribute((const void*)phase_kernel<PH>, hipFuncAttributeMaxDynamicSharedMemorySize, LDS_BYTES); attr = true; }
  hipLaunchKernelGGL(phase_kernel<PH>, dim3(grid), dim3(NT), LDS_BYTES, stream, p);
}
#else
#ifndef PROBE_DUP
#define PROBE_DUP -1
#endif
#ifndef PROBE_DUP2
#define PROBE_DUP2 -1
#endif
#ifndef PROBE_DUP3
#define PROBE_DUP3 -1
#endif
__global__ void __launch_bounds__(NT) fwd_kernel(Params p) {
  extern __shared__ __attribute__((aligned(16))) char smem[];
  cg::grid_group grid = cg::this_grid();
#if PROBE_DUP >= 0
#define PHS(n) if ((n) == PROBE_DUP || (n) == PROBE_DUP2 || (n) == PROBE_DUP3) { run_phase(p, n, smem, p.phase_lo == 0 ? 1 : 0); grid.sync(); } run_phase(p, n, smem); grid.sync();
#else
#define PHS(n) run_phase(p, n, smem); grid.sync();
#endif
  PHS(0) PHS(1) PHS(2) PHS(3) PHS(4) PHS(5) PHS(6) PHS(7) PHS(8)
  PHS(9) PHS(10) PHS(11) PHS(12) PHS(13) PHS(14) PHS(15) PHS(16)
  run_phase(p, 17, smem);
}
#endif

extern "C" void kernel_launch(void* const* d_in, const int* in_sizes, int n_in, void* d_out, int out_size, void* d_ws, size_t ws_size,
                              hipStream_t stream) {
  static int grid = 0;
  if (grid == 0) {
    if (n_in != 29 || ws_size < WS_END) { fprintf(stderr, "kernel_launch: need 29 inputs and %zu B of workspace, got %d / %zu\n", (size_t)WS_END, n_in, ws_size); grid = -1; return; }
#if MULTI_LAUNCH
    grid = 256;
#else
    int dev = 0, cus = 0, per_cu = 0;
    (void)hipGetDevice(&dev);
    (void)hipDeviceGetAttribute(&cus, hipDeviceAttributeMultiprocessorCount, dev);
    if (hipFuncSetAttribute((const void*)fwd_kernel, hipFuncAttributeMaxDynamicSharedMemorySize, LDS_BYTES) != hipSuccess) { fprintf(stderr, "kernel_launch: hipFuncSetAttribute failed\n"); grid = -1; return; }
    (void)hipOccupancyMaxActiveBlocksPerMultiprocessor(&per_cu, (const void*)fwd_kernel, NT, LDS_BYTES);
    if (per_cu < 1) { fprintf(stderr, "kernel_launch: occupancy query returned %d\n", per_cu); per_cu = 1; }
    (void)hipGetLastError();
    grid = cus * per_cu;
    if (grid > 256) grid = 256;
#endif
  }
  if (grid < 0) return;
  Params p{};
  const float** pp = (const float**)&p;
  for (int i = 0; i < 29; ++i) pp[i] = (const float*)d_in[i];
  p.out = (float*)d_out; p.ws = (char*)d_ws;
  p.phase_lo = 0; p.phase_hi = 18;
#if MULTI_LAUNCH
  launch_phase<0>(p, grid, stream); launch_phase<1>(p, grid, stream); launch_phase<2>(p, grid, stream); launch_phase<3>(p, grid, stream);
  launch_phase<4>(p, grid, stream); launch_phase<5>(p, grid, stream); launch_phase<6>(p, grid, stream); launch_phase<7>(p, grid, stream);
  launch_phase<8>(p, grid, stream); launch_phase<9>(p, grid, stream); launch_phase<10>(p, grid, stream); launch_phase<11>(p, grid, stream);
  launch_phase<12>(p, grid, stream); launch_phase<13>(p, grid, stream); launch_phase<14>(p, grid, stream); launch_phase<15>(p, grid, stream);
  launch_phase<16>(p, grid, stream); launch_phase<17>(p, grid, stream);
#else
  void* args[] = {&p};
  hipError_t e = hipLaunchCooperativeKernel((const void*)fwd_kernel, dim3(grid), dim3(NT), args, LDS_BYTES, stream);
  if (e != hipSuccess) fprintf(stderr, "kernel_launch: cooperative launch failed: %s (grid %d)\n", hipGetErrorString(e), grid);
#endif
}
```

```cpp
#include <hip/hip_runtime.h>
#include <hip/hip_cooperative_groups.h>
#include <cstdio>
namespace cg = cooperative_groups;

typedef unsigned short u16;
typedef __attribute__((ext_vector_type(8))) short bf16x8;
typedef __attribute__((ext_vector_type(16))) float f32x16;
typedef __attribute__((ext_vector_type(4))) unsigned u32x4;
typedef __attribute__((ext_vector_type(2))) unsigned u32x2;
#define DI __device__ __forceinline__
#define MFMA(a, b, c) __builtin_amdgcn_mfma_f32_32x32x16_bf16((a), (b), (c), 0, 0, 0)

#ifndef MULTI_LAUNCH
#define MULTI_LAUNCH 0
#endif

constexpr int D = 1024, NBATCH = 2, L = 16384, LC = 256, TB = L + LC, R = NBATCH * TB;
constexpr int NIN = 7968;
constexpr int NP = 2208;
constexpr int NCH = 2688;
constexpr int PC_GQ = 0, PC_GK = 256, PC_GZ = 512, PC_AF = 1024, PC_AQ = 1056, PC_AK = 1568, PC_AZ = 1696;
constexpr int CH_YU = 0, CH_YZ = 1536, CH_GV = 2048, CH_AV = 2560;
constexpr int NCK = 260;
constexpr float EPS = 1e-6f;
constexpr int NT = 512;
constexpr int LDT = 72;

constexpr size_t OFF_P = 0;
constexpr size_t OFF_CT = OFF_P + (size_t)R * NP * 2;
constexpr size_t OFF_H = OFF_CT + (size_t)NCH * 2 * TB * 2;
constexpr size_t OFF_FS = OFF_H + (size_t)R * 1024 * 2;
constexpr size_t OFF_WT = OFF_FS + (size_t)256 * 262144;
constexpr size_t WT_IN = (size_t)NIN * 1024 * 2, WT_BR = (size_t)1024 * 512 * 2, WT_OUT = (size_t)1024 * 1024 * 2;
constexpr size_t WT_LAYER = WT_IN + 3 * WT_BR + WT_OUT;
constexpr size_t OFF_H2T = OFF_WT + 2 * WT_LAYER;
constexpr size_t OFF_H2C = OFF_H2T + (size_t)2 * 64 * L * 4;
constexpr size_t OFF_MOD = OFF_H2C + (size_t)2 * 256 * 64 * 4;
constexpr size_t OFF_CTX1 = OFF_MOD + (size_t)2 * 3 * 3072 * 4;
constexpr size_t OFF_GD = OFF_CTX1 + (size_t)512 * 1024 * 4;
constexpr size_t OFF_PK = OFF_GD + (size_t)16 * NCK * 64 * 4;
constexpr int PK_WAF = 0, PK_BAF = 8192, PK_WAB = 8704, PK_BAB = 16896, PK_GN = 17408, PK_QN = 17664, PK_KN = 17792, PK_CW = 17920,
              PK_CB = 27136, PK_SK = 30208, PK_FN = 32256, PK_F3 = 33280, PK_END = 33280 + 262144;
constexpr size_t WS_END = OFF_PK + (size_t)PK_END * 4;
constexpr size_t OFF_GS = OFF_CT;
constexpr size_t OFF_Y = OFF_CT;
static_assert((size_t)16 * NCK * 8192 * 2 <= (size_t)1536 * 2 * TB * 2, "alias");
static_assert((size_t)R * 1024 * 2 <= (size_t)1536 * 2 * TB * 2, "alias");

constexpr int LDS_BYTES = 131072 + 512;

struct Params {
  const float *x, *c, *ctx, *c_ctx, *w_ada, *b_ada, *w_in, *wa_f, *ba_f, *wa_b, *ba_b, *gla_norm, *qnorm, *knorm,
      *conv_w, *conv_b, *f1_w, *f1_b, *f1_freq, *f2_w, *f2_b, *f2_freq, *f3_w, *skip, *w_g, *w_a, *w_h, *w_o, *final_norm;
  float* out;
  char* ws;
  long long phase_lo, phase_hi;
};

typedef __attribute__((ext_vector_type(2))) float f32x2v;
typedef __attribute__((ext_vector_type(2))) __bf16 bf16x2v;
DI u16 f2bf(float x) { return __builtin_bit_cast(u16, (__bf16)x); }
DI float bf2f(u16 v) { return __uint_as_float(((unsigned)v) << 16); }
DI unsigned pack2(float a, float b) { f32x2v v = {a, b}; return __builtin_bit_cast(unsigned, __builtin_convertvector(v, bf16x2v)); }
DI float bflo(unsigned u) { return __uint_as_float(u << 16); }
DI float bfhi(unsigned u) { return __uint_as_float(u & 0xffff0000u); }
DI float silu_f(float x) { return x / (1.f + __expf(-x)); }
DI float wave_sum(float v) {
#pragma unroll
  for (int o = 32; o >= 1; o >>= 1) v += __shfl_xor(v, o);
  return v;
}
DI int crow(int reg, int h) { return (reg & 3) + 8 * (reg >> 2) + 4 * h; }
DI f32x16 zero16() { f32x16 z; for (int i = 0; i < 16; ++i) z[i] = 0.f; return z; }
DI bf16x8 pack8(const f32x16& x, int s) {
  u32x4 u;
  u.x = pack2(x[8 * s + 0], x[8 * s + 1]); u.y = pack2(x[8 * s + 2], x[8 * s + 3]);
  u.z = pack2(x[8 * s + 4], x[8 * s + 5]); u.w = pack2(x[8 * s + 6], x[8 * s + 7]);
  return __builtin_bit_cast(bf16x8, u);
}
DI bf16x8 ld2x64(const u16* p0, const u16* p1) {
  u32x2 a = *(const u32x2*)p0, b = *(const u32x2*)p1;
  u32x4 u; u.x = a.x; u.y = a.y; u.z = b.x; u.w = b.y;
  return __builtin_bit_cast(bf16x8, u);
}
DI float2 cmul(float2 a, float2 b) { return make_float2(a.x * b.x - a.y * b.y, a.x * b.y + a.y * b.x); }
DI float2 cadd(float2 a, float2 b) { return make_float2(a.x + b.x, a.y + b.y); }
DI float2 csub(float2 a, float2 b) { return make_float2(a.x - b.x, a.y - b.y); }

DI const float* xrow_in(const Params& p, int layer, int row) {
  int b = row / TB, tk = row - b * TB;
  if (tk < LC) return (layer == 0 ? p.ctx : (const float*)(p.ws + OFF_CTX1)) + (size_t)(b * LC + tk) * D;
  return (layer == 0 ? p.x : (const float*)p.out) + (size_t)(b * L + tk - LC) * D;
}
DI float* xrow_out(const Params& p, int row) {
  int b = row / TB, tk = row - b * TB;
  if (tk < LC) return (float*)(p.ws + OFF_CTX1) + (size_t)(b * LC + tk) * D;
  return p.out + (size_t)(b * L + tk - LC) * D;
}
DI const float* pk(const Params& p, int off) { return (const float*)(p.ws + OFF_PK) + off; }
DI int modvec_of(int row) { int b = row / TB, tk = row - b * TB; return tk < LC ? 2 : b; }

struct ALoadN {
  const u16* A; int lda;
  template <int BM> DI void fetch(u32x4 (&r)[BM / 64], int k0, int tid) const {
#pragma unroll
    for (int i = 0; i < BM / 64; ++i) { const int q = tid + NT * i; const unsigned off = (unsigned)((q >> 3) * lda + (q & 7) * 8); r[i] = *(const u32x4*)(A + off + k0); }
  }
  template <int BM> DI void commit(const u32x4 (&r)[BM / 64], u16* As, int tid) const {
#pragma unroll
    for (int i = 0; i < BM / 64; ++i) { int q = tid + NT * i; *(u32x4*)(As + (q >> 3) * LDT + (q & 7) * 8) = r[i]; }
  }
};
struct ALoadT {
  const u16* A; size_t chs;
  template <int BM> DI void fetch(u32x4 (&r)[BM / 64], int k0, int tid) const {
#pragma unroll
    for (int i = 0; i < 2; ++i) { const int q = tid + NT * i; const unsigned off = (unsigned)((q >> 4) * (int)chs + (q & 15) * 8); r[i] = *(const u32x4*)(A + off + (unsigned)(k0 * (int)chs)); }
  }
  template <int BM> DI void commit(const u32x4 (&r)[BM / 64], u16* As, int tid) const {
#pragma unroll
    for (int i = 0; i < 2; ++i) {
      int q = tid + NT * i; int ch = q >> 4, t0 = (q & 15) * 8;
      unsigned w[4] = {r[i].x, r[i].y, r[i].z, r[i].w};
#pragma unroll
      for (int e = 0; e < 4; ++e) { As[(t0 + 2 * e) * LDT + ch] = (u16)(w[e] & 0xffffu); As[(t0 + 2 * e + 1) * LDT + ch] = (u16)(w[e] >> 16); }
    }
  }
};

template <int BM, int KSU>
DI void gemm_compute(const u16* Ac, const u16* Bc, int wm, int wn, int r, int h, f32x16 (&acc)[BM / 128][2]) {
#pragma unroll KSU
  for (int ks = 0; ks < 4; ++ks) {
    bf16x8 a[BM / 128], b[2];
#pragma unroll
    for (int i = 0; i < BM / 128; ++i) a[i] = *(const bf16x8*)(Ac + (wm * (BM / 4) + i * 32 + r) * LDT + ks * 16 + h * 8);
#pragma unroll
    for (int j = 0; j < 2; ++j) b[j] = *(const bf16x8*)(Bc + (wn * 64 + j * 32 + r) * LDT + ks * 16 + h * 8);
#pragma unroll
    for (int i = 0; i < BM / 128; ++i)
#pragma unroll
      for (int j = 0; j < 2; ++j) acc[i][j] = MFMA(a[i], b[j], acc[i][j]);
  }
}
DI void fetch_b(u32x4 (&rb)[2], const u16* Bt, int ldb, int k0, int tid) {
#pragma unroll
  for (int i = 0; i < 2; ++i) { const int q = tid + NT * i; const unsigned off = (unsigned)((q >> 3) * ldb + (q & 7) * 8); rb[i] = *(const u32x4*)(Bt + off + k0); }
}
DI void commit_b(const u32x4 (&rb)[2], u16* Bs, int tid) {
#pragma unroll
  for (int i = 0; i < 2; ++i) { int q = tid + NT * i; *(u32x4*)(Bs + (q >> 3) * LDT + (q & 7) * 8) = rb[i]; }
}
template <int BM> struct GemmRegs { u32x4 ra0[BM / 64], rb0[2], ra1[BM / 64], rb1[2]; };
#define GFENCE asm volatile("" ::: "memory")
template <int BM, class AL>
DI void gemm_prime(GemmRegs<BM>& g, const AL& al, const u16* __restrict__ Bt, int ldb, char* smem) {
  u16* As0 = (u16*)smem;
  u16* Bs0 = As0 + 2 * BM * LDT;
  const int tid = threadIdx.x;
  al.template fetch<BM>(g.ra0, 0, tid); fetch_b(g.rb0, Bt, ldb, 0, tid); GFENCE;
  al.template fetch<BM>(g.ra1, 64, tid); fetch_b(g.rb1, Bt, ldb, 64, tid); GFENCE;
  __syncthreads();
  al.template commit<BM>(g.ra0, As0, tid); commit_b(g.rb0, Bs0, tid);
  __syncthreads();
  al.template fetch<BM>(g.ra0, 128, tid); fetch_b(g.rb0, Bt, ldb, 128, tid); GFENCE;
}
template <int BM, class AL, int KSU, int K, class ALN>
DI void gemm_run(GemmRegs<BM>& g, const AL& al, const u16* __restrict__ Bt, int ldb, const ALN& aln, const u16* __restrict__ Btn, int ldbn,
                 bool hasnext, char* smem, f32x16 (&acc)[BM / 128][2]) {
  u16* As0 = (u16*)smem;
  u16* As1 = As0 + BM * LDT;
  u16* Bs0 = As0 + 2 * BM * LDT;
  u16* Bs1 = Bs0 + 128 * LDT;
  const int tid = threadIdx.x, lane = tid & 63, wid = tid >> 6, r = lane & 31, h = lane >> 5;
  const int wm = wid & 3, wn = wid >> 2;
  constexpr int KT = K >> 6;
#pragma unroll
  for (int kt = 0; kt < KT; kt += 2) {
    al.template commit<BM>(g.ra1, As1, tid); commit_b(g.rb1, Bs1, tid);
    GFENCE;
    if (kt + 3 < KT) { al.template fetch<BM>(g.ra1, (kt + 3) * 64, tid); fetch_b(g.rb1, Bt, ldb, (kt + 3) * 64, tid); GFENCE; }
    else if (hasnext) { aln.template fetch<BM>(g.ra1, (kt + 3 - KT) * 64, tid); fetch_b(g.rb1, Btn, ldbn, (kt + 3 - KT) * 64, tid); GFENCE; }
    gemm_compute<BM, KSU>(As0, Bs0, wm, wn, r, h, acc);
    __syncthreads();
    if (kt + 2 < KT) { al.template commit<BM>(g.ra0, As0, tid); commit_b(g.rb0, Bs0, tid); GFENCE; }
    else if (hasnext) { aln.template commit<BM>(g.ra0, As0, tid); commit_b(g.rb0, Bs0, tid); GFENCE; }
    if (kt + 4 < KT) { al.template fetch<BM>(g.ra0, (kt + 4) * 64, tid); fetch_b(g.rb0, Bt, ldb, (kt + 4) * 64, tid); GFENCE; }
    else if (hasnext) { aln.template fetch<BM>(g.ra0, (kt + 4 - KT) * 64, tid); fetch_b(g.rb0, Btn, ldbn, (kt + 4 - KT) * 64, tid); GFENCE; }
    gemm_compute<BM, KSU>(As1, Bs1, wm, wn, r, h, acc);
    __syncthreads();
  }
}

template <int BM, class AL, int KSU = 4, int K = 1024>
DI void gemm_tile(const AL& al, const u16* __restrict__ Bt, int ldb, char* smem, f32x16 (&acc)[BM / 128][2]) {
  GemmRegs<BM> g;
  gemm_prime<BM>(g, al, Bt, ldb, smem);
  gemm_run<BM, AL, KSU, K, AL>(g, al, Bt, ldb, al, Bt, ldb, false, smem, acc);
}

DI void phase0(const Params& p, char* smem) {
  const int tid = threadIdx.x, lane = tid & 63, wid = tid >> 6, bid = blockIdx.x, nb = gridDim.x;
  float* sm = (float*)smem;
  {
    float* PKW = (float*)(p.ws + OFF_PK);
    const int gt = bid * NT + tid, gn = nb * NT;
#define PKCP(src, off, cnt) for (int i = gt; i < (cnt); i += gn) PKW[(off) + i] = (src)[i];
    PKCP(p.wa_f, PK_WAF, 8192) PKCP(p.ba_f, PK_BAF, 512) PKCP(p.wa_b, PK_WAB, 8192) PKCP(p.ba_b, PK_BAB, 512)
    PKCP(p.gla_norm, PK_GN, 256) PKCP(p.qnorm, PK_QN, 128) PKCP(p.knorm, PK_KN, 128) PKCP(p.conv_w, PK_CW, 9216)
    PKCP(p.conv_b, PK_CB, 3072) PKCP(p.skip, PK_SK, 2048) PKCP(p.final_norm, PK_FN, 1024) PKCP(p.f3_w, PK_F3, 262144)
#undef PKCP
  }
  float* mod = (float*)(p.ws + OFF_MOD);
  for (int task = bid; task < 96; task += nb) {
    const int l = task / 48, cb = task % 48, col = cb * 64 + lane;
    const float* W = p.w_ada + (size_t)l * 1024 * 3072;
    float a0 = 0.f, a1 = 0.f, a2 = 0.f;
#pragma unroll 8
    for (int k = wid * 128; k < wid * 128 + 128; ++k) {
      float wv = W[(size_t)k * 3072 + col];
      a0 += silu_f(p.c[k]) * wv; a1 += silu_f(p.c[1024 + k]) * wv; a2 += silu_f(p.c_ctx[k]) * wv;
    }
    __syncthreads();
    sm[(wid * 3 + 0) * 64 + lane] = a0; sm[(wid * 3 + 1) * 64 + lane] = a1; sm[(wid * 3 + 2) * 64 + lane] = a2;
    __syncthreads();
    if (tid < 192) {
      int v = tid >> 6; float s = p.b_ada[l * 3072 + col];
      for (int w = 0; w < 8; ++w) s += sm[(w * 3 + v) * 64 + lane];
      mod[(l * 3 + v) * 3072 + col] = s;
    }
    __syncthreads();
  }
  for (int it = bid; it < (2 * TB) / 8; it += nb) {
    const int gr = it * 8 + wid, l = gr / TB, rr = gr - l * TB;
    const bool lat = rr < L; const int t = lat ? rr : rr - L; const int Lq = lat ? L : LC;
    float* em = sm + wid * 104; float* h1 = em + 40;
    __syncthreads();
    if (lane < 33) {
      float v;
      if (lane == 0) v = (float)t / (float)(Lq - 1);
      else {
        int bi = (lane - 1) & 15; float fr = 1e-4f + (float)bi * ((15.f - 1e-4f) / 15.f);
        float w = 6.283185307179586f * (float)t / (float)Lq;
        v = (lane <= 16) ? cosf(fr * w) : -sinf(fr * w);
      }
      em[lane] = v;
    }
    __syncthreads();
    {
      float a = p.f1_b[l * 64 + lane];
      for (int e = 0; e < 33; ++e) a += em[e] * p.f1_w[(l * 33 + e) * 64 + lane];
      h1[lane] = sinf(p.f1_freq[l * 64 + lane] * a);
    }
    __syncthreads();
    {
      float a = p.f2_b[l * 64 + lane];
      for (int i = 0; i < 64; ++i) a += h1[i] * p.f2_w[(l * 64 + i) * 64 + lane];
      float v = sinf(p.f2_freq[l * 64 + lane] * a);
      if (lat) ((float*)(p.ws + OFF_H2T))[((size_t)l * 64 + lane) * L + t] = v;
      else ((float*)(p.ws + OFF_H2C))[((size_t)l * 256 + t) * 64 + lane] = v;
    }
  }
  __syncthreads();
  {
    constexpr int T_IN = 16 * 249, T_BR = 8 * 32, T_OUT = 16 * 32, T_LAYER = T_IN + 3 * T_BR + T_OUT;
    float* tile = sm;
    for (int task = bid; task < 2 * T_LAYER; task += nb) {
      const int l = task / T_LAYER; int tt = task - l * T_LAYER;
      const float* src; u16* dst; int K, N, kt, ntile;
      char* wt = p.ws + OFF_WT + (size_t)l * WT_LAYER;
      if (tt < T_IN) { src = p.w_in + (size_t)l * 1024 * NIN; dst = (u16*)wt; K = 1024; N = NIN; kt = tt / 249; ntile = tt % 249; }
      else if (tt < T_IN + 3 * T_BR) {
        tt -= T_IN; int br = tt / T_BR; tt -= br * T_BR;
        src = (br == 0 ? p.w_g : (br == 1 ? p.w_a : p.w_h)) + (size_t)l * 512 * 1024; dst = (u16*)(wt + WT_IN + br * WT_BR);
        K = 512; N = 1024; kt = tt / 32; ntile = tt % 32;
      } else { tt -= T_IN + 3 * T_BR; src = p.w_o + (size_t)l * 1024 * 1024; dst = (u16*)(wt + WT_IN + 3 * WT_BR); K = 1024; N = 1024; kt = tt / 32; ntile = tt % 32; }
      const int k0 = kt * 64, n0 = ntile * 32;
#pragma unroll
      for (int i = 0; i < 4; ++i) { int kk = (tid >> 5) + 16 * i, nn = tid & 31; tile[kk * 33 + nn] = src[(size_t)(k0 + kk) * N + n0 + nn]; }
      __syncthreads();
#pragma unroll
      for (int i = 0; i < 4; ++i) { int nn = (tid >> 6) + 8 * i, kk = tid & 63; dst[(size_t)(n0 + nn) * K + k0 + kk] = f2bf(tile[kk * 33 + nn]); }
      __syncthreads();
    }
  }
}

DI void phase_norm(const Params& p, int l) {
  const int tid = threadIdx.x, lane = tid & 63, wid = tid >> 6;
  const float* mod = (const float*)(p.ws + OFF_MOD);
  u16* H = (u16*)(p.ws + OFF_H);
  for (int row = blockIdx.x * 8 + wid; row < R; row += gridDim.x * 8) {
    const float* src = xrow_in(p, l, row);
    const float* mv = mod + (l * 3 + modvec_of(row)) * 3072;
    float4 xv[4]; float ss = 0.f;
#pragma unroll
    for (int i = 0; i < 4; ++i) { xv[i] = *(const float4*)(src + (i * 64 + lane) * 4); ss += xv[i].x * xv[i].x + xv[i].y * xv[i].y + xv[i].z * xv[i].z + xv[i].w * xv[i].w; }
    ss = wave_sum(ss);
    const float rs = rsqrtf(ss * (1.f / 1024.f) + EPS);
#pragma unroll
    for (int i = 0; i < 4; ++i) {
      const int col = (i * 64 + lane) * 4;
      float4 sh = *(const float4*)(mv + col), sc = *(const float4*)(mv + 1024 + col);
      u32x2 o;
      o.x = pack2(xv[i].x * rs * (1.f + sc.x) + sh.x, xv[i].y * rs * (1.f + sc.y) + sh.y);
      o.y = pack2(xv[i].z * rs * (1.f + sc.z) + sh.z, xv[i].w * rs * (1.f + sc.w) + sh.w);
      *(u32x2*)(H + (size_t)row * 1024 + col) = o;
    }
  }
}

DI void phase_proj(const Params& p, int l, char* smem) {
  const int tid = threadIdx.x, lane = tid & 63, wid = tid >> 6, r = lane & 31, h = lane >> 5, wm = wid & 3, wn = wid >> 2;
  const u16* H = (const u16*)(p.ws + OFF_H);
  const u16* WT = (const u16*)(p.ws + OFF_WT + (size_t)l * WT_LAYER);
  u16* P = (u16*)(p.ws + OFF_P);
  u16* CT = (u16*)(p.ws + OFF_CT);
  u16* Tt = (u16*)smem;
  constexpr int LDE = 260;
  const int xcd = blockIdx.x & 7, nloc = gridDim.x >> 3;
  for (int q = blockIdx.x >> 3; q < 5 * 156; q += nloc) {
    const int g = q / 156, rem = q - g * 156, nt = rem >> 2, mt = (g * 4 + (rem & 3)) * 8 + xcd;
    if (mt >= 130) continue;
    const int m0 = mt * 256, n0 = nt * 128;
    f32x16 acc[2][2];
#pragma unroll
    for (int i = 0; i < 2; ++i) for (int j = 0; j < 2; ++j) acc[i][j] = zero16();
    ALoadN al{H + (size_t)m0 * 1024, 1024};
    gemm_tile<256, ALoadN, 4, 1024>(al, WT + (size_t)n0 * 1024, 1024, smem, acc);
    const int b = m0 / TB, tk0 = m0 - b * TB;
#pragma unroll
    for (int i = 0; i < 2; ++i)
#pragma unroll
      for (int j = 0; j < 2; ++j)
#pragma unroll
        for (int g4 = 0; g4 < 4; ++g4) {
          u32x2 o; o.x = pack2(acc[i][j][4 * g4], acc[i][j][4 * g4 + 1]); o.y = pack2(acc[i][j][4 * g4 + 2], acc[i][j][4 * g4 + 3]);
          *(u32x2*)(Tt + (wn * 64 + j * 32 + r) * LDE + wm * 64 + i * 32 + 8 * g4 + 4 * h) = o;
        }
    __syncthreads();
#pragma unroll 1
    for (int cg = 0; cg < 4; ++cg) {
      const int cb = n0 + cg * 32;
      if (cb >= 4896) continue;
      bool chan; int cm;
      if (cb < 512) { chan = false; cm = cb; }
      else if (cb < 1024) { chan = true; cm = CH_GV + cb - 512; }
      else if (cb < 2208) { chan = false; cm = cb - 512; }
      else if (cb < 2336) { chan = true; cm = CH_AV + cb - 2208; }
      else if (cb < 2848) { chan = false; cm = cb - 640; }
      else { chan = true; cm = cb - 2848; }
      if (chan) {
#pragma unroll
        for (int k = 0; k < 2; ++k) {
          const int idx = tid + NT * k, ch = idx >> 5, t8 = idx & 31;
          const u16* sp = Tt + (cg * 32 + ch) * LDE + t8 * 8;
          const u32x2 lo = *(const u32x2*)sp, hi = *(const u32x2*)(sp + 4);
          *(u32x4*)(CT + ((size_t)(cm + ch) * 2 + b) * TB + tk0 + t8 * 8) = u32x4{lo.x, lo.y, hi.x, hi.y};
        }
      } else {
#pragma unroll
        for (int k = 0; k < 2; ++k) {
          const int idx = tid + NT * k, row = idx >> 2, c8 = idx & 3;
          const u16* sp = Tt + (cg * 32 + c8 * 8) * LDE + row;
          u32x4 o;
          o.x = (unsigned)sp[0] | ((unsigned)sp[LDE] << 16); o.y = (unsigned)sp[2 * LDE] | ((unsigned)sp[3 * LDE] << 16);
          o.z = (unsigned)sp[4 * LDE] | ((unsigned)sp[5 * LDE] << 16); o.w = (unsigned)sp[6 * LDE] | ((unsigned)sp[7 * LDE] << 16);
          *(u32x4*)(P + (size_t)(m0 + row) * NP + cm + c8 * 8) = o;
        }
      }
    }
  }
}

DI void attn_prep(const Params& p, int l, int dry) {
  const int tid = threadIdx.x, lane = tid & 63, wid = tid >> 6;
  u16* P = (u16*)(p.ws + OFF_P);
  const float gq = pk(p, PK_QN)[l * 64 + lane], gk = pk(p, PK_KN)[l * 64 + lane];
  for (int row = blockIdx.x * 8 + wid; row < R; row += gridDim.x * 8) {
    u16* Pr = P + (size_t)row * NP;
    const int b = row / TB, tk = row - b * TB;
    float cs = 1.f, sn = 0.f;
    if (tk >= LC) {
      const int t = tk - LC, pi = lane >> 1;
      const float pos = (pi < 16) ? (float)(t >> 6) : (float)(t & 63);
      const float inv = powf(10000.f, -(float)(2 * (pi & 15)) / 32.f);
      sincosf(pos * inv, &sn, &cs);
    }
#pragma unroll
    for (int hd = 0; hd < 10; ++hd) {
      const int col = (hd < 8) ? PC_AQ + hd * 64 + lane : PC_AK + (hd - 8) * 64 + lane;
      float v = bf2f(Pr[col]);
      const float ss = wave_sum(v * v);
      v = v * rsqrtf(ss * (1.f / 64.f) + EPS) * (hd < 8 ? gq : gk);
      const float pv = __shfl_xor(v, 1);
      float o = (lane & 1) ? (pv * sn + v * cs) : (v * cs - pv * sn);
      if (hd < 8) o *= 0.125f * 1.4426950408889634f;
      if (!dry) Pr[col] = f2bf(o);
    }
  }
}

DI void fft_fwd(float2* X, int tid) {
#pragma unroll 1
  for (int h2 = 4096; h2 >= 1; h2 >>= 2) {
    const float inv4 = 0.25f / (float)h2;
#pragma unroll 2
    for (int i = 0; i < 8; ++i) {
      const int g = tid + NT * i, jp = g & (h2 - 1), base = ((g - jp) << 2) + jp;
      float2 e0 = X[base], e1 = X[base + h2], e2 = X[base + 2 * h2], e3 = X[base + 3 * h2];
      const float fr = (float)jp * inv4;
      const float2 T1 = make_float2(__builtin_amdgcn_cosf(fr), -__builtin_amdgcn_sinf(fr));
      const float2 T2 = cmul(T1, T1);
      float2 a0 = cadd(e0, e2), a2 = cmul(csub(e0, e2), T1);
      float2 a1 = cadd(e1, e3), d13 = cmul(csub(e1, e3), T1);
      float2 a3 = make_float2(d13.y, -d13.x);
      X[base] = cadd(a0, a1); X[base + h2] = cmul(csub(a0, a1), T2);
      X[base + 2 * h2] = cadd(a2, a3); X[base + 3 * h2] = cmul(csub(a2, a3), T2);
    }
    __syncthreads();
  }
}
DI void fft_inv(float2* X, int tid) {
#pragma unroll 1
  for (int h1 = 1; h1 <= 4096; h1 <<= 2) {
    const float inv4 = 0.25f / (float)h1;
#pragma unroll 2
    for (int i = 0; i < 8; ++i) {
      const int g = tid + NT * i, jp = g & (h1 - 1), base = ((g - jp) << 2) + jp;
      float2 e0 = X[base], e1 = X[base + h1], e2 = X[base + 2 * h1], e3 = X[base + 3 * h1];
      const float fr = (float)jp * inv4;
      const float2 V = make_float2(__builtin_amdgcn_cosf(fr), __builtin_amdgcn_sinf(fr));
      const float2 Wc = cmul(V, V);
      float2 t1 = cmul(e1, Wc), t3 = cmul(e3, Wc);
      float2 a0 = cadd(e0, t1), a1 = csub(e0, t1), a2 = cadd(e2, t3), a3 = csub(e2, t3);
      float2 u2 = cmul(a2, V), u3 = cmul(a3, V);
      u3 = make_float2(-u3.y, u3.x);
      X[base] = cadd(a0, u2); X[base + 2 * h1] = csub(a0, u2);
      X[base + h1] = cadd(a1, u3); X[base + 3 * h1] = csub(a1, u3);
    }
    __syncthreads();
  }
}
DI float sconv_at(const u16* src, int t, int len, float w0, float w1, float w2, float bb) {
  float ym = t > 0 ? bf2f(src[t - 1]) : 0.f, y0 = bf2f(src[t]), yp = t < len - 1 ? bf2f(src[t + 1]) : 0.f;
  return bb + w0 * ym + w1 * y0 + w2 * yp;
}
DI float hy_delta(int col) {
  const float A0 = -4.605170185988091f / 0.3f, A1 = -4.605170185988091f / 1.5f;
  return fabsf(A0 + (A1 - A0) * ((float)col / 2047.f));
}

DI void hyena_latent_task(const Params& p, int l, int c, char* smem, int dry) {
  float2* X = (float2*)smem;
  float* red = (float*)(smem + 131072);
  const int tid = threadIdx.x, lane = tid & 63, wid = tid >> 6;
  u16* CT = (u16*)(p.ws + OFF_CT);
  float2* FE = (float2*)(p.ws + OFF_FS + (size_t)blockIdx.x * 262144);
  float2* FO = FE + 16384;
  const float* h2T = (const float*)(p.ws + OFF_H2T) + (size_t)l * 64 * L;
  const float* f3w = pk(p, PK_F3) + (size_t)l * 64 * 2048;
  const float* cw = pk(p, PK_CW) + (size_t)l * 3 * 1536;
  const float* cbv = pk(p, PK_CB) + (size_t)l * 1536;
  const float vw0 = cw[c], vw1 = cw[1536 + c], vw2 = cw[3072 + c], vbb = cbv[c];
  const u16* v0 = CT + ((size_t)(CH_YU + c) * 2 + 0) * TB + LC;
  const u16* v1 = CT + ((size_t)(CH_YU + c) * 2 + 1) * TB + LC;
  u16* z10 = CT + ((size_t)(CH_YU + 512 + c) * 2 + 0) * TB + LC;
  u16* z11 = CT + ((size_t)(CH_YU + 512 + c) * 2 + 1) * TB + LC;
#pragma unroll 1
  for (int o = 0; o < 2; ++o) {
    const int cf = o * 1024 + c, cbk = cf + 512;
    float sf = 0.f, sb = 0.f;
    __syncthreads();
#ifdef PROBE_FFT
    fft_fwd(X, tid); fft_inv(X, tid);
#endif
#pragma unroll 1
    for (int half = 0; half < 2; ++half) {
      float af[16], ab[16];
#pragma unroll
      for (int i = 0; i < 16; ++i) { af[i] = 0.f; ab[i] = 0.f; }
#pragma unroll 1
      for (int j = 0; j < 64; j += 2) {
        const float wf0 = f3w[j * 2048 + cf], wb0 = f3w[j * 2048 + cbk], wf1 = f3w[(j + 1) * 2048 + cf], wb1 = f3w[(j + 1) * 2048 + cbk];
        const float* hrow = h2T + (size_t)j * L + tid + half * 16 * NT;
        float hv0[16], hv1[16];
#pragma unroll
        for (int i = 0; i < 16; ++i) { hv0[i] = hrow[NT * i]; hv1[i] = hrow[L + NT * i]; }
#pragma unroll
        for (int i = 0; i < 16; ++i) { af[i] += hv0[i] * wf0 + hv1[i] * wf1; ab[i] += hv0[i] * wb0 + hv1[i] * wb1; }
      }
      const float df = hy_delta(cf), db = hy_delta(cbk);
#pragma unroll
      for (int i = 0; i < 16; ++i) {
        const int t = tid + NT * (i + half * 16); const float tt = (float)t / (float)(L - 1);
        const float vf = af[i] * (__expf(-tt * df) + 0.05f), vb = ab[i] * (__expf(-tt * db) + 0.05f);
        sf += fabsf(vf); sb += fabsf(vb);
        X[t].x = vf;
        if (t >= 1) X[L - t].y = vb; else X[0].y = 0.f;
      }
    }
    sf = wave_sum(sf); sb = wave_sum(sb);
    if (lane == 0) { red[wid] = sf; red[8 + wid] = sb; }
    __syncthreads();
    float nf = 0.f, nbk = 0.f;
#pragma unroll
    for (int w = 0; w < 8; ++w) { nf += red[w]; nbk += red[8 + w]; }
    const float inv_f = 1.f / nf, inv_b = 1.f / nbk;
#pragma unroll 8
    for (int i = 0; i < 32; ++i) { const int n = tid + NT * i; const float2 s = X[n]; FO[n] = s; X[n] = make_float2(s.x * inv_f + s.y * inv_b, 0.f); }
    __syncthreads();
    fft_fwd(X, tid);
#pragma unroll 8
    for (int i = 0; i < 32; ++i) { const int n = tid + NT * i; FE[n] = X[n]; }
    __syncthreads();
#pragma unroll 8
    for (int i = 0; i < 32; ++i) {
      const int n = tid + NT * i; const float2 s = FO[n]; const float dd = s.x * inv_f - s.y * inv_b; const float fr = (float)n * (1.f / 32768.f);
      X[n] = make_float2(dd * __builtin_amdgcn_cosf(fr), -dd * __builtin_amdgcn_sinf(fr));
    }
    __syncthreads();
    fft_fwd(X, tid);
#pragma unroll 8
    for (int i = 0; i < 32; ++i) { const int n = tid + NT * i; FO[n] = X[n]; }
    __syncthreads();
#pragma unroll 8
    for (int i = 0; i < 32; ++i) {
      const int n = tid + NT * i;
      float2 zz;
      if (o == 0) { zz.x = sconv_at(v0, n, L, vw0, vw1, vw2, vbb); zz.y = sconv_at(v1, n, L, vw0, vw1, vw2, vbb); }
      else { zz.x = bf2f(z10[n]); zz.y = bf2f(z11[n]); }
      X[n] = zz;
    }
    __syncthreads();
    fft_fwd(X, tid);
#pragma unroll 8
    for (int i = 0; i < 32; ++i) { const int n = tid + NT * i; X[n] = cmul(X[n], FE[n]); }
    __syncthreads();
    fft_inv(X, tid);
#pragma unroll 8
    for (int i = 0; i < 32; ++i) { const int n = tid + NT * i; FE[n] = X[n]; }
    __syncthreads();
#pragma unroll 8
    for (int i = 0; i < 32; ++i) {
      const int n = tid + NT * i; const float fr = (float)n * (1.f / 32768.f);
      float2 zz;
      if (o == 0) { zz.x = sconv_at(v0, n, L, vw0, vw1, vw2, vbb); zz.y = sconv_at(v1, n, L, vw0, vw1, vw2, vbb); }
      else { zz.x = bf2f(z10[n]); zz.y = bf2f(z11[n]); }
      X[n] = cmul(zz, make_float2(__builtin_amdgcn_cosf(fr), -__builtin_amdgcn_sinf(fr)));
    }
    __syncthreads();
    fft_fwd(X, tid);
#pragma unroll 8
    for (int i = 0; i < 32; ++i) { const int n = tid + NT * i; X[n] = cmul(X[n], FO[n]); }
    __syncthreads();
    fft_inv(X, tid);
    {
      const int gch = CH_YU + 512 * (o + 1) + c;
      const float w0 = cw[gch], w1 = cw[1536 + gch], w2 = cw[3072 + gch], bb = cbv[gch];
      const u16* s0 = CT + ((size_t)gch * 2 + 0) * TB + LC;
      const u16* s1 = CT + ((size_t)gch * 2 + 1) * TB + LC;
      const float sk = pk(p, PK_SK)[(l * 2 + o) * 512 + c];
#pragma unroll 8
      for (int i = 0; i < 32; ++i) {
        const int n = tid + NT * i; const float fr = (float)n * (1.f / 32768.f);
        const float2 wb = cmul(X[n], make_float2(__builtin_amdgcn_cosf(fr), __builtin_amdgcn_sinf(fr)));
        const float2 A = FE[n];
        const float yr = (A.x + wb.x) * (1.f / 32768.f), yi = (A.y + wb.y) * (1.f / 32768.f);
        const float g0 = sconv_at(s0, n, L, w0, w1, w2, bb), g1 = sconv_at(s1, n, L, w0, w1, w2, bb);
        float2 zz;
        if (o == 0) { zz.x = sconv_at(v0, n, L, vw0, vw1, vw2, vbb); zz.y = sconv_at(v1, n, L, vw0, vw1, vw2, vbb); }
        else { zz.x = bf2f(z10[n]); zz.y = bf2f(z11[n]); }
        X[n] = make_float2(g0 * (yr + sk * zz.x), g1 * (yi + sk * zz.y));
      }
    }
    __syncthreads();
    if (o == 0) {
#pragma unroll 8
      for (int i = 0; i < 32; ++i) { const int n = tid + NT * i; const float2 zz = X[n]; if (!dry) { z10[n] = f2bf(zz.x); z11[n] = f2bf(zz.y); } }
    } else {
      u16* d0 = CT + ((size_t)(CH_YZ + c) * 2 + 0) * TB + LC;
      u16* d1 = CT + ((size_t)(CH_YZ + c) * 2 + 1) * TB + LC;
#pragma unroll 1
      for (int ib = 0; ib < 32; ib += 8) {
        u16 g0[8], g1[8];
#pragma unroll
        for (int i = 0; i < 8; ++i) { const int n = tid + NT * (ib + i); g0[i] = d0[n]; g1[i] = d1[n]; }
#pragma unroll
        for (int i = 0; i < 8; ++i) {
          const int n = tid + NT * (ib + i); const float2 zz = X[n];
          const u16 q0 = f2bf(zz.x * silu_f(bf2f(g0[i]))), q1 = f2bf(zz.y * silu_f(bf2f(g1[i])));
          if (!dry) { d0[n] = q0; d1[n] = q1; }
        }
      }
    }
    __syncthreads();
  }
}

DI void hyena_ctx_task(const Params& p, int l, int c, char* smem, int dry) {
  float* filt = (float*)smem;
  float* zs = filt + 1024;
  float* nrm = zs + 1024;
  const int tid = threadIdx.x, lane = tid & 63, wid = tid >> 6, t = tid & 255, hb = tid >> 8;
  u16* CT = (u16*)(p.ws + OFF_CT);
  const float* h2c = (const float*)(p.ws + OFF_H2C) + (size_t)l * 256 * 64;
  const float* f3w = pk(p, PK_F3) + (size_t)l * 64 * 2048;
  const float* cw = pk(p, PK_CW) + (size_t)l * 3 * 1536;
  const float* cbv = pk(p, PK_CB) + (size_t)l * 1536;
  __syncthreads();
  {
    const int cf = hb * 1024 + c, cbk = cf + 512;
    float a_f = 0.f, a_b = 0.f;
    for (int j = 0; j < 64; ++j) { const float hv = h2c[t * 64 + j]; a_f += hv * f3w[j * 2048 + cf]; a_b += hv * f3w[j * 2048 + cbk]; }
    const float tt = (float)t / 255.f;
    filt[(hb * 2 + 0) * 256 + t] = a_f * (__expf(-tt * hy_delta(cf)) + 0.05f);
    filt[(hb * 2 + 1) * 256 + t] = a_b * (__expf(-tt * hy_delta(cbk)) + 0.05f);
    const u16* src = CT + ((size_t)(CH_YU + c) * 2 + hb) * TB;
    zs[hb * 256 + t] = sconv_at(src, t, LC, cw[c], cw[1536 + c], cw[3072 + c], cbv[c]);
  }
  __syncthreads();
  if (wid < 4) {
    float s = 0.f;
    for (int k = 0; k < 4; ++k) s += fabsf(filt[wid * 256 + lane + 64 * k]);
    s = wave_sum(s);
    if (lane == 0) nrm[wid] = s;
  }
  __syncthreads();
  const int b = hb;
  for (int o = 0; o < 2; ++o) {
    const float inf_ = 1.f / nrm[o * 2], inb_ = 1.f / nrm[o * 2 + 1];
    const float* hf = filt + (o * 2) * 256; const float* hbk = filt + (o * 2 + 1) * 256;
    const float* zc = zs + (o & 1) * 512 + b * 256;
    float accf = 0.f, accb = 0.f;
    for (int s = 0; s <= t; ++s) accf += hf[t - s] * zc[s];
    for (int s = t + 1; s < 256; ++s) accb += hbk[s - t] * zc[s];
    const int gch = CH_YU + 512 * (o + 1) + c;
    const float gate = sconv_at(CT + ((size_t)gch * 2 + b) * TB, t, LC, cw[gch], cw[1536 + gch], cw[3072 + gch], cbv[gch]);
    const float zn = gate * (accf * inf_ + accb * inb_ + pk(p, PK_SK)[(l * 2 + o) * 512 + c] * zc[t]);
    zs[((o + 1) & 1) * 512 + b * 256 + t] = zn;
    __syncthreads();
  }
  {
    u16* d = CT + ((size_t)(CH_YZ + c) * 2 + b) * TB;
    const u16 q0 = f2bf(zs[b * 256 + t] * silu_f(bf2f(d[t])));
    if (!dry) d[t] = q0;
  }
  __syncthreads();
}

DI void gla_bcum(const Params& p, int l, int row0, int hh, int dir, float* gs, float* segs, float* was, float* as_) {
  const int tid = threadIdx.x;
  const u16* P = (const u16*)(p.ws + OFF_P);
  const float* wa = pk(p, dir ? PK_WAB : PK_WAF) + (size_t)l * 16 * 256 + hh * 64;
  const float* ba = pk(p, dir ? PK_BAB : PK_BAF) + l * 256 + hh * 64;
#pragma unroll
  for (int i = 0; i < 2; ++i) {
    const int idx = tid + NT * i;
    was[idx] = wa[(idx >> 6) * 256 + (idx & 63)];
    as_[(idx >> 4) * 17 + (idx & 15)] = bf2f(P[(size_t)(row0 + (idx >> 4)) * NP + PC_AF + dir * 16 + (idx & 15)]);
  }
  __syncthreads();
  {
    const int t = tid >> 3, d0 = (tid & 7) * 8;
    float lin[8];
#pragma unroll
    for (int e = 0; e < 8; ++e) lin[e] = ba[d0 + e];
#pragma unroll 2
    for (int rr = 0; rr < 16; ++rr) {
      const float av = as_[t * 17 + rr];
      const float4 w0 = *(const float4*)(was + rr * 64 + d0), w1 = *(const float4*)(was + rr * 64 + d0 + 4);
      lin[0] += av * w0.x; lin[1] += av * w0.y; lin[2] += av * w0.z; lin[3] += av * w0.w;
      lin[4] += av * w1.x; lin[5] += av * w1.y; lin[6] += av * w1.z; lin[7] += av * w1.w;
    }
#pragma unroll
    for (int e = 0; e < 8; ++e) gs[t * 65 + d0 + e] = (fminf(lin[e], 0.f) - log1pf(__expf(-fabsf(lin[e])))) * (1.f / 16.f);
  }
  __syncthreads();
  {
    const int d = tid & 63, seg = tid >> 6;
    float v[8]; float run = 0.f;
#pragma unroll
    for (int e = 0; e < 8; ++e) { const int tt = dir ? seg * 8 + 7 - e : seg * 8 + e; run += gs[tt * 65 + d]; v[e] = run; }
    segs[seg * 64 + d] = run;
    __syncthreads();
    float off = 0.f;
#pragma unroll
    for (int s = 0; s < 8; ++s) { const bool before = dir ? (s > seg) : (s < seg); if (before) off += segs[s * 64 + d]; }
#pragma unroll
    for (int e = 0; e < 8; ++e) { const int tt = dir ? seg * 8 + 7 - e : seg * 8 + e; gs[tt * 65 + d] = v[e] + off; }
  }
  __syncthreads();
}
DI int gla_tok0(int dir, int n) {
  if (n < 4) return (dir ? 3 - n : n) * 64;
  return LC + (dir ? 255 - (n - 4) : n - 4) * 64;
}
constexpr int G_GS = 0;
constexpr int G_SEG = G_GS + 64 * 65 * 4;
constexpr int G_QS = G_SEG + 8 * 64 * 4;
constexpr int G_KS = G_QS + 64 * LDT * 2;
constexpr int G_VT = G_KS + 64 * LDT * 2;
constexpr int G_ST = G_VT + 128 * LDT * 2;
constexpr int G_RED = G_ST + 128 * LDT * 2;
constexpr int G_WA = G_RED + 8 * 32 * 4;
constexpr int G_AS = G_WA + 16 * 64 * 4;

DI void gla_g1_task(const Params& p, int l, int chain, int n, char* smem) {
  const int tid = threadIdx.x, lane = tid & 63, wid = tid >> 6, r = lane & 31, h = lane >> 5;
  const int b = chain >> 3, hh = (chain >> 1) & 3, dir = chain & 1;
  const int tk0 = gla_tok0(dir, n), row0 = b * TB + tk0;
  float* gs = (float*)(smem + G_GS); float* segs = (float*)(smem + G_SEG);
  u16* kT = (u16*)(smem + G_KS); u16* vT = (u16*)(smem + G_VT);
  const u16* P = (const u16*)(p.ws + OFF_P);
  const u16* CT = (const u16*)(p.ws + OFF_CT);
  __syncthreads();
  gla_bcum(p, l, row0, hh, dir, gs, segs, (float*)(smem + G_WA), (float*)(smem + G_AS));
  const int tl = dir ? 0 : 63;
  {
    const int t = tid >> 3, d0 = (tid & 7) * 8;
    const u32x4 kv = *(const u32x4*)(P + (size_t)(row0 + t) * NP + PC_GK + hh * 64 + d0);
    const unsigned w[4] = {kv.x, kv.y, kv.z, kv.w};
#pragma unroll
    for (int e = 0; e < 8; ++e) {
      const float kx = (e & 1) ? bfhi(w[e >> 1]) : bflo(w[e >> 1]);
      kT[(d0 + e) * LDT + t] = f2bf(kx * __expf(gs[tl * 65 + d0 + e] - gs[t * 65 + d0 + e]));
    }
#pragma unroll
    for (int i = 0; i < 2; ++i) {
      const int q = tid + NT * i, v = q >> 3, cc = q & 7;
      *(u32x4*)(vT + v * LDT + cc * 8) = *(const u32x4*)(CT + ((size_t)(CH_GV + hh * 128 + v) * 2 + b) * TB + tk0 + cc * 8);
    }
    if (tid < 64) ((float*)(p.ws + OFF_GD))[((size_t)chain * NCK + n) * 64 + tid] = __expf(gs[tl * 65 + tid]);
  }
  __syncthreads();
  {
    const int vm = wid >> 1, dn = wid & 1;
    f32x16 acc = zero16();
#pragma unroll
    for (int s = 0; s < 4; ++s) {
      const bf16x8 a = *(const bf16x8*)(vT + (vm * 32 + r) * LDT + s * 16 + h * 8);
      const bf16x8 bb = *(const bf16x8*)(kT + (dn * 32 + r) * LDT + s * 16 + h * 8);
      acc = MFMA(a, bb, acc);
    }
    u16* GS = (u16*)(p.ws + OFF_GS) + ((size_t)chain * NCK + n) * 8192;
#pragma unroll
    for (int reg = 0; reg < 16; ++reg) GS[(vm * 32 + crow(reg, h)) * 64 + dn * 32 + r] = f2bf(acc[reg]);
  }
}
DI void gla_g2(const Params& p, int dry) {
  u16* GSb = (u16*)(p.ws + OFF_GS);
  const float* GD = (const float*)(p.ws + OFF_GD);
  for (int gi = blockIdx.x * NT + threadIdx.x; gi < 16 * 8192; gi += gridDim.x * NT) {
    const int chain = gi >> 13, e = gi & 8191, d = e & 63;
    u16* ptr = GSb + (size_t)chain * NCK * 8192 + e;
    const float* dec = GD + (size_t)chain * NCK * 64 + d;
    float S = 0.f;
#pragma unroll 1
    for (int n0 = 0; n0 < NCK; n0 += 10) {
      float ds[10], a[10];
#pragma unroll
      for (int k = 0; k < 10; ++k) { ds[k] = bf2f(ptr[(size_t)(n0 + k) * 8192]); a[k] = dec[(n0 + k) * 64]; }
#pragma unroll
      for (int k = 0; k < 10; ++k) { if (!dry) ptr[(size_t)(n0 + k) * 8192] = f2bf(S); S = a[k] * S + ds[k]; }
    }
  }
}
DI void gla_g3_task(const Params& p, int l, int b, int hh, int ci, char* smem, int dry) {
  const int tid = threadIdx.x, lane = tid & 63, wid = tid >> 6, r = lane & 31, h = lane >> 5;
  const int tk0 = ci * 64, row0 = b * TB + tk0;
  float* gs = (float*)(smem + G_GS); float* segs = (float*)(smem + G_SEG); float* red = (float*)(smem + G_RED);
  u16* qs = (u16*)(smem + G_QS); u16* ks = (u16*)(smem + G_KS); u16* vT = (u16*)(smem + G_VT); u16* sT = (u16*)(smem + G_ST);
  u16* P = (u16*)(p.ws + OFF_P);
  const u16* CT = (const u16*)(p.ws + OFF_CT);
  const int vm = wid >> 1, in = wid & 1;
  f32x16 o = zero16();
  __syncthreads();
#pragma unroll 1
  for (int dir = 0; dir < 2; ++dir) {
    gla_bcum(p, l, row0, hh, dir, gs, segs, (float*)(smem + G_WA), (float*)(smem + G_AS));
    const int chain = b * 8 + hh * 2 + dir;
    const int n = dir ? ((ci < 4) ? 3 - ci : 263 - ci) : ci;
    {
      const int t = tid >> 3, d0 = (tid & 7) * 8;
      const u32x4 qv = *(const u32x4*)(P + (size_t)(row0 + t) * NP + PC_GQ + hh * 64 + d0);
      const u32x4 kv = *(const u32x4*)(P + (size_t)(row0 + t) * NP + PC_GK + hh * 64 + d0);
      const unsigned qw[4] = {qv.x, qv.y, qv.z, qv.w}, kw[4] = {kv.x, kv.y, kv.z, kv.w};
      unsigned qo[4], ko[4];
#pragma unroll
      for (int e = 0; e < 4; ++e) {
        const float b0 = gs[t * 65 + d0 + 2 * e], b1 = gs[t * 65 + d0 + 2 * e + 1];
        qo[e] = pack2(bflo(qw[e]) * 0.125f * __expf(b0), bfhi(qw[e]) * 0.125f * __expf(b1));
        ko[e] = pack2(bflo(kw[e]) * __expf(-b0), bfhi(kw[e]) * __expf(-b1));
      }
      *(u32x4*)(qs + t * LDT + d0) = u32x4{qo[0], qo[1], qo[2], qo[3]};
      *(u32x4*)(ks + t * LDT + d0) = u32x4{ko[0], ko[1], ko[2], ko[3]};
      const u16* GS = (const u16*)(p.ws + OFF_GS) + ((size_t)chain * NCK + n) * 8192;
#pragma unroll
      for (int i = 0; i < 2; ++i) {
        const int q = tid + NT * i, v = q >> 3, cc = q & 7;
        *(u32x4*)(sT + v * LDT + cc * 8) = *(const u32x4*)(GS + v * 64 + cc * 8);
        if (dir == 0) *(u32x4*)(vT + v * LDT + cc * 8) = *(const u32x4*)(CT + ((size_t)(CH_GV + hh * 128 + v) * 2 + b) * TB + tk0 + cc * 8);
      }
    }
    __syncthreads();
    bf16x8 qf[4];
#pragma unroll
    for (int s = 0; s < 4; ++s) qf[s] = *(const bf16x8*)(qs + (in * 32 + r) * LDT + s * 16 + h * 8);
#pragma unroll
    for (int jt = 0; jt < 2; ++jt) {
      f32x16 at = zero16();
#pragma unroll
      for (int s = 0; s < 4; ++s) at = MFMA(*(const bf16x8*)(ks + (jt * 32 + r) * LDT + s * 16 + h * 8), qf[s], at);
      const int ii = in * 32 + r;
#pragma unroll
      for (int reg = 0; reg < 16; ++reg) {
        const int jj = jt * 32 + crow(reg, h);
        const bool keep = dir ? (jj >= ii) : (jj <= ii);
        if (!keep) at[reg] = 0.f;
      }
#pragma unroll
      for (int s = 0; s < 2; ++s) {
        const u16* vp = vT + (vm * 32 + r) * LDT + jt * 32 + 16 * s + 4 * h;
        o = MFMA(ld2x64(vp, vp + 8), pack8(at, s), o);
      }
    }
#pragma unroll
    for (int s = 0; s < 4; ++s) o = MFMA(*(const bf16x8*)(sT + (vm * 32 + r) * LDT + s * 16 + h * 8), qf[s], o);
    __syncthreads();
  }
  float ss = 0.f;
#pragma unroll
  for (int reg = 0; reg < 16; ++reg) ss += o[reg] * o[reg];
  ss += __shfl_xor(ss, 32);
  if (h == 0) red[wid * 32 + r] = ss;
  __syncthreads();
  float tot = 0.f;
#pragma unroll
  for (int m = 0; m < 4; ++m) tot += red[(m * 2 + in) * 32 + r];
  const float rs = rsqrtf(tot * (1.f / 128.f) + EPS);
  u16* zp = P + (size_t)(row0 + in * 32 + r) * NP + PC_GZ + hh * 128 + vm * 32 + 4 * h;
  const float* gn = pk(p, PK_GN) + l * 128 + vm * 32 + 4 * h;
#pragma unroll
  for (int g = 0; g < 4; ++g) {
    const u32x2 zz = *(const u32x2*)(zp + 8 * g);
    const float4 gw = *(const float4*)(gn + 8 * g);
    u32x2 out;
    out.x = pack2(o[4 * g] * rs * gw.x * silu_f(bflo(zz.x)), o[4 * g + 1] * rs * gw.y * silu_f(bfhi(zz.x)));
    out.y = pack2(o[4 * g + 2] * rs * gw.z * silu_f(bflo(zz.y)), o[4 * g + 3] * rs * gw.w * silu_f(bfhi(zz.y)));
    if (!dry) *(u32x2*)(zp + 8 * g) = out;
  }
}

DI void attn_item(const Params& p, int l, int b, int g, int qtk0, int ntiles, char* smem, int dry) {
  const int tid = threadIdx.x, lane = tid & 63, wid = tid >> 6, r = lane & 31, h = lane >> 5;
  u16* P = (u16*)(p.ws + OFF_P);
  const u16* CT = (const u16*)(p.ws + OFF_CT);
  u16* Ks = (u16*)smem;
  u16* Vs = Ks + 2 * 64 * LDT;
  const int hq = g * 4 + (wid >> 1);
  const size_t qrow = (size_t)b * TB + qtk0 + (wid & 1) * 32 + r;
  bf16x8 qf[4];
#pragma unroll
  for (int s = 0; s < 4; ++s) qf[s] = *(const bf16x8*)(P + qrow * NP + PC_AQ + hq * 64 + s * 16 + h * 8);
  f32x16 O[2] = {zero16(), zero16()};
  float m = -1e30f, lsum = 0.f;
  const int lr = tid >> 3, lc = (tid & 7) * 8;
  const u16* kg = P + ((size_t)b * TB + lr) * NP + PC_AK + g * 64 + lc;
  const u16* vg = CT + ((size_t)(CH_AV + g * 64 + lr) * 2 + b) * TB + lc;
  u32x4 rk = *(const u32x4*)kg, rv = *(const u32x4*)vg;
  __syncthreads();
  *(u32x4*)(Ks + lr * LDT + lc) = rk; *(u32x4*)(Vs + lr * LDT + lc) = rv;
  __syncthreads();
  float gqm = fabsf(pk(p, PK_QN)[l * 64 + lane]), gkm = fabsf(pk(p, PK_KN)[l * 64 + lane]);
#pragma unroll
  for (int o = 32; o >= 1; o >>= 1) { gqm = fmaxf(gqm, __shfl_xor(gqm, o)); gkm = fmaxf(gkm, __shfl_xor(gkm, o)); }
  const float mshift = 8.2f * 1.4426950408889634f * gqm * gkm;
  if (mshift <= 60.f) {
    f32x16 sinit;
#pragma unroll
    for (int i = 0; i < 16; ++i) sinit[i] = -mshift;
#pragma unroll 1
    for (int kt = 0; kt < ntiles; ++kt) {
      const int cur = kt & 1;
      if (kt + 1 < ntiles) { rk = *(const u32x4*)(kg + (size_t)(kt + 1) * 64 * NP); rv = *(const u32x4*)(vg + (kt + 1) * 64); }
      const u16* Kc = Ks + cur * 64 * LDT; const u16* Vc = Vs + cur * 64 * LDT;
      f32x16 st[2];
#pragma unroll
      for (int kk = 0; kk < 2; ++kk) {
        st[kk] = sinit;
#pragma unroll
        for (int s = 0; s < 4; ++s) st[kk] = MFMA(*(const bf16x8*)(Kc + (kk * 32 + r) * LDT + s * 16 + h * 8), qf[s], st[kk]);
      }
#pragma unroll
      for (int kk = 0; kk < 2; ++kk)
#pragma unroll
        for (int i = 0; i < 16; ++i) { const float pv = __builtin_amdgcn_exp2f(st[kk][i]); st[kk][i] = pv; lsum += pv; }
#pragma unroll
      for (int kk = 0; kk < 2; ++kk)
#pragma unroll
        for (int s = 0; s < 2; ++s) {
          const bf16x8 pb = pack8(st[kk], s);
#pragma unroll
          for (int mt = 0; mt < 2; ++mt) {
            const u16* vp = Vc + (mt * 32 + r) * LDT + kk * 32 + 16 * s + 4 * h;
            O[mt] = MFMA(ld2x64(vp, vp + 8), pb, O[mt]);
          }
        }
      if (kt + 1 < ntiles) { *(u32x4*)(Ks + (cur ^ 1) * 64 * LDT + lr * LDT + lc) = rk; *(u32x4*)(Vs + (cur ^ 1) * 64 * LDT + lr * LDT + lc) = rv; }
      __syncthreads();
    }
  } else {
#pragma unroll 1
    for (int kt = 0; kt < ntiles; ++kt) {
      const int cur = kt & 1;
      if (kt + 1 < ntiles) { rk = *(const u32x4*)(kg + (size_t)(kt + 1) * 64 * NP); rv = *(const u32x4*)(vg + (kt + 1) * 64); }
      const u16* Kc = Ks + cur * 64 * LDT; const u16* Vc = Vs + cur * 64 * LDT;
      f32x16 st[2];
#pragma unroll
      for (int kk = 0; kk < 2; ++kk) {
        st[kk] = zero16();
#pragma unroll
        for (int s = 0; s < 4; ++s) st[kk] = MFMA(*(const bf16x8*)(Kc + (kk * 32 + r) * LDT + s * 16 + h * 8), qf[s], st[kk]);
      }
      float mx = st[0][0];
#pragma unroll
      for (int i = 0; i < 16; ++i) { mx = fmaxf(mx, st[0][i]); mx = fmaxf(mx, st[1][i]); }
      mx = fmaxf(mx, __shfl_xor(mx, 32));
      const float mn = fmaxf(m, mx);
      const float alpha = exp2f(m - mn);
      m = mn;
      float rsum = 0.f;
#pragma unroll
      for (int kk = 0; kk < 2; ++kk)
#pragma unroll
        for (int i = 0; i < 16; ++i) { const float pv = exp2f(st[kk][i] - mn); st[kk][i] = pv; rsum += pv; }
      lsum = lsum * alpha + rsum;
#pragma unroll
      for (int mt = 0; mt < 2; ++mt)
#pragma unroll
        for (int i = 0; i < 16; ++i) O[mt][i] *= alpha;
#pragma unroll
      for (int kk = 0; kk < 2; ++kk)
#pragma unroll
        for (int s = 0; s < 2; ++s) {
          const bf16x8 pb = pack8(st[kk], s);
#pragma unroll
          for (int mt = 0; mt < 2; ++mt) {
            const u16* vp = Vc + (mt * 32 + r) * LDT + kk * 32 + 16 * s + 4 * h;
            O[mt] = MFMA(ld2x64(vp, vp + 8), pb, O[mt]);
          }
        }
      if (kt + 1 < ntiles) { *(u32x4*)(Ks + (cur ^ 1) * 64 * LDT + lr * LDT + lc) = rk; *(u32x4*)(Vs + (cur ^ 1) * 64 * LDT + lr * LDT + lc) = rv; }
      __syncthreads();
    }
  }
  lsum += __shfl_xor(lsum, 32);
  const float inv = 1.f / lsum;
  u16* op = P + qrow * NP + PC_AQ + hq * 64 + 4 * h;
  const u16* zp = P + qrow * NP + PC_AZ + hq * 64 + 4 * h;
#pragma unroll
  for (int mt = 0; mt < 2; ++mt)
#pragma unroll
    for (int gg = 0; gg < 4; ++gg) {
      const u32x2 zz = *(const u32x2*)(zp + mt * 32 + 8 * gg);
      u32x2 out;
      out.x = pack2(O[mt][4 * gg] * inv * silu_f(bflo(zz.x)), O[mt][4 * gg + 1] * inv * silu_f(bfhi(zz.x)));
      out.y = pack2(O[mt][4 * gg + 2] * inv * silu_f(bflo(zz.y)), O[mt][4 * gg + 3] * inv * silu_f(bfhi(zz.y)));
      if (!dry) *(u32x2*)(op + mt * 32 + 8 * gg) = out;
    }
}

DI void merge_accum(f32x16 (&ysum)[2], const f32x16 (&am)[1][2], const f32x16 (&ab)[1][2]) {
#pragma unroll
  for (int j = 0; j < 2; ++j)
#pragma unroll
    for (int i = 0; i < 16; ++i) ysum[j][i] += ab[0][j][i] / (1.f + __expf(-am[0][j][i]));
}
DI void phase_merge(const Params& p, int l, char* smem) {
  const int tid = threadIdx.x, lane = tid & 63, wid = tid >> 6, r = lane & 31, h = lane >> 5, wm = wid & 3, wn = wid >> 2;
  const int xcd = blockIdx.x & 7, nloc = gridDim.x >> 3;
  for (int q = blockIdx.x >> 3; q < 33 * 8; q += nloc) {
    const int mt = (q >> 3) * 8 + xcd, nt = q & 7, m0 = mt * 128, n0 = nt * 128;
    if (mt >= 260) continue;
    const int b = m0 / TB, tk0 = m0 - b * TB;
    if (l == 1 && tk0 < LC) continue;
    const u16* H = (const u16*)(p.ws + OFF_H) + (size_t)m0 * 1024;
    const u16* WM = (const u16*)(p.ws + OFF_WT + (size_t)l * WT_LAYER) + (size_t)(4896 + n0) * 1024;
    const u16* WBR = (const u16*)(p.ws + OFF_WT + (size_t)l * WT_LAYER + WT_IN) + (size_t)n0 * 512;
    f32x16 ysum[2] = {zero16(), zero16()};
#pragma unroll 1
    for (int br = 0; br < 2; ++br) {
      f32x16 am[1][2] = {{zero16(), zero16()}};
      ALoadN ah{H, 1024};
      gemm_tile<128, ALoadN, 2, 1024>(ah, WM + (size_t)br * 1024 * 1024, 1024, smem, am);
      f32x16 ab[1][2] = {{zero16(), zero16()}};
      ALoadN ay{(const u16*)(p.ws + OFF_P) + (size_t)m0 * NP + (br == 0 ? PC_GZ : PC_AQ), NP};
      gemm_tile<128, ALoadN, 2, 512>(ay, WBR + (size_t)br * 1024 * 512, 512, smem, ab);
      merge_accum(ysum, am, ab);
    }
    {
      f32x16 am[1][2] = {{zero16(), zero16()}};
      ALoadN ah{H, 1024};
      gemm_tile<128, ALoadN, 2, 1024>(ah, WM + (size_t)2 * 1024 * 1024, 1024, smem, am);
      f32x16 ab[1][2] = {{zero16(), zero16()}};
      ALoadT ay{(const u16*)(p.ws + OFF_CT) + ((size_t)CH_YZ * 2 + b) * TB + tk0, (size_t)2 * TB};
      gemm_tile<128, ALoadT, 2, 512>(ay, WBR + (size_t)2 * 1024 * 512, 512, smem, ab);
      merge_accum(ysum, am, ab);
    }
    u16* Y = (u16*)(p.ws + OFF_Y) + (size_t)(m0 + wm * 32 + 4 * h) * 1024 + n0 + wn * 64 + r;
#pragma unroll
    for (int j = 0; j < 2; ++j)
#pragma unroll
      for (int reg = 0; reg < 16; ++reg) Y[(size_t)((reg & 3) + 8 * (reg >> 2)) * 1024 + j * 32] = f2bf(ysum[j][reg]);
  }
}

DI void phase_out(const Params& p, int l, char* smem) {
  const int tid = threadIdx.x, lane = tid & 63, wid = tid >> 6, r = lane & 31, h = lane >> 5, wm = wid & 3, wn = wid >> 2;
  const u16* Yb = (const u16*)(p.ws + OFF_Y);
  const u16* WO = (const u16*)(p.ws + OFF_WT + (size_t)l * WT_LAYER + WT_IN + 3 * WT_BR);
  const float* mod = (const float*)(p.ws + OFF_MOD);
  const int xcd = blockIdx.x & 7, nloc = gridDim.x >> 3;
  auto tile_of = [&](int q, int& m0, int& n0) -> bool {
    const int mt = (q >> 3) * 8 + xcd; m0 = mt * 128; n0 = (q & 7) * 128;
    if (mt >= 260) return false;
    const int b = m0 / TB, tk0 = m0 - b * TB;
    return !(l == 1 && tk0 < LC);
  };
  auto next_q = [&](int q) -> int { int m, n; for (q += nloc; q < 33 * 8; q += nloc) if (tile_of(q, m, n)) return q; return -1; };
  int q = (int)(blockIdx.x >> 3) - nloc; q = next_q(q);
  if (q < 0) return;
  int m0, n0; tile_of(q, m0, n0);
  GemmRegs<128> gr;
  { ALoadN ay{Yb + (size_t)m0 * 1024, 1024}; gemm_prime<128>(gr, ay, WO + (size_t)n0 * 1024, 1024, smem); }
  while (true) {
    const int qn = next_q(q);
    int m0n = 0, n0n = 0; if (qn >= 0) tile_of(qn, m0n, n0n);
    const int b = m0 / TB, tk0 = m0 - b * TB;
    f32x16 acc[1][2] = {{zero16(), zero16()}};
    const ALoadN ay{Yb + (size_t)m0 * 1024, 1024}, ayn{Yb + (size_t)m0n * 1024, 1024};
    gemm_run<128, ALoadN, 4, 1024, ALoadN>(gr, ay, WO + (size_t)n0 * 1024, 1024, ayn, WO + (size_t)n0n * 1024, 1024, qn >= 0, smem, acc);
    const float* gv = mod + (l * 3 + (tk0 < LC ? 2 : b)) * 3072 + 2048;
    const float* xin = xrow_in(p, l, m0);
    float* xout = xrow_out(p, m0);
#pragma unroll
    for (int j = 0; j < 2; ++j) {
      const int col = n0 + wn * 64 + j * 32 + r;
      const float gate = gv[col];
#pragma unroll
      for (int reg = 0; reg < 16; ++reg) {
        const size_t off = (size_t)(wm * 32 + crow(reg, h)) * D + col;
        xout[off] = xin[off] + gate * acc[0][j][reg];
      }
    }
    if (qn < 0) break;
    q = qn; m0 = m0n; n0 = n0n;
  }
}

DI void phase_final(const Params& p) {
  const int tid = threadIdx.x, lane = tid & 63, wid = tid >> 6;
  for (int row = blockIdx.x * 8 + wid; row < NBATCH * L; row += gridDim.x * 8) {
    float* src = p.out + (size_t)row * D;
    float4 xv[4]; float ss = 0.f;
#pragma unroll
    for (int i = 0; i < 4; ++i) { xv[i] = *(const float4*)(src + (i * 64 + lane) * 4); ss += xv[i].x * xv[i].x + xv[i].y * xv[i].y + xv[i].z * xv[i].z + xv[i].w * xv[i].w; }
    ss = wave_sum(ss);
    const float rs = rsqrtf(ss * (1.f / 1024.f) + EPS);
#pragma unroll
    for (int i = 0; i < 4; ++i) {
      const int col = (i * 64 + lane) * 4;
      const float4 fw = *(const float4*)(pk(p, PK_FN) + col);
      *(float4*)(src + col) = make_float4(xv[i].x * rs * fw.x, xv[i].y * rs * fw.y, xv[i].z * rs * fw.z, xv[i].w * rs * fw.w);
    }
  }
}

DI void run_phase(const Params& p, int ph, char* smem, int dry = 0) {
  const int bid = blockIdx.x, nb = gridDim.x;
  if (ph == 0) { phase0(p, smem); return; }
  if (ph == 17) { phase_final(p); return; }
  const int l = (ph - 1) >> 3, s = (ph - 1) & 7;
  switch (s) {
    case 0: phase_norm(p, l); break;
    case 1: phase_proj(p, l, smem); break;
    case 2: {
      attn_prep(p, l, dry);
      if (l == 0) for (int c = bid; c < 512; c += nb) hyena_ctx_task(p, l, c, smem, dry);
      for (int c = bid; c < 512; c += nb) hyena_latent_task(p, l, c, smem, dry);
    } break;
    case 3: for (int t = bid; t < 16 * NCK; t += nb) gla_g1_task(p, l, t / NCK, t % NCK, smem); break;
    case 4: gla_g2(p, dry); break;
    case 5: {
      for (int it = bid; it < 1024; it += nb) { const int b = it >> 9, g = (it >> 8) & 1, qb = it & 255; attn_item(p, l, b, g, LC + qb * 64, NCK, smem, dry); }
      if (l == 0) for (int it = bid; it < 16; it += nb) { const int b = it >> 3, g = (it >> 2) & 1, qb = it & 3; attn_item(p, l, b, g, qb * 64, 4, smem, dry); }
      const int c0 = (l == 0) ? 0 : 4, per = NCK - c0;
      for (int t = bid; t < 8 * per; t += nb) { const int bh = t / per, ci = c0 + t % per; gla_g3_task(p, l, bh >> 2, bh & 3, ci, smem, dry); }
    } break;
    case 6: phase_merge(p, l, smem); break;
    case 7: phase_out(p, l, smem); break;
  }
}

#if MULTI_LAUNCH
template <int PH> __global__ void __launch_bounds__(NT) phase_kernel(Params p) {
  extern __shared__ __attribute__((aligned(16))) char smem[];
  run_phase(p, PH, smem);
}
template <int PH> static void launch_phase(const Params& p, int grid, hipStream_t stream) {
  static bool attr = false;
  if (!attr) { (void)hipFuncSetAttribute((const void*)phase_kernel<PH>, hipFuncAttributeMaxDynamicSharedMemorySize, LDS_BYTES); attr = true; }
  hipLaunchKernelGGL(phase_kernel<PH>, dim3(grid), dim3(NT), LDS_BYTES, stream, p);
}
#else
#ifndef PROBE_DUP
#define PROBE_DUP -1
#endif
#ifndef PROBE_DUP2
#define PROBE_DUP2 -1
#endif
#ifndef PROBE_DUP3
#define PROBE_DUP3 -1
#endif
__global__ void __launch_bounds__(NT) fwd_kernel(Params p) {
  extern __shared__ __attribute__((aligned(16))) char smem[];
  cg::grid_group grid = cg::this_grid();
#if PROBE_DUP >= 0
#define PHS(n) if ((n) == PROBE_DUP || (n) == PROBE_DUP2 || (n) == PROBE_DUP3) { run_phase(p, n, smem, p.phase_lo == 0 ? 1 : 0); grid.sync(); } run_phase(p, n, smem); grid.sync();
#else
#define PHS(n) run_phase(p, n, smem); grid.sync();
#endif
  PHS(0) PHS(1) PHS(2) PHS(3) PHS(4) PHS(5) PHS(6) PHS(7) PHS(8)
  PHS(9) PHS(10) PHS(11) PHS(12) PHS(13) PHS(14) PHS(15) PHS(16)
  run_phase(p, 17, smem);
}
#endif

extern "C" void kernel_launch(void* const* d_in, const int* in_sizes, int n_in, void* d_out, int out_size, void* d_ws, size_t ws_size,
                              hipStream_t stream) {
  static int grid = 0;
  if (grid == 0) {
    if (n_in != 29 || ws_size < WS_END) { fprintf(stderr, "kernel_launch: need 29 inputs and %zu B of workspace, got %d / %zu\n", (size_t)WS_END, n_in, ws_size); grid = -1; return; }
#if MULTI_LAUNCH
    grid = 256;
#else
    int dev = 0, cus = 0, per_cu = 0;
    (void)hipGetDevice(&dev);
    (void)hipDeviceGetAttribute(&cus, hipDeviceAttributeMultiprocessorCount, dev);
    if (hipFuncSetAttribute((const void*)fwd_kernel, hipFuncAttributeMaxDynamicSharedMemorySize, LDS_BYTES) != hipSuccess) { fprintf(stderr, "kernel_launch: hipFuncSetAttribute failed\n"); grid = -1; return; }
    (void)hipOccupancyMaxActiveBlocksPerMultiprocessor(&per_cu, (const void*)fwd_kernel, NT, LDS_BYTES);
    if (per_cu < 1) { fprintf(stderr, "kernel_launch: occupancy query returned %d\n", per_cu); per_cu = 1; }
    (void)hipGetLastError();
    grid = cus * per_cu;
    if (grid > 256) grid = 256;
#endif
  }
  if (grid < 0) return;
  Params p{};
  const float** pp = (const float**)&p;
  for (int i = 0; i < 29; ++i) pp[i] = (const float*)d_in[i];
  p.out = (float*)d_out; p.ws = (char*)d_ws;
  p.phase_lo = 0; p.phase_hi = 18;
#if MULTI_LAUNCH
  launch_phase<0>(p, grid, stream); launch_phase<1>(p, grid, stream); launch_phase<2>(p, grid, stream); launch_phase<3>(p, grid, stream);
  launch_phase<4>(p, grid, stream); launch_phase<5>(p, grid, stream); launch_phase<6>(p, grid, stream); launch_phase<7>(p, grid, stream);
  launch_phase<8>(p, grid, stream); launch_phase<9>(p, grid, stream); launch_phase<10>(p, grid, stream); launch_phase<11>(p, grid, stream);
  launch_phase<12>(p, grid, stream); launch_phase<13>(p, grid, stream); launch_phase<14>(p, grid, stream); launch_phase<15>(p, grid, stream);
  launch_phase<16>(p, grid, stream); launch_phase<17>(p, grid, stream);
#else
  void* args[] = {&p};
  hipError_t e = hipLaunchCooperativeKernel((const void*)fwd_kernel, dim3(grid), dim3(NT), args, LDS_BYTES, stream);
  if (e != hipSuccess) fprintf(stderr, "kernel_launch: cooperative launch failed: %s (grid %d)\n", hipGetErrorString(e), grid);
#endif
}
```

```cpp
#include <hip/hip_runtime.h>
#include <hip/hip_cooperative_groups.h>
#include <cstdio>
namespace cg = cooperative_groups;

typedef unsigned short u16;
typedef __attribute__((ext_vector_type(8))) short bf16x8;
typedef __attribute__((ext_vector_type(16))) float f32x16;
typedef __attribute__((ext_vector_type(4))) unsigned u32x4;
typedef __attribute__((ext_vector_type(2))) unsigned u32x2;
#define DI __device__ __forceinline__
#define MFMA(a, b, c) __builtin_amdgcn_mfma_f32_32x32x16_bf16((a), (b), (c), 0, 0, 0)

#ifndef MULTI_LAUNCH
#define MULTI_LAUNCH 0
#endif

constexpr int D = 1024, NBATCH = 2, L = 16384, LC = 256, TB = L + LC, R = NBATCH * TB;
constexpr int NIN = 7968;
constexpr int NP = 2208;
constexpr int NCH = 2688;
constexpr int PC_GQ = 0, PC_GK = 256, PC_GZ = 512, PC_AF = 1024, PC_AQ = 1056, PC_AK = 1568, PC_AZ = 1696;
constexpr int CH_YU = 0, CH_YZ = 1536, CH_GV = 2048, CH_AV = 2560;
constexpr int NCK = 260;
constexpr float EPS = 1e-6f;
constexpr int NT = 512;
constexpr int LDT = 72;

constexpr size_t OFF_P = 0;
constexpr size_t OFF_CT = OFF_P + (size_t)R * NP * 2;
constexpr size_t OFF_H = OFF_CT + (size_t)NCH * 2 * TB * 2;
constexpr size_t OFF_FS = OFF_H + (size_t)R * 1024 * 2;
constexpr size_t OFF_WT = OFF_FS + (size_t)256 * 262144;
constexpr size_t WT_IN = (size_t)NIN * 1024 * 2, WT_BR = (size_t)1024 * 512 * 2, WT_OUT = (size_t)1024 * 1024 * 2;
constexpr size_t WT_LAYER = WT_IN + 3 * WT_BR + WT_OUT;
constexpr size_t OFF_H2T = OFF_WT + 2 * WT_LAYER;
constexpr size_t OFF_H2C = OFF_H2T + (size_t)2 * 64 * L * 4;
constexpr size_t OFF_MOD = OFF_H2C + (size_t)2 * 256 * 64 * 4;
constexpr size_t OFF_CTX1 = OFF_MOD + (size_t)2 * 3 * 3072 * 4;
constexpr size_t OFF_GD = OFF_CTX1 + (size_t)512 * 1024 * 4;
constexpr size_t OFF_PK = OFF_GD + (size_t)16 * NCK * 64 * 4;
constexpr int PK_WAF = 0, PK_BAF = 8192, PK_WAB = 8704, PK_BAB = 16896, PK_GN = 17408, PK_QN = 17664, PK_KN = 17792, PK_CW = 17920,
              PK_CB = 27136, PK_SK = 30208, PK_FN = 32256, PK_F3 = 33280, PK_END = 33280 + 262144;
constexpr size_t WS_END = OFF_PK + (size_t)PK_END * 4;
constexpr size_t OFF_GS = OFF_CT;
constexpr size_t OFF_Y = OFF_CT;
static_assert((size_t)16 * NCK * 8192 * 2 <= (size_t)1536 * 2 * TB * 2, "alias");
static_assert((size_t)R * 1024 * 2 <= (size_t)1536 * 2 * TB * 2, "alias");

constexpr int LDS_BYTES = 131072 + 512;

struct Params {
  const float *x, *c, *ctx, *c_ctx, *w_ada, *b_ada, *w_in, *wa_f, *ba_f, *wa_b, *ba_b, *gla_norm, *qnorm, *knorm,
      *conv_w, *conv_b, *f1_w, *f1_b, *f1_freq, *f2_w, *f2_b, *f2_freq, *f3_w, *skip, *w_g, *w_a, *w_h, *w_o, *final_norm;
  float* out;
  char* ws;
  long long phase_lo, phase_hi;
};

typedef __attribute__((ext_vector_type(2))) float f32x2v;
typedef __attribute__((ext_vector_type(2))) __bf16 bf16x2v;
DI int my_tid() {
  int t = (int)threadIdx.x;
  asm volatile("" : "+v"(t));
  __builtin_assume(t >= 0 && t < NT);
  return t;
}
DI u16 f2bf(float x) { return __builtin_bit_cast(u16, (__bf16)x); }
DI float bf2f(u16 v) { return __uint_as_float(((unsigned)v) << 16); }
DI unsigned pack2(float a, float b) { f32x2v v = {a, b}; return __builtin_bit_cast(unsigned, __builtin_convertvector(v, bf16x2v)); }
DI float bflo(unsigned u) { return __uint_as_float(u << 16); }
DI float bfhi(unsigned u) { return __uint_as_float(u & 0xffff0000u); }
DI float silu_f(float x) { return x / (1.f + __expf(-x)); }
DI float wave_sum(float v) {
#pragma unroll
  for (int o = 32; o >= 1; o >>= 1) v += __shfl_xor(v, o);
  return v;
}
DI int crow(int reg, int h) { return (reg & 3) + 8 * (reg >> 2) + 4 * h; }
DI f32x16 zero16() { f32x16 z; for (int i = 0; i < 16; ++i) z[i] = 0.f; return z; }
DI bf16x8 pack8(const f32x16& x, int s) {
  u32x4 u;
  u.x = pack2(x[8 * s + 0], x[8 * s + 1]); u.y = pack2(x[8 * s + 2], x[8 * s + 3]);
  u.z = pack2(x[8 * s + 4], x[8 * s + 5]); u.w = pack2(x[8 * s + 6], x[8 * s + 7]);
  return __builtin_bit_cast(bf16x8, u);
}
DI bf16x8 ld2x64(const u16* p0, const u16* p1) {
  u32x2 a = *(const u32x2*)p0, b = *(const u32x2*)p1;
  u32x4 u; u.x = a.x; u.y = a.y; u.z = b.x; u.w = b.y;
  return __builtin_bit_cast(bf16x8, u);
}
DI float2 cmul(float2 a, float2 b) { return make_float2(a.x * b.x - a.y * b.y, a.x * b.y + a.y * b.x); }
DI float2 cadd(float2 a, float2 b) { return make_float2(a.x + b.x, a.y + b.y); }
DI float2 csub(float2 a, float2 b) { return make_float2(a.x - b.x, a.y - b.y); }

DI const float* xrow_in(const Params& p, int layer, int row) {
  int b = row / TB, tk = row - b * TB;
  if (tk < LC) return (layer == 0 ? p.ctx : (const float*)(p.ws + OFF_CTX1)) + (size_t)(b * LC + tk) * D;
  return (layer == 0 ? p.x : (const float*)p.out) + (size_t)(b * L + tk - LC) * D;
}
DI float* xrow_out(const Params& p, int row) {
  int b = row / TB, tk = row - b * TB;
  if (tk < LC) return (float*)(p.ws + OFF_CTX1) + (size_t)(b * LC + tk) * D;
  return p.out + (size_t)(b * L + tk - LC) * D;
}
DI const float* pk(const Params& p, int off) { return (const float*)(p.ws + OFF_PK) + off; }
DI int modvec_of(int row) { int b = row / TB, tk = row - b * TB; return tk < LC ? 2 : b; }

struct ALoadN {
  const u16* A; int lda;
  template <int BM> DI void fetch(u32x4 (&r)[BM / 64], int k0, int tid) const {
#pragma unroll
    for (int i = 0; i < BM / 64; ++i) { const int q = tid + NT * i; const unsigned off = (unsigned)((q >> 3) * lda + (q & 7) * 8); r[i] = *(const u32x4*)(A + off + k0); }
  }
  template <int BM> DI void commit(const u32x4 (&r)[BM / 64], u16* As, int tid) const {
#pragma unroll
    for (int i = 0; i < BM / 64; ++i) { int q = tid + NT * i; *(u32x4*)(As + (q >> 3) * LDT + (q & 7) * 8) = r[i]; }
  }
};
struct ALoadT {
  const u16* A; size_t chs;
  template <int BM> DI void fetch(u32x4 (&r)[BM / 64], int k0, int tid) const {
#pragma unroll
    for (int i = 0; i < 2; ++i) { const int q = tid + NT * i; const unsigned off = (unsigned)((q >> 4) * (int)chs + (q & 15) * 8); r[i] = *(const u32x4*)(A + off + (unsigned)(k0 * (int)chs)); }
  }
  template <int BM> DI void commit(const u32x4 (&r)[BM / 64], u16* As, int tid) const {
#pragma unroll
    for (int i = 0; i < 2; ++i) {
      int q = tid + NT * i; int ch = q >> 4, t0 = (q & 15) * 8;
      unsigned w[4] = {r[i].x, r[i].y, r[i].z, r[i].w};
#pragma unroll
      for (int e = 0; e < 4; ++e) { As[(t0 + 2 * e) * LDT + ch] = (u16)(w[e] & 0xffffu); As[(t0 + 2 * e + 1) * LDT + ch] = (u16)(w[e] >> 16); }
    }
  }
};

template <int BM, int KSU>
DI void gemm_compute(const u16* Ac, const u16* Bc, int wm, int wn, int r, int h, f32x16 (&acc)[BM / 128][2]) {
#pragma unroll KSU
  for (int ks = 0; ks < 4; ++ks) {
    bf16x8 a[BM / 128], b[2];
#pragma unroll
    for (int i = 0; i < BM / 128; ++i) a[i] = *(const bf16x8*)(Ac + (wm * (BM / 4) + i * 32 + r) * LDT + ks * 16 + h * 8);
#pragma unroll
    for (int j = 0; j < 2; ++j) b[j] = *(const bf16x8*)(Bc + (wn * 64 + j * 32 + r) * LDT + ks * 16 + h * 8);
#pragma unroll
    for (int i = 0; i < BM / 128; ++i)
#pragma unroll
      for (int j = 0; j < 2; ++j) acc[i][j] = MFMA(a[i], b[j], acc[i][j]);
  }
}
DI void fetch_b(u32x4 (&rb)[2], const u16* Bt, int ldb, int k0, int tid) {
#pragma unroll
  for (int i = 0; i < 2; ++i) { const int q = tid + NT * i; const unsigned off = (unsigned)((q >> 3) * ldb + (q & 7) * 8); rb[i] = *(const u32x4*)(Bt + off + k0); }
}
DI void commit_b(const u32x4 (&rb)[2], u16* Bs, int tid) {
#pragma unroll
  for (int i = 0; i < 2; ++i) { int q = tid + NT * i; *(u32x4*)(Bs + (q >> 3) * LDT + (q & 7) * 8) = rb[i]; }
}
template <int BM> struct GemmRegs { u32x4 ra0[BM / 64], rb0[2], ra1[BM / 64], rb1[2]; };
#define GFENCE asm volatile("" ::: "memory")
template <int BM, class AL>
DI void gemm_prime(GemmRegs<BM>& g, const AL& al, const u16* __restrict__ Bt, int ldb, char* smem) {
  u16* As0 = (u16*)smem;
  u16* Bs0 = As0 + 2 * BM * LDT;
  const int tid = my_tid();
  al.template fetch<BM>(g.ra0, 0, tid); fetch_b(g.rb0, Bt, ldb, 0, tid); GFENCE;
  al.template fetch<BM>(g.ra1, 64, tid); fetch_b(g.rb1, Bt, ldb, 64, tid); GFENCE;
  __syncthreads();
  al.template commit<BM>(g.ra0, As0, tid); commit_b(g.rb0, Bs0, tid);
  __syncthreads();
  al.template fetch<BM>(g.ra0, 128, tid); fetch_b(g.rb0, Bt, ldb, 128, tid); GFENCE;
}
template <int BM, class AL, int KSU, int K, class ALN>
DI void gemm_run(GemmRegs<BM>& g, const AL& al, const u16* __restrict__ Bt, int ldb, const ALN& aln, const u16* __restrict__ Btn, int ldbn,
                 bool hasnext, char* smem, f32x16 (&acc)[BM / 128][2]) {
  u16* As0 = (u16*)smem;
  u16* As1 = As0 + BM * LDT;
  u16* Bs0 = As0 + 2 * BM * LDT;
  u16* Bs1 = Bs0 + 128 * LDT;
  const int tid = my_tid(), lane = tid & 63, wid = tid >> 6, r = lane & 31, h = lane >> 5;
  const int wm = wid & 3, wn = wid >> 2;
  constexpr int KT = K >> 6;
#pragma unroll
  for (int kt = 0; kt < KT; kt += 2) {
    al.template commit<BM>(g.ra1, As1, tid); commit_b(g.rb1, Bs1, tid);
    GFENCE;
    if (kt + 3 < KT) { al.template fetch<BM>(g.ra1, (kt + 3) * 64, tid); fetch_b(g.rb1, Bt, ldb, (kt + 3) * 64, tid); GFENCE; }
    else if (hasnext) { aln.template fetch<BM>(g.ra1, (kt + 3 - KT) * 64, tid); fetch_b(g.rb1, Btn, ldbn, (kt + 3 - KT) * 64, tid); GFENCE; }
    gemm_compute<BM, KSU>(As0, Bs0, wm, wn, r, h, acc);
    __syncthreads();
    if (kt + 2 < KT) { al.template commit<BM>(g.ra0, As0, tid); commit_b(g.rb0, Bs0, tid); GFENCE; }
    else if (hasnext) { aln.template commit<BM>(g.ra0, As0, tid); commit_b(g.rb0, Bs0, tid); GFENCE; }
    if (kt + 4 < KT) { al.template fetch<BM>(g.ra0, (kt + 4) * 64, tid); fetch_b(g.rb0, Bt, ldb, (kt + 4) * 64, tid); GFENCE; }
    else if (hasnext) { aln.template fetch<BM>(g.ra0, (kt + 4 - KT) * 64, tid); fetch_b(g.rb0, Btn, ldbn, (kt + 4 - KT) * 64, tid); GFENCE; }
    gemm_compute<BM, KSU>(As1, Bs1, wm, wn, r, h, acc);
    __syncthreads();
  }
}

template <int BM, class AL, int KSU = 4, int K = 1024>
DI void gemm_tile(const AL& al, const u16* __restrict__ Bt, int ldb, char* smem, f32x16 (&acc)[BM / 128][2]) {
  GemmRegs<BM> g;
  gemm_prime<BM>(g, al, Bt, ldb, smem);
  gemm_run<BM, AL, KSU, K, AL>(g, al, Bt, ldb, al, Bt, ldb, false, smem, acc);
}

DI void phase0(const Params& p, char* smem) {
  const int tid = my_tid(), lane = tid & 63, wid = tid >> 6, bid = blockIdx.x, nb = gridDim.x;
  float* sm = (float*)smem;
  {
    float* PKW = (float*)(p.ws + OFF_PK);
    const int gt = bid * NT + tid, gn = nb * NT;
#define PKCP(src, off, cnt) for (int i = gt; i < (cnt); i += gn) PKW[(off) + i] = (src)[i];
    PKCP(p.wa_f, PK_WAF, 8192) PKCP(p.ba_f, PK_BAF, 512) PKCP(p.wa_b, PK_WAB, 8192) PKCP(p.ba_b, PK_BAB, 512)
    PKCP(p.gla_norm, PK_GN, 256) PKCP(p.qnorm, PK_QN, 128) PKCP(p.knorm, PK_KN, 128) PKCP(p.conv_w, PK_CW, 9216)
    PKCP(p.conv_b, PK_CB, 3072) PKCP(p.skip, PK_SK, 2048) PKCP(p.final_norm, PK_FN, 1024) PKCP(p.f3_w, PK_F3, 262144)
#undef PKCP
  }
  float* mod = (float*)(p.ws + OFF_MOD);
  for (int task = bid; task < 96; task += nb) {
    const int l = task / 48, cb = task % 48, col = cb * 64 + lane;
    const float* W = p.w_ada + (size_t)l * 1024 * 3072;
    float a0 = 0.f, a1 = 0.f, a2 = 0.f;
#pragma unroll 8
    for (int k = wid * 128; k < wid * 128 + 128; ++k) {
      float wv = W[(size_t)k * 3072 + col];
      a0 += silu_f(p.c[k]) * wv; a1 += silu_f(p.c[1024 + k]) * wv; a2 += silu_f(p.c_ctx[k]) * wv;
    }
    __syncthreads();
    sm[(wid * 3 + 0) * 64 + lane] = a0; sm[(wid * 3 + 1) * 64 + lane] = a1; sm[(wid * 3 + 2) * 64 + lane] = a2;
    __syncthreads();
    if (tid < 192) {
      int v = tid >> 6; float s = p.b_ada[l * 3072 + col];
      for (int w = 0; w < 8; ++w) s += sm[(w * 3 + v) * 64 + lane];
      mod[(l * 3 + v) * 3072 + col] = s;
    }
    __syncthreads();
  }
  for (int it = bid; it < (2 * TB) / 8; it += nb) {
    const int gr = it * 8 + wid, l = gr / TB, rr = gr - l * TB;
    const bool lat = rr < L; const int t = lat ? rr : rr - L; const int Lq = lat ? L : LC;
    float* em = sm + wid * 104; float* h1 = em + 40;
    __syncthreads();
    if (lane < 33) {
      float v;
      if (lane == 0) v = (float)t / (float)(Lq - 1);
      else {
        int bi = (lane - 1) & 15; float fr = 1e-4f + (float)bi * ((15.f - 1e-4f) / 15.f);
        float w = 6.283185307179586f * (float)t / (float)Lq;
        v = (lane <= 16) ? cosf(fr * w) : -sinf(fr * w);
      }
      em[lane] = v;
    }
    __syncthreads();
    {
      float a = p.f1_b[l * 64 + lane];
      for (int e = 0; e < 33; ++e) a += em[e] * p.f1_w[(l * 33 + e) * 64 + lane];
      h1[lane] = sinf(p.f1_freq[l * 64 + lane] * a);
    }
    __syncthreads();
    {
      float a = p.f2_b[l * 64 + lane];
      for (int i = 0; i < 64; ++i) a += h1[i] * p.f2_w[(l * 64 + i) * 64 + lane];
      float v = sinf(p.f2_freq[l * 64 + lane] * a);
      if (lat) ((float*)(p.ws + OFF_H2T))[((size_t)l * 64 + lane) * L + t] = v;
      else ((float*)(p.ws + OFF_H2C))[((size_t)l * 256 + t) * 64 + lane] = v;
    }
  }
  __syncthreads();
  {
    constexpr int T_IN = 16 * 249, T_BR = 8 * 32, T_OUT = 16 * 32, T_LAYER = T_IN + 3 * T_BR + T_OUT;
    float* tile = sm;
    for (int task = bid; task < 2 * T_LAYER; task += nb) {
      const int l = task / T_LAYER; int tt = task - l * T_LAYER;
      const float* src; u16* dst; int K, N, kt, ntile;
      char* wt = p.ws + OFF_WT + (size_t)l * WT_LAYER;
      if (tt < T_IN) { src = p.w_in + (size_t)l * 1024 * NIN; dst = (u16*)wt; K = 1024; N = NIN; kt = tt / 249; ntile = tt % 249; }
      else if (tt < T_IN + 3 * T_BR) {
        tt -= T_IN; int br = tt / T_BR; tt -= br * T_BR;
        src = (br == 0 ? p.w_g : (br == 1 ? p.w_a : p.w_h)) + (size_t)l * 512 * 1024; dst = (u16*)(wt + WT_IN + br * WT_BR);
        K = 512; N = 1024; kt = tt / 32; ntile = tt % 32;
      } else { tt -= T_IN + 3 * T_BR; src = p.w_o + (size_t)l * 1024 * 1024; dst = (u16*)(wt + WT_IN + 3 * WT_BR); K = 1024; N = 1024; kt = tt / 32; ntile = tt % 32; }
      const int k0 = kt * 64, n0 = ntile * 32;
#pragma unroll
      for (int i = 0; i < 4; ++i) { int kk = (tid >> 5) + 16 * i, nn = tid & 31; tile[kk * 33 + nn] = src[(size_t)(k0 + kk) * N + n0 + nn]; }
      __syncthreads();
#pragma unroll
      for (int i = 0; i < 4; ++i) { int nn = (tid >> 6) + 8 * i, kk = tid & 63; dst[(size_t)(n0 + nn) * K + k0 + kk] = f2bf(tile[kk * 33 + nn]); }
      __syncthreads();
    }
  }
}

DI void phase_norm(const Params& p, int l) {
  const int tid = my_tid(), lane = tid & 63, wid = tid >> 6;
  const float* mod = (const float*)(p.ws + OFF_MOD);
  u16* H = (u16*)(p.ws + OFF_H);
  for (int row = blockIdx.x * 8 + wid; row < R; row += gridDim.x * 8) {
    const float* src = xrow_in(p, l, row);
    const float* mv = mod + (l * 3 + modvec_of(row)) * 3072;
    float4 xv[4]; float ss = 0.f;
#pragma unroll
    for (int i = 0; i < 4; ++i) { xv[i] = *(const float4*)(src + (i * 64 + lane) * 4); ss += xv[i].x * xv[i].x + xv[i].y * xv[i].y + xv[i].z * xv[i].z + xv[i].w * xv[i].w; }
    ss = wave_sum(ss);
    const float rs = rsqrtf(ss * (1.f / 1024.f) + EPS);
#pragma unroll
    for (int i = 0; i < 4; ++i) {
      const int col = (i * 64 + lane) * 4;
      float4 sh = *(const float4*)(mv + col), sc = *(const float4*)(mv + 1024 + col);
      u32x2 o;
      o.x = pack2(xv[i].x * rs * (1.f + sc.x) + sh.x, xv[i].y * rs * (1.f + sc.y) + sh.y);
      o.y = pack2(xv[i].z * rs * (1.f + sc.z) + sh.z, xv[i].w * rs * (1.f + sc.w) + sh.w);
      *(u32x2*)(H + (size_t)row * 1024 + col) = o;
    }
  }
}

DI void phase_proj(const Params& p, int l, char* smem) {
  const int tid = my_tid(), lane = tid & 63, wid = tid >> 6, r = lane & 31, h = lane >> 5, wm = wid & 3, wn = wid >> 2;
  const u16* H = (const u16*)(p.ws + OFF_H);
  const u16* WT = (const u16*)(p.ws + OFF_WT + (size_t)l * WT_LAYER);
  u16* P = (u16*)(p.ws + OFF_P);
  u16* CT = (u16*)(p.ws + OFF_CT);
  u16* Tt = (u16*)smem;
  constexpr int LDE = 260;
  const int xcd = blockIdx.x & 7, nloc = gridDim.x >> 3;
  for (int q = blockIdx.x >> 3; q < 5 * 156; q += nloc) {
    const int g = q / 156, rem = q - g * 156, nt = rem >> 2, mt = (g * 4 + (rem & 3)) * 8 + xcd;
    if (mt >= 130) continue;
    const int m0 = mt * 256, n0 = nt * 128;
    f32x16 acc[2][2];
#pragma unroll
    for (int i = 0; i < 2; ++i) for (int j = 0; j < 2; ++j) acc[i][j] = zero16();
    ALoadN al{H + (size_t)m0 * 1024, 1024};
    gemm_tile<256, ALoadN, 4, 1024>(al, WT + (size_t)n0 * 1024, 1024, smem, acc);
    const int b = m0 / TB, tk0 = m0 - b * TB;
#pragma unroll
    for (int i = 0; i < 2; ++i)
#pragma unroll
      for (int j = 0; j < 2; ++j)
#pragma unroll
        for (int g4 = 0; g4 < 4; ++g4) {
          u32x2 o; o.x = pack2(acc[i][j][4 * g4], acc[i][j][4 * g4 + 1]); o.y = pack2(acc[i][j][4 * g4 + 2], acc[i][j][4 * g4 + 3]);
          *(u32x2*)(Tt + (wn * 64 + j * 32 + r) * LDE + wm * 64 + i * 32 + 8 * g4 + 4 * h) = o;
        }
    __syncthreads();
#pragma unroll 1
    for (int cg = 0; cg < 4; ++cg) {
      const int cb = n0 + cg * 32;
      if (cb >= 4896) continue;
      bool chan; int cm;
      if (cb < 512) { chan = false; cm = cb; }
      else if (cb < 1024) { chan = true; cm = CH_GV + cb - 512; }
      else if (cb < 2208) { chan = false; cm = cb - 512; }
      else if (cb < 2336) { chan = true; cm = CH_AV + cb - 2208; }
      else if (cb < 2848) { chan = false; cm = cb - 640; }
      else { chan = true; cm = cb - 2848; }
      if (chan) {
#pragma unroll
        for (int k = 0; k < 2; ++k) {
          const int idx = tid + NT * k, ch = idx >> 5, t8 = idx & 31;
          const u16* sp = Tt + (cg * 32 + ch) * LDE + t8 * 8;
          const u32x2 lo = *(const u32x2*)sp, hi = *(const u32x2*)(sp + 4);
          *(u32x4*)(CT + ((size_t)(cm + ch) * 2 + b) * TB + tk0 + t8 * 8) = u32x4{lo.x, lo.y, hi.x, hi.y};
        }
      } else {
#pragma unroll
        for (int k = 0; k < 2; ++k) {
          const int idx = tid + NT * k, row = idx >> 2, c8 = idx & 3;
          const u16* sp = Tt + (cg * 32 + c8 * 8) * LDE + row;
          u32x4 o;
          o.x = (unsigned)sp[0] | ((unsigned)sp[LDE] << 16); o.y = (unsigned)sp[2 * LDE] | ((unsigned)sp[3 * LDE] << 16);
          o.z = (unsigned)sp[4 * LDE] | ((unsigned)sp[5 * LDE] << 16); o.w = (unsigned)sp[6 * LDE] | ((unsigned)sp[7 * LDE] << 16);
          *(u32x4*)(P + (size_t)(m0 + row) * NP + cm + c8 * 8) = o;
        }
      }
    }
  }
}

DI void attn_prep(const Params& p, int l, int dry) {
  const int tid = my_tid(), lane = tid & 63, wid = tid >> 6;
  u16* P = (u16*)(p.ws + OFF_P);
  const float gq = pk(p, PK_QN)[l * 64 + lane], gk = pk(p, PK_KN)[l * 64 + lane];
  for (int row = blockIdx.x * 8 + wid; row < R; row += gridDim.x * 8) {
    u16* Pr = P + (size_t)row * NP;
    const int b = row / TB, tk = row - b * TB;
    float cs = 1.f, sn = 0.f;
    if (tk >= LC) {
      const int t = tk - LC, pi = lane >> 1;
      const float pos = (pi < 16) ? (float)(t >> 6) : (float)(t & 63);
      const float inv = powf(10000.f, -(float)(2 * (pi & 15)) / 32.f);
      sincosf(pos * inv, &sn, &cs);
    }
#pragma unroll
    for (int hd = 0; hd < 10; ++hd) {
      const int col = (hd < 8) ? PC_AQ + hd * 64 + lane : PC_AK + (hd - 8) * 64 + lane;
      float v = bf2f(Pr[col]);
      const float ss = wave_sum(v * v);
      v = v * rsqrtf(ss * (1.f / 64.f) + EPS) * (hd < 8 ? gq : gk);
      const float pv = __shfl_xor(v, 1);
      float o = (lane & 1) ? (pv * sn + v * cs) : (v * cs - pv * sn);
      if (hd < 8) o *= 0.125f * 1.4426950408889634f;
      if (!dry) Pr[col] = f2bf(o);
    }
  }
}

DI void fft_fwd(float2* X, int tid) {
#pragma unroll 1
  for (int h2 = 4096; h2 >= 1; h2 >>= 2) {
    const float inv4 = 0.25f / (float)h2;
#pragma unroll 2
    for (int i = 0; i < 8; ++i) {
      const int g = tid + NT * i, jp = g & (h2 - 1), base = ((g - jp) << 2) + jp;
      float2 e0 = X[base], e1 = X[base + h2], e2 = X[base + 2 * h2], e3 = X[base + 3 * h2];
      const float fr = (float)jp * inv4;
      const float2 T1 = make_float2(__builtin_amdgcn_cosf(fr), -__builtin_amdgcn_sinf(fr));
      const float2 T2 = cmul(T1, T1);
      float2 a0 = cadd(e0, e2), a2 = cmul(csub(e0, e2), T1);
      float2 a1 = cadd(e1, e3), d13 = cmul(csub(e1, e3), T1);
      float2 a3 = make_float2(d13.y, -d13.x);
      X[base] = cadd(a0, a1); X[base + h2] = cmul(csub(a0, a1), T2);
      X[base + 2 * h2] = cadd(a2, a3); X[base + 3 * h2] = cmul(csub(a2, a3), T2);
    }
    __syncthreads();
  }
}
DI void fft_inv(float2* X, int tid) {
#pragma unroll 1
  for (int h1 = 1; h1 <= 4096; h1 <<= 2) {
    const float inv4 = 0.25f / (float)h1;
#pragma unroll 2
    for (int i = 0; i < 8; ++i) {
      const int g = tid + NT * i, jp = g & (h1 - 1), base = ((g - jp) << 2) + jp;
      float2 e0 = X[base], e1 = X[base + h1], e2 = X[base + 2 * h1], e3 = X[base + 3 * h1];
      const float fr = (float)jp * inv4;
      const float2 V = make_float2(__builtin_amdgcn_cosf(fr), __builtin_amdgcn_sinf(fr));
      const float2 Wc = cmul(V, V);
      float2 t1 = cmul(e1, Wc), t3 = cmul(e3, Wc);
      float2 a0 = cadd(e0, t1), a1 = csub(e0, t1), a2 = cadd(e2, t3), a3 = csub(e2, t3);
      float2 u2 = cmul(a2, V), u3 = cmul(a3, V);
      u3 = make_float2(-u3.y, u3.x);
      X[base] = cadd(a0, u2); X[base + 2 * h1] = csub(a0, u2);
      X[base + h1] = cadd(a1, u3); X[base + 3 * h1] = csub(a1, u3);
    }
    __syncthreads();
  }
}
DI float sconv_at(const u16* src, int t, int len, float w0, float w1, float w2, float bb) {
  float ym = t > 0 ? bf2f(src[t - 1]) : 0.f, y0 = bf2f(src[t]), yp = t < len - 1 ? bf2f(src[t + 1]) : 0.f;
  return bb + w0 * ym + w1 * y0 + w2 * yp;
}
DI float hy_delta(int col) {
  const float A0 = -4.605170185988091f / 0.3f, A1 = -4.605170185988091f / 1.5f;
  return fabsf(A0 + (A1 - A0) * ((float)col / 2047.f));
}

DI void hyena_latent_task(const Params& p, int l, int c, char* smem, int dry) {
  float2* X = (float2*)smem;
  float* red = (float*)(smem + 131072);
  const int tid = my_tid(), lane = tid & 63, wid = tid >> 6;
  u16* CT = (u16*)(p.ws + OFF_CT);
  float2* FE = (float2*)(p.ws + OFF_FS + (size_t)blockIdx.x * 262144);
  float2* FO = FE + 16384;
  const float* h2T = (const float*)(p.ws + OFF_H2T) + (size_t)l * 64 * L;
  const float* f3w = pk(p, PK_F3) + (size_t)l * 64 * 2048;
  const float* cw = pk(p, PK_CW) + (size_t)l * 3 * 1536;
  const float* cbv = pk(p, PK_CB) + (size_t)l * 1536;
  const float vw0 = cw[c], vw1 = cw[1536 + c], vw2 = cw[3072 + c], vbb = cbv[c];
  const u16* v0 = CT + ((size_t)(CH_YU + c) * 2 + 0) * TB + LC;
  const u16* v1 = CT + ((size_t)(CH_YU + c) * 2 + 1) * TB + LC;
  u16* z10 = CT + ((size_t)(CH_YU + 512 + c) * 2 + 0) * TB + LC;
  u16* z11 = CT + ((size_t)(CH_YU + 512 + c) * 2 + 1) * TB + LC;
#pragma unroll 1
  for (int o = 0; o < 2; ++o) {
    const int cf = o * 1024 + c, cbk = cf + 512;
    float sf = 0.f, sb = 0.f;
    __syncthreads();
#ifdef PROBE_FFT
    fft_fwd(X, tid); fft_inv(X, tid);
#endif
#pragma unroll 1
    for (int half = 0; half < 2; ++half) {
      float af[16], ab[16];
#pragma unroll
      for (int i = 0; i < 16; ++i) { af[i] = 0.f; ab[i] = 0.f; }
#pragma unroll 1
      for (int j = 0; j < 64; j += 2) {
        const float wf0 = f3w[j * 2048 + cf], wb0 = f3w[j * 2048 + cbk], wf1 = f3w[(j + 1) * 2048 + cf], wb1 = f3w[(j + 1) * 2048 + cbk];
        const float* hrow = h2T + (size_t)j * L + tid + half * 16 * NT;
        float hv0[16], hv1[16];
#pragma unroll
        for (int i = 0; i < 16; ++i) { hv0[i] = hrow[NT * i]; hv1[i] = hrow[L + NT * i]; }
#pragma unroll
        for (int i = 0; i < 16; ++i) { af[i] += hv0[i] * wf0 + hv1[i] * wf1; ab[i] += hv0[i] * wb0 + hv1[i] * wb1; }
      }
      const float df = hy_delta(cf), db = hy_delta(cbk);
#pragma unroll
      for (int i = 0; i < 16; ++i) {
        const int t = tid + NT * (i + half * 16); const float tt = (float)t / (float)(L - 1);
        const float vf = af[i] * (__expf(-tt * df) + 0.05f), vb = ab[i] * (__expf(-tt * db) + 0.05f);
        sf += fabsf(vf); sb += fabsf(vb);
        X[t].x = vf;
        if (t >= 1) X[L - t].y = vb; else X[0].y = 0.f;
      }
    }
    sf = wave_sum(sf); sb = wave_sum(sb);
    if (lane == 0) { red[wid] = sf; red[8 + wid] = sb; }
    __syncthreads();
    float nf = 0.f, nbk = 0.f;
#pragma unroll
    for (int w = 0; w < 8; ++w) { nf += red[w]; nbk += red[8 + w]; }
    const float inv_f = 1.f / nf, inv_b = 1.f / nbk;
#pragma unroll 8
    for (int i = 0; i < 32; ++i) { const int n = tid + NT * i; const float2 s = X[n]; FO[n] = s; X[n] = make_float2(s.x * inv_f + s.y * inv_b, 0.f); }
    __syncthreads();
    fft_fwd(X, tid);
#pragma unroll 8
    for (int i = 0; i < 32; ++i) { const int n = tid + NT * i; FE[n] = X[n]; }
    __syncthreads();
#pragma unroll 8
    for (int i = 0; i < 32; ++i) {
      const int n = tid + NT * i; const float2 s = FO[n]; const float dd = s.x * inv_f - s.y * inv_b; const float fr = (float)n * (1.f / 32768.f);
      X[n] = make_float2(dd * __builtin_amdgcn_cosf(fr), -dd * __builtin_amdgcn_sinf(fr));
    }
    __syncthreads();
    fft_fwd(X, tid);
#pragma unroll 8
    for (int i = 0; i < 32; ++i) { const int n = tid + NT * i; FO[n] = X[n]; }
    __syncthreads();
#pragma unroll 8
    for (int i = 0; i < 32; ++i) {
      const int n = tid + NT * i;
      float2 zz;
      if (o == 0) { zz.x = sconv_at(v0, n, L, vw0, vw1, vw2, vbb); zz.y = sconv_at(v1, n, L, vw0, vw1, vw2, vbb); }
      else { zz.x = bf2f(z10[n]); zz.y = bf2f(z11[n]); }
      X[n] = zz;
    }
    __syncthreads();
    fft_fwd(X, tid);
#pragma unroll 8
    for (int i = 0; i < 32; ++i) { const int n = tid + NT * i; X[n] = cmul(X[n], FE[n]); }
    __syncthreads();
    fft_inv(X, tid);
#pragma unroll 8
    for (int i = 0; i < 32; ++i) { const int n = tid + NT * i; FE[n] = X[n]; }
    __syncthreads();
#pragma unroll 8
    for (int i = 0; i < 32; ++i) {
      const int n = tid + NT * i; const float fr = (float)n * (1.f / 32768.f);
      float2 zz;
      if (o == 0) { zz.x = sconv_at(v0, n, L, vw0, vw1, vw2, vbb); zz.y = sconv_at(v1, n, L, vw0, vw1, vw2, vbb); }
      else { zz.x = bf2f(z10[n]); zz.y = bf2f(z11[n]); }
      X[n] = cmul(zz, make_float2(__builtin_amdgcn_cosf(fr), -__builtin_amdgcn_sinf(fr)));
    }
    __syncthreads();
    fft_fwd(X, tid);
#pragma unroll 8
    for (int i = 0; i < 32; ++i) { const int n = tid + NT * i; X[n] = cmul(X[n], FO[n]); }
    __syncthreads();
    fft_inv(X, tid);
    {
      const int gch = CH_YU + 512 * (o + 1) + c;
      const float w0 = cw[gch], w1 = cw[1536 + gch], w2 = cw[3072 + gch], bb = cbv[gch];
      const u16* s0 = CT + ((size_t)gch * 2 + 0) * TB + LC;
      const u16* s1 = CT + ((size_t)gch * 2 + 1) * TB + LC;
      const float sk = pk(p, PK_SK)[(l * 2 + o) * 512 + c];
#pragma unroll 8
      for (int i = 0; i < 32; ++i) {
        const int n = tid + NT * i; const float fr = (float)n * (1.f / 32768.f);
        const float2 wb = cmul(X[n], make_float2(__builtin_amdgcn_cosf(fr), __builtin_amdgcn_sinf(fr)));
        const float2 A = FE[n];
        const float yr = (A.x + wb.x) * (1.f / 32768.f), yi = (A.y + wb.y) * (1.f / 32768.f);
        const float g0 = sconv_at(s0, n, L, w0, w1, w2, bb), g1 = sconv_at(s1, n, L, w0, w1, w2, bb);
        float2 zz;
        if (o == 0) { zz.x = sconv_at(v0, n, L, vw0, vw1, vw2, vbb); zz.y = sconv_at(v1, n, L, vw0, vw1, vw2, vbb); }
        else { zz.x = bf2f(z10[n]); zz.y = bf2f(z11[n]); }
        X[n] = make_float2(g0 * (yr + sk * zz.x), g1 * (yi + sk * zz.y));
      }
    }
    __syncthreads();
    if (o == 0) {
#pragma unroll 8
      for (int i = 0; i < 32; ++i) { const int n = tid + NT * i; const float2 zz = X[n]; if (!dry) { z10[n] = f2bf(zz.x); z11[n] = f2bf(zz.y); } }
    } else {
      u16* d0 = CT + ((size_t)(CH_YZ + c) * 2 + 0) * TB + LC;
      u16* d1 = CT + ((size_t)(CH_YZ + c) * 2 + 1) * TB + LC;
#pragma unroll 1
      for (int ib = 0; ib < 32; ib += 8) {
        u16 g0[8], g1[8];
#pragma unroll
        for (int i = 0; i < 8; ++i) { const int n = tid + NT * (ib + i); g0[i] = d0[n]; g1[i] = d1[n]; }
#pragma unroll
        for (int i = 0; i < 8; ++i) {
          const int n = tid + NT * (ib + i); const float2 zz = X[n];
          const u16 q0 = f2bf(zz.x * silu_f(bf2f(g0[i]))), q1 = f2bf(zz.y * silu_f(bf2f(g1[i])));
          if (!dry) { d0[n] = q0; d1[n] = q1; }
        }
      }
    }
    __syncthreads();
  }
}

DI void hyena_ctx_task(const Params& p, int l, int c, char* smem, int dry) {
  float* filt = (float*)smem;
  float* zs = filt + 1024;
  float* nrm = zs + 1024;
  const int tid = my_tid(), lane = tid & 63, wid = tid >> 6, t = tid & 255, hb = tid >> 8;
  u16* CT = (u16*)(p.ws + OFF_CT);
  const float* h2c = (const float*)(p.ws + OFF_H2C) + (size_t)l * 256 * 64;
  const float* f3w = pk(p, PK_F3) + (size_t)l * 64 * 2048;
  const float* cw = pk(p, PK_CW) + (size_t)l * 3 * 1536;
  const float* cbv = pk(p, PK_CB) + (size_t)l * 1536;
  __syncthreads();
  {
    const int cf = hb * 1024 + c, cbk = cf + 512;
    float a_f = 0.f, a_b = 0.f;
    for (int j = 0; j < 64; ++j) { const float hv = h2c[t * 64 + j]; a_f += hv * f3w[j * 2048 + cf]; a_b += hv * f3w[j * 2048 + cbk]; }
    const float tt = (float)t / 255.f;
    filt[(hb * 2 + 0) * 256 + t] = a_f * (__expf(-tt * hy_delta(cf)) + 0.05f);
    filt[(hb * 2 + 1) * 256 + t] = a_b * (__expf(-tt * hy_delta(cbk)) + 0.05f);
    const u16* src = CT + ((size_t)(CH_YU + c) * 2 + hb) * TB;
    zs[hb * 256 + t] = sconv_at(src, t, LC, cw[c], cw[1536 + c], cw[3072 + c], cbv[c]);
  }
  __syncthreads();
  if (wid < 4) {
    float s = 0.f;
    for (int k = 0; k < 4; ++k) s += fabsf(filt[wid * 256 + lane + 64 * k]);
    s = wave_sum(s);
    if (lane == 0) nrm[wid] = s;
  }
  __syncthreads();
  const int b = hb;
  for (int o = 0; o < 2; ++o) {
    const float inf_ = 1.f / nrm[o * 2], inb_ = 1.f / nrm[o * 2 + 1];
    const float* hf = filt + (o * 2) * 256; const float* hbk = filt + (o * 2 + 1) * 256;
    const float* zc = zs + (o & 1) * 512 + b * 256;
    float accf = 0.f, accb = 0.f;
    for (int s = 0; s <= t; ++s) accf += hf[t - s] * zc[s];
    for (int s = t + 1; s < 256; ++s) accb += hbk[s - t] * zc[s];
    const int gch = CH_YU + 512 * (o + 1) + c;
    const float gate = sconv_at(CT + ((size_t)gch * 2 + b) * TB, t, LC, cw[gch], cw[1536 + gch], cw[3072 + gch], cbv[gch]);
    const float zn = gate * (accf * inf_ + accb * inb_ + pk(p, PK_SK)[(l * 2 + o) * 512 + c] * zc[t]);
    zs[((o + 1) & 1) * 512 + b * 256 + t] = zn;
    __syncthreads();
  }
  {
    u16* d = CT + ((size_t)(CH_YZ + c) * 2 + b) * TB;
    const u16 q0 = f2bf(zs[b * 256 + t] * silu_f(bf2f(d[t])));
    if (!dry) d[t] = q0;
  }
  __syncthreads();
}

DI void gla_bcum(const Params& p, int l, int row0, int hh, int dir, float* gs, float* segs, float* was, float* as_) {
  const int tid = my_tid();
  const u16* P = (const u16*)(p.ws + OFF_P);
  const float* wa = pk(p, dir ? PK_WAB : PK_WAF) + (size_t)l * 16 * 256 + hh * 64;
  const float* ba = pk(p, dir ? PK_BAB : PK_BAF) + l * 256 + hh * 64;
#pragma unroll
  for (int i = 0; i < 2; ++i) {
    const int idx = tid + NT * i;
    was[idx] = wa[(idx >> 6) * 256 + (idx & 63)];
    as_[(idx >> 4) * 17 + (idx & 15)] = bf2f(P[(size_t)(row0 + (idx >> 4)) * NP + PC_AF + dir * 16 + (idx & 15)]);
  }
  __syncthreads();
  {
    const int t = tid >> 3, d0 = (tid & 7) * 8;
    float lin[8];
#pragma unroll
    for (int e = 0; e < 8; ++e) lin[e] = ba[d0 + e];
#pragma unroll 2
    for (int rr = 0; rr < 16; ++rr) {
      const float av = as_[t * 17 + rr];
      const float4 w0 = *(const float4*)(was + rr * 64 + d0), w1 = *(const float4*)(was + rr * 64 + d0 + 4);
      lin[0] += av * w0.x; lin[1] += av * w0.y; lin[2] += av * w0.z; lin[3] += av * w0.w;
      lin[4] += av * w1.x; lin[5] += av * w1.y; lin[6] += av * w1.z; lin[7] += av * w1.w;
    }
#pragma unroll
    for (int e = 0; e < 8; ++e) gs[t * 65 + d0 + e] = (fminf(lin[e], 0.f) - log1pf(__expf(-fabsf(lin[e])))) * (1.f / 16.f);
  }
  __syncthreads();
  {
    const int d = tid & 63, seg = tid >> 6;
    float v[8]; float run = 0.f;
#pragma unroll
    for (int e = 0; e < 8; ++e) { const int tt = dir ? seg * 8 + 7 - e : seg * 8 + e; run += gs[tt * 65 + d]; v[e] = run; }
    segs[seg * 64 + d] = run;
    __syncthreads();
    float off = 0.f;
#pragma unroll
    for (int s = 0; s < 8; ++s) { const bool before = dir ? (s > seg) : (s < seg); if (before) off += segs[s * 64 + d]; }
#pragma unroll
    for (int e = 0; e < 8; ++e) { const int tt = dir ? seg * 8 + 7 - e : seg * 8 + e; gs[tt * 65 + d] = v[e] + off; }
  }
  __syncthreads();
}
DI int gla_tok0(int dir, int n) {
  if (n < 4) return (dir ? 3 - n : n) * 64;
  return LC + (dir ? 255 - (n - 4) : n - 4) * 64;
}
constexpr int G_GS = 0;
constexpr int G_SEG = G_GS + 64 * 65 * 4;
constexpr int G_QS = G_SEG + 8 * 64 * 4;
constexpr int G_KS = G_QS + 64 * LDT * 2;
constexpr int G_VT = G_KS + 64 * LDT * 2;
constexpr int G_ST = G_VT + 128 * LDT * 2;
constexpr int G_RED = G_ST + 128 * LDT * 2;
constexpr int G_WA = G_RED + 8 * 32 * 4;
constexpr int G_AS = G_WA + 16 * 64 * 4;

DI void gla_g1_task(const Params& p, int l, int chain, int n, char* smem) {
  const int tid = my_tid(), lane = tid & 63, wid = tid >> 6, r = lane & 31, h = lane >> 5;
  const int b = chain >> 3, hh = (chain >> 1) & 3, dir = chain & 1;
  const int tk0 = gla_tok0(dir, n), row0 = b * TB + tk0;
  float* gs = (float*)(smem + G_GS); float* segs = (float*)(smem + G_SEG);
  u16* kT = (u16*)(smem + G_KS); u16* vT = (u16*)(smem + G_VT);
  const u16* P = (const u16*)(p.ws + OFF_P);
  const u16* CT = (const u16*)(p.ws + OFF_CT);
  __syncthreads();
  gla_bcum(p, l, row0, hh, dir, gs, segs, (float*)(smem + G_WA), (float*)(smem + G_AS));
  const int tl = dir ? 0 : 63;
  {
    const int t = tid >> 3, d0 = (tid & 7) * 8;
    const u32x4 kv = *(const u32x4*)(P + (size_t)(row0 + t) * NP + PC_GK + hh * 64 + d0);
    const unsigned w[4] = {kv.x, kv.y, kv.z, kv.w};
#pragma unroll
    for (int e = 0; e < 8; ++e) {
      const float kx = (e & 1) ? bfhi(w[e >> 1]) : bflo(w[e >> 1]);
      kT[(d0 + e) * LDT + t] = f2bf(kx * __expf(gs[tl * 65 + d0 + e] - gs[t * 65 + d0 + e]));
    }
#pragma unroll
    for (int i = 0; i < 2; ++i) {
      const int q = tid + NT * i, v = q >> 3, cc = q & 7;
      *(u32x4*)(vT + v * LDT + cc * 8) = *(const u32x4*)(CT + ((size_t)(CH_GV + hh * 128 + v) * 2 + b) * TB + tk0 + cc * 8);
    }
    if (tid < 64) ((float*)(p.ws + OFF_GD))[((size_t)chain * NCK + n) * 64 + tid] = __expf(gs[tl * 65 + tid]);
  }
  __syncthreads();
  {
    const int vm = wid >> 1, dn = wid & 1;
    f32x16 acc = zero16();
#pragma unroll
    for (int s = 0; s < 4; ++s) {
      const bf16x8 a = *(const bf16x8*)(vT + (vm * 32 + r) * LDT + s * 16 + h * 8);
      const bf16x8 bb = *(const bf16x8*)(kT + (dn * 32 + r) * LDT + s * 16 + h * 8);
      acc = MFMA(a, bb, acc);
    }
    u16* GS = (u16*)(p.ws + OFF_GS) + ((size_t)chain * NCK + n) * 8192;
#pragma unroll
    for (int reg = 0; reg < 16; ++reg) GS[(vm * 32 + crow(reg, h)) * 64 + dn * 32 + r] = f2bf(acc[reg]);
  }
}
DI void gla_g2(const Params& p, int dry) {
  u16* GSb = (u16*)(p.ws + OFF_GS);
  const float* GD = (const float*)(p.ws + OFF_GD);
  for (int gi = blockIdx.x * NT + my_tid(); gi < 16 * 8192; gi += gridDim.x * NT) {
    const int chain = gi >> 13, e = gi & 8191, d = e & 63;
    u16* ptr = GSb + (size_t)chain * NCK * 8192 + e;
    const float* dec = GD + (size_t)chain * NCK * 64 + d;
    float S = 0.f;
#pragma unroll 1
    for (int n0 = 0; n0 < NCK; n0 += 10) {
      float ds[10], a[10];
#pragma unroll
      for (int k = 0; k < 10; ++k) { ds[k] = bf2f(ptr[(size_t)(n0 + k) * 8192]); a[k] = dec[(n0 + k) * 64]; }
#pragma unroll
      for (int k = 0; k < 10; ++k) { if (!dry) ptr[(size_t)(n0 + k) * 8192] = f2bf(S); S = a[k] * S + ds[k]; }
    }
  }
}
DI void gla_g3_task(const Params& p, int l, int b, int hh, int ci, char* smem, int dry) {
  const int tid = my_tid(), lane = tid & 63, wid = tid >> 6, r = lane & 31, h = lane >> 5;
  const int tk0 = ci * 64, row0 = b * TB + tk0;
  float* gs = (float*)(smem + G_GS); float* segs = (float*)(smem + G_SEG); float* red = (float*)(smem + G_RED);
  u16* qs = (u16*)(smem + G_QS); u16* ks = (u16*)(smem + G_KS); u16* vT = (u16*)(smem + G_VT); u16* sT = (u16*)(smem + G_ST);
  u16* P = (u16*)(p.ws + OFF_P);
  const u16* CT = (const u16*)(p.ws + OFF_CT);
  const int vm = wid >> 1, in = wid & 1;
  f32x16 o = zero16();
  __syncthreads();
#pragma unroll 1
  for (int dir = 0; dir < 2; ++dir) {
    gla_bcum(p, l, row0, hh, dir, gs, segs, (float*)(smem + G_WA), (float*)(smem + G_AS));
    const int chain = b * 8 + hh * 2 + dir;
    const int n = dir ? ((ci < 4) ? 3 - ci : 263 - ci) : ci;
    {
      const int t = tid >> 3, d0 = (tid & 7) * 8;
      const u32x4 qv = *(const u32x4*)(P + (size_t)(row0 + t) * NP + PC_GQ + hh * 64 + d0);
      const u32x4 kv = *(const u32x4*)(P + (size_t)(row0 + t) * NP + PC_GK + hh * 64 + d0);
      const unsigned qw[4] = {qv.x, qv.y, qv.z, qv.w}, kw[4] = {kv.x, kv.y, kv.z, kv.w};
      unsigned qo[4], ko[4];
#pragma unroll
      for (int e = 0; e < 4; ++e) {
        const float b0 = gs[t * 65 + d0 + 2 * e], b1 = gs[t * 65 + d0 + 2 * e + 1];
        qo[e] = pack2(bflo(qw[e]) * 0.125f * __expf(b0), bfhi(qw[e]) * 0.125f * __expf(b1));
        ko[e] = pack2(bflo(kw[e]) * __expf(-b0), bfhi(kw[e]) * __expf(-b1));
      }
      *(u32x4*)(qs + t * LDT + d0) = u32x4{qo[0], qo[1], qo[2], qo[3]};
      *(u32x4*)(ks + t * LDT + d0) = u32x4{ko[0], ko[1], ko[2], ko[3]};
      const u16* GS = (const u16*)(p.ws + OFF_GS) + ((size_t)chain * NCK + n) * 8192;
#pragma unroll
      for (int i = 0; i < 2; ++i) {
        const int q = tid + NT * i, v = q >> 3, cc = q & 7;
        *(u32x4*)(sT + v * LDT + cc * 8) = *(const u32x4*)(GS + v * 64 + cc * 8);
        if (dir == 0) *(u32x4*)(vT + v * LDT + cc * 8) = *(const u32x4*)(CT + ((size_t)(CH_GV + hh * 128 + v) * 2 + b) * TB + tk0 + cc * 8);
      }
    }
    __syncthreads();
    bf16x8 qf[4];
#pragma unroll
    for (int s = 0; s < 4; ++s) qf[s] = *(const bf16x8*)(qs + (in * 32 + r) * LDT + s * 16 + h * 8);
#pragma unroll
    for (int jt = 0; jt < 2; ++jt) {
      f32x16 at = zero16();
#pragma unroll
      for (int s = 0; s < 4; ++s) at = MFMA(*(const bf16x8*)(ks + (jt * 32 + r) * LDT + s * 16 + h * 8), qf[s], at);
      const int ii = in * 32 + r;
#pragma unroll
      for (int reg = 0; reg < 16; ++reg) {
        const int jj = jt * 32 + crow(reg, h);
        const bool keep = dir ? (jj >= ii) : (jj <= ii);
        if (!keep) at[reg] = 0.f;
      }
#pragma unroll
      for (int s = 0; s < 2; ++s) {
        const u16* vp = vT + (vm * 32 + r) * LDT + jt * 32 + 16 * s + 4 * h;
        o = MFMA(ld2x64(vp, vp + 8), pack8(at, s), o);
      }
    }
#pragma unroll
    for (int s = 0; s < 4; ++s) o = MFMA(*(const bf16x8*)(sT + (vm * 32 + r) * LDT + s * 16 + h * 8), qf[s], o);
    __syncthreads();
  }
  float ss = 0.f;
#pragma unroll
  for (int reg = 0; reg < 16; ++reg) ss += o[reg] * o[reg];
  ss += __shfl_xor(ss, 32);
  if (h == 0) red[wid * 32 + r] = ss;
  __syncthreads();
  float tot = 0.f;
#pragma unroll
  for (int m = 0; m < 4; ++m) tot += red[(m * 2 + in) * 32 + r];
  const float rs = rsqrtf(tot * (1.f / 128.f) + EPS);
  u16* zp = P + (size_t)(row0 + in * 32 + r) * NP + PC_GZ + hh * 128 + vm * 32 + 4 * h;
  const float* gn = pk(p, PK_GN) + l * 128 + vm * 32 + 4 * h;
#pragma unroll
  for (int g = 0; g < 4; ++g) {
    const u32x2 zz = *(const u32x2*)(zp + 8 * g);
    const float4 gw = *(const float4*)(gn + 8 * g);
    u32x2 out;
    out.x = pack2(o[4 * g] * rs * gw.x * silu_f(bflo(zz.x)), o[4 * g + 1] * rs * gw.y * silu_f(bfhi(zz.x)));
    out.y = pack2(o[4 * g + 2] * rs * gw.z * silu_f(bflo(zz.y)), o[4 * g + 3] * rs * gw.w * silu_f(bfhi(zz.y)));
    if (!dry) *(u32x2*)(zp + 8 * g) = out;
  }
}

DI void attn_item(const Params& p, int l, int b, int g, int qtk0, int ntiles, char* smem, int dry) {
  const int tid = my_tid(), lane = tid & 63, wid = tid >> 6, r = lane & 31, h = lane >> 5;
  u16* P = (u16*)(p.ws + OFF_P);
  const u16* CT = (const u16*)(p.ws + OFF_CT);
  u16* Ks = (u16*)smem;
  u16* Vs = Ks + 2 * 64 * LDT;
  const int hq = g * 4 + (wid >> 1);
  const size_t qrow = (size_t)b * TB + qtk0 + (wid & 1) * 32 + r;
  bf16x8 qf[4];
#pragma unroll
  for (int s = 0; s < 4; ++s) qf[s] = *(const bf16x8*)(P + qrow * NP + PC_AQ + hq * 64 + s * 16 + h * 8);
  f32x16 O[2] = {zero16(), zero16()};
  float m = -1e30f, lsum = 0.f;
  const int lr = tid >> 3, lc = (tid & 7) * 8;
  const u16* kg = P + ((size_t)b * TB + lr) * NP + PC_AK + g * 64 + lc;
  const u16* vg = CT + ((size_t)(CH_AV + g * 64 + lr) * 2 + b) * TB + lc;
  u32x4 rk = *(const u32x4*)kg, rv = *(const u32x4*)vg;
  __syncthreads();
  *(u32x4*)(Ks + lr * LDT + lc) = rk; *(u32x4*)(Vs + lr * LDT + lc) = rv;
  __syncthreads();
  float gqm = fabsf(pk(p, PK_QN)[l * 64 + lane]), gkm = fabsf(pk(p, PK_KN)[l * 64 + lane]);
#pragma unroll
  for (int o = 32; o >= 1; o >>= 1) { gqm = fmaxf(gqm, __shfl_xor(gqm, o)); gkm = fmaxf(gkm, __shfl_xor(gkm, o)); }
  const float mshift = 8.2f * 1.4426950408889634f * gqm * gkm;
  if (mshift <= 60.f) {
    f32x16 sinit;
#pragma unroll
    for (int i = 0; i < 16; ++i) sinit[i] = -mshift;
#pragma unroll 1
    for (int kt = 0; kt < ntiles; ++kt) {
      const int cur = kt & 1;
      if (kt + 1 < ntiles) { rk = *(const u32x4*)(kg + (size_t)(kt + 1) * 64 * NP); rv = *(const u32x4*)(vg + (kt + 1) * 64); }
      const u16* Kc = Ks + cur * 64 * LDT; const u16* Vc = Vs + cur * 64 * LDT;
      f32x16 st[2];
#pragma unroll
      for (int kk = 0; kk < 2; ++kk) {
        st[kk] = sinit;
#pragma unroll
        for (int s = 0; s < 4; ++s) st[kk] = MFMA(*(const bf16x8*)(Kc + (kk * 32 + r) * LDT + s * 16 + h * 8), qf[s], st[kk]);
      }
#pragma unroll
      for (int kk = 0; kk < 2; ++kk)
#pragma unroll
        for (int i = 0; i < 16; ++i) { const float pv = __builtin_amdgcn_exp2f(st[kk][i]); st[kk][i] = pv; lsum += pv; }
#pragma unroll
      for (int kk = 0; kk < 2; ++kk)
#pragma unroll
        for (int s = 0; s < 2; ++s) {
          const bf16x8 pb = pack8(st[kk], s);
#pragma unroll
          for (int mt = 0; mt < 2; ++mt) {
            const u16* vp = Vc + (mt * 32 + r) * LDT + kk * 32 + 16 * s + 4 * h;
            O[mt] = MFMA(ld2x64(vp, vp + 8), pb, O[mt]);
          }
        }
      if (kt + 1 < ntiles) { *(u32x4*)(Ks + (cur ^ 1) * 64 * LDT + lr * LDT + lc) = rk; *(u32x4*)(Vs + (cur ^ 1) * 64 * LDT + lr * LDT + lc) = rv; }
      __syncthreads();
    }
  } else {
#pragma unroll 1
    for (int kt = 0; kt < ntiles; ++kt) {
      const int cur = kt & 1;
      if (kt + 1 < ntiles) { rk = *(const u32x4*)(kg + (size_t)(kt + 1) * 64 * NP); rv = *(const u32x4*)(vg + (kt + 1) * 64); }
      const u16* Kc = Ks + cur * 64 * LDT; const u16* Vc = Vs + cur * 64 * LDT;
      f32x16 st[2];
#pragma unroll
      for (int kk = 0; kk < 2; ++kk) {
        st[kk] = zero16();
#pragma unroll
        for (int s = 0; s < 4; ++s) st[kk] = MFMA(*(const bf16x8*)(Kc + (kk * 32 + r) * LDT + s * 16 + h * 8), qf[s], st[kk]);
      }
      float mx = st[0][0];
#pragma unroll
      for (int i = 0; i < 16; ++i) { mx = fmaxf(mx, st[0][i]); mx = fmaxf(mx, st[1][i]); }
      mx = fmaxf(mx, __shfl_xor(mx, 32));
      const float mn = fmaxf(m, mx);
      const float alpha = exp2f(m - mn);
      m = mn;
      float rsum = 0.f;
#pragma unroll
      for (int kk = 0; kk < 2; ++kk)
#pragma unroll
        for (int i = 0; i < 16; ++i) { const float pv = exp2f(st[kk][i] - mn); st[kk][i] = pv; rsum += pv; }
      lsum = lsum * alpha + rsum;
#pragma unroll
      for (int mt = 0; mt < 2; ++mt)
#pragma unroll
        for (int i = 0; i < 16; ++i) O[mt][i] *= alpha;
#pragma unroll
      for (int kk = 0; kk < 2; ++kk)
#pragma unroll
        for (int s = 0; s < 2; ++s) {
          const bf16x8 pb = pack8(st[kk], s);
#pragma unroll
          for (int mt = 0; mt < 2; ++mt) {
            const u16* vp = Vc + (mt * 32 + r) * LDT + kk * 32 + 16 * s + 4 * h;
            O[mt] = MFMA(ld2x64(vp, vp + 8), pb, O[mt]);
          }
        }
      if (kt + 1 < ntiles) { *(u32x4*)(Ks + (cur ^ 1) * 64 * LDT + lr * LDT + lc) = rk; *(u32x4*)(Vs + (cur ^ 1) * 64 * LDT + lr * LDT + lc) = rv; }
      __syncthreads();
    }
  }
  lsum += __shfl_xor(lsum, 32);
  const float inv = 1.f / lsum;
  u16* op = P + qrow * NP + PC_AQ + hq * 64 + 4 * h;
  const u16* zp = P + qrow * NP + PC_AZ + hq * 64 + 4 * h;
#pragma unroll
  for (int mt = 0; mt < 2; ++mt)
#pragma unroll
    for (int gg = 0; gg < 4; ++gg) {
      const u32x2 zz = *(const u32x2*)(zp + mt * 32 + 8 * gg);
      u32x2 out;
      out.x = pack2(O[mt][4 * gg] * inv * silu_f(bflo(zz.x)), O[mt][4 * gg + 1] * inv * silu_f(bfhi(zz.x)));
      out.y = pack2(O[mt][4 * gg + 2] * inv * silu_f(bflo(zz.y)), O[mt][4 * gg + 3] * inv * silu_f(bfhi(zz.y)));
      if (!dry) *(u32x2*)(op + mt * 32 + 8 * gg) = out;
    }
}

DI void merge_accum(f32x16 (&ysum)[2], const f32x16 (&am)[1][2], const f32x16 (&ab)[1][2]) {
#pragma unroll
  for (int j = 0; j < 2; ++j)
#pragma unroll
    for (int i = 0; i < 16; ++i) ysum[j][i] += ab[0][j][i] / (1.f + __expf(-am[0][j][i]));
}
DI void phase_merge(const Params& p, int l, char* smem) {
  const int tid = my_tid(), lane = tid & 63, wid = tid >> 6, r = lane & 31, h = lane >> 5, wm = wid & 3, wn = wid >> 2;
  const int xcd = blockIdx.x & 7, nloc = gridDim.x >> 3;
  for (int q = blockIdx.x >> 3; q < 33 * 8; q += nloc) {
    const int mt = (q >> 3) * 8 + xcd, nt = q & 7, m0 = mt * 128, n0 = nt * 128;
    if (mt >= 260) continue;
    const int b = m0 / TB, tk0 = m0 - b * TB;
    if (l == 1 && tk0 < LC) continue;
    const u16* H = (const u16*)(p.ws + OFF_H) + (size_t)m0 * 1024;
    const u16* WM = (const u16*)(p.ws + OFF_WT + (size_t)l * WT_LAYER) + (size_t)(4896 + n0) * 1024;
    const u16* WBR = (const u16*)(p.ws + OFF_WT + (size_t)l * WT_LAYER + WT_IN) + (size_t)n0 * 512;
    f32x16 ysum[2] = {zero16(), zero16()};
#pragma unroll 1
    for (int br = 0; br < 2; ++br) {
      f32x16 am[1][2] = {{zero16(), zero16()}};
      ALoadN ah{H, 1024};
      gemm_tile<128, ALoadN, 4, 1024>(ah, WM + (size_t)br * 1024 * 1024, 1024, smem, am);
      f32x16 ab[1][2] = {{zero16(), zero16()}};
      ALoadN ay{(const u16*)(p.ws + OFF_P) + (size_t)m0 * NP + (br == 0 ? PC_GZ : PC_AQ), NP};
      gemm_tile<128, ALoadN, 4, 512>(ay, WBR + (size_t)br * 1024 * 512, 512, smem, ab);
      merge_accum(ysum, am, ab);
    }
    {
      f32x16 am[1][2] = {{zero16(), zero16()}};
      ALoadN ah{H, 1024};
      gemm_tile<128, ALoadN, 4, 1024>(ah, WM + (size_t)2 * 1024 * 1024, 1024, smem, am);
      f32x16 ab[1][2] = {{zero16(), zero16()}};
      ALoadT ay{(const u16*)(p.ws + OFF_CT) + ((size_t)CH_YZ * 2 + b) * TB + tk0, (size_t)2 * TB};
      gemm_tile<128, ALoadT, 4, 512>(ay, WBR + (size_t)2 * 1024 * 512, 512, smem, ab);
      merge_accum(ysum, am, ab);
    }
    u16* Y = (u16*)(p.ws + OFF_Y) + (size_t)(m0 + wm * 32 + 4 * h) * 1024 + n0 + wn * 64 + r;
#pragma unroll
    for (int j = 0; j < 2; ++j)
#pragma unroll
      for (int reg = 0; reg < 16; ++reg) Y[(size_t)((reg & 3) + 8 * (reg >> 2)) * 1024 + j * 32] = f2bf(ysum[j][reg]);
  }
}

DI void phase_out(const Params& p, int l, char* smem) {
  const int tid = my_tid(), lane = tid & 63, wid = tid >> 6, r = lane & 31, h = lane >> 5, wm = wid & 3, wn = wid >> 2;
  const u16* Yb = (const u16*)(p.ws + OFF_Y);
  const u16* WO = (const u16*)(p.ws + OFF_WT + (size_t)l * WT_LAYER + WT_IN + 3 * WT_BR);
  const float* mod = (const float*)(p.ws + OFF_MOD);
  const int xcd = blockIdx.x & 7, nloc = gridDim.x >> 3;
  auto tile_of = [&](int q, int& m0, int& n0) -> bool {
    const int mt = (q >> 3) * 8 + xcd; m0 = mt * 128; n0 = (q & 7) * 128;
    if (mt >= 260) return false;
    const int b = m0 / TB, tk0 = m0 - b * TB;
    return !(l == 1 && tk0 < LC);
  };
  auto next_q = [&](int q) -> int { int m, n; for (q += nloc; q < 33 * 8; q += nloc) if (tile_of(q, m, n)) return q; return -1; };
  int q = (int)(blockIdx.x >> 3) - nloc; q = next_q(q);
  if (q < 0) return;
  int m0, n0; tile_of(q, m0, n0);
  GemmRegs<128> gr;
  { ALoadN ay{Yb + (size_t)m0 * 1024, 1024}; gemm_prime<128>(gr, ay, WO + (size_t)n0 * 1024, 1024, smem); }
  while (true) {
    const int qn = next_q(q);
    int m0n = 0, n0n = 0; if (qn >= 0) tile_of(qn, m0n, n0n);
    const int b = m0 / TB, tk0 = m0 - b * TB;
    f32x16 acc[1][2] = {{zero16(), zero16()}};
    const ALoadN ay{Yb + (size_t)m0 * 1024, 1024}, ayn{Yb + (size_t)m0n * 1024, 1024};
    gemm_run<128, ALoadN, 4, 1024, ALoadN>(gr, ay, WO + (size_t)n0 * 1024, 1024, ayn, WO + (size_t)n0n * 1024, 1024, qn >= 0, smem, acc);
    const float* gv = mod + (l * 3 + (tk0 < LC ? 2 : b)) * 3072 + 2048;
    const float* xin = xrow_in(p, l, m0);
    float* xout = xrow_out(p, m0);
#pragma unroll
    for (int j = 0; j < 2; ++j) {
      const int col = n0 + wn * 64 + j * 32 + r;
      const float gate = gv[col];
#pragma unroll
      for (int reg = 0; reg < 16; ++reg) {
        const size_t off = (size_t)(wm * 32 + crow(reg, h)) * D + col;
        xout[off] = xin[off] + gate * acc[0][j][reg];
      }
    }
    if (qn < 0) break;
    q = qn; m0 = m0n; n0 = n0n;
  }
}

DI void phase_final(const Params& p) {
  const int tid = my_tid(), lane = tid & 63, wid = tid >> 6;
  for (int row = blockIdx.x * 8 + wid; row < NBATCH * L; row += gridDim.x * 8) {
    float* src = p.out + (size_t)row * D;
    float4 xv[4]; float ss = 0.f;
#pragma unroll
    for (int i = 0; i < 4; ++i) { xv[i] = *(const float4*)(src + (i * 64 + lane) * 4); ss += xv[i].x * xv[i].x + xv[i].y * xv[i].y + xv[i].z * xv[i].z + xv[i].w * xv[i].w; }
    ss = wave_sum(ss);
    const float rs = rsqrtf(ss * (1.f / 1024.f) + EPS);
#pragma unroll
    for (int i = 0; i < 4; ++i) {
      const int col = (i * 64 + lane) * 4;
      const float4 fw = *(const float4*)(pk(p, PK_FN) + col);
      *(float4*)(src + col) = make_float4(xv[i].x * rs * fw.x, xv[i].y * rs * fw.y, xv[i].z * rs * fw.z, xv[i].w * rs * fw.w);
    }
  }
}

DI void run_phase(const Params& p, int ph, char* smem, int dry = 0) {
  const int bid = blockIdx.x, nb = gridDim.x;
  if (ph == 0) { phase0(p, smem); return; }
  if (ph == 17) { phase_final(p); return; }
  const int l = (ph - 1) >> 3, s = (ph - 1) & 7;
  switch (s) {
    case 0: phase_norm(p, l); break;
    case 1: phase_proj(p, l, smem); break;
    case 2: {
      attn_prep(p, l, dry);
      if (l == 0) for (int c = bid; c < 512; c += nb) hyena_ctx_task(p, l, c, smem, dry);
      for (int c = bid; c < 512; c += nb) hyena_latent_task(p, l, c, smem, dry);
    } break;
    case 3: for (int t = bid; t < 16 * NCK; t += nb) gla_g1_task(p, l, t / NCK, t % NCK, smem); break;
    case 4: gla_g2(p, dry); break;
    case 5: {
      for (int it = bid; it < 1024; it += nb) { const int b = it >> 9, g = (it >> 8) & 1, qb = it & 255; attn_item(p, l, b, g, LC + qb * 64, NCK, smem, dry); }
      if (l == 0) for (int it = bid; it < 16; it += nb) { const int b = it >> 3, g = (it >> 2) & 1, qb = it & 3; attn_item(p, l, b, g, qb * 64, 4, smem, dry); }
      const int c0 = (l == 0) ? 0 : 4, per = NCK - c0;
      for (int t = bid; t < 8 * per; t += nb) { const int bh = t / per, ci = c0 + t % per; gla_g3_task(p, l, bh >> 2, bh & 3, ci, smem, dry); }
    } break;
    case 6: phase_merge(p, l, smem); break;
    case 7: phase_out(p, l, smem); break;
  }
}

#if MULTI_LAUNCH
template <int PH> __global__ void __launch_bounds__(NT) phase_kernel(Params p) {
  extern __shared__ __attribute__((aligned(16))) char smem[];
  run_phase(p, PH, smem);
}
template <int PH> static void launch_phase(const Params& p, int grid, hipStream_t stream) {
  static bool attr = false;
  if (!attr) { (void)hipFuncSetAttribute((const void*)phase_kernel<PH>, hipFuncAttributeMaxDynamicSharedMemorySize, LDS_BYTES); attr = true; }
  hipLaunchKernelGGL(phase_kernel<PH>, dim3(grid), dim3(NT), LDS_BYTES, stream, p);
}
#else
#ifndef PROBE_DUP
#define PROBE_DUP -1
#endif
#ifndef PROBE_DUP2
#define PROBE_DUP2 -1
#endif
#ifndef PROBE_DUP3
#define PROBE_DUP3 -1
#endif
__global__ void __launch_bounds__(NT) fwd_kernel(Params p) {
  extern __shared__ __attribute__((aligned(16))) char smem[];
  cg::grid_group grid = cg::this_grid();
#if PROBE_DUP >= 0
#define PHS(n) if ((n) == PROBE_DUP || (n) == PROBE_DUP2 || (n) == PROBE_DUP3) { run_phase(p, n, smem, p.phase_lo == 0 ? 1 : 0); grid.sync(); } run_phase(p, n, smem); grid.sync();
#else
#define PHS(n) run_phase(p, n, smem); grid.sync();
#endif
  PHS(0) PHS(1) PHS(2) PHS(3) PHS(4) PHS(5) PHS(6) PHS(7) PHS(8)
  PHS(9) PHS(10) PHS(11) PHS(12) PHS(13) PHS(14) PHS(15) PHS(16)
  run_phase(p, 17, smem);
}
#endif

extern "C" void kernel_launch(void* const* d_in, const int* in_sizes, int n_in, void* d_out, int out_size, void* d_ws, size_t ws_size,
                              hipStream_t stream) {
  static int grid = 0;
  if (grid == 0) {
    if (n_in != 29 || ws_size < WS_END) { fprintf(stderr, "kernel_launch: need 29 inputs and %zu B of workspace, got %d / %zu\n", (size_t)WS_END, n_in, ws_size); grid = -1; return; }
#if MULTI_LAUNCH
    grid = 256;
#else
    int dev = 0, cus = 0, per_cu = 0;
    (void)hipGetDevice(&dev);
    (void)hipDeviceGetAttribute(&cus, hipDeviceAttributeMultiprocessorCount, dev);
    if (hipFuncSetAttribute((const void*)fwd_kernel, hipFuncAttributeMaxDynamicSharedMemorySize, LDS_BYTES) != hipSuccess) { fprintf(stderr, "kernel_launch: hipFuncSetAttribute failed\n"); grid = -1; return; }
    (void)hipOccupancyMaxActiveBlocksPerMultiprocessor(&per_cu, (const void*)fwd_kernel, NT, LDS_BYTES);
    if (per_cu < 1) { fprintf(stderr, "kernel_launch: occupancy query returned %d\n", per_cu); per_cu = 1; }
    (void)hipGetLastError();
    grid = cus * per_cu;
    if (grid > 256) grid = 256;
#endif
  }
  if (grid < 0) return;
  Params p{};
  const float** pp = (const float**)&p;
  for (int i = 0; i < 29; ++i) pp[i] = (const float*)d_in[i];
  p.out = (float*)d_out; p.ws = (char*)d_ws;
  p.phase_lo = 0; p.phase_hi = 18;
#if MULTI_LAUNCH
  launch_phase<0>(p, grid, stream); launch_phase<1>(p, grid, stream); launch_phase<2>(p, grid, stream); launch_phase<3>(p, grid, stream);
  launch_phase<4>(p, grid, stream); launch_phase<5>(p, grid, stream); launch_phase<6>(p, grid, stream); launch_phase<7>(p, grid, stream);
  launch_phase<8>(p, grid, stream); launch_phase<9>(p, grid, stream); launch_phase<10>(p, grid, stream); launch_phase<11>(p, grid, stream);
  launch_phase<12>(p, grid, stream); launch_phase<13>(p, grid, stream); launch_phase<14>(p, grid, stream); launch_phase<15>(p, grid, stream);
  launch_phase<16>(p, grid, stream); launch_phase<17>(p, grid, stream);
#else
  void* args[] = {&p};
  hipError_t e = hipLaunchCooperativeKernel((const void*)fwd_kernel, dim3(grid), dim3(NT), args, LDS_BYTES, stream);
  if (e != hipSuccess) fprintf(stderr, "kernel_launch: cooperative launch failed: %s (grid %d)\n", hipGetErrorString(e), grid);
#endif
}
```

```cpp
#include <hip/hip_runtime.h>
#include <hip/hip_cooperative_groups.h>
#include <cstdio>
namespace cg = cooperative_groups;

typedef unsigned short u16;
typedef __attribute__((ext_vector_type(8))) short bf16x8;
typedef __attribute__((ext_vector_type(16))) float f32x16;
typedef __attribute__((ext_vector_type(4))) unsigned u32x4;
typedef __attribute__((ext_vector_type(2))) unsigned u32x2;
#define DI __device__ __forceinline__
#define MFMA(a, b, c) __builtin_amdgcn_mfma_f32_32x32x16_bf16((a), (b), (c), 0, 0, 0)

#ifndef MULTI_LAUNCH
#define MULTI_LAUNCH 0
#endif

constexpr int D = 1024, NBATCH = 2, L = 16384, LC = 256, TB = L + LC, R = NBATCH * TB;
constexpr int NIN = 7968;
constexpr int NP = 2208;
constexpr int NCH = 2688;
constexpr int PC_GQ = 0, PC_GK = 256, PC_GZ = 512, PC_AF = 1024, PC_AQ = 1056, PC_AK = 1568, PC_AZ = 1696;
constexpr int CH_YU = 0, CH_YZ = 1536, CH_GV = 2048, CH_AV = 2560;
constexpr int NCK = 260;
constexpr float EPS = 1e-6f;
constexpr int NT = 512;
constexpr int LDT = 72;

constexpr size_t OFF_P = 0;
constexpr size_t OFF_CT = OFF_P + (size_t)R * NP * 2;
constexpr size_t OFF_H = OFF_CT + (size_t)NCH * 2 * TB * 2;
constexpr size_t OFF_FS = OFF_H + (size_t)R * 1024 * 2;
constexpr size_t OFF_WT = OFF_FS + (size_t)256 * 262144;
constexpr size_t WT_IN = (size_t)NIN * 1024 * 2, WT_BR = (size_t)1024 * 512 * 2, WT_OUT = (size_t)1024 * 1024 * 2;
constexpr size_t WT_LAYER = WT_IN + 3 * WT_BR + WT_OUT;
constexpr size_t OFF_H2T = OFF_WT + 2 * WT_LAYER;
constexpr size_t OFF_H2C = OFF_H2T + (size_t)2 * 64 * L * 4;
constexpr size_t OFF_MOD = OFF_H2C + (size_t)2 * 256 * 64 * 4;
constexpr size_t OFF_CTX1 = OFF_MOD + (size_t)2 * 3 * 3072 * 4;
constexpr size_t OFF_GD = OFF_CTX1 + (size_t)512 * 1024 * 4;
constexpr size_t OFF_PK = OFF_GD + (size_t)16 * NCK * 64 * 4;
constexpr int PK_WAF = 0, PK_BAF = 8192, PK_WAB = 8704, PK_BAB = 16896, PK_GN = 17408, PK_QN = 17664, PK_KN = 17792, PK_CW = 17920,
              PK_CB = 27136, PK_SK = 30208, PK_FN = 32256, PK_F3 = 33280, PK_END = 33280 + 262144;
constexpr size_t WS_END = OFF_PK + (size_t)PK_END * 4;
constexpr size_t OFF_GS = OFF_CT;
constexpr size_t OFF_Y = OFF_CT;
static_assert((size_t)16 * NCK * 8192 * 2 <= (size_t)1536 * 2 * TB * 2, "alias");
static_assert((size_t)R * 1024 * 2 <= (size_t)1536 * 2 * TB * 2, "alias");

constexpr int LDS_BYTES = 131072 + 512;

struct Params {
  const float *x, *c, *ctx, *c_ctx, *w_ada, *b_ada, *w_in, *wa_f, *ba_f, *wa_b, *ba_b, *gla_norm, *qnorm, *knorm,
      *conv_w, *conv_b, *f1_w, *f1_b, *f1_freq, *f2_w, *f2_b, *f2_freq, *f3_w, *skip, *w_g, *w_a, *w_h, *w_o, *final_norm;
  float* out;
  char* ws;
  long long phase_lo, phase_hi;
};

typedef __attribute__((ext_vector_type(2))) float f32x2v;
typedef __attribute__((ext_vector_type(2))) __bf16 bf16x2v;
DI int my_tid() {
  int t = (int)threadIdx.x;
  asm volatile("" : "+v"(t));
  __builtin_assume(t >= 0 && t < NT);
  return t;
}
DI u16 f2bf(float x) { return __builtin_bit_cast(u16, (__bf16)x); }
DI float bf2f(u16 v) { return __uint_as_float(((unsigned)v) << 16); }
DI unsigned pack2(float a, float b) { f32x2v v = {a, b}; return __builtin_bit_cast(unsigned, __builtin_convertvector(v, bf16x2v)); }
DI float bflo(unsigned u) { return __uint_as_float(u << 16); }
DI float bfhi(unsigned u) { return __uint_as_float(u & 0xffff0000u); }
DI float silu_f(float x) { return x / (1.f + __expf(-x)); }
DI float wave_sum(float v) {
#pragma unroll
  for (int o = 32; o >= 1; o >>= 1) v += __shfl_xor(v, o);
  return v;
}
DI int crow(int reg, int h) { return (reg & 3) + 8 * (reg >> 2) + 4 * h; }
DI f32x16 zero16() { f32x16 z; for (int i = 0; i < 16; ++i) z[i] = 0.f; return z; }
DI bf16x8 pack8(const f32x16& x, int s) {
  u32x4 u;
  u.x = pack2(x[8 * s + 0], x[8 * s + 1]); u.y = pack2(x[8 * s + 2], x[8 * s + 3]);
  u.z = pack2(x[8 * s + 4], x[8 * s + 5]); u.w = pack2(x[8 * s + 6], x[8 * s + 7]);
  return __builtin_bit_cast(bf16x8, u);
}
DI bf16x8 ld2x64(const u16* p0, const u16* p1) {
  u32x2 a = *(const u32x2*)p0, b = *(const u32x2*)p1;
  u32x4 u; u.x = a.x; u.y = a.y; u.z = b.x; u.w = b.y;
  return __builtin_bit_cast(bf16x8, u);
}
DI float2 cmul(float2 a, float2 b) { return make_float2(a.x * b.x - a.y * b.y, a.x * b.y + a.y * b.x); }
DI float2 cadd(float2 a, float2 b) { return make_float2(a.x + b.x, a.y + b.y); }
DI float2 csub(float2 a, float2 b) { return make_float2(a.x - b.x, a.y - b.y); }

DI const float* xrow_in(const Params& p, int layer, int row) {
  int b = row / TB, tk = row - b * TB;
  if (tk < LC) return (layer == 0 ? p.ctx : (const float*)(p.ws + OFF_CTX1)) + (size_t)(b * LC + tk) * D;
  return (layer == 0 ? p.x : (const float*)p.out) + (size_t)(b * L + tk - LC) * D;
}
DI float* xrow_out(const Params& p, int row) {
  int b = row / TB, tk = row - b * TB;
  if (tk < LC) return (float*)(p.ws + OFF_CTX1) + (size_t)(b * LC + tk) * D;
  return p.out + (size_t)(b * L + tk - LC) * D;
}
DI const float* pk(const Params& p, int off) { return (const float*)(p.ws + OFF_PK) + off; }
DI int modvec_of(int row) { int b = row / TB, tk = row - b * TB; return tk < LC ? 2 : b; }

struct ALoadN {
  const u16* A; int lda;
  template <int BM> DI void fetch(u32x4 (&r)[BM / 64], int k0, int tid) const {
#pragma unroll
    for (int i = 0; i < BM / 64; ++i) { const int q = tid + NT * i; const unsigned off = (unsigned)((q >> 3) * lda + (q & 7) * 8); r[i] = *(const u32x4*)(A + off + k0); }
  }
  template <int BM> DI void commit(const u32x4 (&r)[BM / 64], u16* As, int tid) const {
#pragma unroll
    for (int i = 0; i < BM / 64; ++i) { int q = tid + NT * i; *(u32x4*)(As + (q >> 3) * LDT + (q & 7) * 8) = r[i]; }
  }
};
struct ALoadT {
  const u16* A; size_t chs;
  template <int BM> DI void fetch(u32x4 (&r)[BM / 64], int k0, int tid) const {
#pragma unroll
    for (int i = 0; i < 2; ++i) { const int q = tid + NT * i; const unsigned off = (unsigned)((q >> 4) * (int)chs + (q & 15) * 8); r[i] = *(const u32x4*)(A + off + (unsigned)(k0 * (int)chs)); }
  }
  template <int BM> DI void commit(const u32x4 (&r)[BM / 64], u16* As, int tid) const {
#pragma unroll
    for (int i = 0; i < 2; ++i) {
      int q = tid + NT * i; int ch = q >> 4, t0 = (q & 15) * 8;
      unsigned w[4] = {r[i].x, r[i].y, r[i].z, r[i].w};
#pragma unroll
      for (int e = 0; e < 4; ++e) { As[(t0 + 2 * e) * LDT + ch] = (u16)(w[e] & 0xffffu); As[(t0 + 2 * e + 1) * LDT + ch] = (u16)(w[e] >> 16); }
    }
  }
};

template <int BM, int KSU>
DI void gemm_compute(const u16* Ac, const u16* Bc, int wm, int wn, int r, int h, f32x16 (&acc)[BM / 128][2]) {
#pragma unroll KSU
  for (int ks = 0; ks < 4; ++ks) {
    bf16x8 a[BM / 128], b[2];
#pragma unroll
    for (int i = 0; i < BM / 128; ++i) a[i] = *(const bf16x8*)(Ac + (wm * (BM / 4) + i * 32 + r) * LDT + ks * 16 + h * 8);
#pragma unroll
    for (int j = 0; j < 2; ++j) b[j] = *(const bf16x8*)(Bc + (wn * 64 + j * 32 + r) * LDT + ks * 16 + h * 8);
#pragma unroll
    for (int i = 0; i < BM / 128; ++i)
#pragma unroll
      for (int j = 0; j < 2; ++j) acc[i][j] = MFMA(a[i], b[j], acc[i][j]);
  }
}
DI void fetch_b(u32x4 (&rb)[2], const u16* Bt, int ldb, int k0, int tid) {
#pragma unroll
  for (int i = 0; i < 2; ++i) { const int q = tid + NT * i; const unsigned off = (unsigned)((q >> 3) * ldb + (q & 7) * 8); rb[i] = *(const u32x4*)(Bt + off + k0); }
}
DI void commit_b(const u32x4 (&rb)[2], u16* Bs, int tid) {
#pragma unroll
  for (int i = 0; i < 2; ++i) { int q = tid + NT * i; *(u32x4*)(Bs + (q >> 3) * LDT + (q & 7) * 8) = rb[i]; }
}
template <int BM> struct GemmRegs { u32x4 ra0[BM / 64], rb0[2], ra1[BM / 64], rb1[2]; };
#define GFENCE asm volatile("" ::: "memory")
template <int BM, class AL>
DI void gemm_prime(GemmRegs<BM>& g, const AL& al, const u16* __restrict__ Bt, int ldb, char* smem) {
  u16* As0 = (u16*)smem;
  u16* Bs0 = As0 + 2 * BM * LDT;
  const int tid = my_tid();
  al.template fetch<BM>(g.ra0, 0, tid); fetch_b(g.rb0, Bt, ldb, 0, tid); GFENCE;
  al.template fetch<BM>(g.ra1, 64, tid); fetch_b(g.rb1, Bt, ldb, 64, tid); GFENCE;
  __syncthreads();
  al.template commit<BM>(g.ra0, As0, tid); commit_b(g.rb0, Bs0, tid);
  __syncthreads();
  al.template fetch<BM>(g.ra0, 128, tid); fetch_b(g.rb0, Bt, ldb, 128, tid); GFENCE;
}
template <int BM, class AL, int KSU, int K, class ALN>
DI void gemm_run(GemmRegs<BM>& g, const AL& al, const u16* __restrict__ Bt, int ldb, const ALN& aln, const u16* __restrict__ Btn, int ldbn,
                 bool hasnext, char* smem, f32x16 (&acc)[BM / 128][2]) {
  u16* As0 = (u16*)smem;
  u16* As1 = As0 + BM * LDT;
  u16* Bs0 = As0 + 2 * BM * LDT;
  u16* Bs1 = Bs0 + 128 * LDT;
  const int tid = my_tid(), lane = tid & 63, wid = tid >> 6, r = lane & 31, h = lane >> 5;
  const int wm = wid & 3, wn = wid >> 2;
  constexpr int KT = K >> 6;
#pragma unroll
  for (int kt = 0; kt < KT; kt += 2) {
    al.template commit<BM>(g.ra1, As1, tid); commit_b(g.rb1, Bs1, tid);
    GFENCE;
    if (kt + 3 < KT) { al.template fetch<BM>(g.ra1, (kt + 3) * 64, tid); fetch_b(g.rb1, Bt, ldb, (kt + 3) * 64, tid); GFENCE; }
    else if (hasnext) { aln.template fetch<BM>(g.ra1, (kt + 3 - KT) * 64, tid); fetch_b(g.rb1, Btn, ldbn, (kt + 3 - KT) * 64, tid); GFENCE; }
    gemm_compute<BM, KSU>(As0, Bs0, wm, wn, r, h, acc);
    __syncthreads();
    if (kt + 2 < KT) { al.template commit<BM>(g.ra0, As0, tid); commit_b(g.rb0, Bs0, tid); GFENCE; }
    else if (hasnext) { aln.template commit<BM>(g.ra0, As0, tid); commit_b(g.rb0, Bs0, tid); GFENCE; }
    if (kt + 4 < KT) { al.template fetch<BM>(g.ra0, (kt + 4) * 64, tid); fetch_b(g.rb0, Bt, ldb, (kt + 4) * 64, tid); GFENCE; }
    else if (hasnext) { aln.template fetch<BM>(g.ra0, (kt + 4 - KT) * 64, tid); fetch_b(g.rb0, Btn, ldbn, (kt + 4 - KT) * 64, tid); GFENCE; }
    gemm_compute<BM, KSU>(As1, Bs1, wm, wn, r, h, acc);
    __syncthreads();
  }
}

template <int BM, class AL, int KSU = 4, int K = 1024>
DI void gemm_tile(const AL& al, const u16* __restrict__ Bt, int ldb, char* smem, f32x16 (&acc)[BM / 128][2]) {
  GemmRegs<BM> g;
  gemm_prime<BM>(g, al, Bt, ldb, smem);
  gemm_run<BM, AL, KSU, K, AL>(g, al, Bt, ldb, al, Bt, ldb, false, smem, acc);
}

DI void phase0(const Params& p, char* smem) {
  const int tid = my_tid(), lane = tid & 63, wid = tid >> 6, bid = blockIdx.x, nb = gridDim.x;
  float* sm = (float*)smem;
  {
    float* PKW = (float*)(p.ws + OFF_PK);
    const int gt = bid * NT + tid, gn = nb * NT;
#define PKCP(src, off, cnt) for (int i = gt; i < (cnt); i += gn) PKW[(off) + i] = (src)[i];
    PKCP(p.wa_f, PK_WAF, 8192) PKCP(p.ba_f, PK_BAF, 512) PKCP(p.wa_b, PK_WAB, 8192) PKCP(p.ba_b, PK_BAB, 512)
    PKCP(p.gla_norm, PK_GN, 256) PKCP(p.qnorm, PK_QN, 128) PKCP(p.knorm, PK_KN, 128) PKCP(p.conv_w, PK_CW, 9216)
    PKCP(p.conv_b, PK_CB, 3072) PKCP(p.skip, PK_SK, 2048) PKCP(p.final_norm, PK_FN, 1024) PKCP(p.f3_w, PK_F3, 262144)
#undef PKCP
  }
  float* mod = (float*)(p.ws + OFF_MOD);
  for (int task = bid; task < 96; task += nb) {
    const int l = task / 48, cb = task % 48, col = cb * 64 + lane;
    const float* W = p.w_ada + (size_t)l * 1024 * 3072;
    float a0 = 0.f, a1 = 0.f, a2 = 0.f;
#pragma unroll 8
    for (int k = wid * 128; k < wid * 128 + 128; ++k) {
      float wv = W[(size_t)k * 3072 + col];
      a0 += silu_f(p.c[k]) * wv; a1 += silu_f(p.c[1024 + k]) * wv; a2 += silu_f(p.c_ctx[k]) * wv;
    }
    __syncthreads();
    sm[(wid * 3 + 0) * 64 + lane] = a0; sm[(wid * 3 + 1) * 64 + lane] = a1; sm[(wid * 3 + 2) * 64 + lane] = a2;
    __syncthreads();
    if (tid < 192) {
      int v = tid >> 6; float s = p.b_ada[l * 3072 + col];
      for (int w = 0; w < 8; ++w) s += sm[(w * 3 + v) * 64 + lane];
      mod[(l * 3 + v) * 3072 + col] = s;
    }
    __syncthreads();
  }
  for (int it = bid; it < (2 * TB) / 8; it += nb) {
    const int gr = it * 8 + wid, l = gr / TB, rr = gr - l * TB;
    const bool lat = rr < L; const int t = lat ? rr : rr - L; const int Lq = lat ? L : LC;
    float* em = sm + wid * 104; float* h1 = em + 40;
    __syncthreads();
    if (lane < 33) {
      float v;
      if (lane == 0) v = (float)t / (float)(Lq - 1);
      else {
        int bi = (lane - 1) & 15; float fr = 1e-4f + (float)bi * ((15.f - 1e-4f) / 15.f);
        float w = 6.283185307179586f * (float)t / (float)Lq;
        v = (lane <= 16) ? cosf(fr * w) : -sinf(fr * w);
      }
      em[lane] = v;
    }
    __syncthreads();
    {
      float a = p.f1_b[l * 64 + lane];
      for (int e = 0; e < 33; ++e) a += em[e] * p.f1_w[(l * 33 + e) * 64 + lane];
      h1[lane] = sinf(p.f1_freq[l * 64 + lane] * a);
    }
    __syncthreads();
    {
      float a = p.f2_b[l * 64 + lane];
      for (int i = 0; i < 64; ++i) a += h1[i] * p.f2_w[(l * 64 + i) * 64 + lane];
      float v = sinf(p.f2_freq[l * 64 + lane] * a);
      if (lat) ((float*)(p.ws + OFF_H2T))[((size_t)l * 64 + lane) * L + t] = v;
      else ((float*)(p.ws + OFF_H2C))[((size_t)l * 256 + t) * 64 + lane] = v;
    }
  }
  __syncthreads();
  {
    constexpr int T_IN = 16 * 249, T_BR = 8 * 32, T_OUT = 16 * 32, T_LAYER = T_IN + 3 * T_BR + T_OUT;
    float* tile = sm;
    for (int task = bid; task < 2 * T_LAYER; task += nb) {
      const int l = task / T_LAYER; int tt = task - l * T_LAYER;
      const float* src; u16* dst; int K, N, kt, ntile;
      char* wt = p.ws + OFF_WT + (size_t)l * WT_LAYER;
      if (tt < T_IN) { src = p.w_in + (size_t)l * 1024 * NIN; dst = (u16*)wt; K = 1024; N = NIN; kt = tt / 249; ntile = tt % 249; }
      else if (tt < T_IN + 3 * T_BR) {
        tt -= T_IN; int br = tt / T_BR; tt -= br * T_BR;
        src = (br == 0 ? p.w_g : (br == 1 ? p.w_a : p.w_h)) + (size_t)l * 512 * 1024; dst = (u16*)(wt + WT_IN + br * WT_BR);
        K = 512; N = 1024; kt = tt / 32; ntile = tt % 32;
      } else { tt -= T_IN + 3 * T_BR; src = p.w_o + (size_t)l * 1024 * 1024; dst = (u16*)(wt + WT_IN + 3 * WT_BR); K = 1024; N = 1024; kt = tt / 32; ntile = tt % 32; }
      const int k0 = kt * 64, n0 = ntile * 32;
#pragma unroll
      for (int i = 0; i < 4; ++i) { int kk = (tid >> 5) + 16 * i, nn = tid & 31; tile[kk * 33 + nn] = src[(size_t)(k0 + kk) * N + n0 + nn]; }
      __syncthreads();
#pragma unroll
      for (int i = 0; i < 4; ++i) { int nn = (tid >> 6) + 8 * i, kk = tid & 63; dst[(size_t)(n0 + nn) * K + k0 + kk] = f2bf(tile[kk * 33 + nn]); }
      __syncthreads();
    }
  }
}

DI void phase_norm(const Params& p, int l) {
  const int tid = my_tid(), lane = tid & 63, wid = tid >> 6;
  const float* mod = (const float*)(p.ws + OFF_MOD);
  u16* H = (u16*)(p.ws + OFF_H);
  for (int row = blockIdx.x * 8 + wid; row < R; row += gridDim.x * 8) {
    const float* src = xrow_in(p, l, row);
    const float* mv = mod + (l * 3 + modvec_of(row)) * 3072;
    float4 xv[4]; float ss = 0.f;
#pragma unroll
    for (int i = 0; i < 4; ++i) { xv[i] = *(const float4*)(src + (i * 64 + lane) * 4); ss += xv[i].x * xv[i].x + xv[i].y * xv[i].y + xv[i].z * xv[i].z + xv[i].w * xv[i].w; }
    ss = wave_sum(ss);
    const float rs = rsqrtf(ss * (1.f / 1024.f) + EPS);
#pragma unroll
    for (int i = 0; i < 4; ++i) {
      const int col = (i * 64 + lane) * 4;
      float4 sh = *(const float4*)(mv + col), sc = *(const float4*)(mv + 1024 + col);
      u32x2 o;
      o.x = pack2(xv[i].x * rs * (1.f + sc.x) + sh.x, xv[i].y * rs * (1.f + sc.y) + sh.y);
      o.y = pack2(xv[i].z * rs * (1.f + sc.z) + sh.z, xv[i].w * rs * (1.f + sc.w) + sh.w);
      *(u32x2*)(H + (size_t)row * 1024 + col) = o;
    }
  }
}

DI void phase_proj(const Params& p, int l, char* smem) {
  const int tid = my_tid(), lane = tid & 63, wid = tid >> 6, r = lane & 31, h = lane >> 5, wm = wid & 3, wn = wid >> 2;
  const u16* H = (const u16*)(p.ws + OFF_H);
  const u16* WT = (const u16*)(p.ws + OFF_WT + (size_t)l * WT_LAYER);
  u16* P = (u16*)(p.ws + OFF_P);
  u16* CT = (u16*)(p.ws + OFF_CT);
  u16* Tt = (u16*)smem;
  constexpr int LDE = 260;
  const int xcd = blockIdx.x & 7, nloc = gridDim.x >> 3;
  for (int q = blockIdx.x >> 3; q < 5 * 156; q += nloc) {
    const int g = q / 156, rem = q - g * 156, nt = rem >> 2, mt = (g * 4 + (rem & 3)) * 8 + xcd;
    if (mt >= 130) continue;
    const int m0 = mt * 256, n0 = nt * 128;
    f32x16 acc[2][2];
#pragma unroll
    for (int i = 0; i < 2; ++i) for (int j = 0; j < 2; ++j) acc[i][j] = zero16();
    ALoadN al{H + (size_t)m0 * 1024, 1024};
    gemm_tile<256, ALoadN, 4, 1024>(al, WT + (size_t)n0 * 1024, 1024, smem, acc);
    const int b = m0 / TB, tk0 = m0 - b * TB;
#pragma unroll
    for (int i = 0; i < 2; ++i)
#pragma unroll
      for (int j = 0; j < 2; ++j)
#pragma unroll
        for (int g4 = 0; g4 < 4; ++g4) {
          u32x2 o; o.x = pack2(acc[i][j][4 * g4], acc[i][j][4 * g4 + 1]); o.y = pack2(acc[i][j][4 * g4 + 2], acc[i][j][4 * g4 + 3]);
          *(u32x2*)(Tt + (wn * 64 + j * 32 + r) * LDE + wm * 64 + i * 32 + 8 * g4 + 4 * h) = o;
        }
    __syncthreads();
#pragma unroll 1
    for (int cg = 0; cg < 4; ++cg) {
      const int cb = n0 + cg * 32;
      if (cb >= 4896) continue;
      bool chan; int cm;
      if (cb < 512) { chan = false; cm = cb; }
      else if (cb < 1024) { chan = true; cm = CH_GV + cb - 512; }
      else if (cb < 2208) { chan = false; cm = cb - 512; }
      else if (cb < 2336) { chan = true; cm = CH_AV + cb - 2208; }
      else if (cb < 2848) { chan = false; cm = cb - 640; }
      else { chan = true; cm = cb - 2848; }
      if (chan) {
#pragma unroll
        for (int k = 0; k < 2; ++k) {
          const int idx = tid + NT * k, ch = idx >> 5, t8 = idx & 31;
          const u16* sp = Tt + (cg * 32 + ch) * LDE + t8 * 8;
          const u32x2 lo = *(const u32x2*)sp, hi = *(const u32x2*)(sp + 4);
          *(u32x4*)(CT + ((size_t)(cm + ch) * 2 + b) * TB + tk0 + t8 * 8) = u32x4{lo.x, lo.y, hi.x, hi.y};
        }
      } else {
#pragma unroll
        for (int k = 0; k < 2; ++k) {
          const int idx = tid + NT * k, row = idx >> 2, c8 = idx & 3;
          const u16* sp = Tt + (cg * 32 + c8 * 8) * LDE + row;
          u32x4 o;
          o.x = (unsigned)sp[0] | ((unsigned)sp[LDE] << 16); o.y = (unsigned)sp[2 * LDE] | ((unsigned)sp[3 * LDE] << 16);
          o.z = (unsigned)sp[4 * LDE] | ((unsigned)sp[5 * LDE] << 16); o.w = (unsigned)sp[6 * LDE] | ((unsigned)sp[7 * LDE] << 16);
          *(u32x4*)(P + (size_t)(m0 + row) * NP + cm + c8 * 8) = o;
        }
      }
    }
  }
}

DI void attn_prep(const Params& p, int l, int dry) {
  const int tid = my_tid(), lane = tid & 63, wid = tid >> 6;
  u16* P = (u16*)(p.ws + OFF_P);
  const float gq = pk(p, PK_QN)[l * 64 + lane], gk = pk(p, PK_KN)[l * 64 + lane];
  for (int row = blockIdx.x * 8 + wid; row < R; row += gridDim.x * 8) {
    u16* Pr = P + (size_t)row * NP;
    const int b = row / TB, tk = row - b * TB;
    float cs = 1.f, sn = 0.f;
    if (tk >= LC) {
      const int t = tk - LC, pi = lane >> 1;
      const float pos = (pi < 16) ? (float)(t >> 6) : (float)(t & 63);
      const float inv = powf(10000.f, -(float)(2 * (pi & 15)) / 32.f);
      sincosf(pos * inv, &sn, &cs);
    }
#pragma unroll
    for (int hd = 0; hd < 10; ++hd) {
      const int col = (hd < 8) ? PC_AQ + hd * 64 + lane : PC_AK + (hd - 8) * 64 + lane;
      float v = bf2f(Pr[col]);
      const float ss = wave_sum(v * v);
      v = v * rsqrtf(ss * (1.f / 64.f) + EPS) * (hd < 8 ? gq : gk);
      const float pv = __shfl_xor(v, 1);
      float o = (lane & 1) ? (pv * sn + v * cs) : (v * cs - pv * sn);
      if (hd < 8) o *= 0.125f * 1.4426950408889634f;
      if (!dry) Pr[col] = f2bf(o);
    }
  }
}

DI void fft_pass4_fwd(float2* X, int tid, int h2) {
  const float inv4 = 0.25f / (float)h2;
#pragma unroll 2
  for (int i = 0; i < 8; ++i) {
    const int g = tid + NT * i, jp = g & (h2 - 1), base = ((g - jp) << 2) + jp;
    float2 e0 = X[base], e1 = X[base + h2], e2 = X[base + 2 * h2], e3 = X[base + 3 * h2];
    const float fr = (float)jp * inv4;
    const float2 T1 = make_float2(__builtin_amdgcn_cosf(fr), -__builtin_amdgcn_sinf(fr));
    const float2 T2 = cmul(T1, T1);
    float2 a0 = cadd(e0, e2), a2 = cmul(csub(e0, e2), T1);
    float2 a1 = cadd(e1, e3), d13 = cmul(csub(e1, e3), T1);
    float2 a3 = make_float2(d13.y, -d13.x);
    X[base] = cadd(a0, a1); X[base + h2] = cmul(csub(a0, a1), T2);
    X[base + 2 * h2] = cadd(a2, a3); X[base + 3 * h2] = cmul(csub(a2, a3), T2);
  }
  __syncthreads();
}
DI void fft_pass4_inv(float2* X, int tid, int h1) {
  const float inv4 = 0.25f / (float)h1;
#pragma unroll 2
  for (int i = 0; i < 8; ++i) {
    const int g = tid + NT * i, jp = g & (h1 - 1), base = ((g - jp) << 2) + jp;
    float2 e0 = X[base], e1 = X[base + h1], e2 = X[base + 2 * h1], e3 = X[base + 3 * h1];
    const float fr = (float)jp * inv4;
    const float2 V = make_float2(__builtin_amdgcn_cosf(fr), __builtin_amdgcn_sinf(fr));
    const float2 Wc = cmul(V, V);
    float2 t1 = cmul(e1, Wc), t3 = cmul(e3, Wc);
    float2 a0 = cadd(e0, t1), a1 = csub(e0, t1), a2 = cadd(e2, t3), a3 = csub(e2, t3);
    float2 u2 = cmul(a2, V), u3 = cmul(a3, V);
    u3 = make_float2(-u3.y, u3.x);
    X[base] = cadd(a0, u2); X[base + 2 * h1] = csub(a0, u2);
    X[base + h1] = cadd(a1, u3); X[base + 3 * h1] = csub(a1, u3);
  }
  __syncthreads();
}
DI constexpr float r16c(int k) { return k == 0 ? 1.f : k == 1 ? 0.9238795325112867f : k == 2 ? 0.7071067811865476f : k == 3 ? 0.3826834323650898f : k == 4 ? 0.f : k == 5 ? -0.3826834323650898f : k == 6 ? -0.7071067811865476f : -0.9238795325112867f; }
DI constexpr float r16s(int k) { return k == 0 ? 0.f : k == 1 ? 0.3826834323650898f : k == 2 ? 0.7071067811865476f : k == 3 ? 0.9238795325112867f : k == 4 ? 1.f : k == 5 ? 0.9238795325112867f : k == 6 ? 0.7071067811865476f : 0.3826834323650898f; }
template <bool INV>
DI void fft_pass16(float2* X, int tid, int q) {
  const float invq = 1.f / (16.f * (float)q);
#pragma unroll 1
  for (int it = 0; it < 2; ++it) {
    const int g = tid + NT * it, jp = g & (q - 1), base = ((g - jp) << 4) + jp;
    float vx[16], vy[16];
#pragma unroll
    for (int r = 0; r < 16; ++r) { const float2 e = X[base + r * q]; vx[r] = e.x; vy[r] = e.y; }
    const float th = (float)jp * invq;
    float bx[4], by[4];
    bx[0] = __builtin_amdgcn_cosf(th); by[0] = INV ? __builtin_amdgcn_sinf(th) : -__builtin_amdgcn_sinf(th);
#pragma unroll
    for (int s = 1; s < 4; ++s) { bx[s] = bx[s - 1] * bx[s - 1] - by[s - 1] * by[s - 1]; by[s] = 2.f * bx[s - 1] * by[s - 1]; }
#pragma unroll
    for (int ss = 0; ss < 4; ++ss) {
      const int s = INV ? 3 - ss : ss;
      const int rs = 8 >> s;
#pragma unroll
      for (int bf = 0; bf < 8; ++bf) {
        const int r = ((bf & ~(rs - 1)) << 1) | (bf & (rs - 1));
        const int k = (r & (rs - 1)) * (8 / rs);
        const float cc = r16c(k), cs = INV ? r16s(k) : -r16s(k);
        const float tx = bx[s] * cc - by[s] * cs, ty = bx[s] * cs + by[s] * cc;
        const float ax = vx[r], ay = vy[r], cx = vx[r + rs], cy = vy[r + rs];
        if (!INV) {
          const float dx = ax - cx, dy = ay - cy;
          vx[r] = ax + cx; vy[r] = ay + cy;
          vx[r + rs] = dx * tx - dy * ty; vy[r + rs] = dx * ty + dy * tx;
        } else {
          const float ux = cx * tx - cy * ty, uy = cx * ty + cy * tx;
          vx[r] = ax + ux; vy[r] = ay + uy;
          vx[r + rs] = ax - ux; vy[r + rs] = ay - uy;
        }
      }
    }
#pragma unroll
    for (int r = 0; r < 16; ++r) X[base + r * q] = make_float2(vx[r], vy[r]);
  }
  __syncthreads();
}
DI void fft_fwd(float2* X, int tid) {
#pragma unroll 1
  for (int q = 1024; q >= 4; q >>= 4) fft_pass16<false>(X, tid, q);
  fft_pass4_fwd(X, tid, 1);
}
DI void fft_inv(float2* X, int tid) {
  fft_pass4_inv(X, tid, 1);
#pragma unroll 1
  for (int q = 4; q <= 1024; q <<= 4) fft_pass16<true>(X, tid, q);
}
DI float sconv_at(const u16* src, int t, int len, float w0, float w1, float w2, float bb) {
  float ym = t > 0 ? bf2f(src[t - 1]) : 0.f, y0 = bf2f(src[t]), yp = t < len - 1 ? bf2f(src[t + 1]) : 0.f;
  return bb + w0 * ym + w1 * y0 + w2 * yp;
}
DI float hy_delta(int col) {
  const float A0 = -4.605170185988091f / 0.3f, A1 = -4.605170185988091f / 1.5f;
  return fabsf(A0 + (A1 - A0) * ((float)col / 2047.f));
}

DI void hyena_latent_task(const Params& p, int l, int c, char* smem, int dry) {
  float2* X = (float2*)smem;
  float* red = (float*)(smem + 131072);
  const int tid = my_tid(), lane = tid & 63, wid = tid >> 6;
  u16* CT = (u16*)(p.ws + OFF_CT);
  float2* FE = (float2*)(p.ws + OFF_FS + (size_t)blockIdx.x * 262144);
  float2* FO = FE + 16384;
  const float* h2T = (const float*)(p.ws + OFF_H2T) + (size_t)l * 64 * L;
  const float* f3w = pk(p, PK_F3) + (size_t)l * 64 * 2048;
  const float* cw = pk(p, PK_CW) + (size_t)l * 3 * 1536;
  const float* cbv = pk(p, PK_CB) + (size_t)l * 1536;
  const float vw0 = cw[c], vw1 = cw[1536 + c], vw2 = cw[3072 + c], vbb = cbv[c];
  const u16* v0 = CT + ((size_t)(CH_YU + c) * 2 + 0) * TB + LC;
  const u16* v1 = CT + ((size_t)(CH_YU + c) * 2 + 1) * TB + LC;
  u16* z10 = CT + ((size_t)(CH_YU + 512 + c) * 2 + 0) * TB + LC;
  u16* z11 = CT + ((size_t)(CH_YU + 512 + c) * 2 + 1) * TB + LC;
#pragma unroll 1
  for (int o = 0; o < 2; ++o) {
    const int cf = o * 1024 + c, cbk = cf + 512;
    float sf = 0.f, sb = 0.f;
    __syncthreads();
#ifdef PROBE_FFT
    fft_fwd(X, tid); fft_inv(X, tid);
#endif
#pragma unroll 1
    for (int half = 0; half < 2; ++half) {
      float af[16], ab[16];
#pragma unroll
      for (int i = 0; i < 16; ++i) { af[i] = 0.f; ab[i] = 0.f; }
#pragma unroll 1
      for (int j = 0; j < 64; j += 2) {
        const float wf0 = f3w[j * 2048 + cf], wb0 = f3w[j * 2048 + cbk], wf1 = f3w[(j + 1) * 2048 + cf], wb1 = f3w[(j + 1) * 2048 + cbk];
        const float* hrow = h2T + (size_t)j * L + tid + half * 16 * NT;
        float hv0[16], hv1[16];
#pragma unroll
        for (int i = 0; i < 16; ++i) { hv0[i] = hrow[NT * i]; hv1[i] = hrow[L + NT * i]; }
#pragma unroll
        for (int i = 0; i < 16; ++i) { af[i] += hv0[i] * wf0 + hv1[i] * wf1; ab[i] += hv0[i] * wb0 + hv1[i] * wb1; }
      }
      const float df = hy_delta(cf), db = hy_delta(cbk);
#pragma unroll
      for (int i = 0; i < 16; ++i) {
        const int t = tid + NT * (i + half * 16); const float tt = (float)t / (float)(L - 1);
        const float vf = af[i] * (__expf(-tt * df) + 0.05f), vb = ab[i] * (__expf(-tt * db) + 0.05f);
        sf += fabsf(vf); sb += fabsf(vb);
        X[t].x = vf;
        if (t >= 1) X[L - t].y = vb; else X[0].y = 0.f;
      }
    }
    sf = wave_sum(sf); sb = wave_sum(sb);
    if (lane == 0) { red[wid] = sf; red[8 + wid] = sb; }
    __syncthreads();
    float nf = 0.f, nbk = 0.f;
#pragma unroll
    for (int w = 0; w < 8; ++w) { nf += red[w]; nbk += red[8 + w]; }
    const float inv_f = 1.f / nf, inv_b = 1.f / nbk;
#pragma unroll 8
    for (int i = 0; i < 32; ++i) { const int n = tid + NT * i; const float2 s = X[n]; FO[n] = s; X[n] = make_float2(s.x * inv_f + s.y * inv_b, 0.f); }
    __syncthreads();
    fft_fwd(X, tid);
#pragma unroll 8
    for (int i = 0; i < 32; ++i) { const int n = tid + NT * i; FE[n] = X[n]; }
    __syncthreads();
#pragma unroll 8
    for (int i = 0; i < 32; ++i) {
      const int n = tid + NT * i; const float2 s = FO[n]; const float dd = s.x * inv_f - s.y * inv_b; const float fr = (float)n * (1.f / 32768.f);
      X[n] = make_float2(dd * __builtin_amdgcn_cosf(fr), -dd * __builtin_amdgcn_sinf(fr));
    }
    __syncthreads();
    fft_fwd(X, tid);
#pragma unroll 8
    for (int i = 0; i < 32; ++i) { const int n = tid + NT * i; FO[n] = X[n]; }
    __syncthreads();
#pragma unroll 8
    for (int i = 0; i < 32; ++i) {
      const int n = tid + NT * i;
      float2 zz;
      if (o == 0) { zz.x = sconv_at(v0, n, L, vw0, vw1, vw2, vbb); zz.y = sconv_at(v1, n, L, vw0, vw1, vw2, vbb); }
      else { zz.x = bf2f(z10[n]); zz.y = bf2f(z11[n]); }
      X[n] = zz;
    }
    __syncthreads();
    fft_fwd(X, tid);
#pragma unroll 8
    for (int i = 0; i < 32; ++i) { const int n = tid + NT * i; X[n] = cmul(X[n], FE[n]); }
    __syncthreads();
    fft_inv(X, tid);
#pragma unroll 8
    for (int i = 0; i < 32; ++i) { const int n = tid + NT * i; FE[n] = X[n]; }
    __syncthreads();
#pragma unroll 8
    for (int i = 0; i < 32; ++i) {
      const int n = tid + NT * i; const float fr = (float)n * (1.f / 32768.f);
      float2 zz;
      if (o == 0) { zz.x = sconv_at(v0, n, L, vw0, vw1, vw2, vbb); zz.y = sconv_at(v1, n, L, vw0, vw1, vw2, vbb); }
      else { zz.x = bf2f(z10[n]); zz.y = bf2f(z11[n]); }
      X[n] = cmul(zz, make_float2(__builtin_amdgcn_cosf(fr), -__builtin_amdgcn_sinf(fr)));
    }
    __syncthreads();
    fft_fwd(X, tid);
#pragma unroll 8
    for (int i = 0; i < 32; ++i) { const int n = tid + NT * i; X[n] = cmul(X[n], FO[n]); }
    __syncthreads();
    fft_inv(X, tid);
    {
      const int gch = CH_YU + 512 * (o + 1) + c;
      const float w0 = cw[gch], w1 = cw[1536 + gch], w2 = cw[3072 + gch], bb = cbv[gch];
      const u16* s0 = CT + ((size_t)gch * 2 + 0) * TB + LC;
      const u16* s1 = CT + ((size_t)gch * 2 + 1) * TB + LC;
      const float sk = pk(p, PK_SK)[(l * 2 + o) * 512 + c];
#pragma unroll 8
      for (int i = 0; i < 32; ++i) {
        const int n = tid + NT * i; const float fr = (float)n * (1.f / 32768.f);
        const float2 wb = cmul(X[n], make_float2(__builtin_amdgcn_cosf(fr), __builtin_amdgcn_sinf(fr)));
        const float2 A = FE[n];
        const float yr = (A.x + wb.x) * (1.f / 32768.f), yi = (A.y + wb.y) * (1.f / 32768.f);
        const float g0 = sconv_at(s0, n, L, w0, w1, w2, bb), g1 = sconv_at(s1, n, L, w0, w1, w2, bb);
        float2 zz;
        if (o == 0) { zz.x = sconv_at(v0, n, L, vw0, vw1, vw2, vbb); zz.y = sconv_at(v1, n, L, vw0, vw1, vw2, vbb); }
        else { zz.x = bf2f(z10[n]); zz.y = bf2f(z11[n]); }
        X[n] = make_float2(g0 * (yr + sk * zz.x), g1 * (yi + sk * zz.y));
      }
    }
    __syncthreads();
    if (o == 0) {
#pragma unroll 8
      for (int i = 0; i < 32; ++i) { const int n = tid + NT * i; const float2 zz = X[n]; if (!dry) { z10[n] = f2bf(zz.x); z11[n] = f2bf(zz.y); } }
    } else {
      u16* d0 = CT + ((size_t)(CH_YZ + c) * 2 + 0) * TB + LC;
      u16* d1 = CT + ((size_t)(CH_YZ + c) * 2 + 1) * TB + LC;
#pragma unroll 1
      for (int ib = 0; ib < 32; ib += 8) {
        u16 g0[8], g1[8];
#pragma unroll
        for (int i = 0; i < 8; ++i) { const int n = tid + NT * (ib + i); g0[i] = d0[n]; g1[i] = d1[n]; }
#pragma unroll
        for (int i = 0; i < 8; ++i) {
          const int n = tid + NT * (ib + i); const float2 zz = X[n];
          const u16 q0 = f2bf(zz.x * silu_f(bf2f(g0[i]))), q1 = f2bf(zz.y * silu_f(bf2f(g1[i])));
          if (!dry) { d0[n] = q0; d1[n] = q1; }
        }
      }
    }
    __syncthreads();
  }
}

DI void hyena_ctx_task(const Params& p, int l, int c, char* smem, int dry) {
  float* filt = (float*)smem;
  float* zs = filt + 1024;
  float* nrm = zs + 1024;
  const int tid = my_tid(), lane = tid & 63, wid = tid >> 6, t = tid & 255, hb = tid >> 8;
  u16* CT = (u16*)(p.ws + OFF_CT);
  const float* h2c = (const float*)(p.ws + OFF_H2C) + (size_t)l * 256 * 64;
  const float* f3w = pk(p, PK_F3) + (size_t)l * 64 * 2048;
  const float* cw = pk(p, PK_CW) + (size_t)l * 3 * 1536;
  const float* cbv = pk(p, PK_CB) + (size_t)l * 1536;
  __syncthreads();
  {
    const int cf = hb * 1024 + c, cbk = cf + 512;
    float a_f = 0.f, a_b = 0.f;
    for (int j = 0; j < 64; ++j) { const float hv = h2c[t * 64 + j]; a_f += hv * f3w[j * 2048 + cf]; a_b += hv * f3w[j * 2048 + cbk]; }
    const float tt = (float)t / 255.f;
    filt[(hb * 2 + 0) * 256 + t] = a_f * (__expf(-tt * hy_delta(cf)) + 0.05f);
    filt[(hb * 2 + 1) * 256 + t] = a_b * (__expf(-tt * hy_delta(cbk)) + 0.05f);
    const u16* src = CT + ((size_t)(CH_YU + c) * 2 + hb) * TB;
    zs[hb * 256 + t] = sconv_at(src, t, LC, cw[c], cw[1536 + c], cw[3072 + c], cbv[c]);
  }
  __syncthreads();
  if (wid < 4) {
    float s = 0.f;
    for (int k = 0; k < 4; ++k) s += fabsf(filt[wid * 256 + lane + 64 * k]);
    s = wave_sum(s);
    if (lane == 0) nrm[wid] = s;
  }
  __syncthreads();
  const int b = hb;
  for (int o = 0; o < 2; ++o) {
    const float inf_ = 1.f / nrm[o * 2], inb_ = 1.f / nrm[o * 2 + 1];
    const float* hf = filt + (o * 2) * 256; const float* hbk = filt + (o * 2 + 1) * 256;
    const float* zc = zs + (o & 1) * 512 + b * 256;
    float accf = 0.f, accb = 0.f;
    for (int s = 0; s <= t; ++s) accf += hf[t - s] * zc[s];
    for (int s = t + 1; s < 256; ++s) accb += hbk[s - t] * zc[s];
    const int gch = CH_YU + 512 * (o + 1) + c;
    const float gate = sconv_at(CT + ((size_t)gch * 2 + b) * TB, t, LC, cw[gch], cw[1536 + gch], cw[3072 + gch], cbv[gch]);
    const float zn = gate * (accf * inf_ + accb * inb_ + pk(p, PK_SK)[(l * 2 + o) * 512 + c] * zc[t]);
    zs[((o + 1) & 1) * 512 + b * 256 + t] = zn;
    __syncthreads();
  }
  {
    u16* d = CT + ((size_t)(CH_YZ + c) * 2 + b) * TB;
    const u16 q0 = f2bf(zs[b * 256 + t] * silu_f(bf2f(d[t])));
    if (!dry) d[t] = q0;
  }
  __syncthreads();
}

DI void gla_bcum(const Params& p, int l, int row0, int hh, int dir, float* gs, float* segs, float* was, float* as_) {
  const int tid = my_tid();
  const u16* P = (const u16*)(p.ws + OFF_P);
  const float* wa = pk(p, dir ? PK_WAB : PK_WAF) + (size_t)l * 16 * 256 + hh * 64;
  const float* ba = pk(p, dir ? PK_BAB : PK_BAF) + l * 256 + hh * 64;
#pragma unroll
  for (int i = 0; i < 2; ++i) {
    const int idx = tid + NT * i;
    was[idx] = wa[(idx >> 6) * 256 + (idx & 63)];
    as_[(idx >> 4) * 17 + (idx & 15)] = bf2f(P[(size_t)(row0 + (idx >> 4)) * NP + PC_AF + dir * 16 + (idx & 15)]);
  }
  __syncthreads();
  {
    const int t = tid >> 3, d0 = (tid & 7) * 8;
    float lin[8];
#pragma unroll
    for (int e = 0; e < 8; ++e) lin[e] = ba[d0 + e];
#pragma unroll 2
    for (int rr = 0; rr < 16; ++rr) {
      const float av = as_[t * 17 + rr];
      const float4 w0 = *(const float4*)(was + rr * 64 + d0), w1 = *(const float4*)(was + rr * 64 + d0 + 4);
      lin[0] += av * w0.x; lin[1] += av * w0.y; lin[2] += av * w0.z; lin[3] += av * w0.w;
      lin[4] += av * w1.x; lin[5] += av * w1.y; lin[6] += av * w1.z; lin[7] += av * w1.w;
    }
#pragma unroll
    for (int e = 0; e < 8; ++e) gs[t * 65 + d0 + e] = (fminf(lin[e], 0.f) - log1pf(__expf(-fabsf(lin[e])))) * (1.f / 16.f);
  }
  __syncthreads();
  {
    const int d = tid & 63, seg = tid >> 6;
    float v[8]; float run = 0.f;
#pragma unroll
    for (int e = 0; e < 8; ++e) { const int tt = dir ? seg * 8 + 7 - e : seg * 8 + e; run += gs[tt * 65 + d]; v[e] = run; }
    segs[seg * 64 + d] = run;
    __syncthreads();
    float off = 0.f;
#pragma unroll
    for (int s = 0; s < 8; ++s) { const bool before = dir ? (s > seg) : (s < seg); if (before) off += segs[s * 64 + d]; }
#pragma unroll
    for (int e = 0; e < 8; ++e) { const int tt = dir ? seg * 8 + 7 - e : seg * 8 + e; gs[tt * 65 + d] = v[e] + off; }
  }
  __syncthreads();
}
DI int gla_tok0(int dir, int n) {
  if (n < 4) return (dir ? 3 - n : n) * 64;
  return LC + (dir ? 255 - (n - 4) : n - 4) * 64;
}
constexpr int G_GS = 0;
constexpr int G_SEG = G_GS + 64 * 65 * 4;
constexpr int G_QS = G_SEG + 8 * 64 * 4;
constexpr int G_KS = G_QS + 64 * LDT * 2;
constexpr int G_VT = G_KS + 64 * LDT * 2;
constexpr int G_ST = G_VT + 128 * LDT * 2;
constexpr int G_RED = G_ST + 128 * LDT * 2;
constexpr int G_WA = G_RED + 8 * 32 * 4;
constexpr int G_AS = G_WA + 16 * 64 * 4;

DI void gla_g1_task(const Params& p, int l, int chain, int n, char* smem) {
  const int tid = my_tid(), lane = tid & 63, wid = tid >> 6, r = lane & 31, h = lane >> 5;
  const int b = chain >> 3, hh = (chain >> 1) & 3, dir = chain & 1;
  const int tk0 = gla_tok0(dir, n), row0 = b * TB + tk0;
  float* gs = (float*)(smem + G_GS); float* segs = (float*)(smem + G_SEG);
  u16* kT = (u16*)(smem + G_KS); u16* vT = (u16*)(smem + G_VT);
  const u16* P = (const u16*)(p.ws + OFF_P);
  const u16* CT = (const u16*)(p.ws + OFF_CT);
  __syncthreads();
  gla_bcum(p, l, row0, hh, dir, gs, segs, (float*)(smem + G_WA), (float*)(smem + G_AS));
  const int tl = dir ? 0 : 63;
  {
    const int t = tid >> 3, d0 = (tid & 7) * 8;
    const u32x4 kv = *(const u32x4*)(P + (size_t)(row0 + t) * NP + PC_GK + hh * 64 + d0);
    const unsigned w[4] = {kv.x, kv.y, kv.z, kv.w};
#pragma unroll
    for (int e = 0; e < 8; ++e) {
      const float kx = (e & 1) ? bfhi(w[e >> 1]) : bflo(w[e >> 1]);
      kT[(d0 + e) * LDT + t] = f2bf(kx * __expf(gs[tl * 65 + d0 + e] - gs[t * 65 + d0 + e]));
    }
#pragma unroll
    for (int i = 0; i < 2; ++i) {
      const int q = tid + NT * i, v = q >> 3, cc = q & 7;
      *(u32x4*)(vT + v * LDT + cc * 8) = *(const u32x4*)(CT + ((size_t)(CH_GV + hh * 128 + v) * 2 + b) * TB + tk0 + cc * 8);
    }
    if (tid < 64) ((float*)(p.ws + OFF_GD))[((size_t)chain * NCK + n) * 64 + tid] = __expf(gs[tl * 65 + tid]);
  }
  __syncthreads();
  {
    const int vm = wid >> 1, dn = wid & 1;
    f32x16 acc = zero16();
#pragma unroll
    for (int s = 0; s < 4; ++s) {
      const bf16x8 a = *(const bf16x8*)(vT + (vm * 32 + r) * LDT + s * 16 + h * 8);
      const bf16x8 bb = *(const bf16x8*)(kT + (dn * 32 + r) * LDT + s * 16 + h * 8);
      acc = MFMA(a, bb, acc);
    }
    u16* GS = (u16*)(p.ws + OFF_GS) + ((size_t)chain * NCK + n) * 8192;
#pragma unroll
    for (int reg = 0; reg < 16; ++reg) GS[(vm * 32 + crow(reg, h)) * 64 + dn * 32 + r] = f2bf(acc[reg]);
  }
}
DI void gla_g2(const Params& p, int dry) {
  u16* GSb = (u16*)(p.ws + OFF_GS);
  const float* GD = (const float*)(p.ws + OFF_GD);
  for (int gi = blockIdx.x * NT + my_tid(); gi < 16 * 8192; gi += gridDim.x * NT) {
    const int chain = gi >> 13, e = gi & 8191, d = e & 63;
    u16* ptr = GSb + (size_t)chain * NCK * 8192 + e;
    const float* dec = GD + (size_t)chain * NCK * 64 + d;
    float S = 0.f;
#pragma unroll 1
    for (int n0 = 0; n0 < NCK; n0 += 10) {
      float ds[10], a[10];
#pragma unroll
      for (int k = 0; k < 10; ++k) { ds[k] = bf2f(ptr[(size_t)(n0 + k) * 8192]); a[k] = dec[(n0 + k) * 64]; }
#pragma unroll
      for (int k = 0; k < 10; ++k) { if (!dry) ptr[(size_t)(n0 + k) * 8192] = f2bf(S); S = a[k] * S + ds[k]; }
    }
  }
}
DI void gla_g3_task(const Params& p, int l, int b, int hh, int ci, char* smem, int dry) {
  const int tid = my_tid(), lane = tid & 63, wid = tid >> 6, r = lane & 31, h = lane >> 5;
  const int tk0 = ci * 64, row0 = b * TB + tk0;
  float* gs = (float*)(smem + G_GS); float* segs = (float*)(smem + G_SEG); float* red = (float*)(smem + G_RED);
  u16* qs = (u16*)(smem + G_QS); u16* ks = (u16*)(smem + G_KS); u16* vT = (u16*)(smem + G_VT); u16* sT = (u16*)(smem + G_ST);
  u16* P = (u16*)(p.ws + OFF_P);
  const u16* CT = (const u16*)(p.ws + OFF_CT);
  const int vm = wid >> 1, in = wid & 1;
  f32x16 o = zero16();
  __syncthreads();
#pragma unroll 1
  for (int dir = 0; dir < 2; ++dir) {
    gla_bcum(p, l, row0, hh, dir, gs, segs, (float*)(smem + G_WA), (float*)(smem + G_AS));
    const int chain = b * 8 + hh * 2 + dir;
    const int n = dir ? ((ci < 4) ? 3 - ci : 263 - ci) : ci;
    {
      const int t = tid >> 3, d0 = (tid & 7) * 8;
      const u32x4 qv = *(const u32x4*)(P + (size_t)(row0 + t) * NP + PC_GQ + hh * 64 + d0);
      const u32x4 kv = *(const u32x4*)(P + (size_t)(row0 + t) * NP + PC_GK + hh * 64 + d0);
      const unsigned qw[4] = {qv.x, qv.y, qv.z, qv.w}, kw[4] = {kv.x, kv.y, kv.z, kv.w};
      unsigned qo[4], ko[4];
#pragma unroll
      for (int e = 0; e < 4; ++e) {
        const float b0 = gs[t * 65 + d0 + 2 * e], b1 = gs[t * 65 + d0 + 2 * e + 1];
        qo[e] = pack2(bflo(qw[e]) * 0.125f * __expf(b0), bfhi(qw[e]) * 0.125f * __expf(b1));
        ko[e] = pack2(bflo(kw[e]) * __expf(-b0), bfhi(kw[e]) * __expf(-b1));
      }
      *(u32x4*)(qs + t * LDT + d0) = u32x4{qo[0], qo[1], qo[2], qo[3]};
      *(u32x4*)(ks + t * LDT + d0) = u32x4{ko[0], ko[1], ko[2], ko[3]};
      const u16* GS = (const u16*)(p.ws + OFF_GS) + ((size_t)chain * NCK + n) * 8192;
#pragma unroll
      for (int i = 0; i < 2; ++i) {
        const int q = tid + NT * i, v = q >> 3, cc = q & 7;
        *(u32x4*)(sT + v * LDT + cc * 8) = *(const u32x4*)(GS + v * 64 + cc * 8);
        if (dir == 0) *(u32x4*)(vT + v * LDT + cc * 8) = *(const u32x4*)(CT + ((size_t)(CH_GV + hh * 128 + v) * 2 + b) * TB + tk0 + cc * 8);
      }
    }
    __syncthreads();
    bf16x8 qf[4];
#pragma unroll
    for (int s = 0; s < 4; ++s) qf[s] = *(const bf16x8*)(qs + (in * 32 + r) * LDT + s * 16 + h * 8);
#pragma unroll
    for (int jt = 0; jt < 2; ++jt) {
      f32x16 at = zero16();
#pragma unroll
      for (int s = 0; s < 4; ++s) at = MFMA(*(const bf16x8*)(ks + (jt * 32 + r) * LDT + s * 16 + h * 8), qf[s], at);
      const int ii = in * 32 + r;
#pragma unroll
      for (int reg = 0; reg < 16; ++reg) {
        const int jj = jt * 32 + crow(reg, h);
        const bool keep = dir ? (jj >= ii) : (jj <= ii);
        if (!keep) at[reg] = 0.f;
      }
#pragma unroll
      for (int s = 0; s < 2; ++s) {
        const u16* vp = vT + (vm * 32 + r) * LDT + jt * 32 + 16 * s + 4 * h;
        o = MFMA(ld2x64(vp, vp + 8), pack8(at, s), o);
      }
    }
#pragma unroll
    for (int s = 0; s < 4; ++s) o = MFMA(*(const bf16x8*)(sT + (vm * 32 + r) * LDT + s * 16 + h * 8), qf[s], o);
    __syncthreads();
  }
  float ss = 0.f;
#pragma unroll
  for (int reg = 0; reg < 16; ++reg) ss += o[reg] * o[reg];
  ss += __shfl_xor(ss, 32);
  if (h == 0) red[wid * 32 + r] = ss;
  __syncthreads();
  float tot = 0.f;
#pragma unroll
  for (int m = 0; m < 4; ++m) tot += red[(m * 2 + in) * 32 + r];
  const float rs = rsqrtf(tot * (1.f / 128.f) + EPS);
  u16* zp = P + (size_t)(row0 + in * 32 + r) * NP + PC_GZ + hh * 128 + vm * 32 + 4 * h;
  const float* gn = pk(p, PK_GN) + l * 128 + vm * 32 + 4 * h;
#pragma unroll
  for (int g = 0; g < 4; ++g) {
    const u32x2 zz = *(const u32x2*)(zp + 8 * g);
    const float4 gw = *(const float4*)(gn + 8 * g);
    u32x2 out;
    out.x = pack2(o[4 * g] * rs * gw.x * silu_f(bflo(zz.x)), o[4 * g + 1] * rs * gw.y * silu_f(bfhi(zz.x)));
    out.y = pack2(o[4 * g + 2] * rs * gw.z * silu_f(bflo(zz.y)), o[4 * g + 3] * rs * gw.w * silu_f(bfhi(zz.y)));
    if (!dry) *(u32x2*)(zp + 8 * g) = out;
  }
}

DI void attn_item(const Params& p, int l, int b, int g, int qtk0, int ntiles, char* smem, int dry) {
  const int tid = my_tid(), lane = tid & 63, wid = tid >> 6, r = lane & 31, h = lane >> 5;
  u16* P = (u16*)(p.ws + OFF_P);
  const u16* CT = (const u16*)(p.ws + OFF_CT);
  u16* Ks = (u16*)smem;
  u16* Vs = Ks + 2 * 64 * LDT;
  const int hq = g * 4 + (wid >> 1);
  const size_t qrow = (size_t)b * TB + qtk0 + (wid & 1) * 32 + r;
  bf16x8 qf[4];
#pragma unroll
  for (int s = 0; s < 4; ++s) qf[s] = *(const bf16x8*)(P + qrow * NP + PC_AQ + hq * 64 + s * 16 + h * 8);
  f32x16 O[2] = {zero16(), zero16()};
  float m = -1e30f, lsum = 0.f;
  const int lr = tid >> 3, lc = (tid & 7) * 8;
  const u16* kg = P + ((size_t)b * TB + lr) * NP + PC_AK + g * 64 + lc;
  const u16* vg = CT + ((size_t)(CH_AV + g * 64 + lr) * 2 + b) * TB + lc;
  u32x4 rk = *(const u32x4*)kg, rv = *(const u32x4*)vg;
  __syncthreads();
  *(u32x4*)(Ks + lr * LDT + lc) = rk; *(u32x4*)(Vs + lr * LDT + lc) = rv;
  __syncthreads();
  float gqm = fabsf(pk(p, PK_QN)[l * 64 + lane]), gkm = fabsf(pk(p, PK_KN)[l * 64 + lane]);
#pragma unroll
  for (int o = 32; o >= 1; o >>= 1) { gqm = fmaxf(gqm, __shfl_xor(gqm, o)); gkm = fmaxf(gkm, __shfl_xor(gkm, o)); }
  const float mshift = 8.2f * 1.4426950408889634f * gqm * gkm;
  if (mshift <= 60.f) {
    f32x16 sinit;
#pragma unroll
    for (int i = 0; i < 16; ++i) sinit[i] = -mshift;
#pragma unroll 1
    for (int kt = 0; kt < ntiles; ++kt) {
      const int cur = kt & 1;
      if (kt + 1 < ntiles) { rk = *(const u32x4*)(kg + (size_t)(kt + 1) * 64 * NP); rv = *(const u32x4*)(vg + (kt + 1) * 64); }
      const u16* Kc = Ks + cur * 64 * LDT; const u16* Vc = Vs + cur * 64 * LDT;
      f32x16 st[2];
#pragma unroll
      for (int kk = 0; kk < 2; ++kk) {
        st[kk] = sinit;
#pragma unroll
        for (int s = 0; s < 4; ++s) st[kk] = MFMA(*(const bf16x8*)(Kc + (kk * 32 + r) * LDT + s * 16 + h * 8), qf[s], st[kk]);
      }
#pragma unroll
      for (int kk = 0; kk < 2; ++kk)
#pragma unroll
        for (int i = 0; i < 16; ++i) { const float pv = __builtin_amdgcn_exp2f(st[kk][i]); st[kk][i] = pv; lsum += pv; }
#pragma unroll
      for (int kk = 0; kk < 2; ++kk)
#pragma unroll
        for (int s = 0; s < 2; ++s) {
          const bf16x8 pb = pack8(st[kk], s);
#pragma unroll
          for (int mt = 0; mt < 2; ++mt) {
            const u16* vp = Vc + (mt * 32 + r) * LDT + kk * 32 + 16 * s + 4 * h;
            O[mt] = MFMA(ld2x64(vp, vp + 8), pb, O[mt]);
          }
        }
      if (kt + 1 < ntiles) { *(u32x4*)(Ks + (cur ^ 1) * 64 * LDT + lr * LDT + lc) = rk; *(u32x4*)(Vs + (cur ^ 1) * 64 * LDT + lr * LDT + lc) = rv; }
      __syncthreads();
    }
  } else {
#pragma unroll 1
    for (int kt = 0; kt < ntiles; ++kt) {
      const int cur = kt & 1;
      if (kt + 1 < ntiles) { rk = *(const u32x4*)(kg + (size_t)(kt + 1) * 64 * NP); rv = *(const u32x4*)(vg + (kt + 1) * 64); }
      const u16* Kc = Ks + cur * 64 * LDT; const u16* Vc = Vs + cur * 64 * LDT;
      f32x16 st[2];
#pragma unroll
      for (int kk = 0; kk < 2; ++kk) {
        st[kk] = zero16();
#pragma unroll
        for (int s = 0; s < 4; ++s) st[kk] = MFMA(*(const bf16x8*)(Kc + (kk * 32 + r) * LDT + s * 16 + h * 8), qf[s], st[kk]);
      }
      float mx = st[0][0];
#pragma unroll
      for (int i = 0; i < 16; ++i) { mx = fmaxf(mx, st[0][i]); mx = fmaxf(mx, st[1][i]); }
      mx = fmaxf(mx, __shfl_xor(mx, 32));
      const float mn = fmaxf(m, mx);
      const float alpha = exp2f(m - mn);
      m = mn;
      float rsum = 0.f;
#pragma unroll
      for (int kk = 0; kk < 2; ++kk)
#pragma unroll
        for (int i = 0; i < 16; ++i) { const float pv = exp2f(st[kk][i] - mn); st[kk][i] = pv; rsum += pv; }
      lsum = lsum * alpha + rsum;
#pragma unroll
      for (int mt = 0; mt < 2; ++mt)
#pragma unroll
        for (int i = 0; i < 16; ++i) O[mt][i] *= alpha;
#pragma unroll
      for (int kk = 0; kk < 2; ++kk)
#pragma unroll
        for (int s = 0; s < 2; ++s) {
          const bf16x8 pb = pack8(st[kk], s);
#pragma unroll
          for (int mt = 0; mt < 2; ++mt) {
            const u16* vp = Vc + (mt * 32 + r) * LDT + kk * 32 + 16 * s + 4 * h;
            O[mt] = MFMA(ld2x64(vp, vp + 8), pb, O[mt]);
          }
        }
      if (kt + 1 < ntiles) { *(u32x4*)(Ks + (cur ^ 1) * 64 * LDT + lr * LDT + lc) = rk; *(u32x4*)(Vs + (cur ^ 1) * 64 * LDT + lr * LDT + lc) = rv; }
      __syncthreads();
    }
  }
  lsum += __shfl_xor(lsum, 32);
  const float inv = 1.f / lsum;
  u16* op = P + qrow * NP + PC_AQ + hq * 64 + 4 * h;
  const u16* zp = P + qrow * NP + PC_AZ + hq * 64 + 4 * h;
#pragma unroll
  for (int mt = 0; mt < 2; ++mt)
#pragma unroll
    for (int gg = 0; gg < 4; ++gg) {
      const u32x2 zz = *(const u32x2*)(zp + mt * 32 + 8 * gg);
      u32x2 out;
      out.x = pack2(O[mt][4 * gg] * inv * silu_f(bflo(zz.x)), O[mt][4 * gg + 1] * inv * silu_f(bfhi(zz.x)));
      out.y = pack2(O[mt][4 * gg + 2] * inv * silu_f(bflo(zz.y)), O[mt][4 * gg + 3] * inv * silu_f(bfhi(zz.y)));
      if (!dry) *(u32x2*)(op + mt * 32 + 8 * gg) = out;
    }
}

DI void merge_accum(f32x16 (&ysum)[2], const f32x16 (&am)[1][2], const f32x16 (&ab)[1][2]) {
#pragma unroll
  for (int j = 0; j < 2; ++j)
#pragma unroll
    for (int i = 0; i < 16; ++i) ysum[j][i] += ab[0][j][i] / (1.f + __expf(-am[0][j][i]));
}
DI void phase_merge(const Params& p, int l, char* smem) {
  const int tid = my_tid(), lane = tid & 63, wid = tid >> 6, r = lane & 31, h = lane >> 5, wm = wid & 3, wn = wid >> 2;
  const int xcd = blockIdx.x & 7, nloc = gridDim.x >> 3;
  for (int q = blockIdx.x >> 3; q < 33 * 8; q += nloc) {
    const int mt = (q >> 3) * 8 + xcd, nt = q & 7, m0 = mt * 128, n0 = nt * 128;
    if (mt >= 260) continue;
    const int b = m0 / TB, tk0 = m0 - b * TB;
    if (l == 1 && tk0 < LC) continue;
    const u16* H = (const u16*)(p.ws + OFF_H) + (size_t)m0 * 1024;
    const u16* WM = (const u16*)(p.ws + OFF_WT + (size_t)l * WT_LAYER) + (size_t)(4896 + n0) * 1024;
    const u16* WBR = (const u16*)(p.ws + OFF_WT + (size_t)l * WT_LAYER + WT_IN) + (size_t)n0 * 512;
    f32x16 ysum[2] = {zero16(), zero16()};
#pragma unroll 1
    for (int br = 0; br < 2; ++br) {
      f32x16 am[1][2] = {{zero16(), zero16()}};
      ALoadN ah{H, 1024};
      gemm_tile<128, ALoadN, 4, 1024>(ah, WM + (size_t)br * 1024 * 1024, 1024, smem, am);
      f32x16 ab[1][2] = {{zero16(), zero16()}};
      ALoadN ay{(const u16*)(p.ws + OFF_P) + (size_t)m0 * NP + (br == 0 ? PC_GZ : PC_AQ), NP};
      gemm_tile<128, ALoadN, 4, 512>(ay, WBR + (size_t)br * 1024 * 512, 512, smem, ab);
      merge_accum(ysum, am, ab);
    }
    {
      f32x16 am[1][2] = {{zero16(), zero16()}};
      ALoadN ah{H, 1024};
      gemm_tile<128, ALoadN, 4, 1024>(ah, WM + (size_t)2 * 1024 * 1024, 1024, smem, am);
      f32x16 ab[1][2] = {{zero16(), zero16()}};
      ALoadT ay{(const u16*)(p.ws + OFF_CT) + ((size_t)CH_YZ * 2 + b) * TB + tk0, (size_t)2 * TB};
      gemm_tile<128, ALoadT, 4, 512>(ay, WBR + (size_t)2 * 1024 * 512, 512, smem, ab);
      merge_accum(ysum, am, ab);
    }
    u16* Y = (u16*)(p.ws + OFF_Y) + (size_t)(m0 + wm * 32 + 4 * h) * 1024 + n0 + wn * 64 + r;
#pragma unroll
    for (int j = 0; j < 2; ++j)
#pragma unroll
      for (int reg = 0; reg < 16; ++reg) Y[(size_t)((reg & 3) + 8 * (reg >> 2)) * 1024 + j * 32] = f2bf(ysum[j][reg]);
  }
}

DI void phase_out(const Params& p, int l, char* smem) {
  const int tid = my_tid(), lane = tid & 63, wid = tid >> 6, r = lane & 31, h = lane >> 5, wm = wid & 3, wn = wid >> 2;
  const u16* Yb = (const u16*)(p.ws + OFF_Y);
  const u16* WO = (const u16*)(p.ws + OFF_WT + (size_t)l * WT_LAYER + WT_IN + 3 * WT_BR);
  const float* mod = (const float*)(p.ws + OFF_MOD);
  const int xcd = blockIdx.x & 7, nloc = gridDim.x >> 3;
  auto tile_of = [&](int q, int& m0, int& n0) -> bool {
    const int mt = (q >> 3) * 8 + xcd; m0 = mt * 128; n0 = (q & 7) * 128;
    if (mt >= 260) return false;
    const int b = m0 / TB, tk0 = m0 - b * TB;
    return !(l == 1 && tk0 < LC);
  };
  auto next_q = [&](int q) -> int { int m, n; for (q += nloc; q < 33 * 8; q += nloc) if (tile_of(q, m, n)) return q; return -1; };
  int q = (int)(blockIdx.x >> 3) - nloc; q = next_q(q);
  if (q < 0) return;
  int m0, n0; tile_of(q, m0, n0);
  GemmRegs<128> gr;
  { ALoadN ay{Yb + (size_t)m0 * 1024, 1024}; gemm_prime<128>(gr, ay, WO + (size_t)n0 * 1024, 1024, smem); }
  while (true) {
    const int qn = next_q(q);
    int m0n = 0, n0n = 0; if (qn >= 0) tile_of(qn, m0n, n0n);
    const int b = m0 / TB, tk0 = m0 - b * TB;
    f32x16 acc[1][2] = {{zero16(), zero16()}};
    const ALoadN ay{Yb + (size_t)m0 * 1024, 1024}, ayn{Yb + (size_t)m0n * 1024, 1024};
    gemm_run<128, ALoadN, 4, 1024, ALoadN>(gr, ay, WO + (size_t)n0 * 1024, 1024, ayn, WO + (size_t)n0n * 1024, 1024, qn >= 0, smem, acc);
    const float* gv = mod + (l * 3 + (tk0 < LC ? 2 : b)) * 3072 + 2048;
    const float* xin = xrow_in(p, l, m0);
    float* xout = xrow_out(p, m0);
#pragma unroll
    for (int j = 0; j < 2; ++j) {
      const int col = n0 + wn * 64 + j * 32 + r;
      const float gate = gv[col];
#pragma unroll
      for (int reg = 0; reg < 16; ++reg) {
        const size_t off = (size_t)(wm * 32 + crow(reg, h)) * D + col;
        xout[off] = xin[off] + gate * acc[0][j][reg];
      }
    }
    if (qn < 0) break;
    q = qn; m0 = m0n; n0 = n0n;
  }
}

DI void phase_final(const Params& p) {
  const int tid = my_tid(), lane = tid & 63, wid = tid >> 6;
  for (int row = blockIdx.x * 8 + wid; row < NBATCH * L; row += gridDim.x * 8) {
    float* src = p.out + (size_t)row * D;
    float4 xv[4]; float ss = 0.f;
#pragma unroll
    for (int i = 0; i < 4; ++i) { xv[i] = *(const float4*)(src + (i * 64 + lane) * 4); ss += xv[i].x * xv[i].x + xv[i].y * xv[i].y + xv[i].z * xv[i].z + xv[i].w * xv[i].w; }
    ss = wave_sum(ss);
    const float rs = rsqrtf(ss * (1.f / 1024.f) + EPS);
#pragma unroll
    for (int i = 0; i < 4; ++i) {
      const int col = (i * 64 + lane) * 4;
      const float4 fw = *(const float4*)(pk(p, PK_FN) + col);
      *(float4*)(src + col) = make_float4(xv[i].x * rs * fw.x, xv[i].y * rs * fw.y, xv[i].z * rs * fw.z, xv[i].w * rs * fw.w);
    }
  }
}

DI void run_phase(const Params& p, int ph, char* smem, int dry = 0) {
  const int bid = blockIdx.x, nb = gridDim.x;
  if (ph == 0) { phase0(p, smem); return; }
  if (ph == 17) { phase_final(p); return; }
  const int l = (ph - 1) >> 3, s = (ph - 1) & 7;
  switch (s) {
    case 0: phase_norm(p, l); break;
    case 1: phase_proj(p, l, smem); break;
    case 2: {
      attn_prep(p, l, dry);
      if (l == 0) for (int c = bid; c < 512; c += nb) hyena_ctx_task(p, l, c, smem, dry);
      for (int c = bid; c < 512; c += nb) hyena_latent_task(p, l, c, smem, dry);
    } break;
    case 3: for (int t = bid; t < 16 * NCK; t += nb) gla_g1_task(p, l, t / NCK, t % NCK, smem); break;
    case 4: gla_g2(p, dry); break;
    case 5: {
      for (int it = bid; it < 1024; it += nb) { const int b = it >> 9, g = (it >> 8) & 1, qb = it & 255; attn_item(p, l, b, g, LC + qb * 64, NCK, smem, dry); }
      if (l == 0) for (int it = bid; it < 16; it += nb) { const int b = it >> 3, g = (it >> 2) & 1, qb = it & 3; attn_item(p, l, b, g, qb * 64, 4, smem, dry); }
      const int c0 = (l == 0) ? 0 : 4, per = NCK - c0;
      for (int t = bid; t < 8 * per; t += nb) { const int bh = t / per, ci = c0 + t % per; gla_g3_task(p, l, bh >> 2, bh & 3, ci, smem, dry); }
    } break;
    case 6: phase_merge(p, l, smem); break;
    case 7: phase_out(p, l, smem); break;
  }
}

#if MULTI_LAUNCH
template <int PH> __global__ void __launch_bounds__(NT) phase_kernel(Params p) {
  extern __shared__ __attribute__((aligned(16))) char smem[];
  run_phase(p, PH, smem);
}
template <int PH> static void launch_phase(const Params& p, int grid, hipStream_t stream) {
  static bool attr = false;
  if (!attr) { (void)hipFuncSetAttribute((const void*)phase_kernel<PH>, hipFuncAttributeMaxDynamicSharedMemorySize, LDS_BYTES); attr = true; }
  hipLaunchKernelGGL(phase_kernel<PH>, dim3(grid), dim3(NT), LDS_BYTES, stream, p);
}
#else
#ifndef PROBE_DUP
#define PROBE_DUP -1
#endif
#ifndef PROBE_DUP2
#define PROBE_DUP2 -1
#endif
#ifndef PROBE_DUP3
#define PROBE_DUP3 -1
#endif
__global__ void __launch_bounds__(NT) fwd_kernel(Params p) {
  extern __shared__ __attribute__((aligned(16))) char smem[];
  cg::grid_group grid = cg::this_grid();
#if PROBE_DUP >= 0
#define PHS(n) if ((n) == PROBE_DUP || (n) == PROBE_DUP2 || (n) == PROBE_DUP3) { run_phase(p, n, smem, p.phase_lo == 0 ? 1 : 0); grid.sync(); } run_phase(p, n, smem); grid.sync();
#else
#define PHS(n) run_phase(p, n, smem); grid.sync();
#endif
  PHS(0) PHS(1) PHS(2) PHS(3) PHS(4) PHS(5) PHS(6) PHS(7) PHS(8)
  PHS(9) PHS(10) PHS(11) PHS(12) PHS(13) PHS(14) PHS(15) PHS(16)
  run_phase(p, 17, smem);
}
#endif

extern "C" void kernel_launch(void* const* d_in, const int* in_sizes, int n_in, void* d_out, int out_size, void* d_ws, size_t ws_size,
                              hipStream_t stream) {
  static int grid = 0;
  if (grid == 0) {
    if (n_in != 29 || ws_size < WS_END) { fprintf(stderr, "kernel_launch: need 29 inputs and %zu B of workspace, got %d / %zu\n", (size_t)WS_END, n_in, ws_size); grid = -1; return; }
#if MULTI_LAUNCH
    grid = 256;
#else
    int dev = 0, cus = 0, per_cu = 0;
    (void)hipGetDevice(&dev);
    (void)hipDeviceGetAttribute(&cus, hipDeviceAttributeMultiprocessorCount, dev);
    if (hipFuncSetAttribute((const void*)fwd_kernel, hipFuncAttributeMaxDynamicSharedMemorySize, LDS_BYTES) != hipSuccess) { fprintf(stderr, "kernel_launch: hipFuncSetAttribute failed\n"); grid = -1; return; }
    (void)hipOccupancyMaxActiveBlocksPerMultiprocessor(&per_cu, (const void*)fwd_kernel, NT, LDS_BYTES);
    if (per_cu < 1) { fprintf(stderr, "kernel_launch: occupancy query returned %d\n", per_cu); per_cu = 1; }
    (void)hipGetLastError();
    grid = cus * per_cu;
    if (grid > 256) grid = 256;
#endif
  }
  if (grid < 0) return;
  Params p{};
  const float** pp = (const float**)&p;
  for (int i = 0; i < 29; ++i) pp[i] = (const float*)d_in[i];
  p.out = (float*)d_out; p.ws = (char*)d_ws;
  p.phase_lo = 0; p.phase_hi = 18;
#if MULTI_LAUNCH
  launch_phase<0>(p, grid, stream); launch_phase<1>(p, grid, stream); launch_phase<2>(p, grid, stream); launch_phase<3>(p, grid, stream);
  launch_phase<4>(p, grid, stream); launch_phase<5>(p, grid, stream); launch_phase<6>(p, grid, stream); launch_phase<7>(p, grid, stream);
  launch_phase<8>(p, grid, stream); launch_phase<9>(p, grid, stream); launch_phase<10>(p, grid, stream); launch_phase<11>(p, grid, stream);
  launch_phase<12>(p, grid, stream); launch_phase<13>(p, grid, stream); launch_phase<14>(p, grid, stream); launch_phase<15>(p, grid, stream);
  launch_phase<16>(p, grid, stream); launch_phase<17>(p, grid, stream);
#else
  void* args[] = {&p};
  hipError_t e = hipLaunchCooperativeKernel((const void*)fwd_kernel, dim3(grid), dim3(NT), args, LDS_BYTES, stream);
  if (e != hipSuccess) fprintf(stderr, "kernel_launch: cooperative launch failed: %s (grid %d)\n", hipGetErrorString(e), grid);
#endif
}
```

```cpp
#include <hip/hip_runtime.h>
#include <hip/hip_cooperative_groups.h>
#include <cstdio>
namespace cg = cooperative_groups;

typedef unsigned short u16;
typedef __attribute__((ext_vector_type(8))) short bf16x8;
typedef __attribute__((ext_vector_type(16))) float f32x16;
typedef __attribute__((ext_vector_type(4))) unsigned u32x4;
typedef __attribute__((ext_vector_type(2))) unsigned u32x2;
#define DI __device__ __forceinline__
#define MFMA(a, b, c) __builtin_amdgcn_mfma_f32_32x32x16_bf16((a), (b), (c), 0, 0, 0)

#ifndef MULTI_LAUNCH
#define MULTI_LAUNCH 0
#endif

constexpr int D = 1024, NBATCH = 2, L = 16384, LC = 256, TB = L + LC, R = NBATCH * TB;
constexpr int NIN = 7968;
constexpr int NP = 2208;
constexpr int NCH = 2688;
constexpr int PC_GQ = 0, PC_GK = 256, PC_GZ = 512, PC_AF = 1024, PC_AQ = 1056, PC_AK = 1568, PC_AZ = 1696;
constexpr int CH_YU = 0, CH_YZ = 1536, CH_GV = 2048, CH_AV = 2560;
constexpr int NCK = 260;
constexpr float EPS = 1e-6f;
constexpr int NT = 512;
constexpr int LDT = 72;

constexpr size_t OFF_P = 0;
constexpr size_t OFF_CT = OFF_P + (size_t)R * NP * 2;
constexpr size_t OFF_H = OFF_CT + (size_t)NCH * 2 * TB * 2;
constexpr size_t OFF_FS = OFF_H + (size_t)R * 1024 * 2;
constexpr size_t OFF_WT = OFF_FS + (size_t)256 * 262144;
constexpr size_t WT_IN = (size_t)NIN * 1024 * 2, WT_BR = (size_t)1024 * 512 * 2, WT_OUT = (size_t)1024 * 1024 * 2;
constexpr size_t WT_LAYER = WT_IN + 3 * WT_BR + WT_OUT;
constexpr size_t OFF_H2T = OFF_WT + 2 * WT_LAYER;
constexpr size_t OFF_H2C = OFF_H2T + (size_t)2 * 64 * L * 4;
constexpr size_t OFF_MOD = OFF_H2C + (size_t)2 * 256 * 64 * 4;
constexpr size_t OFF_CTX1 = OFF_MOD + (size_t)2 * 3 * 3072 * 4;
constexpr size_t OFF_GD = OFF_CTX1 + (size_t)512 * 1024 * 4;
constexpr size_t OFF_PK = OFF_GD + (size_t)16 * NCK * 64 * 4;
constexpr int PK_WAF = 0, PK_BAF = 8192, PK_WAB = 8704, PK_BAB = 16896, PK_GN = 17408, PK_QN = 17664, PK_KN = 17792, PK_CW = 17920,
              PK_CB = 27136, PK_SK = 30208, PK_FN = 32256, PK_F3 = 33280, PK_END = 33280 + 262144;
constexpr size_t WS_END = OFF_PK + (size_t)PK_END * 4;
constexpr size_t OFF_GS = OFF_CT;
constexpr size_t OFF_Y = OFF_CT;
static_assert((size_t)16 * NCK * 8192 * 2 <= (size_t)1536 * 2 * TB * 2, "alias");
static_assert((size_t)R * 1024 * 2 <= (size_t)1536 * 2 * TB * 2, "alias");

constexpr int LDS_BYTES = 131072 + 512;

struct Params {
  const float *x, *c, *ctx, *c_ctx, *w_ada, *b_ada, *w_in, *wa_f, *ba_f, *wa_b, *ba_b, *gla_norm, *qnorm, *knorm,
      *conv_w, *conv_b, *f1_w, *f1_b, *f1_freq, *f2_w, *f2_b, *f2_freq, *f3_w, *skip, *w_g, *w_a, *w_h, *w_o, *final_norm;
  float* out;
  char* ws;
  long long phase_lo, phase_hi;
};

typedef __attribute__((ext_vector_type(2))) float f32x2v;
typedef __attribute__((ext_vector_type(2))) __bf16 bf16x2v;
DI int my_tid() {
  int t = (int)threadIdx.x;
  asm volatile("" : "+v"(t));
  __builtin_assume(t >= 0 && t < NT);
  return t;
}
DI u16 f2bf(float x) { return __builtin_bit_cast(u16, (__bf16)x); }
DI float bf2f(u16 v) { return __uint_as_float(((unsigned)v) << 16); }
DI unsigned pack2(float a, float b) { f32x2v v = {a, b}; return __builtin_bit_cast(unsigned, __builtin_convertvector(v, bf16x2v)); }
DI float bflo(unsigned u) { return __uint_as_float(u << 16); }
DI float bfhi(unsigned u) { return __uint_as_float(u & 0xffff0000u); }
DI float silu_f(float x) { return x / (1.f + __expf(-x)); }
DI float wave_sum(float v) {
#pragma unroll
  for (int o = 32; o >= 1; o >>= 1) v += __shfl_xor(v, o);
  return v;
}
DI int crow(int reg, int h) { return (reg & 3) + 8 * (reg >> 2) + 4 * h; }
DI f32x16 zero16() { f32x16 z; for (int i = 0; i < 16; ++i) z[i] = 0.f; return z; }
DI bf16x8 pack8(const f32x16& x, int s) {
  u32x4 u;
  u.x = pack2(x[8 * s + 0], x[8 * s + 1]); u.y = pack2(x[8 * s + 2], x[8 * s + 3]);
  u.z = pack2(x[8 * s + 4], x[8 * s + 5]); u.w = pack2(x[8 * s + 6], x[8 * s + 7]);
  return __builtin_bit_cast(bf16x8, u);
}
DI bf16x8 ld2x64(const u16* p0, const u16* p1) {
  u32x2 a = *(const u32x2*)p0, b = *(const u32x2*)p1;
  u32x4 u; u.x = a.x; u.y = a.y; u.z = b.x; u.w = b.y;
  return __builtin_bit_cast(bf16x8, u);
}
DI float2 cmul(float2 a, float2 b) { return make_float2(a.x * b.x - a.y * b.y, a.x * b.y + a.y * b.x); }
DI float2 cadd(float2 a, float2 b) { return make_float2(a.x + b.x, a.y + b.y); }
DI float2 csub(float2 a, float2 b) { return make_float2(a.x - b.x, a.y - b.y); }

DI const float* xrow_in(const Params& p, int layer, int row) {
  int b = row / TB, tk = row - b * TB;
  if (tk < LC) return (layer == 0 ? p.ctx : (const float*)(p.ws + OFF_CTX1)) + (size_t)(b * LC + tk) * D;
  return (layer == 0 ? p.x : (const float*)p.out) + (size_t)(b * L + tk - LC) * D;
}
DI float* xrow_out(const Params& p, int row) {
  int b = row / TB, tk = row - b * TB;
  if (tk < LC) return (float*)(p.ws + OFF_CTX1) + (size_t)(b * LC + tk) * D;
  return p.out + (size_t)(b * L + tk - LC) * D;
}
DI const float* pk(const Params& p, int off) { return (const float*)(p.ws + OFF_PK) + off; }
DI int modvec_of(int row) { int b = row / TB, tk = row - b * TB; return tk < LC ? 2 : b; }

struct ALoadN {
  const u16* A; int lda;
  template <int BM> DI void fetch(u32x4 (&r)[BM / 64], int k0, int tid) const {
#pragma unroll
    for (int i = 0; i < BM / 64; ++i) { const int q = tid + NT * i; const unsigned off = (unsigned)((q >> 3) * lda + (q & 7) * 8); r[i] = *(const u32x4*)(A + off + k0); }
  }
  template <int BM> DI void commit(const u32x4 (&r)[BM / 64], u16* As, int tid) const {
#pragma unroll
    for (int i = 0; i < BM / 64; ++i) { int q = tid + NT * i; *(u32x4*)(As + (q >> 3) * LDT + (q & 7) * 8) = r[i]; }
  }
};
struct ALoadT {
  const u16* A; size_t chs;
  template <int BM> DI void fetch(u32x4 (&r)[BM / 64], int k0, int tid) const {
#pragma unroll
    for (int i = 0; i < 2; ++i) { const int q = tid + NT * i; const unsigned off = (unsigned)((q >> 4) * (int)chs + (q & 15) * 8); r[i] = *(const u32x4*)(A + off + (unsigned)(k0 * (int)chs)); }
  }
  template <int BM> DI void commit(const u32x4 (&r)[BM / 64], u16* As, int tid) const {
#pragma unroll
    for (int i = 0; i < 2; ++i) {
      int q = tid + NT * i; int ch = q >> 4, t0 = (q & 15) * 8;
      unsigned w[4] = {r[i].x, r[i].y, r[i].z, r[i].w};
#pragma unroll
      for (int e = 0; e < 4; ++e) { As[(t0 + 2 * e) * LDT + ch] = (u16)(w[e] & 0xffffu); As[(t0 + 2 * e + 1) * LDT + ch] = (u16)(w[e] >> 16); }
    }
  }
};

template <int BM, int KSU>
DI void gemm_compute(const u16* Ac, const u16* Bc, int wm, int wn, int r, int h, f32x16 (&acc)[BM / 128][2]) {
#pragma unroll KSU
  for (int ks = 0; ks < 4; ++ks) {
    bf16x8 a[BM / 128], b[2];
#pragma unroll
    for (int i = 0; i < BM / 128; ++i) a[i] = *(const bf16x8*)(Ac + (wm * (BM / 4) + i * 32 + r) * LDT + ks * 16 + h * 8);
#pragma unroll
    for (int j = 0; j < 2; ++j) b[j] = *(const bf16x8*)(Bc + (wn * 64 + j * 32 + r) * LDT + ks * 16 + h * 8);
#pragma unroll
    for (int i = 0; i < BM / 128; ++i)
#pragma unroll
      for (int j = 0; j < 2; ++j) acc[i][j] = MFMA(a[i], b[j], acc[i][j]);
  }
}
DI void fetch_b(u32x4 (&rb)[2], const u16* Bt, int ldb, int k0, int tid) {
#pragma unroll
  for (int i = 0; i < 2; ++i) { const int q = tid + NT * i; const unsigned off = (unsigned)((q >> 3) * ldb + (q & 7) * 8); rb[i] = *(const u32x4*)(Bt + off + k0); }
}
DI void commit_b(const u32x4 (&rb)[2], u16* Bs, int tid) {
#pragma unroll
  for (int i = 0; i < 2; ++i) { int q = tid + NT * i; *(u32x4*)(Bs + (q >> 3) * LDT + (q & 7) * 8) = rb[i]; }
}
template <int BM> struct GemmRegs { u32x4 ra0[BM / 64], rb0[2], ra1[BM / 64], rb1[2]; };
#define GFENCE asm volatile("" ::: "memory")
template <int BM, class AL>
DI void gemm_prime(GemmRegs<BM>& g, const AL& al, const u16* __restrict__ Bt, int ldb, char* smem) {
  u16* As0 = (u16*)smem;
  u16* Bs0 = As0 + 2 * BM * LDT;
  const int tid = my_tid();
  al.template fetch<BM>(g.ra0, 0, tid); fetch_b(g.rb0, Bt, ldb, 0, tid); GFENCE;
  al.template fetch<BM>(g.ra1, 64, tid); fetch_b(g.rb1, Bt, ldb, 64, tid); GFENCE;
  __syncthreads();
  al.template commit<BM>(g.ra0, As0, tid); commit_b(g.rb0, Bs0, tid);
  __syncthreads();
  al.template fetch<BM>(g.ra0, 128, tid); fetch_b(g.rb0, Bt, ldb, 128, tid); GFENCE;
}
template <int BM, class AL, int KSU, int K, class ALN>
DI void gemm_run(GemmRegs<BM>& g, const AL& al, const u16* __restrict__ Bt, int ldb, const ALN& aln, const u16* __restrict__ Btn, int ldbn,
                 bool hasnext, char* smem, f32x16 (&acc)[BM / 128][2]) {
  u16* As0 = (u16*)smem;
  u16* As1 = As0 + BM * LDT;
  u16* Bs0 = As0 + 2 * BM * LDT;
  u16* Bs1 = Bs0 + 128 * LDT;
  const int tid = my_tid(), lane = tid & 63, wid = tid >> 6, r = lane & 31, h = lane >> 5;
  const int wm = wid & 3, wn = wid >> 2;
  constexpr int KT = K >> 6;
#pragma unroll
  for (int kt = 0; kt < KT; kt += 2) {
    al.template commit<BM>(g.ra1, As1, tid); commit_b(g.rb1, Bs1, tid);
    GFENCE;
    if (kt + 3 < KT) { al.template fetch<BM>(g.ra1, (kt + 3) * 64, tid); fetch_b(g.rb1, Bt, ldb, (kt + 3) * 64, tid); GFENCE; }
    else if (hasnext) { aln.template fetch<BM>(g.ra1, (kt + 3 - KT) * 64, tid); fetch_b(g.rb1, Btn, ldbn, (kt + 3 - KT) * 64, tid); GFENCE; }
    gemm_compute<BM, KSU>(As0, Bs0, wm, wn, r, h, acc);
    __syncthreads();
    if (kt + 2 < KT) { al.template commit<BM>(g.ra0, As0, tid); commit_b(g.rb0, Bs0, tid); GFENCE; }
    else if (hasnext) { aln.template commit<BM>(g.ra0, As0, tid); commit_b(g.rb0, Bs0, tid); GFENCE; }
    if (kt + 4 < KT) { al.template fetch<BM>(g.ra0, (kt + 4) * 64, tid); fetch_b(g.rb0, Bt, ldb, (kt + 4) * 64, tid); GFENCE; }
    else if (hasnext) { aln.template fetch<BM>(g.ra0, (kt + 4 - KT) * 64, tid); fetch_b(g.rb0, Btn, ldbn, (kt + 4 - KT) * 64, tid); GFENCE; }
    gemm_compute<BM, KSU>(As1, Bs1, wm, wn, r, h, acc);
    __syncthreads();
  }
}

template <int BM, class AL, int KSU = 4, int K = 1024>
DI void gemm_tile(const AL& al, const u16* __restrict__ Bt, int ldb, char* smem, f32x16 (&acc)[BM / 128][2]) {
  GemmRegs<BM> g;
  gemm_prime<BM>(g, al, Bt, ldb, smem);
  gemm_run<BM, AL, KSU, K, AL>(g, al, Bt, ldb, al, Bt, ldb, false, smem, acc);
}

DI void phase0(const Params& p, char* smem) {
  const int tid = my_tid(), lane = tid & 63, wid = tid >> 6, bid = blockIdx.x, nb = gridDim.x;
  float* sm = (float*)smem;
  {
    float* PKW = (float*)(p.ws + OFF_PK);
    const int gt = bid * NT + tid, gn = nb * NT;
#define PKCP(src, off, cnt) for (int i = gt; i < (cnt); i += gn) PKW[(off) + i] = (src)[i];
    PKCP(p.wa_f, PK_WAF, 8192) PKCP(p.ba_f, PK_BAF, 512) PKCP(p.wa_b, PK_WAB, 8192) PKCP(p.ba_b, PK_BAB, 512)
    PKCP(p.gla_norm, PK_GN, 256) PKCP(p.qnorm, PK_QN, 128) PKCP(p.knorm, PK_KN, 128) PKCP(p.conv_w, PK_CW, 9216)
    PKCP(p.conv_b, PK_CB, 3072) PKCP(p.skip, PK_SK, 2048) PKCP(p.final_norm, PK_FN, 1024) PKCP(p.f3_w, PK_F3, 262144)
#undef PKCP
  }
  float* mod = (float*)(p.ws + OFF_MOD);
  for (int task = bid; task < 96; task += nb) {
    const int l = task / 48, cb = task % 48, col = cb * 64 + lane;
    const float* W = p.w_ada + (size_t)l * 1024 * 3072;
    float a0 = 0.f, a1 = 0.f, a2 = 0.f;
#pragma unroll 8
    for (int k = wid * 128; k < wid * 128 + 128; ++k) {
      float wv = W[(size_t)k * 3072 + col];
      a0 += silu_f(p.c[k]) * wv; a1 += silu_f(p.c[1024 + k]) * wv; a2 += silu_f(p.c_ctx[k]) * wv;
    }
    __syncthreads();
    sm[(wid * 3 + 0) * 64 + lane] = a0; sm[(wid * 3 + 1) * 64 + lane] = a1; sm[(wid * 3 + 2) * 64 + lane] = a2;
    __syncthreads();
    if (tid < 192) {
      int v = tid >> 6; float s = p.b_ada[l * 3072 + col];
      for (int w = 0; w < 8; ++w) s += sm[(w * 3 + v) * 64 + lane];
      mod[(l * 3 + v) * 3072 + col] = s;
    }
    __syncthreads();
  }
  for (int it = bid; it < (2 * TB) / 8; it += nb) {
    const int gr = it * 8 + wid, l = gr / TB, rr = gr - l * TB;
    const bool lat = rr < L; const int t = lat ? rr : rr - L; const int Lq = lat ? L : LC;
    float* em = sm + wid * 104; float* h1 = em + 40;
    __syncthreads();
    if (lane < 33) {
      float v;
      if (lane == 0) v = (float)t / (float)(Lq - 1);
      else {
        int bi = (lane - 1) & 15; float fr = 1e-4f + (float)bi * ((15.f - 1e-4f) / 15.f);
        float w = 6.283185307179586f * (float)t / (float)Lq;
        v = (lane <= 16) ? cosf(fr * w) : -sinf(fr * w);
      }
      em[lane] = v;
    }
    __syncthreads();
    {
      float a = p.f1_b[l * 64 + lane];
      for (int e = 0; e < 33; ++e) a += em[e] * p.f1_w[(l * 33 + e) * 64 + lane];
      h1[lane] = sinf(p.f1_freq[l * 64 + lane] * a);
    }
    __syncthreads();
    {
      float a = p.f2_b[l * 64 + lane];
      for (int i = 0; i < 64; ++i) a += h1[i] * p.f2_w[(l * 64 + i) * 64 + lane];
      float v = sinf(p.f2_freq[l * 64 + lane] * a);
      if (lat) ((float*)(p.ws + OFF_H2T))[((size_t)l * 64 + lane) * L + t] = v;
      else ((float*)(p.ws + OFF_H2C))[((size_t)l * 256 + t) * 64 + lane] = v;
    }
  }
  __syncthreads();
  {
    constexpr int T_IN = 16 * 249, T_BR = 8 * 32, T_OUT = 16 * 32, T_LAYER = T_IN + 3 * T_BR + T_OUT;
    auto decode = [&](int task, const float*& src, u16*& dst, int& K, int& N, int& k0, int& n0) {
      const int l = task / T_LAYER; int tt = task - l * T_LAYER;
      char* wt = p.ws + OFF_WT + (size_t)l * WT_LAYER;
      int kt, ntile;
      if (tt < T_IN) { src = p.w_in + (size_t)l * 1024 * NIN; dst = (u16*)wt; K = 1024; N = NIN; kt = tt / 249; ntile = tt % 249; }
      else if (tt < T_IN + 3 * T_BR) {
        tt -= T_IN; const int br = tt / T_BR; tt -= br * T_BR;
        src = (br == 0 ? p.w_g : (br == 1 ? p.w_a : p.w_h)) + (size_t)l * 512 * 1024; dst = (u16*)(wt + WT_IN + br * WT_BR);
        K = 512; N = 1024; kt = tt / 32; ntile = tt % 32;
      } else { tt -= T_IN + 3 * T_BR; src = p.w_o + (size_t)l * 1024 * 1024; dst = (u16*)(wt + WT_IN + 3 * WT_BR); K = 1024; N = 1024; kt = tt / 32; ntile = tt % 32; }
      k0 = kt * 64; n0 = ntile * 32;
    };
    float* tileA = sm;
    float* tileB = sm + 64 * 33;
    for (int task = bid; task < 2 * T_LAYER; task += 2 * nb) {
      const bool hasB = task + nb < 2 * T_LAYER;
      const float *sa, *sb = nullptr; u16 *da, *db = nullptr; int Ka, Na, k0a, n0a, Kb = 0, Nb = 0, k0b = 0, n0b = 0;
      decode(task, sa, da, Ka, Na, k0a, n0a);
      if (hasB) decode(task + nb, sb, db, Kb, Nb, k0b, n0b);
      float va[4], vb[4];
#pragma unroll
      for (int i = 0; i < 4; ++i) { const int kk = (tid >> 5) + 16 * i, nn = tid & 31; va[i] = sa[(size_t)(k0a + kk) * Na + n0a + nn]; vb[i] = hasB ? sb[(size_t)(k0b + kk) * Nb + n0b + nn] : 0.f; }
#pragma unroll
      for (int i = 0; i < 4; ++i) { const int kk = (tid >> 5) + 16 * i, nn = tid & 31; tileA[kk * 33 + nn] = va[i]; tileB[kk * 33 + nn] = vb[i]; }
      __syncthreads();
#pragma unroll
      for (int i = 0; i < 4; ++i) {
        const int nn = (tid >> 6) + 8 * i, kk = tid & 63;
        da[(size_t)(n0a + nn) * Ka + k0a + kk] = f2bf(tileA[kk * 33 + nn]);
        if (hasB) db[(size_t)(n0b + nn) * Kb + k0b + kk] = f2bf(tileB[kk * 33 + nn]);
      }
      __syncthreads();
    }
  }
}

DI void phase_norm(const Params& p, int l) {
  const int tid = my_tid(), lane = tid & 63, wid = tid >> 6;
  const float* mod = (const float*)(p.ws + OFF_MOD);
  u16* H = (u16*)(p.ws + OFF_H);
  for (int row = blockIdx.x * 8 + wid; row < R; row += gridDim.x * 8) {
    const float* src = xrow_in(p, l, row);
    const float* mv = mod + (l * 3 + modvec_of(row)) * 3072;
    float4 xv[4]; float ss = 0.f;
#pragma unroll
    for (int i = 0; i < 4; ++i) { xv[i] = *(const float4*)(src + (i * 64 + lane) * 4); ss += xv[i].x * xv[i].x + xv[i].y * xv[i].y + xv[i].z * xv[i].z + xv[i].w * xv[i].w; }
    ss = wave_sum(ss);
    const float rs = rsqrtf(ss * (1.f / 1024.f) + EPS);
#pragma unroll
    for (int i = 0; i < 4; ++i) {
      const int col = (i * 64 + lane) * 4;
      float4 sh = *(const float4*)(mv + col), sc = *(const float4*)(mv + 1024 + col);
      u32x2 o;
      o.x = pack2(xv[i].x * rs * (1.f + sc.x) + sh.x, xv[i].y * rs * (1.f + sc.y) + sh.y);
      o.y = pack2(xv[i].z * rs * (1.f + sc.z) + sh.z, xv[i].w * rs * (1.f + sc.w) + sh.w);
      *(u32x2*)(H + (size_t)row * 1024 + col) = o;
    }
  }
}

DI void phase_proj(const Params& p, int l, char* smem) {
  const int tid = my_tid(), lane = tid & 63, wid = tid >> 6, r = lane & 31, h = lane >> 5, wm = wid & 3, wn = wid >> 2;
  const u16* H = (const u16*)(p.ws + OFF_H);
  const u16* WT = (const u16*)(p.ws + OFF_WT + (size_t)l * WT_LAYER);
  u16* P = (u16*)(p.ws + OFF_P);
  u16* CT = (u16*)(p.ws + OFF_CT);
  u16* Tt = (u16*)smem;
  constexpr int LDE = 260;
  const int xcd = blockIdx.x & 7, nloc = gridDim.x >> 3;
  for (int q = blockIdx.x >> 3; q < 5 * 156; q += nloc) {
    const int g = q / 156, rem = q - g * 156, nt = rem >> 2, mt = (g * 4 + (rem & 3)) * 8 + xcd;
    if (mt >= 130) continue;
    const int m0 = mt * 256, n0 = nt * 128;
    f32x16 acc[2][2];
#pragma unroll
    for (int i = 0; i < 2; ++i) for (int j = 0; j < 2; ++j) acc[i][j] = zero16();
    ALoadN al{H + (size_t)m0 * 1024, 1024};
    gemm_tile<256, ALoadN, 4, 1024>(al, WT + (size_t)n0 * 1024, 1024, smem, acc);
    const int b = m0 / TB, tk0 = m0 - b * TB;
#pragma unroll
    for (int i = 0; i < 2; ++i)
#pragma unroll
      for (int j = 0; j < 2; ++j)
#pragma unroll
        for (int g4 = 0; g4 < 4; ++g4) {
          u32x2 o; o.x = pack2(acc[i][j][4 * g4], acc[i][j][4 * g4 + 1]); o.y = pack2(acc[i][j][4 * g4 + 2], acc[i][j][4 * g4 + 3]);
          *(u32x2*)(Tt + (wn * 64 + j * 32 + r) * LDE + wm * 64 + i * 32 + 8 * g4 + 4 * h) = o;
        }
    __syncthreads();
#pragma unroll 1
    for (int cg = 0; cg < 4; ++cg) {
      const int cb = n0 + cg * 32;
      if (cb >= 4896) continue;
      bool chan; int cm;
      if (cb < 512) { chan = false; cm = cb; }
      else if (cb < 1024) { chan = true; cm = CH_GV + cb - 512; }
      else if (cb < 2208) { chan = false; cm = cb - 512; }
      else if (cb < 2336) { chan = true; cm = CH_AV + cb - 2208; }
      else if (cb < 2848) { chan = false; cm = cb - 640; }
      else { chan = true; cm = cb - 2848; }
      if (chan) {
#pragma unroll
        for (int k = 0; k < 2; ++k) {
          const int idx = tid + NT * k, ch = idx >> 5, t8 = idx & 31;
          const u16* sp = Tt + (cg * 32 + ch) * LDE + t8 * 8;
          const u32x2 lo = *(const u32x2*)sp, hi = *(const u32x2*)(sp + 4);
          *(u32x4*)(CT + ((size_t)(cm + ch) * 2 + b) * TB + tk0 + t8 * 8) = u32x4{lo.x, lo.y, hi.x, hi.y};
        }
      } else {
#pragma unroll
        for (int k = 0; k < 2; ++k) {
          const int idx = tid + NT * k, row = idx >> 2, c8 = idx & 3;
          const u16* sp = Tt + (cg * 32 + c8 * 8) * LDE + row;
          u32x4 o;
          o.x = (unsigned)sp[0] | ((unsigned)sp[LDE] << 16); o.y = (unsigned)sp[2 * LDE] | ((unsigned)sp[3 * LDE] << 16);
          o.z = (unsigned)sp[4 * LDE] | ((unsigned)sp[5 * LDE] << 16); o.w = (unsigned)sp[6 * LDE] | ((unsigned)sp[7 * LDE] << 16);
          *(u32x4*)(P + (size_t)(m0 + row) * NP + cm + c8 * 8) = o;
        }
      }
    }
  }
}

DI void attn_prep(const Params& p, int l, int dry) {
  const int tid = my_tid(), lane = tid & 63, wid = tid >> 6;
  u16* P = (u16*)(p.ws + OFF_P);
  const float gq = pk(p, PK_QN)[l * 64 + lane], gk = pk(p, PK_KN)[l * 64 + lane];
  for (int row = blockIdx.x * 8 + wid; row < R; row += gridDim.x * 8) {
    u16* Pr = P + (size_t)row * NP;
    const int b = row / TB, tk = row - b * TB;
    float cs = 1.f, sn = 0.f;
    if (tk >= LC) {
      const int t = tk - LC, pi = lane >> 1;
      const float pos = (pi < 16) ? (float)(t >> 6) : (float)(t & 63);
      const float inv = powf(10000.f, -(float)(2 * (pi & 15)) / 32.f);
      sincosf(pos * inv, &sn, &cs);
    }
#pragma unroll
    for (int hd = 0; hd < 10; ++hd) {
      const int col = (hd < 8) ? PC_AQ + hd * 64 + lane : PC_AK + (hd - 8) * 64 + lane;
      float v = bf2f(Pr[col]);
      const float ss = wave_sum(v * v);
      v = v * rsqrtf(ss * (1.f / 64.f) + EPS) * (hd < 8 ? gq : gk);
      const float pv = __shfl_xor(v, 1);
      float o = (lane & 1) ? (pv * sn + v * cs) : (v * cs - pv * sn);
      if (hd < 8) o *= 0.125f * 1.4426950408889634f;
      if (!dry) Pr[col] = f2bf(o);
    }
  }
}

DI void fft_pass4_fwd(float2* X, int tid, int h2) {
  const float inv4 = 0.25f / (float)h2;
#pragma unroll 2
  for (int i = 0; i < 8; ++i) {
    const int g = tid + NT * i, jp = g & (h2 - 1), base = ((g - jp) << 2) + jp;
    float2 e0 = X[base], e1 = X[base + h2], e2 = X[base + 2 * h2], e3 = X[base + 3 * h2];
    const float fr = (float)jp * inv4;
    const float2 T1 = make_float2(__builtin_amdgcn_cosf(fr), -__builtin_amdgcn_sinf(fr));
    const float2 T2 = cmul(T1, T1);
    float2 a0 = cadd(e0, e2), a2 = cmul(csub(e0, e2), T1);
    float2 a1 = cadd(e1, e3), d13 = cmul(csub(e1, e3), T1);
    float2 a3 = make_float2(d13.y, -d13.x);
    X[base] = cadd(a0, a1); X[base + h2] = cmul(csub(a0, a1), T2);
    X[base + 2 * h2] = cadd(a2, a3); X[base + 3 * h2] = cmul(csub(a2, a3), T2);
  }
  __syncthreads();
}
DI void fft_pass4_inv(float2* X, int tid, int h1) {
  const float inv4 = 0.25f / (float)h1;
#pragma unroll 2
  for (int i = 0; i < 8; ++i) {
    const int g = tid + NT * i, jp = g & (h1 - 1), base = ((g - jp) << 2) + jp;
    float2 e0 = X[base], e1 = X[base + h1], e2 = X[base + 2 * h1], e3 = X[base + 3 * h1];
    const float fr = (float)jp * inv4;
    const float2 V = make_float2(__builtin_amdgcn_cosf(fr), __builtin_amdgcn_sinf(fr));
    const float2 Wc = cmul(V, V);
    float2 t1 = cmul(e1, Wc), t3 = cmul(e3, Wc);
    float2 a0 = cadd(e0, t1), a1 = csub(e0, t1), a2 = cadd(e2, t3), a3 = csub(e2, t3);
    float2 u2 = cmul(a2, V), u3 = cmul(a3, V);
    u3 = make_float2(-u3.y, u3.x);
    X[base] = cadd(a0, u2); X[base + 2 * h1] = csub(a0, u2);
    X[base + h1] = cadd(a1, u3); X[base + 3 * h1] = csub(a1, u3);
  }
  __syncthreads();
}
DI constexpr float r16c(int k) { return k == 0 ? 1.f : k == 1 ? 0.9238795325112867f : k == 2 ? 0.7071067811865476f : k == 3 ? 0.3826834323650898f : k == 4 ? 0.f : k == 5 ? -0.3826834323650898f : k == 6 ? -0.7071067811865476f : -0.9238795325112867f; }
DI constexpr float r16s(int k) { return k == 0 ? 0.f : k == 1 ? 0.3826834323650898f : k == 2 ? 0.7071067811865476f : k == 3 ? 0.9238795325112867f : k == 4 ? 1.f : k == 5 ? 0.9238795325112867f : k == 6 ? 0.7071067811865476f : 0.3826834323650898f; }
template <bool INV>
DI void fft_pass16(float2* X, int tid, int q) {
  const float invq = 1.f / (16.f * (float)q);
#pragma unroll 1
  for (int it = 0; it < 2; ++it) {
    const int g = tid + NT * it, jp = g & (q - 1), base = ((g - jp) << 4) + jp;
    float vx[16], vy[16];
#pragma unroll
    for (int r = 0; r < 16; ++r) { const float2 e = X[base + r * q]; vx[r] = e.x; vy[r] = e.y; }
    const float th = (float)jp * invq;
    float bx[4], by[4];
    bx[0] = __builtin_amdgcn_cosf(th); by[0] = INV ? __builtin_amdgcn_sinf(th) : -__builtin_amdgcn_sinf(th);
#pragma unroll
    for (int s = 1; s < 4; ++s) { bx[s] = bx[s - 1] * bx[s - 1] - by[s - 1] * by[s - 1]; by[s] = 2.f * bx[s - 1] * by[s - 1]; }
#pragma unroll
    for (int ss = 0; ss < 4; ++ss) {
      const int s = INV ? 3 - ss : ss;
      const int rs = 8 >> s;
#pragma unroll
      for (int bf = 0; bf < 8; ++bf) {
        const int r = ((bf & ~(rs - 1)) << 1) | (bf & (rs - 1));
        const int k = (r & (rs - 1)) * (8 / rs);
        const float cc = r16c(k), cs = INV ? r16s(k) : -r16s(k);
        const float tx = bx[s] * cc - by[s] * cs, ty = bx[s] * cs + by[s] * cc;
        const float ax = vx[r], ay = vy[r], cx = vx[r + rs], cy = vy[r + rs];
        if (!INV) {
          const float dx = ax - cx, dy = ay - cy;
          vx[r] = ax + cx; vy[r] = ay + cy;
          vx[r + rs] = dx * tx - dy * ty; vy[r + rs] = dx * ty + dy * tx;
        } else {
          const float ux = cx * tx - cy * ty, uy = cx * ty + cy * tx;
          vx[r] = ax + ux; vy[r] = ay + uy;
          vx[r + rs] = ax - ux; vy[r + rs] = ay - uy;
        }
      }
    }
#pragma unroll
    for (int r = 0; r < 16; ++r) X[base + r * q] = make_float2(vx[r], vy[r]);
  }
  __syncthreads();
}
DI void fft_fwd(float2* X, int tid) {
#pragma unroll 1
  for (int q = 1024; q >= 4; q >>= 4) fft_pass16<false>(X, tid, q);
  fft_pass4_fwd(X, tid, 1);
}
DI void fft_inv(float2* X, int tid) {
  fft_pass4_inv(X, tid, 1);
#pragma unroll 1
  for (int q = 4; q <= 1024; q <<= 4) fft_pass16<true>(X, tid, q);
}
DI float sconv_at(const u16* src, int t, int len, float w0, float w1, float w2, float bb) {
  float ym = t > 0 ? bf2f(src[t - 1]) : 0.f, y0 = bf2f(src[t]), yp = t < len - 1 ? bf2f(src[t + 1]) : 0.f;
  return bb + w0 * ym + w1 * y0 + w2 * yp;
}
DI float hy_delta(int col) {
  const float A0 = -4.605170185988091f / 0.3f, A1 = -4.605170185988091f / 1.5f;
  return fabsf(A0 + (A1 - A0) * ((float)col / 2047.f));
}

DI void hyena_latent_task(const Params& p, int l, int c, char* smem, int dry) {
  float2* X = (float2*)smem;
  float* red = (float*)(smem + 131072);
  const int tid = my_tid(), lane = tid & 63, wid = tid >> 6;
  u16* CT = (u16*)(p.ws + OFF_CT);
  float2* FE = (float2*)(p.ws + OFF_FS + (size_t)blockIdx.x * 262144);
  float2* FO = FE + 16384;
  const float* h2T = (const float*)(p.ws + OFF_H2T) + (size_t)l * 64 * L;
  const float* f3w = pk(p, PK_F3) + (size_t)l * 64 * 2048;
  const float* cw = pk(p, PK_CW) + (size_t)l * 3 * 1536;
  const float* cbv = pk(p, PK_CB) + (size_t)l * 1536;
  const float vw0 = cw[c], vw1 = cw[1536 + c], vw2 = cw[3072 + c], vbb = cbv[c];
  const u16* v0 = CT + ((size_t)(CH_YU + c) * 2 + 0) * TB + LC;
  const u16* v1 = CT + ((size_t)(CH_YU + c) * 2 + 1) * TB + LC;
  u16* z10 = CT + ((size_t)(CH_YU + 512 + c) * 2 + 0) * TB + LC;
  u16* z11 = CT + ((size_t)(CH_YU + 512 + c) * 2 + 1) * TB + LC;
#pragma unroll 1
  for (int o = 0; o < 2; ++o) {
    const int cf = o * 1024 + c, cbk = cf + 512;
    float sf = 0.f, sb = 0.f;
    __syncthreads();
#ifdef PROBE_FFT
    fft_fwd(X, tid); fft_inv(X, tid);
#endif
#pragma unroll 1
    for (int half = 0; half < 2; ++half) {
      float af[16], ab[16];
#pragma unroll
      for (int i = 0; i < 16; ++i) { af[i] = 0.f; ab[i] = 0.f; }
#pragma unroll 1
      for (int j = 0; j < 64; j += 2) {
        const float wf0 = f3w[j * 2048 + cf], wb0 = f3w[j * 2048 + cbk], wf1 = f3w[(j + 1) * 2048 + cf], wb1 = f3w[(j + 1) * 2048 + cbk];
        const float* hrow = h2T + (size_t)j * L + tid + half * 16 * NT;
        float hv0[16], hv1[16];
#pragma unroll
        for (int i = 0; i < 16; ++i) { hv0[i] = hrow[NT * i]; hv1[i] = hrow[L + NT * i]; }
#pragma unroll
        for (int i = 0; i < 16; ++i) { af[i] += hv0[i] * wf0 + hv1[i] * wf1; ab[i] += hv0[i] * wb0 + hv1[i] * wb1; }
      }
      const float df = hy_delta(cf), db = hy_delta(cbk);
#pragma unroll
      for (int i = 0; i < 16; ++i) {
        const int t = tid + NT * (i + half * 16); const float tt = (float)t / (float)(L - 1);
        const float vf = af[i] * (__expf(-tt * df) + 0.05f), vb = ab[i] * (__expf(-tt * db) + 0.05f);
        sf += fabsf(vf); sb += fabsf(vb);
        X[t].x = vf;
        if (t >= 1) X[L - t].y = vb; else X[0].y = 0.f;
      }
    }
    sf = wave_sum(sf); sb = wave_sum(sb);
    if (lane == 0) { red[wid] = sf; red[8 + wid] = sb; }
    __syncthreads();
    float nf = 0.f, nbk = 0.f;
#pragma unroll
    for (int w = 0; w < 8; ++w) { nf += red[w]; nbk += red[8 + w]; }
    const float inv_f = 1.f / nf, inv_b = 1.f / nbk;
#pragma unroll 8
    for (int i = 0; i < 32; ++i) { const int n = tid + NT * i; const float2 s = X[n]; FO[n] = s; X[n] = make_float2(s.x * inv_f + s.y * inv_b, 0.f); }
    __syncthreads();
    fft_fwd(X, tid);
#pragma unroll 8
    for (int i = 0; i < 32; ++i) { const int n = tid + NT * i; FE[n] = X[n]; }
    __syncthreads();
#pragma unroll 8
    for (int i = 0; i < 32; ++i) {
      const int n = tid + NT * i; const float2 s = FO[n]; const float dd = s.x * inv_f - s.y * inv_b; const float fr = (float)n * (1.f / 32768.f);
      X[n] = make_float2(dd * __builtin_amdgcn_cosf(fr), -dd * __builtin_amdgcn_sinf(fr));
    }
    __syncthreads();
    fft_fwd(X, tid);
#pragma unroll 8
    for (int i = 0; i < 32; ++i) { const int n = tid + NT * i; FO[n] = X[n]; }
    __syncthreads();
#pragma unroll 8
    for (int i = 0; i < 32; ++i) {
      const int n = tid + NT * i;
      float2 zz;
      if (o == 0) { zz.x = sconv_at(v0, n, L, vw0, vw1, vw2, vbb); zz.y = sconv_at(v1, n, L, vw0, vw1, vw2, vbb); }
      else { zz.x = bf2f(z10[n]); zz.y = bf2f(z11[n]); }
      X[n] = zz;
    }
    __syncthreads();
    fft_fwd(X, tid);
#pragma unroll 8
    for (int i = 0; i < 32; ++i) { const int n = tid + NT * i; X[n] = cmul(X[n], FE[n]); }
    __syncthreads();
    fft_inv(X, tid);
#pragma unroll 8
    for (int i = 0; i < 32; ++i) { const int n = tid + NT * i; FE[n] = X[n]; }
    __syncthreads();
#pragma unroll 8
    for (int i = 0; i < 32; ++i) {
      const int n = tid + NT * i; const float fr = (float)n * (1.f / 32768.f);
      float2 zz;
      if (o == 0) { zz.x = sconv_at(v0, n, L, vw0, vw1, vw2, vbb); zz.y = sconv_at(v1, n, L, vw0, vw1, vw2, vbb); }
      else { zz.x = bf2f(z10[n]); zz.y = bf2f(z11[n]); }
      X[n] = cmul(zz, make_float2(__builtin_amdgcn_cosf(fr), -__builtin_amdgcn_sinf(fr)));
    }
    __syncthreads();
    fft_fwd(X, tid);
#pragma unroll 8
    for (int i = 0; i < 32; ++i) { const int n = tid + NT * i; X[n] = cmul(X[n], FO[n]); }
    __syncthreads();
    fft_inv(X, tid);
    {
      const int gch = CH_YU + 512 * (o + 1) + c;
      const float w0 = cw[gch], w1 = cw[1536 + gch], w2 = cw[3072 + gch], bb = cbv[gch];
      const u16* s0 = CT + ((size_t)gch * 2 + 0) * TB + LC;
      const u16* s1 = CT + ((size_t)gch * 2 + 1) * TB + LC;
      const float sk = pk(p, PK_SK)[(l * 2 + o) * 512 + c];
#pragma unroll 8
      for (int i = 0; i < 32; ++i) {
        const int n = tid + NT * i; const float fr = (float)n * (1.f / 32768.f);
        const float2 wb = cmul(X[n], make_float2(__builtin_amdgcn_cosf(fr), __builtin_amdgcn_sinf(fr)));
        const float2 A = FE[n];
        const float yr = (A.x + wb.x) * (1.f / 32768.f), yi = (A.y + wb.y) * (1.f / 32768.f);
        const float g0 = sconv_at(s0, n, L, w0, w1, w2, bb), g1 = sconv_at(s1, n, L, w0, w1, w2, bb);
        float2 zz;
        if (o == 0) { zz.x = sconv_at(v0, n, L, vw0, vw1, vw2, vbb); zz.y = sconv_at(v1, n, L, vw0, vw1, vw2, vbb); }
        else { zz.x = bf2f(z10[n]); zz.y = bf2f(z11[n]); }
        X[n] = make_float2(g0 * (yr + sk * zz.x), g1 * (yi + sk * zz.y));
      }
    }
    __syncthreads();
    if (o == 0) {
#pragma unroll 8
      for (int i = 0; i < 32; ++i) { const int n = tid + NT * i; const float2 zz = X[n]; if (!dry) { z10[n] = f2bf(zz.x); z11[n] = f2bf(zz.y); } }
    } else {
      u16* d0 = CT + ((size_t)(CH_YZ + c) * 2 + 0) * TB + LC;
      u16* d1 = CT + ((size_t)(CH_YZ + c) * 2 + 1) * TB + LC;
#pragma unroll 1
      for (int ib = 0; ib < 32; ib += 8) {
        u16 g0[8], g1[8];
#pragma unroll
        for (int i = 0; i < 8; ++i) { const int n = tid + NT * (ib + i); g0[i] = d0[n]; g1[i] = d1[n]; }
#pragma unroll
        for (int i = 0; i < 8; ++i) {
          const int n = tid + NT * (ib + i); const float2 zz = X[n];
          const u16 q0 = f2bf(zz.x * silu_f(bf2f(g0[i]))), q1 = f2bf(zz.y * silu_f(bf2f(g1[i])));
          if (!dry) { d0[n] = q0; d1[n] = q1; }
        }
      }
    }
    __syncthreads();
  }
}

DI void hyena_ctx_task(const Params& p, int l, int c, char* smem, int dry) {
  float* filt = (float*)smem;
  float* zs = filt + 1024;
  float* nrm = zs + 1024;
  const int tid = my_tid(), lane = tid & 63, wid = tid >> 6, t = tid & 255, hb = tid >> 8;
  u16* CT = (u16*)(p.ws + OFF_CT);
  const float* h2c = (const float*)(p.ws + OFF_H2C) + (size_t)l * 256 * 64;
  const float* f3w = pk(p, PK_F3) + (size_t)l * 64 * 2048;
  const float* cw = pk(p, PK_CW) + (size_t)l * 3 * 1536;
  const float* cbv = pk(p, PK_CB) + (size_t)l * 1536;
  __syncthreads();
  {
    const int cf = hb * 1024 + c, cbk = cf + 512;
    float a_f = 0.f, a_b = 0.f;
    for (int j = 0; j < 64; ++j) { const float hv = h2c[t * 64 + j]; a_f += hv * f3w[j * 2048 + cf]; a_b += hv * f3w[j * 2048 + cbk]; }
    const float tt = (float)t / 255.f;
    filt[(hb * 2 + 0) * 256 + t] = a_f * (__expf(-tt * hy_delta(cf)) + 0.05f);
    filt[(hb * 2 + 1) * 256 + t] = a_b * (__expf(-tt * hy_delta(cbk)) + 0.05f);
    const u16* src = CT + ((size_t)(CH_YU + c) * 2 + hb) * TB;
    zs[hb * 256 + t] = sconv_at(src, t, LC, cw[c], cw[1536 + c], cw[3072 + c], cbv[c]);
  }
  __syncthreads();
  if (wid < 4) {
    float s = 0.f;
    for (int k = 0; k < 4; ++k) s += fabsf(filt[wid * 256 + lane + 64 * k]);
    s = wave_sum(s);
    if (lane == 0) nrm[wid] = s;
  }
  __syncthreads();
  const int b = hb;
  for (int o = 0; o < 2; ++o) {
    const float inf_ = 1.f / nrm[o * 2], inb_ = 1.f / nrm[o * 2 + 1];
    const float* hf = filt + (o * 2) * 256; const float* hbk = filt + (o * 2 + 1) * 256;
    const float* zc = zs + (o & 1) * 512 + b * 256;
    float accf = 0.f, accb = 0.f;
    for (int s = 0; s <= t; ++s) accf += hf[t - s] * zc[s];
    for (int s = t + 1; s < 256; ++s) accb += hbk[s - t] * zc[s];
    const int gch = CH_YU + 512 * (o + 1) + c;
    const float gate = sconv_at(CT + ((size_t)gch * 2 + b) * TB, t, LC, cw[gch], cw[1536 + gch], cw[3072 + gch], cbv[gch]);
    const float zn = gate * (accf * inf_ + accb * inb_ + pk(p, PK_SK)[(l * 2 + o) * 512 + c] * zc[t]);
    zs[((o + 1) & 1) * 512 + b * 256 + t] = zn;
    __syncthreads();
  }
  {
    u16* d = CT + ((size_t)(CH_YZ + c) * 2 + b) * TB;
    const u16 q0 = f2bf(zs[b * 256 + t] * silu_f(bf2f(d[t])));
    if (!dry) d[t] = q0;
  }
  __syncthreads();
}

DI void gla_bcum(const Params& p, int l, int row0, int hh, int dir, float* gs, float* segs, float* was, float* as_) {
  const int tid = my_tid();
  const u16* P = (const u16*)(p.ws + OFF_P);
  const float* wa = pk(p, dir ? PK_WAB : PK_WAF) + (size_t)l * 16 * 256 + hh * 64;
  const float* ba = pk(p, dir ? PK_BAB : PK_BAF) + l * 256 + hh * 64;
#pragma unroll
  for (int i = 0; i < 2; ++i) {
    const int idx = tid + NT * i;
    was[idx] = wa[(idx >> 6) * 256 + (idx & 63)];
    as_[(idx >> 4) * 17 + (idx & 15)] = bf2f(P[(size_t)(row0 + (idx >> 4)) * NP + PC_AF + dir * 16 + (idx & 15)]);
  }
  __syncthreads();
  {
    const int t = tid >> 3, d0 = (tid & 7) * 8;
    float lin[8];
#pragma unroll
    for (int e = 0; e < 8; ++e) lin[e] = ba[d0 + e];
#pragma unroll 2
    for (int rr = 0; rr < 16; ++rr) {
      const float av = as_[t * 17 + rr];
      const float4 w0 = *(const float4*)(was + rr * 64 + d0), w1 = *(const float4*)(was + rr * 64 + d0 + 4);
      lin[0] += av * w0.x; lin[1] += av * w0.y; lin[2] += av * w0.z; lin[3] += av * w0.w;
      lin[4] += av * w1.x; lin[5] += av * w1.y; lin[6] += av * w1.z; lin[7] += av * w1.w;
    }
#pragma unroll
    for (int e = 0; e < 8; ++e) gs[t * 65 + d0 + e] = (fminf(lin[e], 0.f) - log1pf(__expf(-fabsf(lin[e])))) * (1.f / 16.f);
  }
  __syncthreads();
  {
    const int d = tid & 63, seg = tid >> 6;
    float v[8]; float run = 0.f;
#pragma unroll
    for (int e = 0; e < 8; ++e) { const int tt = dir ? seg * 8 + 7 - e : seg * 8 + e; run += gs[tt * 65 + d]; v[e] = run; }
    segs[seg * 64 + d] = run;
    __syncthreads();
    float off = 0.f;
#pragma unroll
    for (int s = 0; s < 8; ++s) { const bool before = dir ? (s > seg) : (s < seg); if (before) off += segs[s * 64 + d]; }
#pragma unroll
    for (int e = 0; e < 8; ++e) { const int tt = dir ? seg * 8 + 7 - e : seg * 8 + e; gs[tt * 65 + d] = v[e] + off; }
  }
  __syncthreads();
}
DI int gla_tok0(int dir, int n) {
  if (n < 4) return (dir ? 3 - n : n) * 64;
  return LC + (dir ? 255 - (n - 4) : n - 4) * 64;
}
constexpr int G_GS = 0;
constexpr int G_SEG = G_GS + 64 * 65 * 4;
constexpr int G_QS = G_SEG + 8 * 64 * 4;
constexpr int G_KS = G_QS + 64 * LDT * 2;
constexpr int G_VT = G_KS + 64 * LDT * 2;
constexpr int G_ST = G_VT + 128 * LDT * 2;
constexpr int G_RED = G_ST + 128 * LDT * 2;
constexpr int G_WA = G_RED + 8 * 32 * 4;
constexpr int G_AS = G_WA + 16 * 64 * 4;

DI void gla_g1_task(const Params& p, int l, int chain, int n, char* smem) {
  const int tid = my_tid(), lane = tid & 63, wid = tid >> 6, r = lane & 31, h = lane >> 5;
  const int b = chain >> 3, hh = (chain >> 1) & 3, dir = chain & 1;
  const int tk0 = gla_tok0(dir, n), row0 = b * TB + tk0;
  float* gs = (float*)(smem + G_GS); float* segs = (float*)(smem + G_SEG);
  u16* kT = (u16*)(smem + G_KS); u16* vT = (u16*)(smem + G_VT);
  const u16* P = (const u16*)(p.ws + OFF_P);
  const u16* CT = (const u16*)(p.ws + OFF_CT);
  __syncthreads();
  gla_bcum(p, l, row0, hh, dir, gs, segs, (float*)(smem + G_WA), (float*)(smem + G_AS));
  const int tl = dir ? 0 : 63;
  {
    const int t = tid >> 3, d0 = (tid & 7) * 8;
    const u32x4 kv = *(const u32x4*)(P + (size_t)(row0 + t) * NP + PC_GK + hh * 64 + d0);
    const unsigned w[4] = {kv.x, kv.y, kv.z, kv.w};
#pragma unroll
    for (int e = 0; e < 8; ++e) {
      const float kx = (e & 1) ? bfhi(w[e >> 1]) : bflo(w[e >> 1]);
      kT[(d0 + e) * LDT + t] = f2bf(kx * __expf(gs[tl * 65 + d0 + e] - gs[t * 65 + d0 + e]));
    }
#pragma unroll
    for (int i = 0; i < 2; ++i) {
      const int q = tid + NT * i, v = q >> 3, cc = q & 7;
      *(u32x4*)(vT + v * LDT + cc * 8) = *(const u32x4*)(CT + ((size_t)(CH_GV + hh * 128 + v) * 2 + b) * TB + tk0 + cc * 8);
    }
    if (tid < 64) ((float*)(p.ws + OFF_GD))[((size_t)chain * NCK + n) * 64 + tid] = __expf(gs[tl * 65 + tid]);
  }
  __syncthreads();
  {
    const int vm = wid >> 1, dn = wid & 1;
    f32x16 acc = zero16();
#pragma unroll
    for (int s = 0; s < 4; ++s) {
      const bf16x8 a = *(const bf16x8*)(vT + (vm * 32 + r) * LDT + s * 16 + h * 8);
      const bf16x8 bb = *(const bf16x8*)(kT + (dn * 32 + r) * LDT + s * 16 + h * 8);
      acc = MFMA(a, bb, acc);
    }
    u16* GS = (u16*)(p.ws + OFF_GS) + ((size_t)chain * NCK + n) * 8192;
#pragma unroll
    for (int reg = 0; reg < 16; ++reg) GS[(vm * 32 + crow(reg, h)) * 64 + dn * 32 + r] = f2bf(acc[reg]);
  }
}
DI void gla_g2(const Params& p, int dry) {
  u16* GSb = (u16*)(p.ws + OFF_GS);
  const float* GD = (const float*)(p.ws + OFF_GD);
  for (int gi = blockIdx.x * NT + my_tid(); gi < 16 * 8192; gi += gridDim.x * NT) {
    const int chain = gi >> 13, e = gi & 8191, d = e & 63;
    u16* ptr = GSb + (size_t)chain * NCK * 8192 + e;
    const float* dec = GD + (size_t)chain * NCK * 64 + d;
    float S = 0.f;
#pragma unroll 1
    for (int n0 = 0; n0 < NCK; n0 += 20) {
      float ds[20], a[20];
#pragma unroll
      for (int k = 0; k < 20; ++k) { ds[k] = bf2f(ptr[(size_t)(n0 + k) * 8192]); a[k] = dec[(n0 + k) * 64]; }
#pragma unroll
      for (int k = 0; k < 20; ++k) { if (!dry) ptr[(size_t)(n0 + k) * 8192] = f2bf(S); S = a[k] * S + ds[k]; }
    }
  }
}
DI void gla_g3_task(const Params& p, int l, int b, int hh, int ci, char* smem, int dry) {
  const int tid = my_tid(), lane = tid & 63, wid = tid >> 6, r = lane & 31, h = lane >> 5;
  const int tk0 = ci * 64, row0 = b * TB + tk0;
  float* gs = (float*)(smem + G_GS); float* segs = (float*)(smem + G_SEG); float* red = (float*)(smem + G_RED);
  u16* qs = (u16*)(smem + G_QS); u16* ks = (u16*)(smem + G_KS); u16* vT = (u16*)(smem + G_VT); u16* sT = (u16*)(smem + G_ST);
  u16* P = (u16*)(p.ws + OFF_P);
  const u16* CT = (const u16*)(p.ws + OFF_CT);
  const int vm = wid >> 1, in = wid & 1;
  f32x16 o = zero16();
  __syncthreads();
#pragma unroll 1
  for (int dir = 0; dir < 2; ++dir) {
    gla_bcum(p, l, row0, hh, dir, gs, segs, (float*)(smem + G_WA), (float*)(smem + G_AS));
    const int chain = b * 8 + hh * 2 + dir;
    const int n = dir ? ((ci < 4) ? 3 - ci : 263 - ci) : ci;
    {
      const int t = tid >> 3, d0 = (tid & 7) * 8;
      const u32x4 qv = *(const u32x4*)(P + (size_t)(row0 + t) * NP + PC_GQ + hh * 64 + d0);
      const u32x4 kv = *(const u32x4*)(P + (size_t)(row0 + t) * NP + PC_GK + hh * 64 + d0);
      const unsigned qw[4] = {qv.x, qv.y, qv.z, qv.w}, kw[4] = {kv.x, kv.y, kv.z, kv.w};
      unsigned qo[4], ko[4];
#pragma unroll
      for (int e = 0; e < 4; ++e) {
        const float b0 = gs[t * 65 + d0 + 2 * e], b1 = gs[t * 65 + d0 + 2 * e + 1];
        qo[e] = pack2(bflo(qw[e]) * 0.125f * __expf(b0), bfhi(qw[e]) * 0.125f * __expf(b1));
        ko[e] = pack2(bflo(kw[e]) * __expf(-b0), bfhi(kw[e]) * __expf(-b1));
      }
      *(u32x4*)(qs + t * LDT + d0) = u32x4{qo[0], qo[1], qo[2], qo[3]};
      *(u32x4*)(ks + t * LDT + d0) = u32x4{ko[0], ko[1], ko[2], ko[3]};
      const u16* GS = (const u16*)(p.ws + OFF_GS) + ((size_t)chain * NCK + n) * 8192;
#pragma unroll
      for (int i = 0; i < 2; ++i) {
        const int q = tid + NT * i, v = q >> 3, cc = q & 7;
        *(u32x4*)(sT + v * LDT + cc * 8) = *(const u32x4*)(GS + v * 64 + cc * 8);
        if (dir == 0) *(u32x4*)(vT + v * LDT + cc * 8) = *(const u32x4*)(CT + ((size_t)(CH_GV + hh * 128 + v) * 2 + b) * TB + tk0 + cc * 8);
      }
    }
    __syncthreads();
    bf16x8 qf[4];
#pragma unroll
    for (int s = 0; s < 4; ++s) qf[s] = *(const bf16x8*)(qs + (in * 32 + r) * LDT + s * 16 + h * 8);
#pragma unroll
    for (int jt = 0; jt < 2; ++jt) {
      f32x16 at = zero16();
#pragma unroll
      for (int s = 0; s < 4; ++s) at = MFMA(*(const bf16x8*)(ks + (jt * 32 + r) * LDT + s * 16 + h * 8), qf[s], at);
      const int ii = in * 32 + r;
#pragma unroll
      for (int reg = 0; reg < 16; ++reg) {
        const int jj = jt * 32 + crow(reg, h);
        const bool keep = dir ? (jj >= ii) : (jj <= ii);
        if (!keep) at[reg] = 0.f;
      }
#pragma unroll
      for (int s = 0; s < 2; ++s) {
        const u16* vp = vT + (vm * 32 + r) * LDT + jt * 32 + 16 * s + 4 * h;
        o = MFMA(ld2x64(vp, vp + 8), pack8(at, s), o);
      }
    }
#pragma unroll
    for (int s = 0; s < 4; ++s) o = MFMA(*(const bf16x8*)(sT + (vm * 32 + r) * LDT + s * 16 + h * 8), qf[s], o);
    __syncthreads();
  }
  float ss = 0.f;
#pragma unroll
  for (int reg = 0; reg < 16; ++reg) ss += o[reg] * o[reg];
  ss += __shfl_xor(ss, 32);
  if (h == 0) red[wid * 32 + r] = ss;
  __syncthreads();
  float tot = 0.f;
#pragma unroll
  for (int m = 0; m < 4; ++m) tot += red[(m * 2 + in) * 32 + r];
  const float rs = rsqrtf(tot * (1.f / 128.f) + EPS);
  u16* zp = P + (size_t)(row0 + in * 32 + r) * NP + PC_GZ + hh * 128 + vm * 32 + 4 * h;
  const float* gn = pk(p, PK_GN) + l * 128 + vm * 32 + 4 * h;
#pragma unroll
  for (int g = 0; g < 4; ++g) {
    const u32x2 zz = *(const u32x2*)(zp + 8 * g);
    const float4 gw = *(const float4*)(gn + 8 * g);
    u32x2 out;
    out.x = pack2(o[4 * g] * rs * gw.x * silu_f(bflo(zz.x)), o[4 * g + 1] * rs * gw.y * silu_f(bfhi(zz.x)));
    out.y = pack2(o[4 * g + 2] * rs * gw.z * silu_f(bflo(zz.y)), o[4 * g + 3] * rs * gw.w * silu_f(bfhi(zz.y)));
    if (!dry) *(u32x2*)(zp + 8 * g) = out;
  }
}

DI void attn_item(const Params& p, int l, int b, int g, int qtk0, int ntiles, char* smem, int dry) {
  const int tid = my_tid(), lane = tid & 63, wid = tid >> 6, r = lane & 31, h = lane >> 5;
  u16* P = (u16*)(p.ws + OFF_P);
  const u16* CT = (const u16*)(p.ws + OFF_CT);
  u16* Ks = (u16*)smem;
  u16* Vs = Ks + 2 * 64 * LDT;
  const int hq = g * 4 + (wid >> 1);
  const size_t qrow = (size_t)b * TB + qtk0 + (wid & 1) * 32 + r;
  bf16x8 qf[4];
#pragma unroll
  for (int s = 0; s < 4; ++s) qf[s] = *(const bf16x8*)(P + qrow * NP + PC_AQ + hq * 64 + s * 16 + h * 8);
  f32x16 O[2] = {zero16(), zero16()};
  float m = -1e30f, lsum = 0.f;
  const int lr = tid >> 3, lc = (tid & 7) * 8;
  const u16* kg = P + ((size_t)b * TB + lr) * NP + PC_AK + g * 64 + lc;
  const u16* vg = CT + ((size_t)(CH_AV + g * 64 + lr) * 2 + b) * TB + lc;
  u32x4 rk = *(const u32x4*)kg, rv = *(const u32x4*)vg;
  __syncthreads();
  *(u32x4*)(Ks + lr * LDT + lc) = rk; *(u32x4*)(Vs + lr * LDT + lc) = rv;
  __syncthreads();
  float gqm = fabsf(pk(p, PK_QN)[l * 64 + lane]), gkm = fabsf(pk(p, PK_KN)[l * 64 + lane]);
#pragma unroll
  for (int o = 32; o >= 1; o >>= 1) { gqm = fmaxf(gqm, __shfl_xor(gqm, o)); gkm = fmaxf(gkm, __shfl_xor(gkm, o)); }
  const float mshift = 8.2f * 1.4426950408889634f * gqm * gkm;
  if (mshift <= 60.f) {
    f32x16 sinit;
#pragma unroll
    for (int i = 0; i < 16; ++i) sinit[i] = -mshift;
#pragma unroll 1
    for (int kt = 0; kt < ntiles; ++kt) {
      const int cur = kt & 1;
      if (kt + 1 < ntiles) { rk = *(const u32x4*)(kg + (size_t)(kt + 1) * 64 * NP); rv = *(const u32x4*)(vg + (kt + 1) * 64); }
      const u16* Kc = Ks + cur * 64 * LDT; const u16* Vc = Vs + cur * 64 * LDT;
      f32x16 st[2];
#pragma unroll
      for (int kk = 0; kk < 2; ++kk) {
        st[kk] = sinit;
#pragma unroll
        for (int s = 0; s < 4; ++s) st[kk] = MFMA(*(const bf16x8*)(Kc + (kk * 32 + r) * LDT + s * 16 + h * 8), qf[s], st[kk]);
      }
#pragma unroll
      for (int kk = 0; kk < 2; ++kk)
#pragma unroll
        for (int i = 0; i < 16; ++i) { const float pv = __builtin_amdgcn_exp2f(st[kk][i]); st[kk][i] = pv; lsum += pv; }
#pragma unroll
      for (int kk = 0; kk < 2; ++kk)
#pragma unroll
        for (int s = 0; s < 2; ++s) {
          const bf16x8 pb = pack8(st[kk], s);
#pragma unroll
          for (int mt = 0; mt < 2; ++mt) {
            const u16* vp = Vc + (mt * 32 + r) * LDT + kk * 32 + 16 * s + 4 * h;
            O[mt] = MFMA(ld2x64(vp, vp + 8), pb, O[mt]);
          }
        }
      if (kt + 1 < ntiles) { *(u32x4*)(Ks + (cur ^ 1) * 64 * LDT + lr * LDT + lc) = rk; *(u32x4*)(Vs + (cur ^ 1) * 64 * LDT + lr * LDT + lc) = rv; }
      __syncthreads();
    }
  } else {
#pragma unroll 1
    for (int kt = 0; kt < ntiles; ++kt) {
      const int cur = kt & 1;
      if (kt + 1 < ntiles) { rk = *(const u32x4*)(kg + (size_t)(kt + 1) * 64 * NP); rv = *(const u32x4*)(vg + (kt + 1) * 64); }
      const u16* Kc = Ks + cur * 64 * LDT; const u16* Vc = Vs + cur * 64 * LDT;
      f32x16 st[2];
#pragma unroll
      for (int kk = 0; kk < 2; ++kk) {
        st[kk] = zero16();
#pragma unroll
        for (int s = 0; s < 4; ++s) st[kk] = MFMA(*(const bf16x8*)(Kc + (kk * 32 + r) * LDT + s * 16 + h * 8), qf[s], st[kk]);
      }
      float mx = st[0][0];
#pragma unroll
      for (int i = 0; i < 16; ++i) { mx = fmaxf(mx, st[0][i]); mx = fmaxf(mx, st[1][i]); }
      mx = fmaxf(mx, __shfl_xor(mx, 32));
      const float mn = fmaxf(m, mx);
      const float alpha = exp2f(m - mn);
      m = mn;
      float rsum = 0.f;
#pragma unroll
      for (int kk = 0; kk < 2; ++kk)
#pragma unroll
        for (int i = 0; i < 16; ++i) { const float pv = exp2f(st[kk][i] - mn); st[kk][i] = pv; rsum += pv; }
      lsum = lsum * alpha + rsum;
#pragma unroll
      for (int mt = 0; mt < 2; ++mt)
#pragma unroll
        for (int i = 0; i < 16; ++i) O[mt][i] *= alpha;
#pragma unroll
      for (int kk = 0; kk < 2; ++kk)
#pragma unroll
        for (int s = 0; s < 2; ++s) {
          const bf16x8 pb = pack8(st[kk], s);
#pragma unroll
          for (int mt = 0; mt < 2; ++mt) {
            const u16* vp = Vc + (mt * 32 + r) * LDT + kk * 32 + 16 * s + 4 * h;
            O[mt] = MFMA(ld2x64(vp, vp + 8), pb, O[mt]);
          }
        }
      if (kt + 1 < ntiles) { *(u32x4*)(Ks + (cur ^ 1) * 64 * LDT + lr * LDT + lc) = rk; *(u32x4*)(Vs + (cur ^ 1) * 64 * LDT + lr * LDT + lc) = rv; }
      __syncthreads();
    }
  }
  lsum += __shfl_xor(lsum, 32);
  const float inv = 1.f / lsum;
  u16* op = P + qrow * NP + PC_AQ + hq * 64 + 4 * h;
  const u16* zp = P + qrow * NP + PC_AZ + hq * 64 + 4 * h;
#pragma unroll
  for (int mt = 0; mt < 2; ++mt)
#pragma unroll
    for (int gg = 0; gg < 4; ++gg) {
      const u32x2 zz = *(const u32x2*)(zp + mt * 32 + 8 * gg);
      u32x2 out;
      out.x = pack2(O[mt][4 * gg] * inv * silu_f(bflo(zz.x)), O[mt][4 * gg + 1] * inv * silu_f(bfhi(zz.x)));
      out.y = pack2(O[mt][4 * gg + 2] * inv * silu_f(bflo(zz.y)), O[mt][4 * gg + 3] * inv * silu_f(bfhi(zz.y)));
      if (!dry) *(u32x2*)(op + mt * 32 + 8 * gg) = out;
    }
}

DI void merge_accum(f32x16 (&ysum)[2], const f32x16 (&am)[1][2], const f32x16 (&ab)[1][2]) {
#pragma unroll
  for (int j = 0; j < 2; ++j)
#pragma unroll
    for (int i = 0; i < 16; ++i) ysum[j][i] += ab[0][j][i] / (1.f + __expf(-am[0][j][i]));
}
DI void phase_merge(const Params& p, int l, char* smem) {
  const int tid = my_tid(), lane = tid & 63, wid = tid >> 6, r = lane & 31, h = lane >> 5, wm = wid & 3, wn = wid >> 2;
  const int xcd = blockIdx.x & 7, nloc = gridDim.x >> 3;
  for (int q = blockIdx.x >> 3; q < 33 * 8; q += nloc) {
    const int mt = (q >> 3) * 8 + xcd, nt = q & 7, m0 = mt * 128, n0 = nt * 128;
    if (mt >= 260) continue;
    const int b = m0 / TB, tk0 = m0 - b * TB;
    if (l == 1 && tk0 < LC) continue;
    const u16* H = (const u16*)(p.ws + OFF_H) + (size_t)m0 * 1024;
    const u16* WM = (const u16*)(p.ws + OFF_WT + (size_t)l * WT_LAYER) + (size_t)(4896 + n0) * 1024;
    const u16* WBR = (const u16*)(p.ws + OFF_WT + (size_t)l * WT_LAYER + WT_IN) + (size_t)n0 * 512;
    f32x16 ysum[2] = {zero16(), zero16()};
#pragma unroll 1
    for (int br = 0; br < 2; ++br) {
      f32x16 am[1][2] = {{zero16(), zero16()}};
      ALoadN ah{H, 1024};
      gemm_tile<128, ALoadN, 4, 1024>(ah, WM + (size_t)br * 1024 * 1024, 1024, smem, am);
      f32x16 ab[1][2] = {{zero16(), zero16()}};
      ALoadN ay{(const u16*)(p.ws + OFF_P) + (size_t)m0 * NP + (br == 0 ? PC_GZ : PC_AQ), NP};
      gemm_tile<128, ALoadN, 4, 512>(ay, WBR + (size_t)br * 1024 * 512, 512, smem, ab);
      merge_accum(ysum, am, ab);
    }
    {
      f32x16 am[1][2] = {{zero16(), zero16()}};
      ALoadN ah{H, 1024};
      gemm_tile<128, ALoadN, 4, 1024>(ah, WM + (size_t)2 * 1024 * 1024, 1024, smem, am);
      f32x16 ab[1][2] = {{zero16(), zero16()}};
      ALoadT ay{(const u16*)(p.ws + OFF_CT) + ((size_t)CH_YZ * 2 + b) * TB + tk0, (size_t)2 * TB};
      gemm_tile<128, ALoadT, 4, 512>(ay, WBR + (size_t)2 * 1024 * 512, 512, smem, ab);
      merge_accum(ysum, am, ab);
    }
    u16* Y = (u16*)(p.ws + OFF_Y) + (size_t)(m0 + wm * 32 + 4 * h) * 1024 + n0 + wn * 64 + r;
#pragma unroll
    for (int j = 0; j < 2; ++j)
#pragma unroll
      for (int reg = 0; reg < 16; ++reg) Y[(size_t)((reg & 3) + 8 * (reg >> 2)) * 1024 + j * 32] = f2bf(ysum[j][reg]);
  }
}

DI void phase_out(const Params& p, int l, char* smem) {
  const int tid = my_tid(), lane = tid & 63, wid = tid >> 6, r = lane & 31, h = lane >> 5, wm = wid & 3, wn = wid >> 2;
  const u16* Yb = (const u16*)(p.ws + OFF_Y);
  const u16* WO = (const u16*)(p.ws + OFF_WT + (size_t)l * WT_LAYER + WT_IN + 3 * WT_BR);
  const float* mod = (const float*)(p.ws + OFF_MOD);
  const int xcd = blockIdx.x & 7, nloc = gridDim.x >> 3;
  auto tile_of = [&](int q, int& m0, int& n0) -> bool {
    const int mt = (q >> 3) * 8 + xcd; m0 = mt * 128; n0 = (q & 7) * 128;
    if (mt >= 260) return false;
    const int b = m0 / TB, tk0 = m0 - b * TB;
    return !(l == 1 && tk0 < LC);
  };
  auto next_q = [&](int q) -> int { int m, n; for (q += nloc; q < 33 * 8; q += nloc) if (tile_of(q, m, n)) return q; return -1; };
  int q = (int)(blockIdx.x >> 3) - nloc; q = next_q(q);
  if (q < 0) return;
  int m0, n0; tile_of(q, m0, n0);
  GemmRegs<128> gr;
  { ALoadN ay{Yb + (size_t)m0 * 1024, 1024}; gemm_prime<128>(gr, ay, WO + (size_t)n0 * 1024, 1024, smem); }
  while (true) {
    const int qn = next_q(q);
    int m0n = 0, n0n = 0; if (qn >= 0) tile_of(qn, m0n, n0n);
    const int b = m0 / TB, tk0 = m0 - b * TB;
    f32x16 acc[1][2] = {{zero16(), zero16()}};
    const ALoadN ay{Yb + (size_t)m0 * 1024, 1024}, ayn{Yb + (size_t)m0n * 1024, 1024};
    gemm_run<128, ALoadN, 4, 1024, ALoadN>(gr, ay, WO + (size_t)n0 * 1024, 1024, ayn, WO + (size_t)n0n * 1024, 1024, qn >= 0, smem, acc);
    const float* gv = mod + (l * 3 + (tk0 < LC ? 2 : b)) * 3072 + 2048;
    const float* xin = xrow_in(p, l, m0);
    float* xout = xrow_out(p, m0);
#pragma unroll
    for (int j = 0; j < 2; ++j) {
      const int col = n0 + wn * 64 + j * 32 + r;
      const float gate = gv[col];
#pragma unroll
      for (int reg = 0; reg < 16; ++reg) {
        const size_t off = (size_t)(wm * 32 + crow(reg, h)) * D + col;
        xout[off] = xin[off] + gate * acc[0][j][reg];
      }
    }
    if (qn < 0) break;
    q = qn; m0 = m0n; n0 = n0n;
  }
}

DI void phase_final(const Params& p) {
  const int tid = my_tid(), lane = tid & 63, wid = tid >> 6;
  for (int row = blockIdx.x * 8 + wid; row < NBATCH * L; row += gridDim.x * 8) {
    float* src = p.out + (size_t)row * D;
    float4 xv[4]; float ss = 0.f;
#pragma unroll
    for (int i = 0; i < 4; ++i) { xv[i] = *(const float4*)(src + (i * 64 + lane) * 4); ss += xv[i].x * xv[i].x + xv[i].y * xv[i].y + xv[i].z * xv[i].z + xv[i].w * xv[i].w; }
    ss = wave_sum(ss);
    const float rs = rsqrtf(ss * (1.f / 1024.f) + EPS);
#pragma unroll
    for (int i = 0; i < 4; ++i) {
      const int col = (i * 64 + lane) * 4;
      const float4 fw = *(const float4*)(pk(p, PK_FN) + col);
      *(float4*)(src + col) = make_float4(xv[i].x * rs * fw.x, xv[i].y * rs * fw.y, xv[i].z * rs * fw.z, xv[i].w * rs * fw.w);
    }
  }
}

DI void run_phase(const Params& p, int ph, char* smem, int dry = 0) {
  const int bid = blockIdx.x, nb = gridDim.x;
  if (ph == 0) { phase0(p, smem); return; }
  if (ph == 17) { phase_final(p); return; }
  const int l = (ph - 1) >> 3, s = (ph - 1) & 7;
  switch (s) {
    case 0: phase_norm(p, l); break;
    case 1: phase_proj(p, l, smem); break;
    case 2: {
      attn_prep(p, l, dry);
      if (l == 0) for (int c = bid; c < 512; c += nb) hyena_ctx_task(p, l, c, smem, dry);
      for (int c = bid; c < 512; c += nb) hyena_latent_task(p, l, c, smem, dry);
    } break;
    case 3: for (int t = bid; t < 16 * NCK; t += nb) gla_g1_task(p, l, t / NCK, t % NCK, smem); break;
    case 4: gla_g2(p, dry); break;
    case 5: {
      for (int it = bid; it < 1024; it += nb) { const int b = it >> 9, g = (it >> 8) & 1, qb = it & 255; attn_item(p, l, b, g, LC + qb * 64, NCK, smem, dry); }
      if (l == 0) for (int it = bid; it < 16; it += nb) { const int b = it >> 3, g = (it >> 2) & 1, qb = it & 3; attn_item(p, l, b, g, qb * 64, 4, smem, dry); }
      const int c0 = (l == 0) ? 0 : 4, per = NCK - c0;
      for (int t = bid; t < 8 * per; t += nb) { const int bh = t / per, ci = c0 + t % per; gla_g3_task(p, l, bh >> 2, bh & 3, ci, smem, dry); }
    } break;
    case 6: phase_merge(p, l, smem); break;
    case 7: phase_out(p, l, smem); break;
  }
}

#if MULTI_LAUNCH
template <int PH> __global__ void __launch_bounds__(NT) phase_kernel(Params p) {
  extern __shared__ __attribute__((aligned(16))) char smem[];
  run_phase(p, PH, smem);
}
template <int PH> static void launch_phase(const Params& p, int grid, hipStream_t stream) {
  static bool attr = false;
  if (!attr) { (void)hipFuncSetAttribute((const void*)phase_kernel<PH>, hipFuncAttributeMaxDynamicSharedMemorySize, LDS_BYTES); attr = true; }
  hipLaunchKernelGGL(phase_kernel<PH>, dim3(grid), dim3(NT), LDS_BYTES, stream, p);
}
#else
#ifndef PROBE_DUP
#define PROBE_DUP -1
#endif
#ifndef PROBE_DUP2
#define PROBE_DUP2 -1
#endif
#ifndef PROBE_DUP3
#define PROBE_DUP3 -1
#endif
__global__ void __launch_bounds__(NT) fwd_kernel(Params p) {
  extern __shared__ __attribute__((aligned(16))) char smem[];
  cg::grid_group grid = cg::this_grid();
#if PROBE_DUP >= 0
#define PHS(n) if ((n) == PROBE_DUP || (n) == PROBE_DUP2 || (n) == PROBE_DUP3) { run_phase(p, n, smem, p.phase_lo == 0 ? 1 : 0); grid.sync(); } run_phase(p, n, smem); grid.sync();
#else
#define PHS(n) run_phase(p, n, smem); grid.sync();
#endif
  PHS(0) PHS(1) PHS(2) PHS(3) PHS(4) PHS(5) PHS(6) PHS(7) PHS(8)
  PHS(9) PHS(10) PHS(11) PHS(12) PHS(13) PHS(14) PHS(15) PHS(16)
  run_phase(p, 17, smem);
}
#endif

extern "C" void kernel_launch(void* const* d_in, const int* in_sizes, int n_in, void* d_out, int out_size, void* d_ws, size_t ws_size,
                              hipStream_t stream) {
  static int grid = 0;
  if (grid == 0) {
    if (n_in != 29 || ws_size < WS_END) { fprintf(stderr, "kernel_launch: need 29 inputs and %zu B of workspace, got %d / %zu\n", (size_t)WS_END, n_in, ws_size); grid = -1; return; }
#if MULTI_LAUNCH
    grid = 256;
#else
    int dev = 0, cus = 0, per_cu = 0;
    (void)hipGetDevice(&dev);
    (void)hipDeviceGetAttribute(&cus, hipDeviceAttributeMultiprocessorCount, dev);
    if (hipFuncSetAttribute((const void*)fwd_kernel, hipFuncAttributeMaxDynamicSharedMemorySize, LDS_BYTES) != hipSuccess) { fprintf(stderr, "kernel_launch: hipFuncSetAttribute failed\n"); grid = -1; return; }
    (void)hipOccupancyMaxActiveBlocksPerMultiprocessor(&per_cu, (const void*)fwd_kernel, NT, LDS_BYTES);
    if (per_cu < 1) { fprintf(stderr, "kernel_launch: occupancy query returned %d\n", per_cu); per_cu = 1; }
    (void)hipGetLastError();
    grid = cus * per_cu;
    if (grid > 256) grid = 256;
#endif
  }
  if (grid < 0) return;
  Params p{};
  const float** pp = (const float**)&p;
  for (int i = 0; i < 29; ++i) pp[i] = (const float*)d_in[i];
  p.out = (float*)d_out; p.ws = (char*)d_ws;
  p.phase_lo = 0; p.phase_hi = 18;
#if MULTI_LAUNCH
  launch_phase<0>(p, grid, stream); launch_phase<1>(p, grid, stream); launch_phase<2>(p, grid, stream); launch_phase<3>(p, grid, stream);
  launch_phase<4>(p, grid, stream); launch_phase<5>(p, grid, stream); launch_phase<6>(p, grid, stream); launch_phase<7>(p, grid, stream);
  launch_phase<8>(p, grid, stream); launch_phase<9>(p, grid, stream); launch_phase<10>(p, grid, stream); launch_phase<11>(p, grid, stream);
  launch_phase<12>(p, grid, stream); launch_phase<13>(p, grid, stream); launch_phase<14>(p, grid, stream); launch_phase<15>(p, grid, stream);
  launch_phase<16>(p, grid, stream); launch_phase<17>(p, grid, stream);
#else
  void* args[] = {&p};
  hipError_t e = hipLaunchCooperativeKernel((const void*)fwd_kernel, dim3(grid), dim3(NT), args, LDS_BYTES, stream);
  if (e != hipSuccess) fprintf(stderr, "kernel_launch: cooperative launch failed: %s (grid %d)\n", hipGetErrorString(e), grid);
#endif
}
```

```cpp
#include <hip/hip_runtime.h>
#include <hip/hip_cooperative_groups.h>
#include <cstdio>
namespace cg = cooperative_groups;

typedef unsigned short u16;
typedef __attribute__((ext_vector_type(8))) short bf16x8;
typedef __attribute__((ext_vector_type(16))) float f32x16;
typedef __attribute__((ext_vector_type(4))) unsigned u32x4;
typedef __attribute__((ext_vector_type(2))) unsigned u32x2;
#define DI __device__ __forceinline__
#define MFMA(a, b, c) __builtin_amdgcn_mfma_f32_32x32x16_bf16((a), (b), (c), 0, 0, 0)

#ifndef MULTI_LAUNCH
#define MULTI_LAUNCH 0
#endif

constexpr int D = 1024, NBATCH = 2, L = 16384, LC = 256, TB = L + LC, R = NBATCH * TB;
constexpr int NIN = 7968;
constexpr int NP = 2208;
constexpr int NCH = 2688;
constexpr int PC_GQ = 0, PC_GK = 256, PC_GZ = 512, PC_AF = 1024, PC_AQ = 1056, PC_AK = 1568, PC_AZ = 1696;
constexpr int CH_YU = 0, CH_YZ = 1536, CH_GV = 2048, CH_AV = 2560;
constexpr int NCK = 260;
constexpr float EPS = 1e-6f;
constexpr int NT = 512;
constexpr int LDT = 72;

constexpr size_t OFF_P = 0;
constexpr size_t OFF_CT = OFF_P + (size_t)R * NP * 2;
constexpr size_t OFF_H = OFF_CT + (size_t)NCH * 2 * TB * 2;
constexpr size_t OFF_FS = OFF_H + (size_t)R * 1024 * 2;
constexpr size_t OFF_WT = OFF_FS + (size_t)256 * 262144;
constexpr size_t WT_IN = (size_t)NIN * 1024 * 2, WT_BR = (size_t)1024 * 512 * 2, WT_OUT = (size_t)1024 * 1024 * 2;
constexpr size_t WT_LAYER = WT_IN + 3 * WT_BR + WT_OUT;
constexpr size_t OFF_H2T = OFF_WT + 2 * WT_LAYER;
constexpr size_t OFF_H2C = OFF_H2T + (size_t)2 * 64 * L * 4;
constexpr size_t OFF_MOD = OFF_H2C + (size_t)2 * 256 * 64 * 4;
constexpr size_t OFF_CTX1 = OFF_MOD + (size_t)2 * 3 * 3072 * 4;
constexpr size_t OFF_GD = OFF_CTX1 + (size_t)512 * 1024 * 4;
constexpr size_t OFF_PK = OFF_GD + (size_t)16 * NCK * 64 * 4;
constexpr int PK_WAF = 0, PK_BAF = 8192, PK_WAB = 8704, PK_BAB = 16896, PK_GN = 17408, PK_QN = 17664, PK_KN = 17792, PK_CW = 17920,
              PK_CB = 27136, PK_SK = 30208, PK_FN = 32256, PK_F3 = 33280, PK_END = 33280 + 262144;
constexpr size_t WS_END = OFF_PK + (size_t)PK_END * 4;
constexpr size_t OFF_GS = OFF_CT;
constexpr size_t OFF_Y = OFF_CT;
static_assert((size_t)16 * NCK * 8192 * 2 <= (size_t)1536 * 2 * TB * 2, "alias");
static_assert((size_t)R * 1024 * 2 <= (size_t)1536 * 2 * TB * 2, "alias");

constexpr int LDS_BYTES = 2 * (128 + 384) * 72 * 2 + 512;

struct Params {
  const float *x, *c, *ctx, *c_ctx, *w_ada, *b_ada, *w_in, *wa_f, *ba_f, *wa_b, *ba_b, *gla_norm, *qnorm, *knorm,
      *conv_w, *conv_b, *f1_w, *f1_b, *f1_freq, *f2_w, *f2_b, *f2_freq, *f3_w, *skip, *w_g, *w_a, *w_h, *w_o, *final_norm;
  float* out;
  char* ws;
  long long phase_lo, phase_hi;
};

typedef __attribute__((ext_vector_type(2))) float f32x2v;
typedef __attribute__((ext_vector_type(2))) __bf16 bf16x2v;
DI int my_tid() {
  int t = (int)threadIdx.x;
  asm volatile("" : "+v"(t));
  __builtin_assume(t >= 0 && t < NT);
  return t;
}
DI u16 f2bf(float x) { return __builtin_bit_cast(u16, (__bf16)x); }
DI float bf2f(u16 v) { return __uint_as_float(((unsigned)v) << 16); }
DI unsigned pack2(float a, float b) { f32x2v v = {a, b}; return __builtin_bit_cast(unsigned, __builtin_convertvector(v, bf16x2v)); }
DI float bflo(unsigned u) { return __uint_as_float(u << 16); }
DI float bfhi(unsigned u) { return __uint_as_float(u & 0xffff0000u); }
DI float silu_f(float x) { return x / (1.f + __expf(-x)); }
DI float wave_sum(float v) {
#pragma unroll
  for (int o = 32; o >= 1; o >>= 1) v += __shfl_xor(v, o);
  return v;
}
DI int crow(int reg, int h) { return (reg & 3) + 8 * (reg >> 2) + 4 * h; }
DI f32x16 zero16() { f32x16 z; for (int i = 0; i < 16; ++i) z[i] = 0.f; return z; }
DI bf16x8 pack8(const f32x16& x, int s) {
  u32x4 u;
  u.x = pack2(x[8 * s + 0], x[8 * s + 1]); u.y = pack2(x[8 * s + 2], x[8 * s + 3]);
  u.z = pack2(x[8 * s + 4], x[8 * s + 5]); u.w = pack2(x[8 * s + 6], x[8 * s + 7]);
  return __builtin_bit_cast(bf16x8, u);
}
DI bf16x8 ld2x64(const u16* p0, const u16* p1) {
  u32x2 a = *(const u32x2*)p0, b = *(const u32x2*)p1;
  u32x4 u; u.x = a.x; u.y = a.y; u.z = b.x; u.w = b.y;
  return __builtin_bit_cast(bf16x8, u);
}
DI float2 cmul(float2 a, float2 b) { return make_float2(a.x * b.x - a.y * b.y, a.x * b.y + a.y * b.x); }
DI float2 cadd(float2 a, float2 b) { return make_float2(a.x + b.x, a.y + b.y); }
DI float2 csub(float2 a, float2 b) { return make_float2(a.x - b.x, a.y - b.y); }

DI const float* xrow_in(const Params& p, int layer, int row) {
  int b = row / TB, tk = row - b * TB;
  if (tk < LC) return (layer == 0 ? p.ctx : (const float*)(p.ws + OFF_CTX1)) + (size_t)(b * LC + tk) * D;
  return (layer == 0 ? p.x : (const float*)p.out) + (size_t)(b * L + tk - LC) * D;
}
DI float* xrow_out(const Params& p, int row) {
  int b = row / TB, tk = row - b * TB;
  if (tk < LC) return (float*)(p.ws + OFF_CTX1) + (size_t)(b * LC + tk) * D;
  return p.out + (size_t)(b * L + tk - LC) * D;
}
DI const float* pk(const Params& p, int off) { return (const float*)(p.ws + OFF_PK) + off; }
DI int modvec_of(int row) { int b = row / TB, tk = row - b * TB; return tk < LC ? 2 : b; }

struct ALoadN {
  const u16* A; int lda;
  template <int BM> DI void fetch(u32x4 (&r)[BM / 64], int k0, int tid) const {
#pragma unroll
    for (int i = 0; i < BM / 64; ++i) { const int q = tid + NT * i; const unsigned off = (unsigned)((q >> 3) * lda + (q & 7) * 8); r[i] = *(const u32x4*)(A + off + k0); }
  }
  template <int BM> DI void commit(const u32x4 (&r)[BM / 64], u16* As, int tid) const {
#pragma unroll
    for (int i = 0; i < BM / 64; ++i) { int q = tid + NT * i; *(u32x4*)(As + (q >> 3) * LDT + (q & 7) * 8) = r[i]; }
  }
};
struct ALoadT {
  const u16* A; size_t chs;
  template <int BM> DI void fetch(u32x4 (&r)[BM / 64], int k0, int tid) const {
#pragma unroll
    for (int i = 0; i < 2; ++i) { const int q = tid + NT * i; const unsigned off = (unsigned)((q >> 4) * (int)chs + (q & 15) * 8); r[i] = *(const u32x4*)(A + off + (unsigned)(k0 * (int)chs)); }
  }
  template <int BM> DI void commit(const u32x4 (&r)[BM / 64], u16* As, int tid) const {
#pragma unroll
    for (int i = 0; i < 2; ++i) {
      int q = tid + NT * i; int ch = q >> 4, t0 = (q & 15) * 8;
      unsigned w[4] = {r[i].x, r[i].y, r[i].z, r[i].w};
#pragma unroll
      for (int e = 0; e < 4; ++e) { As[(t0 + 2 * e) * LDT + ch] = (u16)(w[e] & 0xffffu); As[(t0 + 2 * e + 1) * LDT + ch] = (u16)(w[e] >> 16); }
    }
  }
};

template <int BM, int KSU>
DI void gemm_compute(const u16* Ac, const u16* Bc, int wm, int wn, int r, int h, f32x16 (&acc)[BM / 128][2]) {
#pragma unroll KSU
  for (int ks = 0; ks < 4; ++ks) {
    bf16x8 a[BM / 128], b[2];
#pragma unroll
    for (int i = 0; i < BM / 128; ++i) a[i] = *(const bf16x8*)(Ac + (wm * (BM / 4) + i * 32 + r) * LDT + ks * 16 + h * 8);
#pragma unroll
    for (int j = 0; j < 2; ++j) b[j] = *(const bf16x8*)(Bc + (wn * 64 + j * 32 + r) * LDT + ks * 16 + h * 8);
#pragma unroll
    for (int i = 0; i < BM / 128; ++i)
#pragma unroll
      for (int j = 0; j < 2; ++j) acc[i][j] = MFMA(a[i], b[j], acc[i][j]);
  }
}
DI void fetch_b(u32x4 (&rb)[2], const u16* Bt, int ldb, int k0, int tid) {
#pragma unroll
  for (int i = 0; i < 2; ++i) { const int q = tid + NT * i; const unsigned off = (unsigned)((q >> 3) * ldb + (q & 7) * 8); rb[i] = *(const u32x4*)(Bt + off + k0); }
}
DI void commit_b(const u32x4 (&rb)[2], u16* Bs, int tid) {
#pragma unroll
  for (int i = 0; i < 2; ++i) { int q = tid + NT * i; *(u32x4*)(Bs + (q >> 3) * LDT + (q & 7) * 8) = rb[i]; }
}
template <int BM> struct GemmRegs { u32x4 ra0[BM / 64], rb0[2], ra1[BM / 64], rb1[2]; };
#define GFENCE asm volatile("" ::: "memory")
template <int BM, class AL>
DI void gemm_prime(GemmRegs<BM>& g, const AL& al, const u16* __restrict__ Bt, int ldb, char* smem) {
  u16* As0 = (u16*)smem;
  u16* Bs0 = As0 + 2 * BM * LDT;
  const int tid = my_tid();
  al.template fetch<BM>(g.ra0, 0, tid); fetch_b(g.rb0, Bt, ldb, 0, tid); GFENCE;
  al.template fetch<BM>(g.ra1, 64, tid); fetch_b(g.rb1, Bt, ldb, 64, tid); GFENCE;
  __syncthreads();
  al.template commit<BM>(g.ra0, As0, tid); commit_b(g.rb0, Bs0, tid);
  __syncthreads();
  al.template fetch<BM>(g.ra0, 128, tid); fetch_b(g.rb0, Bt, ldb, 128, tid); GFENCE;
}
template <int BM, class AL, int KSU, int K, class ALN>
DI void gemm_run(GemmRegs<BM>& g, const AL& al, const u16* __restrict__ Bt, int ldb, const ALN& aln, const u16* __restrict__ Btn, int ldbn,
                 bool hasnext, char* smem, f32x16 (&acc)[BM / 128][2]) {
  u16* As0 = (u16*)smem;
  u16* As1 = As0 + BM * LDT;
  u16* Bs0 = As0 + 2 * BM * LDT;
  u16* Bs1 = Bs0 + 128 * LDT;
  const int tid = my_tid(), lane = tid & 63, wid = tid >> 6, r = lane & 31, h = lane >> 5;
  const int wm = wid & 3, wn = wid >> 2;
  constexpr int KT = K >> 6;
#pragma unroll
  for (int kt = 0; kt < KT; kt += 2) {
    al.template commit<BM>(g.ra1, As1, tid); commit_b(g.rb1, Bs1, tid);
    GFENCE;
    if (kt + 3 < KT) { al.template fetch<BM>(g.ra1, (kt + 3) * 64, tid); fetch_b(g.rb1, Bt, ldb, (kt + 3) * 64, tid); GFENCE; }
    else if (hasnext) { aln.template fetch<BM>(g.ra1, (kt + 3 - KT) * 64, tid); fetch_b(g.rb1, Btn, ldbn, (kt + 3 - KT) * 64, tid); GFENCE; }
    gemm_compute<BM, KSU>(As0, Bs0, wm, wn, r, h, acc);
    __syncthreads();
    if (kt + 2 < KT) { al.template commit<BM>(g.ra0, As0, tid); commit_b(g.rb0, Bs0, tid); GFENCE; }
    else if (hasnext) { aln.template commit<BM>(g.ra0, As0, tid); commit_b(g.rb0, Bs0, tid); GFENCE; }
    if (kt + 4 < KT) { al.template fetch<BM>(g.ra0, (kt + 4) * 64, tid); fetch_b(g.rb0, Bt, ldb, (kt + 4) * 64, tid); GFENCE; }
    else if (hasnext) { aln.template fetch<BM>(g.ra0, (kt + 4 - KT) * 64, tid); fetch_b(g.rb0, Btn, ldbn, (kt + 4 - KT) * 64, tid); GFENCE; }
    gemm_compute<BM, KSU>(As1, Bs1, wm, wn, r, h, acc);
    __syncthreads();
  }
}

template <int BM, class AL, int KSU = 4, int K = 1024>
DI void gemm_tile(const AL& al, const u16* __restrict__ Bt, int ldb, char* smem, f32x16 (&acc)[BM / 128][2]) {
  GemmRegs<BM> g;
  gemm_prime<BM>(g, al, Bt, ldb, smem);
  gemm_run<BM, AL, KSU, K, AL>(g, al, Bt, ldb, al, Bt, ldb, false, smem, acc);
}

DI void phase0(const Params& p, char* smem) {
  const int tid = my_tid(), lane = tid & 63, wid = tid >> 6, bid = blockIdx.x, nb = gridDim.x;
  float* sm = (float*)smem;
  {
    float* PKW = (float*)(p.ws + OFF_PK);
    const int gt = bid * NT + tid, gn = nb * NT;
#define PKCP(src, off, cnt) for (int i = gt; i < (cnt); i += gn) PKW[(off) + i] = (src)[i];
    PKCP(p.wa_f, PK_WAF, 8192) PKCP(p.ba_f, PK_BAF, 512) PKCP(p.wa_b, PK_WAB, 8192) PKCP(p.ba_b, PK_BAB, 512)
    PKCP(p.gla_norm, PK_GN, 256) PKCP(p.qnorm, PK_QN, 128) PKCP(p.knorm, PK_KN, 128) PKCP(p.conv_w, PK_CW, 9216)
    PKCP(p.conv_b, PK_CB, 3072) PKCP(p.skip, PK_SK, 2048) PKCP(p.final_norm, PK_FN, 1024) PKCP(p.f3_w, PK_F3, 262144)
#undef PKCP
  }
  float* mod = (float*)(p.ws + OFF_MOD);
  for (int task = bid; task < 96; task += nb) {
    const int l = task / 48, cb = task % 48, col = cb * 64 + lane;
    const float* W = p.w_ada + (size_t)l * 1024 * 3072;
    float a0 = 0.f, a1 = 0.f, a2 = 0.f;
#pragma unroll 8
    for (int k = wid * 128; k < wid * 128 + 128; ++k) {
      float wv = W[(size_t)k * 3072 + col];
      a0 += silu_f(p.c[k]) * wv; a1 += silu_f(p.c[1024 + k]) * wv; a2 += silu_f(p.c_ctx[k]) * wv;
    }
    __syncthreads();
    sm[(wid * 3 + 0) * 64 + lane] = a0; sm[(wid * 3 + 1) * 64 + lane] = a1; sm[(wid * 3 + 2) * 64 + lane] = a2;
    __syncthreads();
    if (tid < 192) {
      int v = tid >> 6; float s = p.b_ada[l * 3072 + col];
      for (int w = 0; w < 8; ++w) s += sm[(w * 3 + v) * 64 + lane];
      mod[(l * 3 + v) * 3072 + col] = s;
    }
    __syncthreads();
  }
  for (int it = bid; it < (2 * TB) / 8; it += nb) {
    const int gr = it * 8 + wid, l = gr / TB, rr = gr - l * TB;
    const bool lat = rr < L; const int t = lat ? rr : rr - L; const int Lq = lat ? L : LC;
    float* em = sm + wid * 104; float* h1 = em + 40;
    __syncthreads();
    if (lane < 33) {
      float v;
      if (lane == 0) v = (float)t / (float)(Lq - 1);
      else {
        int bi = (lane - 1) & 15; float fr = 1e-4f + (float)bi * ((15.f - 1e-4f) / 15.f);
        float w = 6.283185307179586f * (float)t / (float)Lq;
        v = (lane <= 16) ? cosf(fr * w) : -sinf(fr * w);
      }
      em[lane] = v;
    }
    __syncthreads();
    {
      float a = p.f1_b[l * 64 + lane];
      for (int e = 0; e < 33; ++e) a += em[e] * p.f1_w[(l * 33 + e) * 64 + lane];
      h1[lane] = sinf(p.f1_freq[l * 64 + lane] * a);
    }
    __syncthreads();
    {
      float a = p.f2_b[l * 64 + lane];
      for (int i = 0; i < 64; ++i) a += h1[i] * p.f2_w[(l * 64 + i) * 64 + lane];
      float v = sinf(p.f2_freq[l * 64 + lane] * a);
      if (lat) ((float*)(p.ws + OFF_H2T))[((size_t)l * 64 + lane) * L + t] = v;
      else ((float*)(p.ws + OFF_H2C))[((size_t)l * 256 + t) * 64 + lane] = v;
    }
  }
  __syncthreads();
  {
    constexpr int T_IN = 16 * 249, T_BR = 8 * 32, T_OUT = 16 * 32, T_LAYER = T_IN + 3 * T_BR + T_OUT;
    auto decode = [&](int task, const float*& src, u16*& dst, int& K, int& N, int& k0, int& n0) {
      const int l = task / T_LAYER; int tt = task - l * T_LAYER;
      char* wt = p.ws + OFF_WT + (size_t)l * WT_LAYER;
      int kt, ntile;
      if (tt < T_IN) { src = p.w_in + (size_t)l * 1024 * NIN; dst = (u16*)wt; K = 1024; N = NIN; kt = tt / 249; ntile = tt % 249; }
      else if (tt < T_IN + 3 * T_BR) {
        tt -= T_IN; const int br = tt / T_BR; tt -= br * T_BR;
        src = (br == 0 ? p.w_g : (br == 1 ? p.w_a : p.w_h)) + (size_t)l * 512 * 1024; dst = (u16*)(wt + WT_IN + br * WT_BR);
        K = 512; N = 1024; kt = tt / 32; ntile = tt % 32;
      } else { tt -= T_IN + 3 * T_BR; src = p.w_o + (size_t)l * 1024 * 1024; dst = (u16*)(wt + WT_IN + 3 * WT_BR); K = 1024; N = 1024; kt = tt / 32; ntile = tt % 32; }
      k0 = kt * 64; n0 = ntile * 32;
    };
    float* tileA = sm;
    float* tileB = sm + 64 * 33;
    for (int task = bid; task < 2 * T_LAYER; task += 2 * nb) {
      const bool hasB = task + nb < 2 * T_LAYER;
      const float *sa, *sb = nullptr; u16 *da, *db = nullptr; int Ka, Na, k0a, n0a, Kb = 0, Nb = 0, k0b = 0, n0b = 0;
      decode(task, sa, da, Ka, Na, k0a, n0a);
      if (hasB) decode(task + nb, sb, db, Kb, Nb, k0b, n0b);
      float va[4], vb[4];
#pragma unroll
      for (int i = 0; i < 4; ++i) { const int kk = (tid >> 5) + 16 * i, nn = tid & 31; va[i] = sa[(size_t)(k0a + kk) * Na + n0a + nn]; vb[i] = hasB ? sb[(size_t)(k0b + kk) * Nb + n0b + nn] : 0.f; }
#pragma unroll
      for (int i = 0; i < 4; ++i) { const int kk = (tid >> 5) + 16 * i, nn = tid & 31; tileA[kk * 33 + nn] = va[i]; tileB[kk * 33 + nn] = vb[i]; }
      __syncthreads();
#pragma unroll
      for (int i = 0; i < 4; ++i) {
        const int nn = (tid >> 6) + 8 * i, kk = tid & 63;
        da[(size_t)(n0a + nn) * Ka + k0a + kk] = f2bf(tileA[kk * 33 + nn]);
        if (hasB) db[(size_t)(n0b + nn) * Kb + k0b + kk] = f2bf(tileB[kk * 33 + nn]);
      }
      __syncthreads();
    }
  }
}

DI void phase_norm(const Params& p, int l) {
  const int tid = my_tid(), lane = tid & 63, wid = tid >> 6;
  const float* mod = (const float*)(p.ws + OFF_MOD);
  u16* H = (u16*)(p.ws + OFF_H);
  for (int row = blockIdx.x * 8 + wid; row < R; row += gridDim.x * 8) {
    const float* src = xrow_in(p, l, row);
    const float* mv = mod + (l * 3 + modvec_of(row)) * 3072;
    float4 xv[4]; float ss = 0.f;
#pragma unroll
    for (int i = 0; i < 4; ++i) { xv[i] = *(const float4*)(src + (i * 64 + lane) * 4); ss += xv[i].x * xv[i].x + xv[i].y * xv[i].y + xv[i].z * xv[i].z + xv[i].w * xv[i].w; }
    ss = wave_sum(ss);
    const float rs = rsqrtf(ss * (1.f / 1024.f) + EPS);
#pragma unroll
    for (int i = 0; i < 4; ++i) {
      const int col = (i * 64 + lane) * 4;
      float4 sh = *(const float4*)(mv + col), sc = *(const float4*)(mv + 1024 + col);
      u32x2 o;
      o.x = pack2(xv[i].x * rs * (1.f + sc.x) + sh.x, xv[i].y * rs * (1.f + sc.y) + sh.y);
      o.y = pack2(xv[i].z * rs * (1.f + sc.z) + sh.z, xv[i].w * rs * (1.f + sc.w) + sh.w);
      *(u32x2*)(H + (size_t)row * 1024 + col) = o;
    }
  }
}

DI void phase_proj(const Params& p, int l, char* smem) {
  const int tid = my_tid(), lane = tid & 63, wid = tid >> 6, r = lane & 31, h = lane >> 5, wm = wid & 3, wn = wid >> 2;
  const u16* H = (const u16*)(p.ws + OFF_H);
  const u16* WT = (const u16*)(p.ws + OFF_WT + (size_t)l * WT_LAYER);
  u16* P = (u16*)(p.ws + OFF_P);
  u16* CT = (u16*)(p.ws + OFF_CT);
  u16* Tt = (u16*)smem;
  constexpr int LDE = 260;
  const int xcd = blockIdx.x & 7, nloc = gridDim.x >> 3;
  for (int q = blockIdx.x >> 3; q < 5 * 156; q += nloc) {
    const int g = q / 156, rem = q - g * 156, nt = rem >> 2, mt = (g * 4 + (rem & 3)) * 8 + xcd;
    if (mt >= 130) continue;
    const int m0 = mt * 256, n0 = nt * 128;
    f32x16 acc[2][2];
#pragma unroll
    for (int i = 0; i < 2; ++i) for (int j = 0; j < 2; ++j) acc[i][j] = zero16();
    ALoadN al{H + (size_t)m0 * 1024, 1024};
    gemm_tile<256, ALoadN, 4, 1024>(al, WT + (size_t)n0 * 1024, 1024, smem, acc);
    const int b = m0 / TB, tk0 = m0 - b * TB;
#pragma unroll
    for (int i = 0; i < 2; ++i)
#pragma unroll
      for (int j = 0; j < 2; ++j)
#pragma unroll
        for (int g4 = 0; g4 < 4; ++g4) {
          u32x2 o; o.x = pack2(acc[i][j][4 * g4], acc[i][j][4 * g4 + 1]); o.y = pack2(acc[i][j][4 * g4 + 2], acc[i][j][4 * g4 + 3]);
          *(u32x2*)(Tt + (wn * 64 + j * 32 + r) * LDE + wm * 64 + i * 32 + 8 * g4 + 4 * h) = o;
        }
    __syncthreads();
#pragma unroll 1
    for (int cg = 0; cg < 4; ++cg) {
      const int cb = n0 + cg * 32;
      if (cb >= 4896) continue;
      bool chan; int cm;
      if (cb < 512) { chan = false; cm = cb; }
      else if (cb < 1024) { chan = true; cm = CH_GV + cb - 512; }
      else if (cb < 2208) { chan = false; cm = cb - 512; }
      else if (cb < 2336) { chan = true; cm = CH_AV + cb - 2208; }
      else if (cb < 2848) { chan = false; cm = cb - 640; }
      else { chan = true; cm = cb - 2848; }
      if (chan) {
#pragma unroll
        for (int k = 0; k < 2; ++k) {
          const int idx = tid + NT * k, ch = idx >> 5, t8 = idx & 31;
          const u16* sp = Tt + (cg * 32 + ch) * LDE + t8 * 8;
          const u32x2 lo = *(const u32x2*)sp, hi = *(const u32x2*)(sp + 4);
          *(u32x4*)(CT + ((size_t)(cm + ch) * 2 + b) * TB + tk0 + t8 * 8) = u32x4{lo.x, lo.y, hi.x, hi.y};
        }
      } else {
#pragma unroll
        for (int k = 0; k < 2; ++k) {
          const int idx = tid + NT * k, row = idx >> 2, c8 = idx & 3;
          const u16* sp = Tt + (cg * 32 + c8 * 8) * LDE + row;
          u32x4 o;
          o.x = (unsigned)sp[0] | ((unsigned)sp[LDE] << 16); o.y = (unsigned)sp[2 * LDE] | ((unsigned)sp[3 * LDE] << 16);
          o.z = (unsigned)sp[4 * LDE] | ((unsigned)sp[5 * LDE] << 16); o.w = (unsigned)sp[6 * LDE] | ((unsigned)sp[7 * LDE] << 16);
          *(u32x4*)(P + (size_t)(m0 + row) * NP + cm + c8 * 8) = o;
        }
      }
    }
  }
}

DI void attn_prep(const Params& p, int l, int dry) {
  const int tid = my_tid(), lane = tid & 63, wid = tid >> 6;
  u16* P = (u16*)(p.ws + OFF_P);
  const float gq = pk(p, PK_QN)[l * 64 + lane], gk = pk(p, PK_KN)[l * 64 + lane];
  for (int row = blockIdx.x * 8 + wid; row < R; row += gridDim.x * 8) {
    u16* Pr = P + (size_t)row * NP;
    const int b = row / TB, tk = row - b * TB;
    float cs = 1.f, sn = 0.f;
    if (tk >= LC) {
      const int t = tk - LC, pi = lane >> 1;
      const float pos = (pi < 16) ? (float)(t >> 6) : (float)(t & 63);
      const float inv = powf(10000.f, -(float)(2 * (pi & 15)) / 32.f);
      sincosf(pos * inv, &sn, &cs);
    }
#pragma unroll
    for (int hd = 0; hd < 10; ++hd) {
      const int col = (hd < 8) ? PC_AQ + hd * 64 + lane : PC_AK + (hd - 8) * 64 + lane;
      float v = bf2f(Pr[col]);
      const float ss = wave_sum(v * v);
      v = v * rsqrtf(ss * (1.f / 64.f) + EPS) * (hd < 8 ? gq : gk);
      const float pv = __shfl_xor(v, 1);
      float o = (lane & 1) ? (pv * sn + v * cs) : (v * cs - pv * sn);
      if (hd < 8) o *= 0.125f * 1.4426950408889634f;
      if (!dry) Pr[col] = f2bf(o);
    }
  }
}

DI void fft_pass4_fwd(float2* X, int tid, int h2) {
  const float inv4 = 0.25f / (float)h2;
#pragma unroll 2
  for (int i = 0; i < 8; ++i) {
    const int g = tid + NT * i, jp = g & (h2 - 1), base = ((g - jp) << 2) + jp;
    float2 e0 = X[base], e1 = X[base + h2], e2 = X[base + 2 * h2], e3 = X[base + 3 * h2];
    const float fr = (float)jp * inv4;
    const float2 T1 = make_float2(__builtin_amdgcn_cosf(fr), -__builtin_amdgcn_sinf(fr));
    const float2 T2 = cmul(T1, T1);
    float2 a0 = cadd(e0, e2), a2 = cmul(csub(e0, e2), T1);
    float2 a1 = cadd(e1, e3), d13 = cmul(csub(e1, e3), T1);
    float2 a3 = make_float2(d13.y, -d13.x);
    X[base] = cadd(a0, a1); X[base + h2] = cmul(csub(a0, a1), T2);
    X[base + 2 * h2] = cadd(a2, a3); X[base + 3 * h2] = cmul(csub(a2, a3), T2);
  }
  __syncthreads();
}
DI void fft_pass4_inv(float2* X, int tid, int h1) {
  const float inv4 = 0.25f / (float)h1;
#pragma unroll 2
  for (int i = 0; i < 8; ++i) {
    const int g = tid + NT * i, jp = g & (h1 - 1), base = ((g - jp) << 2) + jp;
    float2 e0 = X[base], e1 = X[base + h1], e2 = X[base + 2 * h1], e3 = X[base + 3 * h1];
    const float fr = (float)jp * inv4;
    const float2 V = make_float2(__builtin_amdgcn_cosf(fr), __builtin_amdgcn_sinf(fr));
    const float2 Wc = cmul(V, V);
    float2 t1 = cmul(e1, Wc), t3 = cmul(e3, Wc);
    float2 a0 = cadd(e0, t1), a1 = csub(e0, t1), a2 = cadd(e2, t3), a3 = csub(e2, t3);
    float2 u2 = cmul(a2, V), u3 = cmul(a3, V);
    u3 = make_float2(-u3.y, u3.x);
    X[base] = cadd(a0, u2); X[base + 2 * h1] = csub(a0, u2);
    X[base + h1] = cadd(a1, u3); X[base + 3 * h1] = csub(a1, u3);
  }
  __syncthreads();
}
DI constexpr float r16c(int k) { return k == 0 ? 1.f : k == 1 ? 0.9238795325112867f : k == 2 ? 0.7071067811865476f : k == 3 ? 0.3826834323650898f : k == 4 ? 0.f : k == 5 ? -0.3826834323650898f : k == 6 ? -0.7071067811865476f : -0.9238795325112867f; }
DI constexpr float r16s(int k) { return k == 0 ? 0.f : k == 1 ? 0.3826834323650898f : k == 2 ? 0.7071067811865476f : k == 3 ? 0.9238795325112867f : k == 4 ? 1.f : k == 5 ? 0.9238795325112867f : k == 6 ? 0.7071067811865476f : 0.3826834323650898f; }
template <bool INV>
DI void fft_pass16(float2* X, int tid, int q) {
  const float invq = 1.f / (16.f * (float)q);
#pragma unroll 1
  for (int it = 0; it < 2; ++it) {
    const int g = tid + NT * it, jp = g & (q - 1), base = ((g - jp) << 4) + jp;
    float vx[16], vy[16];
#pragma unroll
    for (int r = 0; r < 16; ++r) { const float2 e = X[base + r * q]; vx[r] = e.x; vy[r] = e.y; }
    const float th = (float)jp * invq;
    float bx[4], by[4];
    bx[0] = __builtin_amdgcn_cosf(th); by[0] = INV ? __builtin_amdgcn_sinf(th) : -__builtin_amdgcn_sinf(th);
#pragma unroll
    for (int s = 1; s < 4; ++s) { bx[s] = bx[s - 1] * bx[s - 1] - by[s - 1] * by[s - 1]; by[s] = 2.f * bx[s - 1] * by[s - 1]; }
#pragma unroll
    for (int ss = 0; ss < 4; ++ss) {
      const int s = INV ? 3 - ss : ss;
      const int rs = 8 >> s;
#pragma unroll
      for (int bf = 0; bf < 8; ++bf) {
        const int r = ((bf & ~(rs - 1)) << 1) | (bf & (rs - 1));
        const int k = (r & (rs - 1)) * (8 / rs);
        const float cc = r16c(k), cs = INV ? r16s(k) : -r16s(k);
        const float tx = bx[s] * cc - by[s] * cs, ty = bx[s] * cs + by[s] * cc;
        const float ax = vx[r], ay = vy[r], cx = vx[r + rs], cy = vy[r + rs];
        if (!INV) {
          const float dx = ax - cx, dy = ay - cy;
          vx[r] = ax + cx; vy[r] = ay + cy;
          vx[r + rs] = dx * tx - dy * ty; vy[r + rs] = dx * ty + dy * tx;
        } else {
          const float ux = cx * tx - cy * ty, uy = cx * ty + cy * tx;
          vx[r] = ax + ux; vy[r] = ay + uy;
          vx[r + rs] = ax - ux; vy[r + rs] = ay - uy;
        }
      }
    }
#pragma unroll
    for (int r = 0; r < 16; ++r) X[base + r * q] = make_float2(vx[r], vy[r]);
  }
  __syncthreads();
}
DI void fft_fwd(float2* X, int tid) {
#pragma unroll 1
  for (int q = 1024; q >= 4; q >>= 4) fft_pass16<false>(X, tid, q);
  fft_pass4_fwd(X, tid, 1);
}
DI void fft_inv(float2* X, int tid) {
  fft_pass4_inv(X, tid, 1);
#pragma unroll 1
  for (int q = 4; q <= 1024; q <<= 4) fft_pass16<true>(X, tid, q);
}
DI float sconv_at(const u16* src, int t, int len, float w0, float w1, float w2, float bb) {
  float ym = t > 0 ? bf2f(src[t - 1]) : 0.f, y0 = bf2f(src[t]), yp = t < len - 1 ? bf2f(src[t + 1]) : 0.f;
  return bb + w0 * ym + w1 * y0 + w2 * yp;
}
DI float hy_delta(int col) {
  const float A0 = -4.605170185988091f / 0.3f, A1 = -4.605170185988091f / 1.5f;
  return fabsf(A0 + (A1 - A0) * ((float)col / 2047.f));
}

DI void hyena_latent_task(const Params& p, int l, int c, char* smem, int dry) {
  float2* X = (float2*)smem;
  float* red = (float*)(smem + 131072);
  const int tid = my_tid(), lane = tid & 63, wid = tid >> 6;
  u16* CT = (u16*)(p.ws + OFF_CT);
  float2* FE = (float2*)(p.ws + OFF_FS + (size_t)blockIdx.x * 262144);
  float2* FO = FE + 16384;
  const float* h2T = (const float*)(p.ws + OFF_H2T) + (size_t)l * 64 * L;
  const float* f3w = pk(p, PK_F3) + (size_t)l * 64 * 2048;
  const float* cw = pk(p, PK_CW) + (size_t)l * 3 * 1536;
  const float* cbv = pk(p, PK_CB) + (size_t)l * 1536;
  const float vw0 = cw[c], vw1 = cw[1536 + c], vw2 = cw[3072 + c], vbb = cbv[c];
  const u16* v0 = CT + ((size_t)(CH_YU + c) * 2 + 0) * TB + LC;
  const u16* v1 = CT + ((size_t)(CH_YU + c) * 2 + 1) * TB + LC;
  u16* z10 = CT + ((size_t)(CH_YU + 512 + c) * 2 + 0) * TB + LC;
  u16* z11 = CT + ((size_t)(CH_YU + 512 + c) * 2 + 1) * TB + LC;
#pragma unroll 1
  for (int o = 0; o < 2; ++o) {
    const int cf = o * 1024 + c, cbk = cf + 512;
    float sf = 0.f, sb = 0.f;
    __syncthreads();
#ifdef PROBE_FFT
    fft_fwd(X, tid); fft_inv(X, tid);
#endif
#pragma unroll 1
    for (int half = 0; half < 2; ++half) {
      float af[16], ab[16];
#pragma unroll
      for (int i = 0; i < 16; ++i) { af[i] = 0.f; ab[i] = 0.f; }
#pragma unroll 1
      for (int j = 0; j < 64; j += 2) {
        const float wf0 = f3w[j * 2048 + cf], wb0 = f3w[j * 2048 + cbk], wf1 = f3w[(j + 1) * 2048 + cf], wb1 = f3w[(j + 1) * 2048 + cbk];
        const float* hrow = h2T + (size_t)j * L + tid + half * 16 * NT;
        float hv0[16], hv1[16];
#pragma unroll
        for (int i = 0; i < 16; ++i) { hv0[i] = hrow[NT * i]; hv1[i] = hrow[L + NT * i]; }
#pragma unroll
        for (int i = 0; i < 16; ++i) { af[i] += hv0[i] * wf0 + hv1[i] * wf1; ab[i] += hv0[i] * wb0 + hv1[i] * wb1; }
      }
      const float df = hy_delta(cf), db = hy_delta(cbk);
#pragma unroll
      for (int i = 0; i < 16; ++i) {
        const int t = tid + NT * (i + half * 16); const float tt = (float)t / (float)(L - 1);
        const float vf = af[i] * (__expf(-tt * df) + 0.05f), vb = ab[i] * (__expf(-tt * db) + 0.05f);
        sf += fabsf(vf); sb += fabsf(vb);
        X[t].x = vf;
        if (t >= 1) X[L - t].y = vb; else X[0].y = 0.f;
      }
    }
    sf = wave_sum(sf); sb = wave_sum(sb);
    if (lane == 0) { red[wid] = sf; red[8 + wid] = sb; }
    __syncthreads();
    float nf = 0.f, nbk = 0.f;
#pragma unroll
    for (int w = 0; w < 8; ++w) { nf += red[w]; nbk += red[8 + w]; }
    const float inv_f = 1.f / nf, inv_b = 1.f / nbk;
#pragma unroll 8
    for (int i = 0; i < 32; ++i) { const int n = tid + NT * i; const float2 s = X[n]; FO[n] = s; X[n] = make_float2(s.x * inv_f + s.y * inv_b, 0.f); }
    __syncthreads();
    fft_fwd(X, tid);
#pragma unroll 8
    for (int i = 0; i < 32; ++i) { const int n = tid + NT * i; FE[n] = X[n]; }
    __syncthreads();
#pragma unroll 8
    for (int i = 0; i < 32; ++i) {
      const int n = tid + NT * i; const float2 s = FO[n]; const float dd = s.x * inv_f - s.y * inv_b; const float fr = (float)n * (1.f / 32768.f);
      X[n] = make_float2(dd * __builtin_amdgcn_cosf(fr), -dd * __builtin_amdgcn_sinf(fr));
    }
    __syncthreads();
    fft_fwd(X, tid);
#pragma unroll 8
    for (int i = 0; i < 32; ++i) { const int n = tid + NT * i; FO[n] = X[n]; }
    __syncthreads();
#pragma unroll 8
    for (int i = 0; i < 32; ++i) {
      const int n = tid + NT * i;
      float2 zz;
      if (o == 0) { zz.x = sconv_at(v0, n, L, vw0, vw1, vw2, vbb); zz.y = sconv_at(v1, n, L, vw0, vw1, vw2, vbb); }
      else { zz.x = bf2f(z10[n]); zz.y = bf2f(z11[n]); }
      X[n] = zz;
    }
    __syncthreads();
    fft_fwd(X, tid);
#pragma unroll 8
    for (int i = 0; i < 32; ++i) { const int n = tid + NT * i; X[n] = cmul(X[n], FE[n]); }
    __syncthreads();
    fft_inv(X, tid);
#pragma unroll 8
    for (int i = 0; i < 32; ++i) { const int n = tid + NT * i; FE[n] = X[n]; }
    __syncthreads();
#pragma unroll 8
    for (int i = 0; i < 32; ++i) {
      const int n = tid + NT * i; const float fr = (float)n * (1.f / 32768.f);
      float2 zz;
      if (o == 0) { zz.x = sconv_at(v0, n, L, vw0, vw1, vw2, vbb); zz.y = sconv_at(v1, n, L, vw0, vw1, vw2, vbb); }
      else { zz.x = bf2f(z10[n]); zz.y = bf2f(z11[n]); }
      X[n] = cmul(zz, make_float2(__builtin_amdgcn_cosf(fr), -__builtin_amdgcn_sinf(fr)));
    }
    __syncthreads();
    fft_fwd(X, tid);
#pragma unroll 8
    for (int i = 0; i < 32; ++i) { const int n = tid + NT * i; X[n] = cmul(X[n], FO[n]); }
    __syncthreads();
    fft_inv(X, tid);
    {
      const int gch = CH_YU + 512 * (o + 1) + c;
      const float w0 = cw[gch], w1 = cw[1536 + gch], w2 = cw[3072 + gch], bb = cbv[gch];
      const u16* s0 = CT + ((size_t)gch * 2 + 0) * TB + LC;
      const u16* s1 = CT + ((size_t)gch * 2 + 1) * TB + LC;
      const float sk = pk(p, PK_SK)[(l * 2 + o) * 512 + c];
#pragma unroll 8
      for (int i = 0; i < 32; ++i) {
        const int n = tid + NT * i; const float fr = (float)n * (1.f / 32768.f);
        const float2 wb = cmul(X[n], make_float2(__builtin_amdgcn_cosf(fr), __builtin_amdgcn_sinf(fr)));
        const float2 A = FE[n];
        const float yr = (A.x + wb.x) * (1.f / 32768.f), yi = (A.y + wb.y) * (1.f / 32768.f);
        const float g0 = sconv_at(s0, n, L, w0, w1, w2, bb), g1 = sconv_at(s1, n, L, w0, w1, w2, bb);
        float2 zz;
        if (o == 0) { zz.x = sconv_at(v0, n, L, vw0, vw1, vw2, vbb); zz.y = sconv_at(v1, n, L, vw0, vw1, vw2, vbb); }
        else { zz.x = bf2f(z10[n]); zz.y = bf2f(z11[n]); }
        X[n] = make_float2(g0 * (yr + sk * zz.x), g1 * (yi + sk * zz.y));
      }
    }
    __syncthreads();
    if (o == 0) {
#pragma unroll 8
      for (int i = 0; i < 32; ++i) { const int n = tid + NT * i; const float2 zz = X[n]; if (!dry) { z10[n] = f2bf(zz.x); z11[n] = f2bf(zz.y); } }
    } else {
      u16* d0 = CT + ((size_t)(CH_YZ + c) * 2 + 0) * TB + LC;
      u16* d1 = CT + ((size_t)(CH_YZ + c) * 2 + 1) * TB + LC;
#pragma unroll 1
      for (int ib = 0; ib < 32; ib += 8) {
        u16 g0[8], g1[8];
#pragma unroll
        for (int i = 0; i < 8; ++i) { const int n = tid + NT * (ib + i); g0[i] = d0[n]; g1[i] = d1[n]; }
#pragma unroll
        for (int i = 0; i < 8; ++i) {
          const int n = tid + NT * (ib + i); const float2 zz = X[n];
          const u16 q0 = f2bf(zz.x * silu_f(bf2f(g0[i]))), q1 = f2bf(zz.y * silu_f(bf2f(g1[i])));
          if (!dry) { d0[n] = q0; d1[n] = q1; }
        }
      }
    }
    __syncthreads();
  }
}

DI void hyena_ctx_task(const Params& p, int l, int c, char* smem, int dry) {
  float* filt = (float*)smem;
  float* zs = filt + 1024;
  float* nrm = zs + 1024;
  const int tid = my_tid(), lane = tid & 63, wid = tid >> 6, t = tid & 255, hb = tid >> 8;
  u16* CT = (u16*)(p.ws + OFF_CT);
  const float* h2c = (const float*)(p.ws + OFF_H2C) + (size_t)l * 256 * 64;
  const float* f3w = pk(p, PK_F3) + (size_t)l * 64 * 2048;
  const float* cw = pk(p, PK_CW) + (size_t)l * 3 * 1536;
  const float* cbv = pk(p, PK_CB) + (size_t)l * 1536;
  __syncthreads();
  {
    const int cf = hb * 1024 + c, cbk = cf + 512;
    float a_f = 0.f, a_b = 0.f;
    for (int j = 0; j < 64; ++j) { const float hv = h2c[t * 64 + j]; a_f += hv * f3w[j * 2048 + cf]; a_b += hv * f3w[j * 2048 + cbk]; }
    const float tt = (float)t / 255.f;
    filt[(hb * 2 + 0) * 256 + t] = a_f * (__expf(-tt * hy_delta(cf)) + 0.05f);
    filt[(hb * 2 + 1) * 256 + t] = a_b * (__expf(-tt * hy_delta(cbk)) + 0.05f);
    const u16* src = CT + ((size_t)(CH_YU + c) * 2 + hb) * TB;
    zs[hb * 256 + t] = sconv_at(src, t, LC, cw[c], cw[1536 + c], cw[3072 + c], cbv[c]);
  }
  __syncthreads();
  if (wid < 4) {
    float s = 0.f;
    for (int k = 0; k < 4; ++k) s += fabsf(filt[wid * 256 + lane + 64 * k]);
    s = wave_sum(s);
    if (lane == 0) nrm[wid] = s;
  }
  __syncthreads();
  const int b = hb;
  for (int o = 0; o < 2; ++o) {
    const float inf_ = 1.f / nrm[o * 2], inb_ = 1.f / nrm[o * 2 + 1];
    const float* hf = filt + (o * 2) * 256; const float* hbk = filt + (o * 2 + 1) * 256;
    const float* zc = zs + (o & 1) * 512 + b * 256;
    float accf = 0.f, accb = 0.f;
    for (int s = 0; s <= t; ++s) accf += hf[t - s] * zc[s];
    for (int s = t + 1; s < 256; ++s) accb += hbk[s - t] * zc[s];
    const int gch = CH_YU + 512 * (o + 1) + c;
    const float gate = sconv_at(CT + ((size_t)gch * 2 + b) * TB, t, LC, cw[gch], cw[1536 + gch], cw[3072 + gch], cbv[gch]);
    const float zn = gate * (accf * inf_ + accb * inb_ + pk(p, PK_SK)[(l * 2 + o) * 512 + c] * zc[t]);
    zs[((o + 1) & 1) * 512 + b * 256 + t] = zn;
    __syncthreads();
  }
  {
    u16* d = CT + ((size_t)(CH_YZ + c) * 2 + b) * TB;
    const u16 q0 = f2bf(zs[b * 256 + t] * silu_f(bf2f(d[t])));
    if (!dry) d[t] = q0;
  }
  __syncthreads();
}

DI void gla_bcum(const Params& p, int l, int row0, int hh, int dir, float* gs, float* segs, float* was, float* as_) {
  const int tid = my_tid();
  const u16* P = (const u16*)(p.ws + OFF_P);
  const float* wa = pk(p, dir ? PK_WAB : PK_WAF) + (size_t)l * 16 * 256 + hh * 64;
  const float* ba = pk(p, dir ? PK_BAB : PK_BAF) + l * 256 + hh * 64;
#pragma unroll
  for (int i = 0; i < 2; ++i) {
    const int idx = tid + NT * i;
    was[idx] = wa[(idx >> 6) * 256 + (idx & 63)];
    as_[(idx >> 4) * 17 + (idx & 15)] = bf2f(P[(size_t)(row0 + (idx >> 4)) * NP + PC_AF + dir * 16 + (idx & 15)]);
  }
  __syncthreads();
  {
    const int t = tid >> 3, d0 = (tid & 7) * 8;
    float lin[8];
#pragma unroll
    for (int e = 0; e < 8; ++e) lin[e] = ba[d0 + e];
#pragma unroll 2
    for (int rr = 0; rr < 16; ++rr) {
      const float av = as_[t * 17 + rr];
      const float4 w0 = *(const float4*)(was + rr * 64 + d0), w1 = *(const float4*)(was + rr * 64 + d0 + 4);
      lin[0] += av * w0.x; lin[1] += av * w0.y; lin[2] += av * w0.z; lin[3] += av * w0.w;
      lin[4] += av * w1.x; lin[5] += av * w1.y; lin[6] += av * w1.z; lin[7] += av * w1.w;
    }
#pragma unroll
    for (int e = 0; e < 8; ++e) gs[t * 65 + d0 + e] = (fminf(lin[e], 0.f) - log1pf(__expf(-fabsf(lin[e])))) * (1.f / 16.f);
  }
  __syncthreads();
  {
    const int d = tid & 63, seg = tid >> 6;
    float v[8]; float run = 0.f;
#pragma unroll
    for (int e = 0; e < 8; ++e) { const int tt = dir ? seg * 8 + 7 - e : seg * 8 + e; run += gs[tt * 65 + d]; v[e] = run; }
    segs[seg * 64 + d] = run;
    __syncthreads();
    float off = 0.f;
#pragma unroll
    for (int s = 0; s < 8; ++s) { const bool before = dir ? (s > seg) : (s < seg); if (before) off += segs[s * 64 + d]; }
#pragma unroll
    for (int e = 0; e < 8; ++e) { const int tt = dir ? seg * 8 + 7 - e : seg * 8 + e; gs[tt * 65 + d] = v[e] + off; }
  }
  __syncthreads();
}
DI int gla_tok0(int dir, int n) {
  if (n < 4) return (dir ? 3 - n : n) * 64;
  return LC + (dir ? 255 - (n - 4) : n - 4) * 64;
}
constexpr int G_GS = 0;
constexpr int G_SEG = G_GS + 64 * 65 * 4;
constexpr int G_QS = G_SEG + 8 * 64 * 4;
constexpr int G_KS = G_QS + 64 * LDT * 2;
constexpr int G_VT = G_KS + 64 * LDT * 2;
constexpr int G_ST = G_VT + 128 * LDT * 2;
constexpr int G_RED = G_ST + 128 * LDT * 2;
constexpr int G_WA = G_RED + 8 * 32 * 4;
constexpr int G_AS = G_WA + 16 * 64 * 4;

DI void gla_g1_task(const Params& p, int l, int chain, int n, char* smem) {
  const int tid = my_tid(), lane = tid & 63, wid = tid >> 6, r = lane & 31, h = lane >> 5;
  const int b = chain >> 3, hh = (chain >> 1) & 3, dir = chain & 1;
  const int tk0 = gla_tok0(dir, n), row0 = b * TB + tk0;
  float* gs = (float*)(smem + G_GS); float* segs = (float*)(smem + G_SEG);
  u16* kT = (u16*)(smem + G_KS); u16* vT = (u16*)(smem + G_VT);
  const u16* P = (const u16*)(p.ws + OFF_P);
  const u16* CT = (const u16*)(p.ws + OFF_CT);
  __syncthreads();
  gla_bcum(p, l, row0, hh, dir, gs, segs, (float*)(smem + G_WA), (float*)(smem + G_AS));
  const int tl = dir ? 0 : 63;
  {
    const int t = tid >> 3, d0 = (tid & 7) * 8;
    const u32x4 kv = *(const u32x4*)(P + (size_t)(row0 + t) * NP + PC_GK + hh * 64 + d0);
    const unsigned w[4] = {kv.x, kv.y, kv.z, kv.w};
#pragma unroll
    for (int e = 0; e < 8; ++e) {
      const float kx = (e & 1) ? bfhi(w[e >> 1]) : bflo(w[e >> 1]);
      kT[(d0 + e) * LDT + t] = f2bf(kx * __expf(gs[tl * 65 + d0 + e] - gs[t * 65 + d0 + e]));
    }
#pragma unroll
    for (int i = 0; i < 2; ++i) {
      const int q = tid + NT * i, v = q >> 3, cc = q & 7;
      *(u32x4*)(vT + v * LDT + cc * 8) = *(const u32x4*)(CT + ((size_t)(CH_GV + hh * 128 + v) * 2 + b) * TB + tk0 + cc * 8);
    }
    if (tid < 64) ((float*)(p.ws + OFF_GD))[((size_t)chain * NCK + n) * 64 + tid] = __expf(gs[tl * 65 + tid]);
  }
  __syncthreads();
  {
    const int vm = wid >> 1, dn = wid & 1;
    f32x16 acc = zero16();
#pragma unroll
    for (int s = 0; s < 4; ++s) {
      const bf16x8 a = *(const bf16x8*)(vT + (vm * 32 + r) * LDT + s * 16 + h * 8);
      const bf16x8 bb = *(const bf16x8*)(kT + (dn * 32 + r) * LDT + s * 16 + h * 8);
      acc = MFMA(a, bb, acc);
    }
    u16* GS = (u16*)(p.ws + OFF_GS) + ((size_t)chain * NCK + n) * 8192;
#pragma unroll
    for (int reg = 0; reg < 16; ++reg) GS[(vm * 32 + crow(reg, h)) * 64 + dn * 32 + r] = f2bf(acc[reg]);
  }
}
DI void gla_g2(const Params& p, int dry) {
  u16* GSb = (u16*)(p.ws + OFF_GS);
  const float* GD = (const float*)(p.ws + OFF_GD);
  for (int gi = blockIdx.x * NT + my_tid(); gi < 16 * 8192; gi += gridDim.x * NT) {
    const int chain = gi >> 13, e = gi & 8191, d = e & 63;
    u16* ptr = GSb + (size_t)chain * NCK * 8192 + e;
    const float* dec = GD + (size_t)chain * NCK * 64 + d;
    float S = 0.f;
#pragma unroll 1
    for (int n0 = 0; n0 < NCK; n0 += 20) {
      float ds[20], a[20];
#pragma unroll
      for (int k = 0; k < 20; ++k) { ds[k] = bf2f(ptr[(size_t)(n0 + k) * 8192]); a[k] = dec[(n0 + k) * 64]; }
#pragma unroll
      for (int k = 0; k < 20; ++k) { if (!dry) ptr[(size_t)(n0 + k) * 8192] = f2bf(S); S = a[k] * S + ds[k]; }
    }
  }
}
DI void gla_g3_task(const Params& p, int l, int b, int hh, int ci, char* smem, int dry) {
  const int tid = my_tid(), lane = tid & 63, wid = tid >> 6, r = lane & 31, h = lane >> 5;
  const int tk0 = ci * 64, row0 = b * TB + tk0;
  float* gs = (float*)(smem + G_GS); float* segs = (float*)(smem + G_SEG); float* red = (float*)(smem + G_RED);
  u16* qs = (u16*)(smem + G_QS); u16* ks = (u16*)(smem + G_KS); u16* vT = (u16*)(smem + G_VT); u16* sT = (u16*)(smem + G_ST);
  u16* P = (u16*)(p.ws + OFF_P);
  const u16* CT = (const u16*)(p.ws + OFF_CT);
  const int vm = wid >> 1, in = wid & 1;
  f32x16 o = zero16();
  __syncthreads();
#pragma unroll 1
  for (int dir = 0; dir < 2; ++dir) {
    gla_bcum(p, l, row0, hh, dir, gs, segs, (float*)(smem + G_WA), (float*)(smem + G_AS));
    const int chain = b * 8 + hh * 2 + dir;
    const int n = dir ? ((ci < 4) ? 3 - ci : 263 - ci) : ci;
    {
      const int t = tid >> 3, d0 = (tid & 7) * 8;
      const u32x4 qv = *(const u32x4*)(P + (size_t)(row0 + t) * NP + PC_GQ + hh * 64 + d0);
      const u32x4 kv = *(const u32x4*)(P + (size_t)(row0 + t) * NP + PC_GK + hh * 64 + d0);
      const unsigned qw[4] = {qv.x, qv.y, qv.z, qv.w}, kw[4] = {kv.x, kv.y, kv.z, kv.w};
      unsigned qo[4], ko[4];
#pragma unroll
      for (int e = 0; e < 4; ++e) {
        const float b0 = gs[t * 65 + d0 + 2 * e], b1 = gs[t * 65 + d0 + 2 * e + 1];
        qo[e] = pack2(bflo(qw[e]) * 0.125f * __expf(b0), bfhi(qw[e]) * 0.125f * __expf(b1));
        ko[e] = pack2(bflo(kw[e]) * __expf(-b0), bfhi(kw[e]) * __expf(-b1));
      }
      *(u32x4*)(qs + t * LDT + d0) = u32x4{qo[0], qo[1], qo[2], qo[3]};
      *(u32x4*)(ks + t * LDT + d0) = u32x4{ko[0], ko[1], ko[2], ko[3]};
      const u16* GS = (const u16*)(p.ws + OFF_GS) + ((size_t)chain * NCK + n) * 8192;
#pragma unroll
      for (int i = 0; i < 2; ++i) {
        const int q = tid + NT * i, v = q >> 3, cc = q & 7;
        *(u32x4*)(sT + v * LDT + cc * 8) = *(const u32x4*)(GS + v * 64 + cc * 8);
        if (dir == 0) *(u32x4*)(vT + v * LDT + cc * 8) = *(const u32x4*)(CT + ((size_t)(CH_GV + hh * 128 + v) * 2 + b) * TB + tk0 + cc * 8);
      }
    }
    __syncthreads();
    bf16x8 qf[4];
#pragma unroll
    for (int s = 0; s < 4; ++s) qf[s] = *(const bf16x8*)(qs + (in * 32 + r) * LDT + s * 16 + h * 8);
#pragma unroll
    for (int jt = 0; jt < 2; ++jt) {
      f32x16 at = zero16();
#pragma unroll
      for (int s = 0; s < 4; ++s) at = MFMA(*(const bf16x8*)(ks + (jt * 32 + r) * LDT + s * 16 + h * 8), qf[s], at);
      const int ii = in * 32 + r;
#pragma unroll
      for (int reg = 0; reg < 16; ++reg) {
        const int jj = jt * 32 + crow(reg, h);
        const bool keep = dir ? (jj >= ii) : (jj <= ii);
        if (!keep) at[reg] = 0.f;
      }
#pragma unroll
      for (int s = 0; s < 2; ++s) {
        const u16* vp = vT + (vm * 32 + r) * LDT + jt * 32 + 16 * s + 4 * h;
        o = MFMA(ld2x64(vp, vp + 8), pack8(at, s), o);
      }
    }
#pragma unroll
    for (int s = 0; s < 4; ++s) o = MFMA(*(const bf16x8*)(sT + (vm * 32 + r) * LDT + s * 16 + h * 8), qf[s], o);
    __syncthreads();
  }
  float ss = 0.f;
#pragma unroll
  for (int reg = 0; reg < 16; ++reg) ss += o[reg] * o[reg];
  ss += __shfl_xor(ss, 32);
  if (h == 0) red[wid * 32 + r] = ss;
  __syncthreads();
  float tot = 0.f;
#pragma unroll
  for (int m = 0; m < 4; ++m) tot += red[(m * 2 + in) * 32 + r];
  const float rs = rsqrtf(tot * (1.f / 128.f) + EPS);
  u16* zp = P + (size_t)(row0 + in * 32 + r) * NP + PC_GZ + hh * 128 + vm * 32 + 4 * h;
  const float* gn = pk(p, PK_GN) + l * 128 + vm * 32 + 4 * h;
#pragma unroll
  for (int g = 0; g < 4; ++g) {
    const u32x2 zz = *(const u32x2*)(zp + 8 * g);
    const float4 gw = *(const float4*)(gn + 8 * g);
    u32x2 out;
    out.x = pack2(o[4 * g] * rs * gw.x * silu_f(bflo(zz.x)), o[4 * g + 1] * rs * gw.y * silu_f(bfhi(zz.x)));
    out.y = pack2(o[4 * g + 2] * rs * gw.z * silu_f(bflo(zz.y)), o[4 * g + 3] * rs * gw.w * silu_f(bfhi(zz.y)));
    if (!dry) *(u32x2*)(zp + 8 * g) = out;
  }
}

DI void attn_item(const Params& p, int l, int b, int g, int qtk0, int ntiles, char* smem, int dry) {
  const int tid = my_tid(), lane = tid & 63, wid = tid >> 6, r = lane & 31, h = lane >> 5;
  u16* P = (u16*)(p.ws + OFF_P);
  const u16* CT = (const u16*)(p.ws + OFF_CT);
  u16* Ks = (u16*)smem;
  u16* Vs = Ks + 2 * 64 * LDT;
  const int hq = g * 4 + (wid >> 1);
  const size_t qrow = (size_t)b * TB + qtk0 + (wid & 1) * 32 + r;
  bf16x8 qf[4];
#pragma unroll
  for (int s = 0; s < 4; ++s) qf[s] = *(const bf16x8*)(P + qrow * NP + PC_AQ + hq * 64 + s * 16 + h * 8);
  f32x16 O[2] = {zero16(), zero16()};
  float m = -1e30f, lsum = 0.f;
  const int lr = tid >> 3, lc = (tid & 7) * 8;
  const u16* kg = P + ((size_t)b * TB + lr) * NP + PC_AK + g * 64 + lc;
  const u16* vg = CT + ((size_t)(CH_AV + g * 64 + lr) * 2 + b) * TB + lc;
  u32x4 rk = *(const u32x4*)kg, rv = *(const u32x4*)vg;
  __syncthreads();
  *(u32x4*)(Ks + lr * LDT + lc) = rk; *(u32x4*)(Vs + lr * LDT + lc) = rv;
  __syncthreads();
  float gqm = fabsf(pk(p, PK_QN)[l * 64 + lane]), gkm = fabsf(pk(p, PK_KN)[l * 64 + lane]);
#pragma unroll
  for (int o = 32; o >= 1; o >>= 1) { gqm = fmaxf(gqm, __shfl_xor(gqm, o)); gkm = fmaxf(gkm, __shfl_xor(gkm, o)); }
  const float mshift = 8.2f * 1.4426950408889634f * gqm * gkm;
  if (mshift <= 60.f) {
    f32x16 sinit;
#pragma unroll
    for (int i = 0; i < 16; ++i) sinit[i] = -mshift;
#pragma unroll 1
    for (int kt = 0; kt < ntiles; ++kt) {
      const int cur = kt & 1;
      if (kt + 1 < ntiles) { rk = *(const u32x4*)(kg + (size_t)(kt + 1) * 64 * NP); rv = *(const u32x4*)(vg + (kt + 1) * 64); }
      const u16* Kc = Ks + cur * 64 * LDT; const u16* Vc = Vs + cur * 64 * LDT;
      f32x16 st[2];
#pragma unroll
      for (int kk = 0; kk < 2; ++kk) {
        st[kk] = sinit;
#pragma unroll
        for (int s = 0; s < 4; ++s) st[kk] = MFMA(*(const bf16x8*)(Kc + (kk * 32 + r) * LDT + s * 16 + h * 8), qf[s], st[kk]);
      }
#pragma unroll
      for (int kk = 0; kk < 2; ++kk)
#pragma unroll
        for (int i = 0; i < 16; ++i) { const float pv = __builtin_amdgcn_exp2f(st[kk][i]); st[kk][i] = pv; lsum += pv; }
#pragma unroll
      for (int kk = 0; kk < 2; ++kk)
#pragma unroll
        for (int s = 0; s < 2; ++s) {
          const bf16x8 pb = pack8(st[kk], s);
#pragma unroll
          for (int mt = 0; mt < 2; ++mt) {
            const u16* vp = Vc + (mt * 32 + r) * LDT + kk * 32 + 16 * s + 4 * h;
            O[mt] = MFMA(ld2x64(vp, vp + 8), pb, O[mt]);
          }
        }
      if (kt + 1 < ntiles) { *(u32x4*)(Ks + (cur ^ 1) * 64 * LDT + lr * LDT + lc) = rk; *(u32x4*)(Vs + (cur ^ 1) * 64 * LDT + lr * LDT + lc) = rv; }
      __syncthreads();
    }
  } else {
#pragma unroll 1
    for (int kt = 0; kt < ntiles; ++kt) {
      const int cur = kt & 1;
      if (kt + 1 < ntiles) { rk = *(const u32x4*)(kg + (size_t)(kt + 1) * 64 * NP); rv = *(const u32x4*)(vg + (kt + 1) * 64); }
      const u16* Kc = Ks + cur * 64 * LDT; const u16* Vc = Vs + cur * 64 * LDT;
      f32x16 st[2];
#pragma unroll
      for (int kk = 0; kk < 2; ++kk) {
        st[kk] = zero16();
#pragma unroll
        for (int s = 0; s < 4; ++s) st[kk] = MFMA(*(const bf16x8*)(Kc + (kk * 32 + r) * LDT + s * 16 + h * 8), qf[s], st[kk]);
      }
      float mx = st[0][0];
#pragma unroll
      for (int i = 0; i < 16; ++i) { mx = fmaxf(mx, st[0][i]); mx = fmaxf(mx, st[1][i]); }
      mx = fmaxf(mx, __shfl_xor(mx, 32));
      const float mn = fmaxf(m, mx);
      const float alpha = exp2f(m - mn);
      m = mn;
      float rsum = 0.f;
#pragma unroll
      for (int kk = 0; kk < 2; ++kk)
#pragma unroll
        for (int i = 0; i < 16; ++i) { const float pv = exp2f(st[kk][i] - mn); st[kk][i] = pv; rsum += pv; }
      lsum = lsum * alpha + rsum;
#pragma unroll
      for (int mt = 0; mt < 2; ++mt)
#pragma unroll
        for (int i = 0; i < 16; ++i) O[mt][i] *= alpha;
#pragma unroll
      for (int kk = 0; kk < 2; ++kk)
#pragma unroll
        for (int s = 0; s < 2; ++s) {
          const bf16x8 pb = pack8(st[kk], s);
#pragma unroll
          for (int mt = 0; mt < 2; ++mt) {
            const u16* vp = Vc + (mt * 32 + r) * LDT + kk * 32 + 16 * s + 4 * h;
            O[mt] = MFMA(ld2x64(vp, vp + 8), pb, O[mt]);
          }
        }
      if (kt + 1 < ntiles) { *(u32x4*)(Ks + (cur ^ 1) * 64 * LDT + lr * LDT + lc) = rk; *(u32x4*)(Vs + (cur ^ 1) * 64 * LDT + lr * LDT + lc) = rv; }
      __syncthreads();
    }
  }
  lsum += __shfl_xor(lsum, 32);
  const float inv = 1.f / lsum;
  u16* op = P + qrow * NP + PC_AQ + hq * 64 + 4 * h;
  const u16* zp = P + qrow * NP + PC_AZ + hq * 64 + 4 * h;
#pragma unroll
  for (int mt = 0; mt < 2; ++mt)
#pragma unroll
    for (int gg = 0; gg < 4; ++gg) {
      const u32x2 zz = *(const u32x2*)(zp + mt * 32 + 8 * gg);
      u32x2 out;
      out.x = pack2(O[mt][4 * gg] * inv * silu_f(bflo(zz.x)), O[mt][4 * gg + 1] * inv * silu_f(bfhi(zz.x)));
      out.y = pack2(O[mt][4 * gg + 2] * inv * silu_f(bflo(zz.y)), O[mt][4 * gg + 3] * inv * silu_f(bfhi(zz.y)));
      if (!dry) *(u32x2*)(op + mt * 32 + 8 * gg) = out;
    }
}

template <int KSU>
DI void gemm_gate3(const u16* __restrict__ A, const u16* __restrict__ WM, char* smem, f32x16 (&acc)[3][2]) {
  u16* As0 = (u16*)smem;
  u16* As1 = As0 + 128 * LDT;
  u16* Bs0 = As0 + 2 * 128 * LDT;
  u16* Bs1 = Bs0 + 384 * LDT;
  const int tid = my_tid(), lane = tid & 63, wid = tid >> 6, r = lane & 31, h = lane >> 5, wm = wid & 3, wn = wid >> 2;
  u32x4 ra0[2], rb0[6], ra1[2], rb1[6];
  auto fetch = [&](u32x4 (&ra)[2], u32x4 (&rb)[6], int k0) {
#pragma unroll
    for (int i = 0; i < 2; ++i) { const int q = tid + NT * i; const unsigned off = (unsigned)((q >> 3) * 1024 + (q & 7) * 8); ra[i] = *(const u32x4*)(A + off + k0); }
#pragma unroll
    for (int i = 0; i < 6; ++i) {
      const int q = tid + NT * i, row = q >> 3;
      const unsigned off = (unsigned)((row >> 7) * (1024 * 1024) + (row & 127) * 1024 + (q & 7) * 8);
      rb[i] = *(const u32x4*)(WM + off + k0);
    }
    GFENCE;
  };
  auto commit = [&](const u32x4 (&ra)[2], const u32x4 (&rb)[6], u16* As, u16* Bs) {
#pragma unroll
    for (int i = 0; i < 2; ++i) { const int q = tid + NT * i; *(u32x4*)(As + (q >> 3) * LDT + (q & 7) * 8) = ra[i]; }
#pragma unroll
    for (int i = 0; i < 6; ++i) { const int q = tid + NT * i; *(u32x4*)(Bs + (q >> 3) * LDT + (q & 7) * 8) = rb[i]; }
    GFENCE;
  };
  auto compute = [&](const u16* Ac, const u16* Bc) {
#pragma unroll KSU
    for (int ks = 0; ks < 4; ++ks) {
      const bf16x8 a = *(const bf16x8*)(Ac + (wm * 32 + r) * LDT + ks * 16 + h * 8);
#pragma unroll
      for (int br = 0; br < 3; ++br)
#pragma unroll
        for (int j = 0; j < 2; ++j)
          acc[br][j] = MFMA(a, *(const bf16x8*)(Bc + (br * 128 + wn * 64 + j * 32 + r) * LDT + ks * 16 + h * 8), acc[br][j]);
    }
  };
  constexpr int KT = 16;
  fetch(ra0, rb0, 0);
  fetch(ra1, rb1, 64);
  __syncthreads();
  commit(ra0, rb0, As0, Bs0);
  __syncthreads();
  fetch(ra0, rb0, 128);
#pragma unroll
  for (int kt = 0; kt < KT; kt += 2) {
    commit(ra1, rb1, As1, Bs1);
    if (kt + 3 < KT) fetch(ra1, rb1, (kt + 3) * 64);
    compute(As0, Bs0);
    __syncthreads();
    if (kt + 2 < KT) commit(ra0, rb0, As0, Bs0);
    if (kt + 4 < KT) fetch(ra0, rb0, (kt + 4) * 64);
    compute(As1, Bs1);
    __syncthreads();
  }
}
DI void phase_merge(const Params& p, int l, char* smem) {
  const int tid = my_tid(), lane = tid & 63, wid = tid >> 6, r = lane & 31, h = lane >> 5, wm = wid & 3, wn = wid >> 2;
  const int xcd = blockIdx.x & 7, nloc = gridDim.x >> 3;
  for (int q = blockIdx.x >> 3; q < 33 * 8; q += nloc) {
    const int mt = (q >> 3) * 8 + xcd, nt = q & 7, m0 = mt * 128, n0 = nt * 128;
    if (mt >= 260) continue;
    const int b = m0 / TB, tk0 = m0 - b * TB;
    if (l == 1 && tk0 < LC) continue;
    const u16* H = (const u16*)(p.ws + OFF_H) + (size_t)m0 * 1024;
    const u16* WM = (const u16*)(p.ws + OFF_WT + (size_t)l * WT_LAYER) + (size_t)(4896 + n0) * 1024;
    const u16* WBR = (const u16*)(p.ws + OFF_WT + (size_t)l * WT_LAYER + WT_IN) + (size_t)n0 * 512;
    unsigned gp[3][2][8];
    {
      f32x16 g3[3][2];
#pragma unroll
      for (int br = 0; br < 3; ++br) for (int j = 0; j < 2; ++j) g3[br][j] = zero16();
      gemm_gate3<2>(H, WM, smem, g3);
#pragma unroll
      for (int br = 0; br < 3; ++br)
#pragma unroll
        for (int j = 0; j < 2; ++j)
#pragma unroll
          for (int i = 0; i < 8; ++i)
            gp[br][j][i] = pack2(1.f / (1.f + __expf(-g3[br][j][2 * i])), 1.f / (1.f + __expf(-g3[br][j][2 * i + 1])));
    }
    f32x16 ysum[2] = {zero16(), zero16()};
#pragma unroll
    for (int br = 0; br < 3; ++br) {
      f32x16 ab[1][2] = {{zero16(), zero16()}};
      if (br < 2) {
        ALoadN ay{(const u16*)(p.ws + OFF_P) + (size_t)m0 * NP + (br == 0 ? PC_GZ : PC_AQ), NP};
        gemm_tile<128, ALoadN, 4, 512>(ay, WBR + (size_t)br * 1024 * 512, 512, smem, ab);
      } else {
        ALoadT ay{(const u16*)(p.ws + OFF_CT) + ((size_t)CH_YZ * 2 + b) * TB + tk0, (size_t)2 * TB};
        gemm_tile<128, ALoadT, 4, 512>(ay, WBR + (size_t)2 * 1024 * 512, 512, smem, ab);
      }
#pragma unroll
      for (int j = 0; j < 2; ++j)
#pragma unroll
        for (int i = 0; i < 8; ++i) {
          ysum[j][2 * i] += bflo(gp[br][j][i]) * ab[0][j][2 * i];
          ysum[j][2 * i + 1] += bfhi(gp[br][j][i]) * ab[0][j][2 * i + 1];
        }
    }
    u16* Y = (u16*)(p.ws + OFF_Y) + (size_t)(m0 + wm * 32 + 4 * h) * 1024 + n0 + wn * 64 + r;
#pragma unroll
    for (int j = 0; j < 2; ++j)
#pragma unroll
      for (int reg = 0; reg < 16; ++reg) Y[(size_t)((reg & 3) + 8 * (reg >> 2)) * 1024 + j * 32] = f2bf(ysum[j][reg]);
  }
}

DI void phase_out(const Params& p, int l, char* smem) {
  const int tid = my_tid(), lane = tid & 63, wid = tid >> 6, r = lane & 31, h = lane >> 5, wm = wid & 3, wn = wid >> 2;
  const u16* Yb = (const u16*)(p.ws + OFF_Y);
  const u16* WO = (const u16*)(p.ws + OFF_WT + (size_t)l * WT_LAYER + WT_IN + 3 * WT_BR);
  const float* mod = (const float*)(p.ws + OFF_MOD);
  const int xcd = blockIdx.x & 7, nloc = gridDim.x >> 3;
  auto tile_of = [&](int q, int& m0, int& n0) -> bool {
    const int mt = (q >> 3) * 8 + xcd; m0 = mt * 128; n0 = (q & 7) * 128;
    if (mt >= 260) return false;
    const int b = m0 / TB, tk0 = m0 - b * TB;
    return !(l == 1 && tk0 < LC);
  };
  auto next_q = [&](int q) -> int { int m, n; for (q += nloc; q < 33 * 8; q += nloc) if (tile_of(q, m, n)) return q; return -1; };
  int q = (int)(blockIdx.x >> 3) - nloc; q = next_q(q);
  if (q < 0) return;
  int m0, n0; tile_of(q, m0, n0);
  GemmRegs<128> gr;
  { ALoadN ay{Yb + (size_t)m0 * 1024, 1024}; gemm_prime<128>(gr, ay, WO + (size_t)n0 * 1024, 1024, smem); }
  while (true) {
    const int qn = next_q(q);
    int m0n = 0, n0n = 0; if (qn >= 0) tile_of(qn, m0n, n0n);
    const int b = m0 / TB, tk0 = m0 - b * TB;
    f32x16 acc[1][2] = {{zero16(), zero16()}};
    const ALoadN ay{Yb + (size_t)m0 * 1024, 1024}, ayn{Yb + (size_t)m0n * 1024, 1024};
    gemm_run<128, ALoadN, 4, 1024, ALoadN>(gr, ay, WO + (size_t)n0 * 1024, 1024, ayn, WO + (size_t)n0n * 1024, 1024, qn >= 0, smem, acc);
    const float* gv = mod + (l * 3 + (tk0 < LC ? 2 : b)) * 3072 + 2048;
    const float* xin = xrow_in(p, l, m0);
    float* xout = xrow_out(p, m0);
#pragma unroll
    for (int j = 0; j < 2; ++j) {
      const int col = n0 + wn * 64 + j * 32 + r;
      const float gate = gv[col];
#pragma unroll
      for (int reg = 0; reg < 16; ++reg) {
        const size_t off = (size_t)(wm * 32 + crow(reg, h)) * D + col;
        xout[off] = xin[off] + gate * acc[0][j][reg];
      }
    }
    if (qn < 0) break;
    q = qn; m0 = m0n; n0 = n0n;
  }
}

DI void phase_final(const Params& p) {
  const int tid = my_tid(), lane = tid & 63, wid = tid >> 6;
  for (int row = blockIdx.x * 8 + wid; row < NBATCH * L; row += gridDim.x * 8) {
    float* src = p.out + (size_t)row * D;
    float4 xv[4]; float ss = 0.f;
#pragma unroll
    for (int i = 0; i < 4; ++i) { xv[i] = *(const float4*)(src + (i * 64 + lane) * 4); ss += xv[i].x * xv[i].x + xv[i].y * xv[i].y + xv[i].z * xv[i].z + xv[i].w * xv[i].w; }
    ss = wave_sum(ss);
    const float rs = rsqrtf(ss * (1.f / 1024.f) + EPS);
#pragma unroll
    for (int i = 0; i < 4; ++i) {
      const int col = (i * 64 + lane) * 4;
      const float4 fw = *(const float4*)(pk(p, PK_FN) + col);
      *(float4*)(src + col) = make_float4(xv[i].x * rs * fw.x, xv[i].y * rs * fw.y, xv[i].z * rs * fw.z, xv[i].w * rs * fw.w);
    }
  }
}

DI void run_phase(const Params& p, int ph, char* smem, int dry = 0) {
  const int bid = blockIdx.x, nb = gridDim.x;
  if (ph == 0) { phase0(p, smem); return; }
  if (ph == 17) { phase_final(p); return; }
  const int l = (ph - 1) >> 3, s = (ph - 1) & 7;
  switch (s) {
    case 0: phase_norm(p, l); break;
    case 1: phase_proj(p, l, smem); break;
    case 2: {
      attn_prep(p, l, dry);
      if (l == 0) for (int c = bid; c < 512; c += nb) hyena_ctx_task(p, l, c, smem, dry);
      for (int c = bid; c < 512; c += nb) hyena_latent_task(p, l, c, smem, dry);
    } break;
    case 3: for (int t = bid; t < 16 * NCK; t += nb) gla_g1_task(p, l, t / NCK, t % NCK, smem); break;
    case 4: gla_g2(p, dry); break;
    case 5: {
      for (int it = bid; it < 1024; it += nb) { const int b = it >> 9, g = (it >> 8) & 1, qb = it & 255; attn_item(p, l, b, g, LC + qb * 64, NCK, smem, dry); }
      if (l == 0) for (int it = bid; it < 16; it += nb) { const int b = it >> 3, g = (it >> 2) & 1, qb = it & 3; attn_item(p, l, b, g, qb * 64, 4, smem, dry); }
      const int c0 = (l == 0) ? 0 : 4, per = NCK - c0;
      for (int t = bid; t < 8 * per; t += nb) { const int bh = t / per, ci = c0 + t % per; gla_g3_task(p, l, bh >> 2, bh & 3, ci, smem, dry); }
    } break;
    case 6: phase_merge(p, l, smem); break;
    case 7: phase_out(p, l, smem); break;
  }
}

#if MULTI_LAUNCH
template <int PH> __global__ void __launch_bounds__(NT) phase_kernel(Params p) {
  extern __shared__ __attribute__((aligned(16))) char smem[];
  run_phase(p, PH, smem);
}
template <int PH> static void launch_phase(const Params& p, int grid, hipStream_t stream) {
  static bool attr = false;
  if (!attr) { (void)hipFuncSetAttribute((const void*)phase_kernel<PH>, hipFuncAttributeMaxDynamicSharedMemorySize, LDS_BYTES); attr = true; }
  hipLaunchKernelGGL(phase_kernel<PH>, dim3(grid), dim3(NT), LDS_BYTES, stream, p);
}
#else
#ifndef PROBE_DUP
#define PROBE_DUP -1
#endif
#ifndef PROBE_DUP2
#define PROBE_DUP2 -1
#endif
#ifndef PROBE_DUP3
#define PROBE_DUP3 -1
#endif
__global__ void __launch_bounds__(NT) fwd_kernel(Params p) {
  extern __shared__ __attribute__((aligned(16))) char smem[];
  cg::grid_group grid = cg::this_grid();
#if PROBE_DUP >= 0
#define PHS(n) if ((n) == PROBE_DUP || (n) == PROBE_DUP2 || (n) == PROBE_DUP3) { run_phase(p, n, smem, p.phase_lo == 0 ? 1 : 0); grid.sync(); } run_phase(p, n, smem); grid.sync();
#else
#define PHS(n) run_phase(p, n, smem); grid.sync();
#endif
  PHS(0) PHS(1) PHS(2) PHS(3) PHS(4) PHS(5) PHS(6) PHS(7) PHS(8)
  PHS(9) PHS(10) PHS(11) PHS(12) PHS(13) PHS(14) PHS(15) PHS(16)
  run_phase(p, 17, smem);
}
#endif

extern "C" void kernel_launch(void* const* d_in, const int* in_sizes, int n_in, void* d_out, int out_size, void* d_ws, size_t ws_size,
                              hipStream_t stream) {
  static int grid = 0;
  if (grid == 0) {
    if (n_in != 29 || ws_size < WS_END) { fprintf(stderr, "kernel_launch: need 29 inputs and %zu B of workspace, got %d / %zu\n", (size_t)WS_END, n_in, ws_size); grid = -1; return; }
#if MULTI_LAUNCH
    grid = 256;
#else
    int dev = 0, cus = 0, per_cu = 0;
    (void)hipGetDevice(&dev);
    (void)hipDeviceGetAttribute(&cus, hipDeviceAttributeMultiprocessorCount, dev);
    if (hipFuncSetAttribute((const void*)fwd_kernel, hipFuncAttributeMaxDynamicSharedMemorySize, LDS_BYTES) != hipSuccess) { fprintf(stderr, "kernel_launch: hipFuncSetAttribute failed\n"); grid = -1; return; }
    (void)hipOccupancyMaxActiveBlocksPerMultiprocessor(&per_cu, (const void*)fwd_kernel, NT, LDS_BYTES);
    if (per_cu < 1) { fprintf(stderr, "kernel_launch: occupancy query returned %d\n", per_cu); per_cu = 1; }
    (void)hipGetLastError();
    grid = cus * per_cu;
    if (grid > 256) grid = 256;
#endif
  }
  if (grid < 0) return;
  Params p{};
  const float** pp = (const float**)&p;
  for (int i = 0; i < 29; ++i) pp[i] = (const float*)d_in[i];
  p.out = (float*)d_out; p.ws = (char*)d_ws;
  p.phase_lo = 0; p.phase_hi = 18;
#if MULTI_LAUNCH
  launch_phase<0>(p, grid, stream); launch_phase<1>(p, grid, stream); launch_phase<2>(p, grid, stream); launch_phase<3>(p, grid, stream);
  launch_phase<4>(p, grid, stream); launch_phase<5>(p, grid, stream); launch_phase<6>(p, grid, stream); launch_phase<7>(p, grid, stream);
  launch_phase<8>(p, grid, stream); launch_phase<9>(p, grid, stream); launch_phase<10>(p, grid, stream); launch_phase<11>(p, grid, stream);
  launch_phase<12>(p, grid, stream); launch_phase<13>(p, grid, stream); launch_phase<14>(p, grid, stream); launch_phase<15>(p, grid, stream);
  launch_phase<16>(p, grid, stream); launch_phase<17>(p, grid, stream);
#else
  void* args[] = {&p};
  hipError_t e = hipLaunchCooperativeKernel((const void*)fwd_kernel, dim3(grid), dim3(NT), args, LDS_BYTES, stream);
  if (e != hipSuccess) fprintf(stderr, "kernel_launch: cooperative launch failed: %s (grid %d)\n", hipGetErrorString(e), grid);
#endif
}
```

```cpp
#include <hip/hip_runtime.h>
#include <hip/hip_cooperative_groups.h>
#include <cstdio>
namespace cg = cooperative_groups;

typedef unsigned short u16;
typedef __attribute__((ext_vector_type(8))) short bf16x8;
typedef __attribute__((ext_vector_type(16))) float f32x16;
typedef __attribute__((ext_vector_type(4))) unsigned u32x4;
typedef __attribute__((ext_vector_type(2))) unsigned u32x2;
#define DI __device__ __forceinline__
#define MFMA(a, b, c) __builtin_amdgcn_mfma_f32_32x32x16_bf16((a), (b), (c), 0, 0, 0)

#ifndef MULTI_LAUNCH
#define MULTI_LAUNCH 0
#endif

constexpr int D = 1024, NBATCH = 2, L = 16384, LC = 256, TB = L + LC, R = NBATCH * TB;
constexpr int NIN = 7968;
constexpr int NP = 2208;
constexpr int NCH = 2688;
constexpr int PC_GQ = 0, PC_GK = 256, PC_GZ = 512, PC_AF = 1024, PC_AQ = 1056, PC_AK = 1568, PC_AZ = 1696;
constexpr int CH_YU = 0, CH_YZ = 1536, CH_GV = 2048, CH_AV = 2560;
constexpr int NCK = 260;
constexpr float EPS = 1e-6f;
constexpr int NT = 512;
constexpr int LDT = 72;

constexpr size_t OFF_P = 0;
constexpr size_t OFF_CT = OFF_P + (size_t)R * NP * 2;
constexpr size_t OFF_H = OFF_CT + (size_t)NCH * 2 * TB * 2;
constexpr size_t OFF_FS = OFF_H + (size_t)R * 1024 * 2;
constexpr size_t OFF_WT = OFF_FS + (size_t)256 * 262144;
constexpr size_t WT_IN = (size_t)NIN * 1024 * 2, WT_BR = (size_t)1024 * 512 * 2, WT_OUT = (size_t)1024 * 1024 * 2;
constexpr size_t WT_LAYER = WT_IN + 3 * WT_BR + WT_OUT;
constexpr size_t OFF_H2T = OFF_WT + 2 * WT_LAYER;
constexpr size_t OFF_H2C = OFF_H2T + (size_t)2 * 64 * L * 4;
constexpr size_t OFF_MOD = OFF_H2C + (size_t)2 * 256 * 64 * 4;
constexpr size_t OFF_CTX1 = OFF_MOD + (size_t)2 * 3 * 3072 * 4;
constexpr size_t OFF_GD = OFF_CTX1 + (size_t)512 * 1024 * 4;
constexpr size_t OFF_PK = OFF_GD + (size_t)16 * NCK * 64 * 4;
constexpr int PK_WAF = 0, PK_BAF = 8192, PK_WAB = 8704, PK_BAB = 16896, PK_GN = 17408, PK_QN = 17664, PK_KN = 17792, PK_CW = 17920,
              PK_CB = 27136, PK_SK = 30208, PK_FN = 32256, PK_F3 = 33280, PK_END = 33280 + 262144;
constexpr size_t WS_END = OFF_PK + (size_t)PK_END * 4;
constexpr size_t OFF_GS = OFF_CT;
constexpr size_t OFF_Y = OFF_CT;
static_assert((size_t)16 * NCK * 8192 * 2 <= (size_t)1536 * 2 * TB * 2, "alias");
static_assert((size_t)R * 1024 * 2 <= (size_t)1536 * 2 * TB * 2, "alias");

constexpr int LDS_BYTES = 2 * (128 + 384) * 72 * 2 + 512;

struct Params {
  const float *x, *c, *ctx, *c_ctx, *w_ada, *b_ada, *w_in, *wa_f, *ba_f, *wa_b, *ba_b, *gla_norm, *qnorm, *knorm,
      *conv_w, *conv_b, *f1_w, *f1_b, *f1_freq, *f2_w, *f2_b, *f2_freq, *f3_w, *skip, *w_g, *w_a, *w_h, *w_o, *final_norm;
  float* out;
  char* ws;
  long long phase_lo, phase_hi;
};

typedef __attribute__((ext_vector_type(2))) float f32x2v;
typedef __attribute__((ext_vector_type(2))) __bf16 bf16x2v;
DI int my_tid() {
  int t = (int)threadIdx.x;
  asm volatile("" : "+v"(t));
  __builtin_assume(t >= 0 && t < NT);
  return t;
}
DI u16 f2bf(float x) { return __builtin_bit_cast(u16, (__bf16)x); }
DI float bf2f(u16 v) { return __uint_as_float(((unsigned)v) << 16); }
DI unsigned pack2(float a, float b) { f32x2v v = {a, b}; return __builtin_bit_cast(unsigned, __builtin_convertvector(v, bf16x2v)); }
DI float bflo(unsigned u) { return __uint_as_float(u << 16); }
DI float bfhi(unsigned u) { return __uint_as_float(u & 0xffff0000u); }
DI float silu_f(float x) { return x / (1.f + __expf(-x)); }
DI float wave_sum(float v) {
#pragma unroll
  for (int o = 32; o >= 1; o >>= 1) v += __shfl_xor(v, o);
  return v;
}
DI int crow(int reg, int h) { return (reg & 3) + 8 * (reg >> 2) + 4 * h; }
DI f32x16 zero16() { f32x16 z; for (int i = 0; i < 16; ++i) z[i] = 0.f; return z; }
DI bf16x8 pack8(const f32x16& x, int s) {
  u32x4 u;
  u.x = pack2(x[8 * s + 0], x[8 * s + 1]); u.y = pack2(x[8 * s + 2], x[8 * s + 3]);
  u.z = pack2(x[8 * s + 4], x[8 * s + 5]); u.w = pack2(x[8 * s + 6], x[8 * s + 7]);
  return __builtin_bit_cast(bf16x8, u);
}
DI bf16x8 ld2x64(const u16* p0, const u16* p1) {
  u32x2 a = *(const u32x2*)p0, b = *(const u32x2*)p1;
  u32x4 u; u.x = a.x; u.y = a.y; u.z = b.x; u.w = b.y;
  return __builtin_bit_cast(bf16x8, u);
}
DI float2 cmul(float2 a, float2 b) { return make_float2(a.x * b.x - a.y * b.y, a.x * b.y + a.y * b.x); }
DI float2 cadd(float2 a, float2 b) { return make_float2(a.x + b.x, a.y + b.y); }
DI float2 csub(float2 a, float2 b) { return make_float2(a.x - b.x, a.y - b.y); }

DI const float* xrow_in(const Params& p, int layer, int row) {
  int b = row / TB, tk = row - b * TB;
  if (tk < LC) return (layer == 0 ? p.ctx : (const float*)(p.ws + OFF_CTX1)) + (size_t)(b * LC + tk) * D;
  return (layer == 0 ? p.x : (const float*)p.out) + (size_t)(b * L + tk - LC) * D;
}
DI float* xrow_out(const Params& p, int row) {
  int b = row / TB, tk = row - b * TB;
  if (tk < LC) return (float*)(p.ws + OFF_CTX1) + (size_t)(b * LC + tk) * D;
  return p.out + (size_t)(b * L + tk - LC) * D;
}
DI const float* pk(const Params& p, int off) { return (const float*)(p.ws + OFF_PK) + off; }
DI int modvec_of(int row) { int b = row / TB, tk = row - b * TB; return tk < LC ? 2 : b; }

struct ALoadN {
  const u16* A; int lda;
  template <int BM> DI void fetch(u32x4 (&r)[BM / 64], int k0, int tid) const {
#pragma unroll
    for (int i = 0; i < BM / 64; ++i) { const int q = tid + NT * i; const unsigned off = (unsigned)((q >> 3) * lda + (q & 7) * 8); r[i] = *(const u32x4*)(A + off + k0); }
  }
  template <int BM> DI void commit(const u32x4 (&r)[BM / 64], u16* As, int tid) const {
#pragma unroll
    for (int i = 0; i < BM / 64; ++i) { int q = tid + NT * i; *(u32x4*)(As + (q >> 3) * LDT + (q & 7) * 8) = r[i]; }
  }
};
struct ALoadT {
  const u16* A; size_t chs;
  template <int BM> DI void fetch(u32x4 (&r)[BM / 64], int k0, int tid) const {
#pragma unroll
    for (int i = 0; i < 2; ++i) { const int q = tid + NT * i; const unsigned off = (unsigned)((q >> 4) * (int)chs + (q & 15) * 8); r[i] = *(const u32x4*)(A + off + (unsigned)(k0 * (int)chs)); }
  }
  template <int BM> DI void commit(const u32x4 (&r)[BM / 64], u16* As, int tid) const {
#pragma unroll
    for (int i = 0; i < 2; ++i) {
      int q = tid + NT * i; int ch = q >> 4, t0 = (q & 15) * 8;
      unsigned w[4] = {r[i].x, r[i].y, r[i].z, r[i].w};
#pragma unroll
      for (int e = 0; e < 4; ++e) { As[(t0 + 2 * e) * LDT + ch] = (u16)(w[e] & 0xffffu); As[(t0 + 2 * e + 1) * LDT + ch] = (u16)(w[e] >> 16); }
    }
  }
};

template <int BM, int KSU>
DI void gemm_compute(const u16* Ac, const u16* Bc, int wm, int wn, int r, int h, f32x16 (&acc)[BM / 128][2]) {
#pragma unroll KSU
  for (int ks = 0; ks < 4; ++ks) {
    bf16x8 a[BM / 128], b[2];
#pragma unroll
    for (int i = 0; i < BM / 128; ++i) a[i] = *(const bf16x8*)(Ac + (wm * (BM / 4) + i * 32 + r) * LDT + ks * 16 + h * 8);
#pragma unroll
    for (int j = 0; j < 2; ++j) b[j] = *(const bf16x8*)(Bc + (wn * 64 + j * 32 + r) * LDT + ks * 16 + h * 8);
#pragma unroll
    for (int i = 0; i < BM / 128; ++i)
#pragma unroll
      for (int j = 0; j < 2; ++j) acc[i][j] = MFMA(a[i], b[j], acc[i][j]);
  }
}
DI void fetch_b(u32x4 (&rb)[2], const u16* Bt, int ldb, int k0, int tid) {
#pragma unroll
  for (int i = 0; i < 2; ++i) { const int q = tid + NT * i; const unsigned off = (unsigned)((q >> 3) * ldb + (q & 7) * 8); rb[i] = *(const u32x4*)(Bt + off + k0); }
}
DI void commit_b(const u32x4 (&rb)[2], u16* Bs, int tid) {
#pragma unroll
  for (int i = 0; i < 2; ++i) { int q = tid + NT * i; *(u32x4*)(Bs + (q >> 3) * LDT + (q & 7) * 8) = rb[i]; }
}
template <int BM> struct GemmRegs { u32x4 ra0[BM / 64], rb0[2], ra1[BM / 64], rb1[2]; };
#define GFENCE asm volatile("" ::: "memory")
template <int BM, class AL>
DI void gemm_prime(GemmRegs<BM>& g, const AL& al, const u16* __restrict__ Bt, int ldb, char* smem) {
  u16* As0 = (u16*)smem;
  u16* Bs0 = As0 + 2 * BM * LDT;
  const int tid = my_tid();
  al.template fetch<BM>(g.ra0, 0, tid); fetch_b(g.rb0, Bt, ldb, 0, tid); GFENCE;
  al.template fetch<BM>(g.ra1, 64, tid); fetch_b(g.rb1, Bt, ldb, 64, tid); GFENCE;
  __syncthreads();
  al.template commit<BM>(g.ra0, As0, tid); commit_b(g.rb0, Bs0, tid);
  __syncthreads();
  al.template fetch<BM>(g.ra0, 128, tid); fetch_b(g.rb0, Bt, ldb, 128, tid); GFENCE;
}
template <int BM, class AL, int KSU, int K, class ALN>
DI void gemm_run(GemmRegs<BM>& g, const AL& al, const u16* __restrict__ Bt, int ldb, const ALN& aln, const u16* __restrict__ Btn, int ldbn,
                 bool hasnext, char* smem, f32x16 (&acc)[BM / 128][2]) {
  u16* As0 = (u16*)smem;
  u16* As1 = As0 + BM * LDT;
  u16* Bs0 = As0 + 2 * BM * LDT;
  u16* Bs1 = Bs0 + 128 * LDT;
  const int tid = my_tid(), lane = tid & 63, wid = tid >> 6, r = lane & 31, h = lane >> 5;
  const int wm = wid & 3, wn = wid >> 2;
  constexpr int KT = K >> 6;
#pragma unroll
  for (int kt = 0; kt < KT; kt += 2) {
    al.template commit<BM>(g.ra1, As1, tid); commit_b(g.rb1, Bs1, tid);
    GFENCE;
    if (kt + 3 < KT) { al.template fetch<BM>(g.ra1, (kt + 3) * 64, tid); fetch_b(g.rb1, Bt, ldb, (kt + 3) * 64, tid); GFENCE; }
    else if (hasnext) { aln.template fetch<BM>(g.ra1, (kt + 3 - KT) * 64, tid); fetch_b(g.rb1, Btn, ldbn, (kt + 3 - KT) * 64, tid); GFENCE; }
    gemm_compute<BM, KSU>(As0, Bs0, wm, wn, r, h, acc);
    __syncthreads();
    if (kt + 2 < KT) { al.template commit<BM>(g.ra0, As0, tid); commit_b(g.rb0, Bs0, tid); GFENCE; }
    else if (hasnext) { aln.template commit<BM>(g.ra0, As0, tid); commit_b(g.rb0, Bs0, tid); GFENCE; }
    if (kt + 4 < KT) { al.template fetch<BM>(g.ra0, (kt + 4) * 64, tid); fetch_b(g.rb0, Bt, ldb, (kt + 4) * 64, tid); GFENCE; }
    else if (hasnext) { aln.template fetch<BM>(g.ra0, (kt + 4 - KT) * 64, tid); fetch_b(g.rb0, Btn, ldbn, (kt + 4 - KT) * 64, tid); GFENCE; }
    gemm_compute<BM, KSU>(As1, Bs1, wm, wn, r, h, acc);
    __syncthreads();
  }
}

template <int BM, class AL, int KSU = 4, int K = 1024>
DI void gemm_tile(const AL& al, const u16* __restrict__ Bt, int ldb, char* smem, f32x16 (&acc)[BM / 128][2]) {
  GemmRegs<BM> g;
  gemm_prime<BM>(g, al, Bt, ldb, smem);
  gemm_run<BM, AL, KSU, K, AL>(g, al, Bt, ldb, al, Bt, ldb, false, smem, acc);
}

DI void phase0(const Params& p, char* smem) {
  const int tid = my_tid(), lane = tid & 63, wid = tid >> 6, bid = blockIdx.x, nb = gridDim.x;
  float* sm = (float*)smem;
  {
    float* PKW = (float*)(p.ws + OFF_PK);
    const int gt = bid * NT + tid, gn = nb * NT;
#define PKCP(src, off, cnt) for (int i = gt; i < (cnt); i += gn) PKW[(off) + i] = (src)[i];
    PKCP(p.wa_f, PK_WAF, 8192) PKCP(p.ba_f, PK_BAF, 512) PKCP(p.wa_b, PK_WAB, 8192) PKCP(p.ba_b, PK_BAB, 512)
    PKCP(p.gla_norm, PK_GN, 256) PKCP(p.qnorm, PK_QN, 128) PKCP(p.knorm, PK_KN, 128) PKCP(p.conv_w, PK_CW, 9216)
    PKCP(p.conv_b, PK_CB, 3072) PKCP(p.skip, PK_SK, 2048) PKCP(p.final_norm, PK_FN, 1024) PKCP(p.f3_w, PK_F3, 262144)
#undef PKCP
  }
  float* mod = (float*)(p.ws + OFF_MOD);
  for (int task = bid; task < 96; task += nb) {
    const int l = task / 48, cb = task % 48, col = cb * 64 + lane;
    const float* W = p.w_ada + (size_t)l * 1024 * 3072;
    float a0 = 0.f, a1 = 0.f, a2 = 0.f;
#pragma unroll 8
    for (int k = wid * 128; k < wid * 128 + 128; ++k) {
      float wv = W[(size_t)k * 3072 + col];
      a0 += silu_f(p.c[k]) * wv; a1 += silu_f(p.c[1024 + k]) * wv; a2 += silu_f(p.c_ctx[k]) * wv;
    }
    __syncthreads();
    sm[(wid * 3 + 0) * 64 + lane] = a0; sm[(wid * 3 + 1) * 64 + lane] = a1; sm[(wid * 3 + 2) * 64 + lane] = a2;
    __syncthreads();
    if (tid < 192) {
      int v = tid >> 6; float s = p.b_ada[l * 3072 + col];
      for (int w = 0; w < 8; ++w) s += sm[(w * 3 + v) * 64 + lane];
      mod[(l * 3 + v) * 3072 + col] = s;
    }
    __syncthreads();
  }
  for (int it = bid; it < (2 * TB) / 8; it += nb) {
    const int gr = it * 8 + wid, l = gr / TB, rr = gr - l * TB;
    const bool lat = rr < L; const int t = lat ? rr : rr - L; const int Lq = lat ? L : LC;
    float* em = sm + wid * 104; float* h1 = em + 40;
    __syncthreads();
    if (lane < 33) {
      float v;
      if (lane == 0) v = (float)t / (float)(Lq - 1);
      else {
        int bi = (lane - 1) & 15; float fr = 1e-4f + (float)bi * ((15.f - 1e-4f) / 15.f);
        float w = 6.283185307179586f * (float)t / (float)Lq;
        v = (lane <= 16) ? cosf(fr * w) : -sinf(fr * w);
      }
      em[lane] = v;
    }
    __syncthreads();
    {
      float a = p.f1_b[l * 64 + lane];
      for (int e = 0; e < 33; ++e) a += em[e] * p.f1_w[(l * 33 + e) * 64 + lane];
      h1[lane] = sinf(p.f1_freq[l * 64 + lane] * a);
    }
    __syncthreads();
    {
      float a = p.f2_b[l * 64 + lane];
      for (int i = 0; i < 64; ++i) a += h1[i] * p.f2_w[(l * 64 + i) * 64 + lane];
      float v = sinf(p.f2_freq[l * 64 + lane] * a);
      if (lat) ((u16*)(p.ws + OFF_H2T))[((size_t)l * 64 + lane) * L + t] = f2bf(v);
      else ((float*)(p.ws + OFF_H2C))[((size_t)l * 256 + t) * 64 + lane] = v;
    }
  }
  __syncthreads();
  {
    constexpr int T_IN = 16 * 249, T_BR = 8 * 32, T_OUT = 16 * 32, T_LAYER = T_IN + 3 * T_BR + T_OUT;
    auto decode = [&](int task, const float*& src, u16*& dst, int& K, int& N, int& k0, int& n0) {
      const int l = task / T_LAYER; int tt = task - l * T_LAYER;
      char* wt = p.ws + OFF_WT + (size_t)l * WT_LAYER;
      int kt, ntile;
      if (tt < T_IN) { src = p.w_in + (size_t)l * 1024 * NIN; dst = (u16*)wt; K = 1024; N = NIN; kt = tt / 249; ntile = tt % 249; }
      else if (tt < T_IN + 3 * T_BR) {
        tt -= T_IN; const int br = tt / T_BR; tt -= br * T_BR;
        src = (br == 0 ? p.w_g : (br == 1 ? p.w_a : p.w_h)) + (size_t)l * 512 * 1024; dst = (u16*)(wt + WT_IN + br * WT_BR);
        K = 512; N = 1024; kt = tt / 32; ntile = tt % 32;
      } else { tt -= T_IN + 3 * T_BR; src = p.w_o + (size_t)l * 1024 * 1024; dst = (u16*)(wt + WT_IN + 3 * WT_BR); K = 1024; N = 1024; kt = tt / 32; ntile = tt % 32; }
      k0 = kt * 64; n0 = ntile * 32;
    };
    float* tileA = sm;
    float* tileB = sm + 64 * 33;
    for (int task = bid; task < 2 * T_LAYER; task += 2 * nb) {
      const bool hasB = task + nb < 2 * T_LAYER;
      const float *sa, *sb = nullptr; u16 *da, *db = nullptr; int Ka, Na, k0a, n0a, Kb = 0, Nb = 0, k0b = 0, n0b = 0;
      decode(task, sa, da, Ka, Na, k0a, n0a);
      if (hasB) decode(task + nb, sb, db, Kb, Nb, k0b, n0b);
      float va[4], vb[4];
#pragma unroll
      for (int i = 0; i < 4; ++i) { const int kk = (tid >> 5) + 16 * i, nn = tid & 31; va[i] = sa[(size_t)(k0a + kk) * Na + n0a + nn]; vb[i] = hasB ? sb[(size_t)(k0b + kk) * Nb + n0b + nn] : 0.f; }
#pragma unroll
      for (int i = 0; i < 4; ++i) { const int kk = (tid >> 5) + 16 * i, nn = tid & 31; tileA[kk * 33 + nn] = va[i]; tileB[kk * 33 + nn] = vb[i]; }
      __syncthreads();
#pragma unroll
      for (int i = 0; i < 4; ++i) {
        const int nn = (tid >> 6) + 8 * i, kk = tid & 63;
        da[(size_t)(n0a + nn) * Ka + k0a + kk] = f2bf(tileA[kk * 33 + nn]);
        if (hasB) db[(size_t)(n0b + nn) * Kb + k0b + kk] = f2bf(tileB[kk * 33 + nn]);
      }
      __syncthreads();
    }
  }
}

DI void phase_norm(const Params& p, int l) {
  const int tid = my_tid(), lane = tid & 63, wid = tid >> 6;
  const float* mod = (const float*)(p.ws + OFF_MOD);
  u16* H = (u16*)(p.ws + OFF_H);
  for (int row = blockIdx.x * 8 + wid; row < R; row += gridDim.x * 8) {
    const float* src = xrow_in(p, l, row);
    const float* mv = mod + (l * 3 + modvec_of(row)) * 3072;
    float4 xv[4]; float ss = 0.f;
#pragma unroll
    for (int i = 0; i < 4; ++i) { xv[i] = *(const float4*)(src + (i * 64 + lane) * 4); ss += xv[i].x * xv[i].x + xv[i].y * xv[i].y + xv[i].z * xv[i].z + xv[i].w * xv[i].w; }
    ss = wave_sum(ss);
    const float rs = rsqrtf(ss * (1.f / 1024.f) + EPS);
#pragma unroll
    for (int i = 0; i < 4; ++i) {
      const int col = (i * 64 + lane) * 4;
      float4 sh = *(const float4*)(mv + col), sc = *(const float4*)(mv + 1024 + col);
      u32x2 o;
      o.x = pack2(xv[i].x * rs * (1.f + sc.x) + sh.x, xv[i].y * rs * (1.f + sc.y) + sh.y);
      o.y = pack2(xv[i].z * rs * (1.f + sc.z) + sh.z, xv[i].w * rs * (1.f + sc.w) + sh.w);
      *(u32x2*)(H + (size_t)row * 1024 + col) = o;
    }
  }
}

DI void phase_proj(const Params& p, int l, char* smem) {
  const int tid = my_tid(), lane = tid & 63, wid = tid >> 6, r = lane & 31, h = lane >> 5, wm = wid & 3, wn = wid >> 2;
  const u16* H = (const u16*)(p.ws + OFF_H);
  const u16* WT = (const u16*)(p.ws + OFF_WT + (size_t)l * WT_LAYER);
  u16* P = (u16*)(p.ws + OFF_P);
  u16* CT = (u16*)(p.ws + OFF_CT);
  u16* Tt = (u16*)smem;
  constexpr int LDE = 260;
  const int xcd = blockIdx.x & 7, nloc = gridDim.x >> 3;
  for (int q = blockIdx.x >> 3; q < 5 * 156; q += nloc) {
    const int g = q / 156, rem = q - g * 156, nt = rem >> 2, mt = (g * 4 + (rem & 3)) * 8 + xcd;
    if (mt >= 130) continue;
    const int m0 = mt * 256, n0 = nt * 128;
    f32x16 acc[2][2];
#pragma unroll
    for (int i = 0; i < 2; ++i) for (int j = 0; j < 2; ++j) acc[i][j] = zero16();
    ALoadN al{H + (size_t)m0 * 1024, 1024};
    gemm_tile<256, ALoadN, 4, 1024>(al, WT + (size_t)n0 * 1024, 1024, smem, acc);
    const int b = m0 / TB, tk0 = m0 - b * TB;
#pragma unroll
    for (int i = 0; i < 2; ++i)
#pragma unroll
      for (int j = 0; j < 2; ++j)
#pragma unroll
        for (int g4 = 0; g4 < 4; ++g4) {
          u32x2 o; o.x = pack2(acc[i][j][4 * g4], acc[i][j][4 * g4 + 1]); o.y = pack2(acc[i][j][4 * g4 + 2], acc[i][j][4 * g4 + 3]);
          *(u32x2*)(Tt + (wn * 64 + j * 32 + r) * LDE + wm * 64 + i * 32 + 8 * g4 + 4 * h) = o;
        }
    __syncthreads();
#pragma unroll 1
    for (int cg = 0; cg < 4; ++cg) {
      const int cb = n0 + cg * 32;
      if (cb >= 4896) continue;
      bool chan; int cm;
      if (cb < 512) { chan = false; cm = cb; }
      else if (cb < 1024) { chan = true; cm = CH_GV + cb - 512; }
      else if (cb < 2208) { chan = false; cm = cb - 512; }
      else if (cb < 2336) { chan = true; cm = CH_AV + cb - 2208; }
      else if (cb < 2848) { chan = false; cm = cb - 640; }
      else { chan = true; cm = cb - 2848; }
      if (chan) {
#pragma unroll
        for (int k = 0; k < 2; ++k) {
          const int idx = tid + NT * k, ch = idx >> 5, t8 = idx & 31;
          const u16* sp = Tt + (cg * 32 + ch) * LDE + t8 * 8;
          const u32x2 lo = *(const u32x2*)sp, hi = *(const u32x2*)(sp + 4);
          *(u32x4*)(CT + ((size_t)(cm + ch) * 2 + b) * TB + tk0 + t8 * 8) = u32x4{lo.x, lo.y, hi.x, hi.y};
        }
      } else {
#pragma unroll
        for (int k = 0; k < 2; ++k) {
          const int idx = tid + NT * k, row = idx >> 2, c8 = idx & 3;
          const u16* sp = Tt + (cg * 32 + c8 * 8) * LDE + row;
          u32x4 o;
          o.x = (unsigned)sp[0] | ((unsigned)sp[LDE] << 16); o.y = (unsigned)sp[2 * LDE] | ((unsigned)sp[3 * LDE] << 16);
          o.z = (unsigned)sp[4 * LDE] | ((unsigned)sp[5 * LDE] << 16); o.w = (unsigned)sp[6 * LDE] | ((unsigned)sp[7 * LDE] << 16);
          *(u32x4*)(P + (size_t)(m0 + row) * NP + cm + c8 * 8) = o;
        }
      }
    }
  }
}

DI void attn_prep(const Params& p, int l, int dry) {
  const int tid = my_tid(), lane = tid & 63, wid = tid >> 6;
  u16* P = (u16*)(p.ws + OFF_P);
  const float gq = pk(p, PK_QN)[l * 64 + lane], gk = pk(p, PK_KN)[l * 64 + lane];
  for (int row = blockIdx.x * 8 + wid; row < R; row += gridDim.x * 8) {
    u16* Pr = P + (size_t)row * NP;
    const int b = row / TB, tk = row - b * TB;
    float cs = 1.f, sn = 0.f;
    if (tk >= LC) {
      const int t = tk - LC, pi = lane >> 1;
      const float pos = (pi < 16) ? (float)(t >> 6) : (float)(t & 63);
      const float inv = powf(10000.f, -(float)(2 * (pi & 15)) / 32.f);
      sincosf(pos * inv, &sn, &cs);
    }
#pragma unroll
    for (int hd = 0; hd < 10; ++hd) {
      const int col = (hd < 8) ? PC_AQ + hd * 64 + lane : PC_AK + (hd - 8) * 64 + lane;
      float v = bf2f(Pr[col]);
      const float ss = wave_sum(v * v);
      v = v * rsqrtf(ss * (1.f / 64.f) + EPS) * (hd < 8 ? gq : gk);
      const float pv = __shfl_xor(v, 1);
      float o = (lane & 1) ? (pv * sn + v * cs) : (v * cs - pv * sn);
      if (hd < 8) o *= 0.125f * 1.4426950408889634f;
      if (!dry) Pr[col] = f2bf(o);
    }
  }
}

DI void fft_pass4_fwd(float2* X, int tid, int h2) {
  const float inv4 = 0.25f / (float)h2;
#pragma unroll 2
  for (int i = 0; i < 8; ++i) {
    const int g = tid + NT * i, jp = g & (h2 - 1), base = ((g - jp) << 2) + jp;
    float2 e0 = X[base], e1 = X[base + h2], e2 = X[base + 2 * h2], e3 = X[base + 3 * h2];
    const float fr = (float)jp * inv4;
    const float2 T1 = make_float2(__builtin_amdgcn_cosf(fr), -__builtin_amdgcn_sinf(fr));
    const float2 T2 = cmul(T1, T1);
    float2 a0 = cadd(e0, e2), a2 = cmul(csub(e0, e2), T1);
    float2 a1 = cadd(e1, e3), d13 = cmul(csub(e1, e3), T1);
    float2 a3 = make_float2(d13.y, -d13.x);
    X[base] = cadd(a0, a1); X[base + h2] = cmul(csub(a0, a1), T2);
    X[base + 2 * h2] = cadd(a2, a3); X[base + 3 * h2] = cmul(csub(a2, a3), T2);
  }
  __syncthreads();
}
DI void fft_pass4_inv(float2* X, int tid, int h1) {
  const float inv4 = 0.25f / (float)h1;
#pragma unroll 2
  for (int i = 0; i < 8; ++i) {
    const int g = tid + NT * i, jp = g & (h1 - 1), base = ((g - jp) << 2) + jp;
    float2 e0 = X[base], e1 = X[base + h1], e2 = X[base + 2 * h1], e3 = X[base + 3 * h1];
    const float fr = (float)jp * inv4;
    const float2 V = make_float2(__builtin_amdgcn_cosf(fr), __builtin_amdgcn_sinf(fr));
    const float2 Wc = cmul(V, V);
    float2 t1 = cmul(e1, Wc), t3 = cmul(e3, Wc);
    float2 a0 = cadd(e0, t1), a1 = csub(e0, t1), a2 = cadd(e2, t3), a3 = csub(e2, t3);
    float2 u2 = cmul(a2, V), u3 = cmul(a3, V);
    u3 = make_float2(-u3.y, u3.x);
    X[base] = cadd(a0, u2); X[base + 2 * h1] = csub(a0, u2);
    X[base + h1] = cadd(a1, u3); X[base + 3 * h1] = csub(a1, u3);
  }
  __syncthreads();
}
DI constexpr float r16c(int k) { return k == 0 ? 1.f : k == 1 ? 0.9238795325112867f : k == 2 ? 0.7071067811865476f : k == 3 ? 0.3826834323650898f : k == 4 ? 0.f : k == 5 ? -0.3826834323650898f : k == 6 ? -0.7071067811865476f : -0.9238795325112867f; }
DI constexpr float r16s(int k) { return k == 0 ? 0.f : k == 1 ? 0.3826834323650898f : k == 2 ? 0.7071067811865476f : k == 3 ? 0.9238795325112867f : k == 4 ? 1.f : k == 5 ? 0.9238795325112867f : k == 6 ? 0.7071067811865476f : 0.3826834323650898f; }
template <bool INV>
DI void fft_pass16(float2* X, int tid, int q) {
  const float invq = 1.f / (16.f * (float)q);
#pragma unroll 1
  for (int it = 0; it < 2; ++it) {
    const int g = tid + NT * it, jp = g & (q - 1), base = ((g - jp) << 4) + jp;
    float vx[16], vy[16];
#pragma unroll
    for (int r = 0; r < 16; ++r) { const float2 e = X[base + r * q]; vx[r] = e.x; vy[r] = e.y; }
    const float th = (float)jp * invq;
    float bx[4], by[4];
    bx[0] = __builtin_amdgcn_cosf(th); by[0] = INV ? __builtin_amdgcn_sinf(th) : -__builtin_amdgcn_sinf(th);
#pragma unroll
    for (int s = 1; s < 4; ++s) { bx[s] = bx[s - 1] * bx[s - 1] - by[s - 1] * by[s - 1]; by[s] = 2.f * bx[s - 1] * by[s - 1]; }
#pragma unroll
    for (int ss = 0; ss < 4; ++ss) {
      const int s = INV ? 3 - ss : ss;
      const int rs = 8 >> s;
#pragma unroll
      for (int bf = 0; bf < 8; ++bf) {
        const int r = ((bf & ~(rs - 1)) << 1) | (bf & (rs - 1));
        const int k = (r & (rs - 1)) * (8 / rs);
        const float cc = r16c(k), cs = INV ? r16s(k) : -r16s(k);
        const float tx = bx[s] * cc - by[s] * cs, ty = bx[s] * cs + by[s] * cc;
        const float ax = vx[r], ay = vy[r], cx = vx[r + rs], cy = vy[r + rs];
        if (!INV) {
          const float dx = ax - cx, dy = ay - cy;
          vx[r] = ax + cx; vy[r] = ay + cy;
          vx[r + rs] = dx * tx - dy * ty; vy[r + rs] = dx * ty + dy * tx;
        } else {
          const float ux = cx * tx - cy * ty, uy = cx * ty + cy * tx;
          vx[r] = ax + ux; vy[r] = ay + uy;
          vx[r + rs] = ax - ux; vy[r + rs] = ay - uy;
        }
      }
    }
#pragma unroll
    for (int r = 0; r < 16; ++r) X[base + r * q] = make_float2(vx[r], vy[r]);
  }
  __syncthreads();
}
DI void fft_fwd(float2* X, int tid) {
#pragma unroll 1
  for (int q = 1024; q >= 4; q >>= 4) fft_pass16<false>(X, tid, q);
  fft_pass4_fwd(X, tid, 1);
}
DI void fft_inv(float2* X, int tid) {
  fft_pass4_inv(X, tid, 1);
#pragma unroll 1
  for (int q = 4; q <= 1024; q <<= 4) fft_pass16<true>(X, tid, q);
}
DI float sconv_at(const u16* src, int t, int len, float w0, float w1, float w2, float bb) {
  float ym = t > 0 ? bf2f(src[t - 1]) : 0.f, y0 = bf2f(src[t]), yp = t < len - 1 ? bf2f(src[t + 1]) : 0.f;
  return bb + w0 * ym + w1 * y0 + w2 * yp;
}
DI float hy_delta(int col) {
  const float A0 = -4.605170185988091f / 0.3f, A1 = -4.605170185988091f / 1.5f;
  return fabsf(A0 + (A1 - A0) * ((float)col / 2047.f));
}

DI void hyena_latent_task(const Params& p, int l, int c, char* smem, int dry) {
  float2* X = (float2*)smem;
  float* red = (float*)(smem + 131072);
  const int tid = my_tid(), lane = tid & 63, wid = tid >> 6;
  u16* CT = (u16*)(p.ws + OFF_CT);
  float2* FE = (float2*)(p.ws + OFF_FS + (size_t)blockIdx.x * 262144);
  float2* FO = FE + 16384;
  const unsigned* h2T = (const unsigned*)(p.ws + OFF_H2T) + (size_t)l * 64 * (L / 2);
  const float* f3w = pk(p, PK_F3) + (size_t)l * 64 * 2048;
  const float* cw = pk(p, PK_CW) + (size_t)l * 3 * 1536;
  const float* cbv = pk(p, PK_CB) + (size_t)l * 1536;
  const float vw0 = cw[c], vw1 = cw[1536 + c], vw2 = cw[3072 + c], vbb = cbv[c];
  const u16* v0 = CT + ((size_t)(CH_YU + c) * 2 + 0) * TB + LC;
  const u16* v1 = CT + ((size_t)(CH_YU + c) * 2 + 1) * TB + LC;
  u16* z10 = CT + ((size_t)(CH_YU + 512 + c) * 2 + 0) * TB + LC;
  u16* z11 = CT + ((size_t)(CH_YU + 512 + c) * 2 + 1) * TB + LC;
#pragma unroll 1
  for (int o = 0; o < 2; ++o) {
    const int cf = o * 1024 + c, cbk = cf + 512;
    float sf = 0.f, sb = 0.f;
    __syncthreads();
#ifdef PROBE_FFT
    fft_fwd(X, tid); fft_inv(X, tid);
#endif
#pragma unroll 1
    for (int half = 0; half < 2; ++half) {
      float af[16], ab[16];
#pragma unroll
      for (int i = 0; i < 16; ++i) { af[i] = 0.f; ab[i] = 0.f; }
#pragma unroll 1
      for (int j = 0; j < 64; j += 2) {
        const float wf0 = f3w[j * 2048 + cf], wb0 = f3w[j * 2048 + cbk], wf1 = f3w[(j + 1) * 2048 + cf], wb1 = f3w[(j + 1) * 2048 + cbk];
        const unsigned* hrow = h2T + (size_t)j * (L / 2) + tid + half * 8 * NT;
        unsigned w0[8], w1[8];
#pragma unroll
        for (int i = 0; i < 8; ++i) { w0[i] = hrow[NT * i]; w1[i] = hrow[L / 2 + NT * i]; }
#pragma unroll
        for (int i = 0; i < 8; ++i) {
          const float a0 = bflo(w0[i]), a1 = bfhi(w0[i]), b0 = bflo(w1[i]), b1 = bfhi(w1[i]);
          af[2 * i] += a0 * wf0 + b0 * wf1; af[2 * i + 1] += a1 * wf0 + b1 * wf1;
          ab[2 * i] += a0 * wb0 + b0 * wb1; ab[2 * i + 1] += a1 * wb0 + b1 * wb1;
        }
      }
      const float df = hy_delta(cf), db = hy_delta(cbk);
#pragma unroll
      for (int i = 0; i < 16; ++i) {
        const int t = 2 * (tid + NT * ((i >> 1) + half * 8)) + (i & 1); const float tt = (float)t / (float)(L - 1);
        const float vf = af[i] * (__expf(-tt * df) + 0.05f), vb = ab[i] * (__expf(-tt * db) + 0.05f);
        sf += fabsf(vf); sb += fabsf(vb);
        X[t].x = vf;
        if (t >= 1) X[L - t].y = vb; else X[0].y = 0.f;
      }
    }
    sf = wave_sum(sf); sb = wave_sum(sb);
    if (lane == 0) { red[wid] = sf; red[8 + wid] = sb; }
    __syncthreads();
    float nf = 0.f, nbk = 0.f;
#pragma unroll
    for (int w = 0; w < 8; ++w) { nf += red[w]; nbk += red[8 + w]; }
    const float inv_f = 1.f / nf, inv_b = 1.f / nbk;
#pragma unroll 8
    for (int i = 0; i < 32; ++i) { const int n = tid + NT * i; const float2 s = X[n]; FO[n] = s; X[n] = make_float2(s.x * inv_f + s.y * inv_b, 0.f); }
    __syncthreads();
    fft_fwd(X, tid);
#pragma unroll 8
    for (int i = 0; i < 32; ++i) { const int n = tid + NT * i; FE[n] = X[n]; }
    __syncthreads();
#pragma unroll 8
    for (int i = 0; i < 32; ++i) {
      const int n = tid + NT * i; const float2 s = FO[n]; const float dd = s.x * inv_f - s.y * inv_b; const float fr = (float)n * (1.f / 32768.f);
      X[n] = make_float2(dd * __builtin_amdgcn_cosf(fr), -dd * __builtin_amdgcn_sinf(fr));
    }
    __syncthreads();
    fft_fwd(X, tid);
#pragma unroll 8
    for (int i = 0; i < 32; ++i) { const int n = tid + NT * i; FO[n] = X[n]; }
    __syncthreads();
#pragma unroll 8
    for (int i = 0; i < 32; ++i) {
      const int n = tid + NT * i;
      float2 zz;
      if (o == 0) { zz.x = sconv_at(v0, n, L, vw0, vw1, vw2, vbb); zz.y = sconv_at(v1, n, L, vw0, vw1, vw2, vbb); }
      else { zz.x = bf2f(z10[n]); zz.y = bf2f(z11[n]); }
      X[n] = zz;
    }
    __syncthreads();
    fft_fwd(X, tid);
#pragma unroll 8
    for (int i = 0; i < 32; ++i) { const int n = tid + NT * i; X[n] = cmul(X[n], FE[n]); }
    __syncthreads();
    fft_inv(X, tid);
#pragma unroll 8
    for (int i = 0; i < 32; ++i) { const int n = tid + NT * i; FE[n] = X[n]; }
    __syncthreads();
#pragma unroll 8
    for (int i = 0; i < 32; ++i) {
      const int n = tid + NT * i; const float fr = (float)n * (1.f / 32768.f);
      float2 zz;
      if (o == 0) { zz.x = sconv_at(v0, n, L, vw0, vw1, vw2, vbb); zz.y = sconv_at(v1, n, L, vw0, vw1, vw2, vbb); }
      else { zz.x = bf2f(z10[n]); zz.y = bf2f(z11[n]); }
      X[n] = cmul(zz, make_float2(__builtin_amdgcn_cosf(fr), -__builtin_amdgcn_sinf(fr)));
    }
    __syncthreads();
    fft_fwd(X, tid);
#pragma unroll 8
    for (int i = 0; i < 32; ++i) { const int n = tid + NT * i; X[n] = cmul(X[n], FO[n]); }
    __syncthreads();
    fft_inv(X, tid);
    {
      const int gch = CH_YU + 512 * (o + 1) + c;
      const float w0 = cw[gch], w1 = cw[1536 + gch], w2 = cw[3072 + gch], bb = cbv[gch];
      const u16* s0 = CT + ((size_t)gch * 2 + 0) * TB + LC;
      const u16* s1 = CT + ((size_t)gch * 2 + 1) * TB + LC;
      const float sk = pk(p, PK_SK)[(l * 2 + o) * 512 + c];
#pragma unroll 8
      for (int i = 0; i < 32; ++i) {
        const int n = tid + NT * i; const float fr = (float)n * (1.f / 32768.f);
        const float2 wb = cmul(X[n], make_float2(__builtin_amdgcn_cosf(fr), __builtin_amdgcn_sinf(fr)));
        const float2 A = FE[n];
        const float yr = (A.x + wb.x) * (1.f / 32768.f), yi = (A.y + wb.y) * (1.f / 32768.f);
        const float g0 = sconv_at(s0, n, L, w0, w1, w2, bb), g1 = sconv_at(s1, n, L, w0, w1, w2, bb);
        float2 zz;
        if (o == 0) { zz.x = sconv_at(v0, n, L, vw0, vw1, vw2, vbb); zz.y = sconv_at(v1, n, L, vw0, vw1, vw2, vbb); }
        else { zz.x = bf2f(z10[n]); zz.y = bf2f(z11[n]); }
        X[n] = make_float2(g0 * (yr + sk * zz.x), g1 * (yi + sk * zz.y));
      }
    }
    __syncthreads();
    if (o == 0) {
#pragma unroll 8
      for (int i = 0; i < 32; ++i) { const int n = tid + NT * i; const float2 zz = X[n]; if (!dry) { z10[n] = f2bf(zz.x); z11[n] = f2bf(zz.y); } }
    } else {
      u16* d0 = CT + ((size_t)(CH_YZ + c) * 2 + 0) * TB + LC;
      u16* d1 = CT + ((size_t)(CH_YZ + c) * 2 + 1) * TB + LC;
#pragma unroll 1
      for (int ib = 0; ib < 32; ib += 8) {
        u16 g0[8], g1[8];
#pragma unroll
        for (int i = 0; i < 8; ++i) { const int n = tid + NT * (ib + i); g0[i] = d0[n]; g1[i] = d1[n]; }
#pragma unroll
        for (int i = 0; i < 8; ++i) {
          const int n = tid + NT * (ib + i); const float2 zz = X[n];
          const u16 q0 = f2bf(zz.x * silu_f(bf2f(g0[i]))), q1 = f2bf(zz.y * silu_f(bf2f(g1[i])));
          if (!dry) { d0[n] = q0; d1[n] = q1; }
        }
      }
    }
    __syncthreads();
  }
}

DI void hyena_ctx_task(const Params& p, int l, int c, char* smem, int dry) {
  float* filt = (float*)smem;
  float* zs = filt + 1024;
  float* nrm = zs + 1024;
  const int tid = my_tid(), lane = tid & 63, wid = tid >> 6, t = tid & 255, hb = tid >> 8;
  u16* CT = (u16*)(p.ws + OFF_CT);
  const float* h2c = (const float*)(p.ws + OFF_H2C) + (size_t)l * 256 * 64;
  const float* f3w = pk(p, PK_F3) + (size_t)l * 64 * 2048;
  const float* cw = pk(p, PK_CW) + (size_t)l * 3 * 1536;
  const float* cbv = pk(p, PK_CB) + (size_t)l * 1536;
  __syncthreads();
  {
    const int cf = hb * 1024 + c, cbk = cf + 512;
    float a_f = 0.f, a_b = 0.f;
    for (int j = 0; j < 64; ++j) { const float hv = h2c[t * 64 + j]; a_f += hv * f3w[j * 2048 + cf]; a_b += hv * f3w[j * 2048 + cbk]; }
    const float tt = (float)t / 255.f;
    filt[(hb * 2 + 0) * 256 + t] = a_f * (__expf(-tt * hy_delta(cf)) + 0.05f);
    filt[(hb * 2 + 1) * 256 + t] = a_b * (__expf(-tt * hy_delta(cbk)) + 0.05f);
    const u16* src = CT + ((size_t)(CH_YU + c) * 2 + hb) * TB;
    zs[hb * 256 + t] = sconv_at(src, t, LC, cw[c], cw[1536 + c], cw[3072 + c], cbv[c]);
  }
  __syncthreads();
  if (wid < 4) {
    float s = 0.f;
    for (int k = 0; k < 4; ++k) s += fabsf(filt[wid * 256 + lane + 64 * k]);
    s = wave_sum(s);
    if (lane == 0) nrm[wid] = s;
  }
  __syncthreads();
  const int b = hb;
  for (int o = 0; o < 2; ++o) {
    const float inf_ = 1.f / nrm[o * 2], inb_ = 1.f / nrm[o * 2 + 1];
    const float* hf = filt + (o * 2) * 256; const float* hbk = filt + (o * 2 + 1) * 256;
    const float* zc = zs + (o & 1) * 512 + b * 256;
    float accf = 0.f, accb = 0.f;
    for (int s = 0; s <= t; ++s) accf += hf[t - s] * zc[s];
    for (int s = t + 1; s < 256; ++s) accb += hbk[s - t] * zc[s];
    const int gch = CH_YU + 512 * (o + 1) + c;
    const float gate = sconv_at(CT + ((size_t)gch * 2 + b) * TB, t, LC, cw[gch], cw[1536 + gch], cw[3072 + gch], cbv[gch]);
    const float zn = gate * (accf * inf_ + accb * inb_ + pk(p, PK_SK)[(l * 2 + o) * 512 + c] * zc[t]);
    zs[((o + 1) & 1) * 512 + b * 256 + t] = zn;
    __syncthreads();
  }
  {
    u16* d = CT + ((size_t)(CH_YZ + c) * 2 + b) * TB;
    const u16 q0 = f2bf(zs[b * 256 + t] * silu_f(bf2f(d[t])));
    if (!dry) d[t] = q0;
  }
  __syncthreads();
}

DI void gla_bcum(const Params& p, int l, int row0, int hh, int dir, float* gs, float* segs, float* was, float* as_) {
  const int tid = my_tid();
  const u16* P = (const u16*)(p.ws + OFF_P);
  const float* wa = pk(p, dir ? PK_WAB : PK_WAF) + (size_t)l * 16 * 256 + hh * 64;
  const float* ba = pk(p, dir ? PK_BAB : PK_BAF) + l * 256 + hh * 64;
#pragma unroll
  for (int i = 0; i < 2; ++i) {
    const int idx = tid + NT * i;
    was[idx] = wa[(idx >> 6) * 256 + (idx & 63)];
    as_[(idx >> 4) * 17 + (idx & 15)] = bf2f(P[(size_t)(row0 + (idx >> 4)) * NP + PC_AF + dir * 16 + (idx & 15)]);
  }
  __syncthreads();
  {
    const int t = tid >> 3, d0 = (tid & 7) * 8;
    float lin[8];
#pragma unroll
    for (int e = 0; e < 8; ++e) lin[e] = ba[d0 + e];
#pragma unroll 2
    for (int rr = 0; rr < 16; ++rr) {
      const float av = as_[t * 17 + rr];
      const float4 w0 = *(const float4*)(was + rr * 64 + d0), w1 = *(const float4*)(was + rr * 64 + d0 + 4);
      lin[0] += av * w0.x; lin[1] += av * w0.y; lin[2] += av * w0.z; lin[3] += av * w0.w;
      lin[4] += av * w1.x; lin[5] += av * w1.y; lin[6] += av * w1.z; lin[7] += av * w1.w;
    }
#pragma unroll
    for (int e = 0; e < 8; ++e) gs[t * 65 + d0 + e] = (fminf(lin[e], 0.f) - log1pf(__expf(-fabsf(lin[e])))) * (1.f / 16.f);
  }
  __syncthreads();
  {
    const int d = tid & 63, seg = tid >> 6;
    float v[8]; float run = 0.f;
#pragma unroll
    for (int e = 0; e < 8; ++e) { const int tt = dir ? seg * 8 + 7 - e : seg * 8 + e; run += gs[tt * 65 + d]; v[e] = run; }
    segs[seg * 64 + d] = run;
    __syncthreads();
    float off = 0.f;
#pragma unroll
    for (int s = 0; s < 8; ++s) { const bool before = dir ? (s > seg) : (s < seg); if (before) off += segs[s * 64 + d]; }
#pragma unroll
    for (int e = 0; e < 8; ++e) { const int tt = dir ? seg * 8 + 7 - e : seg * 8 + e; gs[tt * 65 + d] = v[e] + off; }
  }
  __syncthreads();
}
DI int gla_tok0(int dir, int n) {
  if (n < 4) return (dir ? 3 - n : n) * 64;
  return LC + (dir ? 255 - (n - 4) : n - 4) * 64;
}
constexpr int G_GS = 0;
constexpr int G_SEG = G_GS + 64 * 65 * 4;
constexpr int G_QS = G_SEG + 8 * 64 * 4;
constexpr int G_KS = G_QS + 64 * LDT * 2;
constexpr int G_VT = G_KS + 64 * LDT * 2;
constexpr int G_ST = G_VT + 128 * LDT * 2;
constexpr int G_RED = G_ST + 128 * LDT * 2;
constexpr int G_WA = G_RED + 8 * 32 * 4;
constexpr int G_AS = G_WA + 16 * 64 * 4;

DI void gla_g1_task(const Params& p, int l, int chain, int n, char* smem) {
  const int tid = my_tid(), lane = tid & 63, wid = tid >> 6, r = lane & 31, h = lane >> 5;
  const int b = chain >> 3, hh = (chain >> 1) & 3, dir = chain & 1;
  const int tk0 = gla_tok0(dir, n), row0 = b * TB + tk0;
  float* gs = (float*)(smem + G_GS); float* segs = (float*)(smem + G_SEG);
  u16* kT = (u16*)(smem + G_KS); u16* vT = (u16*)(smem + G_VT);
  const u16* P = (const u16*)(p.ws + OFF_P);
  const u16* CT = (const u16*)(p.ws + OFF_CT);
  __syncthreads();
  gla_bcum(p, l, row0, hh, dir, gs, segs, (float*)(smem + G_WA), (float*)(smem + G_AS));
  const int tl = dir ? 0 : 63;
  {
    const int t = tid >> 3, d0 = (tid & 7) * 8;
    const u32x4 kv = *(const u32x4*)(P + (size_t)(row0 + t) * NP + PC_GK + hh * 64 + d0);
    const unsigned w[4] = {kv.x, kv.y, kv.z, kv.w};
#pragma unroll
    for (int e = 0; e < 8; ++e) {
      const float kx = (e & 1) ? bfhi(w[e >> 1]) : bflo(w[e >> 1]);
      kT[(d0 + e) * LDT + t] = f2bf(kx * __expf(gs[tl * 65 + d0 + e] - gs[t * 65 + d0 + e]));
    }
#pragma unroll
    for (int i = 0; i < 2; ++i) {
      const int q = tid + NT * i, v = q >> 3, cc = q & 7;
      *(u32x4*)(vT + v * LDT + cc * 8) = *(const u32x4*)(CT + ((size_t)(CH_GV + hh * 128 + v) * 2 + b) * TB + tk0 + cc * 8);
    }
    if (tid < 64) ((float*)(p.ws + OFF_GD))[((size_t)chain * NCK + n) * 64 + tid] = __expf(gs[tl * 65 + tid]);
  }
  __syncthreads();
  {
    const int vm = wid >> 1, dn = wid & 1;
    f32x16 acc = zero16();
#pragma unroll
    for (int s = 0; s < 4; ++s) {
      const bf16x8 a = *(const bf16x8*)(vT + (vm * 32 + r) * LDT + s * 16 + h * 8);
      const bf16x8 bb = *(const bf16x8*)(kT + (dn * 32 + r) * LDT + s * 16 + h * 8);
      acc = MFMA(a, bb, acc);
    }
    u16* GS = (u16*)(p.ws + OFF_GS) + ((size_t)chain * NCK + n) * 8192;
#pragma unroll
    for (int reg = 0; reg < 16; ++reg) GS[(vm * 32 + crow(reg, h)) * 64 + dn * 32 + r] = f2bf(acc[reg]);
  }
}
DI void gla_g2(const Params& p, int dry) {
  u16* GSb = (u16*)(p.ws + OFF_GS);
  const float* GD = (const float*)(p.ws + OFF_GD);
  for (int gi = blockIdx.x * NT + my_tid(); gi < 16 * 8192; gi += gridDim.x * NT) {
    const int chain = gi >> 13, e = gi & 8191, d = e & 63;
    u16* ptr = GSb + (size_t)chain * NCK * 8192 + e;
    const float* dec = GD + (size_t)chain * NCK * 64 + d;
    float S = 0.f;
#pragma unroll 1
    for (int n0 = 0; n0 < NCK; n0 += 20) {
      float ds[20], a[20];
#pragma unroll
      for (int k = 0; k < 20; ++k) { ds[k] = bf2f(ptr[(size_t)(n0 + k) * 8192]); a[k] = dec[(n0 + k) * 64]; }
#pragma unroll
      for (int k = 0; k < 20; ++k) { if (!dry) ptr[(size_t)(n0 + k) * 8192] = f2bf(S); S = a[k] * S + ds[k]; }
    }
  }
}
DI void gla_g3_task(const Params& p, int l, int b, int hh, int ci, char* smem, int dry) {
  const int tid = my_tid(), lane = tid & 63, wid = tid >> 6, r = lane & 31, h = lane >> 5;
  const int tk0 = ci * 64, row0 = b * TB + tk0;
  float* gs = (float*)(smem + G_GS); float* segs = (float*)(smem + G_SEG); float* red = (float*)(smem + G_RED);
  u16* qs = (u16*)(smem + G_QS); u16* ks = (u16*)(smem + G_KS); u16* vT = (u16*)(smem + G_VT); u16* sT = (u16*)(smem + G_ST);
  u16* P = (u16*)(p.ws + OFF_P);
  const u16* CT = (const u16*)(p.ws + OFF_CT);
  const int vm = wid >> 1, in = wid & 1;
  f32x16 o = zero16();
  __syncthreads();
#pragma unroll 1
  for (int dir = 0; dir < 2; ++dir) {
    gla_bcum(p, l, row0, hh, dir, gs, segs, (float*)(smem + G_WA), (float*)(smem + G_AS));
    const int chain = b * 8 + hh * 2 + dir;
    const int n = dir ? ((ci < 4) ? 3 - ci : 263 - ci) : ci;
    {
      const int t = tid >> 3, d0 = (tid & 7) * 8;
      const u32x4 qv = *(const u32x4*)(P + (size_t)(row0 + t) * NP + PC_GQ + hh * 64 + d0);
      const u32x4 kv = *(const u32x4*)(P + (size_t)(row0 + t) * NP + PC_GK + hh * 64 + d0);
      const unsigned qw[4] = {qv.x, qv.y, qv.z, qv.w}, kw[4] = {kv.x, kv.y, kv.z, kv.w};
      unsigned qo[4], ko[4];
#pragma unroll
      for (int e = 0; e < 4; ++e) {
        const float b0 = gs[t * 65 + d0 + 2 * e], b1 = gs[t * 65 + d0 + 2 * e + 1];
        qo[e] = pack2(bflo(qw[e]) * 0.125f * __expf(b0), bfhi(qw[e]) * 0.125f * __expf(b1));
        ko[e] = pack2(bflo(kw[e]) * __expf(-b0), bfhi(kw[e]) * __expf(-b1));
      }
      *(u32x4*)(qs + t * LDT + d0) = u32x4{qo[0], qo[1], qo[2], qo[3]};
      *(u32x4*)(ks + t * LDT + d0) = u32x4{ko[0], ko[1], ko[2], ko[3]};
      const u16* GS = (const u16*)(p.ws + OFF_GS) + ((size_t)chain * NCK + n) * 8192;
#pragma unroll
      for (int i = 0; i < 2; ++i) {
        const int q = tid + NT * i, v = q >> 3, cc = q & 7;
        *(u32x4*)(sT + v * LDT + cc * 8) = *(const u32x4*)(GS + v * 64 + cc * 8);
        if (dir == 0) *(u32x4*)(vT + v * LDT + cc * 8) = *(const u32x4*)(CT + ((size_t)(CH_GV + hh * 128 + v) * 2 + b) * TB + tk0 + cc * 8);
      }
    }
    __syncthreads();
    bf16x8 qf[4];
#pragma unroll
    for (int s = 0; s < 4; ++s) qf[s] = *(const bf16x8*)(qs + (in * 32 + r) * LDT + s * 16 + h * 8);
#pragma unroll
    for (int jt = 0; jt < 2; ++jt) {
      f32x16 at = zero16();
#pragma unroll
      for (int s = 0; s < 4; ++s) at = MFMA(*(const bf16x8*)(ks + (jt * 32 + r) * LDT + s * 16 + h * 8), qf[s], at);
      const int ii = in * 32 + r;
#pragma unroll
      for (int reg = 0; reg < 16; ++reg) {
        const int jj = jt * 32 + crow(reg, h);
        const bool keep = dir ? (jj >= ii) : (jj <= ii);
        if (!keep) at[reg] = 0.f;
      }
#pragma unroll
      for (int s = 0; s < 2; ++s) {
        const u16* vp = vT + (vm * 32 + r) * LDT + jt * 32 + 16 * s + 4 * h;
        o = MFMA(ld2x64(vp, vp + 8), pack8(at, s), o);
      }
    }
#pragma unroll
    for (int s = 0; s < 4; ++s) o = MFMA(*(const bf16x8*)(sT + (vm * 32 + r) * LDT + s * 16 + h * 8), qf[s], o);
    __syncthreads();
  }
  float ss = 0.f;
#pragma unroll
  for (int reg = 0; reg < 16; ++reg) ss += o[reg] * o[reg];
  ss += __shfl_xor(ss, 32);
  if (h == 0) red[wid * 32 + r] = ss;
  __syncthreads();
  float tot = 0.f;
#pragma unroll
  for (int m = 0; m < 4; ++m) tot += red[(m * 2 + in) * 32 + r];
  const float rs = rsqrtf(tot * (1.f / 128.f) + EPS);
  u16* zp = P + (size_t)(row0 + in * 32 + r) * NP + PC_GZ + hh * 128 + vm * 32 + 4 * h;
  const float* gn = pk(p, PK_GN) + l * 128 + vm * 32 + 4 * h;
#pragma unroll
  for (int g = 0; g < 4; ++g) {
    const u32x2 zz = *(const u32x2*)(zp + 8 * g);
    const float4 gw = *(const float4*)(gn + 8 * g);
    u32x2 out;
    out.x = pack2(o[4 * g] * rs * gw.x * silu_f(bflo(zz.x)), o[4 * g + 1] * rs * gw.y * silu_f(bfhi(zz.x)));
    out.y = pack2(o[4 * g + 2] * rs * gw.z * silu_f(bflo(zz.y)), o[4 * g + 3] * rs * gw.w * silu_f(bfhi(zz.y)));
    if (!dry) *(u32x2*)(zp + 8 * g) = out;
  }
}

DI void attn_item(const Params& p, int l, int b, int g, int qtk0, int ntiles, char* smem, int dry) {
  const int tid = my_tid(), lane = tid & 63, wid = tid >> 6, r = lane & 31, h = lane >> 5;
  u16* P = (u16*)(p.ws + OFF_P);
  const u16* CT = (const u16*)(p.ws + OFF_CT);
  u16* Ks = (u16*)smem;
  u16* Vs = Ks + 2 * 64 * LDT;
  const int hq = g * 4 + (wid >> 1);
  const size_t qrow = (size_t)b * TB + qtk0 + (wid & 1) * 32 + r;
  bf16x8 qf[4];
#pragma unroll
  for (int s = 0; s < 4; ++s) qf[s] = *(const bf16x8*)(P + qrow * NP + PC_AQ + hq * 64 + s * 16 + h * 8);
  f32x16 O[2] = {zero16(), zero16()};
  float m = -1e30f, lsum = 0.f;
  const int lr = tid >> 3, lc = (tid & 7) * 8;
  const u16* kg = P + ((size_t)b * TB + lr) * NP + PC_AK + g * 64 + lc;
  const u16* vg = CT + ((size_t)(CH_AV + g * 64 + lr) * 2 + b) * TB + lc;
  u32x4 rk = *(const u32x4*)kg, rv = *(const u32x4*)vg;
  __syncthreads();
  *(u32x4*)(Ks + lr * LDT + lc) = rk; *(u32x4*)(Vs + lr * LDT + lc) = rv;
  __syncthreads();
  float gqm = fabsf(pk(p, PK_QN)[l * 64 + lane]), gkm = fabsf(pk(p, PK_KN)[l * 64 + lane]);
#pragma unroll
  for (int o = 32; o >= 1; o >>= 1) { gqm = fmaxf(gqm, __shfl_xor(gqm, o)); gkm = fmaxf(gkm, __shfl_xor(gkm, o)); }
  const float mshift = 8.2f * 1.4426950408889634f * gqm * gkm;
  if (mshift <= 60.f) {
    f32x16 sinit;
#pragma unroll
    for (int i = 0; i < 16; ++i) sinit[i] = -mshift;
#pragma unroll 1
    for (int kt = 0; kt < ntiles; ++kt) {
      const int cur = kt & 1;
      if (kt + 1 < ntiles) { rk = *(const u32x4*)(kg + (size_t)(kt + 1) * 64 * NP); rv = *(const u32x4*)(vg + (kt + 1) * 64); }
      const u16* Kc = Ks + cur * 64 * LDT; const u16* Vc = Vs + cur * 64 * LDT;
      f32x16 st[2];
#pragma unroll
      for (int kk = 0; kk < 2; ++kk) {
        st[kk] = sinit;
#pragma unroll
        for (int s = 0; s < 4; ++s) st[kk] = MFMA(*(const bf16x8*)(Kc + (kk * 32 + r) * LDT + s * 16 + h * 8), qf[s], st[kk]);
      }
#pragma unroll
      for (int kk = 0; kk < 2; ++kk)
#pragma unroll
        for (int i = 0; i < 16; ++i) { const float pv = __builtin_amdgcn_exp2f(st[kk][i]); st[kk][i] = pv; lsum += pv; }
#pragma unroll
      for (int kk = 0; kk < 2; ++kk)
#pragma unroll
        for (int s = 0; s < 2; ++s) {
          const bf16x8 pb = pack8(st[kk], s);
#pragma unroll
          for (int mt = 0; mt < 2; ++mt) {
            const u16* vp = Vc + (mt * 32 + r) * LDT + kk * 32 + 16 * s + 4 * h;
            O[mt] = MFMA(ld2x64(vp, vp + 8), pb, O[mt]);
          }
        }
      if (kt + 1 < ntiles) { *(u32x4*)(Ks + (cur ^ 1) * 64 * LDT + lr * LDT + lc) = rk; *(u32x4*)(Vs + (cur ^ 1) * 64 * LDT + lr * LDT + lc) = rv; }
      __syncthreads();
    }
  } else {
#pragma unroll 1
    for (int kt = 0; kt < ntiles; ++kt) {
      const int cur = kt & 1;
      if (kt + 1 < ntiles) { rk = *(const u32x4*)(kg + (size_t)(kt + 1) * 64 * NP); rv = *(const u32x4*)(vg + (kt + 1) * 64); }
      const u16* Kc = Ks + cur * 64 * LDT; const u16* Vc = Vs + cur * 64 * LDT;
      f32x16 st[2];
#pragma unroll
      for (int kk = 0; kk < 2; ++kk) {
        st[kk] = zero16();
#pragma unroll
        for (int s = 0; s < 4; ++s) st[kk] = MFMA(*(const bf16x8*)(Kc + (kk * 32 + r) * LDT + s * 16 + h * 8), qf[s], st[kk]);
      }
      float mx = st[0][0];
#pragma unroll
      for (int i = 0; i < 16; ++i) { mx = fmaxf(mx, st[0][i]); mx = fmaxf(mx, st[1][i]); }
      mx = fmaxf(mx, __shfl_xor(mx, 32));
      const float mn = fmaxf(m, mx);
      const float alpha = exp2f(m - mn);
      m = mn;
      float rsum = 0.f;
#pragma unroll
      for (int kk = 0; kk < 2; ++kk)
#pragma unroll
        for (int i = 0; i < 16; ++i) { const float pv = exp2f(st[kk][i] - mn); st[kk][i] = pv; rsum += pv; }
      lsum = lsum * alpha + rsum;
#pragma unroll
      for (int mt = 0; mt < 2; ++mt)
#pragma unroll
        for (int i = 0; i < 16; ++i) O[mt][i] *= alpha;
#pragma unroll
      for (int kk = 0; kk < 2; ++kk)
#pragma unroll
        for (int s = 0; s < 2; ++s) {
          const bf16x8 pb = pack8(st[kk], s);
#pragma unroll
          for (int mt = 0; mt < 2; ++mt) {
            const u16* vp = Vc + (mt * 32 + r) * LDT + kk * 32 + 16 * s + 4 * h;
            O[mt] = MFMA(ld2x64(vp, vp + 8), pb, O[mt]);
          }
        }
      if (kt + 1 < ntiles) { *(u32x4*)(Ks + (cur ^ 1) * 64 * LDT + lr * LDT + lc) = rk; *(u32x4*)(Vs + (cur ^ 1) * 64 * LDT + lr * LDT + lc) = rv; }
      __syncthreads();
    }
  }
  lsum += __shfl_xor(lsum, 32);
  const float inv = 1.f / lsum;
  u16* op = P + qrow * NP + PC_AQ + hq * 64 + 4 * h;
  const u16* zp = P + qrow * NP + PC_AZ + hq * 64 + 4 * h;
#pragma unroll
  for (int mt = 0; mt < 2; ++mt)
#pragma unroll
    for (int gg = 0; gg < 4; ++gg) {
      const u32x2 zz = *(const u32x2*)(zp + mt * 32 + 8 * gg);
      u32x2 out;
      out.x = pack2(O[mt][4 * gg] * inv * silu_f(bflo(zz.x)), O[mt][4 * gg + 1] * inv * silu_f(bfhi(zz.x)));
      out.y = pack2(O[mt][4 * gg + 2] * inv * silu_f(bflo(zz.y)), O[mt][4 * gg + 3] * inv * silu_f(bfhi(zz.y)));
      if (!dry) *(u32x2*)(op + mt * 32 + 8 * gg) = out;
    }
}

template <int KSU>
DI void gemm_gate3(const u16* __restrict__ A, const u16* __restrict__ WM, char* smem, f32x16 (&acc)[3][2]) {
  u16* As0 = (u16*)smem;
  u16* As1 = As0 + 128 * LDT;
  u16* Bs0 = As0 + 2 * 128 * LDT;
  u16* Bs1 = Bs0 + 384 * LDT;
  const int tid = my_tid(), lane = tid & 63, wid = tid >> 6, r = lane & 31, h = lane >> 5, wm = wid & 3, wn = wid >> 2;
  u32x4 ra0[2], rb0[6], ra1[2], rb1[6];
  auto fetch = [&](u32x4 (&ra)[2], u32x4 (&rb)[6], int k0) {
#pragma unroll
    for (int i = 0; i < 2; ++i) { const int q = tid + NT * i; const unsigned off = (unsigned)((q >> 3) * 1024 + (q & 7) * 8); ra[i] = *(const u32x4*)(A + off + k0); }
#pragma unroll
    for (int i = 0; i < 6; ++i) {
      const int q = tid + NT * i, row = q >> 3;
      const unsigned off = (unsigned)((row >> 7) * (1024 * 1024) + (row & 127) * 1024 + (q & 7) * 8);
      rb[i] = *(const u32x4*)(WM + off + k0);
    }
    GFENCE;
  };
  auto commit = [&](const u32x4 (&ra)[2], const u32x4 (&rb)[6], u16* As, u16* Bs) {
#pragma unroll
    for (int i = 0; i < 2; ++i) { const int q = tid + NT * i; *(u32x4*)(As + (q >> 3) * LDT + (q & 7) * 8) = ra[i]; }
#pragma unroll
    for (int i = 0; i < 6; ++i) { const int q = tid + NT * i; *(u32x4*)(Bs + (q >> 3) * LDT + (q & 7) * 8) = rb[i]; }
    GFENCE;
  };
  auto compute = [&](const u16* Ac, const u16* Bc) {
#pragma unroll KSU
    for (int ks = 0; ks < 4; ++ks) {
      const bf16x8 a = *(const bf16x8*)(Ac + (wm * 32 + r) * LDT + ks * 16 + h * 8);
#pragma unroll
      for (int br = 0; br < 3; ++br)
#pragma unroll
        for (int j = 0; j < 2; ++j)
          acc[br][j] = MFMA(a, *(const bf16x8*)(Bc + (br * 128 + wn * 64 + j * 32 + r) * LDT + ks * 16 + h * 8), acc[br][j]);
    }
  };
  constexpr int KT = 16;
  fetch(ra0, rb0, 0);
  fetch(ra1, rb1, 64);
  __syncthreads();
  commit(ra0, rb0, As0, Bs0);
  __syncthreads();
  fetch(ra0, rb0, 128);
#pragma unroll
  for (int kt = 0; kt < KT; kt += 2) {
    commit(ra1, rb1, As1, Bs1);
    if (kt + 3 < KT) fetch(ra1, rb1, (kt + 3) * 64);
    compute(As0, Bs0);
    __syncthreads();
    if (kt + 2 < KT) commit(ra0, rb0, As0, Bs0);
    if (kt + 4 < KT) fetch(ra0, rb0, (kt + 4) * 64);
    compute(As1, Bs1);
    __syncthreads();
  }
}
DI void phase_merge(const Params& p, int l, char* smem) {
  const int tid = my_tid(), lane = tid & 63, wid = tid >> 6, r = lane & 31, h = lane >> 5, wm = wid & 3, wn = wid >> 2;
  const int xcd = blockIdx.x & 7, nloc = gridDim.x >> 3;
  for (int q = blockIdx.x >> 3; q < 33 * 8; q += nloc) {
    const int mt = (q >> 3) * 8 + xcd, nt = q & 7, m0 = mt * 128, n0 = nt * 128;
    if (mt >= 260) continue;
    const int b = m0 / TB, tk0 = m0 - b * TB;
    if (l == 1 && tk0 < LC) continue;
    const u16* H = (const u16*)(p.ws + OFF_H) + (size_t)m0 * 1024;
    const u16* WM = (const u16*)(p.ws + OFF_WT + (size_t)l * WT_LAYER) + (size_t)(4896 + n0) * 1024;
    const u16* WBR = (const u16*)(p.ws + OFF_WT + (size_t)l * WT_LAYER + WT_IN) + (size_t)n0 * 512;
    unsigned gp[3][2][8];
    {
      f32x16 g3[3][2];
#pragma unroll
      for (int br = 0; br < 3; ++br) for (int j = 0; j < 2; ++j) g3[br][j] = zero16();
      gemm_gate3<2>(H, WM, smem, g3);
#pragma unroll
      for (int br = 0; br < 3; ++br)
#pragma unroll
        for (int j = 0; j < 2; ++j)
#pragma unroll
          for (int i = 0; i < 8; ++i)
            gp[br][j][i] = pack2(1.f / (1.f + __expf(-g3[br][j][2 * i])), 1.f / (1.f + __expf(-g3[br][j][2 * i + 1])));
    }
    f32x16 ysum[2] = {zero16(), zero16()};
#pragma unroll
    for (int br = 0; br < 3; ++br) {
      f32x16 ab[1][2] = {{zero16(), zero16()}};
      if (br < 2) {
        ALoadN ay{(const u16*)(p.ws + OFF_P) + (size_t)m0 * NP + (br == 0 ? PC_GZ : PC_AQ), NP};
        gemm_tile<128, ALoadN, 4, 512>(ay, WBR + (size_t)br * 1024 * 512, 512, smem, ab);
      } else {
        ALoadT ay{(const u16*)(p.ws + OFF_CT) + ((size_t)CH_YZ * 2 + b) * TB + tk0, (size_t)2 * TB};
        gemm_tile<128, ALoadT, 4, 512>(ay, WBR + (size_t)2 * 1024 * 512, 512, smem, ab);
      }
#pragma unroll
      for (int j = 0; j < 2; ++j)
#pragma unroll
        for (int i = 0; i < 8; ++i) {
          ysum[j][2 * i] += bflo(gp[br][j][i]) * ab[0][j][2 * i];
          ysum[j][2 * i + 1] += bfhi(gp[br][j][i]) * ab[0][j][2 * i + 1];
        }
    }
    u16* Y = (u16*)(p.ws + OFF_Y) + (size_t)(m0 + wm * 32 + 4 * h) * 1024 + n0 + wn * 64 + r;
#pragma unroll
    for (int j = 0; j < 2; ++j)
#pragma unroll
      for (int reg = 0; reg < 16; ++reg) Y[(size_t)((reg & 3) + 8 * (reg >> 2)) * 1024 + j * 32] = f2bf(ysum[j][reg]);
  }
}

DI void phase_out(const Params& p, int l, char* smem) {
  const int tid = my_tid(), lane = tid & 63, wid = tid >> 6, r = lane & 31, h = lane >> 5, wm = wid & 3, wn = wid >> 2;
  const u16* Yb = (const u16*)(p.ws + OFF_Y);
  const u16* WO = (const u16*)(p.ws + OFF_WT + (size_t)l * WT_LAYER + WT_IN + 3 * WT_BR);
  const float* mod = (const float*)(p.ws + OFF_MOD);
  const int xcd = blockIdx.x & 7, nloc = gridDim.x >> 3;
  auto tile_of = [&](int q, int& m0, int& n0) -> bool {
    const int mt = (q >> 3) * 8 + xcd; m0 = mt * 128; n0 = (q & 7) * 128;
    if (mt >= 260) return false;
    const int b = m0 / TB, tk0 = m0 - b * TB;
    return !(l == 1 && tk0 < LC);
  };
  auto next_q = [&](int q) -> int { int m, n; for (q += nloc; q < 33 * 8; q += nloc) if (tile_of(q, m, n)) return q; return -1; };
  int q = (int)(blockIdx.x >> 3) - nloc; q = next_q(q);
  if (q < 0) return;
  int m0, n0; tile_of(q, m0, n0);
  GemmRegs<128> gr;
  { ALoadN ay{Yb + (size_t)m0 * 1024, 1024}; gemm_prime<128>(gr, ay, WO + (size_t)n0 * 1024, 1024, smem); }
  while (true) {
    const int qn = next_q(q);
    int m0n = 0, n0n = 0; if (qn >= 0) tile_of(qn, m0n, n0n);
    const int b = m0 / TB, tk0 = m0 - b * TB;
    f32x16 acc[1][2] = {{zero16(), zero16()}};
    const ALoadN ay{Yb + (size_t)m0 * 1024, 1024}, ayn{Yb + (size_t)m0n * 1024, 1024};
    gemm_run<128, ALoadN, 4, 1024, ALoadN>(gr, ay, WO + (size_t)n0 * 1024, 1024, ayn, WO + (size_t)n0n * 1024, 1024, qn >= 0, smem, acc);
    const float* gv = mod + (l * 3 + (tk0 < LC ? 2 : b)) * 3072 + 2048;
    const float* xin = xrow_in(p, l, m0);
    float* xout = xrow_out(p, m0);
#pragma unroll
    for (int j = 0; j < 2; ++j) {
      const int col = n0 + wn * 64 + j * 32 + r;
      const float gate = gv[col];
#pragma unroll
      for (int reg = 0; reg < 16; ++reg) {
        const size_t off = (size_t)(wm * 32 + crow(reg, h)) * D + col;
        xout[off] = xin[off] + gate * acc[0][j][reg];
      }
    }
    if (qn < 0) break;
    q = qn; m0 = m0n; n0 = n0n;
  }
}

DI void phase_final(const Params& p) {
  const int tid = my_tid(), lane = tid & 63, wid = tid >> 6;
  for (int row = blockIdx.x * 8 + wid; row < NBATCH * L; row += gridDim.x * 8) {
    float* src = p.out + (size_t)row * D;
    float4 xv[4]; float ss = 0.f;
#pragma unroll
    for (int i = 0; i < 4; ++i) { xv[i] = *(const float4*)(src + (i * 64 + lane) * 4); ss += xv[i].x * xv[i].x + xv[i].y * xv[i].y + xv[i].z * xv[i].z + xv[i].w * xv[i].w; }
    ss = wave_sum(ss);
    const float rs = rsqrtf(ss * (1.f / 1024.f) + EPS);
#pragma unroll
    for (int i = 0; i < 4; ++i) {
      const int col = (i * 64 + lane) * 4;
      const float4 fw = *(const float4*)(pk(p, PK_FN) + col);
      *(float4*)(src + col) = make_float4(xv[i].x * rs * fw.x, xv[i].y * rs * fw.y, xv[i].z * rs * fw.z, xv[i].w * rs * fw.w);
    }
  }
}

DI void run_phase(const Params& p, int ph, char* smem, int dry = 0) {
  const int bid = blockIdx.x, nb = gridDim.x;
  if (ph == 0) { phase0(p, smem); return; }
  if (ph == 17) { phase_final(p); return; }
  const int l = (ph - 1) >> 3, s = (ph - 1) & 7;
  switch (s) {
    case 0: phase_norm(p, l); break;
    case 1: phase_proj(p, l, smem); break;
    case 2: {
      attn_prep(p, l, dry);
      if (l == 0) for (int c = bid; c < 512; c += nb) hyena_ctx_task(p, l, c, smem, dry);
      for (int c = bid; c < 512; c += nb) hyena_latent_task(p, l, c, smem, dry);
    } break;
    case 3: for (int t = bid; t < 16 * NCK; t += nb) gla_g1_task(p, l, t / NCK, t % NCK, smem); break;
    case 4: gla_g2(p, dry); break;
    case 5: {
      for (int it = bid; it < 1024; it += nb) { const int b = it >> 9, g = (it >> 8) & 1, qb = it & 255; attn_item(p, l, b, g, LC + qb * 64, NCK, smem, dry); }
      if (l == 0) for (int it = bid; it < 16; it += nb) { const int b = it >> 3, g = (it >> 2) & 1, qb = it & 3; attn_item(p, l, b, g, qb * 64, 4, smem, dry); }
      const int c0 = (l == 0) ? 0 : 4, per = NCK - c0;
      for (int t = bid; t < 8 * per; t += nb) { const int bh = t / per, ci = c0 + t % per; gla_g3_task(p, l, bh >> 2, bh & 3, ci, smem, dry); }
    } break;
    case 6: phase_merge(p, l, smem); break;
    case 7: phase_out(p, l, smem); break;
  }
}

#if MULTI_LAUNCH
template <int PH> __global__ void __launch_bounds__(NT) phase_kernel(Params p) {
  extern __shared__ __attribute__((aligned(16))) char smem[];
  run_phase(p, PH, smem);
}
template <int PH> static void launch_phase(const Params& p, int grid, hipStream_t stream) {
  static bool attr = false;
  if (!attr) { (void)hipFuncSetAttribute((const void*)phase_kernel<PH>, hipFuncAttributeMaxDynamicSharedMemorySize, LDS_BYTES); attr = true; }
  hipLaunchKernelGGL(phase_kernel<PH>, dim3(grid), dim3(NT), LDS_BYTES, stream, p);
}
#else
#ifndef PROBE_DUP
#define PROBE_DUP -1
#endif
#ifndef PROBE_DUP2
#define PROBE_DUP2 -1
#endif
#ifndef PROBE_DUP3
#define PROBE_DUP3 -1
#endif
__global__ void __launch_bounds__(NT) fwd_kernel(Params p) {
  extern __shared__ __attribute__((aligned(16))) char smem[];
  cg::grid_group grid = cg::this_grid();
#if PROBE_DUP >= 0
#define PHS(n) if ((n) == PROBE_DUP || (n) == PROBE_DUP2 || (n) == PROBE_DUP3) { run_phase(p, n, smem, p.phase_lo == 0 ? 1 : 0); grid.sync(); } run_phase(p, n, smem); grid.sync();
#else
#define PHS(n) run_phase(p, n, smem); grid.sync();
#endif
  PHS(0) PHS(1) PHS(2) PHS(3) PHS(4) PHS(5) PHS(6) PHS(7) PHS(8)
  PHS(9) PHS(10) PHS(11) PHS(12) PHS(13) PHS(14) PHS(15) PHS(16)
  run_phase(p, 17, smem);
}
#endif

extern "C" void kernel_launch(void* const* d_in, const int* in_sizes, int n_in, void* d_out, int out_size, void* d_ws, size_t ws_size,
                              hipStream_t stream) {
  static int grid = 0;
  if (grid == 0) {
    if (n_in != 29 || ws_size < WS_END) { fprintf(stderr, "kernel_launch: need 29 inputs and %zu B of workspace, got %d / %zu\n", (size_t)WS_END, n_in, ws_size); grid = -1; return; }
#if MULTI_LAUNCH
    grid = 256;
#else
    int dev = 0, cus = 0, per_cu = 0;
    (void)hipGetDevice(&dev);
    (void)hipDeviceGetAttribute(&cus, hipDeviceAttributeMultiprocessorCount, dev);
    if (hipFuncSetAttribute((const void*)fwd_kernel, hipFuncAttributeMaxDynamicSharedMemorySize, LDS_BYTES) != hipSuccess) { fprintf(stderr, "kernel_launch: hipFuncSetAttribute failed\n"); grid = -1; return; }
    (void)hipOccupancyMaxActiveBlocksPerMultiprocessor(&per_cu, (const void*)fwd_kernel, NT, LDS_BYTES);
    if (per_cu < 1) { fprintf(stderr, "kernel_launch: occupancy query returned %d\n", per_cu); per_cu = 1; }
    (void)hipGetLastError();
    grid = cus * per_cu;
    if (grid > 256) grid = 256;
#endif
  }
  if (grid < 0) return;
  Params p{};
  const float** pp = (const float**)&p;
  for (int i = 0; i < 29; ++i) pp[i] = (const float*)d_in[i];
  p.out = (float*)d_out; p.ws = (char*)d_ws;
  p.phase_lo = 0; p.phase_hi = 18;
#if MULTI_LAUNCH
  launch_phase<0>(p, grid, stream); launch_phase<1>(p, grid, stream); launch_phase<2>(p, grid, stream); launch_phase<3>(p, grid, stream);
  launch_phase<4>(p, grid, stream); launch_phase<5>(p, grid, stream); launch_phase<6>(p, grid, stream); launch_phase<7>(p, grid, stream);
  launch_phase<8>(p, grid, stream); launch_phase<9>(p, grid, stream); launch_phase<10>(p, grid, stream); launch_phase<11>(p, grid, stream);
  launch_phase<12>(p, grid, stream); launch_phase<13>(p, grid, stream); launch_phase<14>(p, grid, stream); launch_phase<15>(p, grid, stream);
  launch_phase<16>(p, grid, stream); launch_phase<17>(p, grid, stream);
#else
  void* args[] = {&p};
  hipError_t e = hipLaunchCooperativeKernel((const void*)fwd_kernel, dim3(grid), dim3(NT), args, LDS_BYTES, stream);
  if (e != hipSuccess) fprintf(stderr, "kernel_launch: cooperative launch failed: %s (grid %d)\n", hipGetErrorString(e), grid);
#endif
}
```

```cpp
#include <hip/hip_runtime.h>
#include <hip/hip_cooperative_groups.h>
#include <cstdio>
namespace cg = cooperative_groups;

typedef unsigned short u16;
typedef __attribute__((ext_vector_type(8))) short bf16x8;
typedef __attribute__((ext_vector_type(16))) float f32x16;
typedef __attribute__((ext_vector_type(4))) unsigned u32x4;
typedef __attribute__((ext_vector_type(2))) unsigned u32x2;
#define DI __device__ __forceinline__
#define MFMA(a, b, c) __builtin_amdgcn_mfma_f32_32x32x16_bf16((a), (b), (c), 0, 0, 0)

#ifndef MULTI_LAUNCH
#define MULTI_LAUNCH 0
#endif

constexpr int D = 1024, NBATCH = 2, L = 16384, LC = 256, TB = L + LC, R = NBATCH * TB;
constexpr int NIN = 7968;
constexpr int NP = 2208;
constexpr int NCH = 2688;
constexpr int PC_GQ = 0, PC_GK = 256, PC_GZ = 512, PC_AF = 1024, PC_AQ = 1056, PC_AK = 1568, PC_AZ = 1696;
constexpr int CH_YU = 0, CH_YZ = 1536, CH_GV = 2048, CH_AV = 2560;
constexpr int NCK = 260;
constexpr float EPS = 1e-6f;
constexpr int NT = 512;
constexpr int LDT = 72;

constexpr size_t OFF_P = 0;
constexpr size_t OFF_CT = OFF_P + (size_t)R * NP * 2;
constexpr size_t OFF_H = OFF_CT + (size_t)NCH * 2 * TB * 2;
constexpr size_t OFF_FS = OFF_H + (size_t)R * 1024 * 2;
constexpr size_t OFF_WT = OFF_FS + (size_t)256 * 262144;
constexpr size_t WT_IN = (size_t)NIN * 1024 * 2, WT_BR = (size_t)1024 * 512 * 2, WT_OUT = (size_t)1024 * 1024 * 2;
constexpr size_t WT_LAYER = WT_IN + 3 * WT_BR + WT_OUT;
constexpr size_t OFF_H2T = OFF_WT + 2 * WT_LAYER;
constexpr size_t OFF_H2C = OFF_H2T + (size_t)2 * 64 * L * 4;
constexpr size_t OFF_MOD = OFF_H2C + (size_t)2 * 256 * 64 * 4;
constexpr size_t OFF_CTX1 = OFF_MOD + (size_t)2 * 3 * 3072 * 4;
constexpr size_t OFF_GD = OFF_CTX1 + (size_t)512 * 1024 * 4;
constexpr size_t OFF_PK = OFF_GD + (size_t)16 * NCK * 64 * 4;
constexpr int PK_WAF = 0, PK_BAF = 8192, PK_WAB = 8704, PK_BAB = 16896, PK_GN = 17408, PK_QN = 17664, PK_KN = 17792, PK_CW = 17920,
              PK_CB = 27136, PK_SK = 30208, PK_FN = 32256, PK_F3 = 33280, PK_END = 33280 + 262144;
constexpr size_t WS_END = OFF_PK + (size_t)PK_END * 4;
constexpr size_t OFF_GS = OFF_CT;
constexpr size_t OFF_Y = OFF_CT;
static_assert((size_t)16 * NCK * 8192 * 2 <= (size_t)1536 * 2 * TB * 2, "alias");
static_assert((size_t)R * 1024 * 2 <= (size_t)1536 * 2 * TB * 2, "alias");

constexpr int LDS_BYTES = 2 * (128 + 384) * 72 * 2 + 512;

struct Params {
  const float *x, *c, *ctx, *c_ctx, *w_ada, *b_ada, *w_in, *wa_f, *ba_f, *wa_b, *ba_b, *gla_norm, *qnorm, *knorm,
      *conv_w, *conv_b, *f1_w, *f1_b, *f1_freq, *f2_w, *f2_b, *f2_freq, *f3_w, *skip, *w_g, *w_a, *w_h, *w_o, *final_norm;
  float* out;
  char* ws;
  long long phase_lo, phase_hi;
};

typedef __attribute__((ext_vector_type(2))) float f32x2v;
typedef __attribute__((ext_vector_type(2))) __bf16 bf16x2v;
DI int my_tid() {
  int t = (int)threadIdx.x;
  asm volatile("" : "+v"(t));
  __builtin_assume(t >= 0 && t < NT);
  return t;
}
DI u16 f2bf(float x) { return __builtin_bit_cast(u16, (__bf16)x); }
DI float bf2f(u16 v) { return __uint_as_float(((unsigned)v) << 16); }
DI unsigned pack2(float a, float b) { f32x2v v = {a, b}; return __builtin_bit_cast(unsigned, __builtin_convertvector(v, bf16x2v)); }
DI float bflo(unsigned u) { return __uint_as_float(u << 16); }
DI float bfhi(unsigned u) { return __uint_as_float(u & 0xffff0000u); }
DI float silu_f(float x) { return x / (1.f + __expf(-x)); }
DI float wave_sum(float v) {
#pragma unroll
  for (int o = 32; o >= 1; o >>= 1) v += __shfl_xor(v, o);
  return v;
}
DI int crow(int reg, int h) { return (reg & 3) + 8 * (reg >> 2) + 4 * h; }
DI f32x16 zero16() { f32x16 z; for (int i = 0; i < 16; ++i) z[i] = 0.f; return z; }
DI bf16x8 pack8(const f32x16& x, int s) {
  u32x4 u;
  u.x = pack2(x[8 * s + 0], x[8 * s + 1]); u.y = pack2(x[8 * s + 2], x[8 * s + 3]);
  u.z = pack2(x[8 * s + 4], x[8 * s + 5]); u.w = pack2(x[8 * s + 6], x[8 * s + 7]);
  return __builtin_bit_cast(bf16x8, u);
}
DI bf16x8 ld2x64(const u16* p0, const u16* p1) {
  u32x2 a = *(const u32x2*)p0, b = *(const u32x2*)p1;
  u32x4 u; u.x = a.x; u.y = a.y; u.z = b.x; u.w = b.y;
  return __builtin_bit_cast(bf16x8, u);
}
DI float2 cmul(float2 a, float2 b) { return make_float2(a.x * b.x - a.y * b.y, a.x * b.y + a.y * b.x); }
DI float2 cadd(float2 a, float2 b) { return make_float2(a.x + b.x, a.y + b.y); }
DI float2 csub(float2 a, float2 b) { return make_float2(a.x - b.x, a.y - b.y); }

DI const float* xrow_in(const Params& p, int layer, int row) {
  int b = row / TB, tk = row - b * TB;
  if (tk < LC) return (layer == 0 ? p.ctx : (const float*)(p.ws + OFF_CTX1)) + (size_t)(b * LC + tk) * D;
  return (layer == 0 ? p.x : (const float*)p.out) + (size_t)(b * L + tk - LC) * D;
}
DI float* xrow_out(const Params& p, int row) {
  int b = row / TB, tk = row - b * TB;
  if (tk < LC) return (float*)(p.ws + OFF_CTX1) + (size_t)(b * LC + tk) * D;
  return p.out + (size_t)(b * L + tk - LC) * D;
}
DI const float* pk(const Params& p, int off) { return (const float*)(p.ws + OFF_PK) + off; }
DI int modvec_of(int row) { int b = row / TB, tk = row - b * TB; return tk < LC ? 2 : b; }

struct ALoadN {
  const u16* A; int lda;
  template <int BM> DI void fetch(u32x4 (&r)[BM / 64], int k0, int tid) const {
#pragma unroll
    for (int i = 0; i < BM / 64; ++i) { const int q = tid + NT * i; const unsigned off = (unsigned)((q >> 3) * lda + (q & 7) * 8); r[i] = *(const u32x4*)(A + off + k0); }
  }
  template <int BM> DI void commit(const u32x4 (&r)[BM / 64], u16* As, int tid) const {
#pragma unroll
    for (int i = 0; i < BM / 64; ++i) { int q = tid + NT * i; *(u32x4*)(As + (q >> 3) * LDT + (q & 7) * 8) = r[i]; }
  }
};
struct ALoadT {
  const u16* A; size_t chs;
  template <int BM> DI void fetch(u32x4 (&r)[BM / 64], int k0, int tid) const {
#pragma unroll
    for (int i = 0; i < 2; ++i) { const int q = tid + NT * i; const unsigned off = (unsigned)((q >> 4) * (int)chs + (q & 15) * 8); r[i] = *(const u32x4*)(A + off + (unsigned)(k0 * (int)chs)); }
  }
  template <int BM> DI void commit(const u32x4 (&r)[BM / 64], u16* As, int tid) const {
#pragma unroll
    for (int i = 0; i < 2; ++i) {
      int q = tid + NT * i; int ch = q >> 4, t0 = (q & 15) * 8;
      unsigned w[4] = {r[i].x, r[i].y, r[i].z, r[i].w};
#pragma unroll
      for (int e = 0; e < 4; ++e) { As[(t0 + 2 * e) * LDT + ch] = (u16)(w[e] & 0xffffu); As[(t0 + 2 * e + 1) * LDT + ch] = (u16)(w[e] >> 16); }
    }
  }
};

template <int BM, int KSU>
DI void gemm_compute(const u16* Ac, const u16* Bc, int wm, int wn, int r, int h, f32x16 (&acc)[BM / 128][2]) {
#pragma unroll KSU
  for (int ks = 0; ks < 4; ++ks) {
    bf16x8 a[BM / 128], b[2];
#pragma unroll
    for (int i = 0; i < BM / 128; ++i) a[i] = *(const bf16x8*)(Ac + (wm * (BM / 4) + i * 32 + r) * LDT + ks * 16 + h * 8);
#pragma unroll
    for (int j = 0; j < 2; ++j) b[j] = *(const bf16x8*)(Bc + (wn * 64 + j * 32 + r) * LDT + ks * 16 + h * 8);
#pragma unroll
    for (int i = 0; i < BM / 128; ++i)
#pragma unroll
      for (int j = 0; j < 2; ++j) acc[i][j] = MFMA(a[i], b[j], acc[i][j]);
  }
}
DI void fetch_b(u32x4 (&rb)[2], const u16* Bt, int ldb, int k0, int tid) {
#pragma unroll
  for (int i = 0; i < 2; ++i) { const int q = tid + NT * i; const unsigned off = (unsigned)((q >> 3) * ldb + (q & 7) * 8); rb[i] = *(const u32x4*)(Bt + off + k0); }
}
DI void commit_b(const u32x4 (&rb)[2], u16* Bs, int tid) {
#pragma unroll
  for (int i = 0; i < 2; ++i) { int q = tid + NT * i; *(u32x4*)(Bs + (q >> 3) * LDT + (q & 7) * 8) = rb[i]; }
}
template <int BM> struct GemmRegs { u32x4 ra0[BM / 64], rb0[2], ra1[BM / 64], rb1[2]; };
#define GFENCE asm volatile("" ::: "memory")
template <int BM, class AL>
DI void gemm_prime(GemmRegs<BM>& g, const AL& al, const u16* __restrict__ Bt, int ldb, char* smem) {
  u16* As0 = (u16*)smem;
  u16* Bs0 = As0 + 2 * BM * LDT;
  const int tid = my_tid();
  al.template fetch<BM>(g.ra0, 0, tid); fetch_b(g.rb0, Bt, ldb, 0, tid); GFENCE;
  al.template fetch<BM>(g.ra1, 64, tid); fetch_b(g.rb1, Bt, ldb, 64, tid); GFENCE;
  __syncthreads();
  al.template commit<BM>(g.ra0, As0, tid); commit_b(g.rb0, Bs0, tid);
  __syncthreads();
  al.template fetch<BM>(g.ra0, 128, tid); fetch_b(g.rb0, Bt, ldb, 128, tid); GFENCE;
}
template <int BM, class AL, int KSU, int K, class ALN>
DI void gemm_run(GemmRegs<BM>& g, const AL& al, const u16* __restrict__ Bt, int ldb, const ALN& aln, const u16* __restrict__ Btn, int ldbn,
                 bool hasnext, char* smem, f32x16 (&acc)[BM / 128][2]) {
  u16* As0 = (u16*)smem;
  u16* As1 = As0 + BM * LDT;
  u16* Bs0 = As0 + 2 * BM * LDT;
  u16* Bs1 = Bs0 + 128 * LDT;
  const int tid = my_tid(), lane = tid & 63, wid = tid >> 6, r = lane & 31, h = lane >> 5;
  const int wm = wid & 3, wn = wid >> 2;
  constexpr int KT = K >> 6;
#pragma unroll
  for (int kt = 0; kt < KT; kt += 2) {
    al.template commit<BM>(g.ra1, As1, tid); commit_b(g.rb1, Bs1, tid);
    GFENCE;
    if (kt + 3 < KT) { al.template fetch<BM>(g.ra1, (kt + 3) * 64, tid); fetch_b(g.rb1, Bt, ldb, (kt + 3) * 64, tid); GFENCE; }
    else if (hasnext) { aln.template fetch<BM>(g.ra1, (kt + 3 - KT) * 64, tid); fetch_b(g.rb1, Btn, ldbn, (kt + 3 - KT) * 64, tid); GFENCE; }
    gemm_compute<BM, KSU>(As0, Bs0, wm, wn, r, h, acc);
    __syncthreads();
    if (kt + 2 < KT) { al.template commit<BM>(g.ra0, As0, tid); commit_b(g.rb0, Bs0, tid); GFENCE; }
    else if (hasnext) { aln.template commit<BM>(g.ra0, As0, tid); commit_b(g.rb0, Bs0, tid); GFENCE; }
    if (kt + 4 < KT) { al.template fetch<BM>(g.ra0, (kt + 4) * 64, tid); fetch_b(g.rb0, Bt, ldb, (kt + 4) * 64, tid); GFENCE; }
    else if (hasnext) { aln.template fetch<BM>(g.ra0, (kt + 4 - KT) * 64, tid); fetch_b(g.rb0, Btn, ldbn, (kt + 4 - KT) * 64, tid); GFENCE; }
    gemm_compute<BM, KSU>(As1, Bs1, wm, wn, r, h, acc);
    __syncthreads();
  }
}

template <int BM, class AL, int KSU = 4, int K = 1024>
DI void gemm_tile(const AL& al, const u16* __restrict__ Bt, int ldb, char* smem, f32x16 (&acc)[BM / 128][2]) {
  GemmRegs<BM> g;
  gemm_prime<BM>(g, al, Bt, ldb, smem);
  gemm_run<BM, AL, KSU, K, AL>(g, al, Bt, ldb, al, Bt, ldb, false, smem, acc);
}

DI void phase0(const Params& p, char* smem) {
  const int tid = my_tid(), lane = tid & 63, wid = tid >> 6, bid = blockIdx.x, nb = gridDim.x;
  float* sm = (float*)smem;
  {
    float* PKW = (float*)(p.ws + OFF_PK);
    const int gt = bid * NT + tid, gn = nb * NT;
#define PKCP(src, off, cnt) for (int i = gt; i < (cnt); i += gn) PKW[(off) + i] = (src)[i];
    PKCP(p.wa_f, PK_WAF, 8192) PKCP(p.ba_f, PK_BAF, 512) PKCP(p.wa_b, PK_WAB, 8192) PKCP(p.ba_b, PK_BAB, 512)
    PKCP(p.gla_norm, PK_GN, 256) PKCP(p.qnorm, PK_QN, 128) PKCP(p.knorm, PK_KN, 128) PKCP(p.conv_w, PK_CW, 9216)
    PKCP(p.conv_b, PK_CB, 3072) PKCP(p.skip, PK_SK, 2048) PKCP(p.final_norm, PK_FN, 1024) PKCP(p.f3_w, PK_F3, 262144)
#undef PKCP
  }
  float* mod = (float*)(p.ws + OFF_MOD);
  for (int task = bid; task < 96; task += nb) {
    const int l = task / 48, cb = task % 48, col = cb * 64 + lane;
    const float* W = p.w_ada + (size_t)l * 1024 * 3072;
    float a0 = 0.f, a1 = 0.f, a2 = 0.f;
#pragma unroll 8
    for (int k = wid * 128; k < wid * 128 + 128; ++k) {
      float wv = W[(size_t)k * 3072 + col];
      a0 += silu_f(p.c[k]) * wv; a1 += silu_f(p.c[1024 + k]) * wv; a2 += silu_f(p.c_ctx[k]) * wv;
    }
    __syncthreads();
    sm[(wid * 3 + 0) * 64 + lane] = a0; sm[(wid * 3 + 1) * 64 + lane] = a1; sm[(wid * 3 + 2) * 64 + lane] = a2;
    __syncthreads();
    if (tid < 192) {
      int v = tid >> 6; float s = p.b_ada[l * 3072 + col];
      for (int w = 0; w < 8; ++w) s += sm[(w * 3 + v) * 64 + lane];
      mod[(l * 3 + v) * 3072 + col] = s;
    }
    __syncthreads();
  }
  for (int it = bid; it < (2 * TB) / 8; it += nb) {
    const int gr = it * 8 + wid, l = gr / TB, rr = gr - l * TB;
    const bool lat = rr < L; const int t = lat ? rr : rr - L; const int Lq = lat ? L : LC;
    float* em = sm + wid * 104; float* h1 = em + 40;
    __syncthreads();
    if (lane < 33) {
      float v;
      if (lane == 0) v = (float)t / (float)(Lq - 1);
      else {
        int bi = (lane - 1) & 15; float fr = 1e-4f + (float)bi * ((15.f - 1e-4f) / 15.f);
        float w = 6.283185307179586f * (float)t / (float)Lq;
        v = (lane <= 16) ? cosf(fr * w) : -sinf(fr * w);
      }
      em[lane] = v;
    }
    __syncthreads();
    {
      float a = p.f1_b[l * 64 + lane];
      for (int e = 0; e < 33; ++e) a += em[e] * p.f1_w[(l * 33 + e) * 64 + lane];
      h1[lane] = sinf(p.f1_freq[l * 64 + lane] * a);
    }
    __syncthreads();
    {
      float a = p.f2_b[l * 64 + lane];
      for (int i = 0; i < 64; ++i) a += h1[i] * p.f2_w[(l * 64 + i) * 64 + lane];
      float v = sinf(p.f2_freq[l * 64 + lane] * a);
      if (lat) ((u16*)(p.ws + OFF_H2T))[((size_t)l * 64 + lane) * L + t] = f2bf(v);
      else ((float*)(p.ws + OFF_H2C))[((size_t)l * 256 + t) * 64 + lane] = v;
    }
  }
  __syncthreads();
  {
    constexpr int T_IN = 16 * 249, T_BR = 8 * 32, T_OUT = 16 * 32, T_LAYER = T_IN + 3 * T_BR + T_OUT;
    auto decode = [&](int task, const float*& src, u16*& dst, int& K, int& N, int& k0, int& n0) {
      const int l = task / T_LAYER; int tt = task - l * T_LAYER;
      char* wt = p.ws + OFF_WT + (size_t)l * WT_LAYER;
      int kt, ntile;
      if (tt < T_IN) { src = p.w_in + (size_t)l * 1024 * NIN; dst = (u16*)wt; K = 1024; N = NIN; kt = tt / 249; ntile = tt % 249; }
      else if (tt < T_IN + 3 * T_BR) {
        tt -= T_IN; const int br = tt / T_BR; tt -= br * T_BR;
        src = (br == 0 ? p.w_g : (br == 1 ? p.w_a : p.w_h)) + (size_t)l * 512 * 1024; dst = (u16*)(wt + WT_IN + br * WT_BR);
        K = 512; N = 1024; kt = tt / 32; ntile = tt % 32;
      } else { tt -= T_IN + 3 * T_BR; src = p.w_o + (size_t)l * 1024 * 1024; dst = (u16*)(wt + WT_IN + 3 * WT_BR); K = 1024; N = 1024; kt = tt / 32; ntile = tt % 32; }
      k0 = kt * 64; n0 = ntile * 32;
    };
    float* tileA = sm;
    float* tileB = sm + 64 * 33;
    for (int task = bid; task < 2 * T_LAYER; task += 2 * nb) {
      const bool hasB = task + nb < 2 * T_LAYER;
      const float *sa, *sb = nullptr; u16 *da, *db = nullptr; int Ka, Na, k0a, n0a, Kb = 0, Nb = 0, k0b = 0, n0b = 0;
      decode(task, sa, da, Ka, Na, k0a, n0a);
      if (hasB) decode(task + nb, sb, db, Kb, Nb, k0b, n0b);
      float va[4], vb[4];
#pragma unroll
      for (int i = 0; i < 4; ++i) { const int kk = (tid >> 5) + 16 * i, nn = tid & 31; va[i] = sa[(size_t)(k0a + kk) * Na + n0a + nn]; vb[i] = hasB ? sb[(size_t)(k0b + kk) * Nb + n0b + nn] : 0.f; }
#pragma unroll
      for (int i = 0; i < 4; ++i) { const int kk = (tid >> 5) + 16 * i, nn = tid & 31; tileA[kk * 33 + nn] = va[i]; tileB[kk * 33 + nn] = vb[i]; }
      __syncthreads();
#pragma unroll
      for (int i = 0; i < 4; ++i) {
        const int nn = (tid >> 6) + 8 * i, kk = tid & 63;
        da[(size_t)(n0a + nn) * Ka + k0a + kk] = f2bf(tileA[kk * 33 + nn]);
        if (hasB) db[(size_t)(n0b + nn) * Kb + k0b + kk] = f2bf(tileB[kk * 33 + nn]);
      }
      __syncthreads();
    }
  }
}

DI void phase_norm(const Params& p, int l) {
  const int tid = my_tid(), lane = tid & 63, wid = tid >> 6;
  const float* mod = (const float*)(p.ws + OFF_MOD);
  u16* H = (u16*)(p.ws + OFF_H);
  for (int row = blockIdx.x * 8 + wid; row < R; row += gridDim.x * 8) {
    const float* src = xrow_in(p, l, row);
    const float* mv = mod + (l * 3 + modvec_of(row)) * 3072;
    float4 xv[4]; float ss = 0.f;
#pragma unroll
    for (int i = 0; i < 4; ++i) { xv[i] = *(const float4*)(src + (i * 64 + lane) * 4); ss += xv[i].x * xv[i].x + xv[i].y * xv[i].y + xv[i].z * xv[i].z + xv[i].w * xv[i].w; }
    ss = wave_sum(ss);
    const float rs = rsqrtf(ss * (1.f / 1024.f) + EPS);
#pragma unroll
    for (int i = 0; i < 4; ++i) {
      const int col = (i * 64 + lane) * 4;
      float4 sh = *(const float4*)(mv + col), sc = *(const float4*)(mv + 1024 + col);
      u32x2 o;
      o.x = pack2(xv[i].x * rs * (1.f + sc.x) + sh.x, xv[i].y * rs * (1.f + sc.y) + sh.y);
      o.y = pack2(xv[i].z * rs * (1.f + sc.z) + sh.z, xv[i].w * rs * (1.f + sc.w) + sh.w);
      *(u32x2*)(H + (size_t)row * 1024 + col) = o;
    }
  }
}

DI void phase_proj(const Params& p, int l, char* smem) {
  const int tid = my_tid(), lane = tid & 63, wid = tid >> 6, r = lane & 31, h = lane >> 5, wm = wid & 3, wn = wid >> 2;
  const u16* H = (const u16*)(p.ws + OFF_H);
  const u16* WT = (const u16*)(p.ws + OFF_WT + (size_t)l * WT_LAYER);
  u16* P = (u16*)(p.ws + OFF_P);
  u16* CT = (u16*)(p.ws + OFF_CT);
  u16* Tt = (u16*)smem;
  constexpr int LDE = 260;
  const int xcd = blockIdx.x & 7, nloc = gridDim.x >> 3;
  for (int q = blockIdx.x >> 3; q < 5 * 156; q += nloc) {
    const int g = q / 156, rem = q - g * 156, nt = rem >> 2, mt = (g * 4 + (rem & 3)) * 8 + xcd;
    if (mt >= 130) continue;
    const int m0 = mt * 256, n0 = nt * 128;
    f32x16 acc[2][2];
#pragma unroll
    for (int i = 0; i < 2; ++i) for (int j = 0; j < 2; ++j) acc[i][j] = zero16();
    ALoadN al{H + (size_t)m0 * 1024, 1024};
    gemm_tile<256, ALoadN, 4, 1024>(al, WT + (size_t)n0 * 1024, 1024, smem, acc);
    const int b = m0 / TB, tk0 = m0 - b * TB;
#pragma unroll
    for (int i = 0; i < 2; ++i)
#pragma unroll
      for (int j = 0; j < 2; ++j)
#pragma unroll
        for (int g4 = 0; g4 < 4; ++g4) {
          u32x2 o; o.x = pack2(acc[i][j][4 * g4], acc[i][j][4 * g4 + 1]); o.y = pack2(acc[i][j][4 * g4 + 2], acc[i][j][4 * g4 + 3]);
          *(u32x2*)(Tt + (wn * 64 + j * 32 + r) * LDE + wm * 64 + i * 32 + 8 * g4 + 4 * h) = o;
        }
    __syncthreads();
#pragma unroll 1
    for (int cg = 0; cg < 4; ++cg) {
      const int cb = n0 + cg * 32;
      if (cb >= 4896) continue;
      bool chan; int cm;
      if (cb < 512) { chan = false; cm = cb; }
      else if (cb < 1024) { chan = true; cm = CH_GV + cb - 512; }
      else if (cb < 2208) { chan = false; cm = cb - 512; }
      else if (cb < 2336) { chan = true; cm = CH_AV + cb - 2208; }
      else if (cb < 2848) { chan = false; cm = cb - 640; }
      else { chan = true; cm = cb - 2848; }
      if (chan) {
#pragma unroll
        for (int k = 0; k < 2; ++k) {
          const int idx = tid + NT * k, ch = idx >> 5, t8 = idx & 31;
          const u16* sp = Tt + (cg * 32 + ch) * LDE + t8 * 8;
          const u32x2 lo = *(const u32x2*)sp, hi = *(const u32x2*)(sp + 4);
          __builtin_nontemporal_store(u32x4{lo.x, lo.y, hi.x, hi.y}, (u32x4*)(CT + ((size_t)(cm + ch) * 2 + b) * TB + tk0 + t8 * 8));
        }
      } else {
#pragma unroll
        for (int k = 0; k < 2; ++k) {
          const int idx = tid + NT * k, row = idx >> 2, c8 = idx & 3;
          const u16* sp = Tt + (cg * 32 + c8 * 8) * LDE + row;
          u32x4 o;
          o.x = (unsigned)sp[0] | ((unsigned)sp[LDE] << 16); o.y = (unsigned)sp[2 * LDE] | ((unsigned)sp[3 * LDE] << 16);
          o.z = (unsigned)sp[4 * LDE] | ((unsigned)sp[5 * LDE] << 16); o.w = (unsigned)sp[6 * LDE] | ((unsigned)sp[7 * LDE] << 16);
          __builtin_nontemporal_store(o, (u32x4*)(P + (size_t)(m0 + row) * NP + cm + c8 * 8));
        }
      }
    }
  }
}

DI void attn_prep(const Params& p, int l, int dry) {
  const int tid = my_tid(), lane = tid & 63, wid = tid >> 6;
  u16* P = (u16*)(p.ws + OFF_P);
  const float gq = pk(p, PK_QN)[l * 64 + lane], gk = pk(p, PK_KN)[l * 64 + lane];
  for (int row = blockIdx.x * 8 + wid; row < R; row += gridDim.x * 8) {
    u16* Pr = P + (size_t)row * NP;
    const int b = row / TB, tk = row - b * TB;
    float cs = 1.f, sn = 0.f;
    if (tk >= LC) {
      const int t = tk - LC, pi = lane >> 1;
      const float pos = (pi < 16) ? (float)(t >> 6) : (float)(t & 63);
      const float inv = powf(10000.f, -(float)(2 * (pi & 15)) / 32.f);
      sincosf(pos * inv, &sn, &cs);
    }
#pragma unroll
    for (int hd = 0; hd < 10; ++hd) {
      const int col = (hd < 8) ? PC_AQ + hd * 64 + lane : PC_AK + (hd - 8) * 64 + lane;
      float v = bf2f(Pr[col]);
      const float ss = wave_sum(v * v);
      v = v * rsqrtf(ss * (1.f / 64.f) + EPS) * (hd < 8 ? gq : gk);
      const float pv = __shfl_xor(v, 1);
      float o = (lane & 1) ? (pv * sn + v * cs) : (v * cs - pv * sn);
      if (hd < 8) o *= 0.125f * 1.4426950408889634f;
      if (!dry) Pr[col] = f2bf(o);
    }
  }
}

DI void fft_pass4_fwd(float2* X, int tid, int h2) {
  const float inv4 = 0.25f / (float)h2;
#pragma unroll 2
  for (int i = 0; i < 8; ++i) {
    const int g = tid + NT * i, jp = g & (h2 - 1), base = ((g - jp) << 2) + jp;
    float2 e0 = X[base], e1 = X[base + h2], e2 = X[base + 2 * h2], e3 = X[base + 3 * h2];
    const float fr = (float)jp * inv4;
    const float2 T1 = make_float2(__builtin_amdgcn_cosf(fr), -__builtin_amdgcn_sinf(fr));
    const float2 T2 = cmul(T1, T1);
    float2 a0 = cadd(e0, e2), a2 = cmul(csub(e0, e2), T1);
    float2 a1 = cadd(e1, e3), d13 = cmul(csub(e1, e3), T1);
    float2 a3 = make_float2(d13.y, -d13.x);
    X[base] = cadd(a0, a1); X[base + h2] = cmul(csub(a0, a1), T2);
    X[base + 2 * h2] = cadd(a2, a3); X[base + 3 * h2] = cmul(csub(a2, a3), T2);
  }
  __syncthreads();
}
DI void fft_pass4_inv(float2* X, int tid, int h1) {
  const float inv4 = 0.25f / (float)h1;
#pragma unroll 2
  for (int i = 0; i < 8; ++i) {
    const int g = tid + NT * i, jp = g & (h1 - 1), base = ((g - jp) << 2) + jp;
    float2 e0 = X[base], e1 = X[base + h1], e2 = X[base + 2 * h1], e3 = X[base + 3 * h1];
    const float fr = (float)jp * inv4;
    const float2 V = make_float2(__builtin_amdgcn_cosf(fr), __builtin_amdgcn_sinf(fr));
    const float2 Wc = cmul(V, V);
    float2 t1 = cmul(e1, Wc), t3 = cmul(e3, Wc);
    float2 a0 = cadd(e0, t1), a1 = csub(e0, t1), a2 = cadd(e2, t3), a3 = csub(e2, t3);
    float2 u2 = cmul(a2, V), u3 = cmul(a3, V);
    u3 = make_float2(-u3.y, u3.x);
    X[base] = cadd(a0, u2); X[base + 2 * h1] = csub(a0, u2);
    X[base + h1] = cadd(a1, u3); X[base + 3 * h1] = csub(a1, u3);
  }
  __syncthreads();
}
DI constexpr float r16c(int k) { return k == 0 ? 1.f : k == 1 ? 0.9238795325112867f : k == 2 ? 0.7071067811865476f : k == 3 ? 0.3826834323650898f : k == 4 ? 0.f : k == 5 ? -0.3826834323650898f : k == 6 ? -0.7071067811865476f : -0.9238795325112867f; }
DI constexpr float r16s(int k) { return k == 0 ? 0.f : k == 1 ? 0.3826834323650898f : k == 2 ? 0.7071067811865476f : k == 3 ? 0.9238795325112867f : k == 4 ? 1.f : k == 5 ? 0.9238795325112867f : k == 6 ? 0.7071067811865476f : 0.3826834323650898f; }
template <bool INV>
DI void fft_pass16(float2* X, int tid, int q) {
  const float invq = 1.f / (16.f * (float)q);
#pragma unroll 1
  for (int it = 0; it < 2; ++it) {
    const int g = tid + NT * it, jp = g & (q - 1), base = ((g - jp) << 4) + jp;
    float vx[16], vy[16];
#pragma unroll
    for (int r = 0; r < 16; ++r) { const float2 e = X[base + r * q]; vx[r] = e.x; vy[r] = e.y; }
    const float th = (float)jp * invq;
    float bx[4], by[4];
    bx[0] = __builtin_amdgcn_cosf(th); by[0] = INV ? __builtin_amdgcn_sinf(th) : -__builtin_amdgcn_sinf(th);
#pragma unroll
    for (int s = 1; s < 4; ++s) { bx[s] = bx[s - 1] * bx[s - 1] - by[s - 1] * by[s - 1]; by[s] = 2.f * bx[s - 1] * by[s - 1]; }
#pragma unroll
    for (int ss = 0; ss < 4; ++ss) {
      const int s = INV ? 3 - ss : ss;
      const int rs = 8 >> s;
#pragma unroll
      for (int bf = 0; bf < 8; ++bf) {
        const int r = ((bf & ~(rs - 1)) << 1) | (bf & (rs - 1));
        const int k = (r & (rs - 1)) * (8 / rs);
        const float cc = r16c(k), cs = INV ? r16s(k) : -r16s(k);
        const float tx = bx[s] * cc - by[s] * cs, ty = bx[s] * cs + by[s] * cc;
        const float ax = vx[r], ay = vy[r], cx = vx[r + rs], cy = vy[r + rs];
        if (!INV) {
          const float dx = ax - cx, dy = ay - cy;
          vx[r] = ax + cx; vy[r] = ay + cy;
          vx[r + rs] = dx * tx - dy * ty; vy[r + rs] = dx * ty + dy * tx;
        } else {
          const float ux = cx * tx - cy * ty, uy = cx * ty + cy * tx;
          vx[r] = ax + ux; vy[r] = ay + uy;
          vx[r + rs] = ax - ux; vy[r + rs] = ay - uy;
        }
      }
    }
#pragma unroll
    for (int r = 0; r < 16; ++r) X[base + r * q] = make_float2(vx[r], vy[r]);
  }
  __syncthreads();
}
DI void fft_fwd(float2* X, int tid) {
#pragma unroll 1
  for (int q = 1024; q >= 4; q >>= 4) fft_pass16<false>(X, tid, q);
  fft_pass4_fwd(X, tid, 1);
}
DI void fft_inv(float2* X, int tid) {
  fft_pass4_inv(X, tid, 1);
#pragma unroll 1
  for (int q = 4; q <= 1024; q <<= 4) fft_pass16<true>(X, tid, q);
}
DI float sconv_at(const u16* src, int t, int len, float w0, float w1, float w2, float bb) {
  float ym = t > 0 ? bf2f(src[t - 1]) : 0.f, y0 = bf2f(src[t]), yp = t < len - 1 ? bf2f(src[t + 1]) : 0.f;
  return bb + w0 * ym + w1 * y0 + w2 * yp;
}
DI float hy_delta(int col) {
  const float A0 = -4.605170185988091f / 0.3f, A1 = -4.605170185988091f / 1.5f;
  return fabsf(A0 + (A1 - A0) * ((float)col / 2047.f));
}

DI void hyena_latent_task(const Params& p, int l, int c, char* smem, int dry) {
  float2* X = (float2*)smem;
  float* red = (float*)(smem + 131072);
  const int tid = my_tid(), lane = tid & 63, wid = tid >> 6;
  u16* CT = (u16*)(p.ws + OFF_CT);
  float2* FE = (float2*)(p.ws + OFF_FS + (size_t)blockIdx.x * 262144);
  float2* FO = FE + 16384;
  const unsigned* h2T = (const unsigned*)(p.ws + OFF_H2T) + (size_t)l * 64 * (L / 2);
  const float* f3w = pk(p, PK_F3) + (size_t)l * 64 * 2048;
  const float* cw = pk(p, PK_CW) + (size_t)l * 3 * 1536;
  const float* cbv = pk(p, PK_CB) + (size_t)l * 1536;
  const float vw0 = cw[c], vw1 = cw[1536 + c], vw2 = cw[3072 + c], vbb = cbv[c];
  const u16* v0 = CT + ((size_t)(CH_YU + c) * 2 + 0) * TB + LC;
  const u16* v1 = CT + ((size_t)(CH_YU + c) * 2 + 1) * TB + LC;
  u16* z10 = CT + ((size_t)(CH_YU + 512 + c) * 2 + 0) * TB + LC;
  u16* z11 = CT + ((size_t)(CH_YU + 512 + c) * 2 + 1) * TB + LC;
#pragma unroll 1
  for (int o = 0; o < 2; ++o) {
    const int cf = o * 1024 + c, cbk = cf + 512;
    float sf = 0.f, sb = 0.f;
    __syncthreads();
#ifdef PROBE_FFT
    fft_fwd(X, tid); fft_inv(X, tid);
#endif
#pragma unroll 1
    for (int half = 0; half < 2; ++half) {
      float af[16], ab[16];
#pragma unroll
      for (int i = 0; i < 16; ++i) { af[i] = 0.f; ab[i] = 0.f; }
#pragma unroll 1
      for (int j = 0; j < 64; j += 2) {
        const float wf0 = f3w[j * 2048 + cf], wb0 = f3w[j * 2048 + cbk], wf1 = f3w[(j + 1) * 2048 + cf], wb1 = f3w[(j + 1) * 2048 + cbk];
        const unsigned* hrow = h2T + (size_t)j * (L / 2) + tid + half * 8 * NT;
        unsigned w0[8], w1[8];
#pragma unroll
        for (int i = 0; i < 8; ++i) { w0[i] = hrow[NT * i]; w1[i] = hrow[L / 2 + NT * i]; }
#pragma unroll
        for (int i = 0; i < 8; ++i) {
          const float a0 = bflo(w0[i]), a1 = bfhi(w0[i]), b0 = bflo(w1[i]), b1 = bfhi(w1[i]);
          af[2 * i] += a0 * wf0 + b0 * wf1; af[2 * i + 1] += a1 * wf0 + b1 * wf1;
          ab[2 * i] += a0 * wb0 + b0 * wb1; ab[2 * i + 1] += a1 * wb0 + b1 * wb1;
        }
      }
      const float df = hy_delta(cf), db = hy_delta(cbk);
#pragma unroll
      for (int i = 0; i < 16; ++i) {
        const int t = 2 * (tid + NT * ((i >> 1) + half * 8)) + (i & 1); const float tt = (float)t / (float)(L - 1);
        const float vf = af[i] * (__expf(-tt * df) + 0.05f), vb = ab[i] * (__expf(-tt * db) + 0.05f);
        sf += fabsf(vf); sb += fabsf(vb);
        X[t].x = vf;
        if (t >= 1) X[L - t].y = vb; else X[0].y = 0.f;
      }
    }
    sf = wave_sum(sf); sb = wave_sum(sb);
    if (lane == 0) { red[wid] = sf; red[8 + wid] = sb; }
    __syncthreads();
    float nf = 0.f, nbk = 0.f;
#pragma unroll
    for (int w = 0; w < 8; ++w) { nf += red[w]; nbk += red[8 + w]; }
    const float inv_f = 1.f / nf, inv_b = 1.f / nbk;
#pragma unroll 8
    for (int i = 0; i < 32; ++i) { const int n = tid + NT * i; const float2 s = X[n]; FO[n] = s; X[n] = make_float2(s.x * inv_f + s.y * inv_b, 0.f); }
    __syncthreads();
    fft_fwd(X, tid);
#pragma unroll 8
    for (int i = 0; i < 32; ++i) { const int n = tid + NT * i; FE[n] = X[n]; }
    __syncthreads();
#pragma unroll 8
    for (int i = 0; i < 32; ++i) {
      const int n = tid + NT * i; const float2 s = FO[n]; const float dd = s.x * inv_f - s.y * inv_b; const float fr = (float)n * (1.f / 32768.f);
      X[n] = make_float2(dd * __builtin_amdgcn_cosf(fr), -dd * __builtin_amdgcn_sinf(fr));
    }
    __syncthreads();
    fft_fwd(X, tid);
#pragma unroll 8
    for (int i = 0; i < 32; ++i) { const int n = tid + NT * i; FO[n] = X[n]; }
    __syncthreads();
#pragma unroll 8
    for (int i = 0; i < 32; ++i) {
      const int n = tid + NT * i;
      float2 zz;
      if (o == 0) { zz.x = sconv_at(v0, n, L, vw0, vw1, vw2, vbb); zz.y = sconv_at(v1, n, L, vw0, vw1, vw2, vbb); }
      else { zz.x = bf2f(z10[n]); zz.y = bf2f(z11[n]); }
      X[n] = zz;
    }
    __syncthreads();
    fft_fwd(X, tid);
#pragma unroll 8
    for (int i = 0; i < 32; ++i) { const int n = tid + NT * i; X[n] = cmul(X[n], FE[n]); }
    __syncthreads();
    fft_inv(X, tid);
#pragma unroll 8
    for (int i = 0; i < 32; ++i) { const int n = tid + NT * i; FE[n] = X[n]; }
    __syncthreads();
#pragma unroll 8
    for (int i = 0; i < 32; ++i) {
      const int n = tid + NT * i; const float fr = (float)n * (1.f / 32768.f);
      float2 zz;
      if (o == 0) { zz.x = sconv_at(v0, n, L, vw0, vw1, vw2, vbb); zz.y = sconv_at(v1, n, L, vw0, vw1, vw2, vbb); }
      else { zz.x = bf2f(z10[n]); zz.y = bf2f(z11[n]); }
      X[n] = cmul(zz, make_float2(__builtin_amdgcn_cosf(fr), -__builtin_amdgcn_sinf(fr)));
    }
    __syncthreads();
    fft_fwd(X, tid);
#pragma unroll 8
    for (int i = 0; i < 32; ++i) { const int n = tid + NT * i; X[n] = cmul(X[n], FO[n]); }
    __syncthreads();
    fft_inv(X, tid);
    {
      const int gch = CH_YU + 512 * (o + 1) + c;
      const float w0 = cw[gch], w1 = cw[1536 + gch], w2 = cw[3072 + gch], bb = cbv[gch];
      const u16* s0 = CT + ((size_t)gch * 2 + 0) * TB + LC;
      const u16* s1 = CT + ((size_t)gch * 2 + 1) * TB + LC;
      const float sk = pk(p, PK_SK)[(l * 2 + o) * 512 + c];
#pragma unroll 8
      for (int i = 0; i < 32; ++i) {
        const int n = tid + NT * i; const float fr = (float)n * (1.f / 32768.f);
        const float2 wb = cmul(X[n], make_float2(__builtin_amdgcn_cosf(fr), __builtin_amdgcn_sinf(fr)));
        const float2 A = FE[n];
        const float yr = (A.x + wb.x) * (1.f / 32768.f), yi = (A.y + wb.y) * (1.f / 32768.f);
        const float g0 = sconv_at(s0, n, L, w0, w1, w2, bb), g1 = sconv_at(s1, n, L, w0, w1, w2, bb);
        float2 zz;
        if (o == 0) { zz.x = sconv_at(v0, n, L, vw0, vw1, vw2, vbb); zz.y = sconv_at(v1, n, L, vw0, vw1, vw2, vbb); }
        else { zz.x = bf2f(z10[n]); zz.y = bf2f(z11[n]); }
        X[n] = make_float2(g0 * (yr + sk * zz.x), g1 * (yi + sk * zz.y));
      }
    }
    __syncthreads();
    if (o == 0) {
#pragma unroll 8
      for (int i = 0; i < 32; ++i) { const int n = tid + NT * i; const float2 zz = X[n]; if (!dry) { z10[n] = f2bf(zz.x); z11[n] = f2bf(zz.y); } }
    } else {
      u16* d0 = CT + ((size_t)(CH_YZ + c) * 2 + 0) * TB + LC;
      u16* d1 = CT + ((size_t)(CH_YZ + c) * 2 + 1) * TB + LC;
#pragma unroll 1
      for (int ib = 0; ib < 32; ib += 8) {
        u16 g0[8], g1[8];
#pragma unroll
        for (int i = 0; i < 8; ++i) { const int n = tid + NT * (ib + i); g0[i] = d0[n]; g1[i] = d1[n]; }
#pragma unroll
        for (int i = 0; i < 8; ++i) {
          const int n = tid + NT * (ib + i); const float2 zz = X[n];
          const u16 q0 = f2bf(zz.x * silu_f(bf2f(g0[i]))), q1 = f2bf(zz.y * silu_f(bf2f(g1[i])));
          if (!dry) { d0[n] = q0; d1[n] = q1; }
        }
      }
    }
    __syncthreads();
  }
}

DI void hyena_ctx_task(const Params& p, int l, int c, char* smem, int dry) {
  float* filt = (float*)smem;
  float* zs = filt + 1024;
  float* nrm = zs + 1024;
  const int tid = my_tid(), lane = tid & 63, wid = tid >> 6, t = tid & 255, hb = tid >> 8;
  u16* CT = (u16*)(p.ws + OFF_CT);
  const float* h2c = (const float*)(p.ws + OFF_H2C) + (size_t)l * 256 * 64;
  const float* f3w = pk(p, PK_F3) + (size_t)l * 64 * 2048;
  const float* cw = pk(p, PK_CW) + (size_t)l * 3 * 1536;
  const float* cbv = pk(p, PK_CB) + (size_t)l * 1536;
  __syncthreads();
  {
    const int cf = hb * 1024 + c, cbk = cf + 512;
    float a_f = 0.f, a_b = 0.f;
    for (int j = 0; j < 64; ++j) { const float hv = h2c[t * 64 + j]; a_f += hv * f3w[j * 2048 + cf]; a_b += hv * f3w[j * 2048 + cbk]; }
    const float tt = (float)t / 255.f;
    filt[(hb * 2 + 0) * 256 + t] = a_f * (__expf(-tt * hy_delta(cf)) + 0.05f);
    filt[(hb * 2 + 1) * 256 + t] = a_b * (__expf(-tt * hy_delta(cbk)) + 0.05f);
    const u16* src = CT + ((size_t)(CH_YU + c) * 2 + hb) * TB;
    zs[hb * 256 + t] = sconv_at(src, t, LC, cw[c], cw[1536 + c], cw[3072 + c], cbv[c]);
  }
  __syncthreads();
  if (wid < 4) {
    float s = 0.f;
    for (int k = 0; k < 4; ++k) s += fabsf(filt[wid * 256 + lane + 64 * k]);
    s = wave_sum(s);
    if (lane == 0) nrm[wid] = s;
  }
  __syncthreads();
  const int b = hb;
  for (int o = 0; o < 2; ++o) {
    const float inf_ = 1.f / nrm[o * 2], inb_ = 1.f / nrm[o * 2 + 1];
    const float* hf = filt + (o * 2) * 256; const float* hbk = filt + (o * 2 + 1) * 256;
    const float* zc = zs + (o & 1) * 512 + b * 256;
    float accf = 0.f, accb = 0.f;
    for (int s = 0; s <= t; ++s) accf += hf[t - s] * zc[s];
    for (int s = t + 1; s < 256; ++s) accb += hbk[s - t] * zc[s];
    const int gch = CH_YU + 512 * (o + 1) + c;
    const float gate = sconv_at(CT + ((size_t)gch * 2 + b) * TB, t, LC, cw[gch], cw[1536 + gch], cw[3072 + gch], cbv[gch]);
    const float zn = gate * (accf * inf_ + accb * inb_ + pk(p, PK_SK)[(l * 2 + o) * 512 + c] * zc[t]);
    zs[((o + 1) & 1) * 512 + b * 256 + t] = zn;
    __syncthreads();
  }
  {
    u16* d = CT + ((size_t)(CH_YZ + c) * 2 + b) * TB;
    const u16 q0 = f2bf(zs[b * 256 + t] * silu_f(bf2f(d[t])));
    if (!dry) d[t] = q0;
  }
  __syncthreads();
}

DI void gla_bcum(const Params& p, int l, int row0, int hh, int dir, float* gs, float* segs, float* was, float* as_) {
  const int tid = my_tid();
  const u16* P = (const u16*)(p.ws + OFF_P);
  const float* wa = pk(p, dir ? PK_WAB : PK_WAF) + (size_t)l * 16 * 256 + hh * 64;
  const float* ba = pk(p, dir ? PK_BAB : PK_BAF) + l * 256 + hh * 64;
#pragma unroll
  for (int i = 0; i < 2; ++i) {
    const int idx = tid + NT * i;
    was[idx] = wa[(idx >> 6) * 256 + (idx & 63)];
    as_[(idx >> 4) * 17 + (idx & 15)] = bf2f(P[(size_t)(row0 + (idx >> 4)) * NP + PC_AF + dir * 16 + (idx & 15)]);
  }
  __syncthreads();
  {
    const int t = tid >> 3, d0 = (tid & 7) * 8;
    float lin[8];
#pragma unroll
    for (int e = 0; e < 8; ++e) lin[e] = ba[d0 + e];
#pragma unroll 2
    for (int rr = 0; rr < 16; ++rr) {
      const float av = as_[t * 17 + rr];
      const float4 w0 = *(const float4*)(was + rr * 64 + d0), w1 = *(const float4*)(was + rr * 64 + d0 + 4);
      lin[0] += av * w0.x; lin[1] += av * w0.y; lin[2] += av * w0.z; lin[3] += av * w0.w;
      lin[4] += av * w1.x; lin[5] += av * w1.y; lin[6] += av * w1.z; lin[7] += av * w1.w;
    }
#pragma unroll
    for (int e = 0; e < 8; ++e) gs[t * 65 + d0 + e] = (fminf(lin[e], 0.f) - log1pf(__expf(-fabsf(lin[e])))) * (1.f / 16.f);
  }
  __syncthreads();
  {
    const int d = tid & 63, seg = tid >> 6;
    float v[8]; float run = 0.f;
#pragma unroll
    for (int e = 0; e < 8; ++e) { const int tt = dir ? seg * 8 + 7 - e : seg * 8 + e; run += gs[tt * 65 + d]; v[e] = run; }
    segs[seg * 64 + d] = run;
    __syncthreads();
    float off = 0.f;
#pragma unroll
    for (int s = 0; s < 8; ++s) { const bool before = dir ? (s > seg) : (s < seg); if (before) off += segs[s * 64 + d]; }
#pragma unroll
    for (int e = 0; e < 8; ++e) { const int tt = dir ? seg * 8 + 7 - e : seg * 8 + e; gs[tt * 65 + d] = v[e] + off; }
  }
  __syncthreads();
}
DI int gla_tok0(int dir, int n) {
  if (n < 4) return (dir ? 3 - n : n) * 64;
  return LC + (dir ? 255 - (n - 4) : n - 4) * 64;
}
constexpr int G_GS = 0;
constexpr int G_SEG = G_GS + 64 * 65 * 4;
constexpr int G_QS = G_SEG + 8 * 64 * 4;
constexpr int G_KS = G_QS + 64 * LDT * 2;
constexpr int G_VT = G_KS + 64 * LDT * 2;
constexpr int G_ST = G_VT + 128 * LDT * 2;
constexpr int G_RED = G_ST + 128 * LDT * 2;
constexpr int G_WA = G_RED + 8 * 32 * 4;
constexpr int G_AS = G_WA + 16 * 64 * 4;

DI void gla_g1_task(const Params& p, int l, int chain, int n, char* smem) {
  const int tid = my_tid(), lane = tid & 63, wid = tid >> 6, r = lane & 31, h = lane >> 5;
  const int b = chain >> 3, hh = (chain >> 1) & 3, dir = chain & 1;
  const int tk0 = gla_tok0(dir, n), row0 = b * TB + tk0;
  float* gs = (float*)(smem + G_GS); float* segs = (float*)(smem + G_SEG);
  u16* kT = (u16*)(smem + G_KS); u16* vT = (u16*)(smem + G_VT);
  const u16* P = (const u16*)(p.ws + OFF_P);
  const u16* CT = (const u16*)(p.ws + OFF_CT);
  __syncthreads();
  gla_bcum(p, l, row0, hh, dir, gs, segs, (float*)(smem + G_WA), (float*)(smem + G_AS));
  const int tl = dir ? 0 : 63;
  {
    const int t = tid >> 3, d0 = (tid & 7) * 8;
    const u32x4 kv = *(const u32x4*)(P + (size_t)(row0 + t) * NP + PC_GK + hh * 64 + d0);
    const unsigned w[4] = {kv.x, kv.y, kv.z, kv.w};
#pragma unroll
    for (int e = 0; e < 8; ++e) {
      const float kx = (e & 1) ? bfhi(w[e >> 1]) : bflo(w[e >> 1]);
      kT[(d0 + e) * LDT + t] = f2bf(kx * __expf(gs[tl * 65 + d0 + e] - gs[t * 65 + d0 + e]));
    }
#pragma unroll
    for (int i = 0; i < 2; ++i) {
      const int q = tid + NT * i, v = q >> 3, cc = q & 7;
      *(u32x4*)(vT + v * LDT + cc * 8) = *(const u32x4*)(CT + ((size_t)(CH_GV + hh * 128 + v) * 2 + b) * TB + tk0 + cc * 8);
    }
    if (tid < 64) ((float*)(p.ws + OFF_GD))[((size_t)chain * NCK + n) * 64 + tid] = __expf(gs[tl * 65 + tid]);
  }
  __syncthreads();
  {
    const int vm = wid >> 1, dn = wid & 1;
    f32x16 acc = zero16();
#pragma unroll
    for (int s = 0; s < 4; ++s) {
      const bf16x8 a = *(const bf16x8*)(vT + (vm * 32 + r) * LDT + s * 16 + h * 8);
      const bf16x8 bb = *(const bf16x8*)(kT + (dn * 32 + r) * LDT + s * 16 + h * 8);
      acc = MFMA(a, bb, acc);
    }
    u16* GS = (u16*)(p.ws + OFF_GS) + ((size_t)chain * NCK + n) * 8192;
#pragma unroll
    for (int reg = 0; reg < 16; ++reg) GS[(vm * 32 + crow(reg, h)) * 64 + dn * 32 + r] = f2bf(acc[reg]);
  }
}
DI void gla_g2(const Params& p, int dry) {
  u16* GSb = (u16*)(p.ws + OFF_GS);
  const float* GD = (const float*)(p.ws + OFF_GD);
  for (int gi = blockIdx.x * NT + my_tid(); gi < 16 * 8192; gi += gridDim.x * NT) {
    const int chain = gi >> 13, e = gi & 8191, d = e & 63;
    u16* ptr = GSb + (size_t)chain * NCK * 8192 + e;
    const float* dec = GD + (size_t)chain * NCK * 64 + d;
    float S = 0.f;
#pragma unroll 1
    for (int n0 = 0; n0 < NCK; n0 += 20) {
      float ds[20], a[20];
#pragma unroll
      for (int k = 0; k < 20; ++k) { ds[k] = bf2f(ptr[(size_t)(n0 + k) * 8192]); a[k] = dec[(n0 + k) * 64]; }
#pragma unroll
      for (int k = 0; k < 20; ++k) { if (!dry) ptr[(size_t)(n0 + k) * 8192] = f2bf(S); S = a[k] * S + ds[k]; }
    }
  }
}
DI void gla_g3_task(const Params& p, int l, int b, int hh, int ci, char* smem, int dry) {
  const int tid = my_tid(), lane = tid & 63, wid = tid >> 6, r = lane & 31, h = lane >> 5;
  const int tk0 = ci * 64, row0 = b * TB + tk0;
  float* gs = (float*)(smem + G_GS); float* segs = (float*)(smem + G_SEG); float* red = (float*)(smem + G_RED);
  u16* qs = (u16*)(smem + G_QS); u16* ks = (u16*)(smem + G_KS); u16* vT = (u16*)(smem + G_VT); u16* sT = (u16*)(smem + G_ST);
  u16* P = (u16*)(p.ws + OFF_P);
  const u16* CT = (const u16*)(p.ws + OFF_CT);
  const int vm = wid >> 1, in = wid & 1;
  f32x16 o = zero16();
  __syncthreads();
#pragma unroll 1
  for (int dir = 0; dir < 2; ++dir) {
    gla_bcum(p, l, row0, hh, dir, gs, segs, (float*)(smem + G_WA), (float*)(smem + G_AS));
    const int chain = b * 8 + hh * 2 + dir;
    const int n = dir ? ((ci < 4) ? 3 - ci : 263 - ci) : ci;
    {
      const int t = tid >> 3, d0 = (tid & 7) * 8;
      const u32x4 qv = *(const u32x4*)(P + (size_t)(row0 + t) * NP + PC_GQ + hh * 64 + d0);
      const u32x4 kv = *(const u32x4*)(P + (size_t)(row0 + t) * NP + PC_GK + hh * 64 + d0);
      const unsigned qw[4] = {qv.x, qv.y, qv.z, qv.w}, kw[4] = {kv.x, kv.y, kv.z, kv.w};
      unsigned qo[4], ko[4];
#pragma unroll
      for (int e = 0; e < 4; ++e) {
        const float b0 = gs[t * 65 + d0 + 2 * e], b1 = gs[t * 65 + d0 + 2 * e + 1];
        qo[e] = pack2(bflo(qw[e]) * 0.125f * __expf(b0), bfhi(qw[e]) * 0.125f * __expf(b1));
        ko[e] = pack2(bflo(kw[e]) * __expf(-b0), bfhi(kw[e]) * __expf(-b1));
      }
      *(u32x4*)(qs + t * LDT + d0) = u32x4{qo[0], qo[1], qo[2], qo[3]};
      *(u32x4*)(ks + t * LDT + d0) = u32x4{ko[0], ko[1], ko[2], ko[3]};
      const u16* GS = (const u16*)(p.ws + OFF_GS) + ((size_t)chain * NCK + n) * 8192;
#pragma unroll
      for (int i = 0; i < 2; ++i) {
        const int q = tid + NT * i, v = q >> 3, cc = q & 7;
        *(u32x4*)(sT + v * LDT + cc * 8) = *(const u32x4*)(GS + v * 64 + cc * 8);
        if (dir == 0) *(u32x4*)(vT + v * LDT + cc * 8) = *(const u32x4*)(CT + ((size_t)(CH_GV + hh * 128 + v) * 2 + b) * TB + tk0 + cc * 8);
      }
    }
    __syncthreads();
    bf16x8 qf[4];
#pragma unroll
    for (int s = 0; s < 4; ++s) qf[s] = *(const bf16x8*)(qs + (in * 32 + r) * LDT + s * 16 + h * 8);
#pragma unroll
    for (int jt = 0; jt < 2; ++jt) {
      f32x16 at = zero16();
#pragma unroll
      for (int s = 0; s < 4; ++s) at = MFMA(*(const bf16x8*)(ks + (jt * 32 + r) * LDT + s * 16 + h * 8), qf[s], at);
      const int ii = in * 32 + r;
#pragma unroll
      for (int reg = 0; reg < 16; ++reg) {
        const int jj = jt * 32 + crow(reg, h);
        const bool keep = dir ? (jj >= ii) : (jj <= ii);
        if (!keep) at[reg] = 0.f;
      }
#pragma unroll
      for (int s = 0; s < 2; ++s) {
        const u16* vp = vT + (vm * 32 + r) * LDT + jt * 32 + 16 * s + 4 * h;
        o = MFMA(ld2x64(vp, vp + 8), pack8(at, s), o);
      }
    }
#pragma unroll
    for (int s = 0; s < 4; ++s) o = MFMA(*(const bf16x8*)(sT + (vm * 32 + r) * LDT + s * 16 + h * 8), qf[s], o);
    __syncthreads();
  }
  float ss = 0.f;
#pragma unroll
  for (int reg = 0; reg < 16; ++reg) ss += o[reg] * o[reg];
  ss += __shfl_xor(ss, 32);
  if (h == 0) red[wid * 32 + r] = ss;
  __syncthreads();
  float tot = 0.f;
#pragma unroll
  for (int m = 0; m < 4; ++m) tot += red[(m * 2 + in) * 32 + r];
  const float rs = rsqrtf(tot * (1.f / 128.f) + EPS);
  u16* zp = P + (size_t)(row0 + in * 32 + r) * NP + PC_GZ + hh * 128 + vm * 32 + 4 * h;
  const float* gn = pk(p, PK_GN) + l * 128 + vm * 32 + 4 * h;
#pragma unroll
  for (int g = 0; g < 4; ++g) {
    const u32x2 zz = *(const u32x2*)(zp + 8 * g);
    const float4 gw = *(const float4*)(gn + 8 * g);
    u32x2 out;
    out.x = pack2(o[4 * g] * rs * gw.x * silu_f(bflo(zz.x)), o[4 * g + 1] * rs * gw.y * silu_f(bfhi(zz.x)));
    out.y = pack2(o[4 * g + 2] * rs * gw.z * silu_f(bflo(zz.y)), o[4 * g + 3] * rs * gw.w * silu_f(bfhi(zz.y)));
    if (!dry) *(u32x2*)(zp + 8 * g) = out;
  }
}

DI void attn_item(const Params& p, int l, int b, int g, int qtk0, int ntiles, char* smem, int dry) {
  const int tid = my_tid(), lane = tid & 63, wid = tid >> 6, r = lane & 31, h = lane >> 5;
  u16* P = (u16*)(p.ws + OFF_P);
  const u16* CT = (const u16*)(p.ws + OFF_CT);
  u16* Ks = (u16*)smem;
  u16* Vs = Ks + 2 * 64 * LDT;
  const int hq = g * 4 + (wid >> 1);
  const size_t qrow = (size_t)b * TB + qtk0 + (wid & 1) * 32 + r;
  bf16x8 qf[4];
#pragma unroll
  for (int s = 0; s < 4; ++s) qf[s] = *(const bf16x8*)(P + qrow * NP + PC_AQ + hq * 64 + s * 16 + h * 8);
  f32x16 O[2] = {zero16(), zero16()};
  float m = -1e30f, lsum = 0.f;
  const int lr = tid >> 3, lc = (tid & 7) * 8;
  const u16* kg = P + ((size_t)b * TB + lr) * NP + PC_AK + g * 64 + lc;
  const u16* vg = CT + ((size_t)(CH_AV + g * 64 + lr) * 2 + b) * TB + lc;
  u32x4 rk = *(const u32x4*)kg, rv = *(const u32x4*)vg;
  __syncthreads();
  *(u32x4*)(Ks + lr * LDT + lc) = rk; *(u32x4*)(Vs + lr * LDT + lc) = rv;
  __syncthreads();
  float gqm = fabsf(pk(p, PK_QN)[l * 64 + lane]), gkm = fabsf(pk(p, PK_KN)[l * 64 + lane]);
#pragma unroll
  for (int o = 32; o >= 1; o >>= 1) { gqm = fmaxf(gqm, __shfl_xor(gqm, o)); gkm = fmaxf(gkm, __shfl_xor(gkm, o)); }
  const float mshift = 8.2f * 1.4426950408889634f * gqm * gkm;
  if (mshift <= 60.f) {
    f32x16 sinit;
#pragma unroll
    for (int i = 0; i < 16; ++i) sinit[i] = -mshift;
#pragma unroll 1
    for (int kt = 0; kt < ntiles; ++kt) {
      const int cur = kt & 1;
      if (kt + 1 < ntiles) { rk = *(const u32x4*)(kg + (size_t)(kt + 1) * 64 * NP); rv = *(const u32x4*)(vg + (kt + 1) * 64); }
      const u16* Kc = Ks + cur * 64 * LDT; const u16* Vc = Vs + cur * 64 * LDT;
      f32x16 st[2];
#pragma unroll
      for (int kk = 0; kk < 2; ++kk) {
        st[kk] = sinit;
#pragma unroll
        for (int s = 0; s < 4; ++s) st[kk] = MFMA(*(const bf16x8*)(Kc + (kk * 32 + r) * LDT + s * 16 + h * 8), qf[s], st[kk]);
      }
#pragma unroll
      for (int kk = 0; kk < 2; ++kk)
#pragma unroll
        for (int i = 0; i < 16; ++i) { const float pv = __builtin_amdgcn_exp2f(st[kk][i]); st[kk][i] = pv; lsum += pv; }
#pragma unroll
      for (int kk = 0; kk < 2; ++kk)
#pragma unroll
        for (int s = 0; s < 2; ++s) {
          const bf16x8 pb = pack8(st[kk], s);
#pragma unroll
          for (int mt = 0; mt < 2; ++mt) {
            const u16* vp = Vc + (mt * 32 + r) * LDT + kk * 32 + 16 * s + 4 * h;
            O[mt] = MFMA(ld2x64(vp, vp + 8), pb, O[mt]);
          }
        }
      if (kt + 1 < ntiles) { *(u32x4*)(Ks + (cur ^ 1) * 64 * LDT + lr * LDT + lc) = rk; *(u32x4*)(Vs + (cur ^ 1) * 64 * LDT + lr * LDT + lc) = rv; }
      __syncthreads();
    }
  } else {
#pragma unroll 1
    for (int kt = 0; kt < ntiles; ++kt) {
      const int cur = kt & 1;
      if (kt + 1 < ntiles) { rk = *(const u32x4*)(kg + (size_t)(kt + 1) * 64 * NP); rv = *(const u32x4*)(vg + (kt + 1) * 64); }
      const u16* Kc = Ks + cur * 64 * LDT; const u16* Vc = Vs + cur * 64 * LDT;
      f32x16 st[2];
#pragma unroll
      for (int kk = 0; kk < 2; ++kk) {
        st[kk] = zero16();
#pragma unroll
        for (int s = 0; s < 4; ++s) st[kk] = MFMA(*(const bf16x8*)(Kc + (kk * 32 + r) * LDT + s * 16 + h * 8), qf[s], st[kk]);
      }
      float mx = st[0][0];
#pragma unroll
      for (int i = 0; i < 16; ++i) { mx = fmaxf(mx, st[0][i]); mx = fmaxf(mx, st[1][i]); }
      mx = fmaxf(mx, __shfl_xor(mx, 32));
      const float mn = fmaxf(m, mx);
      const float alpha = exp2f(m - mn);
      m = mn;
      float rsum = 0.f;
#pragma unroll
      for (int kk = 0; kk < 2; ++kk)
#pragma unroll
        for (int i = 0; i < 16; ++i) { const float pv = exp2f(st[kk][i] - mn); st[kk][i] = pv; rsum += pv; }
      lsum = lsum * alpha + rsum;
#pragma unroll
      for (int mt = 0; mt < 2; ++mt)
#pragma unroll
        for (int i = 0; i < 16; ++i) O[mt][i] *= alpha;
#pragma unroll
      for (int kk = 0; kk < 2; ++kk)
#pragma unroll
        for (int s = 0; s < 2; ++s) {
          const bf16x8 pb = pack8(st[kk], s);
#pragma unroll
          for (int mt = 0; mt < 2; ++mt) {
            const u16* vp = Vc + (mt * 32 + r) * LDT + kk * 32 + 16 * s + 4 * h;
            O[mt] = MFMA(ld2x64(vp, vp + 8), pb, O[mt]);
          }
        }
      if (kt + 1 < ntiles) { *(u32x4*)(Ks + (cur ^ 1) * 64 * LDT + lr * LDT + lc) = rk; *(u32x4*)(Vs + (cur ^ 1) * 64 * LDT + lr * LDT + lc) = rv; }
      __syncthreads();
    }
  }
  lsum += __shfl_xor(lsum, 32);
  const float inv = 1.f / lsum;
  u16* op = P + qrow * NP + PC_AQ + hq * 64 + 4 * h;
  const u16* zp = P + qrow * NP + PC_AZ + hq * 64 + 4 * h;
#pragma unroll
  for (int mt = 0; mt < 2; ++mt)
#pragma unroll
    for (int gg = 0; gg < 4; ++gg) {
      const u32x2 zz = *(const u32x2*)(zp + mt * 32 + 8 * gg);
      u32x2 out;
      out.x = pack2(O[mt][4 * gg] * inv * silu_f(bflo(zz.x)), O[mt][4 * gg + 1] * inv * silu_f(bfhi(zz.x)));
      out.y = pack2(O[mt][4 * gg + 2] * inv * silu_f(bflo(zz.y)), O[mt][4 * gg + 3] * inv * silu_f(bfhi(zz.y)));
      if (!dry) *(u32x2*)(op + mt * 32 + 8 * gg) = out;
    }
}

template <int KSU>
DI void gemm_gate3(const u16* __restrict__ A, const u16* __restrict__ WM, char* smem, f32x16 (&acc)[3][2]) {
  u16* As0 = (u16*)smem;
  u16* As1 = As0 + 128 * LDT;
  u16* Bs0 = As0 + 2 * 128 * LDT;
  u16* Bs1 = Bs0 + 384 * LDT;
  const int tid = my_tid(), lane = tid & 63, wid = tid >> 6, r = lane & 31, h = lane >> 5, wm = wid & 3, wn = wid >> 2;
  u32x4 ra0[2], rb0[6], ra1[2], rb1[6];
  auto fetch = [&](u32x4 (&ra)[2], u32x4 (&rb)[6], int k0) {
#pragma unroll
    for (int i = 0; i < 2; ++i) { const int q = tid + NT * i; const unsigned off = (unsigned)((q >> 3) * 1024 + (q & 7) * 8); ra[i] = *(const u32x4*)(A + off + k0); }
#pragma unroll
    for (int i = 0; i < 6; ++i) {
      const int q = tid + NT * i, row = q >> 3;
      const unsigned off = (unsigned)((row >> 7) * (1024 * 1024) + (row & 127) * 1024 + (q & 7) * 8);
      rb[i] = *(const u32x4*)(WM + off + k0);
    }
    GFENCE;
  };
  auto commit = [&](const u32x4 (&ra)[2], const u32x4 (&rb)[6], u16* As, u16* Bs) {
#pragma unroll
    for (int i = 0; i < 2; ++i) { const int q = tid + NT * i; *(u32x4*)(As + (q >> 3) * LDT + (q & 7) * 8) = ra[i]; }
#pragma unroll
    for (int i = 0; i < 6; ++i) { const int q = tid + NT * i; *(u32x4*)(Bs + (q >> 3) * LDT + (q & 7) * 8) = rb[i]; }
    GFENCE;
  };
  auto compute = [&](const u16* Ac, const u16* Bc) {
#pragma unroll KSU
    for (int ks = 0; ks < 4; ++ks) {
      const bf16x8 a = *(const bf16x8*)(Ac + (wm * 32 + r) * LDT + ks * 16 + h * 8);
#pragma unroll
      for (int br = 0; br < 3; ++br)
#pragma unroll
        for (int j = 0; j < 2; ++j)
          acc[br][j] = MFMA(a, *(const bf16x8*)(Bc + (br * 128 + wn * 64 + j * 32 + r) * LDT + ks * 16 + h * 8), acc[br][j]);
    }
  };
  constexpr int KT = 16;
  fetch(ra0, rb0, 0);
  fetch(ra1, rb1, 64);
  __syncthreads();
  commit(ra0, rb0, As0, Bs0);
  __syncthreads();
  fetch(ra0, rb0, 128);
#pragma unroll
  for (int kt = 0; kt < KT; kt += 2) {
    commit(ra1, rb1, As1, Bs1);
    if (kt + 3 < KT) fetch(ra1, rb1, (kt + 3) * 64);
    compute(As0, Bs0);
    __syncthreads();
    if (kt + 2 < KT) commit(ra0, rb0, As0, Bs0);
    if (kt + 4 < KT) fetch(ra0, rb0, (kt + 4) * 64);
    compute(As1, Bs1);
    __syncthreads();
  }
}
DI void phase_merge(const Params& p, int l, char* smem) {
  const int tid = my_tid(), lane = tid & 63, wid = tid >> 6, r = lane & 31, h = lane >> 5, wm = wid & 3, wn = wid >> 2;
  const int xcd = blockIdx.x & 7, nloc = gridDim.x >> 3;
  for (int q = blockIdx.x >> 3; q < 33 * 8; q += nloc) {
    const int mt = (q >> 3) * 8 + xcd, nt = q & 7, m0 = mt * 128, n0 = nt * 128;
    if (mt >= 260) continue;
    const int b = m0 / TB, tk0 = m0 - b * TB;
    if (l == 1 && tk0 < LC) continue;
    const u16* H = (const u16*)(p.ws + OFF_H) + (size_t)m0 * 1024;
    const u16* WM = (const u16*)(p.ws + OFF_WT + (size_t)l * WT_LAYER) + (size_t)(4896 + n0) * 1024;
    const u16* WBR = (const u16*)(p.ws + OFF_WT + (size_t)l * WT_LAYER + WT_IN) + (size_t)n0 * 512;
    unsigned gp[3][2][8];
    {
      f32x16 g3[3][2];
#pragma unroll
      for (int br = 0; br < 3; ++br) for (int j = 0; j < 2; ++j) g3[br][j] = zero16();
      gemm_gate3<2>(H, WM, smem, g3);
#pragma unroll
      for (int br = 0; br < 3; ++br)
#pragma unroll
        for (int j = 0; j < 2; ++j)
#pragma unroll
          for (int i = 0; i < 8; ++i)
            gp[br][j][i] = pack2(1.f / (1.f + __expf(-g3[br][j][2 * i])), 1.f / (1.f + __expf(-g3[br][j][2 * i + 1])));
    }
    f32x16 ysum[2] = {zero16(), zero16()};
#pragma unroll
    for (int br = 0; br < 3; ++br) {
      f32x16 ab[1][2] = {{zero16(), zero16()}};
      if (br < 2) {
        ALoadN ay{(const u16*)(p.ws + OFF_P) + (size_t)m0 * NP + (br == 0 ? PC_GZ : PC_AQ), NP};
        gemm_tile<128, ALoadN, 4, 512>(ay, WBR + (size_t)br * 1024 * 512, 512, smem, ab);
      } else {
        ALoadT ay{(const u16*)(p.ws + OFF_CT) + ((size_t)CH_YZ * 2 + b) * TB + tk0, (size_t)2 * TB};
        gemm_tile<128, ALoadT, 4, 512>(ay, WBR + (size_t)2 * 1024 * 512, 512, smem, ab);
      }
#pragma unroll
      for (int j = 0; j < 2; ++j)
#pragma unroll
        for (int i = 0; i < 8; ++i) {
          ysum[j][2 * i] += bflo(gp[br][j][i]) * ab[0][j][2 * i];
          ysum[j][2 * i + 1] += bfhi(gp[br][j][i]) * ab[0][j][2 * i + 1];
        }
    }
    u16* Y = (u16*)(p.ws + OFF_Y) + (size_t)(m0 + wm * 32 + 4 * h) * 1024 + n0 + wn * 64 + r;
#pragma unroll
    for (int j = 0; j < 2; ++j)
#pragma unroll
      for (int reg = 0; reg < 16; ++reg) Y[(size_t)((reg & 3) + 8 * (reg >> 2)) * 1024 + j * 32] = f2bf(ysum[j][reg]);
  }
}

DI void phase_out(const Params& p, int l, char* smem) {
  const int tid = my_tid(), lane = tid & 63, wid = tid >> 6, r = lane & 31, h = lane >> 5, wm = wid & 3, wn = wid >> 2;
  const u16* Yb = (const u16*)(p.ws + OFF_Y);
  const u16* WO = (const u16*)(p.ws + OFF_WT + (size_t)l * WT_LAYER + WT_IN + 3 * WT_BR);
  const float* mod = (const float*)(p.ws + OFF_MOD);
  const int xcd = blockIdx.x & 7, nloc = gridDim.x >> 3;
  auto tile_of = [&](int q, int& m0, int& n0) -> bool {
    const int mt = (q >> 3) * 8 + xcd; m0 = mt * 128; n0 = (q & 7) * 128;
    if (mt >= 260) return false;
    const int b = m0 / TB, tk0 = m0 - b * TB;
    return !(l == 1 && tk0 < LC);
  };
  auto next_q = [&](int q) -> int { int m, n; for (q += nloc; q < 33 * 8; q += nloc) if (tile_of(q, m, n)) return q; return -1; };
  int q = (int)(blockIdx.x >> 3) - nloc; q = next_q(q);
  if (q < 0) return;
  int m0, n0; tile_of(q, m0, n0);
  GemmRegs<128> gr;
  { ALoadN ay{Yb + (size_t)m0 * 1024, 1024}; gemm_prime<128>(gr, ay, WO + (size_t)n0 * 1024, 1024, smem); }
  while (true) {
    const int qn = next_q(q);
    int m0n = 0, n0n = 0; if (qn >= 0) tile_of(qn, m0n, n0n);
    const int b = m0 / TB, tk0 = m0 - b * TB;
    f32x16 acc[1][2] = {{zero16(), zero16()}};
    const ALoadN ay{Yb + (size_t)m0 * 1024, 1024}, ayn{Yb + (size_t)m0n * 1024, 1024};
    gemm_run<128, ALoadN, 4, 1024, ALoadN>(gr, ay, WO + (size_t)n0 * 1024, 1024, ayn, WO + (size_t)n0n * 1024, 1024, qn >= 0, smem, acc);
    const float* gv = mod + (l * 3 + (tk0 < LC ? 2 : b)) * 3072 + 2048;
    const float* xin = xrow_in(p, l, m0);
    float* xout = xrow_out(p, m0);
#pragma unroll
    for (int j = 0; j < 2; ++j) {
      const int col = n0 + wn * 64 + j * 32 + r;
      const float gate = gv[col];
#pragma unroll
      for (int reg = 0; reg < 16; ++reg) {
        const size_t off = (size_t)(wm * 32 + crow(reg, h)) * D + col;
        xout[off] = xin[off] + gate * acc[0][j][reg];
      }
    }
    if (qn < 0) break;
    q = qn; m0 = m0n; n0 = n0n;
  }
}

DI void phase_final(const Params& p) {
  const int tid = my_tid(), lane = tid & 63, wid = tid >> 6;
  for (int row = blockIdx.x * 8 + wid; row < NBATCH * L; row += gridDim.x * 8) {
    float* src = p.out + (size_t)row * D;
    float4 xv[4]; float ss = 0.f;
#pragma unroll
    for (int i = 0; i < 4; ++i) { xv[i] = *(const float4*)(src + (i * 64 + lane) * 4); ss += xv[i].x * xv[i].x + xv[i].y * xv[i].y + xv[i].z * xv[i].z + xv[i].w * xv[i].w; }
    ss = wave_sum(ss);
    const float rs = rsqrtf(ss * (1.f / 1024.f) + EPS);
#pragma unroll
    for (int i = 0; i < 4; ++i) {
      const int col = (i * 64 + lane) * 4;
      const float4 fw = *(const float4*)(pk(p, PK_FN) + col);
      *(float4*)(src + col) = make_float4(xv[i].x * rs * fw.x, xv[i].y * rs * fw.y, xv[i].z * rs * fw.z, xv[i].w * rs * fw.w);
    }
  }
}

DI void run_phase(const Params& p, int ph, char* smem, int dry = 0) {
  const int bid = blockIdx.x, nb = gridDim.x;
  if (ph == 0) { phase0(p, smem); return; }
  if (ph == 17) { phase_final(p); return; }
  const int l = (ph - 1) >> 3, s = (ph - 1) & 7;
  switch (s) {
    case 0: phase_norm(p, l); break;
    case 1: phase_proj(p, l, smem); break;
    case 2: {
      attn_prep(p, l, dry);
      if (l == 0) for (int c = bid; c < 512; c += nb) hyena_ctx_task(p, l, c, smem, dry);
      for (int c = bid; c < 512; c += nb) hyena_latent_task(p, l, c, smem, dry);
    } break;
    case 3: for (int t = bid; t < 16 * NCK; t += nb) gla_g1_task(p, l, t / NCK, t % NCK, smem); break;
    case 4: gla_g2(p, dry); break;
    case 5: {
      for (int it = bid; it < 1024; it += nb) { const int b = it >> 9, g = (it >> 8) & 1, qb = it & 255; attn_item(p, l, b, g, LC + qb * 64, NCK, smem, dry); }
      if (l == 0) for (int it = bid; it < 16; it += nb) { const int b = it >> 3, g = (it >> 2) & 1, qb = it & 3; attn_item(p, l, b, g, qb * 64, 4, smem, dry); }
      const int c0 = (l == 0) ? 0 : 4, per = NCK - c0;
      for (int t = bid; t < 8 * per; t += nb) { const int bh = t / per, ci = c0 + t % per; gla_g3_task(p, l, bh >> 2, bh & 3, ci, smem, dry); }
    } break;
    case 6: phase_merge(p, l, smem); break;
    case 7: phase_out(p, l, smem); break;
  }
}

#if MULTI_LAUNCH
template <int PH> __global__ void __launch_bounds__(NT) phase_kernel(Params p) {
  extern __shared__ __attribute__((aligned(16))) char smem[];
  run_phase(p, PH, smem);
}
template <int PH> static void launch_phase(const Params& p, int grid, hipStream_t stream) {
  static bool attr = false;
  if (!attr) { (void)hipFuncSetAttribute((const void*)phase_kernel<PH>, hipFuncAttributeMaxDynamicSharedMemorySize, LDS_BYTES); attr = true; }
  hipLaunchKernelGGL(phase_kernel<PH>, dim3(grid), dim3(NT), LDS_BYTES, stream, p);
}
#else
#ifndef PROBE_DUP
#define PROBE_DUP -1
#endif
#ifndef PROBE_DUP2
#define PROBE_DUP2 -1
#endif
#ifndef PROBE_DUP3
#define PROBE_DUP3 -1
#endif
__global__ void __launch_bounds__(NT) fwd_kernel(Params p) {
  extern __shared__ __attribute__((aligned(16))) char smem[];
  cg::grid_group grid = cg::this_grid();
#if PROBE_DUP >= 0
#define PHS(n) if ((n) == PROBE_DUP || (n) == PROBE_DUP2 || (n) == PROBE_DUP3) { run_phase(p, n, smem, p.phase_lo == 0 ? 1 : 0); grid.sync(); } run_phase(p, n, smem); grid.sync();
#else
#define PHS(n) run_phase(p, n, smem); grid.sync();
#endif
  PHS(0) PHS(1) PHS(2) PHS(3) PHS(4) PHS(5) PHS(6) PHS(7) PHS(8)
  PHS(9) PHS(10) PHS(11) PHS(12) PHS(13) PHS(14) PHS(15) PHS(16)
  run_phase(p, 17, smem);
}
#endif

extern "C" void kernel_launch(void* const* d_in, const int* in_sizes, int n_in, void* d_out, int out_size, void* d_ws, size_t ws_size,
                              hipStream_t stream) {
  static int grid = 0;
  if (grid == 0) {
    if (n_in != 29 || ws_size < WS_END) { fprintf(stderr, "kernel_launch: need 29 inputs and %zu B of workspace, got %d / %zu\n", (size_t)WS_END, n_in, ws_size); grid = -1; return; }
#if MULTI_LAUNCH
    grid = 256;
#else
    int dev = 0, cus = 0, per_cu = 0;
    (void)hipGetDevice(&dev);
    (void)hipDeviceGetAttribute(&cus, hipDeviceAttributeMultiprocessorCount, dev);
    if (hipFuncSetAttribute((const void*)fwd_kernel, hipFuncAttributeMaxDynamicSharedMemorySize, LDS_BYTES) != hipSuccess) { fprintf(stderr, "kernel_launch: hipFuncSetAttribute failed\n"); grid = -1; return; }
    (void)hipOccupancyMaxActiveBlocksPerMultiprocessor(&per_cu, (const void*)fwd_kernel, NT, LDS_BYTES);
    if (per_cu < 1) { fprintf(stderr, "kernel_launch: occupancy query returned %d\n", per_cu); per_cu = 1; }
    (void)hipGetLastError();
    grid = cus * per_cu;
    if (grid > 256) grid = 256;
#endif
  }
  if (grid < 0) return;
  Params p{};
  const float** pp = (const float**)&p;
  for (int i = 0; i < 29; ++i) pp[i] = (const float*)d_in[i];
  p.out = (float*)d_out; p.ws = (char*)d_ws;
  p.phase_lo = 0; p.phase_hi = 18;
#if MULTI_LAUNCH
  launch_phase<0>(p, grid, stream); launch_phase<1>(p, grid, stream); launch_phase<2>(p, grid, stream); launch_phase<3>(p, grid, stream);
  launch_phase<4>(p, grid, stream); launch_phase<5>(p, grid, stream); launch_phase<6>(p, grid, stream); launch_phase<7>(p, grid, stream);
  launch_phase<8>(p, grid, stream); launch_phase<9>(p, grid, stream); launch_phase<10>(p, grid, stream); launch_phase<11>(p, grid, stream);
  launch_phase<12>(p, grid, stream); launch_phase<13>(p, grid, stream); launch_phase<14>(p, grid, stream); launch_phase<15>(p, grid, stream);
  launch_phase<16>(p, grid, stream); launch_phase<17>(p, grid, stream);
#else
  void* args[] = {&p};
  hipError_t e = hipLaunchCooperativeKernel((const void*)fwd_kernel, dim3(grid), dim3(NT), args, LDS_BYTES, stream);
  if (e != hipSuccess) fprintf(stderr, "kernel_launch: cooperative launch failed: %s (grid %d)\n", hipGetErrorString(e), grid);
#endif
}
```

```cpp
#include <hip/hip_runtime.h>
#include <hip/hip_cooperative_groups.h>
#include <cstdio>
namespace cg = cooperative_groups;

typedef unsigned short u16;
typedef __attribute__((ext_vector_type(8))) short bf16x8;
typedef __attribute__((ext_vector_type(16))) float f32x16;
typedef __attribute__((ext_vector_type(4))) unsigned u32x4;
typedef __attribute__((ext_vector_type(2))) unsigned u32x2;
#define DI __device__ __forceinline__
#define MFMA(a, b, c) __builtin_amdgcn_mfma_f32_32x32x16_bf16((a), (b), (c), 0, 0, 0)

#ifndef MULTI_LAUNCH
#define MULTI_LAUNCH 0
#endif

constexpr int D = 1024, NBATCH = 2, L = 16384, LC = 256, TB = L + LC, R = NBATCH * TB;
constexpr int NIN = 7968;
constexpr int NP = 2208;
constexpr int NCH = 2688;
constexpr int PC_GQ = 0, PC_GK = 256, PC_GZ = 512, PC_AF = 1024, PC_AQ = 1056, PC_AK = 1568, PC_AZ = 1696;
constexpr int CH_YU = 0, CH_YZ = 1536, CH_GV = 2048, CH_AV = 2560;
constexpr int NCK = 260;
constexpr float EPS = 1e-6f;
constexpr int NT = 512;
constexpr int LDT = 72;

constexpr size_t OFF_P = 0;
constexpr size_t OFF_CT = OFF_P + (size_t)R * NP * 2;
constexpr size_t OFF_H = OFF_CT + (size_t)NCH * 2 * TB * 2;
constexpr size_t OFF_FS = OFF_H + (size_t)R * 1024 * 2;
constexpr size_t OFF_WT = OFF_FS + (size_t)256 * 262144;
constexpr size_t WT_IN = (size_t)NIN * 1024 * 2, WT_BR = (size_t)1024 * 512 * 2, WT_OUT = (size_t)1024 * 1024 * 2;
constexpr size_t WT_LAYER = WT_IN + 3 * WT_BR + WT_OUT;
constexpr size_t OFF_H2T = OFF_WT + 2 * WT_LAYER;
constexpr size_t OFF_H2C = OFF_H2T + (size_t)2 * 64 * L * 4;
constexpr size_t OFF_MOD = OFF_H2C + (size_t)2 * 256 * 64 * 4;
constexpr size_t OFF_CTX1 = OFF_MOD + (size_t)2 * 3 * 3072 * 4;
constexpr size_t OFF_GD = OFF_CTX1 + (size_t)512 * 1024 * 4;
constexpr size_t OFF_PK = OFF_GD + (size_t)16 * NCK * 64 * 4;
constexpr int PK_WAF = 0, PK_BAF = 8192, PK_WAB = 8704, PK_BAB = 16896, PK_GN = 17408, PK_QN = 17664, PK_KN = 17792, PK_CW = 17920,
              PK_CB = 27136, PK_SK = 30208, PK_FN = 32256, PK_F3 = 33280, PK_END = 33280 + 262144;
constexpr size_t OFF_BAR = OFF_PK + (size_t)PK_END * 4;
constexpr size_t BAR_BYTES = 9 * 256;
constexpr size_t WS_END = OFF_BAR + 4096;
constexpr size_t OFF_GS = OFF_CT;
constexpr size_t OFF_Y = OFF_CT;
static_assert((size_t)16 * NCK * 8192 * 2 <= (size_t)1536 * 2 * TB * 2, "alias");
static_assert((size_t)R * 1024 * 2 <= (size_t)1536 * 2 * TB * 2, "alias");

constexpr int LDS_BYTES = 2 * (128 + 384) * 72 * 2 + 512;

struct Params {
  const float *x, *c, *ctx, *c_ctx, *w_ada, *b_ada, *w_in, *wa_f, *ba_f, *wa_b, *ba_b, *gla_norm, *qnorm, *knorm,
      *conv_w, *conv_b, *f1_w, *f1_b, *f1_freq, *f2_w, *f2_b, *f2_freq, *f3_w, *skip, *w_g, *w_a, *w_h, *w_o, *final_norm;
  float* out;
  char* ws;
  long long phase_lo, phase_hi;
};

typedef __attribute__((ext_vector_type(2))) float f32x2v;
typedef __attribute__((ext_vector_type(2))) __bf16 bf16x2v;
DI int my_tid() {
  int t = (int)threadIdx.x;
  asm volatile("" : "+v"(t));
  __builtin_assume(t >= 0 && t < NT);
  return t;
}
DI u16 f2bf(float x) { return __builtin_bit_cast(u16, (__bf16)x); }
DI float bf2f(u16 v) { return __uint_as_float(((unsigned)v) << 16); }
DI unsigned pack2(float a, float b) { f32x2v v = {a, b}; return __builtin_bit_cast(unsigned, __builtin_convertvector(v, bf16x2v)); }
DI float bflo(unsigned u) { return __uint_as_float(u << 16); }
DI float bfhi(unsigned u) { return __uint_as_float(u & 0xffff0000u); }
DI float silu_f(float x) { return x / (1.f + __expf(-x)); }
DI float wave_sum(float v) {
#pragma unroll
  for (int o = 32; o >= 1; o >>= 1) v += __shfl_xor(v, o);
  return v;
}
DI int crow(int reg, int h) { return (reg & 3) + 8 * (reg >> 2) + 4 * h; }
DI f32x16 zero16() { f32x16 z; for (int i = 0; i < 16; ++i) z[i] = 0.f; return z; }
DI bf16x8 pack8(const f32x16& x, int s) {
  u32x4 u;
  u.x = pack2(x[8 * s + 0], x[8 * s + 1]); u.y = pack2(x[8 * s + 2], x[8 * s + 3]);
  u.z = pack2(x[8 * s + 4], x[8 * s + 5]); u.w = pack2(x[8 * s + 6], x[8 * s + 7]);
  return __builtin_bit_cast(bf16x8, u);
}
DI bf16x8 ld2x64(const u16* p0, const u16* p1) {
  u32x2 a = *(const u32x2*)p0, b = *(const u32x2*)p1;
  u32x4 u; u.x = a.x; u.y = a.y; u.z = b.x; u.w = b.y;
  return __builtin_bit_cast(bf16x8, u);
}
DI float2 cmul(float2 a, float2 b) { return make_float2(a.x * b.x - a.y * b.y, a.x * b.y + a.y * b.x); }
DI float2 cadd(float2 a, float2 b) { return make_float2(a.x + b.x, a.y + b.y); }
DI float2 csub(float2 a, float2 b) { return make_float2(a.x - b.x, a.y - b.y); }

DI const float* xrow_in(const Params& p, int layer, int row) {
  int b = row / TB, tk = row - b * TB;
  if (tk < LC) return (layer == 0 ? p.ctx : (const float*)(p.ws + OFF_CTX1)) + (size_t)(b * LC + tk) * D;
  return (layer == 0 ? p.x : (const float*)p.out) + (size_t)(b * L + tk - LC) * D;
}
DI float* xrow_out(const Params& p, int row) {
  int b = row / TB, tk = row - b * TB;
  if (tk < LC) return (float*)(p.ws + OFF_CTX1) + (size_t)(b * LC + tk) * D;
  return p.out + (size_t)(b * L + tk - LC) * D;
}
DI const float* pk(const Params& p, int off) { return (const float*)(p.ws + OFF_PK) + off; }
DI int modvec_of(int row) { int b = row / TB, tk = row - b * TB; return tk < LC ? 2 : b; }

struct ALoadN {
  const u16* A; int lda;
  template <int BM> DI void fetch(u32x4 (&r)[BM / 64], int k0, int tid) const {
#pragma unroll
    for (int i = 0; i < BM / 64; ++i) { const int q = tid + NT * i; const unsigned off = (unsigned)((q >> 3) * lda + (q & 7) * 8); r[i] = *(const u32x4*)(A + off + k0); }
  }
  template <int BM> DI void commit(const u32x4 (&r)[BM / 64], u16* As, int tid) const {
#pragma unroll
    for (int i = 0; i < BM / 64; ++i) { int q = tid + NT * i; *(u32x4*)(As + (q >> 3) * LDT + (q & 7) * 8) = r[i]; }
  }
};
struct ALoadT {
  const u16* A; size_t chs;
  template <int BM> DI void fetch(u32x4 (&r)[BM / 64], int k0, int tid) const {
#pragma unroll
    for (int i = 0; i < 2; ++i) { const int q = tid + NT * i; const unsigned off = (unsigned)((q >> 4) * (int)chs + (q & 15) * 8); r[i] = *(const u32x4*)(A + off + (unsigned)(k0 * (int)chs)); }
  }
  template <int BM> DI void commit(const u32x4 (&r)[BM / 64], u16* As, int tid) const {
#pragma unroll
    for (int i = 0; i < 2; ++i) {
      int q = tid + NT * i; int ch = q >> 4, t0 = (q & 15) * 8;
      unsigned w[4] = {r[i].x, r[i].y, r[i].z, r[i].w};
#pragma unroll
      for (int e = 0; e < 4; ++e) { As[(t0 + 2 * e) * LDT + ch] = (u16)(w[e] & 0xffffu); As[(t0 + 2 * e + 1) * LDT + ch] = (u16)(w[e] >> 16); }
    }
  }
};

template <int BM, int KSU>
DI void gemm_compute(const u16* Ac, const u16* Bc, int wm, int wn, int r, int h, f32x16 (&acc)[BM / 128][2]) {
#pragma unroll KSU
  for (int ks = 0; ks < 4; ++ks) {
    bf16x8 a[BM / 128], b[2];
#pragma unroll
    for (int i = 0; i < BM / 128; ++i) a[i] = *(const bf16x8*)(Ac + (wm * (BM / 4) + i * 32 + r) * LDT + ks * 16 + h * 8);
#pragma unroll
    for (int j = 0; j < 2; ++j) b[j] = *(const bf16x8*)(Bc + (wn * 64 + j * 32 + r) * LDT + ks * 16 + h * 8);
#pragma unroll
    for (int i = 0; i < BM / 128; ++i)
#pragma unroll
      for (int j = 0; j < 2; ++j) acc[i][j] = MFMA(a[i], b[j], acc[i][j]);
  }
}
DI void fetch_b(u32x4 (&rb)[2], const u16* Bt, int ldb, int k0, int tid) {
#pragma unroll
  for (int i = 0; i < 2; ++i) { const int q = tid + NT * i; const unsigned off = (unsigned)((q >> 3) * ldb + (q & 7) * 8); rb[i] = *(const u32x4*)(Bt + off + k0); }
}
DI void commit_b(const u32x4 (&rb)[2], u16* Bs, int tid) {
#pragma unroll
  for (int i = 0; i < 2; ++i) { int q = tid + NT * i; *(u32x4*)(Bs + (q >> 3) * LDT + (q & 7) * 8) = rb[i]; }
}
template <int BM> struct GemmRegs { u32x4 ra0[BM / 64], rb0[2], ra1[BM / 64], rb1[2]; };
#define GFENCE asm volatile("" ::: "memory")
template <int BM, class AL>
DI void gemm_prime(GemmRegs<BM>& g, const AL& al, const u16* __restrict__ Bt, int ldb, char* smem) {
  u16* As0 = (u16*)smem;
  u16* Bs0 = As0 + 2 * BM * LDT;
  const int tid = my_tid();
  al.template fetch<BM>(g.ra0, 0, tid); fetch_b(g.rb0, Bt, ldb, 0, tid); GFENCE;
  al.template fetch<BM>(g.ra1, 64, tid); fetch_b(g.rb1, Bt, ldb, 64, tid); GFENCE;
  __syncthreads();
  al.template commit<BM>(g.ra0, As0, tid); commit_b(g.rb0, Bs0, tid);
  __syncthreads();
  al.template fetch<BM>(g.ra0, 128, tid); fetch_b(g.rb0, Bt, ldb, 128, tid); GFENCE;
}
template <int BM, class AL, int KSU, int K, class ALN>
DI void gemm_run(GemmRegs<BM>& g, const AL& al, const u16* __restrict__ Bt, int ldb, const ALN& aln, const u16* __restrict__ Btn, int ldbn,
                 bool hasnext, char* smem, f32x16 (&acc)[BM / 128][2]) {
  u16* As0 = (u16*)smem;
  u16* As1 = As0 + BM * LDT;
  u16* Bs0 = As0 + 2 * BM * LDT;
  u16* Bs1 = Bs0 + 128 * LDT;
  const int tid = my_tid(), lane = tid & 63, wid = tid >> 6, r = lane & 31, h = lane >> 5;
  const int wm = wid & 3, wn = wid >> 2;
  constexpr int KT = K >> 6;
#pragma unroll
  for (int kt = 0; kt < KT; kt += 2) {
    al.template commit<BM>(g.ra1, As1, tid); commit_b(g.rb1, Bs1, tid);
    GFENCE;
    if (kt + 3 < KT) { al.template fetch<BM>(g.ra1, (kt + 3) * 64, tid); fetch_b(g.rb1, Bt, ldb, (kt + 3) * 64, tid); GFENCE; }
    else if (hasnext) { aln.template fetch<BM>(g.ra1, (kt + 3 - KT) * 64, tid); fetch_b(g.rb1, Btn, ldbn, (kt + 3 - KT) * 64, tid); GFENCE; }
    gemm_compute<BM, KSU>(As0, Bs0, wm, wn, r, h, acc);
    __syncthreads();
    if (kt + 2 < KT) { al.template commit<BM>(g.ra0, As0, tid); commit_b(g.rb0, Bs0, tid); GFENCE; }
    else if (hasnext) { aln.template commit<BM>(g.ra0, As0, tid); commit_b(g.rb0, Bs0, tid); GFENCE; }
    if (kt + 4 < KT) { al.template fetch<BM>(g.ra0, (kt + 4) * 64, tid); fetch_b(g.rb0, Bt, ldb, (kt + 4) * 64, tid); GFENCE; }
    else if (hasnext) { aln.template fetch<BM>(g.ra0, (kt + 4 - KT) * 64, tid); fetch_b(g.rb0, Btn, ldbn, (kt + 4 - KT) * 64, tid); GFENCE; }
    gemm_compute<BM, KSU>(As1, Bs1, wm, wn, r, h, acc);
    __syncthreads();
  }
}

template <int BM, class AL, int KSU = 4, int K = 1024>
DI void gemm_tile(const AL& al, const u16* __restrict__ Bt, int ldb, char* smem, f32x16 (&acc)[BM / 128][2]) {
  GemmRegs<BM> g;
  gemm_prime<BM>(g, al, Bt, ldb, smem);
  gemm_run<BM, AL, KSU, K, AL>(g, al, Bt, ldb, al, Bt, ldb, false, smem, acc);
}

DI void phase0(const Params& p, char* smem) {
  const int tid = my_tid(), lane = tid & 63, wid = tid >> 6, bid = blockIdx.x, nb = gridDim.x;
  float* sm = (float*)smem;
  {
    float* PKW = (float*)(p.ws + OFF_PK);
    const int gt = bid * NT + tid, gn = nb * NT;
#define PKCP(src, off, cnt) for (int i = gt; i < (cnt); i += gn) PKW[(off) + i] = (src)[i];
    PKCP(p.wa_f, PK_WAF, 8192) PKCP(p.ba_f, PK_BAF, 512) PKCP(p.wa_b, PK_WAB, 8192) PKCP(p.ba_b, PK_BAB, 512)
    PKCP(p.gla_norm, PK_GN, 256) PKCP(p.qnorm, PK_QN, 128) PKCP(p.knorm, PK_KN, 128) PKCP(p.conv_w, PK_CW, 9216)
    PKCP(p.conv_b, PK_CB, 3072) PKCP(p.skip, PK_SK, 2048) PKCP(p.final_norm, PK_FN, 1024) PKCP(p.f3_w, PK_F3, 262144)
#undef PKCP
  }
  float* mod = (float*)(p.ws + OFF_MOD);
  for (int task = bid; task < 96; task += nb) {
    const int l = task / 48, cb = task % 48, col = cb * 64 + lane;
    const float* W = p.w_ada + (size_t)l * 1024 * 3072;
    float a0 = 0.f, a1 = 0.f, a2 = 0.f;
#pragma unroll 8
    for (int k = wid * 128; k < wid * 128 + 128; ++k) {
      float wv = W[(size_t)k * 3072 + col];
      a0 += silu_f(p.c[k]) * wv; a1 += silu_f(p.c[1024 + k]) * wv; a2 += silu_f(p.c_ctx[k]) * wv;
    }
    __syncthreads();
    sm[(wid * 3 + 0) * 64 + lane] = a0; sm[(wid * 3 + 1) * 64 + lane] = a1; sm[(wid * 3 + 2) * 64 + lane] = a2;
    __syncthreads();
    if (tid < 192) {
      int v = tid >> 6; float s = p.b_ada[l * 3072 + col];
      for (int w = 0; w < 8; ++w) s += sm[(w * 3 + v) * 64 + lane];
      mod[(l * 3 + v) * 3072 + col] = s;
    }
    __syncthreads();
  }
  for (int it = bid; it < (2 * TB) / 8; it += nb) {
    const int gr = it * 8 + wid, l = gr / TB, rr = gr - l * TB;
    const bool lat = rr < L; const int t = lat ? rr : rr - L; const int Lq = lat ? L : LC;
    float* em = sm + wid * 104; float* h1 = em + 40;
    __syncthreads();
    if (lane < 33) {
      float v;
      if (lane == 0) v = (float)t / (float)(Lq - 1);
      else {
        int bi = (lane - 1) & 15; float fr = 1e-4f + (float)bi * ((15.f - 1e-4f) / 15.f);
        float w = 6.283185307179586f * (float)t / (float)Lq;
        v = (lane <= 16) ? cosf(fr * w) : -sinf(fr * w);
      }
      em[lane] = v;
    }
    __syncthreads();
    {
      float a = p.f1_b[l * 64 + lane];
      for (int e = 0; e < 33; ++e) a += em[e] * p.f1_w[(l * 33 + e) * 64 + lane];
      h1[lane] = sinf(p.f1_freq[l * 64 + lane] * a);
    }
    __syncthreads();
    {
      float a = p.f2_b[l * 64 + lane];
      for (int i = 0; i < 64; ++i) a += h1[i] * p.f2_w[(l * 64 + i) * 64 + lane];
      float v = sinf(p.f2_freq[l * 64 + lane] * a);
      if (lat) ((u16*)(p.ws + OFF_H2T))[((size_t)l * 64 + lane) * L + t] = f2bf(v);
      else ((float*)(p.ws + OFF_H2C))[((size_t)l * 256 + t) * 64 + lane] = v;
    }
  }
  __syncthreads();
  {
    constexpr int T_IN = 16 * 249, T_BR = 8 * 32, T_OUT = 16 * 32, T_LAYER = T_IN + 3 * T_BR + T_OUT;
    auto decode = [&](int task, const float*& src, u16*& dst, int& K, int& N, int& k0, int& n0) {
      const int l = task / T_LAYER; int tt = task - l * T_LAYER;
      char* wt = p.ws + OFF_WT + (size_t)l * WT_LAYER;
      int kt, ntile;
      if (tt < T_IN) { src = p.w_in + (size_t)l * 1024 * NIN; dst = (u16*)wt; K = 1024; N = NIN; kt = tt / 249; ntile = tt % 249; }
      else if (tt < T_IN + 3 * T_BR) {
        tt -= T_IN; const int br = tt / T_BR; tt -= br * T_BR;
        src = (br == 0 ? p.w_g : (br == 1 ? p.w_a : p.w_h)) + (size_t)l * 512 * 1024; dst = (u16*)(wt + WT_IN + br * WT_BR);
        K = 512; N = 1024; kt = tt / 32; ntile = tt % 32;
      } else { tt -= T_IN + 3 * T_BR; src = p.w_o + (size_t)l * 1024 * 1024; dst = (u16*)(wt + WT_IN + 3 * WT_BR); K = 1024; N = 1024; kt = tt / 32; ntile = tt % 32; }
      k0 = kt * 64; n0 = ntile * 32;
    };
    float* tileA = sm;
    float* tileB = sm + 64 * 33;
    for (int task = bid; task < 2 * T_LAYER; task += 2 * nb) {
      const bool hasB = task + nb < 2 * T_LAYER;
      const float *sa, *sb = nullptr; u16 *da, *db = nullptr; int Ka, Na, k0a, n0a, Kb = 0, Nb = 0, k0b = 0, n0b = 0;
      decode(task, sa, da, Ka, Na, k0a, n0a);
      if (hasB) decode(task + nb, sb, db, Kb, Nb, k0b, n0b);
      float va[4], vb[4];
#pragma unroll
      for (int i = 0; i < 4; ++i) { const int kk = (tid >> 5) + 16 * i, nn = tid & 31; va[i] = sa[(size_t)(k0a + kk) * Na + n0a + nn]; vb[i] = hasB ? sb[(size_t)(k0b + kk) * Nb + n0b + nn] : 0.f; }
#pragma unroll
      for (int i = 0; i < 4; ++i) { const int kk = (tid >> 5) + 16 * i, nn = tid & 31; tileA[kk * 33 + nn] = va[i]; tileB[kk * 33 + nn] = vb[i]; }
      __syncthreads();
#pragma unroll
      for (int i = 0; i < 4; ++i) {
        const int nn = (tid >> 6) + 8 * i, kk = tid & 63;
        da[(size_t)(n0a + nn) * Ka + k0a + kk] = f2bf(tileA[kk * 33 + nn]);
        if (hasB) db[(size_t)(n0b + nn) * Kb + k0b + kk] = f2bf(tileB[kk * 33 + nn]);
      }
      __syncthreads();
    }
  }
}

DI void phase_norm(const Params& p, int l) {
  const int tid = my_tid(), lane = tid & 63, wid = tid >> 6;
  const float* mod = (const float*)(p.ws + OFF_MOD);
  u16* H = (u16*)(p.ws + OFF_H);
  for (int row = blockIdx.x * 8 + wid; row < R; row += gridDim.x * 8) {
    const float* src = xrow_in(p, l, row);
    const float* mv = mod + (l * 3 + modvec_of(row)) * 3072;
    float4 xv[4]; float ss = 0.f;
#pragma unroll
    for (int i = 0; i < 4; ++i) { xv[i] = *(const float4*)(src + (i * 64 + lane) * 4); ss += xv[i].x * xv[i].x + xv[i].y * xv[i].y + xv[i].z * xv[i].z + xv[i].w * xv[i].w; }
    ss = wave_sum(ss);
    const float rs = rsqrtf(ss * (1.f / 1024.f) + EPS);
#pragma unroll
    for (int i = 0; i < 4; ++i) {
      const int col = (i * 64 + lane) * 4;
      float4 sh = *(const float4*)(mv + col), sc = *(const float4*)(mv + 1024 + col);
      u32x2 o;
      o.x = pack2(xv[i].x * rs * (1.f + sc.x) + sh.x, xv[i].y * rs * (1.f + sc.y) + sh.y);
      o.y = pack2(xv[i].z * rs * (1.f + sc.z) + sh.z, xv[i].w * rs * (1.f + sc.w) + sh.w);
      *(u32x2*)(H + (size_t)row * 1024 + col) = o;
    }
  }
}

DI void phase_proj(const Params& p, int l, char* smem) {
  const int tid = my_tid(), lane = tid & 63, wid = tid >> 6, r = lane & 31, h = lane >> 5, wm = wid & 3, wn = wid >> 2;
  const u16* H = (const u16*)(p.ws + OFF_H);
  const u16* WT = (const u16*)(p.ws + OFF_WT + (size_t)l * WT_LAYER);
  u16* P = (u16*)(p.ws + OFF_P);
  u16* CT = (u16*)(p.ws + OFF_CT);
  u16* Tt = (u16*)smem;
  constexpr int LDE = 260;
  const int xcd = blockIdx.x & 7, nloc = gridDim.x >> 3;
  for (int q = blockIdx.x >> 3; q < 5 * 156; q += nloc) {
    const int g = q / 156, rem = q - g * 156, nt = rem >> 2, mt = (g * 4 + (rem & 3)) * 8 + xcd;
    if (mt >= 130) continue;
    const int m0 = mt * 256, n0 = nt * 128;
    f32x16 acc[2][2];
#pragma unroll
    for (int i = 0; i < 2; ++i) for (int j = 0; j < 2; ++j) acc[i][j] = zero16();
    ALoadN al{H + (size_t)m0 * 1024, 1024};
    gemm_tile<256, ALoadN, 4, 1024>(al, WT + (size_t)n0 * 1024, 1024, smem, acc);
    const int b = m0 / TB, tk0 = m0 - b * TB;
#pragma unroll
    for (int i = 0; i < 2; ++i)
#pragma unroll
      for (int j = 0; j < 2; ++j)
#pragma unroll
        for (int g4 = 0; g4 < 4; ++g4) {
          u32x2 o; o.x = pack2(acc[i][j][4 * g4], acc[i][j][4 * g4 + 1]); o.y = pack2(acc[i][j][4 * g4 + 2], acc[i][j][4 * g4 + 3]);
          *(u32x2*)(Tt + (wn * 64 + j * 32 + r) * LDE + wm * 64 + i * 32 + 8 * g4 + 4 * h) = o;
        }
    __syncthreads();
#pragma unroll 1
    for (int cg = 0; cg < 4; ++cg) {
      const int cb = n0 + cg * 32;
      if (cb >= 4896) continue;
      bool chan; int cm;
      if (cb < 512) { chan = false; cm = cb; }
      else if (cb < 1024) { chan = true; cm = CH_GV + cb - 512; }
      else if (cb < 2208) { chan = false; cm = cb - 512; }
      else if (cb < 2336) { chan = true; cm = CH_AV + cb - 2208; }
      else if (cb < 2848) { chan = false; cm = cb - 640; }
      else { chan = true; cm = cb - 2848; }
      if (chan) {
#pragma unroll
        for (int k = 0; k < 2; ++k) {
          const int idx = tid + NT * k, ch = idx >> 5, t8 = idx & 31;
          const u16* sp = Tt + (cg * 32 + ch) * LDE + t8 * 8;
          const u32x2 lo = *(const u32x2*)sp, hi = *(const u32x2*)(sp + 4);
          __builtin_nontemporal_store(u32x4{lo.x, lo.y, hi.x, hi.y}, (u32x4*)(CT + ((size_t)(cm + ch) * 2 + b) * TB + tk0 + t8 * 8));
        }
      } else {
#pragma unroll
        for (int k = 0; k < 2; ++k) {
          const int idx = tid + NT * k, row = idx >> 2, c8 = idx & 3;
          const u16* sp = Tt + (cg * 32 + c8 * 8) * LDE + row;
          u32x4 o;
          o.x = (unsigned)sp[0] | ((unsigned)sp[LDE] << 16); o.y = (unsigned)sp[2 * LDE] | ((unsigned)sp[3 * LDE] << 16);
          o.z = (unsigned)sp[4 * LDE] | ((unsigned)sp[5 * LDE] << 16); o.w = (unsigned)sp[6 * LDE] | ((unsigned)sp[7 * LDE] << 16);
          __builtin_nontemporal_store(o, (u32x4*)(P + (size_t)(m0 + row) * NP + cm + c8 * 8));
        }
      }
    }
  }
}

DI void attn_prep(const Params& p, int l, int dry) {
  const int tid = my_tid(), lane = tid & 63, wid = tid >> 6;
  u16* P = (u16*)(p.ws + OFF_P);
  const float gq = pk(p, PK_QN)[l * 64 + lane], gk = pk(p, PK_KN)[l * 64 + lane];
  for (int row = blockIdx.x * 8 + wid; row < R; row += gridDim.x * 8) {
    u16* Pr = P + (size_t)row * NP;
    const int b = row / TB, tk = row - b * TB;
    float cs = 1.f, sn = 0.f;
    if (tk >= LC) {
      const int t = tk - LC, pi = lane >> 1;
      const float pos = (pi < 16) ? (float)(t >> 6) : (float)(t & 63);
      const float inv = powf(10000.f, -(float)(2 * (pi & 15)) / 32.f);
      sincosf(pos * inv, &sn, &cs);
    }
#pragma unroll
    for (int hd = 0; hd < 10; ++hd) {
      const int col = (hd < 8) ? PC_AQ + hd * 64 + lane : PC_AK + (hd - 8) * 64 + lane;
      float v = bf2f(Pr[col]);
      const float ss = wave_sum(v * v);
      v = v * rsqrtf(ss * (1.f / 64.f) + EPS) * (hd < 8 ? gq : gk);
      const float pv = __shfl_xor(v, 1);
      float o = (lane & 1) ? (pv * sn + v * cs) : (v * cs - pv * sn);
      if (hd < 8) o *= 0.125f * 1.4426950408889634f;
      if (!dry) Pr[col] = f2bf(o);
    }
  }
}

DI void fft_pass4_fwd(float2* X, int tid, int h2) {
  const float inv4 = 0.25f / (float)h2;
#pragma unroll 2
  for (int i = 0; i < 8; ++i) {
    const int g = tid + NT * i, jp = g & (h2 - 1), base = ((g - jp) << 2) + jp;
    float2 e0 = X[base], e1 = X[base + h2], e2 = X[base + 2 * h2], e3 = X[base + 3 * h2];
    const float fr = (float)jp * inv4;
    const float2 T1 = make_float2(__builtin_amdgcn_cosf(fr), -__builtin_amdgcn_sinf(fr));
    const float2 T2 = cmul(T1, T1);
    float2 a0 = cadd(e0, e2), a2 = cmul(csub(e0, e2), T1);
    float2 a1 = cadd(e1, e3), d13 = cmul(csub(e1, e3), T1);
    float2 a3 = make_float2(d13.y, -d13.x);
    X[base] = cadd(a0, a1); X[base + h2] = cmul(csub(a0, a1), T2);
    X[base + 2 * h2] = cadd(a2, a3); X[base + 3 * h2] = cmul(csub(a2, a3), T2);
  }
  __syncthreads();
}
DI void fft_pass4_inv(float2* X, int tid, int h1) {
  const float inv4 = 0.25f / (float)h1;
#pragma unroll 2
  for (int i = 0; i < 8; ++i) {
    const int g = tid + NT * i, jp = g & (h1 - 1), base = ((g - jp) << 2) + jp;
    float2 e0 = X[base], e1 = X[base + h1], e2 = X[base + 2 * h1], e3 = X[base + 3 * h1];
    const float fr = (float)jp * inv4;
    const float2 V = make_float2(__builtin_amdgcn_cosf(fr), __builtin_amdgcn_sinf(fr));
    const float2 Wc = cmul(V, V);
    float2 t1 = cmul(e1, Wc), t3 = cmul(e3, Wc);
    float2 a0 = cadd(e0, t1), a1 = csub(e0, t1), a2 = cadd(e2, t3), a3 = csub(e2, t3);
    float2 u2 = cmul(a2, V), u3 = cmul(a3, V);
    u3 = make_float2(-u3.y, u3.x);
    X[base] = cadd(a0, u2); X[base + 2 * h1] = csub(a0, u2);
    X[base + h1] = cadd(a1, u3); X[base + 3 * h1] = csub(a1, u3);
  }
  __syncthreads();
}
DI constexpr float r16c(int k) { return k == 0 ? 1.f : k == 1 ? 0.9238795325112867f : k == 2 ? 0.7071067811865476f : k == 3 ? 0.3826834323650898f : k == 4 ? 0.f : k == 5 ? -0.3826834323650898f : k == 6 ? -0.7071067811865476f : -0.9238795325112867f; }
DI constexpr float r16s(int k) { return k == 0 ? 0.f : k == 1 ? 0.3826834323650898f : k == 2 ? 0.7071067811865476f : k == 3 ? 0.9238795325112867f : k == 4 ? 1.f : k == 5 ? 0.9238795325112867f : k == 6 ? 0.7071067811865476f : 0.3826834323650898f; }
template <bool INV>
DI void fft_pass16(float2* X, int tid, int q) {
  const float invq = 1.f / (16.f * (float)q);
#pragma unroll 1
  for (int it = 0; it < 2; ++it) {
    const int g = tid + NT * it, jp = g & (q - 1), base = ((g - jp) << 4) + jp;
    float vx[16], vy[16];
#pragma unroll
    for (int r = 0; r < 16; ++r) { const float2 e = X[base + r * q]; vx[r] = e.x; vy[r] = e.y; }
    const float th = (float)jp * invq;
    float bx[4], by[4];
    bx[0] = __builtin_amdgcn_cosf(th); by[0] = INV ? __builtin_amdgcn_sinf(th) : -__builtin_amdgcn_sinf(th);
#pragma unroll
    for (int s = 1; s < 4; ++s) { bx[s] = bx[s - 1] * bx[s - 1] - by[s - 1] * by[s - 1]; by[s] = 2.f * bx[s - 1] * by[s - 1]; }
#pragma unroll
    for (int ss = 0; ss < 4; ++ss) {
      const int s = INV ? 3 - ss : ss;
      const int rs = 8 >> s;
#pragma unroll
      for (int bf = 0; bf < 8; ++bf) {
        const int r = ((bf & ~(rs - 1)) << 1) | (bf & (rs - 1));
        const int k = (r & (rs - 1)) * (8 / rs);
        const float cc = r16c(k), cs = INV ? r16s(k) : -r16s(k);
        const float tx = bx[s] * cc - by[s] * cs, ty = bx[s] * cs + by[s] * cc;
        const float ax = vx[r], ay = vy[r], cx = vx[r + rs], cy = vy[r + rs];
        if (!INV) {
          const float dx = ax - cx, dy = ay - cy;
          vx[r] = ax + cx; vy[r] = ay + cy;
          vx[r + rs] = dx * tx - dy * ty; vy[r + rs] = dx * ty + dy * tx;
        } else {
          const float ux = cx * tx - cy * ty, uy = cx * ty + cy * tx;
          vx[r] = ax + ux; vy[r] = ay + uy;
          vx[r + rs] = ax - ux; vy[r + rs] = ay - uy;
        }
      }
    }
#pragma unroll
    for (int r = 0; r < 16; ++r) X[base + r * q] = make_float2(vx[r], vy[r]);
  }
  __syncthreads();
}
DI void fft_fwd(float2* X, int tid) {
#pragma unroll 1
  for (int q = 1024; q >= 4; q >>= 4) fft_pass16<false>(X, tid, q);
  fft_pass4_fwd(X, tid, 1);
}
DI void fft_inv(float2* X, int tid) {
  fft_pass4_inv(X, tid, 1);
#pragma unroll 1
  for (int q = 4; q <= 1024; q <<= 4) fft_pass16<true>(X, tid, q);
}
DI float sconv_at(const u16* src, int t, int len, float w0, float w1, float w2, float bb) {
  float ym = t > 0 ? bf2f(src[t - 1]) : 0.f, y0 = bf2f(src[t]), yp = t < len - 1 ? bf2f(src[t + 1]) : 0.f;
  return bb + w0 * ym + w1 * y0 + w2 * yp;
}
DI float hy_delta(int col) {
  const float A0 = -4.605170185988091f / 0.3f, A1 = -4.605170185988091f / 1.5f;
  return fabsf(A0 + (A1 - A0) * ((float)col / 2047.f));
}

DI void hyena_latent_task(const Params& p, int l, int c, char* smem, int dry) {
  float2* X = (float2*)smem;
  float* red = (float*)(smem + 131072);
  const int tid = my_tid(), lane = tid & 63, wid = tid >> 6;
  u16* CT = (u16*)(p.ws + OFF_CT);
  float2* FE = (float2*)(p.ws + OFF_FS + (size_t)blockIdx.x * 262144);
  float2* FO = FE + 16384;
  const unsigned* h2T = (const unsigned*)(p.ws + OFF_H2T) + (size_t)l * 64 * (L / 2);
  const float* f3w = pk(p, PK_F3) + (size_t)l * 64 * 2048;
  const float* cw = pk(p, PK_CW) + (size_t)l * 3 * 1536;
  const float* cbv = pk(p, PK_CB) + (size_t)l * 1536;
  const float vw0 = cw[c], vw1 = cw[1536 + c], vw2 = cw[3072 + c], vbb = cbv[c];
  const u16* v0 = CT + ((size_t)(CH_YU + c) * 2 + 0) * TB + LC;
  const u16* v1 = CT + ((size_t)(CH_YU + c) * 2 + 1) * TB + LC;
  u16* z10 = CT + ((size_t)(CH_YU + 512 + c) * 2 + 0) * TB + LC;
  u16* z11 = CT + ((size_t)(CH_YU + 512 + c) * 2 + 1) * TB + LC;
#pragma unroll 1
  for (int o = 0; o < 2; ++o) {
    const int cf = o * 1024 + c, cbk = cf + 512;
    float sf = 0.f, sb = 0.f;
    __syncthreads();
#ifdef PROBE_FFT
    fft_fwd(X, tid); fft_inv(X, tid);
#endif
#pragma unroll 1
    for (int half = 0; half < 2; ++half) {
      float af[16], ab[16];
#pragma unroll
      for (int i = 0; i < 16; ++i) { af[i] = 0.f; ab[i] = 0.f; }
#pragma unroll 1
      for (int j = 0; j < 64; j += 2) {
        const float wf0 = f3w[j * 2048 + cf], wb0 = f3w[j * 2048 + cbk], wf1 = f3w[(j + 1) * 2048 + cf], wb1 = f3w[(j + 1) * 2048 + cbk];
        const unsigned* hrow = h2T + (size_t)j * (L / 2) + tid + half * 8 * NT;
        unsigned w0[8], w1[8];
#pragma unroll
        for (int i = 0; i < 8; ++i) { w0[i] = hrow[NT * i]; w1[i] = hrow[L / 2 + NT * i]; }
#pragma unroll
        for (int i = 0; i < 8; ++i) {
          const float a0 = bflo(w0[i]), a1 = bfhi(w0[i]), b0 = bflo(w1[i]), b1 = bfhi(w1[i]);
          af[2 * i] += a0 * wf0 + b0 * wf1; af[2 * i + 1] += a1 * wf0 + b1 * wf1;
          ab[2 * i] += a0 * wb0 + b0 * wb1; ab[2 * i + 1] += a1 * wb0 + b1 * wb1;
        }
      }
      const float df = hy_delta(cf), db = hy_delta(cbk);
#pragma unroll
      for (int i = 0; i < 16; ++i) {
        const int t = 2 * (tid + NT * ((i >> 1) + half * 8)) + (i & 1); const float tt = (float)t / (float)(L - 1);
        const float vf = af[i] * (__expf(-tt * df) + 0.05f), vb = ab[i] * (__expf(-tt * db) + 0.05f);
        sf += fabsf(vf); sb += fabsf(vb);
        X[t].x = vf;
        if (t >= 1) X[L - t].y = vb; else X[0].y = 0.f;
      }
    }
    sf = wave_sum(sf); sb = wave_sum(sb);
    if (lane == 0) { red[wid] = sf; red[8 + wid] = sb; }
    __syncthreads();
    float nf = 0.f, nbk = 0.f;
#pragma unroll
    for (int w = 0; w < 8; ++w) { nf += red[w]; nbk += red[8 + w]; }
    const float inv_f = 1.f / nf, inv_b = 1.f / nbk;
#pragma unroll 8
    for (int i = 0; i < 32; ++i) { const int n = tid + NT * i; const float2 s = X[n]; FO[n] = s; X[n] = make_float2(s.x * inv_f + s.y * inv_b, 0.f); }
    __syncthreads();
    fft_fwd(X, tid);
#pragma unroll 8
    for (int i = 0; i < 32; ++i) { const int n = tid + NT * i; FE[n] = X[n]; }
    __syncthreads();
#pragma unroll 8
    for (int i = 0; i < 32; ++i) {
      const int n = tid + NT * i; const float2 s = FO[n]; const float dd = s.x * inv_f - s.y * inv_b; const float fr = (float)n * (1.f / 32768.f);
      X[n] = make_float2(dd * __builtin_amdgcn_cosf(fr), -dd * __builtin_amdgcn_sinf(fr));
    }
    __syncthreads();
    fft_fwd(X, tid);
#pragma unroll 8
    for (int i = 0; i < 32; ++i) { const int n = tid + NT * i; FO[n] = X[n]; }
    __syncthreads();
#pragma unroll 8
    for (int i = 0; i < 32; ++i) {
      const int n = tid + NT * i;
      float2 zz;
      if (o == 0) { zz.x = sconv_at(v0, n, L, vw0, vw1, vw2, vbb); zz.y = sconv_at(v1, n, L, vw0, vw1, vw2, vbb); }
      else { zz.x = bf2f(z10[n]); zz.y = bf2f(z11[n]); }
      X[n] = zz;
    }
    __syncthreads();
    fft_fwd(X, tid);
#pragma unroll 8
    for (int i = 0; i < 32; ++i) { const int n = tid + NT * i; X[n] = cmul(X[n], FE[n]); }
    __syncthreads();
    fft_inv(X, tid);
#pragma unroll 8
    for (int i = 0; i < 32; ++i) { const int n = tid + NT * i; FE[n] = X[n]; }
    __syncthreads();
#pragma unroll 8
    for (int i = 0; i < 32; ++i) {
      const int n = tid + NT * i; const float fr = (float)n * (1.f / 32768.f);
      float2 zz;
      if (o == 0) { zz.x = sconv_at(v0, n, L, vw0, vw1, vw2, vbb); zz.y = sconv_at(v1, n, L, vw0, vw1, vw2, vbb); }
      else { zz.x = bf2f(z10[n]); zz.y = bf2f(z11[n]); }
      X[n] = cmul(zz, make_float2(__builtin_amdgcn_cosf(fr), -__builtin_amdgcn_sinf(fr)));
    }
    __syncthreads();
    fft_fwd(X, tid);
#pragma unroll 8
    for (int i = 0; i < 32; ++i) { const int n = tid + NT * i; X[n] = cmul(X[n], FO[n]); }
    __syncthreads();
    fft_inv(X, tid);
    {
      const int gch = CH_YU + 512 * (o + 1) + c;
      const float w0 = cw[gch], w1 = cw[1536 + gch], w2 = cw[3072 + gch], bb = cbv[gch];
      const u16* s0 = CT + ((size_t)gch * 2 + 0) * TB + LC;
      const u16* s1 = CT + ((size_t)gch * 2 + 1) * TB + LC;
      const float sk = pk(p, PK_SK)[(l * 2 + o) * 512 + c];
#pragma unroll 8
      for (int i = 0; i < 32; ++i) {
        const int n = tid + NT * i; const float fr = (float)n * (1.f / 32768.f);
        const float2 wb = cmul(X[n], make_float2(__builtin_amdgcn_cosf(fr), __builtin_amdgcn_sinf(fr)));
        const float2 A = FE[n];
        const float yr = (A.x + wb.x) * (1.f / 32768.f), yi = (A.y + wb.y) * (1.f / 32768.f);
        const float g0 = sconv_at(s0, n, L, w0, w1, w2, bb), g1 = sconv_at(s1, n, L, w0, w1, w2, bb);
        float2 zz;
        if (o == 0) { zz.x = sconv_at(v0, n, L, vw0, vw1, vw2, vbb); zz.y = sconv_at(v1, n, L, vw0, vw1, vw2, vbb); }
        else { zz.x = bf2f(z10[n]); zz.y = bf2f(z11[n]); }
        X[n] = make_float2(g0 * (yr + sk * zz.x), g1 * (yi + sk * zz.y));
      }
    }
    __syncthreads();
    if (o == 0) {
#pragma unroll 8
      for (int i = 0; i < 32; ++i) { const int n = tid + NT * i; const float2 zz = X[n]; if (!dry) { z10[n] = f2bf(zz.x); z11[n] = f2bf(zz.y); } }
    } else {
      u16* d0 = CT + ((size_t)(CH_YZ + c) * 2 + 0) * TB + LC;
      u16* d1 = CT + ((size_t)(CH_YZ + c) * 2 + 1) * TB + LC;
#pragma unroll 1
      for (int ib = 0; ib < 32; ib += 8) {
        u16 g0[8], g1[8];
#pragma unroll
        for (int i = 0; i < 8; ++i) { const int n = tid + NT * (ib + i); g0[i] = d0[n]; g1[i] = d1[n]; }
#pragma unroll
        for (int i = 0; i < 8; ++i) {
          const int n = tid + NT * (ib + i); const float2 zz = X[n];
          const u16 q0 = f2bf(zz.x * silu_f(bf2f(g0[i]))), q1 = f2bf(zz.y * silu_f(bf2f(g1[i])));
          if (!dry) { d0[n] = q0; d1[n] = q1; }
        }
      }
    }
    __syncthreads();
  }
}

DI void hyena_ctx_task(const Params& p, int l, int c, char* smem, int dry) {
  float* filt = (float*)smem;
  float* zs = filt + 1024;
  float* nrm = zs + 1024;
  const int tid = my_tid(), lane = tid & 63, wid = tid >> 6, t = tid & 255, hb = tid >> 8;
  u16* CT = (u16*)(p.ws + OFF_CT);
  const float* h2c = (const float*)(p.ws + OFF_H2C) + (size_t)l * 256 * 64;
  const float* f3w = pk(p, PK_F3) + (size_t)l * 64 * 2048;
  const float* cw = pk(p, PK_CW) + (size_t)l * 3 * 1536;
  const float* cbv = pk(p, PK_CB) + (size_t)l * 1536;
  __syncthreads();
  {
    const int cf = hb * 1024 + c, cbk = cf + 512;
    float a_f = 0.f, a_b = 0.f;
    for (int j = 0; j < 64; ++j) { const float hv = h2c[t * 64 + j]; a_f += hv * f3w[j * 2048 + cf]; a_b += hv * f3w[j * 2048 + cbk]; }
    const float tt = (float)t / 255.f;
    filt[(hb * 2 + 0) * 256 + t] = a_f * (__expf(-tt * hy_delta(cf)) + 0.05f);
    filt[(hb * 2 + 1) * 256 + t] = a_b * (__expf(-tt * hy_delta(cbk)) + 0.05f);
    const u16* src = CT + ((size_t)(CH_YU + c) * 2 + hb) * TB;
    zs[hb * 256 + t] = sconv_at(src, t, LC, cw[c], cw[1536 + c], cw[3072 + c], cbv[c]);
  }
  __syncthreads();
  if (wid < 4) {
    float s = 0.f;
    for (int k = 0; k < 4; ++k) s += fabsf(filt[wid * 256 + lane + 64 * k]);
    s = wave_sum(s);
    if (lane == 0) nrm[wid] = s;
  }
  __syncthreads();
  const int b = hb;
  for (int o = 0; o < 2; ++o) {
    const float inf_ = 1.f / nrm[o * 2], inb_ = 1.f / nrm[o * 2 + 1];
    const float* hf = filt + (o * 2) * 256; const float* hbk = filt + (o * 2 + 1) * 256;
    const float* zc = zs + (o & 1) * 512 + b * 256;
    float accf = 0.f, accb = 0.f;
    for (int s = 0; s <= t; ++s) accf += hf[t - s] * zc[s];
    for (int s = t + 1; s < 256; ++s) accb += hbk[s - t] * zc[s];
    const int gch = CH_YU + 512 * (o + 1) + c;
    const float gate = sconv_at(CT + ((size_t)gch * 2 + b) * TB, t, LC, cw[gch], cw[1536 + gch], cw[3072 + gch], cbv[gch]);
    const float zn = gate * (accf * inf_ + accb * inb_ + pk(p, PK_SK)[(l * 2 + o) * 512 + c] * zc[t]);
    zs[((o + 1) & 1) * 512 + b * 256 + t] = zn;
    __syncthreads();
  }
  {
    u16* d = CT + ((size_t)(CH_YZ + c) * 2 + b) * TB;
    const u16 q0 = f2bf(zs[b * 256 + t] * silu_f(bf2f(d[t])));
    if (!dry) d[t] = q0;
  }
  __syncthreads();
}

DI void gla_bcum(const Params& p, int l, int row0, int hh, int dir, float* gs, float* segs, float* was, float* as_) {
  const int tid = my_tid();
  const u16* P = (const u16*)(p.ws + OFF_P);
  const float* wa = pk(p, dir ? PK_WAB : PK_WAF) + (size_t)l * 16 * 256 + hh * 64;
  const float* ba = pk(p, dir ? PK_BAB : PK_BAF) + l * 256 + hh * 64;
#pragma unroll
  for (int i = 0; i < 2; ++i) {
    const int idx = tid + NT * i;
    was[idx] = wa[(idx >> 6) * 256 + (idx & 63)];
    as_[(idx >> 4) * 17 + (idx & 15)] = bf2f(P[(size_t)(row0 + (idx >> 4)) * NP + PC_AF + dir * 16 + (idx & 15)]);
  }
  __syncthreads();
  {
    const int t = tid >> 3, d0 = (tid & 7) * 8;
    float lin[8];
#pragma unroll
    for (int e = 0; e < 8; ++e) lin[e] = ba[d0 + e];
#pragma unroll 2
    for (int rr = 0; rr < 16; ++rr) {
      const float av = as_[t * 17 + rr];
      const float4 w0 = *(const float4*)(was + rr * 64 + d0), w1 = *(const float4*)(was + rr * 64 + d0 + 4);
      lin[0] += av * w0.x; lin[1] += av * w0.y; lin[2] += av * w0.z; lin[3] += av * w0.w;
      lin[4] += av * w1.x; lin[5] += av * w1.y; lin[6] += av * w1.z; lin[7] += av * w1.w;
    }
#pragma unroll
    for (int e = 0; e < 8; ++e) gs[t * 65 + d0 + e] = (fminf(lin[e], 0.f) - log1pf(__expf(-fabsf(lin[e])))) * (1.f / 16.f);
  }
  __syncthreads();
  {
    const int d = tid & 63, seg = tid >> 6;
    float v[8]; float run = 0.f;
#pragma unroll
    for (int e = 0; e < 8; ++e) { const int tt = dir ? seg * 8 + 7 - e : seg * 8 + e; run += gs[tt * 65 + d]; v[e] = run; }
    segs[seg * 64 + d] = run;
    __syncthreads();
    float off = 0.f;
#pragma unroll
    for (int s = 0; s < 8; ++s) { const bool before = dir ? (s > seg) : (s < seg); if (before) off += segs[s * 64 + d]; }
#pragma unroll
    for (int e = 0; e < 8; ++e) { const int tt = dir ? seg * 8 + 7 - e : seg * 8 + e; gs[tt * 65 + d] = v[e] + off; }
  }
  __syncthreads();
}
DI int gla_tok0(int dir, int n) {
  if (n < 4) return (dir ? 3 - n : n) * 64;
  return LC + (dir ? 255 - (n - 4) : n - 4) * 64;
}
constexpr int G_GS = 0;
constexpr int G_SEG = G_GS + 64 * 65 * 4;
constexpr int G_QS = G_SEG + 8 * 64 * 4;
constexpr int G_KS = G_QS + 64 * LDT * 2;
constexpr int G_VT = G_KS + 64 * LDT * 2;
constexpr int G_ST = G_VT + 128 * LDT * 2;
constexpr int G_RED = G_ST + 128 * LDT * 2;
constexpr int G_WA = G_RED + 8 * 32 * 4;
constexpr int G_AS = G_WA + 16 * 64 * 4;

DI void gla_g1_task(const Params& p, int l, int chain, int n, char* smem) {
  const int tid = my_tid(), lane = tid & 63, wid = tid >> 6, r = lane & 31, h = lane >> 5;
  const int b = chain >> 3, hh = (chain >> 1) & 3, dir = chain & 1;
  const int tk0 = gla_tok0(dir, n), row0 = b * TB + tk0;
  float* gs = (float*)(smem + G_GS); float* segs = (float*)(smem + G_SEG);
  u16* kT = (u16*)(smem + G_KS); u16* vT = (u16*)(smem + G_VT);
  const u16* P = (const u16*)(p.ws + OFF_P);
  const u16* CT = (const u16*)(p.ws + OFF_CT);
  __syncthreads();
  gla_bcum(p, l, row0, hh, dir, gs, segs, (float*)(smem + G_WA), (float*)(smem + G_AS));
  const int tl = dir ? 0 : 63;
  {
    const int t = tid >> 3, d0 = (tid & 7) * 8;
    const u32x4 kv = *(const u32x4*)(P + (size_t)(row0 + t) * NP + PC_GK + hh * 64 + d0);
    const unsigned w[4] = {kv.x, kv.y, kv.z, kv.w};
#pragma unroll
    for (int e = 0; e < 8; ++e) {
      const float kx = (e & 1) ? bfhi(w[e >> 1]) : bflo(w[e >> 1]);
      kT[(d0 + e) * LDT + t] = f2bf(kx * __expf(gs[tl * 65 + d0 + e] - gs[t * 65 + d0 + e]));
    }
#pragma unroll
    for (int i = 0; i < 2; ++i) {
      const int q = tid + NT * i, v = q >> 3, cc = q & 7;
      *(u32x4*)(vT + v * LDT + cc * 8) = *(const u32x4*)(CT + ((size_t)(CH_GV + hh * 128 + v) * 2 + b) * TB + tk0 + cc * 8);
    }
    if (tid < 64) ((float*)(p.ws + OFF_GD))[((size_t)chain * NCK + n) * 64 + tid] = __expf(gs[tl * 65 + tid]);
  }
  __syncthreads();
  {
    const int vm = wid >> 1, dn = wid & 1;
    f32x16 acc = zero16();
#pragma unroll
    for (int s = 0; s < 4; ++s) {
      const bf16x8 a = *(const bf16x8*)(vT + (vm * 32 + r) * LDT + s * 16 + h * 8);
      const bf16x8 bb = *(const bf16x8*)(kT + (dn * 32 + r) * LDT + s * 16 + h * 8);
      acc = MFMA(a, bb, acc);
    }
    u16* GS = (u16*)(p.ws + OFF_GS) + ((size_t)chain * NCK + n) * 8192;
#pragma unroll
    for (int reg = 0; reg < 16; ++reg) GS[(vm * 32 + crow(reg, h)) * 64 + dn * 32 + r] = f2bf(acc[reg]);
  }
}
DI void gla_g2(const Params& p, int dry) {
  u16* GSb = (u16*)(p.ws + OFF_GS);
  const float* GD = (const float*)(p.ws + OFF_GD);
  for (int gi = blockIdx.x * NT + my_tid(); gi < 16 * 8192; gi += gridDim.x * NT) {
    const int chain = gi >> 13, e = gi & 8191, d = e & 63;
    u16* ptr = GSb + (size_t)chain * NCK * 8192 + e;
    const float* dec = GD + (size_t)chain * NCK * 64 + d;
    float S = 0.f;
#pragma unroll 1
    for (int n0 = 0; n0 < NCK; n0 += 20) {
      float ds[20], a[20];
#pragma unroll
      for (int k = 0; k < 20; ++k) { ds[k] = bf2f(ptr[(size_t)(n0 + k) * 8192]); a[k] = dec[(n0 + k) * 64]; }
#pragma unroll
      for (int k = 0; k < 20; ++k) { if (!dry) ptr[(size_t)(n0 + k) * 8192] = f2bf(S); S = a[k] * S + ds[k]; }
    }
  }
}
DI void gla_g3_task(const Params& p, int l, int b, int hh, int ci, char* smem, int dry) {
  const int tid = my_tid(), lane = tid & 63, wid = tid >> 6, r = lane & 31, h = lane >> 5;
  const int tk0 = ci * 64, row0 = b * TB + tk0;
  float* gs = (float*)(smem + G_GS); float* segs = (float*)(smem + G_SEG); float* red = (float*)(smem + G_RED);
  u16* qs = (u16*)(smem + G_QS); u16* ks = (u16*)(smem + G_KS); u16* vT = (u16*)(smem + G_VT); u16* sT = (u16*)(smem + G_ST);
  u16* P = (u16*)(p.ws + OFF_P);
  const u16* CT = (const u16*)(p.ws + OFF_CT);
  const int vm = wid >> 1, in = wid & 1;
  f32x16 o = zero16();
  __syncthreads();
#pragma unroll 1
  for (int dir = 0; dir < 2; ++dir) {
    gla_bcum(p, l, row0, hh, dir, gs, segs, (float*)(smem + G_WA), (float*)(smem + G_AS));
    const int chain = b * 8 + hh * 2 + dir;
    const int n = dir ? ((ci < 4) ? 3 - ci : 263 - ci) : ci;
    {
      const int t = tid >> 3, d0 = (tid & 7) * 8;
      const u32x4 qv = *(const u32x4*)(P + (size_t)(row0 + t) * NP + PC_GQ + hh * 64 + d0);
      const u32x4 kv = *(const u32x4*)(P + (size_t)(row0 + t) * NP + PC_GK + hh * 64 + d0);
      const unsigned qw[4] = {qv.x, qv.y, qv.z, qv.w}, kw[4] = {kv.x, kv.y, kv.z, kv.w};
      unsigned qo[4], ko[4];
#pragma unroll
      for (int e = 0; e < 4; ++e) {
        const float b0 = gs[t * 65 + d0 + 2 * e], b1 = gs[t * 65 + d0 + 2 * e + 1];
        qo[e] = pack2(bflo(qw[e]) * 0.125f * __expf(b0), bfhi(qw[e]) * 0.125f * __expf(b1));
        ko[e] = pack2(bflo(kw[e]) * __expf(-b0), bfhi(kw[e]) * __expf(-b1));
      }
      *(u32x4*)(qs + t * LDT + d0) = u32x4{qo[0], qo[1], qo[2], qo[3]};
      *(u32x4*)(ks + t * LDT + d0) = u32x4{ko[0], ko[1], ko[2], ko[3]};
      const u16* GS = (const u16*)(p.ws + OFF_GS) + ((size_t)chain * NCK + n) * 8192;
#pragma unroll
      for (int i = 0; i < 2; ++i) {
        const int q = tid + NT * i, v = q >> 3, cc = q & 7;
        *(u32x4*)(sT + v * LDT + cc * 8) = *(const u32x4*)(GS + v * 64 + cc * 8);
        if (dir == 0) *(u32x4*)(vT + v * LDT + cc * 8) = *(const u32x4*)(CT + ((size_t)(CH_GV + hh * 128 + v) * 2 + b) * TB + tk0 + cc * 8);
      }
    }
    __syncthreads();
    bf16x8 qf[4];
#pragma unroll
    for (int s = 0; s < 4; ++s) qf[s] = *(const bf16x8*)(qs + (in * 32 + r) * LDT + s * 16 + h * 8);
#pragma unroll
    for (int jt = 0; jt < 2; ++jt) {
      f32x16 at = zero16();
#pragma unroll
      for (int s = 0; s < 4; ++s) at = MFMA(*(const bf16x8*)(ks + (jt * 32 + r) * LDT + s * 16 + h * 8), qf[s], at);
      const int ii = in * 32 + r;
#pragma unroll
      for (int reg = 0; reg < 16; ++reg) {
        const int jj = jt * 32 + crow(reg, h);
        const bool keep = dir ? (jj >= ii) : (jj <= ii);
        if (!keep) at[reg] = 0.f;
      }
#pragma unroll
      for (int s = 0; s < 2; ++s) {
        const u16* vp = vT + (vm * 32 + r) * LDT + jt * 32 + 16 * s + 4 * h;
        o = MFMA(ld2x64(vp, vp + 8), pack8(at, s), o);
      }
    }
#pragma unroll
    for (int s = 0; s < 4; ++s) o = MFMA(*(const bf16x8*)(sT + (vm * 32 + r) * LDT + s * 16 + h * 8), qf[s], o);
    __syncthreads();
  }
  float ss = 0.f;
#pragma unroll
  for (int reg = 0; reg < 16; ++reg) ss += o[reg] * o[reg];
  ss += __shfl_xor(ss, 32);
  if (h == 0) red[wid * 32 + r] = ss;
  __syncthreads();
  float tot = 0.f;
#pragma unroll
  for (int m = 0; m < 4; ++m) tot += red[(m * 2 + in) * 32 + r];
  const float rs = rsqrtf(tot * (1.f / 128.f) + EPS);
  u16* zp = P + (size_t)(row0 + in * 32 + r) * NP + PC_GZ + hh * 128 + vm * 32 + 4 * h;
  const float* gn = pk(p, PK_GN) + l * 128 + vm * 32 + 4 * h;
#pragma unroll
  for (int g = 0; g < 4; ++g) {
    const u32x2 zz = *(const u32x2*)(zp + 8 * g);
    const float4 gw = *(const float4*)(gn + 8 * g);
    u32x2 out;
    out.x = pack2(o[4 * g] * rs * gw.x * silu_f(bflo(zz.x)), o[4 * g + 1] * rs * gw.y * silu_f(bfhi(zz.x)));
    out.y = pack2(o[4 * g + 2] * rs * gw.z * silu_f(bflo(zz.y)), o[4 * g + 3] * rs * gw.w * silu_f(bfhi(zz.y)));
    if (!dry) *(u32x2*)(zp + 8 * g) = out;
  }
}

DI void attn_item(const Params& p, int l, int b, int g, int qtk0, int ntiles, char* smem, int dry) {
  const int tid = my_tid(), lane = tid & 63, wid = tid >> 6, r = lane & 31, h = lane >> 5;
  u16* P = (u16*)(p.ws + OFF_P);
  const u16* CT = (const u16*)(p.ws + OFF_CT);
  u16* Ks = (u16*)smem;
  u16* Vs = Ks + 2 * 64 * LDT;
  const int hq = g * 4 + (wid >> 1);
  const size_t qrow = (size_t)b * TB + qtk0 + (wid & 1) * 32 + r;
  bf16x8 qf[4];
#pragma unroll
  for (int s = 0; s < 4; ++s) qf[s] = *(const bf16x8*)(P + qrow * NP + PC_AQ + hq * 64 + s * 16 + h * 8);
  f32x16 O[2] = {zero16(), zero16()};
  float m = -1e30f, lsum = 0.f;
  const int lr = tid >> 3, lc = (tid & 7) * 8;
  const u16* kg = P + ((size_t)b * TB + lr) * NP + PC_AK + g * 64 + lc;
  const u16* vg = CT + ((size_t)(CH_AV + g * 64 + lr) * 2 + b) * TB + lc;
  u32x4 rk = *(const u32x4*)kg, rv = *(const u32x4*)vg;
  __syncthreads();
  *(u32x4*)(Ks + lr * LDT + lc) = rk; *(u32x4*)(Vs + lr * LDT + lc) = rv;
  __syncthreads();
  float gqm = fabsf(pk(p, PK_QN)[l * 64 + lane]), gkm = fabsf(pk(p, PK_KN)[l * 64 + lane]);
#pragma unroll
  for (int o = 32; o >= 1; o >>= 1) { gqm = fmaxf(gqm, __shfl_xor(gqm, o)); gkm = fmaxf(gkm, __shfl_xor(gkm, o)); }
  const float mshift = 8.2f * 1.4426950408889634f * gqm * gkm;
  if (mshift <= 60.f) {
    f32x16 sinit;
#pragma unroll
    for (int i = 0; i < 16; ++i) sinit[i] = -mshift;
#pragma unroll 1
    for (int kt = 0; kt < ntiles; ++kt) {
      const int cur = kt & 1;
      if (kt + 1 < ntiles) { rk = *(const u32x4*)(kg + (size_t)(kt + 1) * 64 * NP); rv = *(const u32x4*)(vg + (kt + 1) * 64); }
      const u16* Kc = Ks + cur * 64 * LDT; const u16* Vc = Vs + cur * 64 * LDT;
      f32x16 st[2];
#pragma unroll
      for (int kk = 0; kk < 2; ++kk) {
        st[kk] = sinit;
#pragma unroll
        for (int s = 0; s < 4; ++s) st[kk] = MFMA(*(const bf16x8*)(Kc + (kk * 32 + r) * LDT + s * 16 + h * 8), qf[s], st[kk]);
      }
#pragma unroll
      for (int kk = 0; kk < 2; ++kk)
#pragma unroll
        for (int i = 0; i < 16; ++i) { const float pv = __builtin_amdgcn_exp2f(st[kk][i]); st[kk][i] = pv; lsum += pv; }
#pragma unroll
      for (int kk = 0; kk < 2; ++kk)
#pragma unroll
        for (int s = 0; s < 2; ++s) {
          const bf16x8 pb = pack8(st[kk], s);
#pragma unroll
          for (int mt = 0; mt < 2; ++mt) {
            const u16* vp = Vc + (mt * 32 + r) * LDT + kk * 32 + 16 * s + 4 * h;
            O[mt] = MFMA(ld2x64(vp, vp + 8), pb, O[mt]);
          }
        }
      if (kt + 1 < ntiles) { *(u32x4*)(Ks + (cur ^ 1) * 64 * LDT + lr * LDT + lc) = rk; *(u32x4*)(Vs + (cur ^ 1) * 64 * LDT + lr * LDT + lc) = rv; }
      __syncthreads();
    }
  } else {
#pragma unroll 1
    for (int kt = 0; kt < ntiles; ++kt) {
      const int cur = kt & 1;
      if (kt + 1 < ntiles) { rk = *(const u32x4*)(kg + (size_t)(kt + 1) * 64 * NP); rv = *(const u32x4*)(vg + (kt + 1) * 64); }
      const u16* Kc = Ks + cur * 64 * LDT; const u16* Vc = Vs + cur * 64 * LDT;
      f32x16 st[2];
#pragma unroll
      for (int kk = 0; kk < 2; ++kk) {
        st[kk] = zero16();
#pragma unroll
        for (int s = 0; s < 4; ++s) st[kk] = MFMA(*(const bf16x8*)(Kc + (kk * 32 + r) * LDT + s * 16 + h * 8), qf[s], st[kk]);
      }
      float mx = st[0][0];
#pragma unroll
      for (int i = 0; i < 16; ++i) { mx = fmaxf(mx, st[0][i]); mx = fmaxf(mx, st[1][i]); }
      mx = fmaxf(mx, __shfl_xor(mx, 32));
      const float mn = fmaxf(m, mx);
      const float alpha = exp2f(m - mn);
      m = mn;
      float rsum = 0.f;
#pragma unroll
      for (int kk = 0; kk < 2; ++kk)
#pragma unroll
        for (int i = 0; i < 16; ++i) { const float pv = exp2f(st[kk][i] - mn); st[kk][i] = pv; rsum += pv; }
      lsum = lsum * alpha + rsum;
#pragma unroll
      for (int mt = 0; mt < 2; ++mt)
#pragma unroll
        for (int i = 0; i < 16; ++i) O[mt][i] *= alpha;
#pragma unroll
      for (int kk = 0; kk < 2; ++kk)
#pragma unroll
        for (int s = 0; s < 2; ++s) {
          const bf16x8 pb = pack8(st[kk], s);
#pragma unroll
          for (int mt = 0; mt < 2; ++mt) {
            const u16* vp = Vc + (mt * 32 + r) * LDT + kk * 32 + 16 * s + 4 * h;
            O[mt] = MFMA(ld2x64(vp, vp + 8), pb, O[mt]);
          }
        }
      if (kt + 1 < ntiles) { *(u32x4*)(Ks + (cur ^ 1) * 64 * LDT + lr * LDT + lc) = rk; *(u32x4*)(Vs + (cur ^ 1) * 64 * LDT + lr * LDT + lc) = rv; }
      __syncthreads();
    }
  }
  lsum += __shfl_xor(lsum, 32);
  const float inv = 1.f / lsum;
  u16* op = P + qrow * NP + PC_AQ + hq * 64 + 4 * h;
  const u16* zp = P + qrow * NP + PC_AZ + hq * 64 + 4 * h;
#pragma unroll
  for (int mt = 0; mt < 2; ++mt)
#pragma unroll
    for (int gg = 0; gg < 4; ++gg) {
      const u32x2 zz = *(const u32x2*)(zp + mt * 32 + 8 * gg);
      u32x2 out;
      out.x = pack2(O[mt][4 * gg] * inv * silu_f(bflo(zz.x)), O[mt][4 * gg + 1] * inv * silu_f(bfhi(zz.x)));
      out.y = pack2(O[mt][4 * gg + 2] * inv * silu_f(bflo(zz.y)), O[mt][4 * gg + 3] * inv * silu_f(bfhi(zz.y)));
      if (!dry) *(u32x2*)(op + mt * 32 + 8 * gg) = out;
    }
}

template <int KSU>
DI void gemm_gate3(const u16* __restrict__ A, const u16* __restrict__ WM, char* smem, f32x16 (&acc)[3][2]) {
  u16* As0 = (u16*)smem;
  u16* As1 = As0 + 128 * LDT;
  u16* Bs0 = As0 + 2 * 128 * LDT;
  u16* Bs1 = Bs0 + 384 * LDT;
  const int tid = my_tid(), lane = tid & 63, wid = tid >> 6, r = lane & 31, h = lane >> 5, wm = wid & 3, wn = wid >> 2;
  u32x4 ra0[2], rb0[6], ra1[2], rb1[6];
  auto fetch = [&](u32x4 (&ra)[2], u32x4 (&rb)[6], int k0) {
#pragma unroll
    for (int i = 0; i < 2; ++i) { const int q = tid + NT * i; const unsigned off = (unsigned)((q >> 3) * 1024 + (q & 7) * 8); ra[i] = *(const u32x4*)(A + off + k0); }
#pragma unroll
    for (int i = 0; i < 6; ++i) {
      const int q = tid + NT * i, row = q >> 3;
      const unsigned off = (unsigned)((row >> 7) * (1024 * 1024) + (row & 127) * 1024 + (q & 7) * 8);
      rb[i] = *(const u32x4*)(WM + off + k0);
    }
    GFENCE;
  };
  auto commit = [&](const u32x4 (&ra)[2], const u32x4 (&rb)[6], u16* As, u16* Bs) {
#pragma unroll
    for (int i = 0; i < 2; ++i) { const int q = tid + NT * i; *(u32x4*)(As + (q >> 3) * LDT + (q & 7) * 8) = ra[i]; }
#pragma unroll
    for (int i = 0; i < 6; ++i) { const int q = tid + NT * i; *(u32x4*)(Bs + (q >> 3) * LDT + (q & 7) * 8) = rb[i]; }
    GFENCE;
  };
  auto compute = [&](const u16* Ac, const u16* Bc) {
#pragma unroll KSU
    for (int ks = 0; ks < 4; ++ks) {
      const bf16x8 a = *(const bf16x8*)(Ac + (wm * 32 + r) * LDT + ks * 16 + h * 8);
#pragma unroll
      for (int br = 0; br < 3; ++br)
#pragma unroll
        for (int j = 0; j < 2; ++j)
          acc[br][j] = MFMA(a, *(const bf16x8*)(Bc + (br * 128 + wn * 64 + j * 32 + r) * LDT + ks * 16 + h * 8), acc[br][j]);
    }
  };
  constexpr int KT = 16;
  fetch(ra0, rb0, 0);
  fetch(ra1, rb1, 64);
  __syncthreads();
  commit(ra0, rb0, As0, Bs0);
  __syncthreads();
  fetch(ra0, rb0, 128);
#pragma unroll
  for (int kt = 0; kt < KT; kt += 2) {
    commit(ra1, rb1, As1, Bs1);
    if (kt + 3 < KT) fetch(ra1, rb1, (kt + 3) * 64);
    compute(As0, Bs0);
    __syncthreads();
    if (kt + 2 < KT) commit(ra0, rb0, As0, Bs0);
    if (kt + 4 < KT) fetch(ra0, rb0, (kt + 4) * 64);
    compute(As1, Bs1);
    __syncthreads();
  }
}
DI void phase_merge(const Params& p, int l, char* smem) {
  const int tid = my_tid(), lane = tid & 63, wid = tid >> 6, r = lane & 31, h = lane >> 5, wm = wid & 3, wn = wid >> 2;
  const int xcd = blockIdx.x & 7, nloc = gridDim.x >> 3;
  for (int q = blockIdx.x >> 3; q < 33 * 8; q += nloc) {
    const int mt = (q >> 3) * 8 + xcd, nt = q & 7, m0 = mt * 128, n0 = nt * 128;
    if (mt >= 260) continue;
    const int b = m0 / TB, tk0 = m0 - b * TB;
    if (l == 1 && tk0 < LC) continue;
    const u16* H = (const u16*)(p.ws + OFF_H) + (size_t)m0 * 1024;
    const u16* WM = (const u16*)(p.ws + OFF_WT + (size_t)l * WT_LAYER) + (size_t)(4896 + n0) * 1024;
    const u16* WBR = (const u16*)(p.ws + OFF_WT + (size_t)l * WT_LAYER + WT_IN) + (size_t)n0 * 512;
    unsigned gp[3][2][8];
    {
      f32x16 g3[3][2];
#pragma unroll
      for (int br = 0; br < 3; ++br) for (int j = 0; j < 2; ++j) g3[br][j] = zero16();
      gemm_gate3<2>(H, WM, smem, g3);
#pragma unroll
      for (int br = 0; br < 3; ++br)
#pragma unroll
        for (int j = 0; j < 2; ++j)
#pragma unroll
          for (int i = 0; i < 8; ++i)
            gp[br][j][i] = pack2(1.f / (1.f + __expf(-g3[br][j][2 * i])), 1.f / (1.f + __expf(-g3[br][j][2 * i + 1])));
    }
    f32x16 ysum[2] = {zero16(), zero16()};
#pragma unroll
    for (int br = 0; br < 3; ++br) {
      f32x16 ab[1][2] = {{zero16(), zero16()}};
      if (br < 2) {
        ALoadN ay{(const u16*)(p.ws + OFF_P) + (size_t)m0 * NP + (br == 0 ? PC_GZ : PC_AQ), NP};
        gemm_tile<128, ALoadN, 4, 512>(ay, WBR + (size_t)br * 1024 * 512, 512, smem, ab);
      } else {
        ALoadT ay{(const u16*)(p.ws + OFF_CT) + ((size_t)CH_YZ * 2 + b) * TB + tk0, (size_t)2 * TB};
        gemm_tile<128, ALoadT, 4, 512>(ay, WBR + (size_t)2 * 1024 * 512, 512, smem, ab);
      }
#pragma unroll
      for (int j = 0; j < 2; ++j)
#pragma unroll
        for (int i = 0; i < 8; ++i) {
          ysum[j][2 * i] += bflo(gp[br][j][i]) * ab[0][j][2 * i];
          ysum[j][2 * i + 1] += bfhi(gp[br][j][i]) * ab[0][j][2 * i + 1];
        }
    }
    u16* Y = (u16*)(p.ws + OFF_Y) + (size_t)(m0 + wm * 32 + 4 * h) * 1024 + n0 + wn * 64 + r;
#pragma unroll
    for (int j = 0; j < 2; ++j)
#pragma unroll
      for (int reg = 0; reg < 16; ++reg) Y[(size_t)((reg & 3) + 8 * (reg >> 2)) * 1024 + j * 32] = f2bf(ysum[j][reg]);
  }
}

DI void phase_out(const Params& p, int l, char* smem) {
  const int tid = my_tid(), lane = tid & 63, wid = tid >> 6, r = lane & 31, h = lane >> 5, wm = wid & 3, wn = wid >> 2;
  const u16* Yb = (const u16*)(p.ws + OFF_Y);
  const u16* WO = (const u16*)(p.ws + OFF_WT + (size_t)l * WT_LAYER + WT_IN + 3 * WT_BR);
  const float* mod = (const float*)(p.ws + OFF_MOD);
  const int xcd = blockIdx.x & 7, nloc = gridDim.x >> 3;
  auto tile_of = [&](int q, int& m0, int& n0) -> bool {
    const int mt = (q >> 3) * 8 + xcd; m0 = mt * 128; n0 = (q & 7) * 128;
    if (mt >= 260) return false;
    const int b = m0 / TB, tk0 = m0 - b * TB;
    return !(l == 1 && tk0 < LC);
  };
  auto next_q = [&](int q) -> int { int m, n; for (q += nloc; q < 33 * 8; q += nloc) if (tile_of(q, m, n)) return q; return -1; };
  int q = (int)(blockIdx.x >> 3) - nloc; q = next_q(q);
  if (q < 0) return;
  int m0, n0; tile_of(q, m0, n0);
  GemmRegs<128> gr;
  { ALoadN ay{Yb + (size_t)m0 * 1024, 1024}; gemm_prime<128>(gr, ay, WO + (size_t)n0 * 1024, 1024, smem); }
  while (true) {
    const int qn = next_q(q);
    int m0n = 0, n0n = 0; if (qn >= 0) tile_of(qn, m0n, n0n);
    const int b = m0 / TB, tk0 = m0 - b * TB;
    f32x16 acc[1][2] = {{zero16(), zero16()}};
    const ALoadN ay{Yb + (size_t)m0 * 1024, 1024}, ayn{Yb + (size_t)m0n * 1024, 1024};
    gemm_run<128, ALoadN, 4, 1024, ALoadN>(gr, ay, WO + (size_t)n0 * 1024, 1024, ayn, WO + (size_t)n0n * 1024, 1024, qn >= 0, smem, acc);
    const float* gv = mod + (l * 3 + (tk0 < LC ? 2 : b)) * 3072 + 2048;
    const float* xin = xrow_in(p, l, m0);
    float* xout = xrow_out(p, m0);
#pragma unroll
    for (int j = 0; j < 2; ++j) {
      const int col = n0 + wn * 64 + j * 32 + r;
      const float gate = gv[col];
#pragma unroll
      for (int reg = 0; reg < 16; ++reg) {
        const size_t off = (size_t)(wm * 32 + crow(reg, h)) * D + col;
        xout[off] = xin[off] + gate * acc[0][j][reg];
      }
    }
    if (qn < 0) break;
    q = qn; m0 = m0n; n0 = n0n;
  }
}

DI void phase_final(const Params& p) {
  const int tid = my_tid(), lane = tid & 63, wid = tid >> 6;
  for (int row = blockIdx.x * 8 + wid; row < NBATCH * L; row += gridDim.x * 8) {
    float* src = p.out + (size_t)row * D;
    float4 xv[4]; float ss = 0.f;
#pragma unroll
    for (int i = 0; i < 4; ++i) { xv[i] = *(const float4*)(src + (i * 64 + lane) * 4); ss += xv[i].x * xv[i].x + xv[i].y * xv[i].y + xv[i].z * xv[i].z + xv[i].w * xv[i].w; }
    ss = wave_sum(ss);
    const float rs = rsqrtf(ss * (1.f / 1024.f) + EPS);
#pragma unroll
    for (int i = 0; i < 4; ++i) {
      const int col = (i * 64 + lane) * 4;
      const float4 fw = *(const float4*)(pk(p, PK_FN) + col);
      *(float4*)(src + col) = make_float4(xv[i].x * rs * fw.x, xv[i].y * rs * fw.y, xv[i].z * rs * fw.z, xv[i].w * rs * fw.w);
    }
  }
}

DI void run_phase(const Params& p, int ph, char* smem, int dry = 0) {
  const int bid = blockIdx.x, nb = gridDim.x;
  if (ph == 0) { phase0(p, smem); return; }
  if (ph == 17) { phase_final(p); return; }
  const int l = (ph - 1) >> 3, s = (ph - 1) & 7;
  switch (s) {
    case 0: phase_norm(p, l); break;
    case 1: phase_proj(p, l, smem); break;
    case 2: {
      attn_prep(p, l, dry);
      if (l == 0) for (int c = bid; c < 512; c += nb) hyena_ctx_task(p, l, c, smem, dry);
      for (int c = bid; c < 512; c += nb) hyena_latent_task(p, l, c, smem, dry);
    } break;
    case 3: for (int t = bid; t < 16 * NCK; t += nb) gla_g1_task(p, l, t / NCK, t % NCK, smem); break;
    case 4: gla_g2(p, dry); break;
    case 5: {
      for (int it = bid; it < 1024; it += nb) { const int b = it >> 9, g = (it >> 8) & 1, qb = it & 255; attn_item(p, l, b, g, LC + qb * 64, NCK, smem, dry); }
      if (l == 0) for (int it = bid; it < 16; it += nb) { const int b = it >> 3, g = (it >> 2) & 1, qb = it & 3; attn_item(p, l, b, g, qb * 64, 4, smem, dry); }
      const int c0 = (l == 0) ? 0 : 4, per = NCK - c0;
      for (int t = bid; t < 8 * per; t += nb) { const int bh = t / per, ci = c0 + t % per; gla_g3_task(p, l, bh >> 2, bh & 3, ci, smem, dry); }
    } break;
    case 6: phase_merge(p, l, smem); break;
    case 7: phase_out(p, l, smem); break;
  }
}

#if MULTI_LAUNCH
template <int PH> __global__ void __launch_bounds__(NT) phase_kernel(Params p) {
  extern __shared__ __attribute__((aligned(16))) char smem[];
  run_phase(p, PH, smem);
}
template <int PH> static void launch_phase(const Params& p, int grid, hipStream_t stream) {
  static bool attr = false;
  if (!attr) { (void)hipFuncSetAttribute((const void*)phase_kernel<PH>, hipFuncAttributeMaxDynamicSharedMemorySize, LDS_BYTES); attr = true; }
  hipLaunchKernelGGL(phase_kernel<PH>, dim3(grid), dim3(NT), LDS_BYTES, stream, p);
}
#else
DI void gbar(const Params& p, unsigned k) {
  __syncthreads();
  if (threadIdx.x == 0) {
    unsigned* bar = (unsigned*)(p.ws + OFF_BAR);
    const unsigned x = blockIdx.x & 7u;
    const unsigned per = (gridDim.x + 7u - x) >> 3;
    __builtin_amdgcn_fence(__ATOMIC_RELEASE, "agent");
    const unsigned old = __hip_atomic_fetch_add(bar + x * 64, 1u, __ATOMIC_ACQ_REL, __HIP_MEMORY_SCOPE_AGENT);
    if (old + 1u == k * per) __hip_atomic_fetch_add(bar + 8 * 64, 1u, __ATOMIC_ACQ_REL, __HIP_MEMORY_SCOPE_AGENT);
    while (__hip_atomic_load(bar + 8 * 64, __ATOMIC_RELAXED, __HIP_MEMORY_SCOPE_AGENT) < 8u * k) __builtin_amdgcn_s_sleep(1);
    __builtin_amdgcn_fence(__ATOMIC_ACQUIRE, "agent");
  }
  __syncthreads();
}
#ifndef PROBE_DUP
#define PROBE_DUP -1
#endif
#ifndef PROBE_DUP2
#define PROBE_DUP2 -1
#endif
#ifndef PROBE_DUP3
#define PROBE_DUP3 -1
#endif
__global__ void __launch_bounds__(NT) fwd_kernel(Params p) {
  extern __shared__ __attribute__((aligned(16))) char smem[];
  cg::grid_group grid = cg::this_grid();
#if PROBE_DUP >= 0
#define PHS(n) if ((n) == PROBE_DUP || (n) == PROBE_DUP2 || (n) == PROBE_DUP3) { run_phase(p, n, smem, p.phase_lo == 0 ? 1 : 0); grid.sync(); } run_phase(p, n, smem); grid.sync();
#else
#define PHS(n) run_phase(p, n, smem); if ((n) == 0) grid.sync(); else gbar(p, (unsigned)(n));
#endif
  PHS(0) PHS(1) PHS(2) PHS(3) PHS(4) PHS(5) PHS(6) PHS(7) PHS(8)
  PHS(9) PHS(10) PHS(11) PHS(12) PHS(13) PHS(14) PHS(15) PHS(16)
  run_phase(p, 17, smem);
}
#endif

extern "C" void kernel_launch(void* const* d_in, const int* in_sizes, int n_in, void* d_out, int out_size, void* d_ws, size_t ws_size,
                              hipStream_t stream) {
  static int grid = 0;
  if (grid == 0) {
    if (n_in != 29 || ws_size < WS_END) { fprintf(stderr, "kernel_launch: need 29 inputs and %zu B of workspace, got %d / %zu\n", (size_t)WS_END, n_in, ws_size); grid = -1; return; }
#if MULTI_LAUNCH
    grid = 256;
#else
    int dev = 0, cus = 0, per_cu = 0;
    (void)hipGetDevice(&dev);
    (void)hipDeviceGetAttribute(&cus, hipDeviceAttributeMultiprocessorCount, dev);
    if (hipFuncSetAttribute((const void*)fwd_kernel, hipFuncAttributeMaxDynamicSharedMemorySize, LDS_BYTES) != hipSuccess) { fprintf(stderr, "kernel_launch: hipFuncSetAttribute failed\n"); grid = -1; return; }
    (void)hipOccupancyMaxActiveBlocksPerMultiprocessor(&per_cu, (const void*)fwd_kernel, NT, LDS_BYTES);
    if (per_cu < 1) { fprintf(stderr, "kernel_launch: occupancy query returned %d\n", per_cu); per_cu = 1; }
    (void)hipGetLastError();
    grid = cus * per_cu;
    if (grid > 256) grid = 256;
#endif
  }
  if (grid < 0) return;
  Params p{};
  const float** pp = (const float**)&p;
  for (int i = 0; i < 29; ++i) pp[i] = (const float*)d_in[i];
  p.out = (float*)d_out; p.ws = (char*)d_ws;
  p.phase_lo = 0; p.phase_hi = 18;
#if MULTI_LAUNCH
  launch_phase<0>(p, grid, stream); launch_phase<1>(p, grid, stream); launch_phase<2>(p, grid, stream); launch_phase<3>(p, grid, stream);
  launch_phase<4>(p, grid, stream); launch_phase<5>(p, grid, stream); launch_phase<6>(p, grid, stream); launch_phase<7>(p, grid, stream);
  launch_phase<8>(p, grid, stream); launch_phase<9>(p, grid, stream); launch_phase<10>(p, grid, stream); launch_phase<11>(p, grid, stream);
  launch_phase<12>(p, grid, stream); launch_phase<13>(p, grid, stream); launch_phase<14>(p, grid, stream); launch_phase<15>(p, grid, stream);
  launch_phase<16>(p, grid, stream); launch_phase<17>(p, grid, stream);
#else
  if (hipMemsetAsync((char*)d_ws + OFF_BAR, 0, BAR_BYTES, stream) != hipSuccess) { fprintf(stderr, "kernel_launch: barrier memset failed\n"); return; }
  void* args[] = {&p};
  hipError_t e = hipLaunchCooperativeKernel((const void*)fwd_kernel, dim3(grid), dim3(NT), args, LDS_BYTES, stream);
  if (e != hipSuccess) fprintf(stderr, "kernel_launch: cooperative launch failed: %s (grid %d)\n", hipGetErrorString(e), grid);
#endif
}
```

```cpp
#include <hip/hip_runtime.h>
#include <hip/hip_cooperative_groups.h>
#include <cstdio>
namespace cg = cooperative_groups;

typedef unsigned short u16;
typedef __attribute__((ext_vector_type(8))) short bf16x8;
typedef __attribute__((ext_vector_type(16))) float f32x16;
typedef __attribute__((ext_vector_type(4))) unsigned u32x4;
typedef __attribute__((ext_vector_type(2))) unsigned u32x2;
#define DI __device__ __forceinline__
#define MFMA(a, b, c) __builtin_amdgcn_mfma_f32_32x32x16_bf16((a), (b), (c), 0, 0, 0)

#ifndef MULTI_LAUNCH
#define MULTI_LAUNCH 0
#endif

constexpr int D = 1024, NBATCH = 2, L = 16384, LC = 256, TB = L + LC, R = NBATCH * TB;
constexpr int NIN = 7968;
constexpr int NP = 2208;
constexpr int NCH = 2688;
constexpr int PC_GQ = 0, PC_GK = 256, PC_GZ = 512, PC_AF = 1024, PC_AQ = 1056, PC_AK = 1568, PC_AZ = 1696;
constexpr int CH_YU = 0, CH_YZ = 1536, CH_GV = 2048, CH_AV = 2560;
constexpr int NCK = 260;
constexpr float EPS = 1e-6f;
constexpr int NT = 512;
constexpr int LDT = 72;

constexpr size_t OFF_P = 0;
constexpr size_t OFF_CT = OFF_P + (size_t)R * NP * 2;
constexpr size_t OFF_H = OFF_CT + (size_t)NCH * 2 * TB * 2;
constexpr size_t OFF_FS = OFF_H + (size_t)R * 1024 * 2;
constexpr size_t OFF_WT = OFF_FS + (size_t)256 * 262144;
constexpr size_t WT_IN = (size_t)NIN * 1024 * 2, WT_BR = (size_t)1024 * 512 * 2, WT_OUT = (size_t)1024 * 1024 * 2;
constexpr size_t WT_LAYER = WT_IN + 3 * WT_BR + WT_OUT;
constexpr size_t OFF_H2T = OFF_WT + 2 * WT_LAYER;
constexpr size_t OFF_H2C = OFF_H2T + (size_t)2 * 64 * L * 4;
constexpr size_t OFF_MOD = OFF_H2C + (size_t)2 * 256 * 64 * 4;
constexpr size_t OFF_CTX1 = OFF_MOD + (size_t)2 * 3 * 3072 * 4;
constexpr size_t OFF_GD = OFF_CTX1 + (size_t)512 * 1024 * 4;
constexpr size_t OFF_PK = OFF_GD + (size_t)16 * NCK * 64 * 4;
constexpr int PK_WAF = 0, PK_BAF = 8192, PK_WAB = 8704, PK_BAB = 16896, PK_GN = 17408, PK_QN = 17664, PK_KN = 17792, PK_CW = 17920,
              PK_CB = 27136, PK_SK = 30208, PK_FN = 32256, PK_F3 = 33280, PK_END = 33280 + 262144;
constexpr size_t OFF_BAR = OFF_PK + (size_t)PK_END * 4;
constexpr size_t BAR_BYTES = 50 * 256;
constexpr size_t WS_END = OFF_BAR + 16384;
constexpr int BAR_LDS = 147456 + 256;
constexpr size_t OFF_GS = OFF_CT;
constexpr size_t OFF_Y = OFF_CT;
static_assert((size_t)16 * NCK * 8192 * 2 <= (size_t)1536 * 2 * TB * 2, "alias");
static_assert((size_t)R * 1024 * 2 <= (size_t)1536 * 2 * TB * 2, "alias");

constexpr int LDS_BYTES = 2 * (128 + 384) * 72 * 2 + 512;

struct Params {
  const float *x, *c, *ctx, *c_ctx, *w_ada, *b_ada, *w_in, *wa_f, *ba_f, *wa_b, *ba_b, *gla_norm, *qnorm, *knorm,
      *conv_w, *conv_b, *f1_w, *f1_b, *f1_freq, *f2_w, *f2_b, *f2_freq, *f3_w, *skip, *w_g, *w_a, *w_h, *w_o, *final_norm;
  float* out;
  char* ws;
  long long phase_lo, phase_hi;
};

typedef __attribute__((ext_vector_type(2))) float f32x2v;
typedef __attribute__((ext_vector_type(2))) __bf16 bf16x2v;
DI int my_tid() {
  int t = (int)threadIdx.x;
  asm volatile("" : "+v"(t));
  __builtin_assume(t >= 0 && t < NT);
  return t;
}
DI u16 f2bf(float x) { return __builtin_bit_cast(u16, (__bf16)x); }
DI float bf2f(u16 v) { return __uint_as_float(((unsigned)v) << 16); }
DI unsigned pack2(float a, float b) { f32x2v v = {a, b}; return __builtin_bit_cast(unsigned, __builtin_convertvector(v, bf16x2v)); }
DI float bflo(unsigned u) { return __uint_as_float(u << 16); }
DI float bfhi(unsigned u) { return __uint_as_float(u & 0xffff0000u); }
DI float silu_f(float x) { return x / (1.f + __expf(-x)); }
DI float wave_sum(float v) {
#pragma unroll
  for (int o = 32; o >= 1; o >>= 1) v += __shfl_xor(v, o);
  return v;
}
DI int crow(int reg, int h) { return (reg & 3) + 8 * (reg >> 2) + 4 * h; }
DI f32x16 zero16() { f32x16 z; for (int i = 0; i < 16; ++i) z[i] = 0.f; return z; }
DI bf16x8 pack8(const f32x16& x, int s) {
  u32x4 u;
  u.x = pack2(x[8 * s + 0], x[8 * s + 1]); u.y = pack2(x[8 * s + 2], x[8 * s + 3]);
  u.z = pack2(x[8 * s + 4], x[8 * s + 5]); u.w = pack2(x[8 * s + 6], x[8 * s + 7]);
  return __builtin_bit_cast(bf16x8, u);
}
DI bf16x8 ld2x64(const u16* p0, const u16* p1) {
  u32x2 a = *(const u32x2*)p0, b = *(const u32x2*)p1;
  u32x4 u; u.x = a.x; u.y = a.y; u.z = b.x; u.w = b.y;
  return __builtin_bit_cast(bf16x8, u);
}
DI float2 cmul(float2 a, float2 b) { return make_float2(a.x * b.x - a.y * b.y, a.x * b.y + a.y * b.x); }
DI float2 cadd(float2 a, float2 b) { return make_float2(a.x + b.x, a.y + b.y); }
DI float2 csub(float2 a, float2 b) { return make_float2(a.x - b.x, a.y - b.y); }

DI const float* xrow_in(const Params& p, int layer, int row) {
  int b = row / TB, tk = row - b * TB;
  if (tk < LC) return (layer == 0 ? p.ctx : (const float*)(p.ws + OFF_CTX1)) + (size_t)(b * LC + tk) * D;
  return (layer == 0 ? p.x : (const float*)p.out) + (size_t)(b * L + tk - LC) * D;
}
DI float* xrow_out(const Params& p, int row) {
  int b = row / TB, tk = row - b * TB;
  if (tk < LC) return (float*)(p.ws + OFF_CTX1) + (size_t)(b * LC + tk) * D;
  return p.out + (size_t)(b * L + tk - LC) * D;
}
DI const float* pk(const Params& p, int off) { return (const float*)(p.ws + OFF_PK) + off; }
DI int modvec_of(int row) { int b = row / TB, tk = row - b * TB; return tk < LC ? 2 : b; }

struct ALoadN {
  const u16* A; int lda;
  template <int BM> DI void fetch(u32x4 (&r)[BM / 64], int k0, int tid) const {
#pragma unroll
    for (int i = 0; i < BM / 64; ++i) { const int q = tid + NT * i; const unsigned off = (unsigned)((q >> 3) * lda + (q & 7) * 8); r[i] = *(const u32x4*)(A + off + k0); }
  }
  template <int BM> DI void commit(const u32x4 (&r)[BM / 64], u16* As, int tid) const {
#pragma unroll
    for (int i = 0; i < BM / 64; ++i) { int q = tid + NT * i; *(u32x4*)(As + (q >> 3) * LDT + (q & 7) * 8) = r[i]; }
  }
};
struct ALoadT {
  const u16* A; size_t chs;
  template <int BM> DI void fetch(u32x4 (&r)[BM / 64], int k0, int tid) const {
#pragma unroll
    for (int i = 0; i < 2; ++i) { const int q = tid + NT * i; const unsigned off = (unsigned)((q >> 4) * (int)chs + (q & 15) * 8); r[i] = *(const u32x4*)(A + off + (unsigned)(k0 * (int)chs)); }
  }
  template <int BM> DI void commit(const u32x4 (&r)[BM / 64], u16* As, int tid) const {
#pragma unroll
    for (int i = 0; i < 2; ++i) {
      int q = tid + NT * i; int ch = q >> 4, t0 = (q & 15) * 8;
      unsigned w[4] = {r[i].x, r[i].y, r[i].z, r[i].w};
#pragma unroll
      for (int e = 0; e < 4; ++e) { As[(t0 + 2 * e) * LDT + ch] = (u16)(w[e] & 0xffffu); As[(t0 + 2 * e + 1) * LDT + ch] = (u16)(w[e] >> 16); }
    }
  }
};

template <int BM, int KSU>
DI void gemm_compute(const u16* Ac, const u16* Bc, int wm, int wn, int r, int h, f32x16 (&acc)[BM / 128][2]) {
#pragma unroll KSU
  for (int ks = 0; ks < 4; ++ks) {
    bf16x8 a[BM / 128], b[2];
#pragma unroll
    for (int i = 0; i < BM / 128; ++i) a[i] = *(const bf16x8*)(Ac + (wm * (BM / 4) + i * 32 + r) * LDT + ks * 16 + h * 8);
#pragma unroll
    for (int j = 0; j < 2; ++j) b[j] = *(const bf16x8*)(Bc + (wn * 64 + j * 32 + r) * LDT + ks * 16 + h * 8);
#pragma unroll
    for (int i = 0; i < BM / 128; ++i)
#pragma unroll
      for (int j = 0; j < 2; ++j) acc[i][j] = MFMA(a[i], b[j], acc[i][j]);
  }
}
DI void fetch_b(u32x4 (&rb)[2], const u16* Bt, int ldb, int k0, int tid) {
#pragma unroll
  for (int i = 0; i < 2; ++i) { const int q = tid + NT * i; const unsigned off = (unsigned)((q >> 3) * ldb + (q & 7) * 8); rb[i] = *(const u32x4*)(Bt + off + k0); }
}
DI void commit_b(const u32x4 (&rb)[2], u16* Bs, int tid) {
#pragma unroll
  for (int i = 0; i < 2; ++i) { int q = tid + NT * i; *(u32x4*)(Bs + (q >> 3) * LDT + (q & 7) * 8) = rb[i]; }
}
template <int BM> struct GemmRegs { u32x4 ra0[BM / 64], rb0[2], ra1[BM / 64], rb1[2]; };
#define GFENCE asm volatile("" ::: "memory")
template <int BM, class AL>
DI void gemm_prime(GemmRegs<BM>& g, const AL& al, const u16* __restrict__ Bt, int ldb, char* smem) {
  u16* As0 = (u16*)smem;
  u16* Bs0 = As0 + 2 * BM * LDT;
  const int tid = my_tid();
  al.template fetch<BM>(g.ra0, 0, tid); fetch_b(g.rb0, Bt, ldb, 0, tid); GFENCE;
  al.template fetch<BM>(g.ra1, 64, tid); fetch_b(g.rb1, Bt, ldb, 64, tid); GFENCE;
  __syncthreads();
  al.template commit<BM>(g.ra0, As0, tid); commit_b(g.rb0, Bs0, tid);
  __syncthreads();
  al.template fetch<BM>(g.ra0, 128, tid); fetch_b(g.rb0, Bt, ldb, 128, tid); GFENCE;
}
template <int BM, class AL, int KSU, int K, class ALN>
DI void gemm_run(GemmRegs<BM>& g, const AL& al, const u16* __restrict__ Bt, int ldb, const ALN& aln, const u16* __restrict__ Btn, int ldbn,
                 bool hasnext, char* smem, f32x16 (&acc)[BM / 128][2]) {
  u16* As0 = (u16*)smem;
  u16* As1 = As0 + BM * LDT;
  u16* Bs0 = As0 + 2 * BM * LDT;
  u16* Bs1 = Bs0 + 128 * LDT;
  const int tid = my_tid(), lane = tid & 63, wid = tid >> 6, r = lane & 31, h = lane >> 5;
  const int wm = wid & 3, wn = wid >> 2;
  constexpr int KT = K >> 6;
#pragma unroll
  for (int kt = 0; kt < KT; kt += 2) {
    al.template commit<BM>(g.ra1, As1, tid); commit_b(g.rb1, Bs1, tid);
    GFENCE;
    if (kt + 3 < KT) { al.template fetch<BM>(g.ra1, (kt + 3) * 64, tid); fetch_b(g.rb1, Bt, ldb, (kt + 3) * 64, tid); GFENCE; }
    else if (hasnext) { aln.template fetch<BM>(g.ra1, (kt + 3 - KT) * 64, tid); fetch_b(g.rb1, Btn, ldbn, (kt + 3 - KT) * 64, tid); GFENCE; }
    gemm_compute<BM, KSU>(As0, Bs0, wm, wn, r, h, acc);
    __syncthreads();
    if (kt + 2 < KT) { al.template commit<BM>(g.ra0, As0, tid); commit_b(g.rb0, Bs0, tid); GFENCE; }
    else if (hasnext) { aln.template commit<BM>(g.ra0, As0, tid); commit_b(g.rb0, Bs0, tid); GFENCE; }
    if (kt + 4 < KT) { al.template fetch<BM>(g.ra0, (kt + 4) * 64, tid); fetch_b(g.rb0, Bt, ldb, (kt + 4) * 64, tid); GFENCE; }
    else if (hasnext) { aln.template fetch<BM>(g.ra0, (kt + 4 - KT) * 64, tid); fetch_b(g.rb0, Btn, ldbn, (kt + 4 - KT) * 64, tid); GFENCE; }
    gemm_compute<BM, KSU>(As1, Bs1, wm, wn, r, h, acc);
    __syncthreads();
  }
}

template <int BM, class AL, int KSU = 4, int K = 1024>
DI void gemm_tile(const AL& al, const u16* __restrict__ Bt, int ldb, char* smem, f32x16 (&acc)[BM / 128][2]) {
  GemmRegs<BM> g;
  gemm_prime<BM>(g, al, Bt, ldb, smem);
  gemm_run<BM, AL, KSU, K, AL>(g, al, Bt, ldb, al, Bt, ldb, false, smem, acc);
}

DI void phase0(const Params& p, char* smem) {
  const int tid = my_tid(), lane = tid & 63, wid = tid >> 6, bid = blockIdx.x, nb = gridDim.x;
  float* sm = (float*)smem;
  {
    float* PKW = (float*)(p.ws + OFF_PK);
    const int gt = bid * NT + tid, gn = nb * NT;
#define PKCP(src, off, cnt) for (int i = gt; i < (cnt); i += gn) PKW[(off) + i] = (src)[i];
    PKCP(p.wa_f, PK_WAF, 8192) PKCP(p.ba_f, PK_BAF, 512) PKCP(p.wa_b, PK_WAB, 8192) PKCP(p.ba_b, PK_BAB, 512)
    PKCP(p.gla_norm, PK_GN, 256) PKCP(p.qnorm, PK_QN, 128) PKCP(p.knorm, PK_KN, 128) PKCP(p.conv_w, PK_CW, 9216)
    PKCP(p.conv_b, PK_CB, 3072) PKCP(p.skip, PK_SK, 2048) PKCP(p.final_norm, PK_FN, 1024) PKCP(p.f3_w, PK_F3, 262144)
#undef PKCP
  }
  float* mod = (float*)(p.ws + OFF_MOD);
  for (int task = bid; task < 96; task += nb) {
    const int l = task / 48, cb = task % 48, col = cb * 64 + lane;
    const float* W = p.w_ada + (size_t)l * 1024 * 3072;
    float a0 = 0.f, a1 = 0.f, a2 = 0.f;
#pragma unroll 8
    for (int k = wid * 128; k < wid * 128 + 128; ++k) {
      float wv = W[(size_t)k * 3072 + col];
      a0 += silu_f(p.c[k]) * wv; a1 += silu_f(p.c[1024 + k]) * wv; a2 += silu_f(p.c_ctx[k]) * wv;
    }
    __syncthreads();
    sm[(wid * 3 + 0) * 64 + lane] = a0; sm[(wid * 3 + 1) * 64 + lane] = a1; sm[(wid * 3 + 2) * 64 + lane] = a2;
    __syncthreads();
    if (tid < 192) {
      int v = tid >> 6; float s = p.b_ada[l * 3072 + col];
      for (int w = 0; w < 8; ++w) s += sm[(w * 3 + v) * 64 + lane];
      mod[(l * 3 + v) * 3072 + col] = s;
    }
    __syncthreads();
  }
  for (int it = bid; it < (2 * TB) / 8; it += nb) {
    const int gr = it * 8 + wid, l = gr / TB, rr = gr - l * TB;
    const bool lat = rr < L; const int t = lat ? rr : rr - L; const int Lq = lat ? L : LC;
    float* em = sm + wid * 104; float* h1 = em + 40;
    __syncthreads();
    if (lane < 33) {
      float v;
      if (lane == 0) v = (float)t / (float)(Lq - 1);
      else {
        int bi = (lane - 1) & 15; float fr = 1e-4f + (float)bi * ((15.f - 1e-4f) / 15.f);
        float w = 6.283185307179586f * (float)t / (float)Lq;
        v = (lane <= 16) ? cosf(fr * w) : -sinf(fr * w);
      }
      em[lane] = v;
    }
    __syncthreads();
    {
      float a = p.f1_b[l * 64 + lane];
      for (int e = 0; e < 33; ++e) a += em[e] * p.f1_w[(l * 33 + e) * 64 + lane];
      h1[lane] = sinf(p.f1_freq[l * 64 + lane] * a);
    }
    __syncthreads();
    {
      float a = p.f2_b[l * 64 + lane];
      for (int i = 0; i < 64; ++i) a += h1[i] * p.f2_w[(l * 64 + i) * 64 + lane];
      float v = sinf(p.f2_freq[l * 64 + lane] * a);
      if (lat) ((u16*)(p.ws + OFF_H2T))[((size_t)l * 64 + lane) * L + t] = f2bf(v);
      else ((float*)(p.ws + OFF_H2C))[((size_t)l * 256 + t) * 64 + lane] = v;
    }
  }
  __syncthreads();
  {
    constexpr int T_IN = 16 * 249, T_BR = 8 * 32, T_OUT = 16 * 32, T_LAYER = T_IN + 3 * T_BR + T_OUT;
    auto decode = [&](int task, const float*& src, u16*& dst, int& K, int& N, int& k0, int& n0) {
      const int l = task / T_LAYER; int tt = task - l * T_LAYER;
      char* wt = p.ws + OFF_WT + (size_t)l * WT_LAYER;
      int kt, ntile;
      if (tt < T_IN) { src = p.w_in + (size_t)l * 1024 * NIN; dst = (u16*)wt; K = 1024; N = NIN; kt = tt / 249; ntile = tt % 249; }
      else if (tt < T_IN + 3 * T_BR) {
        tt -= T_IN; const int br = tt / T_BR; tt -= br * T_BR;
        src = (br == 0 ? p.w_g : (br == 1 ? p.w_a : p.w_h)) + (size_t)l * 512 * 1024; dst = (u16*)(wt + WT_IN + br * WT_BR);
        K = 512; N = 1024; kt = tt / 32; ntile = tt % 32;
      } else { tt -= T_IN + 3 * T_BR; src = p.w_o + (size_t)l * 1024 * 1024; dst = (u16*)(wt + WT_IN + 3 * WT_BR); K = 1024; N = 1024; kt = tt / 32; ntile = tt % 32; }
      k0 = kt * 64; n0 = ntile * 32;
    };
    float* tileA = sm;
    float* tileB = sm + 64 * 33;
    for (int task = bid; task < 2 * T_LAYER; task += 2 * nb) {
      const bool hasB = task + nb < 2 * T_LAYER;
      const float *sa, *sb = nullptr; u16 *da, *db = nullptr; int Ka, Na, k0a, n0a, Kb = 0, Nb = 0, k0b = 0, n0b = 0;
      decode(task, sa, da, Ka, Na, k0a, n0a);
      if (hasB) decode(task + nb, sb, db, Kb, Nb, k0b, n0b);
      float va[4], vb[4];
#pragma unroll
      for (int i = 0; i < 4; ++i) { const int kk = (tid >> 5) + 16 * i, nn = tid & 31; va[i] = sa[(size_t)(k0a + kk) * Na + n0a + nn]; vb[i] = hasB ? sb[(size_t)(k0b + kk) * Nb + n0b + nn] : 0.f; }
#pragma unroll
      for (int i = 0; i < 4; ++i) { const int kk = (tid >> 5) + 16 * i, nn = tid & 31; tileA[kk * 33 + nn] = va[i]; tileB[kk * 33 + nn] = vb[i]; }
      __syncthreads();
#pragma unroll
      for (int i = 0; i < 4; ++i) {
        const int nn = (tid >> 6) + 8 * i, kk = tid & 63;
        da[(size_t)(n0a + nn) * Ka + k0a + kk] = f2bf(tileA[kk * 33 + nn]);
        if (hasB) db[(size_t)(n0b + nn) * Kb + k0b + kk] = f2bf(tileB[kk * 33 + nn]);
      }
      __syncthreads();
    }
  }
}

DI void phase_norm(const Params& p, int l) {
  const int tid = my_tid(), lane = tid & 63, wid = tid >> 6;
  const float* mod = (const float*)(p.ws + OFF_MOD);
  u16* H = (u16*)(p.ws + OFF_H);
  for (int row = blockIdx.x * 8 + wid; row < R; row += gridDim.x * 8) {
    const float* src = xrow_in(p, l, row);
    const float* mv = mod + (l * 3 + modvec_of(row)) * 3072;
    float4 xv[4]; float ss = 0.f;
#pragma unroll
    for (int i = 0; i < 4; ++i) { xv[i] = *(const float4*)(src + (i * 64 + lane) * 4); ss += xv[i].x * xv[i].x + xv[i].y * xv[i].y + xv[i].z * xv[i].z + xv[i].w * xv[i].w; }
    ss = wave_sum(ss);
    const float rs = rsqrtf(ss * (1.f / 1024.f) + EPS);
#pragma unroll
    for (int i = 0; i < 4; ++i) {
      const int col = (i * 64 + lane) * 4;
      float4 sh = *(const float4*)(mv + col), sc = *(const float4*)(mv + 1024 + col);
      u32x2 o;
      o.x = pack2(xv[i].x * rs * (1.f + sc.x) + sh.x, xv[i].y * rs * (1.f + sc.y) + sh.y);
      o.y = pack2(xv[i].z * rs * (1.f + sc.z) + sh.z, xv[i].w * rs * (1.f + sc.w) + sh.w);
      *(u32x2*)(H + (size_t)row * 1024 + col) = o;
    }
  }
}

DI void phase_proj(const Params& p, int l, char* smem) {
  const int tid = my_tid(), lane = tid & 63, wid = tid >> 6, r = lane & 31, h = lane >> 5, wm = wid & 3, wn = wid >> 2;
  const u16* H = (const u16*)(p.ws + OFF_H);
  const u16* WT = (const u16*)(p.ws + OFF_WT + (size_t)l * WT_LAYER);
  u16* P = (u16*)(p.ws + OFF_P);
  u16* CT = (u16*)(p.ws + OFF_CT);
  u16* Tt = (u16*)smem;
  constexpr int LDE = 260;
  const int xcd = blockIdx.x & 7, nloc = gridDim.x >> 3;
  for (int q = blockIdx.x >> 3; q < 5 * 156; q += nloc) {
    const int g = q / 156, rem = q - g * 156, nt = rem >> 2, mt = (g * 4 + (rem & 3)) * 8 + xcd;
    if (mt >= 130) continue;
    const int m0 = mt * 256, n0 = nt * 128;
    f32x16 acc[2][2];
#pragma unroll
    for (int i = 0; i < 2; ++i) for (int j = 0; j < 2; ++j) acc[i][j] = zero16();
    ALoadN al{H + (size_t)m0 * 1024, 1024};
    gemm_tile<256, ALoadN, 4, 1024>(al, WT + (size_t)n0 * 1024, 1024, smem, acc);
    const int b = m0 / TB, tk0 = m0 - b * TB;
#pragma unroll
    for (int i = 0; i < 2; ++i)
#pragma unroll
      for (int j = 0; j < 2; ++j)
#pragma unroll
        for (int g4 = 0; g4 < 4; ++g4) {
          u32x2 o; o.x = pack2(acc[i][j][4 * g4], acc[i][j][4 * g4 + 1]); o.y = pack2(acc[i][j][4 * g4 + 2], acc[i][j][4 * g4 + 3]);
          *(u32x2*)(Tt + (wn * 64 + j * 32 + r) * LDE + wm * 64 + i * 32 + 8 * g4 + 4 * h) = o;
        }
    __syncthreads();
#pragma unroll 1
    for (int cg = 0; cg < 4; ++cg) {
      const int cb = n0 + cg * 32;
      if (cb >= 4896) continue;
      bool chan; int cm;
      if (cb < 512) { chan = false; cm = cb; }
      else if (cb < 1024) { chan = true; cm = CH_GV + cb - 512; }
      else if (cb < 2208) { chan = false; cm = cb - 512; }
      else if (cb < 2336) { chan = true; cm = CH_AV + cb - 2208; }
      else if (cb < 2848) { chan = false; cm = cb - 640; }
      else { chan = true; cm = cb - 2848; }
      if (chan) {
#pragma unroll
        for (int k = 0; k < 2; ++k) {
          const int idx = tid + NT * k, ch = idx >> 5, t8 = idx & 31;
          const u16* sp = Tt + (cg * 32 + ch) * LDE + t8 * 8;
          const u32x2 lo = *(const u32x2*)sp, hi = *(const u32x2*)(sp + 4);
          __builtin_nontemporal_store(u32x4{lo.x, lo.y, hi.x, hi.y}, (u32x4*)(CT + ((size_t)(cm + ch) * 2 + b) * TB + tk0 + t8 * 8));
        }
      } else {
#pragma unroll
        for (int k = 0; k < 2; ++k) {
          const int idx = tid + NT * k, row = idx >> 2, c8 = idx & 3;
          const u16* sp = Tt + (cg * 32 + c8 * 8) * LDE + row;
          u32x4 o;
          o.x = (unsigned)sp[0] | ((unsigned)sp[LDE] << 16); o.y = (unsigned)sp[2 * LDE] | ((unsigned)sp[3 * LDE] << 16);
          o.z = (unsigned)sp[4 * LDE] | ((unsigned)sp[5 * LDE] << 16); o.w = (unsigned)sp[6 * LDE] | ((unsigned)sp[7 * LDE] << 16);
          __builtin_nontemporal_store(o, (u32x4*)(P + (size_t)(m0 + row) * NP + cm + c8 * 8));
        }
      }
    }
  }
}

DI void attn_prep(const Params& p, int l, int dry) {
  const int tid = my_tid(), lane = tid & 63, wid = tid >> 6;
  u16* P = (u16*)(p.ws + OFF_P);
  const float gq = pk(p, PK_QN)[l * 64 + lane], gk = pk(p, PK_KN)[l * 64 + lane];
  for (int row = blockIdx.x * 8 + wid; row < R; row += gridDim.x * 8) {
    u16* Pr = P + (size_t)row * NP;
    const int b = row / TB, tk = row - b * TB;
    float cs = 1.f, sn = 0.f;
    if (tk >= LC) {
      const int t = tk - LC, pi = lane >> 1;
      const float pos = (pi < 16) ? (float)(t >> 6) : (float)(t & 63);
      const float inv = powf(10000.f, -(float)(2 * (pi & 15)) / 32.f);
      sincosf(pos * inv, &sn, &cs);
    }
#pragma unroll
    for (int hd = 0; hd < 10; ++hd) {
      const int col = (hd < 8) ? PC_AQ + hd * 64 + lane : PC_AK + (hd - 8) * 64 + lane;
      float v = bf2f(Pr[col]);
      const float ss = wave_sum(v * v);
      v = v * rsqrtf(ss * (1.f / 64.f) + EPS) * (hd < 8 ? gq : gk);
      const float pv = __shfl_xor(v, 1);
      float o = (lane & 1) ? (pv * sn + v * cs) : (v * cs - pv * sn);
      if (hd < 8) o *= 0.125f * 1.4426950408889634f;
      if (!dry) Pr[col] = f2bf(o);
    }
  }
}

DI void fft_pass4_fwd(float2* X, int tid, int h2) {
  const float inv4 = 0.25f / (float)h2;
#pragma unroll 2
  for (int i = 0; i < 8; ++i) {
    const int g = tid + NT * i, jp = g & (h2 - 1), base = ((g - jp) << 2) + jp;
    float2 e0 = X[base], e1 = X[base + h2], e2 = X[base + 2 * h2], e3 = X[base + 3 * h2];
    const float fr = (float)jp * inv4;
    const float2 T1 = make_float2(__builtin_amdgcn_cosf(fr), -__builtin_amdgcn_sinf(fr));
    const float2 T2 = cmul(T1, T1);
    float2 a0 = cadd(e0, e2), a2 = cmul(csub(e0, e2), T1);
    float2 a1 = cadd(e1, e3), d13 = cmul(csub(e1, e3), T1);
    float2 a3 = make_float2(d13.y, -d13.x);
    X[base] = cadd(a0, a1); X[base + h2] = cmul(csub(a0, a1), T2);
    X[base + 2 * h2] = cadd(a2, a3); X[base + 3 * h2] = cmul(csub(a2, a3), T2);
  }
  __syncthreads();
}
DI void fft_pass4_inv(float2* X, int tid, int h1) {
  const float inv4 = 0.25f / (float)h1;
#pragma unroll 2
  for (int i = 0; i < 8; ++i) {
    const int g = tid + NT * i, jp = g & (h1 - 1), base = ((g - jp) << 2) + jp;
    float2 e0 = X[base], e1 = X[base + h1], e2 = X[base + 2 * h1], e3 = X[base + 3 * h1];
    const float fr = (float)jp * inv4;
    const float2 V = make_float2(__builtin_amdgcn_cosf(fr), __builtin_amdgcn_sinf(fr));
    const float2 Wc = cmul(V, V);
    float2 t1 = cmul(e1, Wc), t3 = cmul(e3, Wc);
    float2 a0 = cadd(e0, t1), a1 = csub(e0, t1), a2 = cadd(e2, t3), a3 = csub(e2, t3);
    float2 u2 = cmul(a2, V), u3 = cmul(a3, V);
    u3 = make_float2(-u3.y, u3.x);
    X[base] = cadd(a0, u2); X[base + 2 * h1] = csub(a0, u2);
    X[base + h1] = cadd(a1, u3); X[base + 3 * h1] = csub(a1, u3);
  }
  __syncthreads();
}
DI constexpr float r16c(int k) { return k == 0 ? 1.f : k == 1 ? 0.9238795325112867f : k == 2 ? 0.7071067811865476f : k == 3 ? 0.3826834323650898f : k == 4 ? 0.f : k == 5 ? -0.3826834323650898f : k == 6 ? -0.7071067811865476f : -0.9238795325112867f; }
DI constexpr float r16s(int k) { return k == 0 ? 0.f : k == 1 ? 0.3826834323650898f : k == 2 ? 0.7071067811865476f : k == 3 ? 0.9238795325112867f : k == 4 ? 1.f : k == 5 ? 0.9238795325112867f : k == 6 ? 0.7071067811865476f : 0.3826834323650898f; }
template <bool INV>
DI void fft_pass16(float2* X, int tid, int q) {
  const float invq = 1.f / (16.f * (float)q);
#pragma unroll 1
  for (int it = 0; it < 2; ++it) {
    const int g = tid + NT * it, jp = g & (q - 1), base = ((g - jp) << 4) + jp;
    float vx[16], vy[16];
#pragma unroll
    for (int r = 0; r < 16; ++r) { const float2 e = X[base + r * q]; vx[r] = e.x; vy[r] = e.y; }
    const float th = (float)jp * invq;
    float bx[4], by[4];
    bx[0] = __builtin_amdgcn_cosf(th); by[0] = INV ? __builtin_amdgcn_sinf(th) : -__builtin_amdgcn_sinf(th);
#pragma unroll
    for (int s = 1; s < 4; ++s) { bx[s] = bx[s - 1] * bx[s - 1] - by[s - 1] * by[s - 1]; by[s] = 2.f * bx[s - 1] * by[s - 1]; }
#pragma unroll
    for (int ss = 0; ss < 4; ++ss) {
      const int s = INV ? 3 - ss : ss;
      const int rs = 8 >> s;
#pragma unroll
      for (int bf = 0; bf < 8; ++bf) {
        const int r = ((bf & ~(rs - 1)) << 1) | (bf & (rs - 1));
        const int k = (r & (rs - 1)) * (8 / rs);
        const float cc = r16c(k), cs = INV ? r16s(k) : -r16s(k);
        const float tx = bx[s] * cc - by[s] * cs, ty = bx[s] * cs + by[s] * cc;
        const float ax = vx[r], ay = vy[r], cx = vx[r + rs], cy = vy[r + rs];
        if (!INV) {
          const float dx = ax - cx, dy = ay - cy;
          vx[r] = ax + cx; vy[r] = ay + cy;
          vx[r + rs] = dx * tx - dy * ty; vy[r + rs] = dx * ty + dy * tx;
        } else {
          const float ux = cx * tx - cy * ty, uy = cx * ty + cy * tx;
          vx[r] = ax + ux; vy[r] = ay + uy;
          vx[r + rs] = ax - ux; vy[r + rs] = ay - uy;
        }
      }
    }
#pragma unroll
    for (int r = 0; r < 16; ++r) X[base + r * q] = make_float2(vx[r], vy[r]);
  }
  __syncthreads();
}
DI void fft_fwd(float2* X, int tid) {
#pragma unroll 1
  for (int q = 1024; q >= 4; q >>= 4) fft_pass16<false>(X, tid, q);
  fft_pass4_fwd(X, tid, 1);
}
DI void fft_inv(float2* X, int tid) {
  fft_pass4_inv(X, tid, 1);
#pragma unroll 1
  for (int q = 4; q <= 1024; q <<= 4) fft_pass16<true>(X, tid, q);
}
DI float sconv_at(const u16* src, int t, int len, float w0, float w1, float w2, float bb) {
  float ym = t > 0 ? bf2f(src[t - 1]) : 0.f, y0 = bf2f(src[t]), yp = t < len - 1 ? bf2f(src[t + 1]) : 0.f;
  return bb + w0 * ym + w1 * y0 + w2 * yp;
}
DI float hy_delta(int col) {
  const float A0 = -4.605170185988091f / 0.3f, A1 = -4.605170185988091f / 1.5f;
  return fabsf(A0 + (A1 - A0) * ((float)col / 2047.f));
}

DI void hyena_latent_task(const Params& p, int l, int c, char* smem, int dry) {
  float2* X = (float2*)smem;
  float* red = (float*)(smem + 131072);
  const int tid = my_tid(), lane = tid & 63, wid = tid >> 6;
  u16* CT = (u16*)(p.ws + OFF_CT);
  float2* FE = (float2*)(p.ws + OFF_FS + (size_t)blockIdx.x * 262144);
  float2* FO = FE + 16384;
  const unsigned* h2T = (const unsigned*)(p.ws + OFF_H2T) + (size_t)l * 64 * (L / 2);
  const float* f3w = pk(p, PK_F3) + (size_t)l * 64 * 2048;
  const float* cw = pk(p, PK_CW) + (size_t)l * 3 * 1536;
  const float* cbv = pk(p, PK_CB) + (size_t)l * 1536;
  const float vw0 = cw[c], vw1 = cw[1536 + c], vw2 = cw[3072 + c], vbb = cbv[c];
  const u16* v0 = CT + ((size_t)(CH_YU + c) * 2 + 0) * TB + LC;
  const u16* v1 = CT + ((size_t)(CH_YU + c) * 2 + 1) * TB + LC;
  u16* z10 = CT + ((size_t)(CH_YU + 512 + c) * 2 + 0) * TB + LC;
  u16* z11 = CT + ((size_t)(CH_YU + 512 + c) * 2 + 1) * TB + LC;
#pragma unroll 1
  for (int o = 0; o < 2; ++o) {
    const int cf = o * 1024 + c, cbk = cf + 512;
    float sf = 0.f, sb = 0.f;
    __syncthreads();
#ifdef PROBE_FFT
    fft_fwd(X, tid); fft_inv(X, tid);
#endif
#pragma unroll 1
    for (int half = 0; half < 2; ++half) {
      float af[16], ab[16];
#pragma unroll
      for (int i = 0; i < 16; ++i) { af[i] = 0.f; ab[i] = 0.f; }
#pragma unroll 1
      for (int j = 0; j < 64; j += 2) {
        const float wf0 = f3w[j * 2048 + cf], wb0 = f3w[j * 2048 + cbk], wf1 = f3w[(j + 1) * 2048 + cf], wb1 = f3w[(j + 1) * 2048 + cbk];
        const unsigned* hrow = h2T + (size_t)j * (L / 2) + tid + half * 8 * NT;
        unsigned w0[8], w1[8];
#pragma unroll
        for (int i = 0; i < 8; ++i) { w0[i] = hrow[NT * i]; w1[i] = hrow[L / 2 + NT * i]; }
#pragma unroll
        for (int i = 0; i < 8; ++i) {
          const float a0 = bflo(w0[i]), a1 = bfhi(w0[i]), b0 = bflo(w1[i]), b1 = bfhi(w1[i]);
          af[2 * i] += a0 * wf0 + b0 * wf1; af[2 * i + 1] += a1 * wf0 + b1 * wf1;
          ab[2 * i] += a0 * wb0 + b0 * wb1; ab[2 * i + 1] += a1 * wb0 + b1 * wb1;
        }
      }
      const float df = hy_delta(cf), db = hy_delta(cbk);
#pragma unroll
      for (int i = 0; i < 16; ++i) {
        const int t = 2 * (tid + NT * ((i >> 1) + half * 8)) + (i & 1); const float tt = (float)t / (float)(L - 1);
        const float vf = af[i] * (__expf(-tt * df) + 0.05f), vb = ab[i] * (__expf(-tt * db) + 0.05f);
        sf += fabsf(vf); sb += fabsf(vb);
        X[t].x = vf;
        if (t >= 1) X[L - t].y = vb; else X[0].y = 0.f;
      }
    }
    sf = wave_sum(sf); sb = wave_sum(sb);
    if (lane == 0) { red[wid] = sf; red[8 + wid] = sb; }
    __syncthreads();
    float nf = 0.f, nbk = 0.f;
#pragma unroll
    for (int w = 0; w < 8; ++w) { nf += red[w]; nbk += red[8 + w]; }
    const float inv_f = 1.f / nf, inv_b = 1.f / nbk;
#pragma unroll 8
    for (int i = 0; i < 32; ++i) { const int n = tid + NT * i; const float2 s = X[n]; FO[n] = s; X[n] = make_float2(s.x * inv_f + s.y * inv_b, 0.f); }
    __syncthreads();
    fft_fwd(X, tid);
#pragma unroll 8
    for (int i = 0; i < 32; ++i) { const int n = tid + NT * i; FE[n] = X[n]; }
    __syncthreads();
#pragma unroll 8
    for (int i = 0; i < 32; ++i) {
      const int n = tid + NT * i; const float2 s = FO[n]; const float dd = s.x * inv_f - s.y * inv_b; const float fr = (float)n * (1.f / 32768.f);
      X[n] = make_float2(dd * __builtin_amdgcn_cosf(fr), -dd * __builtin_amdgcn_sinf(fr));
    }
    __syncthreads();
    fft_fwd(X, tid);
#pragma unroll 8
    for (int i = 0; i < 32; ++i) { const int n = tid + NT * i; FO[n] = X[n]; }
    __syncthreads();
#pragma unroll 8
    for (int i = 0; i < 32; ++i) {
      const int n = tid + NT * i;
      float2 zz;
      if (o == 0) { zz.x = sconv_at(v0, n, L, vw0, vw1, vw2, vbb); zz.y = sconv_at(v1, n, L, vw0, vw1, vw2, vbb); }
      else { zz.x = bf2f(z10[n]); zz.y = bf2f(z11[n]); }
      X[n] = zz;
    }
    __syncthreads();
    fft_fwd(X, tid);
#pragma unroll 8
    for (int i = 0; i < 32; ++i) { const int n = tid + NT * i; X[n] = cmul(X[n], FE[n]); }
    __syncthreads();
    fft_inv(X, tid);
#pragma unroll 8
    for (int i = 0; i < 32; ++i) { const int n = tid + NT * i; FE[n] = X[n]; }
    __syncthreads();
#pragma unroll 8
    for (int i = 0; i < 32; ++i) {
      const int n = tid + NT * i; const float fr = (float)n * (1.f / 32768.f);
      float2 zz;
      if (o == 0) { zz.x = sconv_at(v0, n, L, vw0, vw1, vw2, vbb); zz.y = sconv_at(v1, n, L, vw0, vw1, vw2, vbb); }
      else { zz.x = bf2f(z10[n]); zz.y = bf2f(z11[n]); }
      X[n] = cmul(zz, make_float2(__builtin_amdgcn_cosf(fr), -__builtin_amdgcn_sinf(fr)));
    }
    __syncthreads();
    fft_fwd(X, tid);
#pragma unroll 8
    for (int i = 0; i < 32; ++i) { const int n = tid + NT * i; X[n] = cmul(X[n], FO[n]); }
    __syncthreads();
    fft_inv(X, tid);
    {
      const int gch = CH_YU + 512 * (o + 1) + c;
      const float w0 = cw[gch], w1 = cw[1536 + gch], w2 = cw[3072 + gch], bb = cbv[gch];
      const u16* s0 = CT + ((size_t)gch * 2 + 0) * TB + LC;
      const u16* s1 = CT + ((size_t)gch * 2 + 1) * TB + LC;
      const float sk = pk(p, PK_SK)[(l * 2 + o) * 512 + c];
#pragma unroll 8
      for (int i = 0; i < 32; ++i) {
        const int n = tid + NT * i; const float fr = (float)n * (1.f / 32768.f);
        const float2 wb = cmul(X[n], make_float2(__builtin_amdgcn_cosf(fr), __builtin_amdgcn_sinf(fr)));
        const float2 A = FE[n];
        const float yr = (A.x + wb.x) * (1.f / 32768.f), yi = (A.y + wb.y) * (1.f / 32768.f);
        const float g0 = sconv_at(s0, n, L, w0, w1, w2, bb), g1 = sconv_at(s1, n, L, w0, w1, w2, bb);
        float2 zz;
        if (o == 0) { zz.x = sconv_at(v0, n, L, vw0, vw1, vw2, vbb); zz.y = sconv_at(v1, n, L, vw0, vw1, vw2, vbb); }
        else { zz.x = bf2f(z10[n]); zz.y = bf2f(z11[n]); }
        X[n] = make_float2(g0 * (yr + sk * zz.x), g1 * (yi + sk * zz.y));
      }
    }
    __syncthreads();
    if (o == 0) {
#pragma unroll 8
      for (int i = 0; i < 32; ++i) { const int n = tid + NT * i; const float2 zz = X[n]; if (!dry) { z10[n] = f2bf(zz.x); z11[n] = f2bf(zz.y); } }
    } else {
      u16* d0 = CT + ((size_t)(CH_YZ + c) * 2 + 0) * TB + LC;
      u16* d1 = CT + ((size_t)(CH_YZ + c) * 2 + 1) * TB + LC;
#pragma unroll 1
      for (int ib = 0; ib < 32; ib += 8) {
        u16 g0[8], g1[8];
#pragma unroll
        for (int i = 0; i < 8; ++i) { const int n = tid + NT * (ib + i); g0[i] = d0[n]; g1[i] = d1[n]; }
#pragma unroll
        for (int i = 0; i < 8; ++i) {
          const int n = tid + NT * (ib + i); const float2 zz = X[n];
          const u16 q0 = f2bf(zz.x * silu_f(bf2f(g0[i]))), q1 = f2bf(zz.y * silu_f(bf2f(g1[i])));
          if (!dry) { d0[n] = q0; d1[n] = q1; }
        }
      }
    }
    __syncthreads();
  }
}

DI void hyena_ctx_task(const Params& p, int l, int c, char* smem, int dry) {
  float* filt = (float*)smem;
  float* zs = filt + 1024;
  float* nrm = zs + 1024;
  const int tid = my_tid(), lane = tid & 63, wid = tid >> 6, t = tid & 255, hb = tid >> 8;
  u16* CT = (u16*)(p.ws + OFF_CT);
  const float* h2c = (const float*)(p.ws + OFF_H2C) + (size_t)l * 256 * 64;
  const float* f3w = pk(p, PK_F3) + (size_t)l * 64 * 2048;
  const float* cw = pk(p, PK_CW) + (size_t)l * 3 * 1536;
  const float* cbv = pk(p, PK_CB) + (size_t)l * 1536;
  __syncthreads();
  {
    const int cf = hb * 1024 + c, cbk = cf + 512;
    float a_f = 0.f, a_b = 0.f;
    for (int j = 0; j < 64; ++j) { const float hv = h2c[t * 64 + j]; a_f += hv * f3w[j * 2048 + cf]; a_b += hv * f3w[j * 2048 + cbk]; }
    const float tt = (float)t / 255.f;
    filt[(hb * 2 + 0) * 256 + t] = a_f * (__expf(-tt * hy_delta(cf)) + 0.05f);
    filt[(hb * 2 + 1) * 256 + t] = a_b * (__expf(-tt * hy_delta(cbk)) + 0.05f);
    const u16* src = CT + ((size_t)(CH_YU + c) * 2 + hb) * TB;
    zs[hb * 256 + t] = sconv_at(src, t, LC, cw[c], cw[1536 + c], cw[3072 + c], cbv[c]);
  }
  __syncthreads();
  if (wid < 4) {
    float s = 0.f;
    for (int k = 0; k < 4; ++k) s += fabsf(filt[wid * 256 + lane + 64 * k]);
    s = wave_sum(s);
    if (lane == 0) nrm[wid] = s;
  }
  __syncthreads();
  const int b = hb;
  for (int o = 0; o < 2; ++o) {
    const float inf_ = 1.f / nrm[o * 2], inb_ = 1.f / nrm[o * 2 + 1];
    const float* hf = filt + (o * 2) * 256; const float* hbk = filt + (o * 2 + 1) * 256;
    const float* zc = zs + (o & 1) * 512 + b * 256;
    float accf = 0.f, accb = 0.f;
    for (int s = 0; s <= t; ++s) accf += hf[t - s] * zc[s];
    for (int s = t + 1; s < 256; ++s) accb += hbk[s - t] * zc[s];
    const int gch = CH_YU + 512 * (o + 1) + c;
    const float gate = sconv_at(CT + ((size_t)gch * 2 + b) * TB, t, LC, cw[gch], cw[1536 + gch], cw[3072 + gch], cbv[gch]);
    const float zn = gate * (accf * inf_ + accb * inb_ + pk(p, PK_SK)[(l * 2 + o) * 512 + c] * zc[t]);
    zs[((o + 1) & 1) * 512 + b * 256 + t] = zn;
    __syncthreads();
  }
  {
    u16* d = CT + ((size_t)(CH_YZ + c) * 2 + b) * TB;
    const u16 q0 = f2bf(zs[b * 256 + t] * silu_f(bf2f(d[t])));
    if (!dry) d[t] = q0;
  }
  __syncthreads();
}

DI void gla_bcum(const Params& p, int l, int row0, int hh, int dir, float* gs, float* segs, float* was, float* as_) {
  const int tid = my_tid();
  const u16* P = (const u16*)(p.ws + OFF_P);
  const float* wa = pk(p, dir ? PK_WAB : PK_WAF) + (size_t)l * 16 * 256 + hh * 64;
  const float* ba = pk(p, dir ? PK_BAB : PK_BAF) + l * 256 + hh * 64;
#pragma unroll
  for (int i = 0; i < 2; ++i) {
    const int idx = tid + NT * i;
    was[idx] = wa[(idx >> 6) * 256 + (idx & 63)];
    as_[(idx >> 4) * 17 + (idx & 15)] = bf2f(P[(size_t)(row0 + (idx >> 4)) * NP + PC_AF + dir * 16 + (idx & 15)]);
  }
  __syncthreads();
  {
    const int t = tid >> 3, d0 = (tid & 7) * 8;
    float lin[8];
#pragma unroll
    for (int e = 0; e < 8; ++e) lin[e] = ba[d0 + e];
#pragma unroll 2
    for (int rr = 0; rr < 16; ++rr) {
      const float av = as_[t * 17 + rr];
      const float4 w0 = *(const float4*)(was + rr * 64 + d0), w1 = *(const float4*)(was + rr * 64 + d0 + 4);
      lin[0] += av * w0.x; lin[1] += av * w0.y; lin[2] += av * w0.z; lin[3] += av * w0.w;
      lin[4] += av * w1.x; lin[5] += av * w1.y; lin[6] += av * w1.z; lin[7] += av * w1.w;
    }
#pragma unroll
    for (int e = 0; e < 8; ++e) gs[t * 65 + d0 + e] = (fminf(lin[e], 0.f) - log1pf(__expf(-fabsf(lin[e])))) * (1.f / 16.f);
  }
  __syncthreads();
  {
    const int d = tid & 63, seg = tid >> 6;
    float v[8]; float run = 0.f;
#pragma unroll
    for (int e = 0; e < 8; ++e) { const int tt = dir ? seg * 8 + 7 - e : seg * 8 + e; run += gs[tt * 65 + d]; v[e] = run; }
    segs[seg * 64 + d] = run;
    __syncthreads();
    float off = 0.f;
#pragma unroll
    for (int s = 0; s < 8; ++s) { const bool before = dir ? (s > seg) : (s < seg); if (before) off += segs[s * 64 + d]; }
#pragma unroll
    for (int e = 0; e < 8; ++e) { const int tt = dir ? seg * 8 + 7 - e : seg * 8 + e; gs[tt * 65 + d] = v[e] + off; }
  }
  __syncthreads();
}
DI int gla_tok0(int dir, int n) {
  if (n < 4) return (dir ? 3 - n : n) * 64;
  return LC + (dir ? 255 - (n - 4) : n - 4) * 64;
}
constexpr int G_GS = 0;
constexpr int G_SEG = G_GS + 64 * 65 * 4;
constexpr int G_QS = G_SEG + 8 * 64 * 4;
constexpr int G_KS = G_QS + 64 * LDT * 2;
constexpr int G_VT = G_KS + 64 * LDT * 2;
constexpr int G_ST = G_VT + 128 * LDT * 2;
constexpr int G_RED = G_ST + 128 * LDT * 2;
constexpr int G_WA = G_RED + 8 * 32 * 4;
constexpr int G_AS = G_WA + 16 * 64 * 4;

DI void gla_g1_task(const Params& p, int l, int chain, int n, char* smem) {
  const int tid = my_tid(), lane = tid & 63, wid = tid >> 6, r = lane & 31, h = lane >> 5;
  const int b = chain >> 3, hh = (chain >> 1) & 3, dir = chain & 1;
  const int tk0 = gla_tok0(dir, n), row0 = b * TB + tk0;
  float* gs = (float*)(smem + G_GS); float* segs = (float*)(smem + G_SEG);
  u16* kT = (u16*)(smem + G_KS); u16* vT = (u16*)(smem + G_VT);
  const u16* P = (const u16*)(p.ws + OFF_P);
  const u16* CT = (const u16*)(p.ws + OFF_CT);
  __syncthreads();
  gla_bcum(p, l, row0, hh, dir, gs, segs, (float*)(smem + G_WA), (float*)(smem + G_AS));
  const int tl = dir ? 0 : 63;
  {
    const int t = tid >> 3, d0 = (tid & 7) * 8;
    const u32x4 kv = *(const u32x4*)(P + (size_t)(row0 + t) * NP + PC_GK + hh * 64 + d0);
    const unsigned w[4] = {kv.x, kv.y, kv.z, kv.w};
#pragma unroll
    for (int e = 0; e < 8; ++e) {
      const float kx = (e & 1) ? bfhi(w[e >> 1]) : bflo(w[e >> 1]);
      kT[(d0 + e) * LDT + t] = f2bf(kx * __expf(gs[tl * 65 + d0 + e] - gs[t * 65 + d0 + e]));
    }
#pragma unroll
    for (int i = 0; i < 2; ++i) {
      const int q = tid + NT * i, v = q >> 3, cc = q & 7;
      *(u32x4*)(vT + v * LDT + cc * 8) = *(const u32x4*)(CT + ((size_t)(CH_GV + hh * 128 + v) * 2 + b) * TB + tk0 + cc * 8);
    }
    if (tid < 64) ((float*)(p.ws + OFF_GD))[((size_t)chain * NCK + n) * 64 + tid] = __expf(gs[tl * 65 + tid]);
  }
  __syncthreads();
  {
    const int vm = wid >> 1, dn = wid & 1;
    f32x16 acc = zero16();
#pragma unroll
    for (int s = 0; s < 4; ++s) {
      const bf16x8 a = *(const bf16x8*)(vT + (vm * 32 + r) * LDT + s * 16 + h * 8);
      const bf16x8 bb = *(const bf16x8*)(kT + (dn * 32 + r) * LDT + s * 16 + h * 8);
      acc = MFMA(a, bb, acc);
    }
    u16* GS = (u16*)(p.ws + OFF_GS) + ((size_t)chain * NCK + n) * 8192;
#pragma unroll
    for (int reg = 0; reg < 16; ++reg) GS[(vm * 32 + crow(reg, h)) * 64 + dn * 32 + r] = f2bf(acc[reg]);
  }
}
DI void gla_g2(const Params& p, int dry) {
  u16* GSb = (u16*)(p.ws + OFF_GS);
  const float* GD = (const float*)(p.ws + OFF_GD);
  for (int gi = blockIdx.x * NT + my_tid(); gi < 16 * 8192; gi += gridDim.x * NT) {
    const int chain = gi >> 13, e = gi & 8191, d = e & 63;
    u16* ptr = GSb + (size_t)chain * NCK * 8192 + e;
    const float* dec = GD + (size_t)chain * NCK * 64 + d;
    float S = 0.f;
#pragma unroll 1
    for (int n0 = 0; n0 < NCK; n0 += 20) {
      float ds[20], a[20];
#pragma unroll
      for (int k = 0; k < 20; ++k) { ds[k] = bf2f(ptr[(size_t)(n0 + k) * 8192]); a[k] = dec[(n0 + k) * 64]; }
#pragma unroll
      for (int k = 0; k < 20; ++k) { if (!dry) ptr[(size_t)(n0 + k) * 8192] = f2bf(S); S = a[k] * S + ds[k]; }
    }
  }
}
DI void gla_g3_task(const Params& p, int l, int b, int hh, int ci, char* smem, int dry) {
  const int tid = my_tid(), lane = tid & 63, wid = tid >> 6, r = lane & 31, h = lane >> 5;
  const int tk0 = ci * 64, row0 = b * TB + tk0;
  float* gs = (float*)(smem + G_GS); float* segs = (float*)(smem + G_SEG); float* red = (float*)(smem + G_RED);
  u16* qs = (u16*)(smem + G_QS); u16* ks = (u16*)(smem + G_KS); u16* vT = (u16*)(smem + G_VT); u16* sT = (u16*)(smem + G_ST);
  u16* P = (u16*)(p.ws + OFF_P);
  const u16* CT = (const u16*)(p.ws + OFF_CT);
  const int vm = wid >> 1, in = wid & 1;
  f32x16 o = zero16();
  __syncthreads();
#pragma unroll 1
  for (int dir = 0; dir < 2; ++dir) {
    gla_bcum(p, l, row0, hh, dir, gs, segs, (float*)(smem + G_WA), (float*)(smem + G_AS));
    const int chain = b * 8 + hh * 2 + dir;
    const int n = dir ? ((ci < 4) ? 3 - ci : 263 - ci) : ci;
    {
      const int t = tid >> 3, d0 = (tid & 7) * 8;
      const u32x4 qv = *(const u32x4*)(P + (size_t)(row0 + t) * NP + PC_GQ + hh * 64 + d0);
      const u32x4 kv = *(const u32x4*)(P + (size_t)(row0 + t) * NP + PC_GK + hh * 64 + d0);
      const unsigned qw[4] = {qv.x, qv.y, qv.z, qv.w}, kw[4] = {kv.x, kv.y, kv.z, kv.w};
      unsigned qo[4], ko[4];
#pragma unroll
      for (int e = 0; e < 4; ++e) {
        const float b0 = gs[t * 65 + d0 + 2 * e], b1 = gs[t * 65 + d0 + 2 * e + 1];
        qo[e] = pack2(bflo(qw[e]) * 0.125f * __expf(b0), bfhi(qw[e]) * 0.125f * __expf(b1));
        ko[e] = pack2(bflo(kw[e]) * __expf(-b0), bfhi(kw[e]) * __expf(-b1));
      }
      *(u32x4*)(qs + t * LDT + d0) = u32x4{qo[0], qo[1], qo[2], qo[3]};
      *(u32x4*)(ks + t * LDT + d0) = u32x4{ko[0], ko[1], ko[2], ko[3]};
      const u16* GS = (const u16*)(p.ws + OFF_GS) + ((size_t)chain * NCK + n) * 8192;
#pragma unroll
      for (int i = 0; i < 2; ++i) {
        const int q = tid + NT * i, v = q >> 3, cc = q & 7;
        *(u32x4*)(sT + v * LDT + cc * 8) = *(const u32x4*)(GS + v * 64 + cc * 8);
        if (dir == 0) *(u32x4*)(vT + v * LDT + cc * 8) = *(const u32x4*)(CT + ((size_t)(CH_GV + hh * 128 + v) * 2 + b) * TB + tk0 + cc * 8);
      }
    }
    __syncthreads();
    bf16x8 qf[4];
#pragma unroll
    for (int s = 0; s < 4; ++s) qf[s] = *(const bf16x8*)(qs + (in * 32 + r) * LDT + s * 16 + h * 8);
#pragma unroll
    for (int jt = 0; jt < 2; ++jt) {
      f32x16 at = zero16();
#pragma unroll
      for (int s = 0; s < 4; ++s) at = MFMA(*(const bf16x8*)(ks + (jt * 32 + r) * LDT + s * 16 + h * 8), qf[s], at);
      const int ii = in * 32 + r;
#pragma unroll
      for (int reg = 0; reg < 16; ++reg) {
        const int jj = jt * 32 + crow(reg, h);
        const bool keep = dir ? (jj >= ii) : (jj <= ii);
        if (!keep) at[reg] = 0.f;
      }
#pragma unroll
      for (int s = 0; s < 2; ++s) {
        const u16* vp = vT + (vm * 32 + r) * LDT + jt * 32 + 16 * s + 4 * h;
        o = MFMA(ld2x64(vp, vp + 8), pack8(at, s), o);
      }
    }
#pragma unroll
    for (int s = 0; s < 4; ++s) o = MFMA(*(const bf16x8*)(sT + (vm * 32 + r) * LDT + s * 16 + h * 8), qf[s], o);
    __syncthreads();
  }
  float ss = 0.f;
#pragma unroll
  for (int reg = 0; reg < 16; ++reg) ss += o[reg] * o[reg];
  ss += __shfl_xor(ss, 32);
  if (h == 0) red[wid * 32 + r] = ss;
  __syncthreads();
  float tot = 0.f;
#pragma unroll
  for (int m = 0; m < 4; ++m) tot += red[(m * 2 + in) * 32 + r];
  const float rs = rsqrtf(tot * (1.f / 128.f) + EPS);
  u16* zp = P + (size_t)(row0 + in * 32 + r) * NP + PC_GZ + hh * 128 + vm * 32 + 4 * h;
  const float* gn = pk(p, PK_GN) + l * 128 + vm * 32 + 4 * h;
#pragma unroll
  for (int g = 0; g < 4; ++g) {
    const u32x2 zz = *(const u32x2*)(zp + 8 * g);
    const float4 gw = *(const float4*)(gn + 8 * g);
    u32x2 out;
    out.x = pack2(o[4 * g] * rs * gw.x * silu_f(bflo(zz.x)), o[4 * g + 1] * rs * gw.y * silu_f(bfhi(zz.x)));
    out.y = pack2(o[4 * g + 2] * rs * gw.z * silu_f(bflo(zz.y)), o[4 * g + 3] * rs * gw.w * silu_f(bfhi(zz.y)));
    if (!dry) *(u32x2*)(zp + 8 * g) = out;
  }
}

DI void attn_item(const Params& p, int l, int b, int g, int qtk0, int ntiles, char* smem, int dry) {
  const int tid = my_tid(), lane = tid & 63, wid = tid >> 6, r = lane & 31, h = lane >> 5;
  u16* P = (u16*)(p.ws + OFF_P);
  const u16* CT = (const u16*)(p.ws + OFF_CT);
  u16* Ks = (u16*)smem;
  u16* Vs = Ks + 2 * 64 * LDT;
  const int hq = g * 4 + (wid >> 1);
  const size_t qrow = (size_t)b * TB + qtk0 + (wid & 1) * 32 + r;
  bf16x8 qf[4];
#pragma unroll
  for (int s = 0; s < 4; ++s) qf[s] = *(const bf16x8*)(P + qrow * NP + PC_AQ + hq * 64 + s * 16 + h * 8);
  f32x16 O[2] = {zero16(), zero16()};
  float m = -1e30f, lsum = 0.f;
  const int lr = tid >> 3, lc = (tid & 7) * 8;
  const u16* kg = P + ((size_t)b * TB + lr) * NP + PC_AK + g * 64 + lc;
  const u16* vg = CT + ((size_t)(CH_AV + g * 64 + lr) * 2 + b) * TB + lc;
  u32x4 rk = *(const u32x4*)kg, rv = *(const u32x4*)vg;
  __syncthreads();
  *(u32x4*)(Ks + lr * LDT + lc) = rk; *(u32x4*)(Vs + lr * LDT + lc) = rv;
  __syncthreads();
  float gqm = fabsf(pk(p, PK_QN)[l * 64 + lane]), gkm = fabsf(pk(p, PK_KN)[l * 64 + lane]);
#pragma unroll
  for (int o = 32; o >= 1; o >>= 1) { gqm = fmaxf(gqm, __shfl_xor(gqm, o)); gkm = fmaxf(gkm, __shfl_xor(gkm, o)); }
  const float mshift = 8.2f * 1.4426950408889634f * gqm * gkm;
  if (mshift <= 60.f) {
    f32x16 sinit;
#pragma unroll
    for (int i = 0; i < 16; ++i) sinit[i] = -mshift;
#pragma unroll 1
    for (int kt = 0; kt < ntiles; ++kt) {
      const int cur = kt & 1;
      if (kt + 1 < ntiles) { rk = *(const u32x4*)(kg + (size_t)(kt + 1) * 64 * NP); rv = *(const u32x4*)(vg + (kt + 1) * 64); }
      const u16* Kc = Ks + cur * 64 * LDT; const u16* Vc = Vs + cur * 64 * LDT;
      f32x16 st[2];
#pragma unroll
      for (int kk = 0; kk < 2; ++kk) {
        st[kk] = sinit;
#pragma unroll
        for (int s = 0; s < 4; ++s) st[kk] = MFMA(*(const bf16x8*)(Kc + (kk * 32 + r) * LDT + s * 16 + h * 8), qf[s], st[kk]);
      }
#pragma unroll
      for (int kk = 0; kk < 2; ++kk)
#pragma unroll
        for (int i = 0; i < 16; ++i) { const float pv = __builtin_amdgcn_exp2f(st[kk][i]); st[kk][i] = pv; lsum += pv; }
#pragma unroll
      for (int kk = 0; kk < 2; ++kk)
#pragma unroll
        for (int s = 0; s < 2; ++s) {
          const bf16x8 pb = pack8(st[kk], s);
#pragma unroll
          for (int mt = 0; mt < 2; ++mt) {
            const u16* vp = Vc + (mt * 32 + r) * LDT + kk * 32 + 16 * s + 4 * h;
            O[mt] = MFMA(ld2x64(vp, vp + 8), pb, O[mt]);
          }
        }
      if (kt + 1 < ntiles) { *(u32x4*)(Ks + (cur ^ 1) * 64 * LDT + lr * LDT + lc) = rk; *(u32x4*)(Vs + (cur ^ 1) * 64 * LDT + lr * LDT + lc) = rv; }
      __syncthreads();
    }
  } else {
#pragma unroll 1
    for (int kt = 0; kt < ntiles; ++kt) {
      const int cur = kt & 1;
      if (kt + 1 < ntiles) { rk = *(const u32x4*)(kg + (size_t)(kt + 1) * 64 * NP); rv = *(const u32x4*)(vg + (kt + 1) * 64); }
      const u16* Kc = Ks + cur * 64 * LDT; const u16* Vc = Vs + cur * 64 * LDT;
      f32x16 st[2];
#pragma unroll
      for (int kk = 0; kk < 2; ++kk) {
        st[kk] = zero16();
#pragma unroll
        for (int s = 0; s < 4; ++s) st[kk] = MFMA(*(const bf16x8*)(Kc + (kk * 32 + r) * LDT + s * 16 + h * 8), qf[s], st[kk]);
      }
      float mx = st[0][0];
#pragma unroll
      for (int i = 0; i < 16; ++i) { mx = fmaxf(mx, st[0][i]); mx = fmaxf(mx, st[1][i]); }
      mx = fmaxf(mx, __shfl_xor(mx, 32));
      const float mn = fmaxf(m, mx);
      const float alpha = exp2f(m - mn);
      m = mn;
      float rsum = 0.f;
#pragma unroll
      for (int kk = 0; kk < 2; ++kk)
#pragma unroll
        for (int i = 0; i < 16; ++i) { const float pv = exp2f(st[kk][i] - mn); st[kk][i] = pv; rsum += pv; }
      lsum = lsum * alpha + rsum;
#pragma unroll
      for (int mt = 0; mt < 2; ++mt)
#pragma unroll
        for (int i = 0; i < 16; ++i) O[mt][i] *= alpha;
#pragma unroll
      for (int kk = 0; kk < 2; ++kk)
#pragma unroll
        for (int s = 0; s < 2; ++s) {
          const bf16x8 pb = pack8(st[kk], s);
#pragma unroll
          for (int mt = 0; mt < 2; ++mt) {
            const u16* vp = Vc + (mt * 32 + r) * LDT + kk * 32 + 16 * s + 4 * h;
            O[mt] = MFMA(ld2x64(vp, vp + 8), pb, O[mt]);
          }
        }
      if (kt + 1 < ntiles) { *(u32x4*)(Ks + (cur ^ 1) * 64 * LDT + lr * LDT + lc) = rk; *(u32x4*)(Vs + (cur ^ 1) * 64 * LDT + lr * LDT + lc) = rv; }
      __syncthreads();
    }
  }
  lsum += __shfl_xor(lsum, 32);
  const float inv = 1.f / lsum;
  u16* op = P + qrow * NP + PC_AQ + hq * 64 + 4 * h;
  const u16* zp = P + qrow * NP + PC_AZ + hq * 64 + 4 * h;
#pragma unroll
  for (int mt = 0; mt < 2; ++mt)
#pragma unroll
    for (int gg = 0; gg < 4; ++gg) {
      const u32x2 zz = *(const u32x2*)(zp + mt * 32 + 8 * gg);
      u32x2 out;
      out.x = pack2(O[mt][4 * gg] * inv * silu_f(bflo(zz.x)), O[mt][4 * gg + 1] * inv * silu_f(bfhi(zz.x)));
      out.y = pack2(O[mt][4 * gg + 2] * inv * silu_f(bflo(zz.y)), O[mt][4 * gg + 3] * inv * silu_f(bfhi(zz.y)));
      if (!dry) *(u32x2*)(op + mt * 32 + 8 * gg) = out;
    }
}

template <int KSU>
DI void gemm_gate3(const u16* __restrict__ A, const u16* __restrict__ WM, char* smem, f32x16 (&acc)[3][2]) {
  u16* As0 = (u16*)smem;
  u16* As1 = As0 + 128 * LDT;
  u16* Bs0 = As0 + 2 * 128 * LDT;
  u16* Bs1 = Bs0 + 384 * LDT;
  const int tid = my_tid(), lane = tid & 63, wid = tid >> 6, r = lane & 31, h = lane >> 5, wm = wid & 3, wn = wid >> 2;
  u32x4 ra0[2], rb0[6], ra1[2], rb1[6];
  auto fetch = [&](u32x4 (&ra)[2], u32x4 (&rb)[6], int k0) {
#pragma unroll
    for (int i = 0; i < 2; ++i) { const int q = tid + NT * i; const unsigned off = (unsigned)((q >> 3) * 1024 + (q & 7) * 8); ra[i] = *(const u32x4*)(A + off + k0); }
#pragma unroll
    for (int i = 0; i < 6; ++i) {
      const int q = tid + NT * i, row = q >> 3;
      const unsigned off = (unsigned)((row >> 7) * (1024 * 1024) + (row & 127) * 1024 + (q & 7) * 8);
      rb[i] = *(const u32x4*)(WM + off + k0);
    }
    GFENCE;
  };
  auto commit = [&](const u32x4 (&ra)[2], const u32x4 (&rb)[6], u16* As, u16* Bs) {
#pragma unroll
    for (int i = 0; i < 2; ++i) { const int q = tid + NT * i; *(u32x4*)(As + (q >> 3) * LDT + (q & 7) * 8) = ra[i]; }
#pragma unroll
    for (int i = 0; i < 6; ++i) { const int q = tid + NT * i; *(u32x4*)(Bs + (q >> 3) * LDT + (q & 7) * 8) = rb[i]; }
    GFENCE;
  };
  auto compute = [&](const u16* Ac, const u16* Bc) {
#pragma unroll KSU
    for (int ks = 0; ks < 4; ++ks) {
      const bf16x8 a = *(const bf16x8*)(Ac + (wm * 32 + r) * LDT + ks * 16 + h * 8);
#pragma unroll
      for (int br = 0; br < 3; ++br)
#pragma unroll
        for (int j = 0; j < 2; ++j)
          acc[br][j] = MFMA(a, *(const bf16x8*)(Bc + (br * 128 + wn * 64 + j * 32 + r) * LDT + ks * 16 + h * 8), acc[br][j]);
    }
  };
  constexpr int KT = 16;
  fetch(ra0, rb0, 0);
  fetch(ra1, rb1, 64);
  __syncthreads();
  commit(ra0, rb0, As0, Bs0);
  __syncthreads();
  fetch(ra0, rb0, 128);
#pragma unroll
  for (int kt = 0; kt < KT; kt += 2) {
    commit(ra1, rb1, As1, Bs1);
    if (kt + 3 < KT) fetch(ra1, rb1, (kt + 3) * 64);
    compute(As0, Bs0);
    __syncthreads();
    if (kt + 2 < KT) commit(ra0, rb0, As0, Bs0);
    if (kt + 4 < KT) fetch(ra0, rb0, (kt + 4) * 64);
    compute(As1, Bs1);
    __syncthreads();
  }
}
DI void phase_merge(const Params& p, int l, char* smem) {
  const int tid = my_tid(), lane = tid & 63, wid = tid >> 6, r = lane & 31, h = lane >> 5, wm = wid & 3, wn = wid >> 2;
  const int xcd = blockIdx.x & 7, nloc = gridDim.x >> 3;
  for (int q = blockIdx.x >> 3; q < 33 * 8; q += nloc) {
    const int mt = (q >> 3) * 8 + xcd, nt = q & 7, m0 = mt * 128, n0 = nt * 128;
    if (mt >= 260) continue;
    const int b = m0 / TB, tk0 = m0 - b * TB;
    if (l == 1 && tk0 < LC) continue;
    const u16* H = (const u16*)(p.ws + OFF_H) + (size_t)m0 * 1024;
    const u16* WM = (const u16*)(p.ws + OFF_WT + (size_t)l * WT_LAYER) + (size_t)(4896 + n0) * 1024;
    const u16* WBR = (const u16*)(p.ws + OFF_WT + (size_t)l * WT_LAYER + WT_IN) + (size_t)n0 * 512;
    unsigned gp[3][2][8];
    {
      f32x16 g3[3][2];
#pragma unroll
      for (int br = 0; br < 3; ++br) for (int j = 0; j < 2; ++j) g3[br][j] = zero16();
      gemm_gate3<2>(H, WM, smem, g3);
#pragma unroll
      for (int br = 0; br < 3; ++br)
#pragma unroll
        for (int j = 0; j < 2; ++j)
#pragma unroll
          for (int i = 0; i < 8; ++i)
            gp[br][j][i] = pack2(1.f / (1.f + __expf(-g3[br][j][2 * i])), 1.f / (1.f + __expf(-g3[br][j][2 * i + 1])));
    }
    f32x16 ysum[2] = {zero16(), zero16()};
#pragma unroll
    for (int br = 0; br < 3; ++br) {
      f32x16 ab[1][2] = {{zero16(), zero16()}};
      if (br < 2) {
        ALoadN ay{(const u16*)(p.ws + OFF_P) + (size_t)m0 * NP + (br == 0 ? PC_GZ : PC_AQ), NP};
        gemm_tile<128, ALoadN, 4, 512>(ay, WBR + (size_t)br * 1024 * 512, 512, smem, ab);
      } else {
        ALoadT ay{(const u16*)(p.ws + OFF_CT) + ((size_t)CH_YZ * 2 + b) * TB + tk0, (size_t)2 * TB};
        gemm_tile<128, ALoadT, 4, 512>(ay, WBR + (size_t)2 * 1024 * 512, 512, smem, ab);
      }
#pragma unroll
      for (int j = 0; j < 2; ++j)
#pragma unroll
        for (int i = 0; i < 8; ++i) {
          ysum[j][2 * i] += bflo(gp[br][j][i]) * ab[0][j][2 * i];
          ysum[j][2 * i + 1] += bfhi(gp[br][j][i]) * ab[0][j][2 * i + 1];
        }
    }
    u16* Y = (u16*)(p.ws + OFF_Y) + (size_t)(m0 + wm * 32 + 4 * h) * 1024 + n0 + wn * 64 + r;
#pragma unroll
    for (int j = 0; j < 2; ++j)
#pragma unroll
      for (int reg = 0; reg < 16; ++reg) Y[(size_t)((reg & 3) + 8 * (reg >> 2)) * 1024 + j * 32] = f2bf(ysum[j][reg]);
  }
}

DI void phase_out(const Params& p, int l, char* smem) {
  const int tid = my_tid(), lane = tid & 63, wid = tid >> 6, r = lane & 31, h = lane >> 5, wm = wid & 3, wn = wid >> 2;
  const u16* Yb = (const u16*)(p.ws + OFF_Y);
  const u16* WO = (const u16*)(p.ws + OFF_WT + (size_t)l * WT_LAYER + WT_IN + 3 * WT_BR);
  const float* mod = (const float*)(p.ws + OFF_MOD);
  const int xcd = blockIdx.x & 7, nloc = gridDim.x >> 3;
  auto tile_of = [&](int q, int& m0, int& n0) -> bool {
    const int mt = (q >> 3) * 8 + xcd; m0 = mt * 128; n0 = (q & 7) * 128;
    if (mt >= 260) return false;
    const int b = m0 / TB, tk0 = m0 - b * TB;
    return !(l == 1 && tk0 < LC);
  };
  auto next_q = [&](int q) -> int { int m, n; for (q += nloc; q < 33 * 8; q += nloc) if (tile_of(q, m, n)) return q; return -1; };
  int q = (int)(blockIdx.x >> 3) - nloc; q = next_q(q);
  if (q < 0) return;
  int m0, n0; tile_of(q, m0, n0);
  GemmRegs<128> gr;
  { ALoadN ay{Yb + (size_t)m0 * 1024, 1024}; gemm_prime<128>(gr, ay, WO + (size_t)n0 * 1024, 1024, smem); }
  while (true) {
    const int qn = next_q(q);
    int m0n = 0, n0n = 0; if (qn >= 0) tile_of(qn, m0n, n0n);
    const int b = m0 / TB, tk0 = m0 - b * TB;
    f32x16 acc[1][2] = {{zero16(), zero16()}};
    const ALoadN ay{Yb + (size_t)m0 * 1024, 1024}, ayn{Yb + (size_t)m0n * 1024, 1024};
    gemm_run<128, ALoadN, 4, 1024, ALoadN>(gr, ay, WO + (size_t)n0 * 1024, 1024, ayn, WO + (size_t)n0n * 1024, 1024, qn >= 0, smem, acc);
    const float* gv = mod + (l * 3 + (tk0 < LC ? 2 : b)) * 3072 + 2048;
    const float* xin = xrow_in(p, l, m0);
    float* xout = xrow_out(p, m0);
#pragma unroll
    for (int j = 0; j < 2; ++j) {
      const int col = n0 + wn * 64 + j * 32 + r;
      const float gate = gv[col];
#pragma unroll
      for (int reg = 0; reg < 16; ++reg) {
        const size_t off = (size_t)(wm * 32 + crow(reg, h)) * D + col;
        xout[off] = xin[off] + gate * acc[0][j][reg];
      }
    }
    if (qn < 0) break;
    q = qn; m0 = m0n; n0 = n0n;
  }
}

DI void phase_final(const Params& p) {
  const int tid = my_tid(), lane = tid & 63, wid = tid >> 6;
  for (int row = blockIdx.x * 8 + wid; row < NBATCH * L; row += gridDim.x * 8) {
    float* src = p.out + (size_t)row * D;
    float4 xv[4]; float ss = 0.f;
#pragma unroll
    for (int i = 0; i < 4; ++i) { xv[i] = *(const float4*)(src + (i * 64 + lane) * 4); ss += xv[i].x * xv[i].x + xv[i].y * xv[i].y + xv[i].z * xv[i].z + xv[i].w * xv[i].w; }
    ss = wave_sum(ss);
    const float rs = rsqrtf(ss * (1.f / 1024.f) + EPS);
#pragma unroll
    for (int i = 0; i < 4; ++i) {
      const int col = (i * 64 + lane) * 4;
      const float4 fw = *(const float4*)(pk(p, PK_FN) + col);
      *(float4*)(src + col) = make_float4(xv[i].x * rs * fw.x, xv[i].y * rs * fw.y, xv[i].z * rs * fw.z, xv[i].w * rs * fw.w);
    }
  }
}

DI void run_phase(const Params& p, int ph, char* smem, int dry = 0) {
  const int bid = blockIdx.x, nb = gridDim.x;
  if (ph == 0) { phase0(p, smem); return; }
  if (ph == 17) { phase_final(p); return; }
  const int l = (ph - 1) >> 3, s = (ph - 1) & 7;
  switch (s) {
    case 0: phase_norm(p, l); break;
    case 1: phase_proj(p, l, smem); break;
    case 2: {
      attn_prep(p, l, dry);
      if (l == 0) for (int c = bid; c < 512; c += nb) hyena_ctx_task(p, l, c, smem, dry);
      for (int c = bid; c < 512; c += nb) hyena_latent_task(p, l, c, smem, dry);
    } break;
    case 3: for (int t = bid; t < 16 * NCK; t += nb) gla_g1_task(p, l, t / NCK, t % NCK, smem); break;
    case 4: gla_g2(p, dry); break;
    case 5: {
      for (int it = bid; it < 1024; it += nb) { const int b = it >> 9, g = (it >> 8) & 1, qb = it & 255; attn_item(p, l, b, g, LC + qb * 64, NCK, smem, dry); }
      if (l == 0) for (int it = bid; it < 16; it += nb) { const int b = it >> 3, g = (it >> 2) & 1, qb = it & 3; attn_item(p, l, b, g, qb * 64, 4, smem, dry); }
      const int c0 = (l == 0) ? 0 : 4, per = NCK - c0;
      for (int t = bid; t < 8 * per; t += nb) { const int bh = t / per, ci = c0 + t % per; gla_g3_task(p, l, bh >> 2, bh & 3, ci, smem, dry); }
    } break;
    case 6: phase_merge(p, l, smem); break;
    case 7: phase_out(p, l, smem); break;
  }
}

#if MULTI_LAUNCH
template <int PH> __global__ void __launch_bounds__(NT) phase_kernel(Params p) {
  extern __shared__ __attribute__((aligned(16))) char smem[];
  run_phase(p, PH, smem);
}
template <int PH> static void launch_phase(const Params& p, int grid, hipStream_t stream) {
  static bool attr = false;
  if (!attr) { (void)hipFuncSetAttribute((const void*)phase_kernel<PH>, hipFuncAttributeMaxDynamicSharedMemorySize, LDS_BYTES); attr = true; }
  hipLaunchKernelGGL(phase_kernel<PH>, dim3(grid), dim3(NT), LDS_BYTES, stream, p);
}
#else
DI unsigned xb_ld(unsigned* q) { return __hip_atomic_load(q, __ATOMIC_RELAXED, __HIP_MEMORY_SCOPE_AGENT); }
DI unsigned xb_add(unsigned* q, unsigned v) { return __hip_atomic_fetch_add(q, v, __ATOMIC_RELAXED, __HIP_MEMORY_SCOPE_AGENT); }
DI unsigned xb_xcc_id() { return (unsigned)__builtin_amdgcn_s_getreg((3 << 11) | 20) & 0xFu; }
#define XB_SPIN(cond) do { unsigned sp_ = 0; while ((cond) && ++sp_ < 400000u) __builtin_amdgcn_s_sleep(1); } while (0)
DI void gbar_census(const Params& p) {
  if (threadIdx.x == 0) (void)xb_add((unsigned*)(p.ws + OFF_BAR) + xb_xcc_id() * 64, 1u);
}
DI void gbar_setup(const Params& p, char* smem) {
  if (threadIdx.x == 0) {
    unsigned* bar = (unsigned*)(p.ws + OFF_BAR);
    const unsigned x = xb_xcc_id();
    unsigned mine = 1u, cnt = 0u;
    for (unsigned j = 0; j < 16; ++j) { const unsigned c = xb_ld(bar + j * 64); cnt += (c > 0u) ? 1u : 0u; if (j == x) mine = c; }
    volatile unsigned* st = (volatile unsigned*)(smem + BAR_LDS);
    st[0] = mine > 0u ? mine : 1u; st[1] = cnt > 0u ? cnt : 1u;
  }
  __syncthreads();
}
DI void gbar(const Params& p, unsigned k, char* smem) {
  asm volatile("s_waitcnt vmcnt(0)" ::: "memory");
  __syncthreads();
  if (threadIdx.x == 0) {
    unsigned* bar = (unsigned*)(p.ws + OFF_BAR);
    volatile unsigned* st = (volatile unsigned*)(smem + BAR_LDS);
    const unsigned nloc = st[0], nx = st[1], x = xb_xcc_id();
    __builtin_amdgcn_s_waitcnt(0);
    const unsigned old = xb_add(bar + (16 + x) * 64, 1u);
    if (old + 1u == k * nloc) {
      __builtin_amdgcn_fence(__ATOMIC_RELEASE, "agent");
      asm volatile("s_waitcnt vmcnt(0)" ::: "memory");
      const unsigned og = xb_add(bar + 48 * 64, 1u);
      if (og + 1u == k * nx) xb_add(bar + 49 * 64, 1u);
      else XB_SPIN(xb_ld(bar + 49 * 64) < k);
      __builtin_amdgcn_fence(__ATOMIC_ACQUIRE, "agent");
      xb_add(bar + (32 + x) * 64, 1u);
      asm volatile("s_waitcnt vmcnt(0)" ::: "memory");
    } else {
      XB_SPIN(xb_ld(bar + (32 + x) * 64) < k);
      __builtin_amdgcn_fence(__ATOMIC_ACQUIRE, "agent");
      asm volatile("s_waitcnt vmcnt(0)" ::: "memory");
    }
  }
  __syncthreads();
}
#ifndef PROBE_DUP
#define PROBE_DUP -1
#endif
#ifndef PROBE_DUP2
#define PROBE_DUP2 -1
#endif
#ifndef PROBE_DUP3
#define PROBE_DUP3 -1
#endif
__global__ void __launch_bounds__(NT) fwd_kernel(Params p) {
  extern __shared__ __attribute__((aligned(16))) char smem[];
  cg::grid_group grid = cg::this_grid();
#if PROBE_DUP >= 0
#define PHS(n) if ((n) == PROBE_DUP || (n) == PROBE_DUP2 || (n) == PROBE_DUP3) { run_phase(p, n, smem, p.phase_lo == 0 ? 1 : 0); grid.sync(); } run_phase(p, n, smem); grid.sync();
#else
#define PHS(n) run_phase(p, n, smem); if ((n) == 0) { grid.sync(); gbar_setup(p, smem); } else gbar(p, (unsigned)(n), smem);
#endif
  gbar_census(p);
  PHS(0) PHS(1) PHS(2) PHS(3) PHS(4) PHS(5) PHS(6) PHS(7) PHS(8)
  PHS(9) PHS(10) PHS(11) PHS(12) PHS(13) PHS(14) PHS(15) PHS(16)
  run_phase(p, 17, smem);
}
#endif

extern "C" void kernel_launch(void* const* d_in, const int* in_sizes, int n_in, void* d_out, int out_size, void* d_ws, size_t ws_size,
                              hipStream_t stream) {
  static int grid = 0;
  if (grid == 0) {
    if (n_in != 29 || ws_size < WS_END) { fprintf(stderr, "kernel_launch: need 29 inputs and %zu B of workspace, got %d / %zu\n", (size_t)WS_END, n_in, ws_size); grid = -1; return; }
#if MULTI_LAUNCH
    grid = 256;
#else
    int dev = 0, cus = 0, per_cu = 0;
    (void)hipGetDevice(&dev);
    (void)hipDeviceGetAttribute(&cus, hipDeviceAttributeMultiprocessorCount, dev);
    if (hipFuncSetAttribute((const void*)fwd_kernel, hipFuncAttributeMaxDynamicSharedMemorySize, LDS_BYTES) != hipSuccess) { fprintf(stderr, "kernel_launch: hipFuncSetAttribute failed\n"); grid = -1; return; }
    (void)hipOccupancyMaxActiveBlocksPerMultiprocessor(&per_cu, (const void*)fwd_kernel, NT, LDS_BYTES);
    if (per_cu < 1) { fprintf(stderr, "kernel_launch: occupancy query returned %d\n", per_cu); per_cu = 1; }
    (void)hipGetLastError();
    grid = cus * per_cu;
    if (grid > 256) grid = 256;
#endif
  }
  if (grid < 0) return;
  Params p{};
  const float** pp = (const float**)&p;
  for (int i = 0; i < 29; ++i) pp[i] = (const float*)d_in[i];
  p.out = (float*)d_out; p.ws = (char*)d_ws;
  p.phase_lo = 0; p.phase_hi = 18;
#if MULTI_LAUNCH
  launch_phase<0>(p, grid, stream); launch_phase<1>(p, grid, stream); launch_phase<2>(p, grid, stream); launch_phase<3>(p, grid, stream);
  launch_phase<4>(p, grid, stream); launch_phase<5>(p, grid, stream); launch_phase<6>(p, grid, stream); launch_phase<7>(p, grid, stream);
  launch_phase<8>(p, grid, stream); launch_phase<9>(p, grid, stream); launch_phase<10>(p, grid, stream); launch_phase<11>(p, grid, stream);
  launch_phase<12>(p, grid, stream); launch_phase<13>(p, grid, stream); launch_phase<14>(p, grid, stream); launch_phase<15>(p, grid, stream);
  launch_phase<16>(p, grid, stream); launch_phase<17>(p, grid, stream);
#else
  if (hipMemsetAsync((char*)d_ws + OFF_BAR, 0, BAR_BYTES, stream) != hipSuccess) { fprintf(stderr, "kernel_launch: barrier memset failed\n"); return; }
  void* args[] = {&p};
  hipError_t e = hipLaunchCooperativeKernel((const void*)fwd_kernel, dim3(grid), dim3(NT), args, LDS_BYTES, stream);
  if (e != hipSuccess) fprintf(stderr, "kernel_launch: cooperative launch failed: %s (grid %d)\n", hipGetErrorString(e), grid);
#endif
}
```

```cpp
#include <hip/hip_runtime.h>
#include <hip/hip_cooperative_groups.h>
#include <cstdio>
namespace cg = cooperative_groups;

typedef unsigned short u16;
typedef __attribute__((ext_vector_type(8))) short bf16x8;
typedef __attribute__((ext_vector_type(16))) float f32x16;
typedef __attribute__((ext_vector_type(4))) unsigned u32x4;
typedef __attribute__((ext_vector_type(2))) unsigned u32x2;
#define DI __device__ __forceinline__
#define MFMA(a, b, c) __builtin_amdgcn_mfma_f32_32x32x16_bf16((a), (b), (c), 0, 0, 0)

#ifndef MULTI_LAUNCH
#define MULTI_LAUNCH 0
#endif

constexpr int D = 1024, NBATCH = 2, L = 16384, LC = 256, TB = L + LC, R = NBATCH * TB;
constexpr int NIN = 7968;
constexpr int NP = 2208;
constexpr int NCH = 2688;
constexpr int PC_GQ = 0, PC_GK = 256, PC_GZ = 512, PC_AF = 1024, PC_AQ = 1056, PC_AK = 1568, PC_AZ = 1696;
constexpr int CH_YU = 0, CH_YZ = 1536, CH_GV = 2048, CH_AV = 2560;
constexpr int NCK = 260;
constexpr float EPS = 1e-6f;
constexpr int NT = 512;
constexpr int LDT = 72;

constexpr size_t OFF_P = 0;
constexpr size_t OFF_CT = OFF_P + (size_t)R * NP * 2;
constexpr size_t OFF_H = OFF_CT + (size_t)NCH * 2 * TB * 2;
constexpr size_t OFF_FS = OFF_H + (size_t)R * 1024 * 2;
constexpr size_t OFF_WT = OFF_FS + (size_t)256 * 262144;
constexpr size_t WT_IN = (size_t)NIN * 1024 * 2, WT_BR = (size_t)1024 * 512 * 2, WT_OUT = (size_t)1024 * 1024 * 2;
constexpr size_t WT_LAYER = WT_IN + 3 * WT_BR + WT_OUT;
constexpr size_t OFF_H2T = OFF_WT + 2 * WT_LAYER;
constexpr size_t OFF_H2C = OFF_H2T + (size_t)2 * 64 * L * 4;
constexpr size_t OFF_MOD = OFF_H2C + (size_t)2 * 256 * 64 * 4;
constexpr size_t OFF_CTX1 = OFF_MOD + (size_t)2 * 3 * 3072 * 4;
constexpr size_t OFF_GD = OFF_CTX1 + (size_t)512 * 1024 * 4;
constexpr size_t OFF_PK = OFF_GD + (size_t)16 * NCK * 64 * 4;
constexpr int PK_WAF = 0, PK_BAF = 8192, PK_WAB = 8704, PK_BAB = 16896, PK_GN = 17408, PK_QN = 17664, PK_KN = 17792, PK_CW = 17920,
              PK_CB = 27136, PK_SK = 30208, PK_FN = 32256, PK_F3 = 33280, PK_END = 33280 + 262144;
constexpr size_t OFF_BAR = OFF_PK + (size_t)PK_END * 4;
constexpr size_t BAR_BYTES = 50 * 256;
constexpr size_t WS_END = OFF_BAR + 16384;
constexpr int BAR_LDS = 147456 + 256;
constexpr size_t OFF_GS = OFF_CT;
constexpr size_t OFF_Y = OFF_CT;
static_assert((size_t)16 * NCK * 8192 * 2 <= (size_t)1536 * 2 * TB * 2, "alias");
static_assert((size_t)R * 1024 * 2 <= (size_t)1536 * 2 * TB * 2, "alias");

constexpr int LDS_BYTES = 2 * (128 + 384) * 72 * 2 + 512;

struct Params {
  const float *x, *c, *ctx, *c_ctx, *w_ada, *b_ada, *w_in, *wa_f, *ba_f, *wa_b, *ba_b, *gla_norm, *qnorm, *knorm,
      *conv_w, *conv_b, *f1_w, *f1_b, *f1_freq, *f2_w, *f2_b, *f2_freq, *f3_w, *skip, *w_g, *w_a, *w_h, *w_o, *final_norm;
  float* out;
  char* ws;
  long long phase_lo, phase_hi;
};

typedef __attribute__((ext_vector_type(2))) float f32x2v;
typedef __attribute__((ext_vector_type(2))) __bf16 bf16x2v;
DI int my_tid() {
  int t = (int)threadIdx.x;
  asm volatile("" : "+v"(t));
  __builtin_assume(t >= 0 && t < NT);
  return t;
}
DI u16 f2bf(float x) { return __builtin_bit_cast(u16, (__bf16)x); }
DI float bf2f(u16 v) { return __uint_as_float(((unsigned)v) << 16); }
DI unsigned pack2(float a, float b) { f32x2v v = {a, b}; return __builtin_bit_cast(unsigned, __builtin_convertvector(v, bf16x2v)); }
DI float bflo(unsigned u) { return __uint_as_float(u << 16); }
DI float bfhi(unsigned u) { return __uint_as_float(u & 0xffff0000u); }
DI float silu_f(float x) { return x / (1.f + __expf(-x)); }
DI float wave_sum(float v) {
#pragma unroll
  for (int o = 32; o >= 1; o >>= 1) v += __shfl_xor(v, o);
  return v;
}
DI int crow(int reg, int h) { return (reg & 3) + 8 * (reg >> 2) + 4 * h; }
DI f32x16 zero16() { f32x16 z; for (int i = 0; i < 16; ++i) z[i] = 0.f; return z; }
DI bf16x8 pack8(const f32x16& x, int s) {
  u32x4 u;
  u.x = pack2(x[8 * s + 0], x[8 * s + 1]); u.y = pack2(x[8 * s + 2], x[8 * s + 3]);
  u.z = pack2(x[8 * s + 4], x[8 * s + 5]); u.w = pack2(x[8 * s + 6], x[8 * s + 7]);
  return __builtin_bit_cast(bf16x8, u);
}
DI bf16x8 ld2x64(const u16* p0, const u16* p1) {
  u32x2 a = *(const u32x2*)p0, b = *(const u32x2*)p1;
  u32x4 u; u.x = a.x; u.y = a.y; u.z = b.x; u.w = b.y;
  return __builtin_bit_cast(bf16x8, u);
}
DI float2 cmul(float2 a, float2 b) { return make_float2(a.x * b.x - a.y * b.y, a.x * b.y + a.y * b.x); }
DI float2 cadd(float2 a, float2 b) { return make_float2(a.x + b.x, a.y + b.y); }
DI float2 csub(float2 a, float2 b) { return make_float2(a.x - b.x, a.y - b.y); }

DI const float* xrow_in(const Params& p, int layer, int row) {
  int b = row / TB, tk = row - b * TB;
  if (tk < LC) return (layer == 0 ? p.ctx : (const float*)(p.ws + OFF_CTX1)) + (size_t)(b * LC + tk) * D;
  return (layer == 0 ? p.x : (const float*)p.out) + (size_t)(b * L + tk - LC) * D;
}
DI float* xrow_out(const Params& p, int row) {
  int b = row / TB, tk = row - b * TB;
  if (tk < LC) return (float*)(p.ws + OFF_CTX1) + (size_t)(b * LC + tk) * D;
  return p.out + (size_t)(b * L + tk - LC) * D;
}
DI const float* pk(const Params& p, int off) { return (const float*)(p.ws + OFF_PK) + off; }
DI int modvec_of(int row) { int b = row / TB, tk = row - b * TB; return tk < LC ? 2 : b; }

struct ALoadN {
  const u16* A; int lda;
  template <int BM> DI void fetch(u32x4 (&r)[BM / 64], int k0, int tid) const {
#pragma unroll
    for (int i = 0; i < BM / 64; ++i) { const int q = tid + NT * i; const unsigned off = (unsigned)((q >> 3) * lda + (q & 7) * 8); r[i] = *(const u32x4*)(A + off + k0); }
  }
  template <int BM> DI void commit(const u32x4 (&r)[BM / 64], u16* As, int tid) const {
#pragma unroll
    for (int i = 0; i < BM / 64; ++i) { int q = tid + NT * i; *(u32x4*)(As + (q >> 3) * LDT + (q & 7) * 8) = r[i]; }
  }
};
struct ALoadT {
  const u16* A; size_t chs;
  template <int BM> DI void fetch(u32x4 (&r)[BM / 64], int k0, int tid) const {
#pragma unroll
    for (int i = 0; i < 2; ++i) { const int q = tid + NT * i; const unsigned off = (unsigned)((q >> 4) * (int)chs + (q & 15) * 8); r[i] = *(const u32x4*)(A + off + (unsigned)(k0 * (int)chs)); }
  }
  template <int BM> DI void commit(const u32x4 (&r)[BM / 64], u16* As, int tid) const {
#pragma unroll
    for (int i = 0; i < 2; ++i) {
      int q = tid + NT * i; int ch = q >> 4, t0 = (q & 15) * 8;
      unsigned w[4] = {r[i].x, r[i].y, r[i].z, r[i].w};
#pragma unroll
      for (int e = 0; e < 4; ++e) { As[(t0 + 2 * e) * LDT + ch] = (u16)(w[e] & 0xffffu); As[(t0 + 2 * e + 1) * LDT + ch] = (u16)(w[e] >> 16); }
    }
  }
};

template <int BM, int KSU>
DI void gemm_compute(const u16* Ac, const u16* Bc, int wm, int wn, int r, int h, f32x16 (&acc)[BM / 128][2]) {
#pragma unroll KSU
  for (int ks = 0; ks < 4; ++ks) {
    bf16x8 a[BM / 128], b[2];
#pragma unroll
    for (int i = 0; i < BM / 128; ++i) a[i] = *(const bf16x8*)(Ac + (wm * (BM / 4) + i * 32 + r) * LDT + ks * 16 + h * 8);
#pragma unroll
    for (int j = 0; j < 2; ++j) b[j] = *(const bf16x8*)(Bc + (wn * 64 + j * 32 + r) * LDT + ks * 16 + h * 8);
#pragma unroll
    for (int i = 0; i < BM / 128; ++i)
#pragma unroll
      for (int j = 0; j < 2; ++j) acc[i][j] = MFMA(a[i], b[j], acc[i][j]);
  }
}
DI void fetch_b(u32x4 (&rb)[2], const u16* Bt, int ldb, int k0, int tid) {
#pragma unroll
  for (int i = 0; i < 2; ++i) { const int q = tid + NT * i; const unsigned off = (unsigned)((q >> 3) * ldb + (q & 7) * 8); rb[i] = *(const u32x4*)(Bt + off + k0); }
}
DI void commit_b(const u32x4 (&rb)[2], u16* Bs, int tid) {
#pragma unroll
  for (int i = 0; i < 2; ++i) { int q = tid + NT * i; *(u32x4*)(Bs + (q >> 3) * LDT + (q & 7) * 8) = rb[i]; }
}
template <int BM> struct GemmRegs { u32x4 ra0[BM / 64], rb0[2], ra1[BM / 64], rb1[2]; };
#define GFENCE asm volatile("" ::: "memory")
template <int BM, class AL>
DI void gemm_prime(GemmRegs<BM>& g, const AL& al, const u16* __restrict__ Bt, int ldb, char* smem) {
  u16* As0 = (u16*)smem;
  u16* Bs0 = As0 + 2 * BM * LDT;
  const int tid = my_tid();
  al.template fetch<BM>(g.ra0, 0, tid); fetch_b(g.rb0, Bt, ldb, 0, tid); GFENCE;
  al.template fetch<BM>(g.ra1, 64, tid); fetch_b(g.rb1, Bt, ldb, 64, tid); GFENCE;
  __syncthreads();
  al.template commit<BM>(g.ra0, As0, tid); commit_b(g.rb0, Bs0, tid);
  __syncthreads();
  al.template fetch<BM>(g.ra0, 128, tid); fetch_b(g.rb0, Bt, ldb, 128, tid); GFENCE;
}
template <int BM, class AL, int KSU, int K, class ALN>
DI void gemm_run(GemmRegs<BM>& g, const AL& al, const u16* __restrict__ Bt, int ldb, const ALN& aln, const u16* __restrict__ Btn, int ldbn,
                 bool hasnext, char* smem, f32x16 (&acc)[BM / 128][2]) {
  u16* As0 = (u16*)smem;
  u16* As1 = As0 + BM * LDT;
  u16* Bs0 = As0 + 2 * BM * LDT;
  u16* Bs1 = Bs0 + 128 * LDT;
  const int tid = my_tid(), lane = tid & 63, wid = tid >> 6, r = lane & 31, h = lane >> 5;
  const int wm = wid & 3, wn = wid >> 2;
  constexpr int KT = K >> 6;
#pragma unroll
  for (int kt = 0; kt < KT; kt += 2) {
    al.template commit<BM>(g.ra1, As1, tid); commit_b(g.rb1, Bs1, tid);
    GFENCE;
    if (kt + 3 < KT) { al.template fetch<BM>(g.ra1, (kt + 3) * 64, tid); fetch_b(g.rb1, Bt, ldb, (kt + 3) * 64, tid); GFENCE; }
    else if (hasnext) { aln.template fetch<BM>(g.ra1, (kt + 3 - KT) * 64, tid); fetch_b(g.rb1, Btn, ldbn, (kt + 3 - KT) * 64, tid); GFENCE; }
    gemm_compute<BM, KSU>(As0, Bs0, wm, wn, r, h, acc);
    __syncthreads();
    if (kt + 2 < KT) { al.template commit<BM>(g.ra0, As0, tid); commit_b(g.rb0, Bs0, tid); GFENCE; }
    else if (hasnext) { aln.template commit<BM>(g.ra0, As0, tid); commit_b(g.rb0, Bs0, tid); GFENCE; }
    if (kt + 4 < KT) { al.template fetch<BM>(g.ra0, (kt + 4) * 64, tid); fetch_b(g.rb0, Bt, ldb, (kt + 4) * 64, tid); GFENCE; }
    else if (hasnext) { aln.template fetch<BM>(g.ra0, (kt + 4 - KT) * 64, tid); fetch_b(g.rb0, Btn, ldbn, (kt + 4 - KT) * 64, tid); GFENCE; }
    gemm_compute<BM, KSU>(As1, Bs1, wm, wn, r, h, acc);
    __syncthreads();
  }
}

template <int BM, class AL, int KSU = 4, int K = 1024>
DI void gemm_tile(const AL& al, const u16* __restrict__ Bt, int ldb, char* smem, f32x16 (&acc)[BM / 128][2]) {
  GemmRegs<BM> g;
  gemm_prime<BM>(g, al, Bt, ldb, smem);
  gemm_run<BM, AL, KSU, K, AL>(g, al, Bt, ldb, al, Bt, ldb, false, smem, acc);
}

DI void phase0(const Params& p, char* smem) {
  const int tid = my_tid(), lane = tid & 63, wid = tid >> 6, bid = blockIdx.x, nb = gridDim.x;
  float* sm = (float*)smem;
  {
    float* PKW = (float*)(p.ws + OFF_PK);
    const int gt = bid * NT + tid, gn = nb * NT;
#define PKCP(src, off, cnt) for (int i = gt; i < (cnt); i += gn) PKW[(off) + i] = (src)[i];
    PKCP(p.wa_f, PK_WAF, 8192) PKCP(p.ba_f, PK_BAF, 512) PKCP(p.wa_b, PK_WAB, 8192) PKCP(p.ba_b, PK_BAB, 512)
    PKCP(p.gla_norm, PK_GN, 256) PKCP(p.qnorm, PK_QN, 128) PKCP(p.knorm, PK_KN, 128) PKCP(p.conv_w, PK_CW, 9216)
    PKCP(p.conv_b, PK_CB, 3072) PKCP(p.skip, PK_SK, 2048) PKCP(p.final_norm, PK_FN, 1024) PKCP(p.f3_w, PK_F3, 262144)
#undef PKCP
  }
  float* mod = (float*)(p.ws + OFF_MOD);
  for (int task = bid; task < 96; task += nb) {
    const int l = task / 48, cb = task % 48, col = cb * 64 + lane;
    const float* W = p.w_ada + (size_t)l * 1024 * 3072;
    float a0 = 0.f, a1 = 0.f, a2 = 0.f;
#pragma unroll 8
    for (int k = wid * 128; k < wid * 128 + 128; ++k) {
      float wv = W[(size_t)k * 3072 + col];
      a0 += silu_f(p.c[k]) * wv; a1 += silu_f(p.c[1024 + k]) * wv; a2 += silu_f(p.c_ctx[k]) * wv;
    }
    __syncthreads();
    sm[(wid * 3 + 0) * 64 + lane] = a0; sm[(wid * 3 + 1) * 64 + lane] = a1; sm[(wid * 3 + 2) * 64 + lane] = a2;
    __syncthreads();
    if (tid < 192) {
      int v = tid >> 6; float s = p.b_ada[l * 3072 + col];
      for (int w = 0; w < 8; ++w) s += sm[(w * 3 + v) * 64 + lane];
      mod[(l * 3 + v) * 3072 + col] = s;
    }
    __syncthreads();
  }
  for (int it = bid; it < (2 * TB) / 8; it += nb) {
    const int gr = it * 8 + wid, l = gr / TB, rr = gr - l * TB;
    const bool lat = rr < L; const int t = lat ? rr : rr - L; const int Lq = lat ? L : LC;
    float* em = sm + wid * 104; float* h1 = em + 40;
    __syncthreads();
    if (lane < 33) {
      float v;
      if (lane == 0) v = (float)t / (float)(Lq - 1);
      else {
        int bi = (lane - 1) & 15; float fr = 1e-4f + (float)bi * ((15.f - 1e-4f) / 15.f);
        float w = 6.283185307179586f * (float)t / (float)Lq;
        v = (lane <= 16) ? cosf(fr * w) : -sinf(fr * w);
      }
      em[lane] = v;
    }
    __syncthreads();
    {
      float a = p.f1_b[l * 64 + lane];
      for (int e = 0; e < 33; ++e) a += em[e] * p.f1_w[(l * 33 + e) * 64 + lane];
      h1[lane] = sinf(p.f1_freq[l * 64 + lane] * a);
    }
    __syncthreads();
    {
      float a = p.f2_b[l * 64 + lane];
      for (int i = 0; i < 64; ++i) a += h1[i] * p.f2_w[(l * 64 + i) * 64 + lane];
      float v = sinf(p.f2_freq[l * 64 + lane] * a);
      if (lat) ((u16*)(p.ws + OFF_H2T))[((size_t)l * 64 + lane) * L + t] = f2bf(v);
      else ((float*)(p.ws + OFF_H2C))[((size_t)l * 256 + t) * 64 + lane] = v;
    }
  }
  __syncthreads();
  {
    constexpr int T_IN = 16 * 249, T_BR = 8 * 32, T_OUT = 16 * 32, T_LAYER = T_IN + 3 * T_BR + T_OUT;
    auto decode = [&](int task, const float*& src, u16*& dst, int& K, int& N, int& k0, int& n0) {
      const int l = task / T_LAYER; int tt = task - l * T_LAYER;
      char* wt = p.ws + OFF_WT + (size_t)l * WT_LAYER;
      int kt, ntile;
      if (tt < T_IN) { src = p.w_in + (size_t)l * 1024 * NIN; dst = (u16*)wt; K = 1024; N = NIN; kt = tt / 249; ntile = tt % 249; }
      else if (tt < T_IN + 3 * T_BR) {
        tt -= T_IN; const int br = tt / T_BR; tt -= br * T_BR;
        src = (br == 0 ? p.w_g : (br == 1 ? p.w_a : p.w_h)) + (size_t)l * 512 * 1024; dst = (u16*)(wt + WT_IN + br * WT_BR);
        K = 512; N = 1024; kt = tt / 32; ntile = tt % 32;
      } else { tt -= T_IN + 3 * T_BR; src = p.w_o + (size_t)l * 1024 * 1024; dst = (u16*)(wt + WT_IN + 3 * WT_BR); K = 1024; N = 1024; kt = tt / 32; ntile = tt % 32; }
      k0 = kt * 64; n0 = ntile * 32;
    };
    float* tileA = sm;
    float* tileB = sm + 64 * 33;
    for (int task = bid; task < 2 * T_LAYER; task += 2 * nb) {
      const bool hasB = task + nb < 2 * T_LAYER;
      const float *sa, *sb = nullptr; u16 *da, *db = nullptr; int Ka, Na, k0a, n0a, Kb = 0, Nb = 0, k0b = 0, n0b = 0;
      decode(task, sa, da, Ka, Na, k0a, n0a);
      if (hasB) decode(task + nb, sb, db, Kb, Nb, k0b, n0b);
      float va[4], vb[4];
#pragma unroll
      for (int i = 0; i < 4; ++i) { const int kk = (tid >> 5) + 16 * i, nn = tid & 31; va[i] = sa[(size_t)(k0a + kk) * Na + n0a + nn]; vb[i] = hasB ? sb[(size_t)(k0b + kk) * Nb + n0b + nn] : 0.f; }
#pragma unroll
      for (int i = 0; i < 4; ++i) { const int kk = (tid >> 5) + 16 * i, nn = tid & 31; tileA[kk * 33 + nn] = va[i]; tileB[kk * 33 + nn] = vb[i]; }
      __syncthreads();
#pragma unroll
      for (int i = 0; i < 4; ++i) {
        const int nn = (tid >> 6) + 8 * i, kk = tid & 63;
        da[(size_t)(n0a + nn) * Ka + k0a + kk] = f2bf(tileA[kk * 33 + nn]);
        if (hasB) db[(size_t)(n0b + nn) * Kb + k0b + kk] = f2bf(tileB[kk * 33 + nn]);
      }
      __syncthreads();
    }
  }
}

DI void phase_norm(const Params& p, int l) {
  const int tid = my_tid(), lane = tid & 63, wid = tid >> 6;
  const float* mod = (const float*)(p.ws + OFF_MOD);
  u16* H = (u16*)(p.ws + OFF_H);
  for (int row = blockIdx.x * 8 + wid; row < R; row += gridDim.x * 8) {
    const float* src = xrow_in(p, l, row);
    const float* mv = mod + (l * 3 + modvec_of(row)) * 3072;
    float4 xv[4]; float ss = 0.f;
#pragma unroll
    for (int i = 0; i < 4; ++i) { xv[i] = *(const float4*)(src + (i * 64 + lane) * 4); ss += xv[i].x * xv[i].x + xv[i].y * xv[i].y + xv[i].z * xv[i].z + xv[i].w * xv[i].w; }
    ss = wave_sum(ss);
    const float rs = rsqrtf(ss * (1.f / 1024.f) + EPS);
#pragma unroll
    for (int i = 0; i < 4; ++i) {
      const int col = (i * 64 + lane) * 4;
      float4 sh = *(const float4*)(mv + col), sc = *(const float4*)(mv + 1024 + col);
      u32x2 o;
      o.x = pack2(xv[i].x * rs * (1.f + sc.x) + sh.x, xv[i].y * rs * (1.f + sc.y) + sh.y);
      o.y = pack2(xv[i].z * rs * (1.f + sc.z) + sh.z, xv[i].w * rs * (1.f + sc.w) + sh.w);
      *(u32x2*)(H + (size_t)row * 1024 + col) = o;
    }
  }
}

DI void phase_proj(const Params& p, int l, char* smem) {
  const int tid = my_tid(), lane = tid & 63, wid = tid >> 6, r = lane & 31, h = lane >> 5, wm = wid & 3, wn = wid >> 2;
  const u16* H = (const u16*)(p.ws + OFF_H);
  const u16* WT = (const u16*)(p.ws + OFF_WT + (size_t)l * WT_LAYER);
  u16* P = (u16*)(p.ws + OFF_P);
  u16* CT = (u16*)(p.ws + OFF_CT);
  u16* Tt = (u16*)smem;
  constexpr int LDE = 260;
  const int xcd = blockIdx.x & 7, nloc = gridDim.x >> 3, local = blockIdx.x >> 3;
  const int nreg = local < 624 ? (624 - local + nloc - 1) / nloc : 0;
  const int r0 = 624 % nloc;
  const int nlight = (r0 == 0 ? nloc : nloc - r0) * 8;
  const int eb = (r0 == 0 ? local : local - r0) * 8 + xcd;
  const int nextra = (eb >= 0 && eb < 78) ? (78 - eb + nlight - 1) / nlight : 0;
  for (int it = 0; it < nreg + nextra; ++it) {
    int mt, nt;
    if (it < nreg) { const int q = local + nloc * it, g = q / 156, rem = q - g * 156; nt = rem >> 2; mt = (g * 4 + (rem & 3)) * 8 + xcd; }
    else { const int e = eb + (it - nreg) * nlight; mt = 128 + e / 39; nt = e % 39; }
    const int m0 = mt * 256, n0 = nt * 128;
    f32x16 acc[2][2];
#pragma unroll
    for (int i = 0; i < 2; ++i) for (int j = 0; j < 2; ++j) acc[i][j] = zero16();
    ALoadN al{H + (size_t)m0 * 1024, 1024};
    gemm_tile<256, ALoadN, 4, 1024>(al, WT + (size_t)n0 * 1024, 1024, smem, acc);
    const int b = m0 / TB, tk0 = m0 - b * TB;
#pragma unroll
    for (int i = 0; i < 2; ++i)
#pragma unroll
      for (int j = 0; j < 2; ++j)
#pragma unroll
        for (int g4 = 0; g4 < 4; ++g4) {
          u32x2 o; o.x = pack2(acc[i][j][4 * g4], acc[i][j][4 * g4 + 1]); o.y = pack2(acc[i][j][4 * g4 + 2], acc[i][j][4 * g4 + 3]);
          *(u32x2*)(Tt + (wn * 64 + j * 32 + r) * LDE + wm * 64 + i * 32 + 8 * g4 + 4 * h) = o;
        }
    __syncthreads();
#pragma unroll 1
    for (int cg = 0; cg < 4; ++cg) {
      const int cb = n0 + cg * 32;
      if (cb >= 4896) continue;
      bool chan; int cm;
      if (cb < 512) { chan = false; cm = cb; }
      else if (cb < 1024) { chan = true; cm = CH_GV + cb - 512; }
      else if (cb < 2208) { chan = false; cm = cb - 512; }
      else if (cb < 2336) { chan = true; cm = CH_AV + cb - 2208; }
      else if (cb < 2848) { chan = false; cm = cb - 640; }
      else { chan = true; cm = cb - 2848; }
      if (chan) {
#pragma unroll
        for (int k = 0; k < 2; ++k) {
          const int idx = tid + NT * k, ch = idx >> 5, t8 = idx & 31;
          const u16* sp = Tt + (cg * 32 + ch) * LDE + t8 * 8;
          const u32x2 lo = *(const u32x2*)sp, hi = *(const u32x2*)(sp + 4);
          __builtin_nontemporal_store(u32x4{lo.x, lo.y, hi.x, hi.y}, (u32x4*)(CT + ((size_t)(cm + ch) * 2 + b) * TB + tk0 + t8 * 8));
        }
      } else {
#pragma unroll
        for (int k = 0; k < 2; ++k) {
          const int idx = tid + NT * k, row = idx >> 2, c8 = idx & 3;
          const u16* sp = Tt + (cg * 32 + c8 * 8) * LDE + row;
          u32x4 o;
          o.x = (unsigned)sp[0] | ((unsigned)sp[LDE] << 16); o.y = (unsigned)sp[2 * LDE] | ((unsigned)sp[3 * LDE] << 16);
          o.z = (unsigned)sp[4 * LDE] | ((unsigned)sp[5 * LDE] << 16); o.w = (unsigned)sp[6 * LDE] | ((unsigned)sp[7 * LDE] << 16);
          __builtin_nontemporal_store(o, (u32x4*)(P + (size_t)(m0 + row) * NP + cm + c8 * 8));
        }
      }
    }
  }
}

DI void attn_prep(const Params& p, int l, int dry) {
  const int tid = my_tid(), lane = tid & 63, wid = tid >> 6;
  u16* P = (u16*)(p.ws + OFF_P);
  const float gq = pk(p, PK_QN)[l * 64 + lane], gk = pk(p, PK_KN)[l * 64 + lane];
  for (int row = blockIdx.x * 8 + wid; row < R; row += gridDim.x * 8) {
    u16* Pr = P + (size_t)row * NP;
    const int b = row / TB, tk = row - b * TB;
    float cs = 1.f, sn = 0.f;
    if (tk >= LC) {
      const int t = tk - LC, pi = lane >> 1;
      const float pos = (pi < 16) ? (float)(t >> 6) : (float)(t & 63);
      const float inv = powf(10000.f, -(float)(2 * (pi & 15)) / 32.f);
      sincosf(pos * inv, &sn, &cs);
    }
#pragma unroll
    for (int hd = 0; hd < 10; ++hd) {
      const int col = (hd < 8) ? PC_AQ + hd * 64 + lane : PC_AK + (hd - 8) * 64 + lane;
      float v = bf2f(Pr[col]);
      const float ss = wave_sum(v * v);
      v = v * rsqrtf(ss * (1.f / 64.f) + EPS) * (hd < 8 ? gq : gk);
      const float pv = __shfl_xor(v, 1);
      float o = (lane & 1) ? (pv * sn + v * cs) : (v * cs - pv * sn);
      if (hd < 8) o *= 0.125f * 1.4426950408889634f;
      if (!dry) Pr[col] = f2bf(o);
    }
  }
}

DI void fft_pass4_fwd(float2* X, int tid, int h2) {
  const float inv4 = 0.25f / (float)h2;
#pragma unroll 2
  for (int i = 0; i < 8; ++i) {
    const int g = tid + NT * i, jp = g & (h2 - 1), base = ((g - jp) << 2) + jp;
    float2 e0 = X[base], e1 = X[base + h2], e2 = X[base + 2 * h2], e3 = X[base + 3 * h2];
    const float fr = (float)jp * inv4;
    const float2 T1 = make_float2(__builtin_amdgcn_cosf(fr), -__builtin_amdgcn_sinf(fr));
    const float2 T2 = cmul(T1, T1);
    float2 a0 = cadd(e0, e2), a2 = cmul(csub(e0, e2), T1);
    float2 a1 = cadd(e1, e3), d13 = cmul(csub(e1, e3), T1);
    float2 a3 = make_float2(d13.y, -d13.x);
    X[base] = cadd(a0, a1); X[base + h2] = cmul(csub(a0, a1), T2);
    X[base + 2 * h2] = cadd(a2, a3); X[base + 3 * h2] = cmul(csub(a2, a3), T2);
  }
  __syncthreads();
}
DI void fft_pass4_inv(float2* X, int tid, int h1) {
  const float inv4 = 0.25f / (float)h1;
#pragma unroll 2
  for (int i = 0; i < 8; ++i) {
    const int g = tid + NT * i, jp = g & (h1 - 1), base = ((g - jp) << 2) + jp;
    float2 e0 = X[base], e1 = X[base + h1], e2 = X[base + 2 * h1], e3 = X[base + 3 * h1];
    const float fr = (float)jp * inv4;
    const float2 V = make_float2(__builtin_amdgcn_cosf(fr), __builtin_amdgcn_sinf(fr));
    const float2 Wc = cmul(V, V);
    float2 t1 = cmul(e1, Wc), t3 = cmul(e3, Wc);
    float2 a0 = cadd(e0, t1), a1 = csub(e0, t1), a2 = cadd(e2, t3), a3 = csub(e2, t3);
    float2 u2 = cmul(a2, V), u3 = cmul(a3, V);
    u3 = make_float2(-u3.y, u3.x);
    X[base] = cadd(a0, u2); X[base + 2 * h1] = csub(a0, u2);
    X[base + h1] = cadd(a1, u3); X[base + 3 * h1] = csub(a1, u3);
  }
  __syncthreads();
}
DI constexpr float r16c(int k) { return k == 0 ? 1.f : k == 1 ? 0.9238795325112867f : k == 2 ? 0.7071067811865476f : k == 3 ? 0.3826834323650898f : k == 4 ? 0.f : k == 5 ? -0.3826834323650898f : k == 6 ? -0.7071067811865476f : -0.9238795325112867f; }
DI constexpr float r16s(int k) { return k == 0 ? 0.f : k == 1 ? 0.3826834323650898f : k == 2 ? 0.7071067811865476f : k == 3 ? 0.9238795325112867f : k == 4 ? 1.f : k == 5 ? 0.9238795325112867f : k == 6 ? 0.7071067811865476f : 0.3826834323650898f; }
template <bool INV>
DI void fft_pass16(float2* X, int tid, int q) {
  const float invq = 1.f / (16.f * (float)q);
#pragma unroll 1
  for (int it = 0; it < 2; ++it) {
    const int g = tid + NT * it, jp = g & (q - 1), base = ((g - jp) << 4) + jp;
    float vx[16], vy[16];
#pragma unroll
    for (int r = 0; r < 16; ++r) { const float2 e = X[base + r * q]; vx[r] = e.x; vy[r] = e.y; }
    const float th = (float)jp * invq;
    float bx[4], by[4];
    bx[0] = __builtin_amdgcn_cosf(th); by[0] = INV ? __builtin_amdgcn_sinf(th) : -__builtin_amdgcn_sinf(th);
#pragma unroll
    for (int s = 1; s < 4; ++s) { bx[s] = bx[s - 1] * bx[s - 1] - by[s - 1] * by[s - 1]; by[s] = 2.f * bx[s - 1] * by[s - 1]; }
#pragma unroll
    for (int ss = 0; ss < 4; ++ss) {
      const int s = INV ? 3 - ss : ss;
      const int rs = 8 >> s;
#pragma unroll
      for (int bf = 0; bf < 8; ++bf) {
        const int r = ((bf & ~(rs - 1)) << 1) | (bf & (rs - 1));
        const int k = (r & (rs - 1)) * (8 / rs);
        const float cc = r16c(k), cs = INV ? r16s(k) : -r16s(k);
        const float tx = bx[s] * cc - by[s] * cs, ty = bx[s] * cs + by[s] * cc;
        const float ax = vx[r], ay = vy[r], cx = vx[r + rs], cy = vy[r + rs];
        if (!INV) {
          const float dx = ax - cx, dy = ay - cy;
          vx[r] = ax + cx; vy[r] = ay + cy;
          vx[r + rs] = dx * tx - dy * ty; vy[r + rs] = dx * ty + dy * tx;
        } else {
          const float ux = cx * tx - cy * ty, uy = cx * ty + cy * tx;
          vx[r] = ax + ux; vy[r] = ay + uy;
          vx[r + rs] = ax - ux; vy[r + rs] = ay - uy;
        }
      }
    }
#pragma unroll
    for (int r = 0; r < 16; ++r) X[base + r * q] = make_float2(vx[r], vy[r]);
  }
  __syncthreads();
}
DI void fft_fwd(float2* X, int tid) {
#pragma unroll 1
  for (int q = 1024; q >= 4; q >>= 4) fft_pass16<false>(X, tid, q);
  fft_pass4_fwd(X, tid, 1);
}
DI void fft_inv(float2* X, int tid) {
  fft_pass4_inv(X, tid, 1);
#pragma unroll 1
  for (int q = 4; q <= 1024; q <<= 4) fft_pass16<true>(X, tid, q);
}
DI float sconv_at(const u16* src, int t, int len, float w0, float w1, float w2, float bb) {
  float ym = t > 0 ? bf2f(src[t - 1]) : 0.f, y0 = bf2f(src[t]), yp = t < len - 1 ? bf2f(src[t + 1]) : 0.f;
  return bb + w0 * ym + w1 * y0 + w2 * yp;
}
DI float hy_delta(int col) {
  const float A0 = -4.605170185988091f / 0.3f, A1 = -4.605170185988091f / 1.5f;
  return fabsf(A0 + (A1 - A0) * ((float)col / 2047.f));
}

DI void hyena_latent_task(const Params& p, int l, int c, char* smem, int dry) {
  float2* X = (float2*)smem;
  float* red = (float*)(smem + 131072);
  const int tid = my_tid(), lane = tid & 63, wid = tid >> 6;
  u16* CT = (u16*)(p.ws + OFF_CT);
  float2* FE = (float2*)(p.ws + OFF_FS + (size_t)blockIdx.x * 262144);
  float2* FO = FE + 16384;
  const unsigned* h2T = (const unsigned*)(p.ws + OFF_H2T) + (size_t)l * 64 * (L / 2);
  const float* f3w = pk(p, PK_F3) + (size_t)l * 64 * 2048;
  const float* cw = pk(p, PK_CW) + (size_t)l * 3 * 1536;
  const float* cbv = pk(p, PK_CB) + (size_t)l * 1536;
  const float vw0 = cw[c], vw1 = cw[1536 + c], vw2 = cw[3072 + c], vbb = cbv[c];
  const u16* v0 = CT + ((size_t)(CH_YU + c) * 2 + 0) * TB + LC;
  const u16* v1 = CT + ((size_t)(CH_YU + c) * 2 + 1) * TB + LC;
  u16* z10 = CT + ((size_t)(CH_YU + 512 + c) * 2 + 0) * TB + LC;
  u16* z11 = CT + ((size_t)(CH_YU + 512 + c) * 2 + 1) * TB + LC;
#pragma unroll 1
  for (int o = 0; o < 2; ++o) {
    const int cf = o * 1024 + c, cbk = cf + 512;
    float sf = 0.f, sb = 0.f;
    __syncthreads();
#ifdef PROBE_FFT
    fft_fwd(X, tid); fft_inv(X, tid);
#endif
#pragma unroll 1
    for (int half = 0; half < 2; ++half) {
      float af[16], ab[16];
#pragma unroll
      for (int i = 0; i < 16; ++i) { af[i] = 0.f; ab[i] = 0.f; }
#pragma unroll 1
      for (int j = 0; j < 64; j += 2) {
        const float wf0 = f3w[j * 2048 + cf], wb0 = f3w[j * 2048 + cbk], wf1 = f3w[(j + 1) * 2048 + cf], wb1 = f3w[(j + 1) * 2048 + cbk];
        const unsigned* hrow = h2T + (size_t)j * (L / 2) + tid + half * 8 * NT;
        unsigned w0[8], w1[8];
#pragma unroll
        for (int i = 0; i < 8; ++i) { w0[i] = hrow[NT * i]; w1[i] = hrow[L / 2 + NT * i]; }
#pragma unroll
        for (int i = 0; i < 8; ++i) {
          const float a0 = bflo(w0[i]), a1 = bfhi(w0[i]), b0 = bflo(w1[i]), b1 = bfhi(w1[i]);
          af[2 * i] += a0 * wf0 + b0 * wf1; af[2 * i + 1] += a1 * wf0 + b1 * wf1;
          ab[2 * i] += a0 * wb0 + b0 * wb1; ab[2 * i + 1] += a1 * wb0 + b1 * wb1;
        }
      }
      const float df = hy_delta(cf), db = hy_delta(cbk);
#pragma unroll
      for (int i = 0; i < 16; ++i) {
        const int t = 2 * (tid + NT * ((i >> 1) + half * 8)) + (i & 1); const float tt = (float)t / (float)(L - 1);
        const float vf = af[i] * (__expf(-tt * df) + 0.05f), vb = ab[i] * (__expf(-tt * db) + 0.05f);
        sf += fabsf(vf); sb += fabsf(vb);
        X[t].x = vf;
        if (t >= 1) X[L - t].y = vb; else X[0].y = 0.f;
      }
    }
    sf = wave_sum(sf); sb = wave_sum(sb);
    if (lane == 0) { red[wid] = sf; red[8 + wid] = sb; }
    __syncthreads();
    float nf = 0.f, nbk = 0.f;
#pragma unroll
    for (int w = 0; w < 8; ++w) { nf += red[w]; nbk += red[8 + w]; }
    const float inv_f = 1.f / nf, inv_b = 1.f / nbk;
#pragma unroll 8
    for (int i = 0; i < 32; ++i) { const int n = tid + NT * i; const float2 s = X[n]; FO[n] = s; X[n] = make_float2(s.x * inv_f + s.y * inv_b, 0.f); }
    __syncthreads();
    fft_fwd(X, tid);
#pragma unroll 8
    for (int i = 0; i < 32; ++i) { const int n = tid + NT * i; FE[n] = X[n]; }
    __syncthreads();
#pragma unroll 8
    for (int i = 0; i < 32; ++i) {
      const int n = tid + NT * i; const float2 s = FO[n]; const float dd = s.x * inv_f - s.y * inv_b; const float fr = (float)n * (1.f / 32768.f);
      X[n] = make_float2(dd * __builtin_amdgcn_cosf(fr), -dd * __builtin_amdgcn_sinf(fr));
    }
    __syncthreads();
    fft_fwd(X, tid);
#pragma unroll 8
    for (int i = 0; i < 32; ++i) { const int n = tid + NT * i; FO[n] = X[n]; }
    __syncthreads();
#pragma unroll 8
    for (int i = 0; i < 32; ++i) {
      const int n = tid + NT * i;
      float2 zz;
      if (o == 0) { zz.x = sconv_at(v0, n, L, vw0, vw1, vw2, vbb); zz.y = sconv_at(v1, n, L, vw0, vw1, vw2, vbb); }
      else { zz.x = bf2f(z10[n]); zz.y = bf2f(z11[n]); }
      X[n] = zz;
    }
    __syncthreads();
    fft_fwd(X, tid);
#pragma unroll 8
    for (int i = 0; i < 32; ++i) { const int n = tid + NT * i; X[n] = cmul(X[n], FE[n]); }
    __syncthreads();
    fft_inv(X, tid);
#pragma unroll 8
    for (int i = 0; i < 32; ++i) { const int n = tid + NT * i; FE[n] = X[n]; }
    __syncthreads();
#pragma unroll 8
    for (int i = 0; i < 32; ++i) {
      const int n = tid + NT * i; const float fr = (float)n * (1.f / 32768.f);
      float2 zz;
      if (o == 0) { zz.x = sconv_at(v0, n, L, vw0, vw1, vw2, vbb); zz.y = sconv_at(v1, n, L, vw0, vw1, vw2, vbb); }
      else { zz.x = bf2f(z10[n]); zz.y = bf2f(z11[n]); }
      X[n] = cmul(zz, make_float2(__builtin_amdgcn_cosf(fr), -__builtin_amdgcn_sinf(fr)));
    }
    __syncthreads();
    fft_fwd(X, tid);
#pragma unroll 8
    for (int i = 0; i < 32; ++i) { const int n = tid + NT * i; X[n] = cmul(X[n], FO[n]); }
    __syncthreads();
    fft_inv(X, tid);
    {
      const int gch = CH_YU + 512 * (o + 1) + c;
      const float w0 = cw[gch], w1 = cw[1536 + gch], w2 = cw[3072 + gch], bb = cbv[gch];
      const u16* s0 = CT + ((size_t)gch * 2 + 0) * TB + LC;
      const u16* s1 = CT + ((size_t)gch * 2 + 1) * TB + LC;
      const float sk = pk(p, PK_SK)[(l * 2 + o) * 512 + c];
#pragma unroll 8
      for (int i = 0; i < 32; ++i) {
        const int n = tid + NT * i; const float fr = (float)n * (1.f / 32768.f);
        const float2 wb = cmul(X[n], make_float2(__builtin_amdgcn_cosf(fr), __builtin_amdgcn_sinf(fr)));
        const float2 A = FE[n];
        const float yr = (A.x + wb.x) * (1.f / 32768.f), yi = (A.y + wb.y) * (1.f / 32768.f);
        const float g0 = sconv_at(s0, n, L, w0, w1, w2, bb), g1 = sconv_at(s1, n, L, w0, w1, w2, bb);
        float2 zz;
        if (o == 0) { zz.x = sconv_at(v0, n, L, vw0, vw1, vw2, vbb); zz.y = sconv_at(v1, n, L, vw0, vw1, vw2, vbb); }
        else { zz.x = bf2f(z10[n]); zz.y = bf2f(z11[n]); }
        X[n] = make_float2(g0 * (yr + sk * zz.x), g1 * (yi + sk * zz.y));
      }
    }
    __syncthreads();
    if (o == 0) {
#pragma unroll 8
      for (int i = 0; i < 32; ++i) { const int n = tid + NT * i; const float2 zz = X[n]; if (!dry) { z10[n] = f2bf(zz.x); z11[n] = f2bf(zz.y); } }
    } else {
      u16* d0 = CT + ((size_t)(CH_YZ + c) * 2 + 0) * TB + LC;
      u16* d1 = CT + ((size_t)(CH_YZ + c) * 2 + 1) * TB + LC;
#pragma unroll 1
      for (int ib = 0; ib < 32; ib += 8) {
        u16 g0[8], g1[8];
#pragma unroll
        for (int i = 0; i < 8; ++i) { const int n = tid + NT * (ib + i); g0[i] = d0[n]; g1[i] = d1[n]; }
#pragma unroll
        for (int i = 0; i < 8; ++i) {
          const int n = tid + NT * (ib + i); const float2 zz = X[n];
          const u16 q0 = f2bf(zz.x * silu_f(bf2f(g0[i]))), q1 = f2bf(zz.y * silu_f(bf2f(g1[i])));
          if (!dry) { d0[n] = q0; d1[n] = q1; }
        }
      }
    }
    __syncthreads();
  }
}

DI void hyena_ctx_task(const Params& p, int l, int c, char* smem, int dry) {
  float* filt = (float*)smem;
  float* zs = filt + 1024;
  float* nrm = zs + 1024;
  const int tid = my_tid(), lane = tid & 63, wid = tid >> 6, t = tid & 255, hb = tid >> 8;
  u16* CT = (u16*)(p.ws + OFF_CT);
  const float* h2c = (const float*)(p.ws + OFF_H2C) + (size_t)l * 256 * 64;
  const float* f3w = pk(p, PK_F3) + (size_t)l * 64 * 2048;
  const float* cw = pk(p, PK_CW) + (size_t)l * 3 * 1536;
  const float* cbv = pk(p, PK_CB) + (size_t)l * 1536;
  __syncthreads();
  {
    const int cf = hb * 1024 + c, cbk = cf + 512;
    float a_f = 0.f, a_b = 0.f;
    for (int j = 0; j < 64; ++j) { const float hv = h2c[t * 64 + j]; a_f += hv * f3w[j * 2048 + cf]; a_b += hv * f3w[j * 2048 + cbk]; }
    const float tt = (float)t / 255.f;
    filt[(hb * 2 + 0) * 256 + t] = a_f * (__expf(-tt * hy_delta(cf)) + 0.05f);
    filt[(hb * 2 + 1) * 256 + t] = a_b * (__expf(-tt * hy_delta(cbk)) + 0.05f);
    const u16* src = CT + ((size_t)(CH_YU + c) * 2 + hb) * TB;
    zs[hb * 256 + t] = sconv_at(src, t, LC, cw[c], cw[1536 + c], cw[3072 + c], cbv[c]);
  }
  __syncthreads();
  if (wid < 4) {
    float s = 0.f;
    for (int k = 0; k < 4; ++k) s += fabsf(filt[wid * 256 + lane + 64 * k]);
    s = wave_sum(s);
    if (lane == 0) nrm[wid] = s;
  }
  __syncthreads();
  const int b = hb;
  for (int o = 0; o < 2; ++o) {
    const float inf_ = 1.f / nrm[o * 2], inb_ = 1.f / nrm[o * 2 + 1];
    const float* hf = filt + (o * 2) * 256; const float* hbk = filt + (o * 2 + 1) * 256;
    const float* zc = zs + (o & 1) * 512 + b * 256;
    float accf = 0.f, accb = 0.f;
    for (int s = 0; s <= t; ++s) accf += hf[t - s] * zc[s];
    for (int s = t + 1; s < 256; ++s) accb += hbk[s - t] * zc[s];
    const int gch = CH_YU + 512 * (o + 1) + c;
    const float gate = sconv_at(CT + ((size_t)gch * 2 + b) * TB, t, LC, cw[gch], cw[1536 + gch], cw[3072 + gch], cbv[gch]);
    const float zn = gate * (accf * inf_ + accb * inb_ + pk(p, PK_SK)[(l * 2 + o) * 512 + c] * zc[t]);
    zs[((o + 1) & 1) * 512 + b * 256 + t] = zn;
    __syncthreads();
  }
  {
    u16* d = CT + ((size_t)(CH_YZ + c) * 2 + b) * TB;
    const u16 q0 = f2bf(zs[b * 256 + t] * silu_f(bf2f(d[t])));
    if (!dry) d[t] = q0;
  }
  __syncthreads();
}

DI void gla_bcum(const Params& p, int l, int row0, int hh, int dir, float* gs, float* segs, float* was, float* as_) {
  const int tid = my_tid();
  const u16* P = (const u16*)(p.ws + OFF_P);
  const float* wa = pk(p, dir ? PK_WAB : PK_WAF) + (size_t)l * 16 * 256 + hh * 64;
  const float* ba = pk(p, dir ? PK_BAB : PK_BAF) + l * 256 + hh * 64;
#pragma unroll
  for (int i = 0; i < 2; ++i) {
    const int idx = tid + NT * i;
    was[idx] = wa[(idx >> 6) * 256 + (idx & 63)];
    as_[(idx >> 4) * 17 + (idx & 15)] = bf2f(P[(size_t)(row0 + (idx >> 4)) * NP + PC_AF + dir * 16 + (idx & 15)]);
  }
  __syncthreads();
  {
    const int t = tid >> 3, d0 = (tid & 7) * 8;
    float lin[8];
#pragma unroll
    for (int e = 0; e < 8; ++e) lin[e] = ba[d0 + e];
#pragma unroll 2
    for (int rr = 0; rr < 16; ++rr) {
      const float av = as_[t * 17 + rr];
      const float4 w0 = *(const float4*)(was + rr * 64 + d0), w1 = *(const float4*)(was + rr * 64 + d0 + 4);
      lin[0] += av * w0.x; lin[1] += av * w0.y; lin[2] += av * w0.z; lin[3] += av * w0.w;
      lin[4] += av * w1.x; lin[5] += av * w1.y; lin[6] += av * w1.z; lin[7] += av * w1.w;
    }
#pragma unroll
    for (int e = 0; e < 8; ++e) gs[t * 65 + d0 + e] = (fminf(lin[e], 0.f) - log1pf(__expf(-fabsf(lin[e])))) * (1.f / 16.f);
  }
  __syncthreads();
  {
    const int d = tid & 63, seg = tid >> 6;
    float v[8]; float run = 0.f;
#pragma unroll
    for (int e = 0; e < 8; ++e) { const int tt = dir ? seg * 8 + 7 - e : seg * 8 + e; run += gs[tt * 65 + d]; v[e] = run; }
    segs[seg * 64 + d] = run;
    __syncthreads();
    float off = 0.f;
#pragma unroll
    for (int s = 0; s < 8; ++s) { const bool before = dir ? (s > seg) : (s < seg); if (before) off += segs[s * 64 + d]; }
#pragma unroll
    for (int e = 0; e < 8; ++e) { const int tt = dir ? seg * 8 + 7 - e : seg * 8 + e; gs[tt * 65 + d] = v[e] + off; }
  }
  __syncthreads();
}
DI int gla_tok0(int dir, int n) {
  if (n < 4) return (dir ? 3 - n : n) * 64;
  return LC + (dir ? 255 - (n - 4) : n - 4) * 64;
}
constexpr int G_GS = 0;
constexpr int G_SEG = G_GS + 64 * 65 * 4;
constexpr int G_QS = G_SEG + 8 * 64 * 4;
constexpr int G_KS = G_QS + 64 * LDT * 2;
constexpr int G_VT = G_KS + 64 * LDT * 2;
constexpr int G_ST = G_VT + 128 * LDT * 2;
constexpr int G_RED = G_ST + 128 * LDT * 2;
constexpr int G_WA = G_RED + 8 * 32 * 4;
constexpr int G_AS = G_WA + 16 * 64 * 4;

DI void gla_g1_task(const Params& p, int l, int chain, int n, char* smem) {
  const int tid = my_tid(), lane = tid & 63, wid = tid >> 6, r = lane & 31, h = lane >> 5;
  const int b = chain >> 3, hh = (chain >> 1) & 3, dir = chain & 1;
  const int tk0 = gla_tok0(dir, n), row0 = b * TB + tk0;
  float* gs = (float*)(smem + G_GS); float* segs = (float*)(smem + G_SEG);
  u16* kT = (u16*)(smem + G_KS); u16* vT = (u16*)(smem + G_VT);
  const u16* P = (const u16*)(p.ws + OFF_P);
  const u16* CT = (const u16*)(p.ws + OFF_CT);
  __syncthreads();
  gla_bcum(p, l, row0, hh, dir, gs, segs, (float*)(smem + G_WA), (float*)(smem + G_AS));
  const int tl = dir ? 0 : 63;
  {
    const int t = tid >> 3, d0 = (tid & 7) * 8;
    const u32x4 kv = *(const u32x4*)(P + (size_t)(row0 + t) * NP + PC_GK + hh * 64 + d0);
    const unsigned w[4] = {kv.x, kv.y, kv.z, kv.w};
#pragma unroll
    for (int e = 0; e < 8; ++e) {
      const float kx = (e & 1) ? bfhi(w[e >> 1]) : bflo(w[e >> 1]);
      kT[(d0 + e) * LDT + t] = f2bf(kx * __expf(gs[tl * 65 + d0 + e] - gs[t * 65 + d0 + e]));
    }
#pragma unroll
    for (int i = 0; i < 2; ++i) {
      const int q = tid + NT * i, v = q >> 3, cc = q & 7;
      *(u32x4*)(vT + v * LDT + cc * 8) = *(const u32x4*)(CT + ((size_t)(CH_GV + hh * 128 + v) * 2 + b) * TB + tk0 + cc * 8);
    }
    if (tid < 64) ((float*)(p.ws + OFF_GD))[((size_t)chain * NCK + n) * 64 + tid] = __expf(gs[tl * 65 + tid]);
  }
  __syncthreads();
  {
    const int vm = wid >> 1, dn = wid & 1;
    f32x16 acc = zero16();
#pragma unroll
    for (int s = 0; s < 4; ++s) {
      const bf16x8 a = *(const bf16x8*)(vT + (vm * 32 + r) * LDT + s * 16 + h * 8);
      const bf16x8 bb = *(const bf16x8*)(kT + (dn * 32 + r) * LDT + s * 16 + h * 8);
      acc = MFMA(a, bb, acc);
    }
    u16* GS = (u16*)(p.ws + OFF_GS) + ((size_t)chain * NCK + n) * 8192;
#pragma unroll
    for (int reg = 0; reg < 16; ++reg) GS[(vm * 32 + crow(reg, h)) * 64 + dn * 32 + r] = f2bf(acc[reg]);
  }
}
DI void gla_g2(const Params& p, int dry) {
  u16* GSb = (u16*)(p.ws + OFF_GS);
  const float* GD = (const float*)(p.ws + OFF_GD);
  for (int gi = blockIdx.x * NT + my_tid(); gi < 16 * 8192; gi += gridDim.x * NT) {
    const int chain = gi >> 13, e = gi & 8191, d = e & 63;
    u16* ptr = GSb + (size_t)chain * NCK * 8192 + e;
    const float* dec = GD + (size_t)chain * NCK * 64 + d;
    float S = 0.f;
#pragma unroll 1
    for (int n0 = 0; n0 < NCK; n0 += 20) {
      float ds[20], a[20];
#pragma unroll
      for (int k = 0; k < 20; ++k) { ds[k] = bf2f(ptr[(size_t)(n0 + k) * 8192]); a[k] = dec[(n0 + k) * 64]; }
#pragma unroll
      for (int k = 0; k < 20; ++k) { if (!dry) ptr[(size_t)(n0 + k) * 8192] = f2bf(S); S = a[k] * S + ds[k]; }
    }
  }
}
DI void gla_g3_task(const Params& p, int l, int b, int hh, int ci, char* smem, int dry) {
  const int tid = my_tid(), lane = tid & 63, wid = tid >> 6, r = lane & 31, h = lane >> 5;
  const int tk0 = ci * 64, row0 = b * TB + tk0;
  float* gs = (float*)(smem + G_GS); float* segs = (float*)(smem + G_SEG); float* red = (float*)(smem + G_RED);
  u16* qs = (u16*)(smem + G_QS); u16* ks = (u16*)(smem + G_KS); u16* vT = (u16*)(smem + G_VT); u16* sT = (u16*)(smem + G_ST);
  u16* P = (u16*)(p.ws + OFF_P);
  const u16* CT = (const u16*)(p.ws + OFF_CT);
  const int vm = wid >> 1, in = wid & 1;
  f32x16 o = zero16();
  __syncthreads();
#pragma unroll 1
  for (int dir = 0; dir < 2; ++dir) {
    gla_bcum(p, l, row0, hh, dir, gs, segs, (float*)(smem + G_WA), (float*)(smem + G_AS));
    const int chain = b * 8 + hh * 2 + dir;
    const int n = dir ? ((ci < 4) ? 3 - ci : 263 - ci) : ci;
    {
      const int t = tid >> 3, d0 = (tid & 7) * 8;
      const u32x4 qv = *(const u32x4*)(P + (size_t)(row0 + t) * NP + PC_GQ + hh * 64 + d0);
      const u32x4 kv = *(const u32x4*)(P + (size_t)(row0 + t) * NP + PC_GK + hh * 64 + d0);
      const unsigned qw[4] = {qv.x, qv.y, qv.z, qv.w}, kw[4] = {kv.x, kv.y, kv.z, kv.w};
      unsigned qo[4], ko[4];
#pragma unroll
      for (int e = 0; e < 4; ++e) {
        const float b0 = gs[t * 65 + d0 + 2 * e], b1 = gs[t * 65 + d0 + 2 * e + 1];
        qo[e] = pack2(bflo(qw[e]) * 0.125f * __expf(b0), bfhi(qw[e]) * 0.125f * __expf(b1));
        ko[e] = pack2(bflo(kw[e]) * __expf(-b0), bfhi(kw[e]) * __expf(-b1));
      }
      *(u32x4*)(qs + t * LDT + d0) = u32x4{qo[0], qo[1], qo[2], qo[3]};
      *(u32x4*)(ks + t * LDT + d0) = u32x4{ko[0], ko[1], ko[2], ko[3]};
      const u16* GS = (const u16*)(p.ws + OFF_GS) + ((size_t)chain * NCK + n) * 8192;
#pragma unroll
      for (int i = 0; i < 2; ++i) {
        const int q = tid + NT * i, v = q >> 3, cc = q & 7;
        *(u32x4*)(sT + v * LDT + cc * 8) = *(const u32x4*)(GS + v * 64 + cc * 8);
        if (dir == 0) *(u32x4*)(vT + v * LDT + cc * 8) = *(const u32x4*)(CT + ((size_t)(CH_GV + hh * 128 + v) * 2 + b) * TB + tk0 + cc * 8);
      }
    }
    __syncthreads();
    bf16x8 qf[4];
#pragma unroll
    for (int s = 0; s < 4; ++s) qf[s] = *(const bf16x8*)(qs + (in * 32 + r) * LDT + s * 16 + h * 8);
#pragma unroll
    for (int jt = 0; jt < 2; ++jt) {
      f32x16 at = zero16();
#pragma unroll
      for (int s = 0; s < 4; ++s) at = MFMA(*(const bf16x8*)(ks + (jt * 32 + r) * LDT + s * 16 + h * 8), qf[s], at);
      const int ii = in * 32 + r;
#pragma unroll
      for (int reg = 0; reg < 16; ++reg) {
        const int jj = jt * 32 + crow(reg, h);
        const bool keep = dir ? (jj >= ii) : (jj <= ii);
        if (!keep) at[reg] = 0.f;
      }
#pragma unroll
      for (int s = 0; s < 2; ++s) {
        const u16* vp = vT + (vm * 32 + r) * LDT + jt * 32 + 16 * s + 4 * h;
        o = MFMA(ld2x64(vp, vp + 8), pack8(at, s), o);
      }
    }
#pragma unroll
    for (int s = 0; s < 4; ++s) o = MFMA(*(const bf16x8*)(sT + (vm * 32 + r) * LDT + s * 16 + h * 8), qf[s], o);
    __syncthreads();
  }
  float ss = 0.f;
#pragma unroll
  for (int reg = 0; reg < 16; ++reg) ss += o[reg] * o[reg];
  ss += __shfl_xor(ss, 32);
  if (h == 0) red[wid * 32 + r] = ss;
  __syncthreads();
  float tot = 0.f;
#pragma unroll
  for (int m = 0; m < 4; ++m) tot += red[(m * 2 + in) * 32 + r];
  const float rs = rsqrtf(tot * (1.f / 128.f) + EPS);
  u16* zp = P + (size_t)(row0 + in * 32 + r) * NP + PC_GZ + hh * 128 + vm * 32 + 4 * h;
  const float* gn = pk(p, PK_GN) + l * 128 + vm * 32 + 4 * h;
#pragma unroll
  for (int g = 0; g < 4; ++g) {
    const u32x2 zz = *(const u32x2*)(zp + 8 * g);
    const float4 gw = *(const float4*)(gn + 8 * g);
    u32x2 out;
    out.x = pack2(o[4 * g] * rs * gw.x * silu_f(bflo(zz.x)), o[4 * g + 1] * rs * gw.y * silu_f(bfhi(zz.x)));
    out.y = pack2(o[4 * g + 2] * rs * gw.z * silu_f(bflo(zz.y)), o[4 * g + 3] * rs * gw.w * silu_f(bfhi(zz.y)));
    if (!dry) *(u32x2*)(zp + 8 * g) = out;
  }
}

DI void attn_item(const Params& p, int l, int b, int g, int qtk0, int ntiles, char* smem, int dry) {
  const int tid = my_tid(), lane = tid & 63, wid = tid >> 6, r = lane & 31, h = lane >> 5;
  u16* P = (u16*)(p.ws + OFF_P);
  const u16* CT = (const u16*)(p.ws + OFF_CT);
  u16* Ks = (u16*)smem;
  u16* Vs = Ks + 2 * 64 * LDT;
  const int hq = g * 4 + (wid >> 1);
  const size_t qrow = (size_t)b * TB + qtk0 + (wid & 1) * 32 + r;
  bf16x8 qf[4];
#pragma unroll
  for (int s = 0; s < 4; ++s) qf[s] = *(const bf16x8*)(P + qrow * NP + PC_AQ + hq * 64 + s * 16 + h * 8);
  f32x16 O[2] = {zero16(), zero16()};
  float m = -1e30f, lsum = 0.f;
  const int lr = tid >> 3, lc = (tid & 7) * 8;
  const u16* kg = P + ((size_t)b * TB + lr) * NP + PC_AK + g * 64 + lc;
  const u16* vg = CT + ((size_t)(CH_AV + g * 64 + lr) * 2 + b) * TB + lc;
  u32x4 rk = *(const u32x4*)kg, rv = *(const u32x4*)vg;
  __syncthreads();
  *(u32x4*)(Ks + lr * LDT + lc) = rk; *(u32x4*)(Vs + lr * LDT + lc) = rv;
  __syncthreads();
  float gqm = fabsf(pk(p, PK_QN)[l * 64 + lane]), gkm = fabsf(pk(p, PK_KN)[l * 64 + lane]);
#pragma unroll
  for (int o = 32; o >= 1; o >>= 1) { gqm = fmaxf(gqm, __shfl_xor(gqm, o)); gkm = fmaxf(gkm, __shfl_xor(gkm, o)); }
  const float mshift = 8.2f * 1.4426950408889634f * gqm * gkm;
  if (mshift <= 60.f) {
    f32x16 sinit;
#pragma unroll
    for (int i = 0; i < 16; ++i) sinit[i] = -mshift;
#pragma unroll 1
    for (int kt = 0; kt < ntiles; ++kt) {
      const int cur = kt & 1;
      if (kt + 1 < ntiles) { rk = *(const u32x4*)(kg + (size_t)(kt + 1) * 64 * NP); rv = *(const u32x4*)(vg + (kt + 1) * 64); }
      const u16* Kc = Ks + cur * 64 * LDT; const u16* Vc = Vs + cur * 64 * LDT;
      f32x16 st[2];
#pragma unroll
      for (int kk = 0; kk < 2; ++kk) {
        st[kk] = sinit;
#pragma unroll
        for (int s = 0; s < 4; ++s) st[kk] = MFMA(*(const bf16x8*)(Kc + (kk * 32 + r) * LDT + s * 16 + h * 8), qf[s], st[kk]);
      }
#pragma unroll
      for (int kk = 0; kk < 2; ++kk)
#pragma unroll
        for (int i = 0; i < 16; ++i) { const float pv = __builtin_amdgcn_exp2f(st[kk][i]); st[kk][i] = pv; lsum += pv; }
#pragma unroll
      for (int kk = 0; kk < 2; ++kk)
#pragma unroll
        for (int s = 0; s < 2; ++s) {
          const bf16x8 pb = pack8(st[kk], s);
#pragma unroll
          for (int mt = 0; mt < 2; ++mt) {
            const u16* vp = Vc + (mt * 32 + r) * LDT + kk * 32 + 16 * s + 4 * h;
            O[mt] = MFMA(ld2x64(vp, vp + 8), pb, O[mt]);
          }
        }
      if (kt + 1 < ntiles) { *(u32x4*)(Ks + (cur ^ 1) * 64 * LDT + lr * LDT + lc) = rk; *(u32x4*)(Vs + (cur ^ 1) * 64 * LDT + lr * LDT + lc) = rv; }
      __syncthreads();
    }
  } else {
#pragma unroll 1
    for (int kt = 0; kt < ntiles; ++kt) {
      const int cur = kt & 1;
      if (kt + 1 < ntiles) { rk = *(const u32x4*)(kg + (size_t)(kt + 1) * 64 * NP); rv = *(const u32x4*)(vg + (kt + 1) * 64); }
      const u16* Kc = Ks + cur * 64 * LDT; const u16* Vc = Vs + cur * 64 * LDT;
      f32x16 st[2];
#pragma unroll
      for (int kk = 0; kk < 2; ++kk) {
        st[kk] = zero16();
#pragma unroll
        for (int s = 0; s < 4; ++s) st[kk] = MFMA(*(const bf16x8*)(Kc + (kk * 32 + r) * LDT + s * 16 + h * 8), qf[s], st[kk]);
      }
      float mx = st[0][0];
#pragma unroll
      for (int i = 0; i < 16; ++i) { mx = fmaxf(mx, st[0][i]); mx = fmaxf(mx, st[1][i]); }
      mx = fmaxf(mx, __shfl_xor(mx, 32));
      const float mn = fmaxf(m, mx);
      const float alpha = exp2f(m - mn);
      m = mn;
      float rsum = 0.f;
#pragma unroll
      for (int kk = 0; kk < 2; ++kk)
#pragma unroll
        for (int i = 0; i < 16; ++i) { const float pv = exp2f(st[kk][i] - mn); st[kk][i] = pv; rsum += pv; }
      lsum = lsum * alpha + rsum;
#pragma unroll
      for (int mt = 0; mt < 2; ++mt)
#pragma unroll
        for (int i = 0; i < 16; ++i) O[mt][i] *= alpha;
#pragma unroll
      for (int kk = 0; kk < 2; ++kk)
#pragma unroll
        for (int s = 0; s < 2; ++s) {
          const bf16x8 pb = pack8(st[kk], s);
#pragma unroll
          for (int mt = 0; mt < 2; ++mt) {
            const u16* vp = Vc + (mt * 32 + r) * LDT + kk * 32 + 16 * s + 4 * h;
            O[mt] = MFMA(ld2x64(vp, vp + 8), pb, O[mt]);
          }
        }
      if (kt + 1 < ntiles) { *(u32x4*)(Ks + (cur ^ 1) * 64 * LDT + lr * LDT + lc) = rk; *(u32x4*)(Vs + (cur ^ 1) * 64 * LDT + lr * LDT + lc) = rv; }
      __syncthreads();
    }
  }
  lsum += __shfl_xor(lsum, 32);
  const float inv = 1.f / lsum;
  u16* op = P + qrow * NP + PC_AQ + hq * 64 + 4 * h;
  const u16* zp = P + qrow * NP + PC_AZ + hq * 64 + 4 * h;
#pragma unroll
  for (int mt = 0; mt < 2; ++mt)
#pragma unroll
    for (int gg = 0; gg < 4; ++gg) {
      const u32x2 zz = *(const u32x2*)(zp + mt * 32 + 8 * gg);
      u32x2 out;
      out.x = pack2(O[mt][4 * gg] * inv * silu_f(bflo(zz.x)), O[mt][4 * gg + 1] * inv * silu_f(bfhi(zz.x)));
      out.y = pack2(O[mt][4 * gg + 2] * inv * silu_f(bflo(zz.y)), O[mt][4 * gg + 3] * inv * silu_f(bfhi(zz.y)));
      if (!dry) *(u32x2*)(op + mt * 32 + 8 * gg) = out;
    }
}

template <int KSU>
DI void gemm_gate3(const u16* __restrict__ A, const u16* __restrict__ WM, char* smem, f32x16 (&acc)[3][2]) {
  u16* As0 = (u16*)smem;
  u16* As1 = As0 + 128 * LDT;
  u16* Bs0 = As0 + 2 * 128 * LDT;
  u16* Bs1 = Bs0 + 384 * LDT;
  const int tid = my_tid(), lane = tid & 63, wid = tid >> 6, r = lane & 31, h = lane >> 5, wm = wid & 3, wn = wid >> 2;
  u32x4 ra0[2], rb0[6], ra1[2], rb1[6];
  auto fetch = [&](u32x4 (&ra)[2], u32x4 (&rb)[6], int k0) {
#pragma unroll
    for (int i = 0; i < 2; ++i) { const int q = tid + NT * i; const unsigned off = (unsigned)((q >> 3) * 1024 + (q & 7) * 8); ra[i] = *(const u32x4*)(A + off + k0); }
#pragma unroll
    for (int i = 0; i < 6; ++i) {
      const int q = tid + NT * i, row = q >> 3;
      const unsigned off = (unsigned)((row >> 7) * (1024 * 1024) + (row & 127) * 1024 + (q & 7) * 8);
      rb[i] = *(const u32x4*)(WM + off + k0);
    }
    GFENCE;
  };
  auto commit = [&](const u32x4 (&ra)[2], const u32x4 (&rb)[6], u16* As, u16* Bs) {
#pragma unroll
    for (int i = 0; i < 2; ++i) { const int q = tid + NT * i; *(u32x4*)(As + (q >> 3) * LDT + (q & 7) * 8) = ra[i]; }
#pragma unroll
    for (int i = 0; i < 6; ++i) { const int q = tid + NT * i; *(u32x4*)(Bs + (q >> 3) * LDT + (q & 7) * 8) = rb[i]; }
    GFENCE;
  };
  auto compute = [&](const u16* Ac, const u16* Bc) {
#pragma unroll KSU
    for (int ks = 0; ks < 4; ++ks) {
      const bf16x8 a = *(const bf16x8*)(Ac + (wm * 32 + r) * LDT + ks * 16 + h * 8);
#pragma unroll
      for (int br = 0; br < 3; ++br)
#pragma unroll
        for (int j = 0; j < 2; ++j)
          acc[br][j] = MFMA(a, *(const bf16x8*)(Bc + (br * 128 + wn * 64 + j * 32 + r) * LDT + ks * 16 + h * 8), acc[br][j]);
    }
  };
  constexpr int KT = 16;
  fetch(ra0, rb0, 0);
  fetch(ra1, rb1, 64);
  __syncthreads();
  commit(ra0, rb0, As0, Bs0);
  __syncthreads();
  fetch(ra0, rb0, 128);
#pragma unroll
  for (int kt = 0; kt < KT; kt += 2) {
    commit(ra1, rb1, As1, Bs1);
    if (kt + 3 < KT) fetch(ra1, rb1, (kt + 3) * 64);
    compute(As0, Bs0);
    __syncthreads();
    if (kt + 2 < KT) commit(ra0, rb0, As0, Bs0);
    if (kt + 4 < KT) fetch(ra0, rb0, (kt + 4) * 64);
    compute(As1, Bs1);
    __syncthreads();
  }
}
DI void phase_merge(const Params& p, int l, char* smem) {
  const int tid = my_tid(), lane = tid & 63, wid = tid >> 6, r = lane & 31, h = lane >> 5, wm = wid & 3, wn = wid >> 2;
  const int xcd = blockIdx.x & 7, nloc = gridDim.x >> 3;
  for (int q = blockIdx.x >> 3; q < 33 * 8; q += nloc) {
    const int mt = (q >> 3) * 8 + xcd, nt = q & 7, m0 = mt * 128, n0 = nt * 128;
    if (mt >= 260) continue;
    const int b = m0 / TB, tk0 = m0 - b * TB;
    if (l == 1 && tk0 < LC) continue;
    const u16* H = (const u16*)(p.ws + OFF_H) + (size_t)m0 * 1024;
    const u16* WM = (const u16*)(p.ws + OFF_WT + (size_t)l * WT_LAYER) + (size_t)(4896 + n0) * 1024;
    const u16* WBR = (const u16*)(p.ws + OFF_WT + (size_t)l * WT_LAYER + WT_IN) + (size_t)n0 * 512;
    unsigned gp[3][2][8];
    {
      f32x16 g3[3][2];
#pragma unroll
      for (int br = 0; br < 3; ++br) for (int j = 0; j < 2; ++j) g3[br][j] = zero16();
      gemm_gate3<2>(H, WM, smem, g3);
#pragma unroll
      for (int br = 0; br < 3; ++br)
#pragma unroll
        for (int j = 0; j < 2; ++j)
#pragma unroll
          for (int i = 0; i < 8; ++i)
            gp[br][j][i] = pack2(1.f / (1.f + __expf(-g3[br][j][2 * i])), 1.f / (1.f + __expf(-g3[br][j][2 * i + 1])));
    }
    f32x16 ysum[2] = {zero16(), zero16()};
#pragma unroll
    for (int br = 0; br < 3; ++br) {
      f32x16 ab[1][2] = {{zero16(), zero16()}};
      if (br < 2) {
        ALoadN ay{(const u16*)(p.ws + OFF_P) + (size_t)m0 * NP + (br == 0 ? PC_GZ : PC_AQ), NP};
        gemm_tile<128, ALoadN, 4, 512>(ay, WBR + (size_t)br * 1024 * 512, 512, smem, ab);
      } else {
        ALoadT ay{(const u16*)(p.ws + OFF_CT) + ((size_t)CH_YZ * 2 + b) * TB + tk0, (size_t)2 * TB};
        gemm_tile<128, ALoadT, 4, 512>(ay, WBR + (size_t)2 * 1024 * 512, 512, smem, ab);
      }
#pragma unroll
      for (int j = 0; j < 2; ++j)
#pragma unroll
        for (int i = 0; i < 8; ++i) {
          ysum[j][2 * i] += bflo(gp[br][j][i]) * ab[0][j][2 * i];
          ysum[j][2 * i + 1] += bfhi(gp[br][j][i]) * ab[0][j][2 * i + 1];
        }
    }
    u16* Y = (u16*)(p.ws + OFF_Y) + (size_t)(m0 + wm * 32 + 4 * h) * 1024 + n0 + wn * 64 + r;
#pragma unroll
    for (int j = 0; j < 2; ++j)
#pragma unroll
      for (int reg = 0; reg < 16; ++reg) Y[(size_t)((reg & 3) + 8 * (reg >> 2)) * 1024 + j * 32] = f2bf(ysum[j][reg]);
  }
}

DI void phase_out(const Params& p, int l, char* smem) {
  const int tid = my_tid(), lane = tid & 63, wid = tid >> 6, r = lane & 31, h = lane >> 5, wm = wid & 3, wn = wid >> 2;
  const u16* Yb = (const u16*)(p.ws + OFF_Y);
  const u16* WO = (const u16*)(p.ws + OFF_WT + (size_t)l * WT_LAYER + WT_IN + 3 * WT_BR);
  const float* mod = (const float*)(p.ws + OFF_MOD);
  const int xcd = blockIdx.x & 7, nloc = gridDim.x >> 3;
  auto tile_of = [&](int q, int& m0, int& n0) -> bool {
    const int mt = (q >> 3) * 8 + xcd; m0 = mt * 128; n0 = (q & 7) * 128;
    if (mt >= 260) return false;
    const int b = m0 / TB, tk0 = m0 - b * TB;
    return !(l == 1 && tk0 < LC);
  };
  auto next_q = [&](int q) -> int { int m, n; for (q += nloc; q < 33 * 8; q += nloc) if (tile_of(q, m, n)) return q; return -1; };
  int q = (int)(blockIdx.x >> 3) - nloc; q = next_q(q);
  if (q < 0) return;
  int m0, n0; tile_of(q, m0, n0);
  GemmRegs<128> gr;
  { ALoadN ay{Yb + (size_t)m0 * 1024, 1024}; gemm_prime<128>(gr, ay, WO + (size_t)n0 * 1024, 1024, smem); }
  while (true) {
    const int qn = next_q(q);
    int m0n = 0, n0n = 0; if (qn >= 0) tile_of(qn, m0n, n0n);
    const int b = m0 / TB, tk0 = m0 - b * TB;
    f32x16 acc[1][2] = {{zero16(), zero16()}};
    const ALoadN ay{Yb + (size_t)m0 * 1024, 1024}, ayn{Yb + (size_t)m0n * 1024, 1024};
    gemm_run<128, ALoadN, 4, 1024, ALoadN>(gr, ay, WO + (size_t)n0 * 1024, 1024, ayn, WO + (size_t)n0n * 1024, 1024, qn >= 0, smem, acc);
    const float* gv = mod + (l * 3 + (tk0 < LC ? 2 : b)) * 3072 + 2048;
    const float* xin = xrow_in(p, l, m0);
    float* xout = xrow_out(p, m0);
#pragma unroll
    for (int j = 0; j < 2; ++j) {
      const int col = n0 + wn * 64 + j * 32 + r;
      const float gate = gv[col];
#pragma unroll
      for (int reg = 0; reg < 16; ++reg) {
        const size_t off = (size_t)(wm * 32 + crow(reg, h)) * D + col;
        xout[off] = xin[off] + gate * acc[0][j][reg];
      }
    }
    if (qn < 0) break;
    q = qn; m0 = m0n; n0 = n0n;
  }
}

DI void phase_final(const Params& p) {
  const int tid = my_tid(), lane = tid & 63, wid = tid >> 6;
  for (int row = blockIdx.x * 8 + wid; row < NBATCH * L; row += gridDim.x * 8) {
    float* src = p.out + (size_t)row * D;
    float4 xv[4]; float ss = 0.f;
#pragma unroll
    for (int i = 0; i < 4; ++i) { xv[i] = *(const float4*)(src + (i * 64 + lane) * 4); ss += xv[i].x * xv[i].x + xv[i].y * xv[i].y + xv[i].z * xv[i].z + xv[i].w * xv[i].w; }
    ss = wave_sum(ss);
    const float rs = rsqrtf(ss * (1.f / 1024.f) + EPS);
#pragma unroll
    for (int i = 0; i < 4; ++i) {
      const int col = (i * 64 + lane) * 4;
      const float4 fw = *(const float4*)(pk(p, PK_FN) + col);
      *(float4*)(src + col) = make_float4(xv[i].x * rs * fw.x, xv[i].y * rs * fw.y, xv[i].z * rs * fw.z, xv[i].w * rs * fw.w);
    }
  }
}

DI void run_phase(const Params& p, int ph, char* smem, int dry = 0) {
  const int bid = blockIdx.x, nb = gridDim.x;
  if (ph == 0) { phase0(p, smem); return; }
  if (ph == 17) { phase_final(p); return; }
  const int l = (ph - 1) >> 3, s = (ph - 1) & 7;
  switch (s) {
    case 0: phase_norm(p, l); break;
    case 1: phase_proj(p, l, smem); break;
    case 2: {
      attn_prep(p, l, dry);
      if (l == 0) for (int c = bid; c < 512; c += nb) hyena_ctx_task(p, l, c, smem, dry);
      for (int c = bid; c < 512; c += nb) hyena_latent_task(p, l, c, smem, dry);
    } break;
    case 3: for (int t = bid; t < 16 * NCK; t += nb) gla_g1_task(p, l, t / NCK, t % NCK, smem); break;
    case 4: gla_g2(p, dry); break;
    case 5: {
      for (int it = bid; it < 1024; it += nb) { const int b = it >> 9, g = (it >> 8) & 1, qb = it & 255; attn_item(p, l, b, g, LC + qb * 64, NCK, smem, dry); }
      if (l == 0) for (int it = bid; it < 16; it += nb) { const int b = it >> 3, g = (it >> 2) & 1, qb = it & 3; attn_item(p, l, b, g, qb * 64, 4, smem, dry); }
      const int c0 = (l == 0) ? 0 : 4, per = NCK - c0;
      for (int t = bid; t < 8 * per; t += nb) { const int bh = t / per, ci = c0 + t % per; gla_g3_task(p, l, bh >> 2, bh & 3, ci, smem, dry); }
    } break;
    case 6: phase_merge(p, l, smem); break;
    case 7: phase_out(p, l, smem); break;
  }
}

#if MULTI_LAUNCH
template <int PH> __global__ void __launch_bounds__(NT) phase_kernel(Params p) {
  extern __shared__ __attribute__((aligned(16))) char smem[];
  run_phase(p, PH, smem);
}
template <int PH> static void launch_phase(const Params& p, int grid, hipStream_t stream) {
  static bool attr = false;
  if (!attr) { (void)hipFuncSetAttribute((const void*)phase_kernel<PH>, hipFuncAttributeMaxDynamicSharedMemorySize, LDS_BYTES); attr = true; }
  hipLaunchKernelGGL(phase_kernel<PH>, dim3(grid), dim3(NT), LDS_BYTES, stream, p);
}
#else
DI unsigned xb_ld(unsigned* q) { return __hip_atomic_load(q, __ATOMIC_RELAXED, __HIP_MEMORY_SCOPE_AGENT); }
DI unsigned xb_add(unsigned* q, unsigned v) { return __hip_atomic_fetch_add(q, v, __ATOMIC_RELAXED, __HIP_MEMORY_SCOPE_AGENT); }
DI unsigned xb_xcc_id() { return (unsigned)__builtin_amdgcn_s_getreg((3 << 11) | 20) & 0xFu; }
#define XB_SPIN(cond) do { unsigned sp_ = 0; while ((cond) && ++sp_ < 400000u) __builtin_amdgcn_s_sleep(1); } while (0)
DI void gbar_census(const Params& p) {
  if (threadIdx.x == 0) (void)xb_add((unsigned*)(p.ws + OFF_BAR) + xb_xcc_id() * 64, 1u);
}
DI void gbar_setup(const Params& p, char* smem) {
  if (threadIdx.x == 0) {
    unsigned* bar = (unsigned*)(p.ws + OFF_BAR);
    const unsigned x = xb_xcc_id();
    unsigned mine = 1u, cnt = 0u;
    for (unsigned j = 0; j < 16; ++j) { const unsigned c = xb_ld(bar + j * 64); cnt += (c > 0u) ? 1u : 0u; if (j == x) mine = c; }
    volatile unsigned* st = (volatile unsigned*)(smem + BAR_LDS);
    st[0] = mine > 0u ? mine : 1u; st[1] = cnt > 0u ? cnt : 1u;
  }
  __syncthreads();
}
DI void gbar(const Params& p, unsigned k, char* smem) {
  asm volatile("s_waitcnt vmcnt(0)" ::: "memory");
  __syncthreads();
  if (threadIdx.x == 0) {
    unsigned* bar = (unsigned*)(p.ws + OFF_BAR);
    volatile unsigned* st = (volatile unsigned*)(smem + BAR_LDS);
    const unsigned nloc = st[0], nx = st[1], x = xb_xcc_id();
    __builtin_amdgcn_s_waitcnt(0);
    const unsigned old = xb_add(bar + (16 + x) * 64, 1u);
    if (old + 1u == k * nloc) {
      __builtin_amdgcn_fence(__ATOMIC_RELEASE, "agent");
      asm volatile("s_waitcnt vmcnt(0)" ::: "memory");
      const unsigned og = xb_add(bar + 48 * 64, 1u);
      if (og + 1u == k * nx) xb_add(bar + 49 * 64, 1u);
      else XB_SPIN(xb_ld(bar + 49 * 64) < k);
      __builtin_amdgcn_fence(__ATOMIC_ACQUIRE, "agent");
      xb_add(bar + (32 + x) * 64, 1u);
      asm volatile("s_waitcnt vmcnt(0)" ::: "memory");
    } else {
      XB_SPIN(xb_ld(bar + (32 + x) * 64) < k);
      __builtin_amdgcn_fence(__ATOMIC_ACQUIRE, "agent");
      asm volatile("s_waitcnt vmcnt(0)" ::: "memory");
    }
  }
  __syncthreads();
}
#ifndef PROBE_DUP
#define PROBE_DUP -1
#endif
#ifndef PROBE_DUP2
#define PROBE_DUP2 -1
#endif
#ifndef PROBE_DUP3
#define PROBE_DUP3 -1
#endif
__global__ void __launch_bounds__(NT) fwd_kernel(Params p) {
  extern __shared__ __attribute__((aligned(16))) char smem[];
  cg::grid_group grid = cg::this_grid();
#if PROBE_DUP >= 0
#define PHS(n) if ((n) == PROBE_DUP || (n) == PROBE_DUP2 || (n) == PROBE_DUP3) { run_phase(p, n, smem, p.phase_lo == 0 ? 1 : 0); grid.sync(); } run_phase(p, n, smem); grid.sync();
#else
#define PHS(n) run_phase(p, n, smem); if ((n) == 0) { grid.sync(); gbar_setup(p, smem); } else gbar(p, (unsigned)(n), smem);
#endif
  gbar_census(p);
  PHS(0) PHS(1) PHS(2) PHS(3) PHS(4) PHS(5) PHS(6) PHS(7) PHS(8)
  PHS(9) PHS(10) PHS(11) PHS(12) PHS(13) PHS(14) PHS(15) PHS(16)
  run_phase(p, 17, smem);
}
#endif

extern "C" void kernel_launch(void* const* d_in, const int* in_sizes, int n_in, void* d_out, int out_size, void* d_ws, size_t ws_size,
                              hipStream_t stream) {
  static int grid = 0;
  if (grid == 0) {
    if (n_in != 29 || ws_size < WS_END) { fprintf(stderr, "kernel_launch: need 29 inputs and %zu B of workspace, got %d / %zu\n", (size_t)WS_END, n_in, ws_size); grid = -1; return; }
#if MULTI_LAUNCH
    grid = 256;
#else
    int dev = 0, cus = 0, per_cu = 0;
    (void)hipGetDevice(&dev);
    (void)hipDeviceGetAttribute(&cus, hipDeviceAttributeMultiprocessorCount, dev);
    if (hipFuncSetAttribute((const void*)fwd_kernel, hipFuncAttributeMaxDynamicSharedMemorySize, LDS_BYTES) != hipSuccess) { fprintf(stderr, "kernel_launch: hipFuncSetAttribute failed\n"); grid = -1; return; }
    (void)hipOccupancyMaxActiveBlocksPerMultiprocessor(&per_cu, (const void*)fwd_kernel, NT, LDS_BYTES);
    if (per_cu < 1) { fprintf(stderr, "kernel_launch: occupancy query returned %d\n", per_cu); per_cu = 1; }
    (void)hipGetLastError();
    grid = cus * per_cu;
    if (grid > 256) grid = 256;
#endif
  }
  if (grid < 0) return;
  Params p{};
  const float** pp = (const float**)&p;
  for (int i = 0; i < 29; ++i) pp[i] = (const float*)d_in[i];
  p.out = (float*)d_out; p.ws = (char*)d_ws;
  p.phase_lo = 0; p.phase_hi = 18;
#if MULTI_LAUNCH
  launch_phase<0>(p, grid, stream); launch_phase<1>(p, grid, stream); launch_phase<2>(p, grid, stream); launch_phase<3>(p, grid, stream);
  launch_phase<4>(p, grid, stream); launch_phase<5>(p, grid, stream); launch_phase<6>(p, grid, stream); launch_phase<7>(p, grid, stream);
  launch_phase<8>(p, grid, stream); launch_phase<9>(p, grid, stream); launch_phase<10>(p, grid, stream); launch_phase<11>(p, grid, stream);
  launch_phase<12>(p, grid, stream); launch_phase<13>(p, grid, stream); launch_phase<14>(p, grid, stream); launch_phase<15>(p, grid, stream);
  launch_phase<16>(p, grid, stream); launch_phase<17>(p, grid, stream);
#else
  if (hipMemsetAsync((char*)d_ws + OFF_BAR, 0, BAR_BYTES, stream) != hipSuccess) { fprintf(stderr, "kernel_launch: barrier memset failed\n"); return; }
  void* args[] = {&p};
  hipError_t e = hipLaunchCooperativeKernel((const void*)fwd_kernel, dim3(grid), dim3(NT), args, LDS_BYTES, stream);
  if (e != hipSuccess) fprintf(stderr, "kernel_launch: cooperative launch failed: %s (grid %d)\n", hipGetErrorString(e), grid);
#endif
}
```

```cpp
#include <hip/hip_runtime.h>
#include <hip/hip_cooperative_groups.h>
#include <cstdio>
namespace cg = cooperative_groups;

typedef unsigned short u16;
typedef __attribute__((ext_vector_type(8))) short bf16x8;
typedef __attribute__((ext_vector_type(16))) float f32x16;
typedef __attribute__((ext_vector_type(4))) unsigned u32x4;
typedef __attribute__((ext_vector_type(2))) unsigned u32x2;
#define DI __device__ __forceinline__
#define MFMA(a, b, c) __builtin_amdgcn_mfma_f32_32x32x16_bf16((a), (b), (c), 0, 0, 0)

#ifndef MULTI_LAUNCH
#define MULTI_LAUNCH 0
#endif

constexpr int D = 1024, NBATCH = 2, L = 16384, LC = 256, TB = L + LC, R = NBATCH * TB;
constexpr int NIN = 7968;
constexpr int NP = 2208;
constexpr int NCH = 2688;
constexpr int PC_GQ = 0, PC_GK = 256, PC_GZ = 512, PC_AF = 1024, PC_AQ = 1056, PC_AK = 1568, PC_AZ = 1696;
constexpr int CH_YU = 0, CH_YZ = 1536, CH_GV = 2048, CH_AV = 2560;
constexpr int NCK = 260;
constexpr float EPS = 1e-6f;
constexpr int NT = 512;
constexpr int LDT = 72;

constexpr size_t OFF_P = 0;
constexpr size_t OFF_CT = OFF_P + (size_t)R * NP * 2;
constexpr size_t OFF_H = OFF_CT + (size_t)NCH * 2 * TB * 2;
constexpr size_t OFF_FS = OFF_H + (size_t)R * 1024 * 2;
constexpr size_t OFF_WT = OFF_FS + (size_t)256 * 262144;
constexpr size_t WT_IN = (size_t)NIN * 1024 * 2, WT_BR = (size_t)1024 * 512 * 2, WT_OUT = (size_t)1024 * 1024 * 2;
constexpr size_t WT_LAYER = WT_IN + 3 * WT_BR + WT_OUT;
constexpr size_t OFF_H2T = OFF_WT + 2 * WT_LAYER;
constexpr size_t OFF_H2C = OFF_H2T + (size_t)2 * 64 * L * 4;
constexpr size_t OFF_MOD = OFF_H2C + (size_t)2 * 256 * 64 * 4;
constexpr size_t OFF_CTX1 = OFF_MOD + (size_t)2 * 3 * 3072 * 4;
constexpr size_t OFF_GD = OFF_CTX1 + (size_t)512 * 1024 * 4;
constexpr size_t OFF_PK = OFF_GD + (size_t)16 * NCK * 64 * 4;
constexpr int PK_WAF = 0, PK_BAF = 8192, PK_WAB = 8704, PK_BAB = 16896, PK_GN = 17408, PK_QN = 17664, PK_KN = 17792, PK_CW = 17920,
              PK_CB = 27136, PK_SK = 30208, PK_FN = 32256, PK_F3 = 33280, PK_END = 33280 + 262144;
constexpr size_t OFF_BAR = OFF_PK + (size_t)PK_END * 4;
constexpr size_t BAR_BYTES = 50 * 256;
constexpr size_t WS_END = OFF_BAR + 16384;
constexpr int BAR_LDS = 147456 + 256;
constexpr size_t OFF_GS = OFF_CT;
constexpr size_t OFF_Y = OFF_CT;
static_assert((size_t)16 * NCK * 8192 * 2 <= (size_t)1536 * 2 * TB * 2, "alias");
static_assert((size_t)R * 1024 * 2 <= (size_t)1536 * 2 * TB * 2, "alias");

constexpr int LDS_BYTES = 2 * (128 + 384) * 72 * 2 + 512;

struct Params {
  const float *x, *c, *ctx, *c_ctx, *w_ada, *b_ada, *w_in, *wa_f, *ba_f, *wa_b, *ba_b, *gla_norm, *qnorm, *knorm,
      *conv_w, *conv_b, *f1_w, *f1_b, *f1_freq, *f2_w, *f2_b, *f2_freq, *f3_w, *skip, *w_g, *w_a, *w_h, *w_o, *final_norm;
  float* out;
  char* ws;
  long long phase_lo, phase_hi;
};

typedef __attribute__((ext_vector_type(2))) float f32x2v;
typedef __attribute__((ext_vector_type(2))) __bf16 bf16x2v;
DI int my_tid() {
  int t = (int)threadIdx.x;
  asm volatile("" : "+v"(t));
  __builtin_assume(t >= 0 && t < NT);
  return t;
}
DI u16 f2bf(float x) { return __builtin_bit_cast(u16, (__bf16)x); }
DI float bf2f(u16 v) { return __uint_as_float(((unsigned)v) << 16); }
DI unsigned pack2(float a, float b) { f32x2v v = {a, b}; return __builtin_bit_cast(unsigned, __builtin_convertvector(v, bf16x2v)); }
DI float bflo(unsigned u) { return __uint_as_float(u << 16); }
DI float bfhi(unsigned u) { return __uint_as_float(u & 0xffff0000u); }
DI float silu_f(float x) { return x / (1.f + __expf(-x)); }
DI float wave_sum(float v) {
#pragma unroll
  for (int o = 32; o >= 1; o >>= 1) v += __shfl_xor(v, o);
  return v;
}
DI int crow(int reg, int h) { return (reg & 3) + 8 * (reg >> 2) + 4 * h; }
DI f32x16 zero16() { f32x16 z; for (int i = 0; i < 16; ++i) z[i] = 0.f; return z; }
DI bf16x8 pack8(const f32x16& x, int s) {
  u32x4 u;
  u.x = pack2(x[8 * s + 0], x[8 * s + 1]); u.y = pack2(x[8 * s + 2], x[8 * s + 3]);
  u.z = pack2(x[8 * s + 4], x[8 * s + 5]); u.w = pack2(x[8 * s + 6], x[8 * s + 7]);
  return __builtin_bit_cast(bf16x8, u);
}
DI bf16x8 ld2x64(const u16* p0, const u16* p1) {
  u32x2 a = *(const u32x2*)p0, b = *(const u32x2*)p1;
  u32x4 u; u.x = a.x; u.y = a.y; u.z = b.x; u.w = b.y;
  return __builtin_bit_cast(bf16x8, u);
}
DI float2 cmul(float2 a, float2 b) { return make_float2(a.x * b.x - a.y * b.y, a.x * b.y + a.y * b.x); }
DI float2 cadd(float2 a, float2 b) { return make_float2(a.x + b.x, a.y + b.y); }
DI float2 csub(float2 a, float2 b) { return make_float2(a.x - b.x, a.y - b.y); }

DI const float* xrow_in(const Params& p, int layer, int row) {
  int b = row / TB, tk = row - b * TB;
  if (tk < LC) return (layer == 0 ? p.ctx : (const float*)(p.ws + OFF_CTX1)) + (size_t)(b * LC + tk) * D;
  return (layer == 0 ? p.x : (const float*)p.out) + (size_t)(b * L + tk - LC) * D;
}
DI float* xrow_out(const Params& p, int row) {
  int b = row / TB, tk = row - b * TB;
  if (tk < LC) return (float*)(p.ws + OFF_CTX1) + (size_t)(b * LC + tk) * D;
  return p.out + (size_t)(b * L + tk - LC) * D;
}
DI const float* pk(const Params& p, int off) { return (const float*)(p.ws + OFF_PK) + off; }
DI int modvec_of(int row) { int b = row / TB, tk = row - b * TB; return tk < LC ? 2 : b; }

struct ALoadN {
  const u16* A; int lda;
  template <int BM> DI void fetch(u32x4 (&r)[BM / 64], int k0, int tid) const {
#pragma unroll
    for (int i = 0; i < BM / 64; ++i) { const int q = tid + NT * i; const unsigned off = (unsigned)((q >> 3) * lda + (q & 7) * 8); r[i] = *(const u32x4*)(A + off + k0); }
  }
  template <int BM> DI void commit(const u32x4 (&r)[BM / 64], u16* As, int tid) const {
#pragma unroll
    for (int i = 0; i < BM / 64; ++i) { int q = tid + NT * i; *(u32x4*)(As + (q >> 3) * LDT + (q & 7) * 8) = r[i]; }
  }
};
struct ALoadT {
  const u16* A; size_t chs;
  template <int BM> DI void fetch(u32x4 (&r)[BM / 64], int k0, int tid) const {
#pragma unroll
    for (int i = 0; i < 2; ++i) { const int q = tid + NT * i; const unsigned off = (unsigned)((q >> 4) * (int)chs + (q & 15) * 8); r[i] = *(const u32x4*)(A + off + (unsigned)(k0 * (int)chs)); }
  }
  template <int BM> DI void commit(const u32x4 (&r)[BM / 64], u16* As, int tid) const {
#pragma unroll
    for (int i = 0; i < 2; ++i) {
      int q = tid + NT * i; int ch = q >> 4, t0 = (q & 15) * 8;
      unsigned w[4] = {r[i].x, r[i].y, r[i].z, r[i].w};
#pragma unroll
      for (int e = 0; e < 4; ++e) { As[(t0 + 2 * e) * LDT + ch] = (u16)(w[e] & 0xffffu); As[(t0 + 2 * e + 1) * LDT + ch] = (u16)(w[e] >> 16); }
    }
  }
};

template <int BM, int KSU>
DI void gemm_compute(const u16* Ac, const u16* Bc, int wm, int wn, int r, int h, f32x16 (&acc)[BM / 128][2]) {
#pragma unroll KSU
  for (int ks = 0; ks < 4; ++ks) {
    bf16x8 a[BM / 128], b[2];
#pragma unroll
    for (int i = 0; i < BM / 128; ++i) a[i] = *(const bf16x8*)(Ac + (wm * (BM / 4) + i * 32 + r) * LDT + ks * 16 + h * 8);
#pragma unroll
    for (int j = 0; j < 2; ++j) b[j] = *(const bf16x8*)(Bc + (wn * 64 + j * 32 + r) * LDT + ks * 16 + h * 8);
#pragma unroll
    for (int i = 0; i < BM / 128; ++i)
#pragma unroll
      for (int j = 0; j < 2; ++j) acc[i][j] = MFMA(a[i], b[j], acc[i][j]);
  }
}
DI void fetch_b(u32x4 (&rb)[2], const u16* Bt, int ldb, int k0, int tid) {
#pragma unroll
  for (int i = 0; i < 2; ++i) { const int q = tid + NT * i; const unsigned off = (unsigned)((q >> 3) * ldb + (q & 7) * 8); rb[i] = *(const u32x4*)(Bt + off + k0); }
}
DI void commit_b(const u32x4 (&rb)[2], u16* Bs, int tid) {
#pragma unroll
  for (int i = 0; i < 2; ++i) { int q = tid + NT * i; *(u32x4*)(Bs + (q >> 3) * LDT + (q & 7) * 8) = rb[i]; }
}
template <int BM> struct GemmRegs { u32x4 ra0[BM / 64], rb0[2], ra1[BM / 64], rb1[2]; };
#define GFENCE asm volatile("" ::: "memory")
template <int BM, class AL>
DI void gemm_prime(GemmRegs<BM>& g, const AL& al, const u16* __restrict__ Bt, int ldb, char* smem) {
  u16* As0 = (u16*)smem;
  u16* Bs0 = As0 + 2 * BM * LDT;
  const int tid = my_tid();
  al.template fetch<BM>(g.ra0, 0, tid); fetch_b(g.rb0, Bt, ldb, 0, tid); GFENCE;
  al.template fetch<BM>(g.ra1, 64, tid); fetch_b(g.rb1, Bt, ldb, 64, tid); GFENCE;
  __syncthreads();
  al.template commit<BM>(g.ra0, As0, tid); commit_b(g.rb0, Bs0, tid);
  __syncthreads();
  al.template fetch<BM>(g.ra0, 128, tid); fetch_b(g.rb0, Bt, ldb, 128, tid); GFENCE;
}
template <int BM, class AL, int KSU, int K, class ALN>
DI void gemm_run(GemmRegs<BM>& g, const AL& al, const u16* __restrict__ Bt, int ldb, const ALN& aln, const u16* __restrict__ Btn, int ldbn,
                 bool hasnext, char* smem, f32x16 (&acc)[BM / 128][2]) {
  u16* As0 = (u16*)smem;
  u16* As1 = As0 + BM * LDT;
  u16* Bs0 = As0 + 2 * BM * LDT;
  u16* Bs1 = Bs0 + 128 * LDT;
  const int tid = my_tid(), lane = tid & 63, wid = tid >> 6, r = lane & 31, h = lane >> 5;
  const int wm = wid & 3, wn = wid >> 2;
  constexpr int KT = K >> 6;
#pragma unroll
  for (int kt = 0; kt < KT; kt += 2) {
    al.template commit<BM>(g.ra1, As1, tid); commit_b(g.rb1, Bs1, tid);
    GFENCE;
    if (kt + 3 < KT) { al.template fetch<BM>(g.ra1, (kt + 3) * 64, tid); fetch_b(g.rb1, Bt, ldb, (kt + 3) * 64, tid); GFENCE; }
    else if (hasnext) { aln.template fetch<BM>(g.ra1, (kt + 3 - KT) * 64, tid); fetch_b(g.rb1, Btn, ldbn, (kt + 3 - KT) * 64, tid); GFENCE; }
    gemm_compute<BM, KSU>(As0, Bs0, wm, wn, r, h, acc);
    __syncthreads();
    if (kt + 2 < KT) { al.template commit<BM>(g.ra0, As0, tid); commit_b(g.rb0, Bs0, tid); GFENCE; }
    else if (hasnext) { aln.template commit<BM>(g.ra0, As0, tid); commit_b(g.rb0, Bs0, tid); GFENCE; }
    if (kt + 4 < KT) { al.template fetch<BM>(g.ra0, (kt + 4) * 64, tid); fetch_b(g.rb0, Bt, ldb, (kt + 4) * 64, tid); GFENCE; }
    else if (hasnext) { aln.template fetch<BM>(g.ra0, (kt + 4 - KT) * 64, tid); fetch_b(g.rb0, Btn, ldbn, (kt + 4 - KT) * 64, tid); GFENCE; }
    gemm_compute<BM, KSU>(As1, Bs1, wm, wn, r, h, acc);
    __syncthreads();
  }
}

template <int BM, class AL, int KSU = 4, int K = 1024>
DI void gemm_tile(const AL& al, const u16* __restrict__ Bt, int ldb, char* smem, f32x16 (&acc)[BM / 128][2]) {
  GemmRegs<BM> g;
  gemm_prime<BM>(g, al, Bt, ldb, smem);
  gemm_run<BM, AL, KSU, K, AL>(g, al, Bt, ldb, al, Bt, ldb, false, smem, acc);
}

DI void phase0(const Params& p, char* smem) {
  const int tid = my_tid(), lane = tid & 63, wid = tid >> 6, bid = blockIdx.x, nb = gridDim.x;
  float* sm = (float*)smem;
  {
    float* PKW = (float*)(p.ws + OFF_PK);
    const int gt = bid * NT + tid, gn = nb * NT;
#define PKCP(src, off, cnt) for (int i = gt; i < (cnt); i += gn) PKW[(off) + i] = (src)[i];
    PKCP(p.wa_f, PK_WAF, 8192) PKCP(p.ba_f, PK_BAF, 512) PKCP(p.wa_b, PK_WAB, 8192) PKCP(p.ba_b, PK_BAB, 512)
    PKCP(p.gla_norm, PK_GN, 256) PKCP(p.qnorm, PK_QN, 128) PKCP(p.knorm, PK_KN, 128) PKCP(p.conv_w, PK_CW, 9216)
    PKCP(p.conv_b, PK_CB, 3072) PKCP(p.skip, PK_SK, 2048) PKCP(p.final_norm, PK_FN, 1024) PKCP(p.f3_w, PK_F3, 262144)
#undef PKCP
  }
  float* mod = (float*)(p.ws + OFF_MOD);
  for (int task = bid; task < 96; task += nb) {
    const int l = task / 48, cb = task % 48, col = cb * 64 + lane;
    const float* W = p.w_ada + (size_t)l * 1024 * 3072;
    float a0 = 0.f, a1 = 0.f, a2 = 0.f;
#pragma unroll 8
    for (int k = wid * 128; k < wid * 128 + 128; ++k) {
      float wv = W[(size_t)k * 3072 + col];
      a0 += silu_f(p.c[k]) * wv; a1 += silu_f(p.c[1024 + k]) * wv; a2 += silu_f(p.c_ctx[k]) * wv;
    }
    __syncthreads();
    sm[(wid * 3 + 0) * 64 + lane] = a0; sm[(wid * 3 + 1) * 64 + lane] = a1; sm[(wid * 3 + 2) * 64 + lane] = a2;
    __syncthreads();
    if (tid < 192) {
      int v = tid >> 6; float s = p.b_ada[l * 3072 + col];
      for (int w = 0; w < 8; ++w) s += sm[(w * 3 + v) * 64 + lane];
      mod[(l * 3 + v) * 3072 + col] = s;
    }
    __syncthreads();
  }
  for (int it = bid; it < (2 * TB) / 8; it += nb) {
    const int gr = it * 8 + wid, l = gr / TB, rr = gr - l * TB;
    const bool lat = rr < L; const int t = lat ? rr : rr - L; const int Lq = lat ? L : LC;
    float* em = sm + wid * 104; float* h1 = em + 40;
    __syncthreads();
    if (lane < 33) {
      float v;
      if (lane == 0) v = (float)t / (float)(Lq - 1);
      else {
        int bi = (lane - 1) & 15; float fr = 1e-4f + (float)bi * ((15.f - 1e-4f) / 15.f);
        float w = 6.283185307179586f * (float)t / (float)Lq;
        v = (lane <= 16) ? cosf(fr * w) : -sinf(fr * w);
      }
      em[lane] = v;
    }
    __syncthreads();
    {
      float a = p.f1_b[l * 64 + lane];
      for (int e = 0; e < 33; ++e) a += em[e] * p.f1_w[(l * 33 + e) * 64 + lane];
      h1[lane] = sinf(p.f1_freq[l * 64 + lane] * a);
    }
    __syncthreads();
    {
      float a = p.f2_b[l * 64 + lane];
      for (int i = 0; i < 64; ++i) a += h1[i] * p.f2_w[(l * 64 + i) * 64 + lane];
      float v = sinf(p.f2_freq[l * 64 + lane] * a);
      if (lat) ((u16*)(p.ws + OFF_H2T))[((size_t)l * 64 + lane) * L + t] = f2bf(v);
      else ((float*)(p.ws + OFF_H2C))[((size_t)l * 256 + t) * 64 + lane] = v;
    }
  }
  __syncthreads();
  {
    constexpr int T_IN = 16 * 249, T_BR = 8 * 32, T_OUT = 16 * 32, T_LAYER = T_IN + 3 * T_BR + T_OUT;
    auto decode = [&](int task, const float*& src, u16*& dst, int& K, int& N, int& k0, int& n0) {
      const int l = task / T_LAYER; int tt = task - l * T_LAYER;
      char* wt = p.ws + OFF_WT + (size_t)l * WT_LAYER;
      int kt, ntile;
      if (tt < T_IN) { src = p.w_in + (size_t)l * 1024 * NIN; dst = (u16*)wt; K = 1024; N = NIN; kt = tt / 249; ntile = tt % 249; }
      else if (tt < T_IN + 3 * T_BR) {
        tt -= T_IN; const int br = tt / T_BR; tt -= br * T_BR;
        src = (br == 0 ? p.w_g : (br == 1 ? p.w_a : p.w_h)) + (size_t)l * 512 * 1024; dst = (u16*)(wt + WT_IN + br * WT_BR);
        K = 512; N = 1024; kt = tt / 32; ntile = tt % 32;
      } else { tt -= T_IN + 3 * T_BR; src = p.w_o + (size_t)l * 1024 * 1024; dst = (u16*)(wt + WT_IN + 3 * WT_BR); K = 1024; N = 1024; kt = tt / 32; ntile = tt % 32; }
      k0 = kt * 64; n0 = ntile * 32;
    };
    float* tileA = sm;
    float* tileB = sm + 64 * 33;
    for (int task = bid; task < 2 * T_LAYER; task += 2 * nb) {
      const bool hasB = task + nb < 2 * T_LAYER;
      const float *sa, *sb = nullptr; u16 *da, *db = nullptr; int Ka, Na, k0a, n0a, Kb = 0, Nb = 0, k0b = 0, n0b = 0;
      decode(task, sa, da, Ka, Na, k0a, n0a);
      if (hasB) decode(task + nb, sb, db, Kb, Nb, k0b, n0b);
      float va[4], vb[4];
#pragma unroll
      for (int i = 0; i < 4; ++i) { const int kk = (tid >> 5) + 16 * i, nn = tid & 31; va[i] = sa[(size_t)(k0a + kk) * Na + n0a + nn]; vb[i] = hasB ? sb[(size_t)(k0b + kk) * Nb + n0b + nn] : 0.f; }
#pragma unroll
      for (int i = 0; i < 4; ++i) { const int kk = (tid >> 5) + 16 * i, nn = tid & 31; tileA[kk * 33 + nn] = va[i]; tileB[kk * 33 + nn] = vb[i]; }
      __syncthreads();
#pragma unroll
      for (int i = 0; i < 4; ++i) {
        const int nn = (tid >> 6) + 8 * i, kk = tid & 63;
        da[(size_t)(n0a + nn) * Ka + k0a + kk] = f2bf(tileA[kk * 33 + nn]);
        if (hasB) db[(size_t)(n0b + nn) * Kb + k0b + kk] = f2bf(tileB[kk * 33 + nn]);
      }
      __syncthreads();
    }
  }
}

DI void phase_norm(const Params& p, int l) {
  const int tid = my_tid(), lane = tid & 63, wid = tid >> 6;
  const float* mod = (const float*)(p.ws + OFF_MOD);
  u16* H = (u16*)(p.ws + OFF_H);
  for (int row = blockIdx.x * 8 + wid; row < R; row += gridDim.x * 8) {
    const float* src = xrow_in(p, l, row);
    const float* mv = mod + (l * 3 + modvec_of(row)) * 3072;
    float4 xv[4]; float ss = 0.f;
#pragma unroll
    for (int i = 0; i < 4; ++i) { xv[i] = *(const float4*)(src + (i * 64 + lane) * 4); ss += xv[i].x * xv[i].x + xv[i].y * xv[i].y + xv[i].z * xv[i].z + xv[i].w * xv[i].w; }
    ss = wave_sum(ss);
    const float rs = rsqrtf(ss * (1.f / 1024.f) + EPS);
#pragma unroll
    for (int i = 0; i < 4; ++i) {
      const int col = (i * 64 + lane) * 4;
      float4 sh = *(const float4*)(mv + col), sc = *(const float4*)(mv + 1024 + col);
      u32x2 o;
      o.x = pack2(xv[i].x * rs * (1.f + sc.x) + sh.x, xv[i].y * rs * (1.f + sc.y) + sh.y);
      o.y = pack2(xv[i].z * rs * (1.f + sc.z) + sh.z, xv[i].w * rs * (1.f + sc.w) + sh.w);
      *(u32x2*)(H + (size_t)row * 1024 + col) = o;
    }
  }
}

DI void phase_proj(const Params& p, int l, char* smem) {
  const int tid = my_tid(), lane = tid & 63, wid = tid >> 6, r = lane & 31, h = lane >> 5, wm = wid & 3, wn = wid >> 2;
  const u16* H = (const u16*)(p.ws + OFF_H);
  const u16* WT = (const u16*)(p.ws + OFF_WT + (size_t)l * WT_LAYER);
  u16* P = (u16*)(p.ws + OFF_P);
  u16* CT = (u16*)(p.ws + OFF_CT);
  u16* Tt = (u16*)smem;
  constexpr int LDE = 260;
  const int xcd = blockIdx.x & 7, nloc = gridDim.x >> 3, local = blockIdx.x >> 3;
  const int nreg = local < 624 ? (624 - local + nloc - 1) / nloc : 0;
  const int r0 = 624 % nloc;
  const int nlight = (r0 == 0 ? nloc : nloc - r0) * 8;
  const int eb = (r0 == 0 ? local : local - r0) * 8 + xcd;
  const int nextra = (eb >= 0 && eb < 78) ? (78 - eb + nlight - 1) / nlight : 0;
  for (int it = 0; it < nreg + nextra; ++it) {
    int mt, nt;
    if (it < nreg) { const int q = local + nloc * it, g = q / 156, rem = q - g * 156; nt = rem >> 2; mt = (g * 4 + (rem & 3)) * 8 + xcd; }
    else { const int e = eb + (it - nreg) * nlight; mt = 128 + e / 39; nt = e % 39; }
    const int m0 = mt * 256, n0 = nt * 128;
    f32x16 acc[2][2];
#pragma unroll
    for (int i = 0; i < 2; ++i) for (int j = 0; j < 2; ++j) acc[i][j] = zero16();
    ALoadN al{H + (size_t)m0 * 1024, 1024};
    gemm_tile<256, ALoadN, 4, 1024>(al, WT + (size_t)n0 * 1024, 1024, smem, acc);
    const int b = m0 / TB, tk0 = m0 - b * TB;
#pragma unroll
    for (int i = 0; i < 2; ++i)
#pragma unroll
      for (int j = 0; j < 2; ++j)
#pragma unroll
        for (int g4 = 0; g4 < 4; ++g4) {
          u32x2 o; o.x = pack2(acc[i][j][4 * g4], acc[i][j][4 * g4 + 1]); o.y = pack2(acc[i][j][4 * g4 + 2], acc[i][j][4 * g4 + 3]);
          *(u32x2*)(Tt + (wn * 64 + j * 32 + r) * LDE + wm * 64 + i * 32 + 8 * g4 + 4 * h) = o;
        }
    __syncthreads();
#pragma unroll 1
    for (int cg = 0; cg < 4; ++cg) {
      const int cb = n0 + cg * 32;
      if (cb >= 4896) continue;
      bool chan; int cm;
      if (cb < 512) { chan = false; cm = cb; }
      else if (cb < 1024) { chan = true; cm = CH_GV + cb - 512; }
      else if (cb < 2208) { chan = false; cm = cb - 512; }
      else if (cb < 2336) { chan = true; cm = CH_AV + cb - 2208; }
      else if (cb < 2848) { chan = false; cm = cb - 640; }
      else { chan = true; cm = cb - 2848; }
      if (chan) {
#pragma unroll
        for (int k = 0; k < 2; ++k) {
          const int idx = tid + NT * k, ch = idx >> 5, t8 = idx & 31;
          const u16* sp = Tt + (cg * 32 + ch) * LDE + t8 * 8;
          const u32x2 lo = *(const u32x2*)sp, hi = *(const u32x2*)(sp + 4);
          __builtin_nontemporal_store(u32x4{lo.x, lo.y, hi.x, hi.y}, (u32x4*)(CT + ((size_t)(cm + ch) * 2 + b) * TB + tk0 + t8 * 8));
        }
      } else {
#pragma unroll
        for (int k = 0; k < 2; ++k) {
          const int idx = tid + NT * k, row = idx >> 2, c8 = idx & 3;
          const u16* sp = Tt + (cg * 32 + c8 * 8) * LDE + row;
          u32x4 o;
          o.x = (unsigned)sp[0] | ((unsigned)sp[LDE] << 16); o.y = (unsigned)sp[2 * LDE] | ((unsigned)sp[3 * LDE] << 16);
          o.z = (unsigned)sp[4 * LDE] | ((unsigned)sp[5 * LDE] << 16); o.w = (unsigned)sp[6 * LDE] | ((unsigned)sp[7 * LDE] << 16);
          __builtin_nontemporal_store(o, (u32x4*)(P + (size_t)(m0 + row) * NP + cm + c8 * 8));
        }
      }
    }
  }
}

DI void attn_prep(const Params& p, int l, int dry) {
  const int tid = my_tid(), lane = tid & 63, wid = tid >> 6;
  u16* P = (u16*)(p.ws + OFF_P);
  const float gq = pk(p, PK_QN)[l * 64 + lane], gk = pk(p, PK_KN)[l * 64 + lane];
  for (int row = blockIdx.x * 8 + wid; row < R; row += gridDim.x * 8) {
    u16* Pr = P + (size_t)row * NP;
    const int b = row / TB, tk = row - b * TB;
    float cs = 1.f, sn = 0.f;
    if (tk >= LC) {
      const int t = tk - LC, pi = lane >> 1;
      const float pos = (pi < 16) ? (float)(t >> 6) : (float)(t & 63);
      const float inv = powf(10000.f, -(float)(2 * (pi & 15)) / 32.f);
      sincosf(pos * inv, &sn, &cs);
    }
#pragma unroll
    for (int hd = 0; hd < 10; ++hd) {
      const int col = (hd < 8) ? PC_AQ + hd * 64 + lane : PC_AK + (hd - 8) * 64 + lane;
      float v = bf2f(Pr[col]);
      const float ss = wave_sum(v * v);
      v = v * rsqrtf(ss * (1.f / 64.f) + EPS) * (hd < 8 ? gq : gk);
      const float pv = __shfl_xor(v, 1);
      float o = (lane & 1) ? (pv * sn + v * cs) : (v * cs - pv * sn);
      if (hd < 8) o *= 0.125f * 1.4426950408889634f;
      if (!dry) Pr[col] = f2bf(o);
    }
  }
}

DI void fft_pass4_fwd(float2* X, int tid, int h2) {
  const float inv4 = 0.25f / (float)h2;
#pragma unroll 2
  for (int i = 0; i < 8; ++i) {
    const int g = tid + NT * i, jp = g & (h2 - 1), base = ((g - jp) << 2) + jp;
    float2 e0 = X[base], e1 = X[base + h2], e2 = X[base + 2 * h2], e3 = X[base + 3 * h2];
    const float fr = (float)jp * inv4;
    const float2 T1 = make_float2(__builtin_amdgcn_cosf(fr), -__builtin_amdgcn_sinf(fr));
    const float2 T2 = cmul(T1, T1);
    float2 a0 = cadd(e0, e2), a2 = cmul(csub(e0, e2), T1);
    float2 a1 = cadd(e1, e3), d13 = cmul(csub(e1, e3), T1);
    float2 a3 = make_float2(d13.y, -d13.x);
    X[base] = cadd(a0, a1); X[base + h2] = cmul(csub(a0, a1), T2);
    X[base + 2 * h2] = cadd(a2, a3); X[base + 3 * h2] = cmul(csub(a2, a3), T2);
  }
  __syncthreads();
}
DI void fft_pass4_inv(float2* X, int tid, int h1) {
  const float inv4 = 0.25f / (float)h1;
#pragma unroll 2
  for (int i = 0; i < 8; ++i) {
    const int g = tid + NT * i, jp = g & (h1 - 1), base = ((g - jp) << 2) + jp;
    float2 e0 = X[base], e1 = X[base + h1], e2 = X[base + 2 * h1], e3 = X[base + 3 * h1];
    const float fr = (float)jp * inv4;
    const float2 V = make_float2(__builtin_amdgcn_cosf(fr), __builtin_amdgcn_sinf(fr));
    const float2 Wc = cmul(V, V);
    float2 t1 = cmul(e1, Wc), t3 = cmul(e3, Wc);
    float2 a0 = cadd(e0, t1), a1 = csub(e0, t1), a2 = cadd(e2, t3), a3 = csub(e2, t3);
    float2 u2 = cmul(a2, V), u3 = cmul(a3, V);
    u3 = make_float2(-u3.y, u3.x);
    X[base] = cadd(a0, u2); X[base + 2 * h1] = csub(a0, u2);
    X[base + h1] = cadd(a1, u3); X[base + 3 * h1] = csub(a1, u3);
  }
  __syncthreads();
}
DI constexpr float r16c(int k) { return k == 0 ? 1.f : k == 1 ? 0.9238795325112867f : k == 2 ? 0.7071067811865476f : k == 3 ? 0.3826834323650898f : k == 4 ? 0.f : k == 5 ? -0.3826834323650898f : k == 6 ? -0.7071067811865476f : -0.9238795325112867f; }
DI constexpr float r16s(int k) { return k == 0 ? 0.f : k == 1 ? 0.3826834323650898f : k == 2 ? 0.7071067811865476f : k == 3 ? 0.9238795325112867f : k == 4 ? 1.f : k == 5 ? 0.9238795325112867f : k == 6 ? 0.7071067811865476f : 0.3826834323650898f; }
template <bool INV>
DI void fft_pass16(float2* X, int tid, int q) {
  const float invq = 1.f / (16.f * (float)q);
#pragma unroll
  for (int it = 0; it < 2; ++it) {
    const int g = tid + NT * it, jp = g & (q - 1), base = ((g - jp) << 4) + jp;
    float vx[16], vy[16];
#pragma unroll
    for (int r = 0; r < 16; ++r) { const float2 e = X[base + r * q]; vx[r] = e.x; vy[r] = e.y; }
    const float th = (float)jp * invq;
    float bx[4], by[4];
    bx[0] = __builtin_amdgcn_cosf(th); by[0] = INV ? __builtin_amdgcn_sinf(th) : -__builtin_amdgcn_sinf(th);
#pragma unroll
    for (int s = 1; s < 4; ++s) { bx[s] = bx[s - 1] * bx[s - 1] - by[s - 1] * by[s - 1]; by[s] = 2.f * bx[s - 1] * by[s - 1]; }
#pragma unroll
    for (int ss = 0; ss < 4; ++ss) {
      const int s = INV ? 3 - ss : ss;
      const int rs = 8 >> s;
#pragma unroll
      for (int bf = 0; bf < 8; ++bf) {
        const int r = ((bf & ~(rs - 1)) << 1) | (bf & (rs - 1));
        const int k = (r & (rs - 1)) * (8 / rs);
        const float cc = r16c(k), cs = INV ? r16s(k) : -r16s(k);
        const float tx = bx[s] * cc - by[s] * cs, ty = bx[s] * cs + by[s] * cc;
        const float ax = vx[r], ay = vy[r], cx = vx[r + rs], cy = vy[r + rs];
        if (!INV) {
          const float dx = ax - cx, dy = ay - cy;
          vx[r] = ax + cx; vy[r] = ay + cy;
          vx[r + rs] = dx * tx - dy * ty; vy[r + rs] = dx * ty + dy * tx;
        } else {
          const float ux = cx * tx - cy * ty, uy = cx * ty + cy * tx;
          vx[r] = ax + ux; vy[r] = ay + uy;
          vx[r + rs] = ax - ux; vy[r + rs] = ay - uy;
        }
      }
    }
#pragma unroll
    for (int r = 0; r < 16; ++r) X[base + r * q] = make_float2(vx[r], vy[r]);
  }
  __syncthreads();
}
DI void fft_fwd(float2* X, int tid) {
#pragma unroll 1
  for (int q = 1024; q >= 4; q >>= 4) fft_pass16<false>(X, tid, q);
  fft_pass4_fwd(X, tid, 1);
}
DI void fft_inv(float2* X, int tid) {
  fft_pass4_inv(X, tid, 1);
#pragma unroll 1
  for (int q = 4; q <= 1024; q <<= 4) fft_pass16<true>(X, tid, q);
}
DI float sconv_at(const u16* src, int t, int len, float w0, float w1, float w2, float bb) {
  float ym = t > 0 ? bf2f(src[t - 1]) : 0.f, y0 = bf2f(src[t]), yp = t < len - 1 ? bf2f(src[t + 1]) : 0.f;
  return bb + w0 * ym + w1 * y0 + w2 * yp;
}
DI float hy_delta(int col) {
  const float A0 = -4.605170185988091f / 0.3f, A1 = -4.605170185988091f / 1.5f;
  return fabsf(A0 + (A1 - A0) * ((float)col / 2047.f));
}

DI void hyena_latent_task(const Params& p, int l, int c, char* smem, int dry) {
  float2* X = (float2*)smem;
  float* red = (float*)(smem + 131072);
  const int tid = my_tid(), lane = tid & 63, wid = tid >> 6;
  u16* CT = (u16*)(p.ws + OFF_CT);
  float2* FE = (float2*)(p.ws + OFF_FS + (size_t)blockIdx.x * 262144);
  float2* FO = FE + 16384;
  const unsigned* h2T = (const unsigned*)(p.ws + OFF_H2T) + (size_t)l * 64 * (L / 2);
  const float* f3w = pk(p, PK_F3) + (size_t)l * 64 * 2048;
  const float* cw = pk(p, PK_CW) + (size_t)l * 3 * 1536;
  const float* cbv = pk(p, PK_CB) + (size_t)l * 1536;
  const float vw0 = cw[c], vw1 = cw[1536 + c], vw2 = cw[3072 + c], vbb = cbv[c];
  const u16* v0 = CT + ((size_t)(CH_YU + c) * 2 + 0) * TB + LC;
  const u16* v1 = CT + ((size_t)(CH_YU + c) * 2 + 1) * TB + LC;
  u16* z10 = CT + ((size_t)(CH_YU + 512 + c) * 2 + 0) * TB + LC;
  u16* z11 = CT + ((size_t)(CH_YU + 512 + c) * 2 + 1) * TB + LC;
#pragma unroll 1
  for (int o = 0; o < 2; ++o) {
    const int cf = o * 1024 + c, cbk = cf + 512;
    float sf = 0.f, sb = 0.f;
    __syncthreads();
#ifdef PROBE_FFT
    fft_fwd(X, tid); fft_inv(X, tid);
#endif
#pragma unroll 1
    for (int half = 0; half < 2; ++half) {
      float af[16], ab[16];
#pragma unroll
      for (int i = 0; i < 16; ++i) { af[i] = 0.f; ab[i] = 0.f; }
#pragma unroll 1
      for (int j = 0; j < 64; j += 2) {
        const float wf0 = f3w[j * 2048 + cf], wb0 = f3w[j * 2048 + cbk], wf1 = f3w[(j + 1) * 2048 + cf], wb1 = f3w[(j + 1) * 2048 + cbk];
        const unsigned* hrow = h2T + (size_t)j * (L / 2) + tid + half * 8 * NT;
        unsigned w0[8], w1[8];
#pragma unroll
        for (int i = 0; i < 8; ++i) { w0[i] = hrow[NT * i]; w1[i] = hrow[L / 2 + NT * i]; }
#pragma unroll
        for (int i = 0; i < 8; ++i) {
          const float a0 = bflo(w0[i]), a1 = bfhi(w0[i]), b0 = bflo(w1[i]), b1 = bfhi(w1[i]);
          af[2 * i] += a0 * wf0 + b0 * wf1; af[2 * i + 1] += a1 * wf0 + b1 * wf1;
          ab[2 * i] += a0 * wb0 + b0 * wb1; ab[2 * i + 1] += a1 * wb0 + b1 * wb1;
        }
      }
      const float df = hy_delta(cf), db = hy_delta(cbk);
#pragma unroll
      for (int i = 0; i < 16; ++i) {
        const int t = 2 * (tid + NT * ((i >> 1) + half * 8)) + (i & 1); const float tt = (float)t / (float)(L - 1);
        const float vf = af[i] * (__expf(-tt * df) + 0.05f), vb = ab[i] * (__expf(-tt * db) + 0.05f);
        sf += fabsf(vf); sb += fabsf(vb);
        X[t].x = vf;
        if (t >= 1) X[L - t].y = vb; else X[0].y = 0.f;
      }
    }
    sf = wave_sum(sf); sb = wave_sum(sb);
    if (lane == 0) { red[wid] = sf; red[8 + wid] = sb; }
    __syncthreads();
    float nf = 0.f, nbk = 0.f;
#pragma unroll
    for (int w = 0; w < 8; ++w) { nf += red[w]; nbk += red[8 + w]; }
    const float inv_f = 1.f / nf, inv_b = 1.f / nbk;
#pragma unroll 8
    for (int i = 0; i < 32; ++i) { const int n = tid + NT * i; const float2 s = X[n]; FO[n] = s; X[n] = make_float2(s.x * inv_f + s.y * inv_b, 0.f); }
    __syncthreads();
    fft_fwd(X, tid);
#pragma unroll 8
    for (int i = 0; i < 32; ++i) { const int n = tid + NT * i; FE[n] = X[n]; }
    __syncthreads();
#pragma unroll 8
    for (int i = 0; i < 32; ++i) {
      const int n = tid + NT * i; const float2 s = FO[n]; const float dd = s.x * inv_f - s.y * inv_b; const float fr = (float)n * (1.f / 32768.f);
      X[n] = make_float2(dd * __builtin_amdgcn_cosf(fr), -dd * __builtin_amdgcn_sinf(fr));
    }
    __syncthreads();
    fft_fwd(X, tid);
#pragma unroll 8
    for (int i = 0; i < 32; ++i) { const int n = tid + NT * i; FO[n] = X[n]; }
    __syncthreads();
#pragma unroll 8
    for (int i = 0; i < 32; ++i) {
      const int n = tid + NT * i;
      float2 zz;
      if (o == 0) { zz.x = sconv_at(v0, n, L, vw0, vw1, vw2, vbb); zz.y = sconv_at(v1, n, L, vw0, vw1, vw2, vbb); }
      else { zz.x = bf2f(z10[n]); zz.y = bf2f(z11[n]); }
      X[n] = zz;
    }
    __syncthreads();
    fft_fwd(X, tid);
#pragma unroll 8
    for (int i = 0; i < 32; ++i) { const int n = tid + NT * i; X[n] = cmul(X[n], FE[n]); }
    __syncthreads();
    fft_inv(X, tid);
#pragma unroll 8
    for (int i = 0; i < 32; ++i) { const int n = tid + NT * i; FE[n] = X[n]; }
    __syncthreads();
#pragma unroll 8
    for (int i = 0; i < 32; ++i) {
      const int n = tid + NT * i; const float fr = (float)n * (1.f / 32768.f);
      float2 zz;
      if (o == 0) { zz.x = sconv_at(v0, n, L, vw0, vw1, vw2, vbb); zz.y = sconv_at(v1, n, L, vw0, vw1, vw2, vbb); }
      else { zz.x = bf2f(z10[n]); zz.y = bf2f(z11[n]); }
      X[n] = cmul(zz, make_float2(__builtin_amdgcn_cosf(fr), -__builtin_amdgcn_sinf(fr)));
    }
    __syncthreads();
    fft_fwd(X, tid);
#pragma unroll 8
    for (int i = 0; i < 32; ++i) { const int n = tid + NT * i; X[n] = cmul(X[n], FO[n]); }
    __syncthreads();
    fft_inv(X, tid);
    {
      const int gch = CH_YU + 512 * (o + 1) + c;
      const float w0 = cw[gch], w1 = cw[1536 + gch], w2 = cw[3072 + gch], bb = cbv[gch];
      const u16* s0 = CT + ((size_t)gch * 2 + 0) * TB + LC;
      const u16* s1 = CT + ((size_t)gch * 2 + 1) * TB + LC;
      const float sk = pk(p, PK_SK)[(l * 2 + o) * 512 + c];
#pragma unroll 8
      for (int i = 0; i < 32; ++i) {
        const int n = tid + NT * i; const float fr = (float)n * (1.f / 32768.f);
        const float2 wb = cmul(X[n], make_float2(__builtin_amdgcn_cosf(fr), __builtin_amdgcn_sinf(fr)));
        const float2 A = FE[n];
        const float yr = (A.x + wb.x) * (1.f / 32768.f), yi = (A.y + wb.y) * (1.f / 32768.f);
        const float g0 = sconv_at(s0, n, L, w0, w1, w2, bb), g1 = sconv_at(s1, n, L, w0, w1, w2, bb);
        float2 zz;
        if (o == 0) { zz.x = sconv_at(v0, n, L, vw0, vw1, vw2, vbb); zz.y = sconv_at(v1, n, L, vw0, vw1, vw2, vbb); }
        else { zz.x = bf2f(z10[n]); zz.y = bf2f(z11[n]); }
        X[n] = make_float2(g0 * (yr + sk * zz.x), g1 * (yi + sk * zz.y));
      }
    }
    __syncthreads();
    if (o == 0) {
#pragma unroll 8
      for (int i = 0; i < 32; ++i) { const int n = tid + NT * i; const float2 zz = X[n]; if (!dry) { z10[n] = f2bf(zz.x); z11[n] = f2bf(zz.y); } }
    } else {
      u16* d0 = CT + ((size_t)(CH_YZ + c) * 2 + 0) * TB + LC;
      u16* d1 = CT + ((size_t)(CH_YZ + c) * 2 + 1) * TB + LC;
#pragma unroll 1
      for (int ib = 0; ib < 32; ib += 8) {
        u16 g0[8], g1[8];
#pragma unroll
        for (int i = 0; i < 8; ++i) { const int n = tid + NT * (ib + i); g0[i] = d0[n]; g1[i] = d1[n]; }
#pragma unroll
        for (int i = 0; i < 8; ++i) {
          const int n = tid + NT * (ib + i); const float2 zz = X[n];
          const u16 q0 = f2bf(zz.x * silu_f(bf2f(g0[i]))), q1 = f2bf(zz.y * silu_f(bf2f(g1[i])));
          if (!dry) { d0[n] = q0; d1[n] = q1; }
        }
      }
    }
    __syncthreads();
  }
}

DI void hyena_ctx_task(const Params& p, int l, int c, char* smem, int dry) {
  float* filt = (float*)smem;
  float* zs = filt + 1024;
  float* nrm = zs + 1024;
  const int tid = my_tid(), lane = tid & 63, wid = tid >> 6, t = tid & 255, hb = tid >> 8;
  u16* CT = (u16*)(p.ws + OFF_CT);
  const float* h2c = (const float*)(p.ws + OFF_H2C) + (size_t)l * 256 * 64;
  const float* f3w = pk(p, PK_F3) + (size_t)l * 64 * 2048;
  const float* cw = pk(p, PK_CW) + (size_t)l * 3 * 1536;
  const float* cbv = pk(p, PK_CB) + (size_t)l * 1536;
  __syncthreads();
  {
    const int cf = hb * 1024 + c, cbk = cf + 512;
    float a_f = 0.f, a_b = 0.f;
    for (int j = 0; j < 64; ++j) { const float hv = h2c[t * 64 + j]; a_f += hv * f3w[j * 2048 + cf]; a_b += hv * f3w[j * 2048 + cbk]; }
    const float tt = (float)t / 255.f;
    filt[(hb * 2 + 0) * 256 + t] = a_f * (__expf(-tt * hy_delta(cf)) + 0.05f);
    filt[(hb * 2 + 1) * 256 + t] = a_b * (__expf(-tt * hy_delta(cbk)) + 0.05f);
    const u16* src = CT + ((size_t)(CH_YU + c) * 2 + hb) * TB;
    zs[hb * 256 + t] = sconv_at(src, t, LC, cw[c], cw[1536 + c], cw[3072 + c], cbv[c]);
  }
  __syncthreads();
  if (wid < 4) {
    float s = 0.f;
    for (int k = 0; k < 4; ++k) s += fabsf(filt[wid * 256 + lane + 64 * k]);
    s = wave_sum(s);
    if (lane == 0) nrm[wid] = s;
  }
  __syncthreads();
  const int b = hb;
  for (int o = 0; o < 2; ++o) {
    const float inf_ = 1.f / nrm[o * 2], inb_ = 1.f / nrm[o * 2 + 1];
    const float* hf = filt + (o * 2) * 256; const float* hbk = filt + (o * 2 + 1) * 256;
    const float* zc = zs + (o & 1) * 512 + b * 256;
    float accf = 0.f, accb = 0.f;
    for (int s = 0; s <= t; ++s) accf += hf[t - s] * zc[s];
    for (int s = t + 1; s < 256; ++s) accb += hbk[s - t] * zc[s];
    const int gch = CH_YU + 512 * (o + 1) + c;
    const float gate = sconv_at(CT + ((size_t)gch * 2 + b) * TB, t, LC, cw[gch], cw[1536 + gch], cw[3072 + gch], cbv[gch]);
    const float zn = gate * (accf * inf_ + accb * inb_ + pk(p, PK_SK)[(l * 2 + o) * 512 + c] * zc[t]);
    zs[((o + 1) & 1) * 512 + b * 256 + t] = zn;
    __syncthreads();
  }
  {
    u16* d = CT + ((size_t)(CH_YZ + c) * 2 + b) * TB;
    const u16 q0 = f2bf(zs[b * 256 + t] * silu_f(bf2f(d[t])));
    if (!dry) d[t] = q0;
  }
  __syncthreads();
}

DI void gla_bcum(const Params& p, int l, int row0, int hh, int dir, float* gs, float* segs, float* was, float* as_) {
  const int tid = my_tid();
  const u16* P = (const u16*)(p.ws + OFF_P);
  const float* wa = pk(p, dir ? PK_WAB : PK_WAF) + (size_t)l * 16 * 256 + hh * 64;
  const float* ba = pk(p, dir ? PK_BAB : PK_BAF) + l * 256 + hh * 64;
#pragma unroll
  for (int i = 0; i < 2; ++i) {
    const int idx = tid + NT * i;
    was[idx] = wa[(idx >> 6) * 256 + (idx & 63)];
    as_[(idx >> 4) * 17 + (idx & 15)] = bf2f(P[(size_t)(row0 + (idx >> 4)) * NP + PC_AF + dir * 16 + (idx & 15)]);
  }
  __syncthreads();
  {
    const int t = tid >> 3, d0 = (tid & 7) * 8;
    float lin[8];
#pragma unroll
    for (int e = 0; e < 8; ++e) lin[e] = ba[d0 + e];
#pragma unroll 2
    for (int rr = 0; rr < 16; ++rr) {
      const float av = as_[t * 17 + rr];
      const float4 w0 = *(const float4*)(was + rr * 64 + d0), w1 = *(const float4*)(was + rr * 64 + d0 + 4);
      lin[0] += av * w0.x; lin[1] += av * w0.y; lin[2] += av * w0.z; lin[3] += av * w0.w;
      lin[4] += av * w1.x; lin[5] += av * w1.y; lin[6] += av * w1.z; lin[7] += av * w1.w;
    }
#pragma unroll
    for (int e = 0; e < 8; ++e) gs[t * 65 + d0 + e] = (fminf(lin[e], 0.f) - log1pf(__expf(-fabsf(lin[e])))) * (1.f / 16.f);
  }
  __syncthreads();
  {
    const int d = tid & 63, seg = tid >> 6;
    float v[8]; float run = 0.f;
#pragma unroll
    for (int e = 0; e < 8; ++e) { const int tt = dir ? seg * 8 + 7 - e : seg * 8 + e; run += gs[tt * 65 + d]; v[e] = run; }
    segs[seg * 64 + d] = run;
    __syncthreads();
    float off = 0.f;
#pragma unroll
    for (int s = 0; s < 8; ++s) { const bool before = dir ? (s > seg) : (s < seg); if (before) off += segs[s * 64 + d]; }
#pragma unroll
    for (int e = 0; e < 8; ++e) { const int tt = dir ? seg * 8 + 7 - e : seg * 8 + e; gs[tt * 65 + d] = v[e] + off; }
  }
  __syncthreads();
}
DI int gla_tok0(int dir, int n) {
  if (n < 4) return (dir ? 3 - n : n) * 64;
  return LC + (dir ? 255 - (n - 4) : n - 4) * 64;
}
constexpr int G_GS = 0;
constexpr int G_SEG = G_GS + 64 * 65 * 4;
constexpr int G_QS = G_SEG + 8 * 64 * 4;
constexpr int G_KS = G_QS + 64 * LDT * 2;
constexpr int G_VT = G_KS + 64 * LDT * 2;
constexpr int G_ST = G_VT + 128 * LDT * 2;
constexpr int G_RED = G_ST + 128 * LDT * 2;
constexpr int G_WA = G_RED + 8 * 32 * 4;
constexpr int G_AS = G_WA + 16 * 64 * 4;

DI void gla_g1_task(const Params& p, int l, int chain, int n, char* smem) {
  const int tid = my_tid(), lane = tid & 63, wid = tid >> 6, r = lane & 31, h = lane >> 5;
  const int b = chain >> 3, hh = (chain >> 1) & 3, dir = chain & 1;
  const int tk0 = gla_tok0(dir, n), row0 = b * TB + tk0;
  float* gs = (float*)(smem + G_GS); float* segs = (float*)(smem + G_SEG);
  u16* kT = (u16*)(smem + G_KS); u16* vT = (u16*)(smem + G_VT);
  const u16* P = (const u16*)(p.ws + OFF_P);
  const u16* CT = (const u16*)(p.ws + OFF_CT);
  __syncthreads();
  gla_bcum(p, l, row0, hh, dir, gs, segs, (float*)(smem + G_WA), (float*)(smem + G_AS));
  const int tl = dir ? 0 : 63;
  {
    const int t = tid >> 3, d0 = (tid & 7) * 8;
    const u32x4 kv = *(const u32x4*)(P + (size_t)(row0 + t) * NP + PC_GK + hh * 64 + d0);
    const unsigned w[4] = {kv.x, kv.y, kv.z, kv.w};
#pragma unroll
    for (int e = 0; e < 8; ++e) {
      const float kx = (e & 1) ? bfhi(w[e >> 1]) : bflo(w[e >> 1]);
      kT[(d0 + e) * LDT + t] = f2bf(kx * __expf(gs[tl * 65 + d0 + e] - gs[t * 65 + d0 + e]));
    }
#pragma unroll
    for (int i = 0; i < 2; ++i) {
      const int q = tid + NT * i, v = q >> 3, cc = q & 7;
      *(u32x4*)(vT + v * LDT + cc * 8) = *(const u32x4*)(CT + ((size_t)(CH_GV + hh * 128 + v) * 2 + b) * TB + tk0 + cc * 8);
    }
    if (tid < 64) ((float*)(p.ws + OFF_GD))[((size_t)chain * NCK + n) * 64 + tid] = __expf(gs[tl * 65 + tid]);
  }
  __syncthreads();
  {
    const int vm = wid >> 1, dn = wid & 1;
    f32x16 acc = zero16();
#pragma unroll
    for (int s = 0; s < 4; ++s) {
      const bf16x8 a = *(const bf16x8*)(vT + (vm * 32 + r) * LDT + s * 16 + h * 8);
      const bf16x8 bb = *(const bf16x8*)(kT + (dn * 32 + r) * LDT + s * 16 + h * 8);
      acc = MFMA(a, bb, acc);
    }
    u16* GS = (u16*)(p.ws + OFF_GS) + ((size_t)chain * NCK + n) * 8192;
#pragma unroll
    for (int reg = 0; reg < 16; ++reg) GS[(vm * 32 + crow(reg, h)) * 64 + dn * 32 + r] = f2bf(acc[reg]);
  }
}
DI void gla_g2(const Params& p, int dry) {
  u16* GSb = (u16*)(p.ws + OFF_GS);
  const float* GD = (const float*)(p.ws + OFF_GD);
  for (int gi = blockIdx.x * NT + my_tid(); gi < 16 * 8192; gi += gridDim.x * NT) {
    const int chain = gi >> 13, e = gi & 8191, d = e & 63;
    u16* ptr = GSb + (size_t)chain * NCK * 8192 + e;
    const float* dec = GD + (size_t)chain * NCK * 64 + d;
    float S = 0.f;
#pragma unroll 1
    for (int n0 = 0; n0 < NCK; n0 += 20) {
      float ds[20], a[20];
#pragma unroll
      for (int k = 0; k < 20; ++k) { ds[k] = bf2f(ptr[(size_t)(n0 + k) * 8192]); a[k] = dec[(n0 + k) * 64]; }
#pragma unroll
      for (int k = 0; k < 20; ++k) { if (!dry) ptr[(size_t)(n0 + k) * 8192] = f2bf(S); S = a[k] * S + ds[k]; }
    }
  }
}
DI void gla_g3_task(const Params& p, int l, int b, int hh, int ci, char* smem, int dry) {
  const int tid = my_tid(), lane = tid & 63, wid = tid >> 6, r = lane & 31, h = lane >> 5;
  const int tk0 = ci * 64, row0 = b * TB + tk0;
  float* gs = (float*)(smem + G_GS); float* segs = (float*)(smem + G_SEG); float* red = (float*)(smem + G_RED);
  u16* qs = (u16*)(smem + G_QS); u16* ks = (u16*)(smem + G_KS); u16* vT = (u16*)(smem + G_VT); u16* sT = (u16*)(smem + G_ST);
  u16* P = (u16*)(p.ws + OFF_P);
  const u16* CT = (const u16*)(p.ws + OFF_CT);
  const int vm = wid >> 1, in = wid & 1;
  f32x16 o = zero16();
  __syncthreads();
#pragma unroll 1
  for (int dir = 0; dir < 2; ++dir) {
    gla_bcum(p, l, row0, hh, dir, gs, segs, (float*)(smem + G_WA), (float*)(smem + G_AS));
    const int chain = b * 8 + hh * 2 + dir;
    const int n = dir ? ((ci < 4) ? 3 - ci : 263 - ci) : ci;
    {
      const int t = tid >> 3, d0 = (tid & 7) * 8;
      const u32x4 qv = *(const u32x4*)(P + (size_t)(row0 + t) * NP + PC_GQ + hh * 64 + d0);
      const u32x4 kv = *(const u32x4*)(P + (size_t)(row0 + t) * NP + PC_GK + hh * 64 + d0);
      const unsigned qw[4] = {qv.x, qv.y, qv.z, qv.w}, kw[4] = {kv.x, kv.y, kv.z, kv.w};
      unsigned qo[4], ko[4];
#pragma unroll
      for (int e = 0; e < 4; ++e) {
        const float b0 = gs[t * 65 + d0 + 2 * e], b1 = gs[t * 65 + d0 + 2 * e + 1];
        qo[e] = pack2(bflo(qw[e]) * 0.125f * __expf(b0), bfhi(qw[e]) * 0.125f * __expf(b1));
        ko[e] = pack2(bflo(kw[e]) * __expf(-b0), bfhi(kw[e]) * __expf(-b1));
      }
      *(u32x4*)(qs + t * LDT + d0) = u32x4{qo[0], qo[1], qo[2], qo[3]};
      *(u32x4*)(ks + t * LDT + d0) = u32x4{ko[0], ko[1], ko[2], ko[3]};
      const u16* GS = (const u16*)(p.ws + OFF_GS) + ((size_t)chain * NCK + n) * 8192;
#pragma unroll
      for (int i = 0; i < 2; ++i) {
        const int q = tid + NT * i, v = q >> 3, cc = q & 7;
        *(u32x4*)(sT + v * LDT + cc * 8) = *(const u32x4*)(GS + v * 64 + cc * 8);
        if (dir == 0) *(u32x4*)(vT + v * LDT + cc * 8) = *(const u32x4*)(CT + ((size_t)(CH_GV + hh * 128 + v) * 2 + b) * TB + tk0 + cc * 8);
      }
    }
    __syncthreads();
    bf16x8 qf[4];
#pragma unroll
    for (int s = 0; s < 4; ++s) qf[s] = *(const bf16x8*)(qs + (in * 32 + r) * LDT + s * 16 + h * 8);
#pragma unroll
    for (int jt = 0; jt < 2; ++jt) {
      f32x16 at = zero16();
#pragma unroll
      for (int s = 0; s < 4; ++s) at = MFMA(*(const bf16x8*)(ks + (jt * 32 + r) * LDT + s * 16 + h * 8), qf[s], at);
      const int ii = in * 32 + r;
#pragma unroll
      for (int reg = 0; reg < 16; ++reg) {
        const int jj = jt * 32 + crow(reg, h);
        const bool keep = dir ? (jj >= ii) : (jj <= ii);
        if (!keep) at[reg] = 0.f;
      }
#pragma unroll
      for (int s = 0; s < 2; ++s) {
        const u16* vp = vT + (vm * 32 + r) * LDT + jt * 32 + 16 * s + 4 * h;
        o = MFMA(ld2x64(vp, vp + 8), pack8(at, s), o);
      }
    }
#pragma unroll
    for (int s = 0; s < 4; ++s) o = MFMA(*(const bf16x8*)(sT + (vm * 32 + r) * LDT + s * 16 + h * 8), qf[s], o);
    __syncthreads();
  }
  float ss = 0.f;
#pragma unroll
  for (int reg = 0; reg < 16; ++reg) ss += o[reg] * o[reg];
  ss += __shfl_xor(ss, 32);
  if (h == 0) red[wid * 32 + r] = ss;
  __syncthreads();
  float tot = 0.f;
#pragma unroll
  for (int m = 0; m < 4; ++m) tot += red[(m * 2 + in) * 32 + r];
  const float rs = rsqrtf(tot * (1.f / 128.f) + EPS);
  u16* zp = P + (size_t)(row0 + in * 32 + r) * NP + PC_GZ + hh * 128 + vm * 32 + 4 * h;
  const float* gn = pk(p, PK_GN) + l * 128 + vm * 32 + 4 * h;
#pragma unroll
  for (int g = 0; g < 4; ++g) {
    const u32x2 zz = *(const u32x2*)(zp + 8 * g);
    const float4 gw = *(const float4*)(gn + 8 * g);
    u32x2 out;
    out.x = pack2(o[4 * g] * rs * gw.x * silu_f(bflo(zz.x)), o[4 * g + 1] * rs * gw.y * silu_f(bfhi(zz.x)));
    out.y = pack2(o[4 * g + 2] * rs * gw.z * silu_f(bflo(zz.y)), o[4 * g + 3] * rs * gw.w * silu_f(bfhi(zz.y)));
    if (!dry) *(u32x2*)(zp + 8 * g) = out;
  }
}

DI void attn_item(const Params& p, int l, int b, int g, int qtk0, int ntiles, char* smem, int dry) {
  const int tid = my_tid(), lane = tid & 63, wid = tid >> 6, r = lane & 31, h = lane >> 5;
  u16* P = (u16*)(p.ws + OFF_P);
  const u16* CT = (const u16*)(p.ws + OFF_CT);
  u16* Ks = (u16*)smem;
  u16* Vs = Ks + 2 * 64 * LDT;
  const int hq = g * 4 + (wid >> 1);
  const size_t qrow = (size_t)b * TB + qtk0 + (wid & 1) * 32 + r;
  bf16x8 qf[4];
#pragma unroll
  for (int s = 0; s < 4; ++s) qf[s] = *(const bf16x8*)(P + qrow * NP + PC_AQ + hq * 64 + s * 16 + h * 8);
  f32x16 O[2] = {zero16(), zero16()};
  float m = -1e30f, lsum = 0.f;
  const int lr = tid >> 3, lc = (tid & 7) * 8;
  const u16* kg = P + ((size_t)b * TB + lr) * NP + PC_AK + g * 64 + lc;
  const u16* vg = CT + ((size_t)(CH_AV + g * 64 + lr) * 2 + b) * TB + lc;
  u32x4 rk = *(const u32x4*)kg, rv = *(const u32x4*)vg;
  __syncthreads();
  *(u32x4*)(Ks + lr * LDT + lc) = rk; *(u32x4*)(Vs + lr * LDT + lc) = rv;
  __syncthreads();
  float gqm = fabsf(pk(p, PK_QN)[l * 64 + lane]), gkm = fabsf(pk(p, PK_KN)[l * 64 + lane]);
#pragma unroll
  for (int o = 32; o >= 1; o >>= 1) { gqm = fmaxf(gqm, __shfl_xor(gqm, o)); gkm = fmaxf(gkm, __shfl_xor(gkm, o)); }
  const float mshift = 8.2f * 1.4426950408889634f * gqm * gkm;
  if (mshift <= 60.f) {
    f32x16 sinit;
#pragma unroll
    for (int i = 0; i < 16; ++i) sinit[i] = -mshift;
#pragma unroll 1
    for (int kt = 0; kt < ntiles; ++kt) {
      const int cur = kt & 1;
      if (kt + 1 < ntiles) { rk = *(const u32x4*)(kg + (size_t)(kt + 1) * 64 * NP); rv = *(const u32x4*)(vg + (kt + 1) * 64); }
      const u16* Kc = Ks + cur * 64 * LDT; const u16* Vc = Vs + cur * 64 * LDT;
      f32x16 st[2];
#pragma unroll
      for (int kk = 0; kk < 2; ++kk) {
        st[kk] = sinit;
#pragma unroll
        for (int s = 0; s < 4; ++s) st[kk] = MFMA(*(const bf16x8*)(Kc + (kk * 32 + r) * LDT + s * 16 + h * 8), qf[s], st[kk]);
      }
#pragma unroll
      for (int kk = 0; kk < 2; ++kk)
#pragma unroll
        for (int i = 0; i < 16; ++i) { const float pv = __builtin_amdgcn_exp2f(st[kk][i]); st[kk][i] = pv; lsum += pv; }
#pragma unroll
      for (int kk = 0; kk < 2; ++kk)
#pragma unroll
        for (int s = 0; s < 2; ++s) {
          const bf16x8 pb = pack8(st[kk], s);
#pragma unroll
          for (int mt = 0; mt < 2; ++mt) {
            const u16* vp = Vc + (mt * 32 + r) * LDT + kk * 32 + 16 * s + 4 * h;
            O[mt] = MFMA(ld2x64(vp, vp + 8), pb, O[mt]);
          }
        }
      if (kt + 1 < ntiles) { *(u32x4*)(Ks + (cur ^ 1) * 64 * LDT + lr * LDT + lc) = rk; *(u32x4*)(Vs + (cur ^ 1) * 64 * LDT + lr * LDT + lc) = rv; }
      __syncthreads();
    }
  } else {
#pragma unroll 1
    for (int kt = 0; kt < ntiles; ++kt) {
      const int cur = kt & 1;
      if (kt + 1 < ntiles) { rk = *(const u32x4*)(kg + (size_t)(kt + 1) * 64 * NP); rv = *(const u32x4*)(vg + (kt + 1) * 64); }
      const u16* Kc = Ks + cur * 64 * LDT; const u16* Vc = Vs + cur * 64 * LDT;
      f32x16 st[2];
#pragma unroll
      for (int kk = 0; kk < 2; ++kk) {
        st[kk] = zero16();
#pragma unroll
        for (int s = 0; s < 4; ++s) st[kk] = MFMA(*(const bf16x8*)(Kc + (kk * 32 + r) * LDT + s * 16 + h * 8), qf[s], st[kk]);
      }
      float mx = st[0][0];
#pragma unroll
      for (int i = 0; i < 16; ++i) { mx = fmaxf(mx, st[0][i]); mx = fmaxf(mx, st[1][i]); }
      mx = fmaxf(mx, __shfl_xor(mx, 32));
      const float mn = fmaxf(m, mx);
      const float alpha = exp2f(m - mn);
      m = mn;
      float rsum = 0.f;
#pragma unroll
      for (int kk = 0; kk < 2; ++kk)
#pragma unroll
        for (int i = 0; i < 16; ++i) { const float pv = exp2f(st[kk][i] - mn); st[kk][i] = pv; rsum += pv; }
      lsum = lsum * alpha + rsum;
#pragma unroll
      for (int mt = 0; mt < 2; ++mt)
#pragma unroll
        for (int i = 0; i < 16; ++i) O[mt][i] *= alpha;
#pragma unroll
      for (int kk = 0; kk < 2; ++kk)
#pragma unroll
        for (int s = 0; s < 2; ++s) {
          const bf16x8 pb = pack8(st[kk], s);
#pragma unroll
          for (int mt = 0; mt < 2; ++mt) {
            const u16* vp = Vc + (mt * 32 + r) * LDT + kk * 32 + 16 * s + 4 * h;
            O[mt] = MFMA(ld2x64(vp, vp + 8), pb, O[mt]);
          }
        }
      if (kt + 1 < ntiles) { *(u32x4*)(Ks + (cur ^ 1) * 64 * LDT + lr * LDT + lc) = rk; *(u32x4*)(Vs + (cur ^ 1) * 64 * LDT + lr * LDT + lc) = rv; }
      __syncthreads();
    }
  }
  lsum += __shfl_xor(lsum, 32);
  const float inv = 1.f / lsum;
  u16* op = P + qrow * NP + PC_AQ + hq * 64 + 4 * h;
  const u16* zp = P + qrow * NP + PC_AZ + hq * 64 + 4 * h;
#pragma unroll
  for (int mt = 0; mt < 2; ++mt)
#pragma unroll
    for (int gg = 0; gg < 4; ++gg) {
      const u32x2 zz = *(const u32x2*)(zp + mt * 32 + 8 * gg);
      u32x2 out;
      out.x = pack2(O[mt][4 * gg] * inv * silu_f(bflo(zz.x)), O[mt][4 * gg + 1] * inv * silu_f(bfhi(zz.x)));
      out.y = pack2(O[mt][4 * gg + 2] * inv * silu_f(bflo(zz.y)), O[mt][4 * gg + 3] * inv * silu_f(bfhi(zz.y)));
      if (!dry) *(u32x2*)(op + mt * 32 + 8 * gg) = out;
    }
}

template <int KSU>
DI void gemm_gate3(const u16* __restrict__ A, const u16* __restrict__ WM, char* smem, f32x16 (&acc)[3][2]) {
  u16* As0 = (u16*)smem;
  u16* As1 = As0 + 128 * LDT;
  u16* Bs0 = As0 + 2 * 128 * LDT;
  u16* Bs1 = Bs0 + 384 * LDT;
  const int tid = my_tid(), lane = tid & 63, wid = tid >> 6, r = lane & 31, h = lane >> 5, wm = wid & 3, wn = wid >> 2;
  u32x4 ra0[2], rb0[6], ra1[2], rb1[6];
  auto fetch = [&](u32x4 (&ra)[2], u32x4 (&rb)[6], int k0) {
#pragma unroll
    for (int i = 0; i < 2; ++i) { const int q = tid + NT * i; const unsigned off = (unsigned)((q >> 3) * 1024 + (q & 7) * 8); ra[i] = *(const u32x4*)(A + off + k0); }
#pragma unroll
    for (int i = 0; i < 6; ++i) {
      const int q = tid + NT * i, row = q >> 3;
      const unsigned off = (unsigned)((row >> 7) * (1024 * 1024) + (row & 127) * 1024 + (q & 7) * 8);
      rb[i] = *(const u32x4*)(WM + off + k0);
    }
    GFENCE;
  };
  auto commit = [&](const u32x4 (&ra)[2], const u32x4 (&rb)[6], u16* As, u16* Bs) {
#pragma unroll
    for (int i = 0; i < 2; ++i) { const int q = tid + NT * i; *(u32x4*)(As + (q >> 3) * LDT + (q & 7) * 8) = ra[i]; }
#pragma unroll
    for (int i = 0; i < 6; ++i) { const int q = tid + NT * i; *(u32x4*)(Bs + (q >> 3) * LDT + (q & 7) * 8) = rb[i]; }
    GFENCE;
  };
  auto compute = [&](const u16* Ac, const u16* Bc) {
#pragma unroll KSU
    for (int ks = 0; ks < 4; ++ks) {
      const bf16x8 a = *(const bf16x8*)(Ac + (wm * 32 + r) * LDT + ks * 16 + h * 8);
#pragma unroll
      for (int br = 0; br < 3; ++br)
#pragma unroll
        for (int j = 0; j < 2; ++j)
          acc[br][j] = MFMA(a, *(const bf16x8*)(Bc + (br * 128 + wn * 64 + j * 32 + r) * LDT + ks * 16 + h * 8), acc[br][j]);
    }
  };
  constexpr int KT = 16;
  fetch(ra0, rb0, 0);
  fetch(ra1, rb1, 64);
  __syncthreads();
  commit(ra0, rb0, As0, Bs0);
  __syncthreads();
  fetch(ra0, rb0, 128);
#pragma unroll
  for (int kt = 0; kt < KT; kt += 2) {
    commit(ra1, rb1, As1, Bs1);
    if (kt + 3 < KT) fetch(ra1, rb1, (kt + 3) * 64);
    compute(As0, Bs0);
    __syncthreads();
    if (kt + 2 < KT) commit(ra0, rb0, As0, Bs0);
    if (kt + 4 < KT) fetch(ra0, rb0, (kt + 4) * 64);
    compute(As1, Bs1);
    __syncthreads();
  }
}
DI void phase_merge(const Params& p, int l, char* smem) {
  const int tid = my_tid(), lane = tid & 63, wid = tid >> 6, r = lane & 31, h = lane >> 5, wm = wid & 3, wn = wid >> 2;
  const int xcd = blockIdx.x & 7, nloc = gridDim.x >> 3;
  for (int q = blockIdx.x >> 3; q < 33 * 8; q += nloc) {
    const int mt = (q >> 3) * 8 + xcd, nt = q & 7, m0 = mt * 128, n0 = nt * 128;
    if (mt >= 260) continue;
    const int b = m0 / TB, tk0 = m0 - b * TB;
    if (l == 1 && tk0 < LC) continue;
    const u16* H = (const u16*)(p.ws + OFF_H) + (size_t)m0 * 1024;
    const u16* WM = (const u16*)(p.ws + OFF_WT + (size_t)l * WT_LAYER) + (size_t)(4896 + n0) * 1024;
    const u16* WBR = (const u16*)(p.ws + OFF_WT + (size_t)l * WT_LAYER + WT_IN) + (size_t)n0 * 512;
    unsigned gp[3][2][8];
    {
      f32x16 g3[3][2];
#pragma unroll
      for (int br = 0; br < 3; ++br) for (int j = 0; j < 2; ++j) g3[br][j] = zero16();
      gemm_gate3<2>(H, WM, smem, g3);
#pragma unroll
      for (int br = 0; br < 3; ++br)
#pragma unroll
        for (int j = 0; j < 2; ++j)
#pragma unroll
          for (int i = 0; i < 8; ++i)
            gp[br][j][i] = pack2(1.f / (1.f + __expf(-g3[br][j][2 * i])), 1.f / (1.f + __expf(-g3[br][j][2 * i + 1])));
    }
    f32x16 ysum[2] = {zero16(), zero16()};
#pragma unroll
    for (int br = 0; br < 3; ++br) {
      f32x16 ab[1][2] = {{zero16(), zero16()}};
      if (br < 2) {
        ALoadN ay{(const u16*)(p.ws + OFF_P) + (size_t)m0 * NP + (br == 0 ? PC_GZ : PC_AQ), NP};
        gemm_tile<128, ALoadN, 4, 512>(ay, WBR + (size_t)br * 1024 * 512, 512, smem, ab);
      } else {
        ALoadT ay{(const u16*)(p.ws + OFF_CT) + ((size_t)CH_YZ * 2 + b) * TB + tk0, (size_t)2 * TB};
        gemm_tile<128, ALoadT, 4, 512>(ay, WBR + (size_t)2 * 1024 * 512, 512, smem, ab);
      }
#pragma unroll
      for (int j = 0; j < 2; ++j)
#pragma unroll
        for (int i = 0; i < 8; ++i) {
          ysum[j][2 * i] += bflo(gp[br][j][i]) * ab[0][j][2 * i];
          ysum[j][2 * i + 1] += bfhi(gp[br][j][i]) * ab[0][j][2 * i + 1];
        }
    }
    u16* Y = (u16*)(p.ws + OFF_Y) + (size_t)(m0 + wm * 32 + 4 * h) * 1024 + n0 + wn * 64 + r;
#pragma unroll
    for (int j = 0; j < 2; ++j)
#pragma unroll
      for (int reg = 0; reg < 16; ++reg) Y[(size_t)((reg & 3) + 8 * (reg >> 2)) * 1024 + j * 32] = f2bf(ysum[j][reg]);
  }
}

DI void phase_out(const Params& p, int l, char* smem) {
  const int tid = my_tid(), lane = tid & 63, wid = tid >> 6, r = lane & 31, h = lane >> 5, wm = wid & 3, wn = wid >> 2;
  const u16* Yb = (const u16*)(p.ws + OFF_Y);
  const u16* WO = (const u16*)(p.ws + OFF_WT + (size_t)l * WT_LAYER + WT_IN + 3 * WT_BR);
  const float* mod = (const float*)(p.ws + OFF_MOD);
  const int xcd = blockIdx.x & 7, nloc = gridDim.x >> 3;
  auto tile_of = [&](int q, int& m0, int& n0) -> bool {
    const int mt = (q >> 3) * 8 + xcd; m0 = mt * 128; n0 = (q & 7) * 128;
    if (mt >= 260) return false;
    const int b = m0 / TB, tk0 = m0 - b * TB;
    return !(l == 1 && tk0 < LC);
  };
  auto next_q = [&](int q) -> int { int m, n; for (q += nloc; q < 33 * 8; q += nloc) if (tile_of(q, m, n)) return q; return -1; };
  int q = (int)(blockIdx.x >> 3) - nloc; q = next_q(q);
  if (q < 0) return;
  int m0, n0; tile_of(q, m0, n0);
  GemmRegs<128> gr;
  { ALoadN ay{Yb + (size_t)m0 * 1024, 1024}; gemm_prime<128>(gr, ay, WO + (size_t)n0 * 1024, 1024, smem); }
  while (true) {
    const int qn = next_q(q);
    int m0n = 0, n0n = 0; if (qn >= 0) tile_of(qn, m0n, n0n);
    const int b = m0 / TB, tk0 = m0 - b * TB;
    f32x16 acc[1][2] = {{zero16(), zero16()}};
    const ALoadN ay{Yb + (size_t)m0 * 1024, 1024}, ayn{Yb + (size_t)m0n * 1024, 1024};
    gemm_run<128, ALoadN, 4, 1024, ALoadN>(gr, ay, WO + (size_t)n0 * 1024, 1024, ayn, WO + (size_t)n0n * 1024, 1024, qn >= 0, smem, acc);
    const float* gv = mod + (l * 3 + (tk0 < LC ? 2 : b)) * 3072 + 2048;
    const float* xin = xrow_in(p, l, m0);
    float* xout = xrow_out(p, m0);
#pragma unroll
    for (int j = 0; j < 2; ++j) {
      const int col = n0 + wn * 64 + j * 32 + r;
      const float gate = gv[col];
#pragma unroll
      for (int reg = 0; reg < 16; ++reg) {
        const size_t off = (size_t)(wm * 32 + crow(reg, h)) * D + col;
        xout[off] = xin[off] + gate * acc[0][j][reg];
      }
    }
    if (qn < 0) break;
    q = qn; m0 = m0n; n0 = n0n;
  }
}

DI void phase_final(const Params& p) {
  const int tid = my_tid(), lane = tid & 63, wid = tid >> 6;
  for (int row = blockIdx.x * 8 + wid; row < NBATCH * L; row += gridDim.x * 8) {
    float* src = p.out + (size_t)row * D;
    float4 xv[4]; float ss = 0.f;
#pragma unroll
    for (int i = 0; i < 4; ++i) { xv[i] = *(const float4*)(src + (i * 64 + lane) * 4); ss += xv[i].x * xv[i].x + xv[i].y * xv[i].y + xv[i].z * xv[i].z + xv[i].w * xv[i].w; }
    ss = wave_sum(ss);
    const float rs = rsqrtf(ss * (1.f / 1024.f) + EPS);
#pragma unroll
    for (int i = 0; i < 4; ++i) {
      const int col = (i * 64 + lane) * 4;
      const float4 fw = *(const float4*)(pk(p, PK_FN) + col);
      *(float4*)(src + col) = make_float4(xv[i].x * rs * fw.x, xv[i].y * rs * fw.y, xv[i].z * rs * fw.z, xv[i].w * rs * fw.w);
    }
  }
}

DI void run_phase(const Params& p, int ph, char* smem, int dry = 0) {
  const int bid = blockIdx.x, nb = gridDim.x;
  if (ph == 0) { phase0(p, smem); return; }
  if (ph == 17) { phase_final(p); return; }
  const int l = (ph - 1) >> 3, s = (ph - 1) & 7;
  switch (s) {
    case 0: phase_norm(p, l); break;
    case 1: phase_proj(p, l, smem); break;
    case 2: {
      attn_prep(p, l, dry);
      if (l == 0) for (int c = bid; c < 512; c += nb) hyena_ctx_task(p, l, c, smem, dry);
      for (int c = bid; c < 512; c += nb) hyena_latent_task(p, l, c, smem, dry);
    } break;
    case 3: for (int t = bid; t < 16 * NCK; t += nb) gla_g1_task(p, l, t / NCK, t % NCK, smem); break;
    case 4: gla_g2(p, dry); break;
    case 5: {
      for (int it = bid; it < 1024; it += nb) { const int b = it >> 9, g = (it >> 8) & 1, qb = it & 255; attn_item(p, l, b, g, LC + qb * 64, NCK, smem, dry); }
      if (l == 0) for (int it = bid; it < 16; it += nb) { const int b = it >> 3, g = (it >> 2) & 1, qb = it & 3; attn_item(p, l, b, g, qb * 64, 4, smem, dry); }
      const int c0 = (l == 0) ? 0 : 4, per = NCK - c0;
      for (int t = bid; t < 8 * per; t += nb) { const int bh = t / per, ci = c0 + t % per; gla_g3_task(p, l, bh >> 2, bh & 3, ci, smem, dry); }
    } break;
    case 6: phase_merge(p, l, smem); break;
    case 7: phase_out(p, l, smem); break;
  }
}

#if MULTI_LAUNCH
template <int PH> __global__ void __launch_bounds__(NT) phase_kernel(Params p) {
  extern __shared__ __attribute__((aligned(16))) char smem[];
  run_phase(p, PH, smem);
}
template <int PH> static void launch_phase(const Params& p, int grid, hipStream_t stream) {
  static bool attr = false;
  if (!attr) { (void)hipFuncSetAttribute((const void*)phase_kernel<PH>, hipFuncAttributeMaxDynamicSharedMemorySize, LDS_BYTES); attr = true; }
  hipLaunchKernelGGL(phase_kernel<PH>, dim3(grid), dim3(NT), LDS_BYTES, stream, p);
}
#else
DI unsigned xb_ld(unsigned* q) { return __hip_atomic_load(q, __ATOMIC_RELAXED, __HIP_MEMORY_SCOPE_AGENT); }
DI unsigned xb_add(unsigned* q, unsigned v) { return __hip_atomic_fetch_add(q, v, __ATOMIC_RELAXED, __HIP_MEMORY_SCOPE_AGENT); }
DI unsigned xb_xcc_id() { return (unsigned)__builtin_amdgcn_s_getreg((3 << 11) | 20) & 0xFu; }
#define XB_SPIN(cond) do { unsigned sp_ = 0; while ((cond) && ++sp_ < 400000u) __builtin_amdgcn_s_sleep(1); } while (0)
DI void gbar_census(const Params& p) {
  if (threadIdx.x == 0) (void)xb_add((unsigned*)(p.ws + OFF_BAR) + xb_xcc_id() * 64, 1u);
}
DI void gbar_setup(const Params& p, char* smem) {
  if (threadIdx.x == 0) {
    unsigned* bar = (unsigned*)(p.ws + OFF_BAR);
    const unsigned x = xb_xcc_id();
    unsigned mine = 1u, cnt = 0u;
    for (unsigned j = 0; j < 16; ++j) { const unsigned c = xb_ld(bar + j * 64); cnt += (c > 0u) ? 1u : 0u; if (j == x) mine = c; }
    volatile unsigned* st = (volatile unsigned*)(smem + BAR_LDS);
    st[0] = mine > 0u ? mine : 1u; st[1] = cnt > 0u ? cnt : 1u;
  }
  __syncthreads();
}
DI void gbar(const Params& p, unsigned k, char* smem) {
  asm volatile("s_waitcnt vmcnt(0)" ::: "memory");
  __syncthreads();
  if (threadIdx.x == 0) {
    unsigned* bar = (unsigned*)(p.ws + OFF_BAR);
    volatile unsigned* st = (volatile unsigned*)(smem + BAR_LDS);
    const unsigned nloc = st[0], nx = st[1], x = xb_xcc_id();
    __builtin_amdgcn_s_waitcnt(0);
    const unsigned old = xb_add(bar + (16 + x) * 64, 1u);
    if (old + 1u == k * nloc) {
      __builtin_amdgcn_fence(__ATOMIC_RELEASE, "agent");
      asm volatile("s_waitcnt vmcnt(0)" ::: "memory");
      const unsigned og = xb_add(bar + 48 * 64, 1u);
      if (og + 1u == k * nx) xb_add(bar + 49 * 64, 1u);
      else XB_SPIN(xb_ld(bar + 49 * 64) < k);
      __builtin_amdgcn_fence(__ATOMIC_ACQUIRE, "agent");
      xb_add(bar + (32 + x) * 64, 1u);
      asm volatile("s_waitcnt vmcnt(0)" ::: "memory");
    } else {
      XB_SPIN(xb_ld(bar + (32 + x) * 64) < k);
      __builtin_amdgcn_fence(__ATOMIC_ACQUIRE, "agent");
      asm volatile("s_waitcnt vmcnt(0)" ::: "memory");
    }
  }
  __syncthreads();
}
#ifndef PROBE_DUP
#define PROBE_DUP -1
#endif
#ifndef PROBE_DUP2
#define PROBE_DUP2 -1
#endif
#ifndef PROBE_DUP3
#define PROBE_DUP3 -1
#endif
__global__ void __launch_bounds__(NT) fwd_kernel(Params p) {
  extern __shared__ __attribute__((aligned(16))) char smem[];
  cg::grid_group grid = cg::this_grid();
#if PROBE_DUP >= 0
#define PHS(n) if ((n) == PROBE_DUP || (n) == PROBE_DUP2 || (n) == PROBE_DUP3) { run_phase(p, n, smem, p.phase_lo == 0 ? 1 : 0); grid.sync(); } run_phase(p, n, smem); grid.sync();
#else
#define PHS(n) run_phase(p, n, smem); if ((n) == 0) { grid.sync(); gbar_setup(p, smem); } else gbar(p, (unsigned)(n), smem);
#endif
  gbar_census(p);
  PHS(0) PHS(1) PHS(2) PHS(3) PHS(4) PHS(5) PHS(6) PHS(7) PHS(8)
  PHS(9) PHS(10) PHS(11) PHS(12) PHS(13) PHS(14) PHS(15) PHS(16)
  run_phase(p, 17, smem);
}
#endif

extern "C" void kernel_launch(void* const* d_in, const int* in_sizes, int n_in, void* d_out, int out_size, void* d_ws, size_t ws_size,
                              hipStream_t stream) {
  static int grid = 0;
  if (grid == 0) {
    if (n_in != 29 || ws_size < WS_END) { fprintf(stderr, "kernel_launch: need 29 inputs and %zu B of workspace, got %d / %zu\n", (size_t)WS_END, n_in, ws_size); grid = -1; return; }
#if MULTI_LAUNCH
    grid = 256;
#else
    int dev = 0, cus = 0, per_cu = 0;
    (void)hipGetDevice(&dev);
    (void)hipDeviceGetAttribute(&cus, hipDeviceAttributeMultiprocessorCount, dev);
    if (hipFuncSetAttribute((const void*)fwd_kernel, hipFuncAttributeMaxDynamicSharedMemorySize, LDS_BYTES) != hipSuccess) { fprintf(stderr, "kernel_launch: hipFuncSetAttribute failed\n"); grid = -1; return; }
    (void)hipOccupancyMaxActiveBlocksPerMultiprocessor(&per_cu, (const void*)fwd_kernel, NT, LDS_BYTES);
    if (per_cu < 1) { fprintf(stderr, "kernel_launch: occupancy query returned %d\n", per_cu); per_cu = 1; }
    (void)hipGetLastError();
    grid = cus * per_cu;
    if (grid > 256) grid = 256;
#endif
  }
  if (grid < 0) return;
  Params p{};
  const float** pp = (const float**)&p;
  for (int i = 0; i < 29; ++i) pp[i] = (const float*)d_in[i];
  p.out = (float*)d_out; p.ws = (char*)d_ws;
  p.phase_lo = 0; p.phase_hi = 18;
#if MULTI_LAUNCH
  launch_phase<0>(p, grid, stream); launch_phase<1>(p, grid, stream); launch_phase<2>(p, grid, stream); launch_phase<3>(p, grid, stream);
  launch_phase<4>(p, grid, stream); launch_phase<5>(p, grid, stream); launch_phase<6>(p, grid, stream); launch_phase<7>(p, grid, stream);
  launch_phase<8>(p, grid, stream); launch_phase<9>(p, grid, stream); launch_phase<10>(p, grid, stream); launch_phase<11>(p, grid, stream);
  launch_phase<12>(p, grid, stream); launch_phase<13>(p, grid, stream); launch_phase<14>(p, grid, stream); launch_phase<15>(p, grid, stream);
  launch_phase<16>(p, grid, stream); launch_phase<17>(p, grid, stream);
#else
  if (hipMemsetAsync((char*)d_ws + OFF_BAR, 0, BAR_BYTES, stream) != hipSuccess) { fprintf(stderr, "kernel_launch: barrier memset failed\n"); return; }
  void* args[] = {&p};
  hipError_t e = hipLaunchCooperativeKernel((const void*)fwd_kernel, dim3(grid), dim3(NT), args, LDS_BYTES, stream);
  if (e != hipSuccess) fprintf(stderr, "kernel_launch: cooperative launch failed: %s (grid %d)\n", hipGetErrorString(e), grid);
#endif
}
```

```cpp
#include <hip/hip_runtime.h>
#include <hip/hip_cooperative_groups.h>
#include <cstdio>
namespace cg = cooperative_groups;

typedef unsigned short u16;
typedef __attribute__((ext_vector_type(8))) short bf16x8;
typedef __attribute__((ext_vector_type(16))) float f32x16;
typedef __attribute__((ext_vector_type(4))) unsigned u32x4;
typedef __attribute__((ext_vector_type(2))) unsigned u32x2;
#define DI __device__ __forceinline__
#define MFMA(a, b, c) __builtin_amdgcn_mfma_f32_32x32x16_bf16((a), (b), (c), 0, 0, 0)

#ifndef MULTI_LAUNCH
#define MULTI_LAUNCH 0
#endif

constexpr int D = 1024, NBATCH = 2, L = 16384, LC = 256, TB = L + LC, R = NBATCH * TB;
constexpr int NIN = 7968;
constexpr int NP = 2208;
constexpr int NCH = 2688;
constexpr int PC_GQ = 0, PC_GK = 256, PC_GZ = 512, PC_AF = 1024, PC_AQ = 1056, PC_AK = 1568, PC_AZ = 1696;
constexpr int CH_YU = 0, CH_YZ = 1536, CH_GV = 2048, CH_AV = 2560;
constexpr int NCK = 260;
constexpr float EPS = 1e-6f;
constexpr int NT = 512;
constexpr int LDT = 72;

constexpr size_t OFF_P = 0;
constexpr size_t OFF_CT = OFF_P + (size_t)R * NP * 2;
constexpr size_t OFF_H = OFF_CT + (size_t)NCH * 2 * TB * 2;
constexpr size_t OFF_FS = OFF_H + (size_t)R * 1024 * 2;
constexpr size_t OFF_WT = OFF_FS + (size_t)256 * 262144;
constexpr size_t WT_IN = (size_t)NIN * 1024 * 2, WT_BR = (size_t)1024 * 512 * 2, WT_OUT = (size_t)1024 * 1024 * 2;
constexpr size_t WT_LAYER = WT_IN + 3 * WT_BR + WT_OUT;
constexpr size_t OFF_H2T = OFF_WT + 2 * WT_LAYER;
constexpr size_t OFF_H2C = OFF_H2T + (size_t)2 * 64 * L * 4;
constexpr size_t OFF_MOD = OFF_H2C + (size_t)2 * 256 * 64 * 4;
constexpr size_t OFF_CTX1 = OFF_MOD + (size_t)2 * 3 * 3072 * 4;
constexpr size_t OFF_GD = OFF_CTX1 + (size_t)512 * 1024 * 4;
constexpr size_t OFF_PK = OFF_GD + (size_t)16 * NCK * 64 * 4;
constexpr int PK_WAF = 0, PK_BAF = 8192, PK_WAB = 8704, PK_BAB = 16896, PK_GN = 17408, PK_QN = 17664, PK_KN = 17792, PK_CW = 17920,
              PK_CB = 27136, PK_SK = 30208, PK_FN = 32256, PK_F3 = 33280, PK_END = 33280 + 262144;
constexpr size_t OFF_BAR = OFF_PK + (size_t)PK_END * 4;
constexpr size_t BAR_BYTES = 50 * 256;
constexpr size_t WS_END = OFF_BAR + 16384;
constexpr int BAR_LDS = 147456 + 256;
constexpr size_t OFF_GS = OFF_CT;
constexpr size_t OFF_Y = OFF_CT;
static_assert((size_t)16 * NCK * 8192 * 2 <= (size_t)1536 * 2 * TB * 2, "alias");
static_assert((size_t)R * 1024 * 2 <= (size_t)1536 * 2 * TB * 2, "alias");

constexpr int LDS_BYTES = 2 * (128 + 384) * 72 * 2 + 512;

struct Params {
  const float *x, *c, *ctx, *c_ctx, *w_ada, *b_ada, *w_in, *wa_f, *ba_f, *wa_b, *ba_b, *gla_norm, *qnorm, *knorm,
      *conv_w, *conv_b, *f1_w, *f1_b, *f1_freq, *f2_w, *f2_b, *f2_freq, *f3_w, *skip, *w_g, *w_a, *w_h, *w_o, *final_norm;
  float* out;
  char* ws;
  long long phase_lo, phase_hi;
};

typedef __attribute__((ext_vector_type(2))) float f32x2v;
typedef __attribute__((ext_vector_type(2))) __bf16 bf16x2v;
DI int my_tid() {
  int t = (int)threadIdx.x;
  asm volatile("" : "+v"(t));
  __builtin_assume(t >= 0 && t < NT);
  return t;
}
DI u16 f2bf(float x) { return __builtin_bit_cast(u16, (__bf16)x); }
DI float bf2f(u16 v) { return __uint_as_float(((unsigned)v) << 16); }
DI unsigned pack2(float a, float b) { f32x2v v = {a, b}; return __builtin_bit_cast(unsigned, __builtin_convertvector(v, bf16x2v)); }
DI float bflo(unsigned u) { return __uint_as_float(u << 16); }
DI float bfhi(unsigned u) { return __uint_as_float(u & 0xffff0000u); }
DI float silu_f(float x) { return x / (1.f + __expf(-x)); }
DI float wave_sum(float v) {
#pragma unroll
  for (int o = 32; o >= 1; o >>= 1) v += __shfl_xor(v, o);
  return v;
}
DI int crow(int reg, int h) { return (reg & 3) + 8 * (reg >> 2) + 4 * h; }
DI f32x16 zero16() { f32x16 z; for (int i = 0; i < 16; ++i) z[i] = 0.f; return z; }
DI bf16x8 pack8(const f32x16& x, int s) {
  u32x4 u;
  u.x = pack2(x[8 * s + 0], x[8 * s + 1]); u.y = pack2(x[8 * s + 2], x[8 * s + 3]);
  u.z = pack2(x[8 * s + 4], x[8 * s + 5]); u.w = pack2(x[8 * s + 6], x[8 * s + 7]);
  return __builtin_bit_cast(bf16x8, u);
}
DI bf16x8 ld2x64(const u16* p0, const u16* p1) {
  u32x2 a = *(const u32x2*)p0, b = *(const u32x2*)p1;
  u32x4 u; u.x = a.x; u.y = a.y; u.z = b.x; u.w = b.y;
  return __builtin_bit_cast(bf16x8, u);
}
DI float2 cmul(float2 a, float2 b) { return make_float2(a.x * b.x - a.y * b.y, a.x * b.y + a.y * b.x); }
DI float2 cadd(float2 a, float2 b) { return make_float2(a.x + b.x, a.y + b.y); }
DI float2 csub(float2 a, float2 b) { return make_float2(a.x - b.x, a.y - b.y); }

DI const float* xrow_in(const Params& p, int layer, int row) {
  int b = row / TB, tk = row - b * TB;
  if (tk < LC) return (layer == 0 ? p.ctx : (const float*)(p.ws + OFF_CTX1)) + (size_t)(b * LC + tk) * D;
  return (layer == 0 ? p.x : (const float*)p.out) + (size_t)(b * L + tk - LC) * D;
}
DI float* xrow_out(const Params& p, int row) {
  int b = row / TB, tk = row - b * TB;
  if (tk < LC) return (float*)(p.ws + OFF_CTX1) + (size_t)(b * LC + tk) * D;
  return p.out + (size_t)(b * L + tk - LC) * D;
}
DI const float* pk(const Params& p, int off) { return (const float*)(p.ws + OFF_PK) + off; }
DI int modvec_of(int row) { int b = row / TB, tk = row - b * TB; return tk < LC ? 2 : b; }

struct ALoadN {
  const u16* A; int lda;
  template <int BM> DI void fetch(u32x4 (&r)[BM / 64], int k0, int tid) const {
#pragma unroll
    for (int i = 0; i < BM / 64; ++i) { const int q = tid + NT * i; const unsigned off = (unsigned)((q >> 3) * lda + (q & 7) * 8); r[i] = *(const u32x4*)(A + off + k0); }
  }
  template <int BM> DI void commit(const u32x4 (&r)[BM / 64], u16* As, int tid) const {
#pragma unroll
    for (int i = 0; i < BM / 64; ++i) { int q = tid + NT * i; *(u32x4*)(As + (q >> 3) * LDT + (q & 7) * 8) = r[i]; }
  }
};
struct ALoadT {
  const u16* A; size_t chs;
  template <int BM> DI void fetch(u32x4 (&r)[BM / 64], int k0, int tid) const {
#pragma unroll
    for (int i = 0; i < 2; ++i) { const int q = tid + NT * i; const unsigned off = (unsigned)((q >> 4) * (int)chs + (q & 15) * 8); r[i] = *(const u32x4*)(A + off + (unsigned)(k0 * (int)chs)); }
  }
  template <int BM> DI void commit(const u32x4 (&r)[BM / 64], u16* As, int tid) const {
#pragma unroll
    for (int i = 0; i < 2; ++i) {
      int q = tid + NT * i; int ch = q >> 4, t0 = (q & 15) * 8;
      unsigned w[4] = {r[i].x, r[i].y, r[i].z, r[i].w};
#pragma unroll
      for (int e = 0; e < 4; ++e) { As[(t0 + 2 * e) * LDT + ch] = (u16)(w[e] & 0xffffu); As[(t0 + 2 * e + 1) * LDT + ch] = (u16)(w[e] >> 16); }
    }
  }
};

template <int BM, int KSU>
DI void gemm_compute(const u16* Ac, const u16* Bc, int wm, int wn, int r, int h, f32x16 (&acc)[BM / 128][2]) {
#pragma unroll KSU
  for (int ks = 0; ks < 4; ++ks) {
    bf16x8 a[BM / 128], b[2];
#pragma unroll
    for (int i = 0; i < BM / 128; ++i) a[i] = *(const bf16x8*)(Ac + (wm * (BM / 4) + i * 32 + r) * LDT + ks * 16 + h * 8);
#pragma unroll
    for (int j = 0; j < 2; ++j) b[j] = *(const bf16x8*)(Bc + (wn * 64 + j * 32 + r) * LDT + ks * 16 + h * 8);
#pragma unroll
    for (int i = 0; i < BM / 128; ++i)
#pragma unroll
      for (int j = 0; j < 2; ++j) acc[i][j] = MFMA(a[i], b[j], acc[i][j]);
  }
}
DI void fetch_b(u32x4 (&rb)[2], const u16* Bt, int ldb, int k0, int tid) {
#pragma unroll
  for (int i = 0; i < 2; ++i) { const int q = tid + NT * i; const unsigned off = (unsigned)((q >> 3) * ldb + (q & 7) * 8); rb[i] = *(const u32x4*)(Bt + off + k0); }
}
DI void commit_b(const u32x4 (&rb)[2], u16* Bs, int tid) {
#pragma unroll
  for (int i = 0; i < 2; ++i) { int q = tid + NT * i; *(u32x4*)(Bs + (q >> 3) * LDT + (q & 7) * 8) = rb[i]; }
}
template <int BM> struct GemmRegs { u32x4 ra0[BM / 64], rb0[2], ra1[BM / 64], rb1[2]; };
#define GFENCE asm volatile("" ::: "memory")
template <int BM, class AL>
DI void gemm_prime(GemmRegs<BM>& g, const AL& al, const u16* __restrict__ Bt, int ldb, char* smem) {
  u16* As0 = (u16*)smem;
  u16* Bs0 = As0 + 2 * BM * LDT;
  const int tid = my_tid();
  al.template fetch<BM>(g.ra0, 0, tid); fetch_b(g.rb0, Bt, ldb, 0, tid); GFENCE;
  al.template fetch<BM>(g.ra1, 64, tid); fetch_b(g.rb1, Bt, ldb, 64, tid); GFENCE;
  __syncthreads();
  al.template commit<BM>(g.ra0, As0, tid); commit_b(g.rb0, Bs0, tid);
  __syncthreads();
  al.template fetch<BM>(g.ra0, 128, tid); fetch_b(g.rb0, Bt, ldb, 128, tid); GFENCE;
}
template <int BM, class AL, int KSU, int K, class ALN>
DI void gemm_run(GemmRegs<BM>& g, const AL& al, const u16* __restrict__ Bt, int ldb, const ALN& aln, const u16* __restrict__ Btn, int ldbn,
                 bool hasnext, char* smem, f32x16 (&acc)[BM / 128][2]) {
  u16* As0 = (u16*)smem;
  u16* As1 = As0 + BM * LDT;
  u16* Bs0 = As0 + 2 * BM * LDT;
  u16* Bs1 = Bs0 + 128 * LDT;
  const int tid = my_tid(), lane = tid & 63, wid = tid >> 6, r = lane & 31, h = lane >> 5;
  const int wm = wid & 3, wn = wid >> 2;
  constexpr int KT = K >> 6;
#pragma unroll
  for (int kt = 0; kt < KT; kt += 2) {
    al.template commit<BM>(g.ra1, As1, tid); commit_b(g.rb1, Bs1, tid);
    GFENCE;
    if (kt + 3 < KT) { al.template fetch<BM>(g.ra1, (kt + 3) * 64, tid); fetch_b(g.rb1, Bt, ldb, (kt + 3) * 64, tid); GFENCE; }
    else if (hasnext) { aln.template fetch<BM>(g.ra1, (kt + 3 - KT) * 64, tid); fetch_b(g.rb1, Btn, ldbn, (kt + 3 - KT) * 64, tid); GFENCE; }
    gemm_compute<BM, KSU>(As0, Bs0, wm, wn, r, h, acc);
    __syncthreads();
    if (kt + 2 < KT) { al.template commit<BM>(g.ra0, As0, tid); commit_b(g.rb0, Bs0, tid); GFENCE; }
    else if (hasnext) { aln.template commit<BM>(g.ra0, As0, tid); commit_b(g.rb0, Bs0, tid); GFENCE; }
    if (kt + 4 < KT) { al.template fetch<BM>(g.ra0, (kt + 4) * 64, tid); fetch_b(g.rb0, Bt, ldb, (kt + 4) * 64, tid); GFENCE; }
    else if (hasnext) { aln.template fetch<BM>(g.ra0, (kt + 4 - KT) * 64, tid); fetch_b(g.rb0, Btn, ldbn, (kt + 4 - KT) * 64, tid); GFENCE; }
    gemm_compute<BM, KSU>(As1, Bs1, wm, wn, r, h, acc);
    __syncthreads();
  }
}

template <int BM, class AL, int KSU = 4, int K = 1024>
DI void gemm_tile(const AL& al, const u16* __restrict__ Bt, int ldb, char* smem, f32x16 (&acc)[BM / 128][2]) {
  GemmRegs<BM> g;
  gemm_prime<BM>(g, al, Bt, ldb, smem);
  gemm_run<BM, AL, KSU, K, AL>(g, al, Bt, ldb, al, Bt, ldb, false, smem, acc);
}

DI void phase0(const Params& p, char* smem) {
  const int tid = my_tid(), lane = tid & 63, wid = tid >> 6, bid = blockIdx.x, nb = gridDim.x;
  float* sm = (float*)smem;
  {
    float* PKW = (float*)(p.ws + OFF_PK);
    const int gt = bid * NT + tid, gn = nb * NT;
#define PKCP(src, off, cnt) for (int i = gt; i < (cnt); i += gn) PKW[(off) + i] = (src)[i];
    PKCP(p.wa_f, PK_WAF, 8192) PKCP(p.ba_f, PK_BAF, 512) PKCP(p.wa_b, PK_WAB, 8192) PKCP(p.ba_b, PK_BAB, 512)
    PKCP(p.gla_norm, PK_GN, 256) PKCP(p.qnorm, PK_QN, 128) PKCP(p.knorm, PK_KN, 128) PKCP(p.conv_w, PK_CW, 9216)
    PKCP(p.conv_b, PK_CB, 3072) PKCP(p.skip, PK_SK, 2048) PKCP(p.final_norm, PK_FN, 1024) PKCP(p.f3_w, PK_F3, 262144)
#undef PKCP
  }
  float* mod = (float*)(p.ws + OFF_MOD);
  for (int task = bid; task < 96; task += nb) {
    const int l = task / 48, cb = task % 48, col = cb * 64 + lane;
    const float* W = p.w_ada + (size_t)l * 1024 * 3072;
    float a0 = 0.f, a1 = 0.f, a2 = 0.f;
#pragma unroll 8
    for (int k = wid * 128; k < wid * 128 + 128; ++k) {
      float wv = W[(size_t)k * 3072 + col];
      a0 += silu_f(p.c[k]) * wv; a1 += silu_f(p.c[1024 + k]) * wv; a2 += silu_f(p.c_ctx[k]) * wv;
    }
    __syncthreads();
    sm[(wid * 3 + 0) * 64 + lane] = a0; sm[(wid * 3 + 1) * 64 + lane] = a1; sm[(wid * 3 + 2) * 64 + lane] = a2;
    __syncthreads();
    if (tid < 192) {
      int v = tid >> 6; float s = p.b_ada[l * 3072 + col];
      for (int w = 0; w < 8; ++w) s += sm[(w * 3 + v) * 64 + lane];
      mod[(l * 3 + v) * 3072 + col] = s;
    }
    __syncthreads();
  }
  for (int it = bid; it < (2 * TB) / 8; it += nb) {
    const int gr = it * 8 + wid, l = gr / TB, rr = gr - l * TB;
    const bool lat = rr < L; const int t = lat ? rr : rr - L; const int Lq = lat ? L : LC;
    float* em = sm + wid * 104; float* h1 = em + 40;
    __syncthreads();
    if (lane < 33) {
      float v;
      if (lane == 0) v = (float)t / (float)(Lq - 1);
      else {
        int bi = (lane - 1) & 15; float fr = 1e-4f + (float)bi * ((15.f - 1e-4f) / 15.f);
        float w = 6.283185307179586f * (float)t / (float)Lq;
        v = (lane <= 16) ? cosf(fr * w) : -sinf(fr * w);
      }
      em[lane] = v;
    }
    __syncthreads();
    {
      float a = p.f1_b[l * 64 + lane];
      for (int e = 0; e < 33; ++e) a += em[e] * p.f1_w[(l * 33 + e) * 64 + lane];
      h1[lane] = sinf(p.f1_freq[l * 64 + lane] * a);
    }
    __syncthreads();
    {
      float a = p.f2_b[l * 64 + lane];
      for (int i = 0; i < 64; ++i) a += h1[i] * p.f2_w[(l * 64 + i) * 64 + lane];
      float v = sinf(p.f2_freq[l * 64 + lane] * a);
      if (lat) ((u16*)(p.ws + OFF_H2T))[((size_t)l * 64 + lane) * L + t] = f2bf(v);
      else ((float*)(p.ws + OFF_H2C))[((size_t)l * 256 + t) * 64 + lane] = v;
    }
  }
  __syncthreads();
  {
    constexpr int T_IN = 16 * 249, T_BR = 8 * 32, T_OUT = 16 * 32, T_LAYER = T_IN + 3 * T_BR + T_OUT;
    auto decode = [&](int task, const float*& src, u16*& dst, int& K, int& N, int& k0, int& n0) {
      const int l = task / T_LAYER; int tt = task - l * T_LAYER;
      char* wt = p.ws + OFF_WT + (size_t)l * WT_LAYER;
      int kt, ntile;
      if (tt < T_IN) { src = p.w_in + (size_t)l * 1024 * NIN; dst = (u16*)wt; K = 1024; N = NIN; kt = tt / 249; ntile = tt % 249; }
      else if (tt < T_IN + 3 * T_BR) {
        tt -= T_IN; const int br = tt / T_BR; tt -= br * T_BR;
        src = (br == 0 ? p.w_g : (br == 1 ? p.w_a : p.w_h)) + (size_t)l * 512 * 1024; dst = (u16*)(wt + WT_IN + br * WT_BR);
        K = 512; N = 1024; kt = tt / 32; ntile = tt % 32;
      } else { tt -= T_IN + 3 * T_BR; src = p.w_o + (size_t)l * 1024 * 1024; dst = (u16*)(wt + WT_IN + 3 * WT_BR); K = 1024; N = 1024; kt = tt / 32; ntile = tt % 32; }
      k0 = kt * 64; n0 = ntile * 32;
    };
    float* tileA = sm;
    float* tileB = sm + 64 * 33;
    for (int task = bid; task < 2 * T_LAYER; task += 2 * nb) {
      const bool hasB = task + nb < 2 * T_LAYER;
      const float *sa, *sb = nullptr; u16 *da, *db = nullptr; int Ka, Na, k0a, n0a, Kb = 0, Nb = 0, k0b = 0, n0b = 0;
      decode(task, sa, da, Ka, Na, k0a, n0a);
      if (hasB) decode(task + nb, sb, db, Kb, Nb, k0b, n0b);
      float va[4], vb[4];
#pragma unroll
      for (int i = 0; i < 4; ++i) { const int kk = (tid >> 5) + 16 * i, nn = tid & 31; va[i] = sa[(size_t)(k0a + kk) * Na + n0a + nn]; vb[i] = hasB ? sb[(size_t)(k0b + kk) * Nb + n0b + nn] : 0.f; }
#pragma unroll
      for (int i = 0; i < 4; ++i) { const int kk = (tid >> 5) + 16 * i, nn = tid & 31; tileA[kk * 33 + nn] = va[i]; tileB[kk * 33 + nn] = vb[i]; }
      __syncthreads();
#pragma unroll
      for (int i = 0; i < 4; ++i) {
        const int nn = (tid >> 6) + 8 * i, kk = tid & 63;
        da[(size_t)(n0a + nn) * Ka + k0a + kk] = f2bf(tileA[kk * 33 + nn]);
        if (hasB) db[(size_t)(n0b + nn) * Kb + k0b + kk] = f2bf(tileB[kk * 33 + nn]);
      }
      __syncthreads();
    }
  }
}

DI void phase_norm(const Params& p, int l) {
  const int tid = my_tid(), lane = tid & 63, wid = tid >> 6;
  const float* mod = (const float*)(p.ws + OFF_MOD);
  u16* H = (u16*)(p.ws + OFF_H);
  for (int row = blockIdx.x * 8 + wid; row < R; row += gridDim.x * 8) {
    const float* src = xrow_in(p, l, row);
    const float* mv = mod + (l * 3 + modvec_of(row)) * 3072;
    float4 xv[4]; float ss = 0.f;
#pragma unroll
    for (int i = 0; i < 4; ++i) { xv[i] = *(const float4*)(src + (i * 64 + lane) * 4); ss += xv[i].x * xv[i].x + xv[i].y * xv[i].y + xv[i].z * xv[i].z + xv[i].w * xv[i].w; }
    ss = wave_sum(ss);
    const float rs = rsqrtf(ss * (1.f / 1024.f) + EPS);
#pragma unroll
    for (int i = 0; i < 4; ++i) {
      const int col = (i * 64 + lane) * 4;
      float4 sh = *(const float4*)(mv + col), sc = *(const float4*)(mv + 1024 + col);
      u32x2 o;
      o.x = pack2(xv[i].x * rs * (1.f + sc.x) + sh.x, xv[i].y * rs * (1.f + sc.y) + sh.y);
      o.y = pack2(xv[i].z * rs * (1.f + sc.z) + sh.z, xv[i].w * rs * (1.f + sc.w) + sh.w);
      *(u32x2*)(H + (size_t)row * 1024 + col) = o;
    }
  }
}

DI void phase_proj(const Params& p, int l, char* smem) {
  const int tid = my_tid(), lane = tid & 63, wid = tid >> 6, r = lane & 31, h = lane >> 5, wm = wid & 3, wn = wid >> 2;
  const u16* H = (const u16*)(p.ws + OFF_H);
  const u16* WT = (const u16*)(p.ws + OFF_WT + (size_t)l * WT_LAYER);
  u16* P = (u16*)(p.ws + OFF_P);
  u16* CT = (u16*)(p.ws + OFF_CT);
  u16* Tt = (u16*)smem;
  constexpr int LDE = 260;
  const int xcd = blockIdx.x & 7, nloc = gridDim.x >> 3, local = blockIdx.x >> 3;
  const int nreg = local < 624 ? (624 - local + nloc - 1) / nloc : 0;
  const int r0 = 624 % nloc;
  const int nlight = (r0 == 0 ? nloc : nloc - r0) * 8;
  const int eb = (r0 == 0 ? local : local - r0) * 8 + xcd;
  const int nextra = (eb >= 0 && eb < 78) ? (78 - eb + nlight - 1) / nlight : 0;
  for (int it = 0; it < nreg + nextra; ++it) {
    int mt, nt;
    if (it < nreg) { const int q = local + nloc * it, g = q / 156, rem = q - g * 156; nt = rem >> 2; mt = (g * 4 + (rem & 3)) * 8 + xcd; }
    else { const int e = eb + (it - nreg) * nlight; mt = 128 + e / 39; nt = e % 39; }
    const int m0 = mt * 256, n0 = nt * 128;
    f32x16 acc[2][2];
#pragma unroll
    for (int i = 0; i < 2; ++i) for (int j = 0; j < 2; ++j) acc[i][j] = zero16();
    ALoadN al{H + (size_t)m0 * 1024, 1024};
    gemm_tile<256, ALoadN, 4, 1024>(al, WT + (size_t)n0 * 1024, 1024, smem, acc);
    const int b = m0 / TB, tk0 = m0 - b * TB;
#pragma unroll
    for (int i = 0; i < 2; ++i)
#pragma unroll
      for (int j = 0; j < 2; ++j)
#pragma unroll
        for (int g4 = 0; g4 < 4; ++g4) {
          u32x2 o; o.x = pack2(acc[i][j][4 * g4], acc[i][j][4 * g4 + 1]); o.y = pack2(acc[i][j][4 * g4 + 2], acc[i][j][4 * g4 + 3]);
          *(u32x2*)(Tt + (wn * 64 + j * 32 + r) * LDE + wm * 64 + i * 32 + 8 * g4 + 4 * h) = o;
        }
    __syncthreads();
#pragma unroll 1
    for (int cg = 0; cg < 4; ++cg) {
      const int cb = n0 + cg * 32;
      if (cb >= 4896) continue;
      bool chan; int cm;
      if (cb < 512) { chan = false; cm = cb; }
      else if (cb < 1024) { chan = true; cm = CH_GV + cb - 512; }
      else if (cb < 2208) { chan = false; cm = cb - 512; }
      else if (cb < 2336) { chan = true; cm = CH_AV + cb - 2208; }
      else if (cb < 2848) { chan = false; cm = cb - 640; }
      else { chan = true; cm = cb - 2848; }
      if (chan) {
#pragma unroll
        for (int k = 0; k < 2; ++k) {
          const int idx = tid + NT * k, ch = idx >> 5, t8 = idx & 31;
          const u16* sp = Tt + (cg * 32 + ch) * LDE + t8 * 8;
          const u32x2 lo = *(const u32x2*)sp, hi = *(const u32x2*)(sp + 4);
          __builtin_nontemporal_store(u32x4{lo.x, lo.y, hi.x, hi.y}, (u32x4*)(CT + ((size_t)(cm + ch) * 2 + b) * TB + tk0 + t8 * 8));
        }
      } else {
#pragma unroll
        for (int k = 0; k < 2; ++k) {
          const int idx = tid + NT * k, row = idx >> 2, c8 = idx & 3;
          const u16* sp = Tt + (cg * 32 + c8 * 8) * LDE + row;
          u32x4 o;
          o.x = (unsigned)sp[0] | ((unsigned)sp[LDE] << 16); o.y = (unsigned)sp[2 * LDE] | ((unsigned)sp[3 * LDE] << 16);
          o.z = (unsigned)sp[4 * LDE] | ((unsigned)sp[5 * LDE] << 16); o.w = (unsigned)sp[6 * LDE] | ((unsigned)sp[7 * LDE] << 16);
          __builtin_nontemporal_store(o, (u32x4*)(P + (size_t)(m0 + row) * NP + cm + c8 * 8));
        }
      }
    }
  }
}

DI void attn_prep(const Params& p, int l, int dry) {
  const int tid = my_tid(), lane = tid & 63, wid = tid >> 6;
  u16* P = (u16*)(p.ws + OFF_P);
  const float gq = pk(p, PK_QN)[l * 64 + lane], gk = pk(p, PK_KN)[l * 64 + lane];
  for (int row = blockIdx.x * 8 + wid; row < R; row += gridDim.x * 8) {
    u16* Pr = P + (size_t)row * NP;
    const int b = row / TB, tk = row - b * TB;
    float cs = 1.f, sn = 0.f;
    if (tk >= LC) {
      const int t = tk - LC, pi = lane >> 1;
      const float pos = (pi < 16) ? (float)(t >> 6) : (float)(t & 63);
      const float inv = powf(10000.f, -(float)(2 * (pi & 15)) / 32.f);
      sincosf(pos * inv, &sn, &cs);
    }
#pragma unroll
    for (int hd = 0; hd < 10; ++hd) {
      const int col = (hd < 8) ? PC_AQ + hd * 64 + lane : PC_AK + (hd - 8) * 64 + lane;
      float v = bf2f(Pr[col]);
      const float ss = wave_sum(v * v);
      v = v * rsqrtf(ss * (1.f / 64.f) + EPS) * (hd < 8 ? gq : gk);
      const float pv = __shfl_xor(v, 1);
      float o = (lane & 1) ? (pv * sn + v * cs) : (v * cs - pv * sn);
      if (hd < 8) o *= 0.125f * 1.4426950408889634f;
      if (!dry) Pr[col] = f2bf(o);
    }
  }
}

DI void fft_pass4_fwd(float2* X, int tid, int h2) {
  const float inv4 = 0.25f / (float)h2;
#pragma unroll 4
  for (int i = 0; i < 8; ++i) {
    const int g = tid + NT * i, jp = g & (h2 - 1), base = ((g - jp) << 2) + jp;
    float2 e0 = X[base], e1 = X[base + h2], e2 = X[base + 2 * h2], e3 = X[base + 3 * h2];
    const float fr = (float)jp * inv4;
    const float2 T1 = make_float2(__builtin_amdgcn_cosf(fr), -__builtin_amdgcn_sinf(fr));
    const float2 T2 = cmul(T1, T1);
    float2 a0 = cadd(e0, e2), a2 = cmul(csub(e0, e2), T1);
    float2 a1 = cadd(e1, e3), d13 = cmul(csub(e1, e3), T1);
    float2 a3 = make_float2(d13.y, -d13.x);
    X[base] = cadd(a0, a1); X[base + h2] = cmul(csub(a0, a1), T2);
    X[base + 2 * h2] = cadd(a2, a3); X[base + 3 * h2] = cmul(csub(a2, a3), T2);
  }
  __syncthreads();
}
DI void fft_pass4_inv(float2* X, int tid, int h1) {
  const float inv4 = 0.25f / (float)h1;
#pragma unroll 4
  for (int i = 0; i < 8; ++i) {
    const int g = tid + NT * i, jp = g & (h1 - 1), base = ((g - jp) << 2) + jp;
    float2 e0 = X[base], e1 = X[base + h1], e2 = X[base + 2 * h1], e3 = X[base + 3 * h1];
    const float fr = (float)jp * inv4;
    const float2 V = make_float2(__builtin_amdgcn_cosf(fr), __builtin_amdgcn_sinf(fr));
    const float2 Wc = cmul(V, V);
    float2 t1 = cmul(e1, Wc), t3 = cmul(e3, Wc);
    float2 a0 = cadd(e0, t1), a1 = csub(e0, t1), a2 = cadd(e2, t3), a3 = csub(e2, t3);
    float2 u2 = cmul(a2, V), u3 = cmul(a3, V);
    u3 = make_float2(-u3.y, u3.x);
    X[base] = cadd(a0, u2); X[base + 2 * h1] = csub(a0, u2);
    X[base + h1] = cadd(a1, u3); X[base + 3 * h1] = csub(a1, u3);
  }
  __syncthreads();
}
DI constexpr float r16c(int k) { return k == 0 ? 1.f : k == 1 ? 0.9238795325112867f : k == 2 ? 0.7071067811865476f : k == 3 ? 0.3826834323650898f : k == 4 ? 0.f : k == 5 ? -0.3826834323650898f : k == 6 ? -0.7071067811865476f : -0.9238795325112867f; }
DI constexpr float r16s(int k) { return k == 0 ? 0.f : k == 1 ? 0.3826834323650898f : k == 2 ? 0.7071067811865476f : k == 3 ? 0.9238795325112867f : k == 4 ? 1.f : k == 5 ? 0.9238795325112867f : k == 6 ? 0.7071067811865476f : 0.3826834323650898f; }
template <bool INV>
DI void fft_pass16(float2* X, int tid, int q) {
  const float invq = 1.f / (16.f * (float)q);
#pragma unroll
  for (int it = 0; it < 2; ++it) {
    const int g = tid + NT * it, jp = g & (q - 1), base = ((g - jp) << 4) + jp;
    float vx[16], vy[16];
#pragma unroll
    for (int r = 0; r < 16; ++r) { const float2 e = X[base + r * q]; vx[r] = e.x; vy[r] = e.y; }
    const float th = (float)jp * invq;
    float bx[4], by[4];
    bx[0] = __builtin_amdgcn_cosf(th); by[0] = INV ? __builtin_amdgcn_sinf(th) : -__builtin_amdgcn_sinf(th);
#pragma unroll
    for (int s = 1; s < 4; ++s) { bx[s] = bx[s - 1] * bx[s - 1] - by[s - 1] * by[s - 1]; by[s] = 2.f * bx[s - 1] * by[s - 1]; }
#pragma unroll
    for (int ss = 0; ss < 4; ++ss) {
      const int s = INV ? 3 - ss : ss;
      const int rs = 8 >> s;
#pragma unroll
      for (int bf = 0; bf < 8; ++bf) {
        const int r = ((bf & ~(rs - 1)) << 1) | (bf & (rs - 1));
        const int k = (r & (rs - 1)) * (8 / rs);
        const float cc = r16c(k), cs = INV ? r16s(k) : -r16s(k);
        const float tx = bx[s] * cc - by[s] * cs, ty = bx[s] * cs + by[s] * cc;
        const float ax = vx[r], ay = vy[r], cx = vx[r + rs], cy = vy[r + rs];
        if (!INV) {
          const float dx = ax - cx, dy = ay - cy;
          vx[r] = ax + cx; vy[r] = ay + cy;
          vx[r + rs] = dx * tx - dy * ty; vy[r + rs] = dx * ty + dy * tx;
        } else {
          const float ux = cx * tx - cy * ty, uy = cx * ty + cy * tx;
          vx[r] = ax + ux; vy[r] = ay + uy;
          vx[r + rs] = ax - ux; vy[r + rs] = ay - uy;
        }
      }
    }
#pragma unroll
    for (int r = 0; r < 16; ++r) X[base + r * q] = make_float2(vx[r], vy[r]);
  }
  __syncthreads();
}
DI void fft_fwd(float2* X, int tid) {
#pragma unroll 1
  for (int q = 1024; q >= 4; q >>= 4) fft_pass16<false>(X, tid, q);
  fft_pass4_fwd(X, tid, 1);
}
DI void fft_inv(float2* X, int tid) {
  fft_pass4_inv(X, tid, 1);
#pragma unroll 1
  for (int q = 4; q <= 1024; q <<= 4) fft_pass16<true>(X, tid, q);
}
DI float sconv_at(const u16* src, int t, int len, float w0, float w1, float w2, float bb) {
  float ym = t > 0 ? bf2f(src[t - 1]) : 0.f, y0 = bf2f(src[t]), yp = t < len - 1 ? bf2f(src[t + 1]) : 0.f;
  return bb + w0 * ym + w1 * y0 + w2 * yp;
}
DI float hy_delta(int col) {
  const float A0 = -4.605170185988091f / 0.3f, A1 = -4.605170185988091f / 1.5f;
  return fabsf(A0 + (A1 - A0) * ((float)col / 2047.f));
}

DI void hyena_latent_task(const Params& p, int l, int c, char* smem, int dry) {
  float2* X = (float2*)smem;
  float* red = (float*)(smem + 131072);
  const int tid = my_tid(), lane = tid & 63, wid = tid >> 6;
  u16* CT = (u16*)(p.ws + OFF_CT);
  float2* FE = (float2*)(p.ws + OFF_FS + (size_t)blockIdx.x * 262144);
  float2* FO = FE + 16384;
  const unsigned* h2T = (const unsigned*)(p.ws + OFF_H2T) + (size_t)l * 64 * (L / 2);
  const float* f3w = pk(p, PK_F3) + (size_t)l * 64 * 2048;
  const float* cw = pk(p, PK_CW) + (size_t)l * 3 * 1536;
  const float* cbv = pk(p, PK_CB) + (size_t)l * 1536;
  const float vw0 = cw[c], vw1 = cw[1536 + c], vw2 = cw[3072 + c], vbb = cbv[c];
  const u16* v0 = CT + ((size_t)(CH_YU + c) * 2 + 0) * TB + LC;
  const u16* v1 = CT + ((size_t)(CH_YU + c) * 2 + 1) * TB + LC;
  u16* z10 = CT + ((size_t)(CH_YU + 512 + c) * 2 + 0) * TB + LC;
  u16* z11 = CT + ((size_t)(CH_YU + 512 + c) * 2 + 1) * TB + LC;
#pragma unroll 1
  for (int o = 0; o < 2; ++o) {
    const int cf = o * 1024 + c, cbk = cf + 512;
    float sf = 0.f, sb = 0.f;
    __syncthreads();
#ifdef PROBE_FFT
    fft_fwd(X, tid); fft_inv(X, tid);
#endif
#pragma unroll 1
    for (int half = 0; half < 2; ++half) {
      float af[16], ab[16];
#pragma unroll
      for (int i = 0; i < 16; ++i) { af[i] = 0.f; ab[i] = 0.f; }
#pragma unroll 1
      for (int j = 0; j < 64; j += 2) {
        const float wf0 = f3w[j * 2048 + cf], wb0 = f3w[j * 2048 + cbk], wf1 = f3w[(j + 1) * 2048 + cf], wb1 = f3w[(j + 1) * 2048 + cbk];
        const unsigned* hrow = h2T + (size_t)j * (L / 2) + tid + half * 8 * NT;
        unsigned w0[8], w1[8];
#pragma unroll
        for (int i = 0; i < 8; ++i) { w0[i] = hrow[NT * i]; w1[i] = hrow[L / 2 + NT * i]; }
#pragma unroll
        for (int i = 0; i < 8; ++i) {
          const float a0 = bflo(w0[i]), a1 = bfhi(w0[i]), b0 = bflo(w1[i]), b1 = bfhi(w1[i]);
          af[2 * i] += a0 * wf0 + b0 * wf1; af[2 * i + 1] += a1 * wf0 + b1 * wf1;
          ab[2 * i] += a0 * wb0 + b0 * wb1; ab[2 * i + 1] += a1 * wb0 + b1 * wb1;
        }
      }
      const float df = hy_delta(cf), db = hy_delta(cbk);
#pragma unroll
      for (int i = 0; i < 16; ++i) {
        const int t = 2 * (tid + NT * ((i >> 1) + half * 8)) + (i & 1); const float tt = (float)t / (float)(L - 1);
        const float vf = af[i] * (__expf(-tt * df) + 0.05f), vb = ab[i] * (__expf(-tt * db) + 0.05f);
        sf += fabsf(vf); sb += fabsf(vb);
        X[t].x = vf;
        if (t >= 1) X[L - t].y = vb; else X[0].y = 0.f;
      }
    }
    sf = wave_sum(sf); sb = wave_sum(sb);
    if (lane == 0) { red[wid] = sf; red[8 + wid] = sb; }
    __syncthreads();
    float nf = 0.f, nbk = 0.f;
#pragma unroll
    for (int w = 0; w < 8; ++w) { nf += red[w]; nbk += red[8 + w]; }
    const float inv_f = 1.f / nf, inv_b = 1.f / nbk;
#pragma unroll 8
    for (int i = 0; i < 32; ++i) { const int n = tid + NT * i; const float2 s = X[n]; FO[n] = s; X[n] = make_float2(s.x * inv_f + s.y * inv_b, 0.f); }
    __syncthreads();
    fft_fwd(X, tid);
#pragma unroll 8
    for (int i = 0; i < 32; ++i) { const int n = tid + NT * i; FE[n] = X[n]; }
    __syncthreads();
#pragma unroll 8
    for (int i = 0; i < 32; ++i) {
      const int n = tid + NT * i; const float2 s = FO[n]; const float dd = s.x * inv_f - s.y * inv_b; const float fr = (float)n * (1.f / 32768.f);
      X[n] = make_float2(dd * __builtin_amdgcn_cosf(fr), -dd * __builtin_amdgcn_sinf(fr));
    }
    __syncthreads();
    fft_fwd(X, tid);
#pragma unroll 8
    for (int i = 0; i < 32; ++i) { const int n = tid + NT * i; FO[n] = X[n]; }
    __syncthreads();
#pragma unroll 8
    for (int i = 0; i < 32; ++i) {
      const int n = tid + NT * i;
      float2 zz;
      if (o == 0) { zz.x = sconv_at(v0, n, L, vw0, vw1, vw2, vbb); zz.y = sconv_at(v1, n, L, vw0, vw1, vw2, vbb); }
      else { zz.x = bf2f(z10[n]); zz.y = bf2f(z11[n]); }
      X[n] = zz;
    }
    __syncthreads();
    fft_fwd(X, tid);
#pragma unroll 8
    for (int i = 0; i < 32; ++i) { const int n = tid + NT * i; X[n] = cmul(X[n], FE[n]); }
    __syncthreads();
    fft_inv(X, tid);
#pragma unroll 8
    for (int i = 0; i < 32; ++i) { const int n = tid + NT * i; FE[n] = X[n]; }
    __syncthreads();
#pragma unroll 8
    for (int i = 0; i < 32; ++i) {
      const int n = tid + NT * i; const float fr = (float)n * (1.f / 32768.f);
      float2 zz;
      if (o == 0) { zz.x = sconv_at(v0, n, L, vw0, vw1, vw2, vbb); zz.y = sconv_at(v1, n, L, vw0, vw1, vw2, vbb); }
      else { zz.x = bf2f(z10[n]); zz.y = bf2f(z11[n]); }
      X[n] = cmul(zz, make_float2(__builtin_amdgcn_cosf(fr), -__builtin_amdgcn_sinf(fr)));
    }
    __syncthreads();
    fft_fwd(X, tid);
#pragma unroll 8
    for (int i = 0; i < 32; ++i) { const int n = tid + NT * i; X[n] = cmul(X[n], FO[n]); }
    __syncthreads();
    fft_inv(X, tid);
    {
      const int gch = CH_YU + 512 * (o + 1) + c;
      const float w0 = cw[gch], w1 = cw[1536 + gch], w2 = cw[3072 + gch], bb = cbv[gch];
      const u16* s0 = CT + ((size_t)gch * 2 + 0) * TB + LC;
      const u16* s1 = CT + ((size_t)gch * 2 + 1) * TB + LC;
      const float sk = pk(p, PK_SK)[(l * 2 + o) * 512 + c];
#pragma unroll 8
      for (int i = 0; i < 32; ++i) {
        const int n = tid + NT * i; const float fr = (float)n * (1.f / 32768.f);
        const float2 wb = cmul(X[n], make_float2(__builtin_amdgcn_cosf(fr), __builtin_amdgcn_sinf(fr)));
        const float2 A = FE[n];
        const float yr = (A.x + wb.x) * (1.f / 32768.f), yi = (A.y + wb.y) * (1.f / 32768.f);
        const float g0 = sconv_at(s0, n, L, w0, w1, w2, bb), g1 = sconv_at(s1, n, L, w0, w1, w2, bb);
        float2 zz;
        if (o == 0) { zz.x = sconv_at(v0, n, L, vw0, vw1, vw2, vbb); zz.y = sconv_at(v1, n, L, vw0, vw1, vw2, vbb); }
        else { zz.x = bf2f(z10[n]); zz.y = bf2f(z11[n]); }
        X[n] = make_float2(g0 * (yr + sk * zz.x), g1 * (yi + sk * zz.y));
      }
    }
    __syncthreads();
    if (o == 0) {
#pragma unroll 8
      for (int i = 0; i < 32; ++i) { const int n = tid + NT * i; const float2 zz = X[n]; if (!dry) { z10[n] = f2bf(zz.x); z11[n] = f2bf(zz.y); } }
    } else {
      u16* d0 = CT + ((size_t)(CH_YZ + c) * 2 + 0) * TB + LC;
      u16* d1 = CT + ((size_t)(CH_YZ + c) * 2 + 1) * TB + LC;
#pragma unroll 1
      for (int ib = 0; ib < 32; ib += 8) {
        u16 g0[8], g1[8];
#pragma unroll
        for (int i = 0; i < 8; ++i) { const int n = tid + NT * (ib + i); g0[i] = d0[n]; g1[i] = d1[n]; }
#pragma unroll
        for (int i = 0; i < 8; ++i) {
          const int n = tid + NT * (ib + i); const float2 zz = X[n];
          const u16 q0 = f2bf(zz.x * silu_f(bf2f(g0[i]))), q1 = f2bf(zz.y * silu_f(bf2f(g1[i])));
          if (!dry) { d0[n] = q0; d1[n] = q1; }
        }
      }
    }
    __syncthreads();
  }
}

DI void hyena_ctx_task(const Params& p, int l, int c, char* smem, int dry) {
  float* filt = (float*)smem;
  float* zs = filt + 1024;
  float* nrm = zs + 1024;
  const int tid = my_tid(), lane = tid & 63, wid = tid >> 6, t = tid & 255, hb = tid >> 8;
  u16* CT = (u16*)(p.ws + OFF_CT);
  const float* h2c = (const float*)(p.ws + OFF_H2C) + (size_t)l * 256 * 64;
  const float* f3w = pk(p, PK_F3) + (size_t)l * 64 * 2048;
  const float* cw = pk(p, PK_CW) + (size_t)l * 3 * 1536;
  const float* cbv = pk(p, PK_CB) + (size_t)l * 1536;
  __syncthreads();
  {
    const int cf = hb * 1024 + c, cbk = cf + 512;
    float a_f = 0.f, a_b = 0.f;
    for (int j = 0; j < 64; ++j) { const float hv = h2c[t * 64 + j]; a_f += hv * f3w[j * 2048 + cf]; a_b += hv * f3w[j * 2048 + cbk]; }
    const float tt = (float)t / 255.f;
    filt[(hb * 2 + 0) * 256 + t] = a_f * (__expf(-tt * hy_delta(cf)) + 0.05f);
    filt[(hb * 2 + 1) * 256 + t] = a_b * (__expf(-tt * hy_delta(cbk)) + 0.05f);
    const u16* src = CT + ((size_t)(CH_YU + c) * 2 + hb) * TB;
    zs[hb * 256 + t] = sconv_at(src, t, LC, cw[c], cw[1536 + c], cw[3072 + c], cbv[c]);
  }
  __syncthreads();
  if (wid < 4) {
    float s = 0.f;
    for (int k = 0; k < 4; ++k) s += fabsf(filt[wid * 256 + lane + 64 * k]);
    s = wave_sum(s);
    if (lane == 0) nrm[wid] = s;
  }
  __syncthreads();
  const int b = hb;
  for (int o = 0; o < 2; ++o) {
    const float inf_ = 1.f / nrm[o * 2], inb_ = 1.f / nrm[o * 2 + 1];
    const float* hf = filt + (o * 2) * 256; const float* hbk = filt + (o * 2 + 1) * 256;
    const float* zc = zs + (o & 1) * 512 + b * 256;
    float accf = 0.f, accb = 0.f;
    for (int s = 0; s <= t; ++s) accf += hf[t - s] * zc[s];
    for (int s = t + 1; s < 256; ++s) accb += hbk[s - t] * zc[s];
    const int gch = CH_YU + 512 * (o + 1) + c;
    const float gate = sconv_at(CT + ((size_t)gch * 2 + b) * TB, t, LC, cw[gch], cw[1536 + gch], cw[3072 + gch], cbv[gch]);
    const float zn = gate * (accf * inf_ + accb * inb_ + pk(p, PK_SK)[(l * 2 + o) * 512 + c] * zc[t]);
    zs[((o + 1) & 1) * 512 + b * 256 + t] = zn;
    __syncthreads();
  }
  {
    u16* d = CT + ((size_t)(CH_YZ + c) * 2 + b) * TB;
    const u16 q0 = f2bf(zs[b * 256 + t] * silu_f(bf2f(d[t])));
    if (!dry) d[t] = q0;
  }
  __syncthreads();
}

DI void gla_bcum(const Params& p, int l, int row0, int hh, int dir, float* gs, float* segs, float* was, float* as_) {
  const int tid = my_tid();
  const u16* P = (const u16*)(p.ws + OFF_P);
  const float* wa = pk(p, dir ? PK_WAB : PK_WAF) + (size_t)l * 16 * 256 + hh * 64;
  const float* ba = pk(p, dir ? PK_BAB : PK_BAF) + l * 256 + hh * 64;
#pragma unroll
  for (int i = 0; i < 2; ++i) {
    const int idx = tid + NT * i;
    was[idx] = wa[(idx >> 6) * 256 + (idx & 63)];
    as_[(idx >> 4) * 17 + (idx & 15)] = bf2f(P[(size_t)(row0 + (idx >> 4)) * NP + PC_AF + dir * 16 + (idx & 15)]);
  }
  __syncthreads();
  {
    const int t = tid >> 3, d0 = (tid & 7) * 8;
    float lin[8];
#pragma unroll
    for (int e = 0; e < 8; ++e) lin[e] = ba[d0 + e];
#pragma unroll 2
    for (int rr = 0; rr < 16; ++rr) {
      const float av = as_[t * 17 + rr];
      const float4 w0 = *(const float4*)(was + rr * 64 + d0), w1 = *(const float4*)(was + rr * 64 + d0 + 4);
      lin[0] += av * w0.x; lin[1] += av * w0.y; lin[2] += av * w0.z; lin[3] += av * w0.w;
      lin[4] += av * w1.x; lin[5] += av * w1.y; lin[6] += av * w1.z; lin[7] += av * w1.w;
    }
#pragma unroll
    for (int e = 0; e < 8; ++e) gs[t * 65 + d0 + e] = (fminf(lin[e], 0.f) - log1pf(__expf(-fabsf(lin[e])))) * (1.f / 16.f);
  }
  __syncthreads();
  {
    const int d = tid & 63, seg = tid >> 6;
    float v[8]; float run = 0.f;
#pragma unroll
    for (int e = 0; e < 8; ++e) { const int tt = dir ? seg * 8 + 7 - e : seg * 8 + e; run += gs[tt * 65 + d]; v[e] = run; }
    segs[seg * 64 + d] = run;
    __syncthreads();
    float off = 0.f;
#pragma unroll
    for (int s = 0; s < 8; ++s) { const bool before = dir ? (s > seg) : (s < seg); if (before) off += segs[s * 64 + d]; }
#pragma unroll
    for (int e = 0; e < 8; ++e) { const int tt = dir ? seg * 8 + 7 - e : seg * 8 + e; gs[tt * 65 + d] = v[e] + off; }
  }
  __syncthreads();
}
DI int gla_tok0(int dir, int n) {
  if (n < 4) return (dir ? 3 - n : n) * 64;
  return LC + (dir ? 255 - (n - 4) : n - 4) * 64;
}
constexpr int G_GS = 0;
constexpr int G_SEG = G_GS + 64 * 65 * 4;
constexpr int G_QS = G_SEG + 8 * 64 * 4;
constexpr int G_KS = G_QS + 64 * LDT * 2;
constexpr int G_VT = G_KS + 64 * LDT * 2;
constexpr int G_ST = G_VT + 128 * LDT * 2;
constexpr int G_RED = G_ST + 128 * LDT * 2;
constexpr int G_WA = G_RED + 8 * 32 * 4;
constexpr int G_AS = G_WA + 16 * 64 * 4;

DI void gla_g1_task(const Params& p, int l, int chain, int n, char* smem) {
  const int tid = my_tid(), lane = tid & 63, wid = tid >> 6, r = lane & 31, h = lane >> 5;
  const int b = chain >> 3, hh = (chain >> 1) & 3, dir = chain & 1;
  const int tk0 = gla_tok0(dir, n), row0 = b * TB + tk0;
  float* gs = (float*)(smem + G_GS); float* segs = (float*)(smem + G_SEG);
  u16* kT = (u16*)(smem + G_KS); u16* vT = (u16*)(smem + G_VT);
  const u16* P = (const u16*)(p.ws + OFF_P);
  const u16* CT = (const u16*)(p.ws + OFF_CT);
  __syncthreads();
  gla_bcum(p, l, row0, hh, dir, gs, segs, (float*)(smem + G_WA), (float*)(smem + G_AS));
  const int tl = dir ? 0 : 63;
  {
    const int t = tid >> 3, d0 = (tid & 7) * 8;
    const u32x4 kv = *(const u32x4*)(P + (size_t)(row0 + t) * NP + PC_GK + hh * 64 + d0);
    const unsigned w[4] = {kv.x, kv.y, kv.z, kv.w};
#pragma unroll
    for (int e = 0; e < 8; ++e) {
      const float kx = (e & 1) ? bfhi(w[e >> 1]) : bflo(w[e >> 1]);
      kT[(d0 + e) * LDT + t] = f2bf(kx * __expf(gs[tl * 65 + d0 + e] - gs[t * 65 + d0 + e]));
    }
#pragma unroll
    for (int i = 0; i < 2; ++i) {
      const int q = tid + NT * i, v = q >> 3, cc = q & 7;
      *(u32x4*)(vT + v * LDT + cc * 8) = *(const u32x4*)(CT + ((size_t)(CH_GV + hh * 128 + v) * 2 + b) * TB + tk0 + cc * 8);
    }
    if (tid < 64) ((float*)(p.ws + OFF_GD))[((size_t)chain * NCK + n) * 64 + tid] = __expf(gs[tl * 65 + tid]);
  }
  __syncthreads();
  {
    const int vm = wid >> 1, dn = wid & 1;
    f32x16 acc = zero16();
#pragma unroll
    for (int s = 0; s < 4; ++s) {
      const bf16x8 a = *(const bf16x8*)(vT + (vm * 32 + r) * LDT + s * 16 + h * 8);
      const bf16x8 bb = *(const bf16x8*)(kT + (dn * 32 + r) * LDT + s * 16 + h * 8);
      acc = MFMA(a, bb, acc);
    }
    u16* GS = (u16*)(p.ws + OFF_GS) + ((size_t)chain * NCK + n) * 8192;
#pragma unroll
    for (int reg = 0; reg < 16; ++reg) GS[(vm * 32 + crow(reg, h)) * 64 + dn * 32 + r] = f2bf(acc[reg]);
  }
}
DI void gla_g2(const Params& p, int dry) {
  u16* GSb = (u16*)(p.ws + OFF_GS);
  const float* GD = (const float*)(p.ws + OFF_GD);
  for (int gi = blockIdx.x * NT + my_tid(); gi < 16 * 8192; gi += gridDim.x * NT) {
    const int chain = gi >> 13, e = gi & 8191, d = e & 63;
    u16* ptr = GSb + (size_t)chain * NCK * 8192 + e;
    const float* dec = GD + (size_t)chain * NCK * 64 + d;
    float S = 0.f;
#pragma unroll 1
    for (int n0 = 0; n0 < NCK; n0 += 20) {
      float ds[20], a[20];
#pragma unroll
      for (int k = 0; k < 20; ++k) { ds[k] = bf2f(ptr[(size_t)(n0 + k) * 8192]); a[k] = dec[(n0 + k) * 64]; }
#pragma unroll
      for (int k = 0; k < 20; ++k) { if (!dry) ptr[(size_t)(n0 + k) * 8192] = f2bf(S); S = a[k] * S + ds[k]; }
    }
  }
}
DI void gla_g3_task(const Params& p, int l, int b, int hh, int ci, char* smem, int dry) {
  const int tid = my_tid(), lane = tid & 63, wid = tid >> 6, r = lane & 31, h = lane >> 5;
  const int tk0 = ci * 64, row0 = b * TB + tk0;
  float* gs = (float*)(smem + G_GS); float* segs = (float*)(smem + G_SEG); float* red = (float*)(smem + G_RED);
  u16* qs = (u16*)(smem + G_QS); u16* ks = (u16*)(smem + G_KS); u16* vT = (u16*)(smem + G_VT); u16* sT = (u16*)(smem + G_ST);
  u16* P = (u16*)(p.ws + OFF_P);
  const u16* CT = (const u16*)(p.ws + OFF_CT);
  const int vm = wid >> 1, in = wid & 1;
  f32x16 o = zero16();
  __syncthreads();
#pragma unroll 1
  for (int dir = 0; dir < 2; ++dir) {
    gla_bcum(p, l, row0, hh, dir, gs, segs, (float*)(smem + G_WA), (float*)(smem + G_AS));
    const int chain = b * 8 + hh * 2 + dir;
    const int n = dir ? ((ci < 4) ? 3 - ci : 263 - ci) : ci;
    {
      const int t = tid >> 3, d0 = (tid & 7) * 8;
      const u32x4 qv = *(const u32x4*)(P + (size_t)(row0 + t) * NP + PC_GQ + hh * 64 + d0);
      const u32x4 kv = *(const u32x4*)(P + (size_t)(row0 + t) * NP + PC_GK + hh * 64 + d0);
      const unsigned qw[4] = {qv.x, qv.y, qv.z, qv.w}, kw[4] = {kv.x, kv.y, kv.z, kv.w};
      unsigned qo[4], ko[4];
#pragma unroll
      for (int e = 0; e < 4; ++e) {
        const float b0 = gs[t * 65 + d0 + 2 * e], b1 = gs[t * 65 + d0 + 2 * e + 1];
        qo[e] = pack2(bflo(qw[e]) * 0.125f * __expf(b0), bfhi(qw[e]) * 0.125f * __expf(b1));
        ko[e] = pack2(bflo(kw[e]) * __expf(-b0), bfhi(kw[e]) * __expf(-b1));
      }
      *(u32x4*)(qs + t * LDT + d0) = u32x4{qo[0], qo[1], qo[2], qo[3]};
      *(u32x4*)(ks + t * LDT + d0) = u32x4{ko[0], ko[1], ko[2], ko[3]};
      const u16* GS = (const u16*)(p.ws + OFF_GS) + ((size_t)chain * NCK + n) * 8192;
#pragma unroll
      for (int i = 0; i < 2; ++i) {
        const int q = tid + NT * i, v = q >> 3, cc = q & 7;
        *(u32x4*)(sT + v * LDT + cc * 8) = *(const u32x4*)(GS + v * 64 + cc * 8);
        if (dir == 0) *(u32x4*)(vT + v * LDT + cc * 8) = *(const u32x4*)(CT + ((size_t)(CH_GV + hh * 128 + v) * 2 + b) * TB + tk0 + cc * 8);
      }
    }
    __syncthreads();
    bf16x8 qf[4];
#pragma unroll
    for (int s = 0; s < 4; ++s) qf[s] = *(const bf16x8*)(qs + (in * 32 + r) * LDT + s * 16 + h * 8);
#pragma unroll
    for (int jt = 0; jt < 2; ++jt) {
      f32x16 at = zero16();
#pragma unroll
      for (int s = 0; s < 4; ++s) at = MFMA(*(const bf16x8*)(ks + (jt * 32 + r) * LDT + s * 16 + h * 8), qf[s], at);
      const int ii = in * 32 + r;
#pragma unroll
      for (int reg = 0; reg < 16; ++reg) {
        const int jj = jt * 32 + crow(reg, h);
        const bool keep = dir ? (jj >= ii) : (jj <= ii);
        if (!keep) at[reg] = 0.f;
      }
#pragma unroll
      for (int s = 0; s < 2; ++s) {
        const u16* vp = vT + (vm * 32 + r) * LDT + jt * 32 + 16 * s + 4 * h;
        o = MFMA(ld2x64(vp, vp + 8), pack8(at, s), o);
      }
    }
#pragma unroll
    for (int s = 0; s < 4; ++s) o = MFMA(*(const bf16x8*)(sT + (vm * 32 + r) * LDT + s * 16 + h * 8), qf[s], o);
    __syncthreads();
  }
  float ss = 0.f;
#pragma unroll
  for (int reg = 0; reg < 16; ++reg) ss += o[reg] * o[reg];
  ss += __shfl_xor(ss, 32);
  if (h == 0) red[wid * 32 + r] = ss;
  __syncthreads();
  float tot = 0.f;
#pragma unroll
  for (int m = 0; m < 4; ++m) tot += red[(m * 2 + in) * 32 + r];
  const float rs = rsqrtf(tot * (1.f / 128.f) + EPS);
  u16* zp = P + (size_t)(row0 + in * 32 + r) * NP + PC_GZ + hh * 128 + vm * 32 + 4 * h;
  const float* gn = pk(p, PK_GN) + l * 128 + vm * 32 + 4 * h;
#pragma unroll
  for (int g = 0; g < 4; ++g) {
    const u32x2 zz = *(const u32x2*)(zp + 8 * g);
    const float4 gw = *(const float4*)(gn + 8 * g);
    u32x2 out;
    out.x = pack2(o[4 * g] * rs * gw.x * silu_f(bflo(zz.x)), o[4 * g + 1] * rs * gw.y * silu_f(bfhi(zz.x)));
    out.y = pack2(o[4 * g + 2] * rs * gw.z * silu_f(bflo(zz.y)), o[4 * g + 3] * rs * gw.w * silu_f(bfhi(zz.y)));
    if (!dry) *(u32x2*)(zp + 8 * g) = out;
  }
}

DI void attn_item(const Params& p, int l, int b, int g, int qtk0, int ntiles, char* smem, int dry) {
  const int tid = my_tid(), lane = tid & 63, wid = tid >> 6, r = lane & 31, h = lane >> 5;
  u16* P = (u16*)(p.ws + OFF_P);
  const u16* CT = (const u16*)(p.ws + OFF_CT);
  u16* Ks = (u16*)smem;
  u16* Vs = Ks + 2 * 64 * LDT;
  const int hq = g * 4 + (wid >> 1);
  const size_t qrow = (size_t)b * TB + qtk0 + (wid & 1) * 32 + r;
  bf16x8 qf[4];
#pragma unroll
  for (int s = 0; s < 4; ++s) qf[s] = *(const bf16x8*)(P + qrow * NP + PC_AQ + hq * 64 + s * 16 + h * 8);
  f32x16 O[2] = {zero16(), zero16()};
  float m = -1e30f, lsum = 0.f;
  const int lr = tid >> 3, lc = (tid & 7) * 8;
  const u16* kg = P + ((size_t)b * TB + lr) * NP + PC_AK + g * 64 + lc;
  const u16* vg = CT + ((size_t)(CH_AV + g * 64 + lr) * 2 + b) * TB + lc;
  u32x4 rk = *(const u32x4*)kg, rv = *(const u32x4*)vg;
  __syncthreads();
  *(u32x4*)(Ks + lr * LDT + lc) = rk; *(u32x4*)(Vs + lr * LDT + lc) = rv;
  __syncthreads();
  float gqm = fabsf(pk(p, PK_QN)[l * 64 + lane]), gkm = fabsf(pk(p, PK_KN)[l * 64 + lane]);
#pragma unroll
  for (int o = 32; o >= 1; o >>= 1) { gqm = fmaxf(gqm, __shfl_xor(gqm, o)); gkm = fmaxf(gkm, __shfl_xor(gkm, o)); }
  const float mshift = 8.2f * 1.4426950408889634f * gqm * gkm;
  if (mshift <= 60.f) {
    f32x16 sinit;
#pragma unroll
    for (int i = 0; i < 16; ++i) sinit[i] = -mshift;
#pragma unroll 1
    for (int kt = 0; kt < ntiles; ++kt) {
      const int cur = kt & 1;
      if (kt + 1 < ntiles) { rk = *(const u32x4*)(kg + (size_t)(kt + 1) * 64 * NP); rv = *(const u32x4*)(vg + (kt + 1) * 64); }
      const u16* Kc = Ks + cur * 64 * LDT; const u16* Vc = Vs + cur * 64 * LDT;
      f32x16 st[2];
#pragma unroll
      for (int kk = 0; kk < 2; ++kk) {
        st[kk] = sinit;
#pragma unroll
        for (int s = 0; s < 4; ++s) st[kk] = MFMA(*(const bf16x8*)(Kc + (kk * 32 + r) * LDT + s * 16 + h * 8), qf[s], st[kk]);
      }
#pragma unroll
      for (int kk = 0; kk < 2; ++kk)
#pragma unroll
        for (int i = 0; i < 16; ++i) { const float pv = __builtin_amdgcn_exp2f(st[kk][i]); st[kk][i] = pv; lsum += pv; }
#pragma unroll
      for (int kk = 0; kk < 2; ++kk)
#pragma unroll
        for (int s = 0; s < 2; ++s) {
          const bf16x8 pb = pack8(st[kk], s);
#pragma unroll
          for (int mt = 0; mt < 2; ++mt) {
            const u16* vp = Vc + (mt * 32 + r) * LDT + kk * 32 + 16 * s + 4 * h;
            O[mt] = MFMA(ld2x64(vp, vp + 8), pb, O[mt]);
          }
        }
      if (kt + 1 < ntiles) { *(u32x4*)(Ks + (cur ^ 1) * 64 * LDT + lr * LDT + lc) = rk; *(u32x4*)(Vs + (cur ^ 1) * 64 * LDT + lr * LDT + lc) = rv; }
      __syncthreads();
    }
  } else {
#pragma unroll 1
    for (int kt = 0; kt < ntiles; ++kt) {
      const int cur = kt & 1;
      if (kt + 1 < ntiles) { rk = *(const u32x4*)(kg + (size_t)(kt + 1) * 64 * NP); rv = *(const u32x4*)(vg + (kt + 1) * 64); }
      const u16* Kc = Ks + cur * 64 * LDT; const u16* Vc = Vs + cur * 64 * LDT;
      f32x16 st[2];
#pragma unroll
      for (int kk = 0; kk < 2; ++kk) {
        st[kk] = zero16();
#pragma unroll
        for (int s = 0; s < 4; ++s) st[kk] = MFMA(*(const bf16x8*)(Kc + (kk * 32 + r) * LDT + s * 16 + h * 8), qf[s], st[kk]);
      }
      float mx = st[0][0];
#pragma unroll
      for (int i = 0; i < 16; ++i) { mx = fmaxf(mx, st[0][i]); mx = fmaxf(mx, st[1][i]); }
      mx = fmaxf(mx, __shfl_xor(mx, 32));
      const float mn = fmaxf(m, mx);
      const float alpha = exp2f(m - mn);
      m = mn;
      float rsum = 0.f;
#pragma unroll
      for (int kk = 0; kk < 2; ++kk)
#pragma unroll
        for (int i = 0; i < 16; ++i) { const float pv = exp2f(st[kk][i] - mn); st[kk][i] = pv; rsum += pv; }
      lsum = lsum * alpha + rsum;
#pragma unroll
      for (int mt = 0; mt < 2; ++mt)
#pragma unroll
        for (int i = 0; i < 16; ++i) O[mt][i] *= alpha;
#pragma unroll
      for (int kk = 0; kk < 2; ++kk)
#pragma unroll
        for (int s = 0; s < 2; ++s) {
          const bf16x8 pb = pack8(st[kk], s);
#pragma unroll
          for (int mt = 0; mt < 2; ++mt) {
            const u16* vp = Vc + (mt * 32 + r) * LDT + kk * 32 + 16 * s + 4 * h;
            O[mt] = MFMA(ld2x64(vp, vp + 8), pb, O[mt]);
          }
        }
      if (kt + 1 < ntiles) { *(u32x4*)(Ks + (cur ^ 1) * 64 * LDT + lr * LDT + lc) = rk; *(u32x4*)(Vs + (cur ^ 1) * 64 * LDT + lr * LDT + lc) = rv; }
      __syncthreads();
    }
  }
  lsum += __shfl_xor(lsum, 32);
  const float inv = 1.f / lsum;
  u16* op = P + qrow * NP + PC_AQ + hq * 64 + 4 * h;
  const u16* zp = P + qrow * NP + PC_AZ + hq * 64 + 4 * h;
#pragma unroll
  for (int mt = 0; mt < 2; ++mt)
#pragma unroll
    for (int gg = 0; gg < 4; ++gg) {
      const u32x2 zz = *(const u32x2*)(zp + mt * 32 + 8 * gg);
      u32x2 out;
      out.x = pack2(O[mt][4 * gg] * inv * silu_f(bflo(zz.x)), O[mt][4 * gg + 1] * inv * silu_f(bfhi(zz.x)));
      out.y = pack2(O[mt][4 * gg + 2] * inv * silu_f(bflo(zz.y)), O[mt][4 * gg + 3] * inv * silu_f(bfhi(zz.y)));
      if (!dry) *(u32x2*)(op + mt * 32 + 8 * gg) = out;
    }
}

template <int KSU>
DI void gemm_gate3(const u16* __restrict__ A, const u16* __restrict__ WM, char* smem, f32x16 (&acc)[3][2]) {
  u16* As0 = (u16*)smem;
  u16* As1 = As0 + 128 * LDT;
  u16* Bs0 = As0 + 2 * 128 * LDT;
  u16* Bs1 = Bs0 + 384 * LDT;
  const int tid = my_tid(), lane = tid & 63, wid = tid >> 6, r = lane & 31, h = lane >> 5, wm = wid & 3, wn = wid >> 2;
  u32x4 ra0[2], rb0[6], ra1[2], rb1[6];
  auto fetch = [&](u32x4 (&ra)[2], u32x4 (&rb)[6], int k0) {
#pragma unroll
    for (int i = 0; i < 2; ++i) { const int q = tid + NT * i; const unsigned off = (unsigned)((q >> 3) * 1024 + (q & 7) * 8); ra[i] = *(const u32x4*)(A + off + k0); }
#pragma unroll
    for (int i = 0; i < 6; ++i) {
      const int q = tid + NT * i, row = q >> 3;
      const unsigned off = (unsigned)((row >> 7) * (1024 * 1024) + (row & 127) * 1024 + (q & 7) * 8);
      rb[i] = *(const u32x4*)(WM + off + k0);
    }
    GFENCE;
  };
  auto commit = [&](const u32x4 (&ra)[2], const u32x4 (&rb)[6], u16* As, u16* Bs) {
#pragma unroll
    for (int i = 0; i < 2; ++i) { const int q = tid + NT * i; *(u32x4*)(As + (q >> 3) * LDT + (q & 7) * 8) = ra[i]; }
#pragma unroll
    for (int i = 0; i < 6; ++i) { const int q = tid + NT * i; *(u32x4*)(Bs + (q >> 3) * LDT + (q & 7) * 8) = rb[i]; }
    GFENCE;
  };
  auto compute = [&](const u16* Ac, const u16* Bc) {
#pragma unroll KSU
    for (int ks = 0; ks < 4; ++ks) {
      const bf16x8 a = *(const bf16x8*)(Ac + (wm * 32 + r) * LDT + ks * 16 + h * 8);
#pragma unroll
      for (int br = 0; br < 3; ++br)
#pragma unroll
        for (int j = 0; j < 2; ++j)
          acc[br][j] = MFMA(a, *(const bf16x8*)(Bc + (br * 128 + wn * 64 + j * 32 + r) * LDT + ks * 16 + h * 8), acc[br][j]);
    }
  };
  constexpr int KT = 16;
  fetch(ra0, rb0, 0);
  fetch(ra1, rb1, 64);
  __syncthreads();
  commit(ra0, rb0, As0, Bs0);
  __syncthreads();
  fetch(ra0, rb0, 128);
#pragma unroll
  for (int kt = 0; kt < KT; kt += 2) {
    commit(ra1, rb1, As1, Bs1);
    if (kt + 3 < KT) fetch(ra1, rb1, (kt + 3) * 64);
    compute(As0, Bs0);
    __syncthreads();
    if (kt + 2 < KT) commit(ra0, rb0, As0, Bs0);
    if (kt + 4 < KT) fetch(ra0, rb0, (kt + 4) * 64);
    compute(As1, Bs1);
    __syncthreads();
  }
}
DI void phase_merge(const Params& p, int l, char* smem) {
  const int tid = my_tid(), lane = tid & 63, wid = tid >> 6, r = lane & 31, h = lane >> 5, wm = wid & 3, wn = wid >> 2;
  const int xcd = blockIdx.x & 7, nloc = gridDim.x >> 3;
  for (int q = blockIdx.x >> 3; q < 33 * 8; q += nloc) {
    const int mt = (q >> 3) * 8 + xcd, nt = q & 7, m0 = mt * 128, n0 = nt * 128;
    if (mt >= 260) continue;
    const int b = m0 / TB, tk0 = m0 - b * TB;
    if (l == 1 && tk0 < LC) continue;
    const u16* H = (const u16*)(p.ws + OFF_H) + (size_t)m0 * 1024;
    const u16* WM = (const u16*)(p.ws + OFF_WT + (size_t)l * WT_LAYER) + (size_t)(4896 + n0) * 1024;
    const u16* WBR = (const u16*)(p.ws + OFF_WT + (size_t)l * WT_LAYER + WT_IN) + (size_t)n0 * 512;
    unsigned gp[3][2][8];
    {
      f32x16 g3[3][2];
#pragma unroll
      for (int br = 0; br < 3; ++br) for (int j = 0; j < 2; ++j) g3[br][j] = zero16();
      gemm_gate3<2>(H, WM, smem, g3);
#pragma unroll
      for (int br = 0; br < 3; ++br)
#pragma unroll
        for (int j = 0; j < 2; ++j)
#pragma unroll
          for (int i = 0; i < 8; ++i)
            gp[br][j][i] = pack2(1.f / (1.f + __expf(-g3[br][j][2 * i])), 1.f / (1.f + __expf(-g3[br][j][2 * i + 1])));
    }
    f32x16 ysum[2] = {zero16(), zero16()};
#pragma unroll
    for (int br = 0; br < 3; ++br) {
      f32x16 ab[1][2] = {{zero16(), zero16()}};
      if (br < 2) {
        ALoadN ay{(const u16*)(p.ws + OFF_P) + (size_t)m0 * NP + (br == 0 ? PC_GZ : PC_AQ), NP};
        gemm_tile<128, ALoadN, 4, 512>(ay, WBR + (size_t)br * 1024 * 512, 512, smem, ab);
      } else {
        ALoadT ay{(const u16*)(p.ws + OFF_CT) + ((size_t)CH_YZ * 2 + b) * TB + tk0, (size_t)2 * TB};
        gemm_tile<128, ALoadT, 4, 512>(ay, WBR + (size_t)2 * 1024 * 512, 512, smem, ab);
      }
#pragma unroll
      for (int j = 0; j < 2; ++j)
#pragma unroll
        for (int i = 0; i < 8; ++i) {
          ysum[j][2 * i] += bflo(gp[br][j][i]) * ab[0][j][2 * i];
          ysum[j][2 * i + 1] += bfhi(gp[br][j][i]) * ab[0][j][2 * i + 1];
        }
    }
    u16* Y = (u16*)(p.ws + OFF_Y) + (size_t)(m0 + wm * 32 + 4 * h) * 1024 + n0 + wn * 64 + r;
#pragma unroll
    for (int j = 0; j < 2; ++j)
#pragma unroll
      for (int reg = 0; reg < 16; ++reg) Y[(size_t)((reg & 3) + 8 * (reg >> 2)) * 1024 + j * 32] = f2bf(ysum[j][reg]);
  }
}

DI void phase_out(const Params& p, int l, char* smem) {
  const int tid = my_tid(), lane = tid & 63, wid = tid >> 6, r = lane & 31, h = lane >> 5, wm = wid & 3, wn = wid >> 2;
  const u16* Yb = (const u16*)(p.ws + OFF_Y);
  const u16* WO = (const u16*)(p.ws + OFF_WT + (size_t)l * WT_LAYER + WT_IN + 3 * WT_BR);
  const float* mod = (const float*)(p.ws + OFF_MOD);
  const int xcd = blockIdx.x & 7, nloc = gridDim.x >> 3;
  auto tile_of = [&](int q, int& m0, int& n0) -> bool {
    const int mt = (q >> 3) * 8 + xcd; m0 = mt * 128; n0 = (q & 7) * 128;
    if (mt >= 260) return false;
    const int b = m0 / TB, tk0 = m0 - b * TB;
    return !(l == 1 && tk0 < LC);
  };
  auto next_q = [&](int q) -> int { int m, n; for (q += nloc; q < 33 * 8; q += nloc) if (tile_of(q, m, n)) return q; return -1; };
  int q = (int)(blockIdx.x >> 3) - nloc; q = next_q(q);
  if (q < 0) return;
  int m0, n0; tile_of(q, m0, n0);
  GemmRegs<128> gr;
  { ALoadN ay{Yb + (size_t)m0 * 1024, 1024}; gemm_prime<128>(gr, ay, WO + (size_t)n0 * 1024, 1024, smem); }
  while (true) {
    const int qn = next_q(q);
    int m0n = 0, n0n = 0; if (qn >= 0) tile_of(qn, m0n, n0n);
    const int b = m0 / TB, tk0 = m0 - b * TB;
    f32x16 acc[1][2] = {{zero16(), zero16()}};
    const ALoadN ay{Yb + (size_t)m0 * 1024, 1024}, ayn{Yb + (size_t)m0n * 1024, 1024};
    gemm_run<128, ALoadN, 4, 1024, ALoadN>(gr, ay, WO + (size_t)n0 * 1024, 1024, ayn, WO + (size_t)n0n * 1024, 1024, qn >= 0, smem, acc);
    const float* gv = mod + (l * 3 + (tk0 < LC ? 2 : b)) * 3072 + 2048;
    const float* xin = xrow_in(p, l, m0);
    float* xout = xrow_out(p, m0);
#pragma unroll
    for (int j = 0; j < 2; ++j) {
      const int col = n0 + wn * 64 + j * 32 + r;
      const float gate = gv[col];
#pragma unroll
      for (int reg = 0; reg < 16; ++reg) {
        const size_t off = (size_t)(wm * 32 + crow(reg, h)) * D + col;
        xout[off] = xin[off] + gate * acc[0][j][reg];
      }
    }
    if (qn < 0) break;
    q = qn; m0 = m0n; n0 = n0n;
  }
}

DI void phase_final(const Params& p) {
  const int tid = my_tid(), lane = tid & 63, wid = tid >> 6;
  for (int row = blockIdx.x * 8 + wid; row < NBATCH * L; row += gridDim.x * 8) {
    float* src = p.out + (size_t)row * D;
    float4 xv[4]; float ss = 0.f;
#pragma unroll
    for (int i = 0; i < 4; ++i) { xv[i] = *(const float4*)(src + (i * 64 + lane) * 4); ss += xv[i].x * xv[i].x + xv[i].y * xv[i].y + xv[i].z * xv[i].z + xv[i].w * xv[i].w; }
    ss = wave_sum(ss);
    const float rs = rsqrtf(ss * (1.f / 1024.f) + EPS);
#pragma unroll
    for (int i = 0; i < 4; ++i) {
      const int col = (i * 64 + lane) * 4;
      const float4 fw = *(const float4*)(pk(p, PK_FN) + col);
      *(float4*)(src + col) = make_float4(xv[i].x * rs * fw.x, xv[i].y * rs * fw.y, xv[i].z * rs * fw.z, xv[i].w * rs * fw.w);
    }
  }
}

DI void run_phase(const Params& p, int ph, char* smem, int dry = 0) {
  const int bid = blockIdx.x, nb = gridDim.x;
  if (ph == 0) { phase0(p, smem); return; }
  if (ph == 17) { phase_final(p); return; }
  const int l = (ph - 1) >> 3, s = (ph - 1) & 7;
  switch (s) {
    case 0: phase_norm(p, l); break;
    case 1: phase_proj(p, l, smem); break;
    case 2: {
      attn_prep(p, l, dry);
      if (l == 0) for (int c = bid; c < 512; c += nb) hyena_ctx_task(p, l, c, smem, dry);
      for (int c = bid; c < 512; c += nb) hyena_latent_task(p, l, c, smem, dry);
    } break;
    case 3: for (int t = bid; t < 16 * NCK; t += nb) gla_g1_task(p, l, t / NCK, t % NCK, smem); break;
    case 4: gla_g2(p, dry); break;
    case 5: {
      for (int it = bid; it < 1024; it += nb) { const int b = it >> 9, g = (it >> 8) & 1, qb = it & 255; attn_item(p, l, b, g, LC + qb * 64, NCK, smem, dry); }
      if (l == 0) for (int it = bid; it < 16; it += nb) { const int b = it >> 3, g = (it >> 2) & 1, qb = it & 3; attn_item(p, l, b, g, qb * 64, 4, smem, dry); }
      const int c0 = (l == 0) ? 0 : 4, per = NCK - c0;
      for (int t = bid; t < 8 * per; t += nb) { const int bh = t / per, ci = c0 + t % per; gla_g3_task(p, l, bh >> 2, bh & 3, ci, smem, dry); }
    } break;
    case 6: phase_merge(p, l, smem); break;
    case 7: phase_out(p, l, smem); break;
  }
}

#if MULTI_LAUNCH
template <int PH> __global__ void __launch_bounds__(NT) phase_kernel(Params p) {
  extern __shared__ __attribute__((aligned(16))) char smem[];
  run_phase(p, PH, smem);
}
template <int PH> static void launch_phase(const Params& p, int grid, hipStream_t stream) {
  static bool attr = false;
  if (!attr) { (void)hipFuncSetAttribute((const void*)phase_kernel<PH>, hipFuncAttributeMaxDynamicSharedMemorySize, LDS_BYTES); attr = true; }
  hipLaunchKernelGGL(phase_kernel<PH>, dim3(grid), dim3(NT), LDS_BYTES, stream, p);
}
#else
DI unsigned xb_ld(unsigned* q) { return __hip_atomic_load(q, __ATOMIC_RELAXED, __HIP_MEMORY_SCOPE_AGENT); }
DI unsigned xb_add(unsigned* q, unsigned v) { return __hip_atomic_fetch_add(q, v, __ATOMIC_RELAXED, __HIP_MEMORY_SCOPE_AGENT); }
DI unsigned xb_xcc_id() { return (unsigned)__builtin_amdgcn_s_getreg((3 << 11) | 20) & 0xFu; }
#define XB_SPIN(cond) do { unsigned sp_ = 0; while ((cond) && ++sp_ < 400000u) __builtin_amdgcn_s_sleep(1); } while (0)
DI void gbar_census(const Params& p) {
  if (threadIdx.x == 0) (void)xb_add((unsigned*)(p.ws + OFF_BAR) + xb_xcc_id() * 64, 1u);
}
DI void gbar_setup(const Params& p, char* smem) {
  if (threadIdx.x == 0) {
    unsigned* bar = (unsigned*)(p.ws + OFF_BAR);
    const unsigned x = xb_xcc_id();
    unsigned mine = 1u, cnt = 0u;
    for (unsigned j = 0; j < 16; ++j) { const unsigned c = xb_ld(bar + j * 64); cnt += (c > 0u) ? 1u : 0u; if (j == x) mine = c; }
    volatile unsigned* st = (volatile unsigned*)(smem + BAR_LDS);
    st[0] = mine > 0u ? mine : 1u; st[1] = cnt > 0u ? cnt : 1u;
  }
  __syncthreads();
}
DI void gbar(const Params& p, unsigned k, char* smem) {
  asm volatile("s_waitcnt vmcnt(0)" ::: "memory");
  __syncthreads();
  if (threadIdx.x == 0) {
    unsigned* bar = (unsigned*)(p.ws + OFF_BAR);
    volatile unsigned* st = (volatile unsigned*)(smem + BAR_LDS);
    const unsigned nloc = st[0], nx = st[1], x = xb_xcc_id();
    __builtin_amdgcn_s_waitcnt(0);
    const unsigned old = xb_add(bar + (16 + x) * 64, 1u);
    if (old + 1u == k * nloc) {
      __builtin_amdgcn_fence(__ATOMIC_RELEASE, "agent");
      asm volatile("s_waitcnt vmcnt(0)" ::: "memory");
      const unsigned og = xb_add(bar + 48 * 64, 1u);
      if (og + 1u == k * nx) xb_add(bar + 49 * 64, 1u);
      else XB_SPIN(xb_ld(bar + 49 * 64) < k);
      __builtin_amdgcn_fence(__ATOMIC_ACQUIRE, "agent");
      xb_add(bar + (32 + x) * 64, 1u);
      asm volatile("s_waitcnt vmcnt(0)" ::: "memory");
    } else {
      XB_SPIN(xb_ld(bar + (32 + x) * 64) < k);
      __builtin_amdgcn_fence(__ATOMIC_ACQUIRE, "agent");
      asm volatile("s_waitcnt vmcnt(0)" ::: "memory");
    }
  }
  __syncthreads();
}
#ifndef PROBE_DUP
#define PROBE_DUP -1
#endif
#ifndef PROBE_DUP2
#define PROBE_DUP2 -1
#endif
#ifndef PROBE_DUP3
#define PROBE_DUP3 -1
#endif
__global__ void __launch_bounds__(NT) fwd_kernel(Params p) {
  extern __shared__ __attribute__((aligned(16))) char smem[];
  cg::grid_group grid = cg::this_grid();
#if PROBE_DUP >= 0
#define PHS(n) if ((n) == PROBE_DUP || (n) == PROBE_DUP2 || (n) == PROBE_DUP3) { run_phase(p, n, smem, p.phase_lo == 0 ? 1 : 0); grid.sync(); } run_phase(p, n, smem); grid.sync();
#else
#define PHS(n) run_phase(p, n, smem); if ((n) == 0) { grid.sync(); gbar_setup(p, smem); } else gbar(p, (unsigned)(n), smem);
#endif
  gbar_census(p);
  PHS(0) PHS(1) PHS(2) PHS(3) PHS(4) PHS(5) PHS(6) PHS(7) PHS(8)
  PHS(9) PHS(10) PHS(11) PHS(12) PHS(13) PHS(14) PHS(15) PHS(16)
  run_phase(p, 17, smem);
}
#endif

extern "C" void kernel_launch(void* const* d_in, const int* in_sizes, int n_in, void* d_out, int out_size, void* d_ws, size_t ws_size,
                              hipStream_t stream) {
  static int grid = 0;
  if (grid == 0) {
    if (n_in != 29 || ws_size < WS_END) { fprintf(stderr, "kernel_launch: need 29 inputs and %zu B of workspace, got %d / %zu\n", (size_t)WS_END, n_in, ws_size); grid = -1; return; }
#if MULTI_LAUNCH
    grid = 256;
#else
    int dev = 0, cus = 0, per_cu = 0;
    (void)hipGetDevice(&dev);
    (void)hipDeviceGetAttribute(&cus, hipDeviceAttributeMultiprocessorCount, dev);
    if (hipFuncSetAttribute((const void*)fwd_kernel, hipFuncAttributeMaxDynamicSharedMemorySize, LDS_BYTES) != hipSuccess) { fprintf(stderr, "kernel_launch: hipFuncSetAttribute failed\n"); grid = -1; return; }
    (void)hipOccupancyMaxActiveBlocksPerMultiprocessor(&per_cu, (const void*)fwd_kernel, NT, LDS_BYTES);
    if (per_cu < 1) { fprintf(stderr, "kernel_launch: occupancy query returned %d\n", per_cu); per_cu = 1; }
    (void)hipGetLastError();
    grid = cus * per_cu;
    if (grid > 256) grid = 256;
#endif
  }
  if (grid < 0) return;
  Params p{};
  const float** pp = (const float**)&p;
  for (int i = 0; i < 29; ++i) pp[i] = (const float*)d_in[i];
  p.out = (float*)d_out; p.ws = (char*)d_ws;
  p.phase_lo = 0; p.phase_hi = 18;
#if MULTI_LAUNCH
  launch_phase<0>(p, grid, stream); launch_phase<1>(p, grid, stream); launch_phase<2>(p, grid, stream); launch_phase<3>(p, grid, stream);
  launch_phase<4>(p, grid, stream); launch_phase<5>(p, grid, stream); launch_phase<6>(p, grid, stream); launch_phase<7>(p, grid, stream);
  launch_phase<8>(p, grid, stream); launch_phase<9>(p, grid, stream); launch_phase<10>(p, grid, stream); launch_phase<11>(p, grid, stream);
  launch_phase<12>(p, grid, stream); launch_phase<13>(p, grid, stream); launch_phase<14>(p, grid, stream); launch_phase<15>(p, grid, stream);
  launch_phase<16>(p, grid, stream); launch_phase<17>(p, grid, stream);
#else
  if (hipMemsetAsync((char*)d_ws + OFF_BAR, 0, BAR_BYTES, stream) != hipSuccess) { fprintf(stderr, "kernel_launch: barrier memset failed\n"); return; }
  void* args[] = {&p};
  hipError_t e = hipLaunchCooperativeKernel((const void*)fwd_kernel, dim3(grid), dim3(NT), args, LDS_BYTES, stream);
  if (e != hipSuccess) fprintf(stderr, "kernel_launch: cooperative launch failed: %s (grid %d)\n", hipGetErrorString(e), grid);
#endif
}
```

```cpp
#include <hip/hip_runtime.h>
#include <hip/hip_cooperative_groups.h>
#include <cstdio>
namespace cg = cooperative_groups;

typedef unsigned short u16;
typedef __attribute__((ext_vector_type(8))) short bf16x8;
typedef __attribute__((ext_vector_type(16))) float f32x16;
typedef __attribute__((ext_vector_type(4))) unsigned u32x4;
typedef __attribute__((ext_vector_type(2))) unsigned u32x2;
#define DI __device__ __forceinline__
#define MFMA(a, b, c) __builtin_amdgcn_mfma_f32_32x32x16_bf16((a), (b), (c), 0, 0, 0)

#ifndef MULTI_LAUNCH
#define MULTI_LAUNCH 0
#endif

constexpr int D = 1024, NBATCH = 2, L = 16384, LC = 256, TB = L + LC, R = NBATCH * TB;
constexpr int NIN = 7968;
constexpr int NP = 2208;
constexpr int NCH = 2688;
constexpr int PC_GQ = 0, PC_GK = 256, PC_GZ = 512, PC_AF = 1024, PC_AQ = 1056, PC_AK = 1568, PC_AZ = 1696;
constexpr int CH_YU = 0, CH_YZ = 1536, CH_GV = 2048, CH_AV = 2560;
constexpr int NCK = 260;
constexpr float EPS = 1e-6f;
constexpr int NT = 512;
constexpr int LDT = 72;

constexpr size_t OFF_P = 0;
constexpr size_t OFF_CT = OFF_P + (size_t)R * NP * 2;
constexpr size_t OFF_H = OFF_CT + (size_t)NCH * 2 * TB * 2;
constexpr size_t OFF_FS = OFF_H + (size_t)R * 1024 * 2;
constexpr size_t OFF_WT = OFF_FS + (size_t)256 * 262144;
constexpr size_t WT_IN = (size_t)NIN * 1024 * 2, WT_BR = (size_t)1024 * 512 * 2, WT_OUT = (size_t)1024 * 1024 * 2;
constexpr size_t WT_LAYER = WT_IN + 3 * WT_BR + WT_OUT;
constexpr size_t OFF_H2T = OFF_WT + 2 * WT_LAYER;
constexpr size_t OFF_H2C = OFF_H2T + (size_t)2 * 64 * L * 4;
constexpr size_t OFF_MOD = OFF_H2C + (size_t)2 * 256 * 64 * 4;
constexpr size_t OFF_CTX1 = OFF_MOD + (size_t)2 * 3 * 3072 * 4;
constexpr size_t OFF_GD = OFF_CTX1 + (size_t)512 * 1024 * 4;
constexpr size_t OFF_PK = OFF_GD + (size_t)16 * NCK * 64 * 4;
constexpr int PK_WAF = 0, PK_BAF = 8192, PK_WAB = 8704, PK_BAB = 16896, PK_GN = 17408, PK_QN = 17664, PK_KN = 17792, PK_CW = 17920,
              PK_CB = 27136, PK_SK = 30208, PK_FN = 32256, PK_F3 = 33280, PK_END = 33280 + 262144;
constexpr size_t OFF_BAR = OFF_PK + (size_t)PK_END * 4;
constexpr size_t BAR_BYTES = 50 * 256;
constexpr size_t WS_END = OFF_BAR + 16384;
constexpr int BAR_LDS = 147456 + 256;
constexpr size_t OFF_GS = OFF_CT;
constexpr size_t OFF_Y = OFF_CT;
static_assert((size_t)16 * NCK * 8192 * 2 <= (size_t)1536 * 2 * TB * 2, "alias");
static_assert((size_t)R * 1024 * 2 <= (size_t)1536 * 2 * TB * 2, "alias");

constexpr int LDS_BYTES = 2 * (128 + 384) * 72 * 2 + 512;

struct Params {
  const float *x, *c, *ctx, *c_ctx, *w_ada, *b_ada, *w_in, *wa_f, *ba_f, *wa_b, *ba_b, *gla_norm, *qnorm, *knorm,
      *conv_w, *conv_b, *f1_w, *f1_b, *f1_freq, *f2_w, *f2_b, *f2_freq, *f3_w, *skip, *w_g, *w_a, *w_h, *w_o, *final_norm;
  float* out;
  char* ws;
  long long phase_lo, phase_hi;
};

typedef __attribute__((ext_vector_type(2))) float f32x2v;
typedef __attribute__((ext_vector_type(2))) __bf16 bf16x2v;
DI int my_tid() {
  int t = (int)threadIdx.x;
  asm volatile("" : "+v"(t));
  __builtin_assume(t >= 0 && t < NT);
  return t;
}
DI u16 f2bf(float x) { return __builtin_bit_cast(u16, (__bf16)x); }
DI float bf2f(u16 v) { return __uint_as_float(((unsigned)v) << 16); }
DI unsigned pack2(float a, float b) { f32x2v v = {a, b}; return __builtin_bit_cast(unsigned, __builtin_convertvector(v, bf16x2v)); }
DI float bflo(unsigned u) { return __uint_as_float(u << 16); }
DI float bfhi(unsigned u) { return __uint_as_float(u & 0xffff0000u); }
DI float silu_f(float x) { return x / (1.f + __expf(-x)); }
DI float wave_sum(float v) {
#pragma unroll
  for (int o = 32; o >= 1; o >>= 1) v += __shfl_xor(v, o);
  return v;
}
DI int crow(int reg, int h) { return (reg & 3) + 8 * (reg >> 2) + 4 * h; }
DI f32x16 zero16() { f32x16 z; for (int i = 0; i < 16; ++i) z[i] = 0.f; return z; }
DI bf16x8 pack8(const f32x16& x, int s) {
  u32x4 u;
  u.x = pack2(x[8 * s + 0], x[8 * s + 1]); u.y = pack2(x[8 * s + 2], x[8 * s + 3]);
  u.z = pack2(x[8 * s + 4], x[8 * s + 5]); u.w = pack2(x[8 * s + 6], x[8 * s + 7]);
  return __builtin_bit_cast(bf16x8, u);
}
DI bf16x8 ld2x64(const u16* p0, const u16* p1) {
  u32x2 a = *(const u32x2*)p0, b = *(const u32x2*)p1;
  u32x4 u; u.x = a.x; u.y = a.y; u.z = b.x; u.w = b.y;
  return __builtin_bit_cast(bf16x8, u);
}
DI float2 cmul(float2 a, float2 b) { return make_float2(a.x * b.x - a.y * b.y, a.x * b.y + a.y * b.x); }
DI float2 cadd(float2 a, float2 b) { return make_float2(a.x + b.x, a.y + b.y); }
DI float2 csub(float2 a, float2 b) { return make_float2(a.x - b.x, a.y - b.y); }

DI const float* xrow_in(const Params& p, int layer, int row) {
  int b = row / TB, tk = row - b * TB;
  if (tk < LC) return (layer == 0 ? p.ctx : (const float*)(p.ws + OFF_CTX1)) + (size_t)(b * LC + tk) * D;
  return (layer == 0 ? p.x : (const float*)p.out) + (size_t)(b * L + tk - LC) * D;
}
DI float* xrow_out(const Params& p, int row) {
  int b = row / TB, tk = row - b * TB;
  if (tk < LC) return (float*)(p.ws + OFF_CTX1) + (size_t)(b * LC + tk) * D;
  return p.out + (size_t)(b * L + tk - LC) * D;
}
DI const float* pk(const Params& p, int off) { return (const float*)(p.ws + OFF_PK) + off; }
DI int modvec_of(int row) { int b = row / TB, tk = row - b * TB; return tk < LC ? 2 : b; }

struct ALoadN {
  const u16* A; int lda;
  template <int BM> DI void fetch(u32x4 (&r)[BM / 64], int k0, int tid) const {
#pragma unroll
    for (int i = 0; i < BM / 64; ++i) { const int q = tid + NT * i; const unsigned off = (unsigned)((q >> 3) * lda + (q & 7) * 8); r[i] = *(const u32x4*)(A + off + k0); }
  }
  template <int BM> DI void commit(const u32x4 (&r)[BM / 64], u16* As, int tid) const {
#pragma unroll
    for (int i = 0; i < BM / 64; ++i) { int q = tid + NT * i; *(u32x4*)(As + (q >> 3) * LDT + (q & 7) * 8) = r[i]; }
  }
};
struct ALoadT {
  const u16* A; size_t chs;
  template <int BM> DI void fetch(u32x4 (&r)[BM / 64], int k0, int tid) const {
#pragma unroll
    for (int i = 0; i < 2; ++i) { const int q = tid + NT * i; const unsigned off = (unsigned)((q >> 4) * (int)chs + (q & 15) * 8); r[i] = *(const u32x4*)(A + off + (unsigned)(k0 * (int)chs)); }
  }
  template <int BM> DI void commit(const u32x4 (&r)[BM / 64], u16* As, int tid) const {
#pragma unroll
    for (int i = 0; i < 2; ++i) {
      int q = tid + NT * i; int ch = q >> 4, t0 = (q & 15) * 8;
      unsigned w[4] = {r[i].x, r[i].y, r[i].z, r[i].w};
#pragma unroll
      for (int e = 0; e < 4; ++e) { As[(t0 + 2 * e) * LDT + ch] = (u16)(w[e] & 0xffffu); As[(t0 + 2 * e + 1) * LDT + ch] = (u16)(w[e] >> 16); }
    }
  }
};

template <int BM, int KSU>
DI void gemm_compute(const u16* Ac, const u16* Bc, int wm, int wn, int r, int h, f32x16 (&acc)[BM / 128][2]) {
#pragma unroll KSU
  for (int ks = 0; ks < 4; ++ks) {
    bf16x8 a[BM / 128], b[2];
#pragma unroll
    for (int i = 0; i < BM / 128; ++i) a[i] = *(const bf16x8*)(Ac + (wm * (BM / 4) + i * 32 + r) * LDT + ks * 16 + h * 8);
#pragma unroll
    for (int j = 0; j < 2; ++j) b[j] = *(const bf16x8*)(Bc + (wn * 64 + j * 32 + r) * LDT + ks * 16 + h * 8);
#pragma unroll
    for (int i = 0; i < BM / 128; ++i)
#pragma unroll
      for (int j = 0; j < 2; ++j) acc[i][j] = MFMA(a[i], b[j], acc[i][j]);
  }
}
DI void fetch_b(u32x4 (&rb)[2], const u16* Bt, int ldb, int k0, int tid) {
#pragma unroll
  for (int i = 0; i < 2; ++i) { const int q = tid + NT * i; const unsigned off = (unsigned)((q >> 3) * ldb + (q & 7) * 8); rb[i] = *(const u32x4*)(Bt + off + k0); }
}
DI void commit_b(const u32x4 (&rb)[2], u16* Bs, int tid) {
#pragma unroll
  for (int i = 0; i < 2; ++i) { int q = tid + NT * i; *(u32x4*)(Bs + (q >> 3) * LDT + (q & 7) * 8) = rb[i]; }
}
template <int BM> struct GemmRegs { u32x4 ra0[BM / 64], rb0[2], ra1[BM / 64], rb1[2]; };
#define GFENCE asm volatile("" ::: "memory")
template <int BM, class AL>
DI void gemm_prime(GemmRegs<BM>& g, const AL& al, const u16* __restrict__ Bt, int ldb, char* smem) {
  u16* As0 = (u16*)smem;
  u16* Bs0 = As0 + 2 * BM * LDT;
  const int tid = my_tid();
  al.template fetch<BM>(g.ra0, 0, tid); fetch_b(g.rb0, Bt, ldb, 0, tid); GFENCE;
  al.template fetch<BM>(g.ra1, 64, tid); fetch_b(g.rb1, Bt, ldb, 64, tid); GFENCE;
  __syncthreads();
  al.template commit<BM>(g.ra0, As0, tid); commit_b(g.rb0, Bs0, tid);
  __syncthreads();
  al.template fetch<BM>(g.ra0, 128, tid); fetch_b(g.rb0, Bt, ldb, 128, tid); GFENCE;
}
template <int BM, class AL, int KSU, int K, class ALN>
DI void gemm_run(GemmRegs<BM>& g, const AL& al, const u16* __restrict__ Bt, int ldb, const ALN& aln, const u16* __restrict__ Btn, int ldbn,
                 bool hasnext, char* smem, f32x16 (&acc)[BM / 128][2]) {
  u16* As0 = (u16*)smem;
  u16* As1 = As0 + BM * LDT;
  u16* Bs0 = As0 + 2 * BM * LDT;
  u16* Bs1 = Bs0 + 128 * LDT;
  const int tid = my_tid(), lane = tid & 63, wid = tid >> 6, r = lane & 31, h = lane >> 5;
  const int wm = wid & 3, wn = wid >> 2;
  constexpr int KT = K >> 6;
#pragma unroll
  for (int kt = 0; kt < KT; kt += 2) {
    al.template commit<BM>(g.ra1, As1, tid); commit_b(g.rb1, Bs1, tid);
    GFENCE;
    if (kt + 3 < KT) { al.template fetch<BM>(g.ra1, (kt + 3) * 64, tid); fetch_b(g.rb1, Bt, ldb, (kt + 3) * 64, tid); GFENCE; }
    else if (hasnext) { aln.template fetch<BM>(g.ra1, (kt + 3 - KT) * 64, tid); fetch_b(g.rb1, Btn, ldbn, (kt + 3 - KT) * 64, tid); GFENCE; }
    gemm_compute<BM, KSU>(As0, Bs0, wm, wn, r, h, acc);
    __syncthreads();
    if (kt + 2 < KT) { al.template commit<BM>(g.ra0, As0, tid); commit_b(g.rb0, Bs0, tid); GFENCE; }
    else if (hasnext) { aln.template commit<BM>(g.ra0, As0, tid); commit_b(g.rb0, Bs0, tid); GFENCE; }
    if (kt + 4 < KT) { al.template fetch<BM>(g.ra0, (kt + 4) * 64, tid); fetch_b(g.rb0, Bt, ldb, (kt + 4) * 64, tid); GFENCE; }
    else if (hasnext) { aln.template fetch<BM>(g.ra0, (kt + 4 - KT) * 64, tid); fetch_b(g.rb0, Btn, ldbn, (kt + 4 - KT) * 64, tid); GFENCE; }
    gemm_compute<BM, KSU>(As1, Bs1, wm, wn, r, h, acc);
    __syncthreads();
  }
}

template <int BM, class AL, int KSU = 4, int K = 1024>
DI void gemm_tile(const AL& al, const u16* __restrict__ Bt, int ldb, char* smem, f32x16 (&acc)[BM / 128][2]) {
  GemmRegs<BM> g;
  gemm_prime<BM>(g, al, Bt, ldb, smem);
  gemm_run<BM, AL, KSU, K, AL>(g, al, Bt, ldb, al, Bt, ldb, false, smem, acc);
}

DI void phase0(const Params& p, char* smem) {
  const int tid = my_tid(), lane = tid & 63, wid = tid >> 6, bid = blockIdx.x, nb = gridDim.x;
  float* sm = (float*)smem;
  {
    float* PKW = (float*)(p.ws + OFF_PK);
    const int gt = bid * NT + tid, gn = nb * NT;
#define PKCP(src, off, cnt) for (int i = gt; i < (cnt); i += gn) PKW[(off) + i] = (src)[i];
    PKCP(p.wa_f, PK_WAF, 8192) PKCP(p.ba_f, PK_BAF, 512) PKCP(p.wa_b, PK_WAB, 8192) PKCP(p.ba_b, PK_BAB, 512)
    PKCP(p.gla_norm, PK_GN, 256) PKCP(p.qnorm, PK_QN, 128) PKCP(p.knorm, PK_KN, 128) PKCP(p.conv_w, PK_CW, 9216)
    PKCP(p.conv_b, PK_CB, 3072) PKCP(p.skip, PK_SK, 2048) PKCP(p.final_norm, PK_FN, 1024) PKCP(p.f3_w, PK_F3, 262144)
#undef PKCP
  }
  float* mod = (float*)(p.ws + OFF_MOD);
  for (int task = bid; task < 96; task += nb) {
    const int l = task / 48, cb = task % 48, col = cb * 64 + lane;
    const float* W = p.w_ada + (size_t)l * 1024 * 3072;
    float a0 = 0.f, a1 = 0.f, a2 = 0.f;
#pragma unroll 8
    for (int k = wid * 128; k < wid * 128 + 128; ++k) {
      float wv = W[(size_t)k * 3072 + col];
      a0 += silu_f(p.c[k]) * wv; a1 += silu_f(p.c[1024 + k]) * wv; a2 += silu_f(p.c_ctx[k]) * wv;
    }
    __syncthreads();
    sm[(wid * 3 + 0) * 64 + lane] = a0; sm[(wid * 3 + 1) * 64 + lane] = a1; sm[(wid * 3 + 2) * 64 + lane] = a2;
    __syncthreads();
    if (tid < 192) {
      int v = tid >> 6; float s = p.b_ada[l * 3072 + col];
      for (int w = 0; w < 8; ++w) s += sm[(w * 3 + v) * 64 + lane];
      mod[(l * 3 + v) * 3072 + col] = s;
    }
    __syncthreads();
  }
  for (int it = bid; it < (2 * TB) / 8; it += nb) {
    const int gr = it * 8 + wid, l = gr / TB, rr = gr - l * TB;
    const bool lat = rr < L; const int t = lat ? rr : rr - L; const int Lq = lat ? L : LC;
    float* em = sm + wid * 104; float* h1 = em + 40;
    __syncthreads();
    if (lane < 33) {
      float v;
      if (lane == 0) v = (float)t / (float)(Lq - 1);
      else {
        int bi = (lane - 1) & 15; float fr = 1e-4f + (float)bi * ((15.f - 1e-4f) / 15.f);
        float w = 6.283185307179586f * (float)t / (float)Lq;
        v = (lane <= 16) ? cosf(fr * w) : -sinf(fr * w);
      }
      em[lane] = v;
    }
    __syncthreads();
    {
      float a = p.f1_b[l * 64 + lane];
      for (int e = 0; e < 33; ++e) a += em[e] * p.f1_w[(l * 33 + e) * 64 + lane];
      h1[lane] = sinf(p.f1_freq[l * 64 + lane] * a);
    }
    __syncthreads();
    {
      float a = p.f2_b[l * 64 + lane];
      for (int i = 0; i < 64; ++i) a += h1[i] * p.f2_w[(l * 64 + i) * 64 + lane];
      float v = sinf(p.f2_freq[l * 64 + lane] * a);
      if (lat) ((u16*)(p.ws + OFF_H2T))[((size_t)l * 64 + lane) * L + t] = f2bf(v);
      else ((float*)(p.ws + OFF_H2C))[((size_t)l * 256 + t) * 64 + lane] = v;
    }
  }
  __syncthreads();
  {
    constexpr int T_IN = 16 * 249, T_BR = 8 * 32, T_OUT = 16 * 32, T_LAYER = T_IN + 3 * T_BR + T_OUT;
    auto decode = [&](int task, const float*& src, u16*& dst, int& K, int& N, int& k0, int& n0) {
      const int l = task / T_LAYER; int tt = task - l * T_LAYER;
      char* wt = p.ws + OFF_WT + (size_t)l * WT_LAYER;
      int kt, ntile;
      if (tt < T_IN) { src = p.w_in + (size_t)l * 1024 * NIN; dst = (u16*)wt; K = 1024; N = NIN; kt = tt / 249; ntile = tt % 249; }
      else if (tt < T_IN + 3 * T_BR) {
        tt -= T_IN; const int br = tt / T_BR; tt -= br * T_BR;
        src = (br == 0 ? p.w_g : (br == 1 ? p.w_a : p.w_h)) + (size_t)l * 512 * 1024; dst = (u16*)(wt + WT_IN + br * WT_BR);
        K = 512; N = 1024; kt = tt / 32; ntile = tt % 32;
      } else { tt -= T_IN + 3 * T_BR; src = p.w_o + (size_t)l * 1024 * 1024; dst = (u16*)(wt + WT_IN + 3 * WT_BR); K = 1024; N = 1024; kt = tt / 32; ntile = tt % 32; }
      k0 = kt * 64; n0 = ntile * 32;
    };
    float* tileA = sm;
    float* tileB = sm + 64 * 33;
    for (int task = bid; task < 2 * T_LAYER; task += 2 * nb) {
      const bool hasB = task + nb < 2 * T_LAYER;
      const float *sa, *sb = nullptr; u16 *da, *db = nullptr; int Ka, Na, k0a, n0a, Kb = 0, Nb = 0, k0b = 0, n0b = 0;
      decode(task, sa, da, Ka, Na, k0a, n0a);
      if (hasB) decode(task + nb, sb, db, Kb, Nb, k0b, n0b);
      float va[4], vb[4];
#pragma unroll
      for (int i = 0; i < 4; ++i) { const int kk = (tid >> 5) + 16 * i, nn = tid & 31; va[i] = sa[(size_t)(k0a + kk) * Na + n0a + nn]; vb[i] = hasB ? sb[(size_t)(k0b + kk) * Nb + n0b + nn] : 0.f; }
#pragma unroll
      for (int i = 0; i < 4; ++i) { const int kk = (tid >> 5) + 16 * i, nn = tid & 31; tileA[kk * 33 + nn] = va[i]; tileB[kk * 33 + nn] = vb[i]; }
      __syncthreads();
#pragma unroll
      for (int i = 0; i < 4; ++i) {
        const int nn = (tid >> 6) + 8 * i, kk = tid & 63;
        da[(size_t)(n0a + nn) * Ka + k0a + kk] = f2bf(tileA[kk * 33 + nn]);
        if (hasB) db[(size_t)(n0b + nn) * Kb + k0b + kk] = f2bf(tileB[kk * 33 + nn]);
      }
      __syncthreads();
    }
  }
}

DI void phase_norm(const Params& p, int l) {
  const int tid = my_tid(), lane = tid & 63, wid = tid >> 6;
  const float* mod = (const float*)(p.ws + OFF_MOD);
  u16* H = (u16*)(p.ws + OFF_H);
  for (int row = blockIdx.x * 8 + wid; row < R; row += gridDim.x * 8) {
    const float* src = xrow_in(p, l, row);
    const float* mv = mod + (l * 3 + modvec_of(row)) * 3072;
    float4 xv[4]; float ss = 0.f;
#pragma unroll
    for (int i = 0; i < 4; ++i) { xv[i] = *(const float4*)(src + (i * 64 + lane) * 4); ss += xv[i].x * xv[i].x + xv[i].y * xv[i].y + xv[i].z * xv[i].z + xv[i].w * xv[i].w; }
    ss = wave_sum(ss);
    const float rs = rsqrtf(ss * (1.f / 1024.f) + EPS);
#pragma unroll
    for (int i = 0; i < 4; ++i) {
      const int col = (i * 64 + lane) * 4;
      float4 sh = *(const float4*)(mv + col), sc = *(const float4*)(mv + 1024 + col);
      u32x2 o;
      o.x = pack2(xv[i].x * rs * (1.f + sc.x) + sh.x, xv[i].y * rs * (1.f + sc.y) + sh.y);
      o.y = pack2(xv[i].z * rs * (1.f + sc.z) + sh.z, xv[i].w * rs * (1.f + sc.w) + sh.w);
      *(u32x2*)(H + (size_t)row * 1024 + col) = o;
    }
  }
}

DI void phase_proj(const Params& p, int l, char* smem) {
  const int tid = my_tid(), lane = tid & 63, wid = tid >> 6, r = lane & 31, h = lane >> 5, wm = wid & 3, wn = wid >> 2;
  const u16* H = (const u16*)(p.ws + OFF_H);
  const u16* WT = (const u16*)(p.ws + OFF_WT + (size_t)l * WT_LAYER);
  u16* P = (u16*)(p.ws + OFF_P);
  u16* CT = (u16*)(p.ws + OFF_CT);
  u16* Tt = (u16*)smem;
  constexpr int LDE = 260;
  const int xcd = blockIdx.x & 7, nloc = gridDim.x >> 3, local = blockIdx.x >> 3;
  const int nreg = local < 624 ? (624 - local + nloc - 1) / nloc : 0;
  const int r0 = 624 % nloc;
  const int nlight = (r0 == 0 ? nloc : nloc - r0) * 8;
  const int eb = (r0 == 0 ? local : local - r0) * 8 + xcd;
  const int nextra = (eb >= 0 && eb < 78) ? (78 - eb + nlight - 1) / nlight : 0;
  for (int it = 0; it < nreg + nextra; ++it) {
    int mt, nt;
    if (it < nreg) { const int q = local + nloc * it, g = q / 156, rem = q - g * 156; nt = rem >> 2; mt = (g * 4 + (rem & 3)) * 8 + xcd; }
    else { const int e = eb + (it - nreg) * nlight; mt = 128 + e / 39; nt = e % 39; }
    const int m0 = mt * 256, n0 = nt * 128;
    f32x16 acc[2][2];
#pragma unroll
    for (int i = 0; i < 2; ++i) for (int j = 0; j < 2; ++j) acc[i][j] = zero16();
    ALoadN al{H + (size_t)m0 * 1024, 1024};
    gemm_tile<256, ALoadN, 4, 1024>(al, WT + (size_t)n0 * 1024, 1024, smem, acc);
    const int b = m0 / TB, tk0 = m0 - b * TB;
#pragma unroll
    for (int i = 0; i < 2; ++i)
#pragma unroll
      for (int j = 0; j < 2; ++j)
#pragma unroll
        for (int g4 = 0; g4 < 4; ++g4) {
          u32x2 o; o.x = pack2(acc[i][j][4 * g4], acc[i][j][4 * g4 + 1]); o.y = pack2(acc[i][j][4 * g4 + 2], acc[i][j][4 * g4 + 3]);
          *(u32x2*)(Tt + (wn * 64 + j * 32 + r) * LDE + wm * 64 + i * 32 + 8 * g4 + 4 * h) = o;
        }
    __syncthreads();
#pragma unroll 1
    for (int cg = 0; cg < 4; ++cg) {
      const int cb = n0 + cg * 32;
      if (cb >= 4896) continue;
      bool chan; int cm;
      if (cb < 512) { chan = false; cm = cb; }
      else if (cb < 1024) { chan = true; cm = CH_GV + cb - 512; }
      else if (cb < 2208) { chan = false; cm = cb - 512; }
      else if (cb < 2336) { chan = true; cm = CH_AV + cb - 2208; }
      else if (cb < 2848) { chan = false; cm = cb - 640; }
      else { chan = true; cm = cb - 2848; }
      if (chan) {
#pragma unroll
        for (int k = 0; k < 2; ++k) {
          const int idx = tid + NT * k, ch = idx >> 5, t8 = idx & 31;
          const u16* sp = Tt + (cg * 32 + ch) * LDE + t8 * 8;
          const u32x2 lo = *(const u32x2*)sp, hi = *(const u32x2*)(sp + 4);
          __builtin_nontemporal_store(u32x4{lo.x, lo.y, hi.x, hi.y}, (u32x4*)(CT + ((size_t)(cm + ch) * 2 + b) * TB + tk0 + t8 * 8));
        }
      } else {
#pragma unroll
        for (int k = 0; k < 2; ++k) {
          const int idx = tid + NT * k, row = idx >> 2, c8 = idx & 3;
          const u16* sp = Tt + (cg * 32 + c8 * 8) * LDE + row;
          u32x4 o;
          o.x = (unsigned)sp[0] | ((unsigned)sp[LDE] << 16); o.y = (unsigned)sp[2 * LDE] | ((unsigned)sp[3 * LDE] << 16);
          o.z = (unsigned)sp[4 * LDE] | ((unsigned)sp[5 * LDE] << 16); o.w = (unsigned)sp[6 * LDE] | ((unsigned)sp[7 * LDE] << 16);
          __builtin_nontemporal_store(o, (u32x4*)(P + (size_t)(m0 + row) * NP + cm + c8 * 8));
        }
      }
    }
  }
}

DI void attn_prep(const Params& p, int l, int dry) {
  const int tid = my_tid(), lane = tid & 63, wid = tid >> 6;
  u16* P = (u16*)(p.ws + OFF_P);
  const float gq = pk(p, PK_QN)[l * 64 + lane], gk = pk(p, PK_KN)[l * 64 + lane];
  for (int row = blockIdx.x * 8 + wid; row < R; row += gridDim.x * 8) {
    u16* Pr = P + (size_t)row * NP;
    const int b = row / TB, tk = row - b * TB;
    float cs = 1.f, sn = 0.f;
    if (tk >= LC) {
      const int t = tk - LC, pi = lane >> 1;
      const float pos = (pi < 16) ? (float)(t >> 6) : (float)(t & 63);
      const float inv = powf(10000.f, -(float)(2 * (pi & 15)) / 32.f);
      sincosf(pos * inv, &sn, &cs);
    }
#pragma unroll
    for (int hd = 0; hd < 10; ++hd) {
      const int col = (hd < 8) ? PC_AQ + hd * 64 + lane : PC_AK + (hd - 8) * 64 + lane;
      float v = bf2f(Pr[col]);
      const float ss = wave_sum(v * v);
      v = v * rsqrtf(ss * (1.f / 64.f) + EPS) * (hd < 8 ? gq : gk);
      const float pv = __shfl_xor(v, 1);
      float o = (lane & 1) ? (pv * sn + v * cs) : (v * cs - pv * sn);
      if (hd < 8) o *= 0.125f * 1.4426950408889634f;
      if (!dry) Pr[col] = f2bf(o);
    }
  }
}

DI void fft_pass4_fwd(float2* X, int tid, int h2) {
  const float inv4 = 0.25f / (float)h2;
#pragma unroll 8
  for (int i = 0; i < 8; ++i) {
    const int g = tid + NT * i, jp = g & (h2 - 1), base = ((g - jp) << 2) + jp;
    float2 e0 = X[base], e1 = X[base + h2], e2 = X[base + 2 * h2], e3 = X[base + 3 * h2];
    const float fr = (float)jp * inv4;
    const float2 T1 = make_float2(__builtin_amdgcn_cosf(fr), -__builtin_amdgcn_sinf(fr));
    const float2 T2 = cmul(T1, T1);
    float2 a0 = cadd(e0, e2), a2 = cmul(csub(e0, e2), T1);
    float2 a1 = cadd(e1, e3), d13 = cmul(csub(e1, e3), T1);
    float2 a3 = make_float2(d13.y, -d13.x);
    X[base] = cadd(a0, a1); X[base + h2] = cmul(csub(a0, a1), T2);
    X[base + 2 * h2] = cadd(a2, a3); X[base + 3 * h2] = cmul(csub(a2, a3), T2);
  }
  __syncthreads();
}
DI void fft_pass4_inv(float2* X, int tid, int h1) {
  const float inv4 = 0.25f / (float)h1;
#pragma unroll 8
  for (int i = 0; i < 8; ++i) {
    const int g = tid + NT * i, jp = g & (h1 - 1), base = ((g - jp) << 2) + jp;
    float2 e0 = X[base], e1 = X[base + h1], e2 = X[base + 2 * h1], e3 = X[base + 3 * h1];
    const float fr = (float)jp * inv4;
    const float2 V = make_float2(__builtin_amdgcn_cosf(fr), __builtin_amdgcn_sinf(fr));
    const float2 Wc = cmul(V, V);
    float2 t1 = cmul(e1, Wc), t3 = cmul(e3, Wc);
    float2 a0 = cadd(e0, t1), a1 = csub(e0, t1), a2 = cadd(e2, t3), a3 = csub(e2, t3);
    float2 u2 = cmul(a2, V), u3 = cmul(a3, V);
    u3 = make_float2(-u3.y, u3.x);
    X[base] = cadd(a0, u2); X[base + 2 * h1] = csub(a0, u2);
    X[base + h1] = cadd(a1, u3); X[base + 3 * h1] = csub(a1, u3);
  }
  __syncthreads();
}
DI constexpr float r16c(int k) { return k == 0 ? 1.f : k == 1 ? 0.9238795325112867f : k == 2 ? 0.7071067811865476f : k == 3 ? 0.3826834323650898f : k == 4 ? 0.f : k == 5 ? -0.3826834323650898f : k == 6 ? -0.7071067811865476f : -0.9238795325112867f; }
DI constexpr float r16s(int k) { return k == 0 ? 0.f : k == 1 ? 0.3826834323650898f : k == 2 ? 0.7071067811865476f : k == 3 ? 0.9238795325112867f : k == 4 ? 1.f : k == 5 ? 0.9238795325112867f : k == 6 ? 0.7071067811865476f : 0.3826834323650898f; }
template <bool INV>
DI void fft_pass16(float2* X, int tid, int q) {
  const float invq = 1.f / (16.f * (float)q);
#pragma unroll
  for (int it = 0; it < 2; ++it) {
    const int g = tid + NT * it, jp = g & (q - 1), base = ((g - jp) << 4) + jp;
    float vx[16], vy[16];
#pragma unroll
    for (int r = 0; r < 16; ++r) { const float2 e = X[base + r * q]; vx[r] = e.x; vy[r] = e.y; }
    const float th = (float)jp * invq;
    float bx[4], by[4];
    bx[0] = __builtin_amdgcn_cosf(th); by[0] = INV ? __builtin_amdgcn_sinf(th) : -__builtin_amdgcn_sinf(th);
#pragma unroll
    for (int s = 1; s < 4; ++s) { bx[s] = bx[s - 1] * bx[s - 1] - by[s - 1] * by[s - 1]; by[s] = 2.f * bx[s - 1] * by[s - 1]; }
#pragma unroll
    for (int ss = 0; ss < 4; ++ss) {
      const int s = INV ? 3 - ss : ss;
      const int rs = 8 >> s;
#pragma unroll
      for (int bf = 0; bf < 8; ++bf) {
        const int r = ((bf & ~(rs - 1)) << 1) | (bf & (rs - 1));
        const int k = (r & (rs - 1)) * (8 / rs);
        const float cc = r16c(k), cs = INV ? r16s(k) : -r16s(k);
        const float tx = bx[s] * cc - by[s] * cs, ty = bx[s] * cs + by[s] * cc;
        const float ax = vx[r], ay = vy[r], cx = vx[r + rs], cy = vy[r + rs];
        if (!INV) {
          const float dx = ax - cx, dy = ay - cy;
          vx[r] = ax + cx; vy[r] = ay + cy;
          vx[r + rs] = dx * tx - dy * ty; vy[r + rs] = dx * ty + dy * tx;
        } else {
          const float ux = cx * tx - cy * ty, uy = cx * ty + cy * tx;
          vx[r] = ax + ux; vy[r] = ay + uy;
          vx[r + rs] = ax - ux; vy[r + rs] = ay - uy;
        }
      }
    }
#pragma unroll
    for (int r = 0; r < 16; ++r) X[base + r * q] = make_float2(vx[r], vy[r]);
  }
  __syncthreads();
}
DI void fft_fwd(float2* X, int tid) {
#pragma unroll 1
  for (int q = 1024; q >= 4; q >>= 4) fft_pass16<false>(X, tid, q);
  fft_pass4_fwd(X, tid, 1);
}
DI void fft_inv(float2* X, int tid) {
  fft_pass4_inv(X, tid, 1);
#pragma unroll 1
  for (int q = 4; q <= 1024; q <<= 4) fft_pass16<true>(X, tid, q);
}
DI float sconv_at(const u16* src, int t, int len, float w0, float w1, float w2, float bb) {
  float ym = t > 0 ? bf2f(src[t - 1]) : 0.f, y0 = bf2f(src[t]), yp = t < len - 1 ? bf2f(src[t + 1]) : 0.f;
  return bb + w0 * ym + w1 * y0 + w2 * yp;
}
DI float hy_delta(int col) {
  const float A0 = -4.605170185988091f / 0.3f, A1 = -4.605170185988091f / 1.5f;
  return fabsf(A0 + (A1 - A0) * ((float)col / 2047.f));
}

DI void hyena_latent_task(const Params& p, int l, int c, char* smem, int dry) {
  float2* X = (float2*)smem;
  float* red = (float*)(smem + 131072);
  const int tid = my_tid(), lane = tid & 63, wid = tid >> 6;
  u16* CT = (u16*)(p.ws + OFF_CT);
  float2* FE = (float2*)(p.ws + OFF_FS + (size_t)blockIdx.x * 262144);
  float2* FO = FE + 16384;
  const unsigned* h2T = (const unsigned*)(p.ws + OFF_H2T) + (size_t)l * 64 * (L / 2);
  const float* f3w = pk(p, PK_F3) + (size_t)l * 64 * 2048;
  const float* cw = pk(p, PK_CW) + (size_t)l * 3 * 1536;
  const float* cbv = pk(p, PK_CB) + (size_t)l * 1536;
  const float vw0 = cw[c], vw1 = cw[1536 + c], vw2 = cw[3072 + c], vbb = cbv[c];
  const u16* v0 = CT + ((size_t)(CH_YU + c) * 2 + 0) * TB + LC;
  const u16* v1 = CT + ((size_t)(CH_YU + c) * 2 + 1) * TB + LC;
  u16* z10 = CT + ((size_t)(CH_YU + 512 + c) * 2 + 0) * TB + LC;
  u16* z11 = CT + ((size_t)(CH_YU + 512 + c) * 2 + 1) * TB + LC;
#pragma unroll 1
  for (int o = 0; o < 2; ++o) {
    const int cf = o * 1024 + c, cbk = cf + 512;
    float sf = 0.f, sb = 0.f;
    __syncthreads();
#ifdef PROBE_FFT
    fft_fwd(X, tid); fft_inv(X, tid);
#endif
#pragma unroll 1
    for (int half = 0; half < 2; ++half) {
      float af[16], ab[16];
#pragma unroll
      for (int i = 0; i < 16; ++i) { af[i] = 0.f; ab[i] = 0.f; }
#pragma unroll 1
      for (int j = 0; j < 64; j += 2) {
        const float wf0 = f3w[j * 2048 + cf], wb0 = f3w[j * 2048 + cbk], wf1 = f3w[(j + 1) * 2048 + cf], wb1 = f3w[(j + 1) * 2048 + cbk];
        const unsigned* hrow = h2T + (size_t)j * (L / 2) + tid + half * 8 * NT;
        unsigned w0[8], w1[8];
#pragma unroll
        for (int i = 0; i < 8; ++i) { w0[i] = hrow[NT * i]; w1[i] = hrow[L / 2 + NT * i]; }
#pragma unroll
        for (int i = 0; i < 8; ++i) {
          const float a0 = bflo(w0[i]), a1 = bfhi(w0[i]), b0 = bflo(w1[i]), b1 = bfhi(w1[i]);
          af[2 * i] += a0 * wf0 + b0 * wf1; af[2 * i + 1] += a1 * wf0 + b1 * wf1;
          ab[2 * i] += a0 * wb0 + b0 * wb1; ab[2 * i + 1] += a1 * wb0 + b1 * wb1;
        }
      }
      const float df = hy_delta(cf), db = hy_delta(cbk);
#pragma unroll
      for (int i = 0; i < 16; ++i) {
        const int t = 2 * (tid + NT * ((i >> 1) + half * 8)) + (i & 1); const float tt = (float)t / (float)(L - 1);
        const float vf = af[i] * (__expf(-tt * df) + 0.05f), vb = ab[i] * (__expf(-tt * db) + 0.05f);
        sf += fabsf(vf); sb += fabsf(vb);
        X[t].x = vf;
        if (t >= 1) X[L - t].y = vb; else X[0].y = 0.f;
      }
    }
    sf = wave_sum(sf); sb = wave_sum(sb);
    if (lane == 0) { red[wid] = sf; red[8 + wid] = sb; }
    __syncthreads();
    float nf = 0.f, nbk = 0.f;
#pragma unroll
    for (int w = 0; w < 8; ++w) { nf += red[w]; nbk += red[8 + w]; }
    const float inv_f = 1.f / nf, inv_b = 1.f / nbk;
#pragma unroll 8
    for (int i = 0; i < 32; ++i) { const int n = tid + NT * i; const float2 s = X[n]; FO[n] = s; X[n] = make_float2(s.x * inv_f + s.y * inv_b, 0.f); }
    __syncthreads();
    fft_fwd(X, tid);
#pragma unroll 8
    for (int i = 0; i < 32; ++i) { const int n = tid + NT * i; FE[n] = X[n]; }
    __syncthreads();
#pragma unroll 8
    for (int i = 0; i < 32; ++i) {
      const int n = tid + NT * i; const float2 s = FO[n]; const float dd = s.x * inv_f - s.y * inv_b; const float fr = (float)n * (1.f / 32768.f);
      X[n] = make_float2(dd * __builtin_amdgcn_cosf(fr), -dd * __builtin_amdgcn_sinf(fr));
    }
    __syncthreads();
    fft_fwd(X, tid);
#pragma unroll 8
    for (int i = 0; i < 32; ++i) { const int n = tid + NT * i; FO[n] = X[n]; }
    __syncthreads();
#pragma unroll 8
    for (int i = 0; i < 32; ++i) {
      const int n = tid + NT * i;
      float2 zz;
      if (o == 0) { zz.x = sconv_at(v0, n, L, vw0, vw1, vw2, vbb); zz.y = sconv_at(v1, n, L, vw0, vw1, vw2, vbb); }
      else { zz.x = bf2f(z10[n]); zz.y = bf2f(z11[n]); }
      X[n] = zz;
    }
    __syncthreads();
    fft_fwd(X, tid);
#pragma unroll 8
    for (int i = 0; i < 32; ++i) { const int n = tid + NT * i; X[n] = cmul(X[n], FE[n]); }
    __syncthreads();
    fft_inv(X, tid);
#pragma unroll 8
    for (int i = 0; i < 32; ++i) { const int n = tid + NT * i; FE[n] = X[n]; }
    __syncthreads();
#pragma unroll 8
    for (int i = 0; i < 32; ++i) {
      const int n = tid + NT * i; const float fr = (float)n * (1.f / 32768.f);
      float2 zz;
      if (o == 0) { zz.x = sconv_at(v0, n, L, vw0, vw1, vw2, vbb); zz.y = sconv_at(v1, n, L, vw0, vw1, vw2, vbb); }
      else { zz.x = bf2f(z10[n]); zz.y = bf2f(z11[n]); }
      X[n] = cmul(zz, make_float2(__builtin_amdgcn_cosf(fr), -__builtin_amdgcn_sinf(fr)));
    }
    __syncthreads();
    fft_fwd(X, tid);
#pragma unroll 8
    for (int i = 0; i < 32; ++i) { const int n = tid + NT * i; X[n] = cmul(X[n], FO[n]); }
    __syncthreads();
    fft_inv(X, tid);
    {
      const int gch = CH_YU + 512 * (o + 1) + c;
      const float w0 = cw[gch], w1 = cw[1536 + gch], w2 = cw[3072 + gch], bb = cbv[gch];
      const u16* s0 = CT + ((size_t)gch * 2 + 0) * TB + LC;
      const u16* s1 = CT + ((size_t)gch * 2 + 1) * TB + LC;
      const float sk = pk(p, PK_SK)[(l * 2 + o) * 512 + c];
#pragma unroll 8
      for (int i = 0; i < 32; ++i) {
        const int n = tid + NT * i; const float fr = (float)n * (1.f / 32768.f);
        const float2 wb = cmul(X[n], make_float2(__builtin_amdgcn_cosf(fr), __builtin_amdgcn_sinf(fr)));
        const float2 A = FE[n];
        const float yr = (A.x + wb.x) * (1.f / 32768.f), yi = (A.y + wb.y) * (1.f / 32768.f);
        const float g0 = sconv_at(s0, n, L, w0, w1, w2, bb), g1 = sconv_at(s1, n, L, w0, w1, w2, bb);
        float2 zz;
        if (o == 0) { zz.x = sconv_at(v0, n, L, vw0, vw1, vw2, vbb); zz.y = sconv_at(v1, n, L, vw0, vw1, vw2, vbb); }
        else { zz.x = bf2f(z10[n]); zz.y = bf2f(z11[n]); }
        X[n] = make_float2(g0 * (yr + sk * zz.x), g1 * (yi + sk * zz.y));
      }
    }
    __syncthreads();
    if (o == 0) {
#pragma unroll 8
      for (int i = 0; i < 32; ++i) { const int n = tid + NT * i; const float2 zz = X[n]; if (!dry) { z10[n] = f2bf(zz.x); z11[n] = f2bf(zz.y); } }
    } else {
      u16* d0 = CT + ((size_t)(CH_YZ + c) * 2 + 0) * TB + LC;
      u16* d1 = CT + ((size_t)(CH_YZ + c) * 2 + 1) * TB + LC;
#pragma unroll 1
      for (int ib = 0; ib < 32; ib += 8) {
        u16 g0[8], g1[8];
#pragma unroll
        for (int i = 0; i < 8; ++i) { const int n = tid + NT * (ib + i); g0[i] = d0[n]; g1[i] = d1[n]; }
#pragma unroll
        for (int i = 0; i < 8; ++i) {
          const int n = tid + NT * (ib + i); const float2 zz = X[n];
          const u16 q0 = f2bf(zz.x * silu_f(bf2f(g0[i]))), q1 = f2bf(zz.y * silu_f(bf2f(g1[i])));
          if (!dry) { d0[n] = q0; d1[n] = q1; }
        }
      }
    }
    __syncthreads();
  }
}

DI void hyena_ctx_task(const Params& p, int l, int c, char* smem, int dry) {
  float* filt = (float*)smem;
  float* zs = filt + 1024;
  float* nrm = zs + 1024;
  const int tid = my_tid(), lane = tid & 63, wid = tid >> 6, t = tid & 255, hb = tid >> 8;
  u16* CT = (u16*)(p.ws + OFF_CT);
  const float* h2c = (const float*)(p.ws + OFF_H2C) + (size_t)l * 256 * 64;
  const float* f3w = pk(p, PK_F3) + (size_t)l * 64 * 2048;
  const float* cw = pk(p, PK_CW) + (size_t)l * 3 * 1536;
  const float* cbv = pk(p, PK_CB) + (size_t)l * 1536;
  __syncthreads();
  {
    const int cf = hb * 1024 + c, cbk = cf + 512;
    float a_f = 0.f, a_b = 0.f;
    for (int j = 0; j < 64; ++j) { const float hv = h2c[t * 64 + j]; a_f += hv * f3w[j * 2048 + cf]; a_b += hv * f3w[j * 2048 + cbk]; }
    const float tt = (float)t / 255.f;
    filt[(hb * 2 + 0) * 256 + t] = a_f * (__expf(-tt * hy_delta(cf)) + 0.05f);
    filt[(hb * 2 + 1) * 256 + t] = a_b * (__expf(-tt * hy_delta(cbk)) + 0.05f);
    const u16* src = CT + ((size_t)(CH_YU + c) * 2 + hb) * TB;
    zs[hb * 256 + t] = sconv_at(src, t, LC, cw[c], cw[1536 + c], cw[3072 + c], cbv[c]);
  }
  __syncthreads();
  if (wid < 4) {
    float s = 0.f;
    for (int k = 0; k < 4; ++k) s += fabsf(filt[wid * 256 + lane + 64 * k]);
    s = wave_sum(s);
    if (lane == 0) nrm[wid] = s;
  }
  __syncthreads();
  const int b = hb;
  for (int o = 0; o < 2; ++o) {
    const float inf_ = 1.f / nrm[o * 2], inb_ = 1.f / nrm[o * 2 + 1];
    const float* hf = filt + (o * 2) * 256; const float* hbk = filt + (o * 2 + 1) * 256;
    const float* zc = zs + (o & 1) * 512 + b * 256;
    float accf = 0.f, accb = 0.f;
    for (int s = 0; s <= t; ++s) accf += hf[t - s] * zc[s];
    for (int s = t + 1; s < 256; ++s) accb += hbk[s - t] * zc[s];
    const int gch = CH_YU + 512 * (o + 1) + c;
    const float gate = sconv_at(CT + ((size_t)gch * 2 + b) * TB, t, LC, cw[gch], cw[1536 + gch], cw[3072 + gch], cbv[gch]);
    const float zn = gate * (accf * inf_ + accb * inb_ + pk(p, PK_SK)[(l * 2 + o) * 512 + c] * zc[t]);
    zs[((o + 1) & 1) * 512 + b * 256 + t] = zn;
    __syncthreads();
  }
  {
    u16* d = CT + ((size_t)(CH_YZ + c) * 2 + b) * TB;
    const u16 q0 = f2bf(zs[b * 256 + t] * silu_f(bf2f(d[t])));
    if (!dry) d[t] = q0;
  }
  __syncthreads();
}

DI void gla_bcum(const Params& p, int l, int row0, int hh, int dir, float* gs, float* segs, float* was, float* as_) {
  const int tid = my_tid();
  const u16* P = (const u16*)(p.ws + OFF_P);
  const float* wa = pk(p, dir ? PK_WAB : PK_WAF) + (size_t)l * 16 * 256 + hh * 64;
  const float* ba = pk(p, dir ? PK_BAB : PK_BAF) + l * 256 + hh * 64;
#pragma unroll
  for (int i = 0; i < 2; ++i) {
    const int idx = tid + NT * i;
    was[idx] = wa[(idx >> 6) * 256 + (idx & 63)];
    as_[(idx >> 4) * 17 + (idx & 15)] = bf2f(P[(size_t)(row0 + (idx >> 4)) * NP + PC_AF + dir * 16 + (idx & 15)]);
  }
  __syncthreads();
  {
    const int t = tid >> 3, d0 = (tid & 7) * 8;
    float lin[8];
#pragma unroll
    for (int e = 0; e < 8; ++e) lin[e] = ba[d0 + e];
#pragma unroll 2
    for (int rr = 0; rr < 16; ++rr) {
      const float av = as_[t * 17 + rr];
      const float4 w0 = *(const float4*)(was + rr * 64 + d0), w1 = *(const float4*)(was + rr * 64 + d0 + 4);
      lin[0] += av * w0.x; lin[1] += av * w0.y; lin[2] += av * w0.z; lin[3] += av * w0.w;
      lin[4] += av * w1.x; lin[5] += av * w1.y; lin[6] += av * w1.z; lin[7] += av * w1.w;
    }
#pragma unroll
    for (int e = 0; e < 8; ++e) gs[t * 65 + d0 + e] = (fminf(lin[e], 0.f) - log1pf(__expf(-fabsf(lin[e])))) * (1.f / 16.f);
  }
  __syncthreads();
  {
    const int d = tid & 63, seg = tid >> 6;
    float v[8]; float run = 0.f;
#pragma unroll
    for (int e = 0; e < 8; ++e) { const int tt = dir ? seg * 8 + 7 - e : seg * 8 + e; run += gs[tt * 65 + d]; v[e] = run; }
    segs[seg * 64 + d] = run;
    __syncthreads();
    float off = 0.f;
#pragma unroll
    for (int s = 0; s < 8; ++s) { const bool before = dir ? (s > seg) : (s < seg); if (before) off += segs[s * 64 + d]; }
#pragma unroll
    for (int e = 0; e < 8; ++e) { const int tt = dir ? seg * 8 + 7 - e : seg * 8 + e; gs[tt * 65 + d] = v[e] + off; }
  }
  __syncthreads();
}
DI int gla_tok0(int dir, int n) {
  if (n < 4) return (dir ? 3 - n : n) * 64;
  return LC + (dir ? 255 - (n - 4) : n - 4) * 64;
}
constexpr int G_GS = 0;
constexpr int G_SEG = G_GS + 64 * 65 * 4;
constexpr int G_QS = G_SEG + 8 * 64 * 4;
constexpr int G_KS = G_QS + 64 * LDT * 2;
constexpr int G_VT = G_KS + 64 * LDT * 2;
constexpr int G_ST = G_VT + 128 * LDT * 2;
constexpr int G_RED = G_ST + 128 * LDT * 2;
constexpr int G_WA = G_RED + 8 * 32 * 4;
constexpr int G_AS = G_WA + 16 * 64 * 4;

DI void gla_g1_task(const Params& p, int l, int chain, int n, char* smem) {
  const int tid = my_tid(), lane = tid & 63, wid = tid >> 6, r = lane & 31, h = lane >> 5;
  const int b = chain >> 3, hh = (chain >> 1) & 3, dir = chain & 1;
  const int tk0 = gla_tok0(dir, n), row0 = b * TB + tk0;
  float* gs = (float*)(smem + G_GS); float* segs = (float*)(smem + G_SEG);
  u16* kT = (u16*)(smem + G_KS); u16* vT = (u16*)(smem + G_VT);
  const u16* P = (const u16*)(p.ws + OFF_P);
  const u16* CT = (const u16*)(p.ws + OFF_CT);
  __syncthreads();
  gla_bcum(p, l, row0, hh, dir, gs, segs, (float*)(smem + G_WA), (float*)(smem + G_AS));
  const int tl = dir ? 0 : 63;
  {
    const int t = tid >> 3, d0 = (tid & 7) * 8;
    const u32x4 kv = *(const u32x4*)(P + (size_t)(row0 + t) * NP + PC_GK + hh * 64 + d0);
    const unsigned w[4] = {kv.x, kv.y, kv.z, kv.w};
#pragma unroll
    for (int e = 0; e < 8; ++e) {
      const float kx = (e & 1) ? bfhi(w[e >> 1]) : bflo(w[e >> 1]);
      kT[(d0 + e) * LDT + t] = f2bf(kx * __expf(gs[tl * 65 + d0 + e] - gs[t * 65 + d0 + e]));
    }
#pragma unroll
    for (int i = 0; i < 2; ++i) {
      const int q = tid + NT * i, v = q >> 3, cc = q & 7;
      *(u32x4*)(vT + v * LDT + cc * 8) = *(const u32x4*)(CT + ((size_t)(CH_GV + hh * 128 + v) * 2 + b) * TB + tk0 + cc * 8);
    }
    if (tid < 64) ((float*)(p.ws + OFF_GD))[((size_t)chain * NCK + n) * 64 + tid] = __expf(gs[tl * 65 + tid]);
  }
  __syncthreads();
  {
    const int vm = wid >> 1, dn = wid & 1;
    f32x16 acc = zero16();
#pragma unroll
    for (int s = 0; s < 4; ++s) {
      const bf16x8 a = *(const bf16x8*)(vT + (vm * 32 + r) * LDT + s * 16 + h * 8);
      const bf16x8 bb = *(const bf16x8*)(kT + (dn * 32 + r) * LDT + s * 16 + h * 8);
      acc = MFMA(a, bb, acc);
    }
    u16* GS = (u16*)(p.ws + OFF_GS) + ((size_t)chain * NCK + n) * 8192;
#pragma unroll
    for (int reg = 0; reg < 16; ++reg) GS[(vm * 32 + crow(reg, h)) * 64 + dn * 32 + r] = f2bf(acc[reg]);
  }
}
DI void gla_g2(const Params& p, int dry) {
  u16* GSb = (u16*)(p.ws + OFF_GS);
  const float* GD = (const float*)(p.ws + OFF_GD);
  for (int gi = blockIdx.x * NT + my_tid(); gi < 16 * 8192; gi += gridDim.x * NT) {
    const int chain = gi >> 13, e = gi & 8191, d = e & 63;
    u16* ptr = GSb + (size_t)chain * NCK * 8192 + e;
    const float* dec = GD + (size_t)chain * NCK * 64 + d;
    float S = 0.f;
#pragma unroll 1
    for (int n0 = 0; n0 < NCK; n0 += 20) {
      float ds[20], a[20];
#pragma unroll
      for (int k = 0; k < 20; ++k) { ds[k] = bf2f(ptr[(size_t)(n0 + k) * 8192]); a[k] = dec[(n0 + k) * 64]; }
#pragma unroll
      for (int k = 0; k < 20; ++k) { if (!dry) ptr[(size_t)(n0 + k) * 8192] = f2bf(S); S = a[k] * S + ds[k]; }
    }
  }
}
DI void gla_g3_task(const Params& p, int l, int b, int hh, int ci, char* smem, int dry) {
  const int tid = my_tid(), lane = tid & 63, wid = tid >> 6, r = lane & 31, h = lane >> 5;
  const int tk0 = ci * 64, row0 = b * TB + tk0;
  float* gs = (float*)(smem + G_GS); float* segs = (float*)(smem + G_SEG); float* red = (float*)(smem + G_RED);
  u16* qs = (u16*)(smem + G_QS); u16* ks = (u16*)(smem + G_KS); u16* vT = (u16*)(smem + G_VT); u16* sT = (u16*)(smem + G_ST);
  u16* P = (u16*)(p.ws + OFF_P);
  const u16* CT = (const u16*)(p.ws + OFF_CT);
  const int vm = wid >> 1, in = wid & 1;
  f32x16 o = zero16();
  __syncthreads();
#pragma unroll 1
  for (int dir = 0; dir < 2; ++dir) {
    gla_bcum(p, l, row0, hh, dir, gs, segs, (float*)(smem + G_WA), (float*)(smem + G_AS));
    const int chain = b * 8 + hh * 2 + dir;
    const int n = dir ? ((ci < 4) ? 3 - ci : 263 - ci) : ci;
    {
      const int t = tid >> 3, d0 = (tid & 7) * 8;
      const u32x4 qv = *(const u32x4*)(P + (size_t)(row0 + t) * NP + PC_GQ + hh * 64 + d0);
      const u32x4 kv = *(const u32x4*)(P + (size_t)(row0 + t) * NP + PC_GK + hh * 64 + d0);
      const unsigned qw[4] = {qv.x, qv.y, qv.z, qv.w}, kw[4] = {kv.x, kv.y, kv.z, kv.w};
      unsigned qo[4], ko[4];
#pragma unroll
      for (int e = 0; e < 4; ++e) {
        const float b0 = gs[t * 65 + d0 + 2 * e], b1 = gs[t * 65 + d0 + 2 * e + 1];
        qo[e] = pack2(bflo(qw[e]) * 0.125f * __expf(b0), bfhi(qw[e]) * 0.125f * __expf(b1));
        ko[e] = pack2(bflo(kw[e]) * __expf(-b0), bfhi(kw[e]) * __expf(-b1));
      }
      *(u32x4*)(qs + t * LDT + d0) = u32x4{qo[0], qo[1], qo[2], qo[3]};
      *(u32x4*)(ks + t * LDT + d0) = u32x4{ko[0], ko[1], ko[2], ko[3]};
      const u16* GS = (const u16*)(p.ws + OFF_GS) + ((size_t)chain * NCK + n) * 8192;
#pragma unroll
      for (int i = 0; i < 2; ++i) {
        const int q = tid + NT * i, v = q >> 3, cc = q & 7;
        *(u32x4*)(sT + v * LDT + cc * 8) = *(const u32x4*)(GS + v * 64 + cc * 8);
        if (dir == 0) *(u32x4*)(vT + v * LDT + cc * 8) = *(const u32x4*)(CT + ((size_t)(CH_GV + hh * 128 + v) * 2 + b) * TB + tk0 + cc * 8);
      }
    }
    __syncthreads();
    bf16x8 qf[4];
#pragma unroll
    for (int s = 0; s < 4; ++s) qf[s] = *(const bf16x8*)(qs + (in * 32 + r) * LDT + s * 16 + h * 8);
#pragma unroll
    for (int jt = 0; jt < 2; ++jt) {
      f32x16 at = zero16();
#pragma unroll
      for (int s = 0; s < 4; ++s) at = MFMA(*(const bf16x8*)(ks + (jt * 32 + r) * LDT + s * 16 + h * 8), qf[s], at);
      const int ii = in * 32 + r;
#pragma unroll
      for (int reg = 0; reg < 16; ++reg) {
        const int jj = jt * 32 + crow(reg, h);
        const bool keep = dir ? (jj >= ii) : (jj <= ii);
        if (!keep) at[reg] = 0.f;
      }
#pragma unroll
      for (int s = 0; s < 2; ++s) {
        const u16* vp = vT + (vm * 32 + r) * LDT + jt * 32 + 16 * s + 4 * h;
        o = MFMA(ld2x64(vp, vp + 8), pack8(at, s), o);
      }
    }
#pragma unroll
    for (int s = 0; s < 4; ++s) o = MFMA(*(const bf16x8*)(sT + (vm * 32 + r) * LDT + s * 16 + h * 8), qf[s], o);
    __syncthreads();
  }
  float ss = 0.f;
#pragma unroll
  for (int reg = 0; reg < 16; ++reg) ss += o[reg] * o[reg];
  ss += __shfl_xor(ss, 32);
  if (h == 0) red[wid * 32 + r] = ss;
  __syncthreads();
  float tot = 0.f;
#pragma unroll
  for (int m = 0; m < 4; ++m) tot += red[(m * 2 + in) * 32 + r];
  const float rs = rsqrtf(tot * (1.f / 128.f) + EPS);
  u16* zp = P + (size_t)(row0 + in * 32 + r) * NP + PC_GZ + hh * 128 + vm * 32 + 4 * h;
  const float* gn = pk(p, PK_GN) + l * 128 + vm * 32 + 4 * h;
#pragma unroll
  for (int g = 0; g < 4; ++g) {
    const u32x2 zz = *(const u32x2*)(zp + 8 * g);
    const float4 gw = *(const float4*)(gn + 8 * g);
    u32x2 out;
    out.x = pack2(o[4 * g] * rs * gw.x * silu_f(bflo(zz.x)), o[4 * g + 1] * rs * gw.y * silu_f(bfhi(zz.x)));
    out.y = pack2(o[4 * g + 2] * rs * gw.z * silu_f(bflo(zz.y)), o[4 * g + 3] * rs * gw.w * silu_f(bfhi(zz.y)));
    if (!dry) *(u32x2*)(zp + 8 * g) = out;
  }
}

DI void attn_item(const Params& p, int l, int b, int g, int qtk0, int ntiles, char* smem, int dry) {
  const int tid = my_tid(), lane = tid & 63, wid = tid >> 6, r = lane & 31, h = lane >> 5;
  u16* P = (u16*)(p.ws + OFF_P);
  const u16* CT = (const u16*)(p.ws + OFF_CT);
  u16* Ks = (u16*)smem;
  u16* Vs = Ks + 2 * 64 * LDT;
  const int hq = g * 4 + (wid >> 1);
  const size_t qrow = (size_t)b * TB + qtk0 + (wid & 1) * 32 + r;
  bf16x8 qf[4];
#pragma unroll
  for (int s = 0; s < 4; ++s) qf[s] = *(const bf16x8*)(P + qrow * NP + PC_AQ + hq * 64 + s * 16 + h * 8);
  f32x16 O[2] = {zero16(), zero16()};
  float m = -1e30f, lsum = 0.f;
  const int lr = tid >> 3, lc = (tid & 7) * 8;
  const u16* kg = P + ((size_t)b * TB + lr) * NP + PC_AK + g * 64 + lc;
  const u16* vg = CT + ((size_t)(CH_AV + g * 64 + lr) * 2 + b) * TB + lc;
  u32x4 rk = *(const u32x4*)kg, rv = *(const u32x4*)vg;
  __syncthreads();
  *(u32x4*)(Ks + lr * LDT + lc) = rk; *(u32x4*)(Vs + lr * LDT + lc) = rv;
  __syncthreads();
  float gqm = fabsf(pk(p, PK_QN)[l * 64 + lane]), gkm = fabsf(pk(p, PK_KN)[l * 64 + lane]);
#pragma unroll
  for (int o = 32; o >= 1; o >>= 1) { gqm = fmaxf(gqm, __shfl_xor(gqm, o)); gkm = fmaxf(gkm, __shfl_xor(gkm, o)); }
  const float mshift = 8.2f * 1.4426950408889634f * gqm * gkm;
  if (mshift <= 60.f) {
    f32x16 sinit;
#pragma unroll
    for (int i = 0; i < 16; ++i) sinit[i] = -mshift;
#pragma unroll 1
    for (int kt = 0; kt < ntiles; ++kt) {
      const int cur = kt & 1;
      if (kt + 1 < ntiles) { rk = *(const u32x4*)(kg + (size_t)(kt + 1) * 64 * NP); rv = *(const u32x4*)(vg + (kt + 1) * 64); }
      const u16* Kc = Ks + cur * 64 * LDT; const u16* Vc = Vs + cur * 64 * LDT;
      f32x16 st[2];
#pragma unroll
      for (int kk = 0; kk < 2; ++kk) {
        st[kk] = sinit;
#pragma unroll
        for (int s = 0; s < 4; ++s) st[kk] = MFMA(*(const bf16x8*)(Kc + (kk * 32 + r) * LDT + s * 16 + h * 8), qf[s], st[kk]);
      }
#pragma unroll
      for (int kk = 0; kk < 2; ++kk)
#pragma unroll
        for (int i = 0; i < 16; ++i) { const float pv = __builtin_amdgcn_exp2f(st[kk][i]); st[kk][i] = pv; lsum += pv; }
#pragma unroll
      for (int kk = 0; kk < 2; ++kk)
#pragma unroll
        for (int s = 0; s < 2; ++s) {
          const bf16x8 pb = pack8(st[kk], s);
#pragma unroll
          for (int mt = 0; mt < 2; ++mt) {
            const u16* vp = Vc + (mt * 32 + r) * LDT + kk * 32 + 16 * s + 4 * h;
            O[mt] = MFMA(ld2x64(vp, vp + 8), pb, O[mt]);
          }
        }
      if (kt + 1 < ntiles) { *(u32x4*)(Ks + (cur ^ 1) * 64 * LDT + lr * LDT + lc) = rk; *(u32x4*)(Vs + (cur ^ 1) * 64 * LDT + lr * LDT + lc) = rv; }
      __syncthreads();
    }
  } else {
#pragma unroll 1
    for (int kt = 0; kt < ntiles; ++kt) {
      const int cur = kt & 1;
      if (kt + 1 < ntiles) { rk = *(const u32x4*)(kg + (size_t)(kt + 1) * 64 * NP); rv = *(const u32x4*)(vg + (kt + 1) * 64); }
      const u16* Kc = Ks + cur * 64 * LDT; const u16* Vc = Vs + cur * 64 * LDT;
      f32x16 st[2];
#pragma unroll
      for (int kk = 0; kk < 2; ++kk) {
        st[kk] = zero16();
#pragma unroll
        for (int s = 0; s < 4; ++s) st[kk] = MFMA(*(const bf16x8*)(Kc + (kk * 32 + r) * LDT + s * 16 + h * 8), qf[s], st[kk]);
      }
      float mx = st[0][0];
#pragma unroll
      for (int i = 0; i < 16; ++i) { mx = fmaxf(mx, st[0][i]); mx = fmaxf(mx, st[1][i]); }
      mx = fmaxf(mx, __shfl_xor(mx, 32));
      const float mn = fmaxf(m, mx);
      const float alpha = exp2f(m - mn);
      m = mn;
      float rsum = 0.f;
#pragma unroll
      for (int kk = 0; kk < 2; ++kk)
#pragma unroll
        for (int i = 0; i < 16; ++i) { const float pv = exp2f(st[kk][i] - mn); st[kk][i] = pv; rsum += pv; }
      lsum = lsum * alpha + rsum;
#pragma unroll
      for (int mt = 0; mt < 2; ++mt)
#pragma unroll
        for (int i = 0; i < 16; ++i) O[mt][i] *= alpha;
#pragma unroll
      for (int kk = 0; kk < 2; ++kk)
#pragma unroll
        for (int s = 0; s < 2; ++s) {
          const bf16x8 pb = pack8(st[kk], s);
#pragma unroll
          for (int mt = 0; mt < 2; ++mt) {
            const u16* vp = Vc + (mt * 32 + r) * LDT + kk * 32 + 16 * s + 4 * h;
            O[mt] = MFMA(ld2x64(vp, vp + 8), pb, O[mt]);
          }
        }
      if (kt + 1 < ntiles) { *(u32x4*)(Ks + (cur ^ 1) * 64 * LDT + lr * LDT + lc) = rk; *(u32x4*)(Vs + (cur ^ 1) * 64 * LDT + lr * LDT + lc) = rv; }
      __syncthreads();
    }
  }
  lsum += __shfl_xor(lsum, 32);
  const float inv = 1.f / lsum;
  u16* op = P + qrow * NP + PC_AQ + hq * 64 + 4 * h;
  const u16* zp = P + qrow * NP + PC_AZ + hq * 64 + 4 * h;
#pragma unroll
  for (int mt = 0; mt < 2; ++mt)
#pragma unroll
    for (int gg = 0; gg < 4; ++gg) {
      const u32x2 zz = *(const u32x2*)(zp + mt * 32 + 8 * gg);
      u32x2 out;
      out.x = pack2(O[mt][4 * gg] * inv * silu_f(bflo(zz.x)), O[mt][4 * gg + 1] * inv * silu_f(bfhi(zz.x)));
      out.y = pack2(O[mt][4 * gg + 2] * inv * silu_f(bflo(zz.y)), O[mt][4 * gg + 3] * inv * silu_f(bfhi(zz.y)));
      if (!dry) *(u32x2*)(op + mt * 32 + 8 * gg) = out;
    }
}

template <int KSU>
DI void gemm_gate3(const u16* __restrict__ A, const u16* __restrict__ WM, char* smem, f32x16 (&acc)[3][2]) {
  u16* As0 = (u16*)smem;
  u16* As1 = As0 + 128 * LDT;
  u16* Bs0 = As0 + 2 * 128 * LDT;
  u16* Bs1 = Bs0 + 384 * LDT;
  const int tid = my_tid(), lane = tid & 63, wid = tid >> 6, r = lane & 31, h = lane >> 5, wm = wid & 3, wn = wid >> 2;
  u32x4 ra0[2], rb0[6], ra1[2], rb1[6];
  auto fetch = [&](u32x4 (&ra)[2], u32x4 (&rb)[6], int k0) {
#pragma unroll
    for (int i = 0; i < 2; ++i) { const int q = tid + NT * i; const unsigned off = (unsigned)((q >> 3) * 1024 + (q & 7) * 8); ra[i] = *(const u32x4*)(A + off + k0); }
#pragma unroll
    for (int i = 0; i < 6; ++i) {
      const int q = tid + NT * i, row = q >> 3;
      const unsigned off = (unsigned)((row >> 7) * (1024 * 1024) + (row & 127) * 1024 + (q & 7) * 8);
      rb[i] = *(const u32x4*)(WM + off + k0);
    }
    GFENCE;
  };
  auto commit = [&](const u32x4 (&ra)[2], const u32x4 (&rb)[6], u16* As, u16* Bs) {
#pragma unroll
    for (int i = 0; i < 2; ++i) { const int q = tid + NT * i; *(u32x4*)(As + (q >> 3) * LDT + (q & 7) * 8) = ra[i]; }
#pragma unroll
    for (int i = 0; i < 6; ++i) { const int q = tid + NT * i; *(u32x4*)(Bs + (q >> 3) * LDT + (q & 7) * 8) = rb[i]; }
    GFENCE;
  };
  auto compute = [&](const u16* Ac, const u16* Bc) {
#pragma unroll KSU
    for (int ks = 0; ks < 4; ++ks) {
      const bf16x8 a = *(const bf16x8*)(Ac + (wm * 32 + r) * LDT + ks * 16 + h * 8);
#pragma unroll
      for (int br = 0; br < 3; ++br)
#pragma unroll
        for (int j = 0; j < 2; ++j)
          acc[br][j] = MFMA(a, *(const bf16x8*)(Bc + (br * 128 + wn * 64 + j * 32 + r) * LDT + ks * 16 + h * 8), acc[br][j]);
    }
  };
  constexpr int KT = 16;
  fetch(ra0, rb0, 0);
  fetch(ra1, rb1, 64);
  __syncthreads();
  commit(ra0, rb0, As0, Bs0);
  __syncthreads();
  fetch(ra0, rb0, 128);
#pragma unroll
  for (int kt = 0; kt < KT; kt += 2) {
    commit(ra1, rb1, As1, Bs1);
    if (kt + 3 < KT) fetch(ra1, rb1, (kt + 3) * 64);
    compute(As0, Bs0);
    __syncthreads();
    if (kt + 2 < KT) commit(ra0, rb0, As0, Bs0);
    if (kt + 4 < KT) fetch(ra0, rb0, (kt + 4) * 64);
    compute(As1, Bs1);
    __syncthreads();
  }
}
DI void phase_merge(const Params& p, int l, char* smem) {
  const int tid = my_tid(), lane = tid & 63, wid = tid >> 6, r = lane & 31, h = lane >> 5, wm = wid & 3, wn = wid >> 2;
  const int xcd = blockIdx.x & 7, nloc = gridDim.x >> 3;
  for (int q = blockIdx.x >> 3; q < 33 * 8; q += nloc) {
    const int mt = (q >> 3) * 8 + xcd, nt = q & 7, m0 = mt * 128, n0 = nt * 128;
    if (mt >= 260) continue;
    const int b = m0 / TB, tk0 = m0 - b * TB;
    if (l == 1 && tk0 < LC) continue;
    const u16* H = (const u16*)(p.ws + OFF_H) + (size_t)m0 * 1024;
    const u16* WM = (const u16*)(p.ws + OFF_WT + (size_t)l * WT_LAYER) + (size_t)(4896 + n0) * 1024;
    const u16* WBR = (const u16*)(p.ws + OFF_WT + (size_t)l * WT_LAYER + WT_IN) + (size_t)n0 * 512;
    unsigned gp[3][2][8];
    {
      f32x16 g3[3][2];
#pragma unroll
      for (int br = 0; br < 3; ++br) for (int j = 0; j < 2; ++j) g3[br][j] = zero16();
      gemm_gate3<2>(H, WM, smem, g3);
#pragma unroll
      for (int br = 0; br < 3; ++br)
#pragma unroll
        for (int j = 0; j < 2; ++j)
#pragma unroll
          for (int i = 0; i < 8; ++i)
            gp[br][j][i] = pack2(1.f / (1.f + __expf(-g3[br][j][2 * i])), 1.f / (1.f + __expf(-g3[br][j][2 * i + 1])));
    }
    f32x16 ysum[2] = {zero16(), zero16()};
#pragma unroll
    for (int br = 0; br < 3; ++br) {
      f32x16 ab[1][2] = {{zero16(), zero16()}};
      if (br < 2) {
        ALoadN ay{(const u16*)(p.ws + OFF_P) + (size_t)m0 * NP + (br == 0 ? PC_GZ : PC_AQ), NP};
        gemm_tile<128, ALoadN, 4, 512>(ay, WBR + (size_t)br * 1024 * 512, 512, smem, ab);
      } else {
        ALoadT ay{(const u16*)(p.ws + OFF_CT) + ((size_t)CH_YZ * 2 + b) * TB + tk0, (size_t)2 * TB};
        gemm_tile<128, ALoadT, 4, 512>(ay, WBR + (size_t)2 * 1024 * 512, 512, smem, ab);
      }
#pragma unroll
      for (int j = 0; j < 2; ++j)
#pragma unroll
        for (int i = 0; i < 8; ++i) {
          ysum[j][2 * i] += bflo(gp[br][j][i]) * ab[0][j][2 * i];
          ysum[j][2 * i + 1] += bfhi(gp[br][j][i]) * ab[0][j][2 * i + 1];
        }
    }
    u16* Y = (u16*)(p.ws + OFF_Y) + (size_t)(m0 + wm * 32 + 4 * h) * 1024 + n0 + wn * 64 + r;
#pragma unroll
    for (int j = 0; j < 2; ++j)
#pragma unroll
      for (int reg = 0; reg < 16; ++reg) Y[(size_t)((reg & 3) + 8 * (reg >> 2)) * 1024 + j * 32] = f2bf(ysum[j][reg]);
  }
}

DI void phase_out(const Params& p, int l, char* smem) {
  const int tid = my_tid(), lane = tid & 63, wid = tid >> 6, r = lane & 31, h = lane >> 5, wm = wid & 3, wn = wid >> 2;
  const u16* Yb = (const u16*)(p.ws + OFF_Y);
  const u16* WO = (const u16*)(p.ws + OFF_WT + (size_t)l * WT_LAYER + WT_IN + 3 * WT_BR);
  const float* mod = (const float*)(p.ws + OFF_MOD);
  const int xcd = blockIdx.x & 7, nloc = gridDim.x >> 3;
  auto tile_of = [&](int q, int& m0, int& n0) -> bool {
    const int mt = (q >> 3) * 8 + xcd; m0 = mt * 128; n0 = (q & 7) * 128;
    if (mt >= 260) return false;
    const int b = m0 / TB, tk0 = m0 - b * TB;
    return !(l == 1 && tk0 < LC);
  };
  auto next_q = [&](int q) -> int { int m, n; for (q += nloc; q < 33 * 8; q += nloc) if (tile_of(q, m, n)) return q; return -1; };
  int q = (int)(blockIdx.x >> 3) - nloc; q = next_q(q);
  if (q < 0) return;
  int m0, n0; tile_of(q, m0, n0);
  GemmRegs<128> gr;
  { ALoadN ay{Yb + (size_t)m0 * 1024, 1024}; gemm_prime<128>(gr, ay, WO + (size_t)n0 * 1024, 1024, smem); }
  while (true) {
    const int qn = next_q(q);
    int m0n = 0, n0n = 0; if (qn >= 0) tile_of(qn, m0n, n0n);
    const int b = m0 / TB, tk0 = m0 - b * TB;
    f32x16 acc[1][2] = {{zero16(), zero16()}};
    const ALoadN ay{Yb + (size_t)m0 * 1024, 1024}, ayn{Yb + (size_t)m0n * 1024, 1024};
    gemm_run<128, ALoadN, 4, 1024, ALoadN>(gr, ay, WO + (size_t)n0 * 1024, 1024, ayn, WO + (size_t)n0n * 1024, 1024, qn >= 0, smem, acc);
    const float* gv = mod + (l * 3 + (tk0 < LC ? 2 : b)) * 3072 + 2048;
    const float* xin = xrow_in(p, l, m0);
    float* xout = xrow_out(p, m0);
#pragma unroll
    for (int j = 0; j < 2; ++j) {
      const int col = n0 + wn * 64 + j * 32 + r;
      const float gate = gv[col];
#pragma unroll
      for (int reg = 0; reg < 16; ++reg) {
        const size_t off = (size_t)(wm * 32 + crow(reg, h)) * D + col;
        xout[off] = xin[off] + gate * acc[0][j][reg];
      }
    }
    if (qn < 0) break;
    q = qn; m0 = m0n; n0 = n0n;
  }
}

DI void phase_final(const Params& p) {
  const int tid = my_tid(), lane = tid & 63, wid = tid >> 6;
  for (int row = blockIdx.x * 8 + wid; row < NBATCH * L; row += gridDim.x * 8) {
    float* src = p.out + (size_t)row * D;
    float4 xv[4]; float ss = 0.f;
#pragma unroll
    for (int i = 0; i < 4; ++i) { xv[i] = *(const float4*)(src + (i * 64 + lane) * 4); ss += xv[i].x * xv[i].x + xv[i].y * xv[i].y + xv[i].z * xv[i].z + xv[i].w * xv[i].w; }
    ss = wave_sum(ss);
    const float rs = rsqrtf(ss * (1.f / 1024.f) + EPS);
#pragma unroll
    for (int i = 0; i < 4; ++i) {
      const int col = (i * 64 + lane) * 4;
      const float4 fw = *(const float4*)(pk(p, PK_FN) + col);
      *(float4*)(src + col) = make_float4(xv[i].x * rs * fw.x, xv[i].y * rs * fw.y, xv[i].z * rs * fw.z, xv[i].w * rs * fw.w);
    }
  }
}

DI void run_phase(const Params& p, int ph, char* smem, int dry = 0) {
  const int bid = blockIdx.x, nb = gridDim.x;
  if (ph == 0) { phase0(p, smem); return; }
  if (ph == 17) { phase_final(p); return; }
  const int l = (ph - 1) >> 3, s = (ph - 1) & 7;
  switch (s) {
    case 0: phase_norm(p, l); break;
    case 1: phase_proj(p, l, smem); break;
    case 2: {
      attn_prep(p, l, dry);
      if (l == 0) for (int c = bid; c < 512; c += nb) hyena_ctx_task(p, l, c, smem, dry);
      for (int c = bid; c < 512; c += nb) hyena_latent_task(p, l, c, smem, dry);
    } break;
    case 3: for (int t = bid; t < 16 * NCK; t += nb) gla_g1_task(p, l, t / NCK, t % NCK, smem); break;
    case 4: gla_g2(p, dry); break;
    case 5: {
      for (int it = bid; it < 1024; it += nb) { const int b = it >> 9, g = (it >> 8) & 1, qb = it & 255; attn_item(p, l, b, g, LC + qb * 64, NCK, smem, dry); }
      if (l == 0) for (int it = bid; it < 16; it += nb) { const int b = it >> 3, g = (it >> 2) & 1, qb = it & 3; attn_item(p, l, b, g, qb * 64, 4, smem, dry); }
      const int c0 = (l == 0) ? 0 : 4, per = NCK - c0;
      for (int t = bid; t < 8 * per; t += nb) { const int bh = t / per, ci = c0 + t % per; gla_g3_task(p, l, bh >> 2, bh & 3, ci, smem, dry); }
    } break;
    case 6: phase_merge(p, l, smem); break;
    case 7: phase_out(p, l, smem); break;
  }
}

#if MULTI_LAUNCH
template <int PH> __global__ void __launch_bounds__(NT) phase_kernel(Params p) {
  extern __shared__ __attribute__((aligned(16))) char smem[];
  run_phase(p, PH, smem);
}
template <int PH> static void launch_phase(const Params& p, int grid, hipStream_t stream) {
  static bool attr = false;
  if (!attr) { (void)hipFuncSetAttribute((const void*)phase_kernel<PH>, hipFuncAttributeMaxDynamicSharedMemorySize, LDS_BYTES); attr = true; }
  hipLaunchKernelGGL(phase_kernel<PH>, dim3(grid), dim3(NT), LDS_BYTES, stream, p);
}
#else
DI unsigned xb_ld(unsigned* q) { return __hip_atomic_load(q, __ATOMIC_RELAXED, __HIP_MEMORY_SCOPE_AGENT); }
DI unsigned xb_add(unsigned* q, unsigned v) { return __hip_atomic_fetch_add(q, v, __ATOMIC_RELAXED, __HIP_MEMORY_SCOPE_AGENT); }
DI unsigned xb_xcc_id() { return (unsigned)__builtin_amdgcn_s_getreg((3 << 11) | 20) & 0xFu; }
#define XB_SPIN(cond) do { unsigned sp_ = 0; while ((cond) && ++sp_ < 400000u) __builtin_amdgcn_s_sleep(1); } while (0)
DI void gbar_census(const Params& p) {
  if (threadIdx.x == 0) (void)xb_add((unsigned*)(p.ws + OFF_BAR) + xb_xcc_id() * 64, 1u);
}
DI void gbar_setup(const Params& p, char* smem) {
  if (threadIdx.x == 0) {
    unsigned* bar = (unsigned*)(p.ws + OFF_BAR);
    const unsigned x = xb_xcc_id();
    unsigned mine = 1u, cnt = 0u;
    for (unsigned j = 0; j < 16; ++j) { const unsigned c = xb_ld(bar + j * 64); cnt += (c > 0u) ? 1u : 0u; if (j == x) mine = c; }
    volatile unsigned* st = (volatile unsigned*)(smem + BAR_LDS);
    st[0] = mine > 0u ? mine : 1u; st[1] = cnt > 0u ? cnt : 1u;
  }
  __syncthreads();
}
DI void gbar(const Params& p, unsigned k, char* smem) {
  asm volatile("s_waitcnt vmcnt(0)" ::: "memory");
  __syncthreads();
  if (threadIdx.x == 0) {
    unsigned* bar = (unsigned*)(p.ws + OFF_BAR);
    volatile unsigned* st = (volatile unsigned*)(smem + BAR_LDS);
    const unsigned nloc = st[0], nx = st[1], x = xb_xcc_id();
    __builtin_amdgcn_s_waitcnt(0);
    const unsigned old = xb_add(bar + (16 + x) * 64, 1u);
    if (old + 1u == k * nloc) {
      __builtin_amdgcn_fence(__ATOMIC_RELEASE, "agent");
      asm volatile("s_waitcnt vmcnt(0)" ::: "memory");
      const unsigned og = xb_add(bar + 48 * 64, 1u);
      if (og + 1u == k * nx) xb_add(bar + 49 * 64, 1u);
      else XB_SPIN(xb_ld(bar + 49 * 64) < k);
      __builtin_amdgcn_fence(__ATOMIC_ACQUIRE, "agent");
      xb_add(bar + (32 + x) * 64, 1u);
      asm volatile("s_waitcnt vmcnt(0)" ::: "memory");
    } else {
      XB_SPIN(xb_ld(bar + (32 + x) * 64) < k);
      __builtin_amdgcn_fence(__ATOMIC_ACQUIRE, "agent");
      asm volatile("s_waitcnt vmcnt(0)" ::: "memory");
    }
  }
  __syncthreads();
}
#ifndef PROBE_DUP
#define PROBE_DUP -1
#endif
#ifndef PROBE_DUP2
#define PROBE_DUP2 -1
#endif
#ifndef PROBE_DUP3
#define PROBE_DUP3 -1
#endif
__global__ void __launch_bounds__(NT) fwd_kernel(Params p) {
  extern __shared__ __attribute__((aligned(16))) char smem[];
  cg::grid_group grid = cg::this_grid();
#if PROBE_DUP >= 0
#define PHS(n) if ((n) == PROBE_DUP || (n) == PROBE_DUP2 || (n) == PROBE_DUP3) { run_phase(p, n, smem, p.phase_lo == 0 ? 1 : 0); grid.sync(); } run_phase(p, n, smem); grid.sync();
#else
#define PHS(n) run_phase(p, n, smem); if ((n) == 0) { grid.sync(); gbar_setup(p, smem); } else gbar(p, (unsigned)(n), smem);
#endif
  gbar_census(p);
  PHS(0) PHS(1) PHS(2) PHS(3) PHS(4) PHS(5) PHS(6) PHS(7) PHS(8)
  PHS(9) PHS(10) PHS(11) PHS(12) PHS(13) PHS(14) PHS(15) PHS(16)
  run_phase(p, 17, smem);
}
#endif

extern "C" void kernel_launch(void* const* d_in, const int* in_sizes, int n_in, void* d_out, int out_size, void* d_ws, size_t ws_size,
                              hipStream_t stream) {
  static int grid = 0;
  if (grid == 0) {
    if (n_in != 29 || ws_size < WS_END) { fprintf(stderr, "kernel_launch: need 29 inputs and %zu B of workspace, got %d / %zu\n", (size_t)WS_END, n_in, ws_size); grid = -1; return; }
#if MULTI_LAUNCH
    grid = 256;
#else
    int dev = 0, cus = 0, per_cu = 0;
    (void)hipGetDevice(&dev);
    (void)hipDeviceGetAttribute(&cus, hipDeviceAttributeMultiprocessorCount, dev);
    if (hipFuncSetAttribute((const void*)fwd_kernel, hipFuncAttributeMaxDynamicSharedMemorySize, LDS_BYTES) != hipSuccess) { fprintf(stderr, "kernel_launch: hipFuncSetAttribute failed\n"); grid = -1; return; }
    (void)hipOccupancyMaxActiveBlocksPerMultiprocessor(&per_cu, (const void*)fwd_kernel, NT, LDS_BYTES);
    if (per_cu < 1) { fprintf(stderr, "kernel_launch: occupancy query returned %d\n", per_cu); per_cu = 1; }
    (void)hipGetLastError();
    grid = cus * per_cu;
    if (grid > 256) grid = 256;
#endif
  }
  if (grid < 0) return;
  Params p{};
  const float** pp = (const float**)&p;
  for (int i = 0; i < 29; ++i) pp[i] = (const float*)d_in[i];
  p.out = (float*)d_out; p.ws = (char*)d_ws;
  p.phase_lo = 0; p.phase_hi = 18;
#if MULTI_LAUNCH
  launch_phase<0>(p, grid, stream); launch_phase<1>(p, grid, stream); launch_phase<2>(p, grid, stream); launch_phase<3>(p, grid, stream);
  launch_phase<4>(p, grid, stream); launch_phase<5>(p, grid, stream); launch_phase<6>(p, grid, stream); launch_phase<7>(p, grid, stream);
  launch_phase<8>(p, grid, stream); launch_phase<9>(p, grid, stream); launch_phase<10>(p, grid, stream); launch_phase<11>(p, grid, stream);
  launch_phase<12>(p, grid, stream); launch_phase<13>(p, grid, stream); launch_phase<14>(p, grid, stream); launch_phase<15>(p, grid, stream);
  launch_phase<16>(p, grid, stream); launch_phase<17>(p, grid, stream);
#else
  if (hipMemsetAsync((char*)d_ws + OFF_BAR, 0, BAR_BYTES, stream) != hipSuccess) { fprintf(stderr, "kernel_launch: barrier memset failed\n"); return; }
  void* args[] = {&p};
  hipError_t e = hipLaunchCooperativeKernel((const void*)fwd_kernel, dim3(grid), dim3(NT), args, LDS_BYTES, stream);
  if (e != hipSuccess) fprintf(stderr, "kernel_launch: cooperative launch failed: %s (grid %d)\n", hipGetErrorString(e), grid);
#endif
}
```
